# Optimizing an MI355X kernel written in HIP

```python
import jax, jax.numpy as jnp
from jax import lax
import numpy as np

D_MODEL = 1024
BATCH = 8
SEQ = 4096
DEPTH = 4

MLA_HEADS = 8
MLA_NOPE_DIM = 64
MLA_ROPE_DIM = 32
MLA_V_DIM = 64
MLA_Q_RANK = 256
MLA_KV_RANK = 128
ROPE_THETA = 10000.0
FOX_HEADS = 4
FOX_HEAD_DIM = 64
CONV_CHANNELS = 256
CONV_GROUPS = 4
CONV_WIDTH = 31
MLA_WIDTH = MLA_HEADS * MLA_V_DIM
FOX_WIDTH = FOX_HEADS * FOX_HEAD_DIM
MIX_WIDTH = MLA_WIDTH + FOX_WIDTH + CONV_CHANNELS
IN_SIZES = (MLA_Q_RANK, MLA_KV_RANK, MLA_ROPE_DIM, FOX_WIDTH, FOX_WIDTH, FOX_WIDTH, FOX_HEADS, 2 * CONV_CHANNELS)
IN_COLS = sum(IN_SIZES)
D_FF_DENSE = 2816
N_EXPERTS = 8
TOP_K = 2
D_FF_EXPERT = 1408
Q_BLOCK = 128
ALPHA = (2.0 * DEPTH) ** 0.25
BETA = (8.0 * DEPTH) ** -0.25
NORM_EPS = 1e-5

kernel_name = 'hybrid_mla_fox_conformer_moe_deepnorm'


def layer_norm(x, g, b):
    xf = x.astype(jnp.float32)
    mu = jnp.mean(xf, axis=-1, keepdims=True)
    var = jnp.mean(jnp.square(xf - mu), axis=-1, keepdims=True)
    return ((xf - mu) * lax.rsqrt(var + NORM_EPS) * g.astype(jnp.float32) + b.astype(jnp.float32)).astype(x.dtype)


def rms_norm(x, g):
    xf = x.astype(jnp.float32)
    ms = jnp.mean(jnp.square(xf), axis=-1, keepdims=True)
    return (xf * lax.rsqrt(ms + NORM_EPS) * g.astype(jnp.float32)).astype(x.dtype)


def group_norm_per_position(x, g, b):
    bsz, s, c = x.shape
    xf = x.astype(jnp.float32).reshape(bsz, s, CONV_GROUPS, c // CONV_GROUPS)
    mu = jnp.mean(xf, axis=-1, keepdims=True)
    var = jnp.mean(jnp.square(xf - mu), axis=-1, keepdims=True)
    xn = ((xf - mu) * lax.rsqrt(var + NORM_EPS)).reshape(bsz, s, c)
    return (xn * g.astype(jnp.float32) + b.astype(jnp.float32)).astype(x.dtype)


def rope_tables(positions):
    inv_freq = ROPE_THETA ** (-jnp.arange(0, MLA_ROPE_DIM, 2, dtype=jnp.float32) / MLA_ROPE_DIM)
    ang = positions.astype(jnp.float32)[..., None] * inv_freq
    return jnp.cos(ang), jnp.sin(ang)


def apply_rope(x, cos, sin):
    x1, x2 = jnp.split(x.astype(jnp.float32), 2, axis=-1)
    return jnp.concatenate([x1 * cos - x2 * sin, x1 * sin + x2 * cos], axis=-1).astype(x.dtype)


def causal_block_attention(q, k, v, scale, log_decay_cum=None):
    bsz, s, h, _ = q.shape
    n_blocks = s // Q_BLOCK
    kf = k.astype(jnp.float32)
    vf = v.astype(jnp.float32)
    k_pos = jnp.arange(s)
    cum_t = None if log_decay_cum is None else jnp.transpose(log_decay_cum.astype(jnp.float32), (0, 2, 1))

    def one_block(i):
        start = i * Q_BLOCK
        qb = lax.dynamic_slice_in_dim(q, start, Q_BLOCK, axis=1).astype(jnp.float32)
        logits = jnp.einsum('bqhd,bkhd->bhqk', qb, kf) * scale
        if cum_t is not None:
            cq = lax.dynamic_slice_in_dim(cum_t, start, Q_BLOCK, axis=2)
            logits = logits + cq[..., None] - cum_t[:, :, None, :]
        q_pos = start + jnp.arange(Q_BLOCK)
        mask = k_pos[None, :] <= q_pos[:, None]
        logits = jnp.where(mask, logits, -jnp.inf)
        p = jax.nn.softmax(logits, axis=-1)
        return jnp.einsum('bhqk,bkhd->bqhd', p, vf)

    out = lax.map(one_block, jnp.arange(n_blocks))
    out = jnp.moveaxis(out, 0, 1).reshape(bsz, s, h, vf.shape[-1])
    return out.astype(v.dtype)


def hybrid_mixer(x, cos, sin, w_in, mla_q_norm_g, w_uq, mla_kv_norm_g, w_ukv, fox_forget_b,
                 conv_w, conv_b, conv_norm_g, conv_norm_b, mla_out_norm_g, fox_out_norm_g, w_out):
    bsz, s, _ = x.shape
    proj = jnp.einsum('bsd,dc->bsc', x, w_in)
    offsets = np.cumsum(IN_SIZES)[:-1].tolist()
    c_q, c_kv, k_rope, fq, fk, fv, f_logit, conv_in = jnp.split(proj, offsets, axis=-1)

    q = jnp.einsum('bsr,rc->bsc', rms_norm(c_q, mla_q_norm_g), w_uq)
    q = q.reshape(bsz, s, MLA_HEADS, MLA_NOPE_DIM + MLA_ROPE_DIM)
    q_nope, q_rope = q[..., :MLA_NOPE_DIM], q[..., MLA_NOPE_DIM:]
    kv = jnp.einsum('bsr,rc->bsc', rms_norm(c_kv, mla_kv_norm_g), w_ukv)
    kv = kv.reshape(bsz, s, MLA_HEADS, MLA_NOPE_DIM + MLA_V_DIM)
    k_nope, v_mla = kv[..., :MLA_NOPE_DIM], kv[..., MLA_NOPE_DIM:]
    q_rope = apply_rope(q_rope, cos[:, :, None, :], sin[:, :, None, :])
    k_rope = apply_rope(k_rope, cos, sin)
    q_mla = jnp.concatenate([q_nope, q_rope], axis=-1)
    k_mla = jnp.concatenate(
        [k_nope, jnp.broadcast_to(k_rope[:, :, None, :], (bsz, s, MLA_HEADS, MLA_ROPE_DIM))], axis=-1)
    mla = causal_block_attention(q_mla, k_mla, v_mla, (MLA_NOPE_DIM + MLA_ROPE_DIM) ** -0.5)
    mla = mla.reshape(bsz, s, MLA_WIDTH)

    log_f = jax.nn.log_sigmoid(f_logit.astype(jnp.float32) + fox_forget_b.astype(jnp.float32))
    cum = jnp.cumsum(log_f, axis=1)
    fox = causal_block_attention(
        fq.reshape(bsz, s, FOX_HEADS, FOX_HEAD_DIM),
        fk.reshape(bsz, s, FOX_HEADS, FOX_HEAD_DIM),
        fv.reshape(bsz, s, FOX_HEADS, FOX_HEAD_DIM),
        FOX_HEAD_DIM ** -0.5, cum)
    fox = fox.reshape(bsz, s, FOX_WIDTH)

    a, g = jnp.split(conv_in, 2, axis=-1)
    h = a * jax.nn.sigmoid(g)
    h = lax.conv_general_dilated(
        h, conv_w[:, None, :], window_strides=(1,), padding=[(CONV_WIDTH - 1, 0)],
        dimension_numbers=('NWC', 'WIO', 'NWC'), feature_group_count=CONV_CHANNELS) + conv_b
    h = jax.nn.silu(group_norm_per_position(h, conv_norm_g, conv_norm_b))

    mixed = jnp.concatenate([rms_norm(mla, mla_out_norm_g), rms_norm(fox, fox_out_norm_g), h], axis=-1)
    return jnp.einsum('bsc,cd->bsd', mixed, w_out)


def swiglu(x, w1, w3, w2):
    hid = jax.nn.silu(jnp.einsum('bsd,df->bsf', x, w1)) * jnp.einsum('bsd,df->bsf', x, w3)
    return jnp.einsum('bsf,fd->bsd', hid, w2)


def moe_swiglu(x, router_w, w1, w3, w2):
    logits = jnp.einsum('bsd,de->bse', x, router_w).astype(jnp.float32)
    top_val, top_idx = lax.top_k(logits, TOP_K)
    top_w = jax.nn.softmax(top_val, axis=-1)
    gates = jnp.sum(jax.nn.one_hot(top_idx, N_EXPERTS, dtype=jnp.float32) * top_w[..., None], axis=-2)
    y = jnp.zeros_like(x)
    for e in range(N_EXPERTS):
        y = y + gates[..., e:e + 1].astype(x.dtype) * swiglu(x, w1[e], w3[e], w2[e])
    return y


def setup_inputs(seed: int = 0) -> dict:
    key = jax.random.key(seed)
    keys = jax.random.split(key, 40)
    ks = [keys[i] for i in range(40)]
    f32 = jnp.float32
    n_dense = (DEPTH + 1) // 2
    n_moe = DEPTH // 2

    def nrm(shape, scale):
        return jax.random.normal(ks.pop(), shape, f32) * scale

    def gain(shape):
        return 1.0 + 0.02 * jax.random.normal(ks.pop(), shape, f32)

    x = jax.random.normal(ks.pop(), (BATCH, SEQ, D_MODEL), f32)
    positions = jnp.tile(jnp.arange(SEQ, dtype=jnp.int32)[None, :], (BATCH, 1))
    return {
        'x': x,
        'positions': positions,
        'w_in': nrm((DEPTH, D_MODEL, IN_COLS), D_MODEL ** -0.5),
        'mla_q_norm_g': gain((DEPTH, MLA_Q_RANK)),
        'w_uq': nrm((DEPTH, MLA_Q_RANK, MLA_HEADS * (MLA_NOPE_DIM + MLA_ROPE_DIM)), MLA_Q_RANK ** -0.5),
        'mla_kv_norm_g': gain((DEPTH, MLA_KV_RANK)),
        'w_ukv': nrm((DEPTH, MLA_KV_RANK, MLA_HEADS * (MLA_NOPE_DIM + MLA_V_DIM)), MLA_KV_RANK ** -0.5),
        'fox_forget_b': jax.random.uniform(ks.pop(), (DEPTH, FOX_HEADS), f32, minval=1.0, maxval=5.0),
        'conv_w': nrm((DEPTH, CONV_WIDTH, CONV_CHANNELS), CONV_WIDTH ** -0.5),
        'conv_b': nrm((DEPTH, CONV_CHANNELS), 0.02),
        'conv_norm_g': gain((DEPTH, CONV_CHANNELS)),
        'conv_norm_b': nrm((DEPTH, CONV_CHANNELS), 0.02),
        'mla_out_norm_g': gain((DEPTH, MLA_WIDTH)),
        'fox_out_norm_g': gain((DEPTH, FOX_WIDTH)),
        'w_out': nrm((DEPTH, MIX_WIDTH, D_MODEL), BETA * MIX_WIDTH ** -0.5),
        'ln1_g': gain((DEPTH, D_MODEL)),
        'ln1_b': nrm((DEPTH, D_MODEL), 0.02),
        'dense_w1': nrm((n_dense, D_MODEL, D_FF_DENSE), D_MODEL ** -0.5),
        'dense_w3': nrm((n_dense, D_MODEL, D_FF_DENSE), D_MODEL ** -0.5),
        'dense_w2': nrm((n_dense, D_FF_DENSE, D_MODEL), BETA * D_FF_DENSE ** -0.5),
        'router_w': nrm((n_moe, D_MODEL, N_EXPERTS), D_MODEL ** -0.5),
        'expert_w1': nrm((n_moe, N_EXPERTS, D_MODEL, D_FF_EXPERT), D_MODEL ** -0.5),
        'expert_w3': nrm((n_moe, N_EXPERTS, D_MODEL, D_FF_EXPERT), D_MODEL ** -0.5),
        'expert_w2': nrm((n_moe, N_EXPERTS, D_FF_EXPERT, D_MODEL), BETA * D_FF_EXPERT ** -0.5),
        'ln2_g': gain((DEPTH, D_MODEL)),
        'ln2_b': nrm((DEPTH, D_MODEL), 0.02),
    }


def reference(x, positions, w_in, mla_q_norm_g, w_uq, mla_kv_norm_g, w_ukv, fox_forget_b,
              conv_w, conv_b, conv_norm_g, conv_norm_b, mla_out_norm_g, fox_out_norm_g, w_out,
              ln1_g, ln1_b, dense_w1, dense_w3, dense_w2, router_w, expert_w1, expert_w3,
              expert_w2, ln2_g, ln2_b):
    cos, sin = rope_tables(positions)
    for layer in range(DEPTH):
        mix = hybrid_mixer(x, cos, sin, w_in[layer], mla_q_norm_g[layer], w_uq[layer],
                           mla_kv_norm_g[layer], w_ukv[layer], fox_forget_b[layer],
                           conv_w[layer], conv_b[layer], conv_norm_g[layer], conv_norm_b[layer],
                           mla_out_norm_g[layer], fox_out_norm_g[layer], w_out[layer])
        x = layer_norm(ALPHA * x + mix, ln1_g[layer], ln1_b[layer])
        j = layer // 2
        if layer % 2 == 0:
            ff = swiglu(x, dense_w1[j], dense_w3[j], dense_w2[j])
        else:
            ff = moe_swiglu(x, router_w[j], expert_w1[j], expert_w3[j], expert_w2[j])
        x = layer_norm(ALPHA * x + ff, ln2_g[layer], ln2_b[layer])
    return x
```

```cpp
#include <hip/hip_runtime.h>
#include <cstdio>
#include <cstdint>
#include <cmath>

#define GAS __attribute__((address_space(1)))
#define LAS __attribute__((address_space(3)))
typedef unsigned short bf16;
typedef short bf16x8 __attribute__((ext_vector_type(8)));
typedef short s16x4 __attribute__((ext_vector_type(4)));
typedef float f32x2 __attribute__((ext_vector_type(2)));
typedef float f32x4 __attribute__((ext_vector_type(4)));
typedef float f32x16 __attribute__((ext_vector_type(16)));
typedef unsigned u32x2 __attribute__((ext_vector_type(2)));
typedef unsigned u32x4 __attribute__((ext_vector_type(4)));
typedef __bf16 bf16x2_t __attribute__((ext_vector_type(2)));

constexpr int BATCH = 8, SEQ = 4096, DM = 1024, M = BATCH * SEQ, DEPTH = 4;
constexpr int IN_COLS = 1700, NP1 = 1792;
constexpr int DFF = 2816, DFE = 1408, NEXP = 8;
constexpr int NWAVES = 8, NTHR = 512;
constexpr float ALPHA = 1.6817928305074290f;
constexpr float EPS = 1e-5f;
constexpr float LOG2E = 1.4426950408889634f;
constexpr float C2_MLA = 0.10206207261596577f * LOG2E;
constexpr float C2_FOX = 0.125f * LOG2E;
constexpr int PC_CQ = 0, PC_CKV = 256, PC_KR = 384, PC_FL = 416, PC_FQ = 512, PC_FK = 768, PC_FV = 1024, PC_CI = 1280;
constexpr int MOE_ROWS_MAX = 2 * M + NEXP * 256;

constexpr size_t MiB = 1u << 20;
constexpr size_t WS_CTL = 0, CTL_ZERO_BYTES = 1 * MiB;
constexpr size_t WS_WIN = 1 * MiB;
constexpr size_t WS_WQ2 = WS_WIN + 14 * MiB;
constexpr size_t WS_WOUT = WS_WQ2 + 4 * MiB;
constexpr size_t WS_TAB = WS_WOUT + 8 * MiB;
constexpr size_t WS_MOE = WS_TAB + 4 * MiB;
constexpr size_t WS_WFFN = WS_MOE + 2 * MiB;
constexpr size_t WS_XB = WS_WFFN + 68 * MiB;
constexpr size_t WS_SCR = WS_XB + 64 * MiB;
constexpr size_t SC_CQKV = 0;
constexpr size_t SC_KR = SC_CQKV + 32 * MiB;
constexpr size_t SC_FL = SC_KR + 4 * MiB;
constexpr size_t SC_CUM = SC_FL + MiB / 2;
constexpr size_t SC_FQ = SC_CUM + MiB / 2;
constexpr size_t SC_CI = SC_FQ + 48 * MiB;
constexpr size_t SC_QM = SC_CI + 32 * MiB;
constexpr size_t SC_KM = SC_QM + 48 * MiB;
constexpr size_t SC_VM = SC_KM + 48 * MiB;
constexpr size_t SC_MIXED = SC_VM + 32 * MiB;
constexpr size_t SC_MIXOUT = SC_QM;
constexpr size_t SC_MIX_END = SC_MIXED + 64 * MiB;
constexpr size_t SC_HID = 0;
constexpr size_t SC_FF = 182 * MiB;
constexpr size_t SC_END = 316 * MiB;
constexpr size_t WS_END = WS_SCR + SC_END;
static_assert(SC_MIX_END <= SC_END && SC_FF + (size_t)MOE_ROWS_MAX * 1024 * 2 <= SC_END && (size_t)MOE_ROWS_MAX * DFE * 2 <= SC_FF, "scratch map");
static_assert(WS_END <= 512 * MiB, "workspace map");
constexpr size_t WF_W13_ELEMS = (size_t)NEXP * 2 * DFE * DM;
constexpr size_t MT_TOPE = 0;
constexpr size_t MT_TOPG = 256 * 1024;
constexpr size_t MT_TOKSLOT = 512 * 1024;
constexpr size_t MT_SLOTTOK = 768 * 1024;
constexpr size_t MT_SLOTGATE = 768 * 1024 + 272 * 1024;
static_assert((size_t)MOE_ROWS_MAX * 4 <= 272 * 1024 && MT_SLOTGATE + 272 * 1024 <= 2 * MiB, "moe tables");
constexpr int CW_BAR = 4096;
constexpr int CW_CNTB = 16384;
constexpr int CW_SEG = 20480;

constexpr int RING_BYTES = 131072;
constexpr int LDSCTL_OFF = RING_BYTES, MISC_OFF = LDSCTL_OFF + 320;
constexpr int LDS_BYTES = 147456;

#define RLX_AGENT __ATOMIC_RELAXED, __HIP_MEMORY_SCOPE_AGENT
__device__ __forceinline__ unsigned pk2(float lo, float hi) { f32x2 v = {lo, hi}; bf16x2_t b = __builtin_convertvector(v, bf16x2_t); return __builtin_bit_cast(unsigned, b); }
__device__ __forceinline__ float bf2f(unsigned short u) { return __uint_as_float((unsigned)u << 16); }
__device__ __forceinline__ float bflo(unsigned u) { return __uint_as_float(u << 16); }
__device__ __forceinline__ float bfhi(unsigned u) { return __uint_as_float(u & 0xffff0000u); }
__device__ __forceinline__ float fexp2(float x) { return __builtin_amdgcn_exp2f(x); }
__device__ __forceinline__ float frcp(float x) { return __builtin_amdgcn_rcpf(x); }
__device__ __forceinline__ float sigmoidf_(float x) { return frcp(1.0f + fexp2(-x * LOG2E)); }
__device__ __forceinline__ float siluf_(float x) { return x * sigmoidf_(x); }
template <int O> __device__ __forceinline__ float lane_xor(float v) {
    if constexpr (O < 32) return __int_as_float(__builtin_amdgcn_ds_swizzle(__float_as_int(v), (O << 10) | 0x1f));
    else { auto rr = __builtin_amdgcn_permlane32_swap(__float_as_uint(v), __float_as_uint(v), false, false); return __uint_as_float(rr[0]) == v ? __uint_as_float(rr[1]) : __uint_as_float(rr[0]); }
}
__device__ __forceinline__ float wave_sum(float v) {
    v += lane_xor<1>(v); v += lane_xor<2>(v); v += lane_xor<4>(v); v += lane_xor<8>(v); v += lane_xor<16>(v);
    { auto rr = __builtin_amdgcn_permlane32_swap(__float_as_uint(v), __float_as_uint(v), false, false); v = __uint_as_float(rr[0]) + __uint_as_float(rr[1]); }
    return v;
}
__device__ __forceinline__ int wave_sum_i(int v) {
    v += __builtin_amdgcn_ds_swizzle(v, (1 << 10) | 0x1f); v += __builtin_amdgcn_ds_swizzle(v, (2 << 10) | 0x1f); v += __builtin_amdgcn_ds_swizzle(v, (4 << 10) | 0x1f);
    v += __builtin_amdgcn_ds_swizzle(v, (8 << 10) | 0x1f); v += __builtin_amdgcn_ds_swizzle(v, (16 << 10) | 0x1f);
    { auto rr = __builtin_amdgcn_permlane32_swap((unsigned)v, (unsigned)v, false, false); v = (int)(rr[0] + rr[1]); }
    return v;
}
__device__ __forceinline__ u32x4 pack8(const f32x4 a, const f32x4 b) { u32x4 w; w.x = pk2(a[0], a[1]); w.y = pk2(a[2], a[3]); w.z = pk2(b[0], b[1]); w.w = pk2(b[2], b[3]); return w; }

#define XB_TMO      128
#define XB_XCNT(j)  (256  + 64 * (j))
#define XB_XSUB(j)  (1280 + 64 * (j))
#define XB_XGEN(j)  (2304 + 64 * (j))
#define XB_TOP      3328
#define XB_TOPGEN   3392
#define XCD_BAR_WORDS 3456
#define XB_SPIN_CAP (1u << 18)
__device__ __forceinline__ unsigned xb_ld(unsigned* p)              { return __hip_atomic_load(p, __ATOMIC_RELAXED, __HIP_MEMORY_SCOPE_AGENT); }
__device__ __forceinline__ unsigned xb_add(unsigned* p, unsigned v) { return __hip_atomic_fetch_add(p, v, __ATOMIC_RELAXED, __HIP_MEMORY_SCOPE_AGENT); }
__device__ __forceinline__ unsigned xb_xcc_id() { return (unsigned)__builtin_amdgcn_s_getreg((3 << 11) | 20) & 0xFu; }
#define XB_SPIN(cond, bar) do { unsigned _sp = 0; while (cond) { __builtin_amdgcn_s_sleep(1); \
    if ((++_sp & 255u) == 0u) { if (xb_ld(&(bar)[XB_TMO])) break; if (_sp > XB_SPIN_CAP) { atomicAdd(&(bar)[XB_TMO], 1u); break; } } } } while (0)
struct XcdBarrier { unsigned* bar; unsigned x; volatile LAS unsigned* st; };
__device__ __forceinline__ bool xb_is_t0(int wave0) { unsigned ones = ~0u; asm volatile("" : "+s"(ones)); return wave0 == 0 && __builtin_amdgcn_mbcnt_hi(ones, __builtin_amdgcn_mbcnt_lo(ones, 0u)) == 0u; }
__device__ __forceinline__ XcdBarrier xcd_barrier_post(unsigned* bar, volatile LAS unsigned* st, int wave0) {
    XcdBarrier b; b.bar = bar; b.x = xb_xcc_id(); b.st = st;
    if (xb_is_t0(wave0)) (void)xb_add(&bar[XB_XCNT(b.x)], 1u);
    return b;
}
__device__ __forceinline__ void xcd_barrier_complete(unsigned* bar, unsigned x, unsigned& nloc, unsigned& nx) {
    const unsigned G = gridDim.x * gridDim.y * gridDim.z;
    unsigned sum, cnt, mine, sp = 0u;
    for (;;) {
        sum = 0u; cnt = 0u; mine = 0u;
#pragma unroll
        for (unsigned j = 0; j < 16; ++j) { const unsigned c = xb_ld(&bar[XB_XCNT(j)]); sum += c; cnt += (c > 0u) ? 1u : 0u; mine = (j == x) ? c : mine; }
        if (sum == G) break;
        __builtin_amdgcn_s_sleep(1);
        if ((++sp & 255u) == 0u) { if (xb_ld(&bar[XB_TMO])) break; if (sp > XB_SPIN_CAP) { atomicAdd(&bar[XB_TMO], 1u); break; } }
    }
    nloc = mine > 0u ? mine : 1u; nx = cnt > 0u ? cnt : 1u;
}
template <bool FIRST>
__device__ __forceinline__ void xcd_barrier(const XcdBarrier& b, int wave0) {
    asm volatile("s_waitcnt vmcnt(0)" ::: "memory");
    __syncthreads();
    if (xb_is_t0(wave0)) {
        unsigned* bar = b.bar;
        __builtin_amdgcn_s_waitcnt(0);
        unsigned nloc = b.st[0], nx = b.st[1];
        if constexpr (FIRST) { if (nloc == 0u) { xcd_barrier_complete(bar, b.x, nloc, nx); b.st[0] = nloc; b.st[1] = nx; } }
        const unsigned old = xb_add(&bar[XB_XSUB(b.x)], 1u);
        const unsigned gen = old / nloc;
        if (old + 1u == (gen + 1u) * nloc) {
            __builtin_amdgcn_fence(__ATOMIC_RELEASE, "agent");
            asm volatile("s_waitcnt vmcnt(0)" ::: "memory");
            const unsigned og = xb_add(&bar[XB_TOP], 1u);
            const unsigned tg = og / nx;
            if (og + 1u == (tg + 1u) * nx) xb_add(&bar[XB_TOPGEN], 1u);
            else XB_SPIN(xb_ld(&bar[XB_TOPGEN]) == tg, bar);
            __builtin_amdgcn_fence(__ATOMIC_ACQUIRE, "agent");
            xb_add(&bar[XB_XGEN(b.x)], 1u);
            asm volatile("s_waitcnt vmcnt(0)" ::: "memory");
        } else {
            XB_SPIN(xb_ld(&bar[XB_XGEN(b.x)]) == gen, bar);
            __builtin_amdgcn_fence(__ATOMIC_ACQUIRE, "agent");
            asm volatile("s_waitcnt vmcnt(0)" ::: "memory");
        }
    }
    __syncthreads();
}

namespace pg8 {
constexpr int BM = 256, BK = 64, HALF = 128, HTB = HALF * BK * 2, STAGE_BYTES = 8 * HTB, NXCD = 8, WGM = 8;
__host__ __device__ __forceinline__ int lds_byte(int r, int c) { const int st = (r >> 4) * 2 + (c >> 5), rr = r & 15, cc = c & 31, ob = rr * 64 + cc * 2; return st * 1024 + (ob ^ (((ob >> 9) & 1) << 5)); }
__host__ __device__ __forceinline__ void stage_rc(int b, int& R, int& C) { const int st = b / 1024, sb = b % 1024, swz = sb ^ (((sb >> 9) & 1) << 5); R = (st >> 1) * 16 + swz / 64; C = (st & 1) * 32 + (swz % 64) / 2; }
__host__ __device__ __forceinline__ int perm32(int rho) { const int n = rho >> 4, i = rho & 15; return 8 * (i >> 2) + 4 * n + (i & 3); }
struct Unit { int pm, pn; };

__device__ __forceinline__ bool tile_order(long L, int nM, int nN, int& pm, int& pn) {
    const int nwg = nM * nN; if (L >= nwg) return false;
    int wgid = (int)L; { const int q = nwg / NXCD, r = nwg % NXCD, xcd = wgid % NXCD, off = wgid / NXCD; wgid = (xcd < r ? xcd * (q + 1) : r * (q + 1) + (xcd - r) * q) + off; }
    const int nig = WGM * nN, gid = wgid / nig, fm = gid * WGM, gsz = (nM - fm) < WGM ? (nM - fm) : WGM;
    pm = fm + ((wgid % nig) % gsz); pn = (wgid % nig) / gsz; return true;
}
struct DenseOrder {
    const bf16* A; const bf16* Bt; int lda, ldb, nM, nN, G, c;
    __device__ __forceinline__ bool next(int i, Unit& u) const { return tile_order((long)i * G + c, nM, nN, u.pm, u.pn); }
    __device__ __forceinline__ const char* a_base(const Unit& u) const { return (const char*)A + (size_t)u.pm * BM * lda * 2; }
    __device__ __forceinline__ const char* b_base(const Unit& u) const { return (const char*)Bt + (size_t)u.pn * BM * ldb * 2; }
    __device__ __forceinline__ int tok(const Unit&, int) const { return 0; }
};

template <class Epi, class Sched, bool GATHER, int K, int lda, int ldb>
__device__ __forceinline__ void gemm_phase(LAS unsigned char* lds, const int tid, const Sched& S, const Epi& E) {
    const int wid = __builtin_amdgcn_readfirstlane(tid >> 6), lane = tid & 63, wr = wid >> 2, wc = wid & 3, fr = lane & 15, fq = lane >> 4;
    constexpr int nt = K / BK;
    unsigned voffA[2], voffB[2];
#pragma unroll
    for (int i = 0; i < 2; ++i) { int R, C; stage_rc(tid * 16 + i * 8192, R, C); const int Rb = Epi::PERM ? ((R & ~31) + perm32(R & 31)) : R;
        voffA[i] = (unsigned)(R * lda + C) * 2u; voffB[i] = (unsigned)(Rb * ldb + C) * 2u; }
#define PG8_GOFF(u_, h_, o0_, o1_) do { unsigned ones_ = ~0u; asm volatile("" : "+s"(ones_)); const int t_ = wid * 64 + (int)__builtin_amdgcn_mbcnt_hi(ones_, __builtin_amdgcn_mbcnt_lo(ones_, 0u)); \
        int R0_, C0_, R1_, C1_; stage_rc(t_ * 16, R0_, C0_); stage_rc(t_ * 16 + 8192, R1_, C1_); \
        o0_ = (unsigned)S.tok(u_, (h_) * HALF + R0_) * (unsigned)(lda * 2) + (unsigned)(C0_ * 2); o1_ = (unsigned)S.tok(u_, (h_) * HALF + R1_) * (unsigned)(lda * 2) + (unsigned)(C1_ * 2); } while (0)
    const size_t kstep = (size_t)(BK * 2);
    constexpr size_t hstepA = (size_t)HALF * lda * 2, hstepB = (size_t)HALF * ldb * 2;
    const unsigned ldsw = (unsigned)wid * 1024u;
    const int aoff = lds_byte(wr * 64 + fr, fq * 8), boff = lds_byte(wc * 32 + fr, fq * 8);
#define PG8_SA(b, h) (((b) * 2 + (h)) * HTB)
#define PG8_SB(b, h) ((4 + (b) * 2 + (h)) * HTB)
#define PG8_STAGE(bufoff, gbase, v0, v1) do { \
        __builtin_amdgcn_global_load_lds((const unsigned*)((const char*)(gbase) + (v0)), (LAS unsigned*)(lds + (bufoff) + ldsw), 16, 0, 0); \
        __builtin_amdgcn_global_load_lds((const unsigned*)((const char*)(gbase) + (v1)), (LAS unsigned*)(lds + (bufoff) + ldsw + 8192), 16, 0, 0); } while (0)
#define PG8_STB(bufoff, gbase) PG8_STAGE(bufoff, gbase, voffB[0], voffB[1])
#define PG8_STA(bufoff, gbase, h, G0, G1) do { if constexpr (GATHER) PG8_STAGE(bufoff, gbase, G0, G1); else PG8_STAGE(bufoff, (gbase) + (h) * hstepA, voffA[0], voffA[1]); } while (0)
#define PG8_LDA(dst, b, h) do { _Pragma("unroll") for (int m = 0; m < 4; ++m) _Pragma("unroll") for (int k = 0; k < 2; ++k) dst[m][k] = *(const LAS bf16x8*)(lds + PG8_SA(b, h) + aoff + m * 2048 + k * 1024); } while (0)
#define PG8_LDB(dst, b, h) do { _Pragma("unroll") for (int n = 0; n < 2; ++n) _Pragma("unroll") for (int k = 0; k < 2; ++k) dst[n][k] = *(const LAS bf16x8*)(lds + PG8_SB(b, h) + boff + n * 2048 + k * 1024); } while (0)
#define PG8_MMA(ai, bj, At, Bt) do { __builtin_amdgcn_s_setprio(1); _Pragma("unroll") for (int m = 0; m < 4; ++m) _Pragma("unroll") for (int n = 0; n < 2; ++n) _Pragma("unroll") for (int k = 0; k < 2; ++k) \
        acc[ai][bj][m][n] = __builtin_amdgcn_mfma_f32_16x16x32_bf16(Bt[n][k], At[m][k], acc[ai][bj][m][n], 0, 0, 0); __builtin_amdgcn_s_setprio(0); } while (0)
#define PG8_WAIT_V(n) asm volatile("s_waitcnt vmcnt(" #n ")" ::: "memory")
#define PG8_WAIT_L(n) asm volatile("s_waitcnt lgkmcnt(" #n ")" ::: "memory")
#define PG8_BAR __builtin_amdgcn_s_barrier()
#define PG8_SCHED __builtin_amdgcn_sched_barrier(0)
    Unit cur, nxt; int ui = 0;
    if (!S.next(0, cur)) return;
    f32x4 acc[2][2][4][2];
#pragma unroll
    for (int a = 0; a < 2; ++a)
#pragma unroll
        for (int b = 0; b < 2; ++b)
#pragma unroll
            for (int m = 0; m < 4; ++m)
#pragma unroll
                for (int n = 0; n < 2; ++n) acc[a][b][m][n] = (f32x4){0.f, 0.f, 0.f, 0.f};
    bf16x8 At[4][2], B0[2][2], B1[2][2];
    const char* cA = S.a_base(cur); const char* cB = S.b_base(cur);
    unsigned gc00 = 0, gc01 = 0, gc10 = 0, gc11 = 0, gn00 = 0, gn01 = 0, gn10 = 0, gn11 = 0;
    if constexpr (GATHER) { PG8_GOFF(cur, 0, gc00, gc01); PG8_GOFF(cur, 1, gc10, gc11); }
    PG8_STB(PG8_SB(0, 0), cB); PG8_STB(PG8_SB(0, 1), cB + hstepB); PG8_STA(PG8_SA(0, 0), cA, 0, gc00, gc01); PG8_STA(PG8_SA(0, 1), cA, 1, gc10, gc11);
    if (wr == 1) PG8_BAR;
    PG8_WAIT_V(2); PG8_BAR;
    PG8_STB(PG8_SB(1, 0), cB + kstep); PG8_STA(PG8_SA(1, 0), cA + kstep, 0, gc00, gc01); PG8_STB(PG8_SB(1, 1), cB + hstepB + kstep);
    PG8_WAIT_V(6); PG8_BAR;
    for (;;) {
        const bool has_next = S.next(ui + 1, nxt);
        const char* nA = has_next ? S.a_base(nxt) : cA; const char* nB = has_next ? S.b_base(nxt) : cB;
        if constexpr (GATHER) {
            if (has_next) { PG8_GOFF(nxt, 0, gn00, gn01); PG8_GOFF(nxt, 1, gn10, gn11); }
            else { gn00 = gc00; gn01 = gc01; gn10 = gc10; gn11 = gc11; }
        }
#pragma nounroll
        for (int t = 0; t < nt; t += 2) {
            const bool last = (t == nt - 2);
            const char* a1 = cA + (size_t)(t + 1) * kstep;
            const char* a2 = last ? nA : cA + (size_t)(t + 2) * kstep; const char* b2 = last ? nB : cB + (size_t)(t + 2) * kstep;
            const char* a3 = a2 + kstep; const char* b3 = b2 + kstep;
            const unsigned g00 = last ? gn00 : gc00, g01 = last ? gn01 : gc01, g10 = last ? gn10 : gc10, g11 = last ? gn11 : gc11;
            PG8_LDB(B0, 0, 0); PG8_LDB(B1, 0, 1); PG8_SCHED; PG8_LDA(At, 0, 0); PG8_STA(PG8_SA(1, 1), a1, 1, gc10, gc11);
            PG8_WAIT_V(8); PG8_WAIT_L(0); PG8_BAR; PG8_MMA(0, 0, At, B0); PG8_MMA(0, 1, At, B1); PG8_BAR; PG8_SCHED;
            PG8_LDA(At, 0, 1); PG8_STB(PG8_SB(0, 0), b2); PG8_STB(PG8_SB(0, 1), b2 + hstepB); PG8_STA(PG8_SA(0, 0), a2, 0, g00, g01);
            PG8_WAIT_V(8); PG8_WAIT_L(0); PG8_BAR; PG8_MMA(1, 0, At, B0); PG8_MMA(1, 1, At, B1); PG8_BAR; PG8_SCHED;
            PG8_LDB(B0, 1, 0); PG8_LDB(B1, 1, 1); PG8_SCHED; PG8_LDA(At, 1, 0); PG8_STA(PG8_SA(0, 1), a2, 1, g10, g11);
            PG8_WAIT_V(8); PG8_WAIT_L(0); PG8_BAR; PG8_MMA(0, 0, At, B0); PG8_MMA(0, 1, At, B1); PG8_BAR; PG8_SCHED;
            PG8_LDA(At, 1, 1); PG8_STB(PG8_SB(1, 0), b3); PG8_STB(PG8_SB(1, 1), b3 + hstepB); PG8_STA(PG8_SA(1, 0), a3, 0, g00, g01);
            PG8_WAIT_V(8); PG8_WAIT_L(0); PG8_BAR; PG8_MMA(1, 0, At, B0); PG8_MMA(1, 1, At, B1); PG8_BAR; PG8_SCHED;
        }
        if (wr == 0) PG8_BAR;
        { unsigned ones_ = ~0u; asm volatile("" : "+s"(ones_)); const int l_ = (int)__builtin_amdgcn_mbcnt_hi(ones_, __builtin_amdgcn_mbcnt_lo(ones_, 0u)); E(acc, cur, wr, wc, l_ & 15, l_ >> 4); }
        if (!has_next) break;
#pragma unroll
        for (int a = 0; a < 2; ++a)
#pragma unroll
            for (int b = 0; b < 2; ++b)
#pragma unroll
                for (int m = 0; m < 4; ++m)
#pragma unroll
                    for (int n = 0; n < 2; ++n) acc[a][b][m][n] = (f32x4){0.f, 0.f, 0.f, 0.f};
        cur = nxt; cA = nA; cB = nB; ++ui;
        if constexpr (GATHER) { gc00 = gn00; gc01 = gn01; gc10 = gn10; gc11 = gn11; }
        if (wr == 1) PG8_BAR;
    }
    PG8_WAIT_V(0);
    PG8_BAR;
#undef PG8_GOFF
#undef PG8_SA
#undef PG8_SB
#undef PG8_STAGE
#undef PG8_STB
#undef PG8_STA
#undef PG8_LDA
#undef PG8_LDB
#undef PG8_MMA
#undef PG8_WAIT_V
#undef PG8_WAIT_L
#undef PG8_BAR
#undef PG8_SCHED
}
}

#define EPI_ROWS_BEGIN _Pragma("unroll") for (int ai = 0; ai < 2; ++ai) _Pragma("unroll") for (int m = 0; m < 4; ++m) { const unsigned row = (unsigned)(u.pm * 256 + ai * 128 + wr * 64 + m * 16 + fr);
#define EPI_ROWS_END asm volatile("" ::: "memory"); }
__device__ __forceinline__ void st16(void* base, unsigned off, u32x4 v) { *(u32x4*)((char*)base + off) = v; }
struct EpiInProj {
    static constexpr bool PERM = true;
    bf16* CQ; bf16* CKV; float* KR; float* FL; bf16* FQ; bf16* CI;
    __device__ __forceinline__ void operator()(const f32x4 (&acc)[2][2][4][2], const pg8::Unit& u, int wr, int wc, int fr, int fq) const {
        const int t = u.pn; const unsigned c8 = (unsigned)(wc * 32 + 8 * fq);
        if (t != 1) {
            bf16* base; unsigned ld;
            if (t == 0) { base = CQ; ld = 256; } else if (t <= 4) { base = FQ + (size_t)(t - 2) * M * 256; ld = 256; } else { base = CI + (t - 5) * 256; ld = 512; }
            EPI_ROWS_BEGIN
                const unsigned off = (row * ld + c8) * 2u;
                st16(base, off, pack8(acc[ai][0][m][0], acc[ai][0][m][1]));
                st16(base, off + 256u, pack8(acc[ai][1][m][0], acc[ai][1][m][1]));
            EPI_ROWS_END
        } else {
            EPI_ROWS_BEGIN
                const unsigned off = (row * 256u + c8) * 2u;
                st16(CKV, off, pack8(acc[ai][0][m][0], acc[ai][0][m][1]));
                st16(CKV, off + 256u, (u32x4){0u, 0u, 0u, 0u});
                if (c8 < 32) { const unsigned ko = (row * 32u + c8) * 4u; *(f32x4*)((char*)KR + ko) = acc[ai][1][m][0]; *(f32x4*)((char*)KR + ko + 16) = acc[ai][1][m][1]; }
                else if (c8 == 32) { *(f32x4*)((char*)FL + row * 16u) = acc[ai][1][m][0]; }
            EPI_ROWS_END
        }
    }
};
struct EpiQKV {
    static constexpr bool PERM = true;
    bf16* QM; bf16* KM; bf16* VM; const float* COS; const float* SIN;
    __device__ __forceinline__ void operator()(const f32x4 (&acc)[2][2][4][2], const pg8::Unit& u, int wr, int wc, int fr, int fq) const {
        const int t = u.pn; const unsigned c8 = (unsigned)(wc * 32 + 8 * fq);
        if (t < 3) {
#pragma unroll
            for (int bj = 0; bj < 2; ++bj) {
                const unsigned col = (unsigned)(t * 256 + bj * 128) + c8, h = col / 96u, d = col - h * 96u;
                const bool rope = d >= 64; const unsigned f4 = rope ? ((d - 64) >> 1) : 0u;
                EPI_ROWS_BEGIN
                    f32x4 v0 = acc[ai][bj][m][0], v1 = acc[ai][bj][m][1];
                    if (rope) {
                        const unsigned to = (row * 16u + f4) * 4u;
                        const f32x4 c = *(const f32x4*)((const char*)COS + to), s = *(const f32x4*)((const char*)SIN + to);
                        const f32x4 a = v0, b = v1;
                        v0 = (f32x4){a[0] * c[0] - a[2] * s[0], a[1] * c[1] - a[3] * s[1], a[0] * s[0] + a[2] * c[0], a[1] * s[1] + a[3] * c[1]};
                        v1 = (f32x4){b[0] * c[2] - b[2] * s[2], b[1] * c[3] - b[3] * s[3], b[0] * s[2] + b[2] * c[2], b[1] * s[3] + b[3] * c[3]};
                    }
                    st16(QM, (row * 768u + col) * 2u, pack8(v0, v1));
                EPI_ROWS_END
            }
        } else if (t < 5) {
#pragma unroll
            for (int bj = 0; bj < 2; ++bj) {
                const unsigned kc = (unsigned)((t - 3) * 256 + bj * 128) + c8, h = kc >> 6, d = kc & 63;
                EPI_ROWS_BEGIN
                    st16(KM, (row * 768u + h * 96u + d) * 2u, pack8(acc[ai][bj][m][0], acc[ai][bj][m][1]));
                EPI_ROWS_END
            }
        } else {
#pragma unroll
            for (int bj = 0; bj < 2; ++bj) {
                const unsigned vc = (unsigned)((t - 5) * 256 + bj * 128) + c8;
                EPI_ROWS_BEGIN
                    st16(VM, (row * 512u + vc) * 2u, pack8(acc[ai][bj][m][0], acc[ai][bj][m][1]));
                EPI_ROWS_END
            }
        }
    }
};
template <int LDC, bool SCALE>
struct EpiBf16 {
    static constexpr bool PERM = true;
    bf16* O; int ntn; const float* rowscale;
    __device__ __forceinline__ void operator()(const f32x4 (&acc)[2][2][4][2], const pg8::Unit& u, int wr, int wc, int fr, int fq) const {
        const unsigned col = (unsigned)((u.pn % ntn) * 256 + wc * 32 + 8 * fq);
        EPI_ROWS_BEGIN
            float s = 1.0f; if constexpr (SCALE) s = *(const float*)((const char*)rowscale + row * 4u);
            const unsigned off = (row * (unsigned)LDC + col) * 2u;
            st16(O, off, pack8(acc[ai][0][m][0] * s, acc[ai][0][m][1] * s));
            st16(O, off + 256u, pack8(acc[ai][1][m][0] * s, acc[ai][1][m][1] * s));
        EPI_ROWS_END
    }
};
template <int LDH>
struct EpiSwiGLU {
    static constexpr bool PERM = true;
    bf16* H; int ntn;
    __device__ __forceinline__ void operator()(const f32x4 (&acc)[2][2][4][2], const pg8::Unit& u, int wr, int wc, int fr, int fq) const {
        const unsigned col = (unsigned)((u.pn % ntn) * 128 + wc * 32 + 8 * fq);
        EPI_ROWS_BEGIN
            f32x4 a0 = acc[ai][0][m][0], a1 = acc[ai][0][m][1]; const f32x4 b0 = acc[ai][1][m][0], b1 = acc[ai][1][m][1];
#pragma unroll
            for (int j = 0; j < 4; ++j) { a0[j] = siluf_(a0[j]) * b0[j]; a1[j] = siluf_(a1[j]) * b1[j]; }
            st16(H, (row * (unsigned)LDH + col) * 2u, pack8(a0, a1));
        EPI_ROWS_END
    }
};
struct MoeOrder {
    const bf16* A; const bf16* Bt; int lda, ldb, nM, nN, G, c; const int* slot_tok; int s1, s2, s3, s4, s5, s6, s7;
    __device__ __forceinline__ int expert_of(int rt) const { const int r = rt * 256; return (r >= s1) + (r >= s2) + (r >= s3) + (r >= s4) + (r >= s5) + (r >= s6) + (r >= s7); }
    __device__ __forceinline__ bool next(int i, pg8::Unit& u) const { int pm, pn; if (!pg8::tile_order((long)i * G + c, nM, nN, pm, pn)) return false; u.pm = pm; u.pn = expert_of(pm) * nN + pn; return true; }
    __device__ __forceinline__ const char* a_base(const pg8::Unit& u) const { return slot_tok ? (const char*)A : (const char*)A + (size_t)u.pm * 256 * lda * 2; }
    __device__ __forceinline__ const char* b_base(const pg8::Unit& u) const { return (const char*)Bt + (size_t)u.pn * 256 * ldb * 2; }
    __device__ __forceinline__ int tok(const pg8::Unit& u, int r) const { return slot_tok[u.pm * 256 + r]; }
};

namespace att {
__device__ __forceinline__ int crow(int r, int hi) { return (r & 3) + 8 * (r >> 2) + 4 * hi; }
__device__ __forceinline__ s16x4 vtr(const LAS unsigned char* p) { typedef short v4i16_t __attribute__((ext_vector_type(4))); return __builtin_bit_cast(s16x4, __builtin_amdgcn_ds_read_tr16_b64_v4i16((LAS v4i16_t*)p)); }
#define ATT_WAITBAR() asm volatile("s_waitcnt vmcnt(0) lgkmcnt(0)\n\ts_barrier" ::: "memory")

template <int DQK, bool BIAS>
__device__ __forceinline__ void attn_unit(int b, int h, int qb, const bf16* Q, int pq, const bf16* K, int pk, const bf16* V, int pv,
                                          bf16* O, int po, int ocol, const float* cum, LAS unsigned char* shm, const int tid) {
    constexpr int NCH = DQK / 8, KSLOT = NCH * 1024, ND0 = DQK / 16;
    constexpr int LK = 0, LV = 2 * KSLOT, LWS = LV + 2 * 8192, LOST = LWS + NWAVES * 256, LCUM = LOST + NWAVES * 4096;
    static_assert(LCUM + SEQ * 4 <= RING_BYTES, "attention LDS");
    const int lane = tid & 63, r32 = lane & 31, hi = lane >> 5; const int wid = __builtin_amdgcn_readfirstlane(tid >> 6);
    const long rowbase = (long)b * SEQ; const int q0 = qb * 256;
    const bf16* Qw = Q + (rowbase + q0 + wid * 32) * pq + h * DQK;
    const bf16* Kh = K + rowbase * pk + h * DQK; const bf16* Vh = V + rowbase * pv + h * 64;
    const int NT = (q0 + 256) / 64;
    LAS float* wsf = (LAS float*)(shm + LWS) + wid * 64;
    LAS float* cumL = (LAS float*)(shm + LCUM);
    if constexpr (BIAS) { const float* cs = cum + (size_t)(b * 4 + h) * SEQ; for (int i = tid * 4; i < q0 + 256; i += NTHR * 4) *(LAS f32x4*)(cumL + i) = *(const f32x4*)(cs + i); }
    const bf16* ksrc = Kh + (long)lane * pk + wid * 8;
    const bf16* vsrc = Vh + (long)(16 * (wid & 3) + (lane >> 2)) * pv + (wid >> 2) * 32 + (lane & 3) * 8;
#define ATT_DMA(t, slot) do { \
        __builtin_amdgcn_global_load_lds((const unsigned*)(ksrc + (long)(t) * 64 * pk), (LAS unsigned*)(shm + LK + (slot) * KSLOT + wid * 1024), 16, 0, 0); \
        if (NCH > 8 && wid + 8 < NCH) __builtin_amdgcn_global_load_lds((const unsigned*)(ksrc + (long)(t) * 64 * pk + 64), (LAS unsigned*)(shm + LK + (slot) * KSLOT + (wid + 8) * 1024), 16, 0, 0); \
        __builtin_amdgcn_global_load_lds((const unsigned*)(vsrc + (long)(t) * 64 * pv), (LAS unsigned*)(shm + LV + (slot) * 8192 + wid * 1024), 16, 0, 0); } while (0)
    ATT_DMA(0, 0);
    bf16x8 qr[ND0];
#pragma unroll
    for (int d0 = 0; d0 < ND0; ++d0) qr[d0] = *(const bf16x8*)(Qw + (long)r32 * pq + d0 * 16 + hi * 8);
    float mrow = -1e30f, lrow = 0.f; f32x16 o0 = {}, o1 = {};
    const int qrel = wid * 32 + r32;
    ATT_WAITBAR();
    float fqb = 0.f; if constexpr (BIAS) fqb = cumL[q0 + qrel];
    for (int t = 0; t < NT; ++t) {
        const int cur = t & 1;
        if (t + 1 < NT) ATT_DMA(t + 1, cur ^ 1);
        f32x16 p0 = {}, p1 = {};
        const LAS unsigned char* kp = shm + LK + cur * KSLOT + hi * 1024 + r32 * 16;
#pragma unroll
        for (int d0 = 0; d0 < ND0; ++d0) {
            const bf16x8 a0 = *(const LAS bf16x8*)(kp + d0 * 2048), a1 = *(const LAS bf16x8*)(kp + d0 * 2048 + 512);
            p0 = __builtin_amdgcn_mfma_f32_32x32x16_bf16(a0, qr[d0], p0, 0, 0, 0);
            p1 = __builtin_amdgcn_mfma_f32_32x32x16_bf16(a1, qr[d0], p1, 0, 0, 0);
        }
        if constexpr (BIAS) {
#pragma unroll
            for (int g = 0; g < 4; ++g) {
                const f32x4 f0 = *(const LAS f32x4*)(cumL + t * 64 + 8 * g + 4 * hi), f1 = *(const LAS f32x4*)(cumL + t * 64 + 32 + 8 * g + 4 * hi);
#pragma unroll
                for (int j = 0; j < 4; ++j) { p0[4 * g + j] += fqb - f0[j]; p1[4 * g + j] += fqb - f1[j]; }
            }
        }
        if (t >= NT - 4) {
            const int kb = 64 * (t - (NT - 4)) + 4 * hi;
#pragma unroll
            for (int r = 0; r < 16; ++r) { const int kv = kb + (r & 3) + 8 * (r >> 2); if (kv > qrel) p0[r] = -INFINITY; if (kv + 32 > qrel) p1[r] = -INFINITY; }
        }
        float rm = fmaxf(p0[0], p1[0]);
#pragma unroll
        for (int r = 1; r < 16; ++r) rm = fmaxf(rm, fmaxf(p0[r], p1[r]));
        { auto rr = __builtin_amdgcn_permlane32_swap(__float_as_uint(rm), __float_as_uint(rm), false, false); rm = fmaxf(__uint_as_float(rr[0]), __uint_as_float(rr[1])); }
        const float mnew = fmaxf(mrow, rm);
        const float alpha = fexp2(mrow - mnew);
        const bool grew = mnew > mrow;
        mrow = mnew;
        float ps = 0.f;
#pragma unroll
        for (int r = 0; r < 16; ++r) { p0[r] = fexp2(p0[r] - mnew); p1[r] = fexp2(p1[r] - mnew); ps += p0[r] + p1[r]; }
        lrow = lrow * alpha + ps;
        if (__builtin_amdgcn_ballot_w64(grew) != 0ull) {
            if (hi == 0) wsf[r32] = alpha;
#pragma unroll
            for (int g = 0; g < 4; ++g) { const f32x4 a4 = *(const LAS f32x4*)(wsf + 8 * g + 4 * hi);
#pragma unroll
                for (int j = 0; j < 4; ++j) { o0[4 * g + j] *= a4[j]; o1[4 * g + j] *= a4[j]; } }
        }
        u32x4 pw[4];
        pw[0] = (u32x4){pk2(p0[0], p0[1]), pk2(p0[2], p0[3]), pk2(p0[4], p0[5]), pk2(p0[6], p0[7])};
        pw[1] = (u32x4){pk2(p0[8], p0[9]), pk2(p0[10], p0[11]), pk2(p0[12], p0[13]), pk2(p0[14], p0[15])};
        pw[2] = (u32x4){pk2(p1[0], p1[1]), pk2(p1[2], p1[3]), pk2(p1[4], p1[5]), pk2(p1[6], p1[7])};
        pw[3] = (u32x4){pk2(p1[8], p1[9]), pk2(p1[10], p1[11]), pk2(p1[12], p1[13]), pk2(p1[14], p1[15])};
        const LAS unsigned char* vp = shm + LV + cur * 8192 + ((lane >> 4) & 1) * 32 + (lane & 3) * 8 + (4 * hi + ((lane & 15) >> 2)) * 64;
#pragma unroll
        for (int ks = 0; ks < 4; ++ks) {
            const s16x4 l0 = vtr(vp + ks * 1024), h0 = vtr(vp + ks * 1024 + 512), l1 = vtr(vp + 4096 + ks * 1024), h1 = vtr(vp + 4096 + ks * 1024 + 512);
            const bf16x8 v0 = (bf16x8){l0[0], l0[1], l0[2], l0[3], h0[0], h0[1], h0[2], h0[3]}, v1 = (bf16x8){l1[0], l1[1], l1[2], l1[3], h1[0], h1[1], h1[2], h1[3]};
            o0 = __builtin_amdgcn_mfma_f32_32x32x16_bf16(__builtin_bit_cast(bf16x8, pw[ks]), v0, o0, 0, 0, 0);
            o1 = __builtin_amdgcn_mfma_f32_32x32x16_bf16(__builtin_bit_cast(bf16x8, pw[ks]), v1, o1, 0, 0, 0);
        }
        ATT_WAITBAR();
    }
    { auto rr = __builtin_amdgcn_permlane32_swap(__float_as_uint(lrow), __float_as_uint(lrow), false, false); lrow = __uint_as_float(rr[0]) + __uint_as_float(rr[1]); }
    if (hi == 0) wsf[32 + r32] = lrow;
    LAS bf16* stg = (LAS bf16*)(shm + LOST) + wid * 2048;
#pragma unroll
    for (int g = 0; g < 4; ++g) { const f32x4 l4 = *(const LAS f32x4*)(wsf + 32 + 8 * g + 4 * hi);
#pragma unroll
        for (int j = 0; j < 4; ++j) { const int r = 4 * g + j, orow = crow(r, hi); const float rl = frcp(l4[j]);
            stg[orow * 64 + r32] = (bf16)(pk2(o0[r] * rl, 0.f) & 0xffffu); stg[orow * 64 + 32 + r32] = (bf16)(pk2(o1[r] * rl, 0.f) & 0xffffu); } }
    asm volatile("s_waitcnt lgkmcnt(0)" ::: "memory");
    bf16* Ow = O + (rowbase + q0 + wid * 32) * po + ocol;
#pragma unroll
    for (int i = 0; i < 4; ++i) { const int row = i * 8 + (lane >> 3), ch = lane & 7; const u32x4 v = *(const LAS u32x4*)(stg + row * 64 + ch * 8); *(u32x4*)(Ow + (long)row * po + ch * 8) = v; }
    asm volatile("s_waitcnt lgkmcnt(0)\n\ts_barrier" ::: "memory");
#undef ATT_DMA
}
}

struct Args { const float* in[26]; float* out; unsigned char* ws; int ph_lo, ph_hi; };
typedef const __attribute__((address_space(4))) Args* kargs_t;
struct Ctx {
    LAS unsigned char* lds; unsigned* ctl; unsigned char* ws; float* out;
    int tid, lane, wave, vcu, G, gw, NGW, bx;
};
__device__ __forceinline__ kargs_t opaque_args() { kargs_t p = (kargs_t)__builtin_amdgcn_kernarg_segment_ptr(); asm volatile("" : "+s"(p)); return p; }
__device__ __forceinline__ Ctx make_ctx(kargs_t A, LAS unsigned char* lds, int wave0) {
    Ctx C; unsigned ones = ~0u; asm volatile("" : "+s"(ones));
    int t = wave0 * 64 + (int)__builtin_amdgcn_mbcnt_hi(ones, __builtin_amdgcn_mbcnt_lo(ones, 0u)); asm volatile("" : "+v"(t));
    C.lds = lds; C.ws = A->ws; C.ctl = (unsigned*)(C.ws + WS_CTL); C.out = A->out;
    C.tid = t; C.lane = t & 63; C.wave = __builtin_amdgcn_readfirstlane(t >> 6);
    { int g_ = gridDim.x, b_ = blockIdx.x; asm volatile("" : "+s"(g_), "+s"(b_)); C.G = g_; C.bx = b_; } C.vcu = (C.bx % 8) * (C.G / 8) + C.bx / 8;
    C.gw = C.vcu * NWAVES + C.wave; C.NGW = C.G * NWAVES;
    return C;
}
#define LDS_WAIT() asm volatile("s_waitcnt lgkmcnt(0)" ::: "memory")

struct MapWin { __device__ __forceinline__ int row(int n) const {
        if (n < 256) return PC_CQ + n; if (n < 384) return PC_CKV + (n - 256); if (n < 416) return PC_KR + (n - 384); if (n < 672) return PC_FQ + (n - 416);
        if (n < 928) return PC_FK + (n - 672); if (n < 1184) return PC_FV + (n - 928); if (n < 1188) return PC_FL + (n - 1184); return PC_CI + (n - 1188); }
    __device__ __forceinline__ float scale(int, int n) const { return (n >= 416 && n < 672) ? C2_FOX : 1.0f; } };
struct MapUq { const float* g; __device__ __forceinline__ int row(int n) const { const int h = n / 96, d = n - h * 96; if (d < 64) return n; const int i = d - 64;
        const int s = (i < 16) ? (4 * (i >> 1) + (i & 1)) : (4 * ((i - 16) >> 1) + 2 + (i & 1)); return h * 96 + 64 + s; }
    __device__ __forceinline__ float scale(int k, int) const { return g[k] * C2_MLA; } };
struct MapUkv { const float* g; __device__ __forceinline__ int row(int n) const { const int h = n >> 7, d = n & 127; return d < 64 ? (768 + h * 64 + d) : (1280 + h * 64 + (d - 64)); }
    __device__ __forceinline__ float scale(int k, int) const { return g[k]; } };
struct MapWout { const float* gm; const float* gf; __device__ __forceinline__ int row(int n) const { return n; }
    __device__ __forceinline__ float scale(int k, int) const { return k < 512 ? gm[k] : (k < 768 ? gf[k - 512] : 1.0f); } };
struct MapW13 { int which; __device__ __forceinline__ int row(int n) const { return (n >> 7) * 256 + which * 128 + (n & 127); }
    __device__ __forceinline__ float scale(int, int) const { return 1.0f; } };
struct MapId { __device__ __forceinline__ int row(int n) const { return n; } __device__ __forceinline__ float scale(int, int) const { return 1.0f; } };

template <class Map>
__device__ __forceinline__ void transpose_item(const float* W, int Nsrc, bf16* WT, int ldk, LAS float* scr, int kb, int nb, int lane, const Map mp) {
    const int k0 = 64 * kb, n0 = 32 * nb, nn = n0 + (lane & 31); const bool nok = nn < Nsrc;
#pragma unroll 8
    for (int i = 0; i < 32; ++i) { const int kk = 2 * i + (lane >> 5); float v = 0.f; if (nok) v = W[(size_t)(k0 + kk) * Nsrc + nn] * mp.scale(k0 + kk, nn); scr[kk * 33 + (lane & 31)] = v; }
    LDS_WAIT(); asm volatile("" ::: "memory");
    const int c = lane & 7;
#pragma unroll
    for (int j = 0; j < 4; ++j) { const int n = (lane >> 3) + 8 * j; const LAS float* s = scr + (8 * c) * 33 + n;
        if (n0 + n < Nsrc) { u32x4 o; o.x = pk2(s[0 * 33], s[1 * 33]); o.y = pk2(s[2 * 33], s[3 * 33]); o.z = pk2(s[4 * 33], s[5 * 33]); o.w = pk2(s[6 * 33], s[7 * 33]);
            *(u32x4*)(WT + (size_t)mp.row(n0 + n) * ldk + k0 + 8 * c) = o; } }
    LDS_WAIT(); asm volatile("" ::: "memory");
}

__device__ __forceinline__ void sincos_acc(float ang, float& c, float& s) {
    const double a = (double)ang, q = __builtin_rint(a * 0.63661977236758134308);
    const double y = (a - q * 1.57079632679489655800) - q * 6.12323399573676603587e-17, y2 = y * y;
    const double sp = y * (1.0 + y2 * (-1.0 / 6 + y2 * (1.0 / 120 + y2 * (-1.0 / 5040 + y2 * (1.0 / 362880 + y2 * (-1.0 / 39916800 + y2 * (1.0 / 6227020800.0)))))));
    const double cp = 1.0 + y2 * (-0.5 + y2 * (1.0 / 24 + y2 * (-1.0 / 720 + y2 * (1.0 / 40320 + y2 * (-1.0 / 3628800 + y2 * (1.0 / 479001600 + y2 * (-1.0 / 87178291200.0)))))));
    const int quad = (int)((long long)q & 3);
    const double ss = (quad == 0) ? sp : (quad == 1) ? cp : (quad == 2) ? -sp : -cp;
    const double cc = (quad == 0) ? cp : (quad == 1) ? -sp : (quad == 2) ? -cp : sp;
    c = (float)cc; s = (float)ss;
}
__device__ __forceinline__ float inv_freq(int f) {
    const int a = f >> 2, b = f & 3;
    const float p = (a == 0) ? 1.0f : (a == 1) ? 0.1f : (a == 2) ? 0.01f : 0.001f;
    const float m = (b == 0) ? 1.0f : (b == 1) ? 0.56234132519034908f : (b == 2) ? 0.31622776601683794f : 0.17782794100389228f;
    return (b == 0) ? p : (float)((double)p * (double)m);
}

__device__ __forceinline__ void p0_prologue(Ctx& C, kargs_t A) {
    LAS float* scr = (LAS float*)(C.lds + C.wave * 16384);
    bf16* WIN = (bf16*)(C.ws + WS_WIN); bf16* WQ2 = (bf16*)(C.ws + WS_WQ2); bf16* WOUT = (bf16*)(C.ws + WS_WOUT);
    constexpr int I_IN = 16 * 54, I_UQ = 4 * 24, I_UKV = 2 * 32, I_OUT = 16 * 32, I_L = I_IN + I_UQ + I_UKV + I_OUT;
    for (int it = C.gw; it < DEPTH * I_L; it += C.NGW) {
        const int l = it / I_L; int r = it - l * I_L;
        if (r < I_IN) { transpose_item(A->in[2] + (size_t)l * DM * IN_COLS, IN_COLS, WIN + (size_t)l * NP1 * DM, DM, scr, r / 54, r % 54, C.lane, MapWin{}); continue; } r -= I_IN;
        if (r < I_UQ) { transpose_item(A->in[4] + (size_t)l * 256 * 768, 768, WQ2 + (size_t)l * NP1 * 256, 256, scr, r / 24, r % 24, C.lane, MapUq{A->in[3] + l * 256}); continue; } r -= I_UQ;
        if (r < I_UKV) { transpose_item(A->in[6] + (size_t)l * 128 * 1024, 1024, WQ2 + (size_t)l * NP1 * 256, 256, scr, r / 32, r % 32, C.lane, MapUkv{A->in[5] + l * 128}); continue; } r -= I_UKV;
        transpose_item(A->in[14] + (size_t)l * DM * DM, DM, WOUT + (size_t)l * DM * DM, DM, scr, r / 32, r % 32, C.lane, MapWout{A->in[12] + l * 512, A->in[13] + l * 256});
    }
    const int gt = C.vcu * NTHR + C.tid, NGT = C.G * NTHR;
    for (int i = gt; i < DEPTH * 92 * 128; i += NGT) { const int l = i / (92 * 128), r = i % (92 * 128); *(u32x4*)(WIN + (size_t)l * NP1 * DM + (size_t)(420 + r / 128) * DM + (r % 128) * 8) = (u32x4){0u, 0u, 0u, 0u}; }
    for (int i = gt; i < DEPTH * 1024 * 16; i += NGT) { const int l = i / (1024 * 16), r = i % (1024 * 16); *(u32x4*)(WQ2 + (size_t)l * NP1 * 256 + (size_t)(768 + r / 16) * 256 + 128 + (r % 16) * 8) = (u32x4){0u, 0u, 0u, 0u}; }
    bf16* XB = (bf16*)(C.ws + WS_XB); const float* x = A->in[0];
    for (int m = C.gw; m < M; m += C.NGW) { const f32x4* xr = (const f32x4*)(x + (size_t)m * DM) + C.lane; u32x2* o = (u32x2*)(XB + (size_t)m * DM) + C.lane;
#pragma unroll
        for (int j = 0; j < 4; ++j) { const f32x4 v = xr[64 * j]; o[64 * j] = (u32x2){pk2(v[0], v[1]), pk2(v[2], v[3])}; } }
    float* COS = (float*)(C.ws + WS_TAB); float* SIN = COS + (size_t)M * 16; const int* pos = (const int*)A->in[1];
    for (int i = gt; i < M * 16; i += NGT) { const float ang = (float)pos[i >> 4] * inv_freq(i & 15); float c, s; sincos_acc(ang, c, s); COS[i] = c; SIN[i] = s; }
}

__device__ __forceinline__ void ffn_weights(Ctx& C, kargs_t A, int layer) {
    LAS float* scr = (LAS float*)(C.lds + C.wave * 16384);
    bf16* W13 = (bf16*)(C.ws + WS_WFFN); bf16* W2T = W13 + WF_W13_ELEMS; const int j = layer >> 1;
    if ((layer & 1) == 0) {
        constexpr int I1 = 16 * 88, I2 = 44 * 32;
        const float* w1 = A->in[17] + (size_t)j * DM * DFF; const float* w3 = A->in[18] + (size_t)j * DM * DFF; const float* w2 = A->in[19] + (size_t)j * DFF * DM;
        for (int it = C.gw; it < 2 * I1 + I2; it += C.NGW) {
            int r = it;
            if (r < I1) { transpose_item(w1, DFF, W13, DM, scr, r / 88, r % 88, C.lane, MapW13{0}); continue; } r -= I1;
            if (r < I1) { transpose_item(w3, DFF, W13, DM, scr, r / 88, r % 88, C.lane, MapW13{1}); continue; } r -= I1;
            transpose_item(w2, DM, W2T, DFF, scr, r / 32, r % 32, C.lane, MapId{});
        }
    } else {
        constexpr int I1 = 16 * 44, I2 = 22 * 32, IE = 2 * I1 + I2;
        for (int it = C.gw; it < NEXP * IE; it += C.NGW) {
            const int e = it / IE; int r = it - e * IE;
            const float* w1 = A->in[21] + ((size_t)j * NEXP + e) * DM * DFE; const float* w3 = A->in[22] + ((size_t)j * NEXP + e) * DM * DFE; const float* w2 = A->in[23] + ((size_t)j * NEXP + e) * DFE * DM;
            bf16* W13e = W13 + (size_t)e * 2 * DFE * DM; bf16* W2Te = W2T + (size_t)e * DM * DFE;
            if (r < I1) { transpose_item(w1, DFE, W13e, DM, scr, r / 44, r % 44, C.lane, MapW13{0}); continue; } r -= I1;
            if (r < I1) { transpose_item(w3, DFE, W13e, DM, scr, r / 44, r % 44, C.lane, MapW13{1}); continue; } r -= I1;
            transpose_item(w2, DM, W2Te, DFE, scr, r / 32, r % 32, C.lane, MapId{});
        }
    }
}

__device__ __forceinline__ void p2_thin(Ctx& C, kargs_t A, int layer) {
    unsigned char* sc = C.ws + WS_SCR;
    bf16* CQ = (bf16*)(sc + SC_CQKV); bf16* CKV = CQ + (size_t)M * 256; const float* KR = (const float*)(sc + SC_KR); const float* FL = (const float*)(sc + SC_FL);
    float* CUM = (float*)(sc + SC_CUM); const bf16* CI = (const bf16*)(sc + SC_CI); bf16* KM = (bf16*)(sc + SC_KM); bf16* MIXED = (bf16*)(sc + SC_MIXED);
    const float* COS = (const float*)(C.ws + WS_TAB); const float* SIN = COS + (size_t)M * 16;
    if (C.gw < BATCH * 4) {
        const int b = C.gw >> 2, h = C.gw & 3; const float bias = A->in[7][layer * 4 + h];
        float v[64]; float run = 0.f;
#pragma unroll
        for (int i = 0; i < 64; ++i) { const float z = FL[((size_t)b * SEQ + C.lane * 64 + i) * 4 + h] + bias; const float e = fexp2(-fabsf(z) * LOG2E);
            const float ls = fminf(z, 0.f) - __builtin_amdgcn_logf(1.0f + e) * 0.6931471805599453f; run += ls * LOG2E; v[i] = run; }
        float incl = run;
#pragma unroll
        for (int o = 1; o < 64; o <<= 1) { const float t = __int_as_float(__builtin_amdgcn_ds_bpermute((C.lane - o) << 2, __float_as_int(incl))); if (C.lane >= o) incl += t; }
        const float excl = incl - run; float* dst = CUM + (size_t)C.gw * SEQ + C.lane * 64;
#pragma unroll
        for (int i = 0; i < 64; i += 4) *(f32x4*)(dst + i) = (f32x4){v[i] + excl, v[i + 1] + excl, v[i + 2] + excl, v[i + 3] + excl};
    }
    for (int m = C.gw; m < M; m += C.NGW) {
        { u32x2* p = (u32x2*)(CQ + (size_t)m * 256) + C.lane; const u32x2 w = *p; const float a0 = bflo(w.x), a1 = bfhi(w.x), a2 = bflo(w.y), a3 = bfhi(w.y);
          const float ss = wave_sum((a0 * a0 + a1 * a1) + (a2 * a2 + a3 * a3)); const float r = 1.0f / sqrtf(ss * (1.0f / 256) + EPS); *p = (u32x2){pk2(a0 * r, a1 * r), pk2(a2 * r, a3 * r)}; }
        { unsigned* p = (unsigned*)(CKV + (size_t)m * 256) + C.lane; const unsigned w = *p; const float a0 = bflo(w), a1 = bfhi(w);
          const float ss = wave_sum(a0 * a0 + a1 * a1); const float r = 1.0f / sqrtf(ss * (1.0f / 128) + EPS); *p = pk2(a0 * r, a1 * r); }
        { const int h = C.lane >> 3, g4 = C.lane & 7; const f32x2 x1 = *(const f32x2*)(KR + (size_t)m * 32 + 2 * g4), x2 = *(const f32x2*)(KR + (size_t)m * 32 + 16 + 2 * g4);
          const f32x2 c = *(const f32x2*)(COS + (size_t)m * 16 + 2 * g4), s = *(const f32x2*)(SIN + (size_t)m * 16 + 2 * g4);
          *(u32x2*)(KM + (size_t)m * 768 + h * 96 + 64 + 4 * g4) = (u32x2){pk2(x1.x * c.x - x2.x * s.x, x1.y * c.y - x2.y * s.y), pk2(x1.x * s.x + x2.x * c.x, x1.y * s.y + x2.y * c.y)}; }
    }
    {
        LAS float* hL = (LAS float*)C.lds; LAS float* yL = hL + 62 * 256;
        const int cch = (C.wave & 3) * 64 + C.lane, tt0 = (C.wave >> 2) * 16;
        float wj[31];
#pragma unroll
        for (int j = 0; j < 31; ++j) wj[j] = A->in[8][((size_t)layer * 31 + j) * 256 + cch];
        const float cb = A->in[9][layer * 256 + cch];
        const int ntok = C.tid >> 4, ngrp = (C.tid >> 2) & 3, nqt = C.tid & 3, nc0 = ngrp * 64 + nqt * 16;
        for (int tile = C.vcu; tile < M / 32; tile += C.G) {
            const int t0 = tile * 32, seq0 = (t0 / SEQ) * SEQ;
            for (int it = C.tid; it < 62 * 32; it += NTHR) { const int r = it >> 5, ch = it & 31, tok = t0 - 30 + r; f32x4 o0 = {0.f, 0.f, 0.f, 0.f}, o1 = o0;
                if (tok >= seq0) { const u32x4 a = *(const u32x4*)(CI + (size_t)tok * 512 + ch * 8), g = *(const u32x4*)(CI + (size_t)tok * 512 + 256 + ch * 8);
                    o0 = (f32x4){bflo(a.x) * sigmoidf_(bflo(g.x)), bfhi(a.x) * sigmoidf_(bfhi(g.x)), bflo(a.y) * sigmoidf_(bflo(g.y)), bfhi(a.y) * sigmoidf_(bfhi(g.y))};
                    o1 = (f32x4){bflo(a.z) * sigmoidf_(bflo(g.z)), bfhi(a.z) * sigmoidf_(bfhi(g.z)), bflo(a.w) * sigmoidf_(bflo(g.w)), bfhi(a.w) * sigmoidf_(bfhi(g.w))}; }
                *(LAS f32x4*)(hL + r * 256 + ch * 8) = o0; *(LAS f32x4*)(hL + r * 256 + ch * 8 + 4) = o1; }
            __syncthreads();
#pragma unroll
            for (int chunk = 0; chunk < 2; ++chunk) { const int base = tt0 + chunk * 8; float hv[38];
#pragma unroll
                for (int i = 0; i < 38; ++i) hv[i] = hL[(base + i) * 256 + cch];
#pragma unroll
                for (int tt = 0; tt < 8; ++tt) { float acc = cb;
#pragma unroll
                    for (int j = 0; j < 31; ++j) acc += wj[j] * hv[tt + j];
                    yL[(base + tt) * 256 + cch] = acc; } }
            __syncthreads();
            { float v[16]; float s = 0.f;
#pragma unroll
              for (int i = 0; i < 16; i += 4) { const f32x4 t4 = *(const LAS f32x4*)(yL + ntok * 256 + nc0 + i); v[i] = t4[0]; v[i + 1] = t4[1]; v[i + 2] = t4[2]; v[i + 3] = t4[3]; s += (t4[0] + t4[1]) + (t4[2] + t4[3]); }
              s += lane_xor<1>(s); s += lane_xor<2>(s); const float mean = s * (1.0f / 64); float q = 0.f;
#pragma unroll
              for (int i = 0; i < 16; ++i) { v[i] -= mean; q += v[i] * v[i]; }
              q += lane_xor<1>(q); q += lane_xor<2>(q); const float rstd = 1.0f / sqrtf(q * (1.0f / 64) + EPS);
              const float* gg = A->in[10] + layer * 256 + nc0; const float* gb = A->in[11] + layer * 256 + nc0; float o[16];
#pragma unroll
              for (int i = 0; i < 16; ++i) o[i] = siluf_(v[i] * rstd * gg[i] + gb[i]);
              bf16* dst = MIXED + (size_t)(t0 + ntok) * 1024 + 768 + nc0;
              *(u32x4*)dst = (u32x4){pk2(o[0], o[1]), pk2(o[2], o[3]), pk2(o[4], o[5]), pk2(o[6], o[7])};
              *(u32x4*)(dst + 8) = (u32x4){pk2(o[8], o[9]), pk2(o[10], o[11]), pk2(o[12], o[13]), pk2(o[14], o[15])}; }
        }
        __syncthreads();
    }
    ffn_weights(C, A, layer);
}

__device__ __forceinline__ void p5_rms(Ctx& C) {
    bf16* MIXED = (bf16*)(C.ws + WS_SCR + SC_MIXED);
    for (int m = C.gw; m < M; m += C.NGW) {
        bf16* r = MIXED + (size_t)m * 1024;
        { u32x4* p = (u32x4*)r + C.lane; const u32x4 w = *p; float a[8] = {bflo(w.x), bfhi(w.x), bflo(w.y), bfhi(w.y), bflo(w.z), bfhi(w.z), bflo(w.w), bfhi(w.w)}; float ss = 0.f;
#pragma unroll
          for (int i = 0; i < 8; ++i) ss += a[i] * a[i];
          ss = wave_sum(ss); const float rs = 1.0f / sqrtf(ss * (1.0f / 512) + EPS);
          *p = (u32x4){pk2(a[0] * rs, a[1] * rs), pk2(a[2] * rs, a[3] * rs), pk2(a[4] * rs, a[5] * rs), pk2(a[6] * rs, a[7] * rs)}; }
        { u32x2* p = (u32x2*)(r + 512) + C.lane; const u32x2 w = *p; const float a0 = bflo(w.x), a1 = bfhi(w.x), a2 = bflo(w.y), a3 = bfhi(w.y);
          const float ss = wave_sum((a0 * a0 + a1 * a1) + (a2 * a2 + a3 * a3)); const float rs = 1.0f / sqrtf(ss * (1.0f / 256) + EPS); *p = (u32x2){pk2(a0 * rs, a1 * rs), pk2(a2 * rs, a3 * rs)}; }
    }
}

template <int MODE>
__device__ __forceinline__ void ln_pass(Ctx& C, const float* res, const bf16* add, const float* gam, const float* bet, const float* router_w) {
    bf16* XB = (bf16*)(C.ws + WS_XB); float* out = C.out;
    int* TOPE = (int*)(C.ws + WS_MOE + MT_TOPE); float* TOPG = (float*)(C.ws + WS_MOE + MT_TOPG); const int* TOKSLOT = (const int*)(C.ws + WS_MOE + MT_TOKSLOT);
    LAS float* RW = (LAS float*)C.lds; LAS unsigned* CNT = (LAS unsigned*)(C.lds + 32768);
    if constexpr (MODE == 1) {
        for (int i = C.tid; i < 1024 * 8 / 4; i += NTHR) *(LAS f32x4*)(RW + 4 * i) = *(const f32x4*)(router_w + 4 * i);
        if (C.tid < 8) CNT[C.tid] = 0u;
        __syncthreads();
    }
    f32x4 g4[4], b4[4];
#pragma unroll
    for (int j = 0; j < 4; ++j) { g4[j] = ((const f32x4*)gam)[64 * j + C.lane]; b4[j] = ((const f32x4*)bet)[64 * j + C.lane]; }
    const int RPB = M / C.G, row0 = C.bx * RPB;
    unsigned cnt0 = 0, cnt1 = 0, cnt2 = 0, cnt3 = 0, cnt4 = 0, cnt5 = 0, cnt6 = 0, cnt7 = 0;
    for (int rr = C.wave; rr < RPB; rr += NWAVES) {
        const int m = row0 + rr;
        f32x4 v[4];
#pragma unroll
        for (int j = 0; j < 4; ++j) v[j] = ((const f32x4*)(res + (size_t)m * DM))[64 * j + C.lane] * ALPHA;
        if constexpr (MODE == 2) {
            const int s0 = TOKSLOT[2 * m], s1 = TOKSLOT[2 * m + 1];
#pragma unroll
            for (int j = 0; j < 4; ++j) { const u32x2 w0 = ((const u32x2*)(add + (size_t)s0 * DM))[64 * j + C.lane], w1 = ((const u32x2*)(add + (size_t)s1 * DM))[64 * j + C.lane];
                v[j] += (f32x4){bflo(w0.x) + bflo(w1.x), bfhi(w0.x) + bfhi(w1.x), bflo(w0.y) + bflo(w1.y), bfhi(w0.y) + bfhi(w1.y)}; }
        } else {
#pragma unroll
            for (int j = 0; j < 4; ++j) { const u32x2 w0 = ((const u32x2*)(add + (size_t)m * DM))[64 * j + C.lane]; v[j] += (f32x4){bflo(w0.x), bfhi(w0.x), bflo(w0.y), bfhi(w0.y)}; }
        }
        float s = 0.f;
#pragma unroll
        for (int j = 0; j < 4; ++j) s += (v[j][0] + v[j][1]) + (v[j][2] + v[j][3]);
        const float mean = wave_sum(s) * (1.0f / DM); float q = 0.f;
#pragma unroll
        for (int j = 0; j < 4; ++j) { v[j] = v[j] - mean; q += (v[j][0] * v[j][0] + v[j][1] * v[j][1]) + (v[j][2] * v[j][2] + v[j][3] * v[j][3]); }
        const float rstd = 1.0f / sqrtf(wave_sum(q) * (1.0f / DM) + EPS);
#pragma unroll
        for (int j = 0; j < 4; ++j) { v[j] = v[j] * rstd * g4[j] + b4[j]; ((f32x4*)(out + (size_t)m * DM))[64 * j + C.lane] = v[j];
            ((u32x2*)(XB + (size_t)m * DM))[64 * j + C.lane] = (u32x2){pk2(v[j][0], v[j][1]), pk2(v[j][2], v[j][3])}; }
        if constexpr (MODE == 1) {
            float lg[8] = {0.f, 0.f, 0.f, 0.f, 0.f, 0.f, 0.f, 0.f};
#pragma unroll
            for (int j = 0; j < 4; ++j)
#pragma unroll
                for (int i = 0; i < 4; ++i) { const int col = 256 * j + 4 * C.lane + i; const f32x4 w0 = *(const LAS f32x4*)(RW + col * 8), w1 = *(const LAS f32x4*)(RW + col * 8 + 4); const float xv = v[j][i];
                    lg[0] += xv * w0[0]; lg[1] += xv * w0[1]; lg[2] += xv * w0[2]; lg[3] += xv * w0[3]; lg[4] += xv * w1[0]; lg[5] += xv * w1[1]; lg[6] += xv * w1[2]; lg[7] += xv * w1[3]; }
#pragma unroll
            for (int e = 0; e < 8; ++e) lg[e] = wave_sum(lg[e]);
            int e1 = 0; float v1 = lg[0];
#pragma unroll
            for (int e = 1; e < 8; ++e) if (lg[e] > v1) { v1 = lg[e]; e1 = e; }
            int e2 = -1; float v2 = -INFINITY;
#pragma unroll
            for (int e = 0; e < 8; ++e) if (e != e1 && lg[e] > v2) { v2 = lg[e]; e2 = e; }
            const float ex = fexp2((v2 - v1) * LOG2E), gA = 1.0f / (1.0f + ex), gB = ex * gA;
            if (C.lane == 0) { TOPE[2 * m] = e1; TOPE[2 * m + 1] = e2; TOPG[2 * m] = gA; TOPG[2 * m + 1] = gB; }
            cnt0 += (e1 == 0) + (e2 == 0); cnt1 += (e1 == 1) + (e2 == 1); cnt2 += (e1 == 2) + (e2 == 2); cnt3 += (e1 == 3) + (e2 == 3);
            cnt4 += (e1 == 4) + (e2 == 4); cnt5 += (e1 == 5) + (e2 == 5); cnt6 += (e1 == 6) + (e2 == 6); cnt7 += (e1 == 7) + (e2 == 7);
        }
    }
    if constexpr (MODE == 1) {
        if (C.lane == 0) { atomicAdd((unsigned*)&CNT[0], cnt0); atomicAdd((unsigned*)&CNT[1], cnt1); atomicAdd((unsigned*)&CNT[2], cnt2); atomicAdd((unsigned*)&CNT[3], cnt3);
                           atomicAdd((unsigned*)&CNT[4], cnt4); atomicAdd((unsigned*)&CNT[5], cnt5); atomicAdd((unsigned*)&CNT[6], cnt6); atomicAdd((unsigned*)&CNT[7], cnt7); }
        __syncthreads();
        if (C.tid < 8) C.ctl[CW_CNTB + C.bx * 8 + C.tid] = CNT[C.tid];
    }
}

__device__ __forceinline__ void moe_assign(Ctx& C) {
    if (C.wave != 0) return;
    const int* TOPE = (const int*)(C.ws + WS_MOE + MT_TOPE); const float* TOPG = (const float*)(C.ws + WS_MOE + MT_TOPG);
    int* TOKSLOT = (int*)(C.ws + WS_MOE + MT_TOKSLOT); int* SLOTTOK = (int*)(C.ws + WS_MOE + MT_SLOTTOK); float* SLOTGATE = (float*)(C.ws + WS_MOE + MT_SLOTGATE);
    const int blk = C.bx, RPB = M / C.G, row0 = blk * RPB;
    int tot[8], pre[8];
#pragma unroll
    for (int e = 0; e < 8; ++e) { int t = 0, p = 0; for (int bb = C.lane; bb < C.G; bb += 64) { const int c = (int)C.ctl[CW_CNTB + bb * 8 + e]; t += c; if (bb < blk) p += c; }
        tot[e] = wave_sum_i(t); pre[e] = wave_sum_i(p); }
    int seg[9]; seg[0] = 0;
#pragma unroll
    for (int e = 0; e < 8; ++e) seg[e + 1] = seg[e] + ((tot[e] + 255) & ~255);
    int run[8];
#pragma unroll
    for (int e = 0; e < 8; ++e) run[e] = seg[e] + pre[e];
    const unsigned long long ltmask = (1ull << C.lane) - 1ull;
    for (int base = 0; base < RPB * 2; base += 64) {
        const int idx = base + C.lane, token = row0 + (idx >> 1), choice = idx & 1;
        const int ex = TOPE[2 * token + choice]; const float gate = TOPG[2 * token + choice]; int slot = 0;
#pragma unroll
        for (int e = 0; e < 8; ++e) { const unsigned long long mk = __builtin_amdgcn_ballot_w64(ex == e); if (ex == e) slot = run[e] + __popcll(mk & ltmask); run[e] += __popcll(mk); }
        SLOTTOK[slot] = token; SLOTGATE[slot] = gate; TOKSLOT[2 * token + choice] = slot;
    }
    if (blk < 8) {
        int lo = 0, hi = 0;
#pragma unroll
        for (int e = 0; e < 8; ++e) if (e == blk) { lo = seg[e] + tot[e]; hi = seg[e + 1]; }
        for (int s = lo + C.lane; s < hi; s += 64) { SLOTTOK[s] = 0; SLOTGATE[s] = 0.f; }
    }
    if (blk == 0 && C.lane == 0) {
#pragma unroll
        for (int e = 0; e < 9; ++e) C.ctl[CW_SEG + e] = (unsigned)seg[e];
    }
}

#ifndef MK_PER_PHASE
#define MK_PER_PHASE 0
#endif
#ifndef PH_ENABLE
#define PH_ENABLE 0xFFFF
#endif
constexpr int PH_PER_LAYER = 12, N_PHASES = 1 + DEPTH * PH_PER_LAYER;

__global__ void __launch_bounds__(NTHR, 2) fwd_kernel(Args args) {
    extern __shared__ __attribute__((aligned(16))) unsigned char lds_raw[];
    LAS unsigned char* const lds = (LAS unsigned char*)lds_raw;
    volatile LAS unsigned* MISC = (volatile LAS unsigned*)(lds + MISC_OFF);
    for (int u = threadIdx.x; u < (LDS_BYTES - LDSCTL_OFF) / 4; u += NTHR) ((LAS unsigned*)(lds + LDSCTL_OFF))[u] = 0u;
    __syncthreads();
    const int wave0 = __builtin_amdgcn_readfirstlane((int)threadIdx.x >> 6);
    XcdBarrier bar; bar.bar = (unsigned*)(args.ws + WS_CTL) + CW_BAR; bar.x = 0; bar.st = nullptr;
    if (!MK_PER_PHASE) bar = xcd_barrier_post((unsigned*)(args.ws + WS_CTL) + CW_BAR, MISC + 8, wave0);
    const int lo = args.ph_lo, hi = args.ph_hi;
#define IN(k) (lo <= (k) && (k) < hi)
#define EN(p) ((PH_ENABLE >> (p)) & 1)
#define SEAM(k) do { if (IN((k) + 1)) { if (!MK_PER_PHASE) xcd_barrier<false>(bar, wave0); } } while (0)
#define SEAM0(k) do { if (IN((k) + 1)) { if (!MK_PER_PHASE) xcd_barrier<true>(bar, wave0); } } while (0)
#define PHASE_CTX kargs_t A = opaque_args(); Ctx C = make_ctx(A, lds, wave0); unsigned char* sc = C.ws + WS_SCR; (void)sc

    if (EN(15) && IN(0)) { PHASE_CTX; p0_prologue(C, A); }
    SEAM0(0);

    for (int layer = 0; layer < DEPTH; ++layer) {
        const int P = 1 + layer * PH_PER_LAYER;
#ifdef FORCE_MOE
        const bool moe = FORCE_MOE != 0;
#else
        const bool moe = (layer & 1) != 0;
#endif
        if (EN(0) && IN(P + 0)) {
            PHASE_CTX;
            pg8::DenseOrder S{(const bf16*)(C.ws + WS_XB), (const bf16*)(C.ws + WS_WIN) + (size_t)layer * NP1 * DM, DM, DM, M / 256, NP1 / 256, C.G, C.bx};
            EpiInProj E{(bf16*)(sc + SC_CQKV), (bf16*)(sc + SC_CQKV) + (size_t)M * 256, (float*)(sc + SC_KR), (float*)(sc + SC_FL), (bf16*)(sc + SC_FQ), (bf16*)(sc + SC_CI)};
            pg8::gemm_phase<EpiInProj, pg8::DenseOrder, false, DM, DM, DM>(C.lds, C.tid, S, E);
            SEAM(P + 0);
        }
        if (EN(1) && IN(P + 1)) { PHASE_CTX; p2_thin(C, A, layer); SEAM(P + 1); }
        if (EN(2) && IN(P + 2)) {
            PHASE_CTX;
            struct QkvOrder { const bf16* A; const bf16* Bt; int G, c;
                __device__ __forceinline__ bool next(int i, pg8::Unit& u) const { return pg8::tile_order((long)i * G + c, M / 256, 7, u.pm, u.pn); }
                __device__ __forceinline__ const char* a_base(const pg8::Unit& u) const { return (const char*)(A + (u.pn < 3 ? (size_t)0 : (size_t)M * 256)) + (size_t)u.pm * 256 * 256 * 2; }
                __device__ __forceinline__ const char* b_base(const pg8::Unit& u) const { return (const char*)Bt + (size_t)u.pn * 256 * 256 * 2; }
                __device__ __forceinline__ int tok(const pg8::Unit&, int) const { return 0; } };
            QkvOrder S{(const bf16*)(sc + SC_CQKV), (const bf16*)(C.ws + WS_WQ2) + (size_t)layer * NP1 * 256, C.G, C.bx};
            EpiQKV E{(bf16*)(sc + SC_QM), (bf16*)(sc + SC_KM), (bf16*)(sc + SC_VM), (const float*)(C.ws + WS_TAB), (const float*)(C.ws + WS_TAB) + (size_t)M * 16};
            pg8::gemm_phase<EpiQKV, QkvOrder, false, 256, 256, 256>(C.lds, C.tid, S, E);
            SEAM(P + 2);
        }
        if (EN(3) && IN(P + 3)) {
            PHASE_CTX;
            bf16* MIXED = (bf16*)(sc + SC_MIXED);
            for (int p = C.vcu; p < 768; p += C.G) {
                if (p < 512) { const int bh = p >> 3, s = p & 7;
                    for (int i = 0; i < 2; ++i) att::attn_unit<96, false>(bh >> 3, bh & 7, i == 0 ? 15 - s : s, (const bf16*)(sc + SC_QM), 768, (const bf16*)(sc + SC_KM), 768, (const bf16*)(sc + SC_VM), 512, MIXED, 1024, (bh & 7) * 64, nullptr, C.lds, C.tid);
                } else { const int f = p - 512, bh = f >> 3, s = f & 7; const bf16* FQ = (const bf16*)(sc + SC_FQ);
                    for (int i = 0; i < 2; ++i) att::attn_unit<64, true>(bh >> 2, bh & 3, i == 0 ? 15 - s : s, FQ, 256, FQ + (size_t)M * 256, 256, FQ + (size_t)2 * M * 256, 256, MIXED, 1024, 512 + (bh & 3) * 64, (const float*)(sc + SC_CUM), C.lds, C.tid);
                }
            }
            SEAM(P + 3);
        }
        if (EN(4) && IN(P + 4)) { PHASE_CTX; p5_rms(C); SEAM(P + 4); }
        if (EN(5) && IN(P + 5)) {
            PHASE_CTX;
            pg8::DenseOrder S{(const bf16*)(sc + SC_MIXED), (const bf16*)(C.ws + WS_WOUT) + (size_t)layer * DM * DM, DM, DM, M / 256, DM / 256, C.G, C.bx};
            EpiBf16<DM, false> E{(bf16*)(sc + SC_MIXOUT), DM / 256, nullptr};
            pg8::gemm_phase<EpiBf16<DM, false>, pg8::DenseOrder, false, DM, DM, DM>(C.lds, C.tid, S, E);
            SEAM(P + 5);
        }
        if (EN(6) && IN(P + 6)) {
            if (moe) { PHASE_CTX; ln_pass<1>(C, C.out, (const bf16*)(sc + SC_MIXOUT), A->in[15] + layer * DM, A->in[16] + layer * DM, A->in[20] + (size_t)(layer >> 1) * DM * NEXP); }
            else     { PHASE_CTX; const float* res = (layer == 0) ? A->in[0] : C.out; ln_pass<0>(C, res, (const bf16*)(sc + SC_MIXOUT), A->in[15] + layer * DM, A->in[16] + layer * DM, nullptr); }
            SEAM(P + 6);
        }
        if (EN(7) && IN(P + 7)) { if (moe) { PHASE_CTX; moe_assign(C); } SEAM(P + 7); }
        if (EN(8) && IN(P + 8)) {
            if (moe) {
                PHASE_CTX; bf16* W13 = (bf16*)(C.ws + WS_WFFN); bf16* HID = (bf16*)(sc + SC_HID);
                const int* seg = (const int*)(C.ctl + CW_SEG);
                MoeOrder S{(const bf16*)(C.ws + WS_XB), W13, DM, DM, seg[8] / 256, 11, C.G, C.bx, (const int*)(C.ws + WS_MOE + MT_SLOTTOK), seg[1], seg[2], seg[3], seg[4], seg[5], seg[6], seg[7]};
                EpiSwiGLU<DFE> E{HID, 11};
                pg8::gemm_phase<EpiSwiGLU<DFE>, MoeOrder, true, DM, DM, DM>(C.lds, C.tid, S, E);
            } else {
                PHASE_CTX; bf16* W13 = (bf16*)(C.ws + WS_WFFN); bf16* HID = (bf16*)(sc + SC_HID);
                pg8::DenseOrder S{(const bf16*)(C.ws + WS_XB), W13, DM, DM, M / 256, 2 * DFF / 256, C.G, C.bx};
                EpiSwiGLU<DFF> E{HID, 1 << 30};
                pg8::gemm_phase<EpiSwiGLU<DFF>, pg8::DenseOrder, false, DM, DM, DM>(C.lds, C.tid, S, E);
            }
            SEAM(P + 8);
        }
        if (EN(9) && IN(P + 9)) {
            if (moe) {
                PHASE_CTX; bf16* W2T = (bf16*)(C.ws + WS_WFFN) + WF_W13_ELEMS; bf16* HID = (bf16*)(sc + SC_HID); bf16* FF = (bf16*)(sc + SC_FF);
                const int* seg = (const int*)(C.ctl + CW_SEG);
                MoeOrder S{HID, W2T, DFE, DFE, seg[8] / 256, 4, C.G, C.bx, nullptr, seg[1], seg[2], seg[3], seg[4], seg[5], seg[6], seg[7]};
                EpiBf16<DM, true> E{FF, 4, (const float*)(C.ws + WS_MOE + MT_SLOTGATE)};
                pg8::gemm_phase<EpiBf16<DM, true>, MoeOrder, false, DFE, DFE, DFE>(C.lds, C.tid, S, E);
            } else {
                PHASE_CTX; bf16* W2T = (bf16*)(C.ws + WS_WFFN) + WF_W13_ELEMS; bf16* HID = (bf16*)(sc + SC_HID); bf16* FF = (bf16*)(sc + SC_FF);
                pg8::DenseOrder S{HID, W2T, DFF, DFF, M / 256, DM / 256, C.G, C.bx};
                EpiBf16<DM, false> E{FF, DM / 256, nullptr};
                pg8::gemm_phase<EpiBf16<DM, false>, pg8::DenseOrder, false, DFF, DFF, DFF>(C.lds, C.tid, S, E);
            }
            SEAM(P + 9);
        }
        if (EN(10) && IN(P + 10)) {
            if (moe) { PHASE_CTX; ln_pass<2>(C, C.out, (const bf16*)(sc + SC_FF), A->in[24] + layer * DM, A->in[25] + layer * DM, nullptr); }
            else     { PHASE_CTX; ln_pass<0>(C, C.out, (const bf16*)(sc + SC_FF), A->in[24] + layer * DM, A->in[25] + layer * DM, nullptr); }
            SEAM(P + 10);
        }
        if (IN(P + 11)) { SEAM(P + 11); }
    }
#undef IN
#undef SEAM
}

extern "C" void kernel_launch(void* const* d_in, const int* in_sizes, int n_in, void* d_out, int out_size, void* d_ws, size_t ws_size, hipStream_t stream) {
    static int grid = 0;
    if (grid == 0) {
        if (n_in != 26 || out_size != M * DM || ws_size < WS_END) { fprintf(stderr, "kernel_launch: unexpected problem (n_in %d, out %d, ws %zu < %zu)\n", n_in, out_size, ws_size, (size_t)WS_END); grid = -1; return; }
        int dev = 0, cus = 0, per_cu = 0;
        if (hipGetDevice(&dev) != hipSuccess || hipDeviceGetAttribute(&cus, hipDeviceAttributeMultiprocessorCount, dev) != hipSuccess) { grid = -1; return; }
        if (hipFuncSetAttribute((const void*)fwd_kernel, hipFuncAttributeMaxDynamicSharedMemorySize, LDS_BYTES) != hipSuccess) { fprintf(stderr, "kernel_launch: hipFuncSetAttribute failed\n"); grid = -1; return; }
        if (hipOccupancyMaxActiveBlocksPerMultiprocessor(&per_cu, (const void*)fwd_kernel, NTHR, LDS_BYTES) != hipSuccess || per_cu < 1) fprintf(stderr, "kernel_launch: occupancy query says %d\n", per_cu);
        (void)hipGetLastError();
        grid = 256; while (grid > cus && grid > 8) grid >>= 1;
    }
    if (grid < 0) return;
    (void)hipMemsetAsync((char*)d_ws + WS_CTL, 0, CTL_ZERO_BYTES, stream);
    Args a{};
    for (int i = 0; i < 26; ++i) a.in[i] = (const float*)d_in[i];
    a.out = (float*)d_out; a.ws = (unsigned char*)d_ws;
#if MK_PER_PHASE
    for (int p = 0; p < N_PHASES; ++p) { a.ph_lo = p; a.ph_hi = p + 1; hipLaunchKernelGGL(fwd_kernel, dim3(grid), dim3(NTHR), LDS_BYTES, stream, a); }
#else
    a.ph_lo = 0; a.ph_hi = N_PHASES;
    hipLaunchKernelGGL(fwd_kernel, dim3(grid), dim3(NTHR), LDS_BYTES, stream, a);
#endif
}
```

```cpp
#include <hip/hip_runtime.h>
#include <cstdio>
#include <cstdint>
#include <cmath>

#ifndef REP_MASK
#define REP_MASK 0x0
#endif
#define REPN(p) (1 + ((REP_MASK >> (p)) & 1))
#define REPS(p) for (int rep_ = 0; rep_ < 1 + ((REP_MASK >> (p)) & 1); ++rep_)
#define GAS __attribute__((address_space(1)))
#define LAS __attribute__((address_space(3)))
typedef unsigned short bf16;
typedef short bf16x8 __attribute__((ext_vector_type(8)));
typedef short s16x4 __attribute__((ext_vector_type(4)));
typedef float f32x2 __attribute__((ext_vector_type(2)));
typedef float f32x4 __attribute__((ext_vector_type(4)));
typedef float f32x16 __attribute__((ext_vector_type(16)));
typedef unsigned u32x2 __attribute__((ext_vector_type(2)));
typedef unsigned u32x4 __attribute__((ext_vector_type(4)));
typedef __bf16 bf16x2_t __attribute__((ext_vector_type(2)));

constexpr int BATCH = 8, SEQ = 4096, DM = 1024, M = BATCH * SEQ, DEPTH = 4;
constexpr int IN_COLS = 1700, NP1 = 1792;
constexpr int DFF = 2816, DFE = 1408, NEXP = 8;
constexpr int NWAVES = 8, NTHR = 512;
constexpr float ALPHA = 1.6817928305074290f;
constexpr float EPS = 1e-5f;
constexpr float LOG2E = 1.4426950408889634f;
constexpr float C2_MLA = 0.10206207261596577f * LOG2E;
constexpr float C2_FOX = 0.125f * LOG2E;
constexpr int PC_CQ = 0, PC_CKV = 256, PC_KR = 384, PC_FL = 416, PC_FQ = 512, PC_FK = 768, PC_FV = 1024, PC_CI = 1280;
constexpr int MOE_ROWS_MAX = 2 * M + NEXP * 256;

constexpr size_t MiB = 1u << 20;
constexpr size_t WS_CTL = 0, CTL_ZERO_BYTES = 1 * MiB;
constexpr size_t WS_WIN = 1 * MiB;
constexpr size_t WS_WQ2 = WS_WIN + 14 * MiB;
constexpr size_t WS_WOUT = WS_WQ2 + 4 * MiB;
constexpr size_t WS_TAB = WS_WOUT + 8 * MiB;
constexpr size_t WS_MOE = WS_TAB + 4 * MiB;
constexpr size_t WS_WFFN = WS_MOE + 2 * MiB;
constexpr size_t WS_XB = WS_WFFN + 68 * MiB;
constexpr size_t WS_SCR = WS_XB + 64 * MiB;
constexpr size_t SC_CQKV = 0;
constexpr size_t SC_KR = SC_CQKV + 32 * MiB;
constexpr size_t SC_FL = SC_KR + 4 * MiB;
constexpr size_t SC_CUM = SC_FL + MiB / 2;
constexpr size_t SC_FQ = SC_CUM + MiB / 2;
constexpr size_t SC_CI = SC_FQ + 48 * MiB;
constexpr size_t SC_QM = SC_CI + 32 * MiB;
constexpr size_t SC_KM = SC_QM + 48 * MiB;
constexpr size_t SC_VM = SC_KM + 48 * MiB;
constexpr size_t SC_MIXED = SC_VM + 32 * MiB;
constexpr size_t SC_MIXOUT = SC_QM;
constexpr size_t SC_MIX_END = SC_MIXED + 64 * MiB;
constexpr size_t SC_HID = 0;
constexpr size_t SC_FF = 182 * MiB;
constexpr size_t SC_END = 316 * MiB;
constexpr size_t WS_END = WS_SCR + SC_END;
static_assert(SC_MIX_END <= SC_END && SC_FF + (size_t)MOE_ROWS_MAX * 1024 * 2 <= SC_END && (size_t)MOE_ROWS_MAX * DFE * 2 <= SC_FF, "scratch map");
static_assert(WS_END <= 512 * MiB, "workspace map");
constexpr size_t WF_W13_ELEMS = (size_t)NEXP * 2 * DFE * DM;
constexpr size_t MT_TOPE = 0;
constexpr size_t MT_TOPG = 256 * 1024;
constexpr size_t MT_TOKSLOT = 512 * 1024;
constexpr size_t MT_SLOTTOK = 768 * 1024;
constexpr size_t MT_SLOTGATE = 768 * 1024 + 272 * 1024;
static_assert((size_t)MOE_ROWS_MAX * 4 <= 272 * 1024 && MT_SLOTGATE + 272 * 1024 <= 2 * MiB, "moe tables");
constexpr int CW_BAR = 4096;
constexpr int CW_CNTB = 16384;
constexpr int CW_SEG = 20480;

constexpr int RING_BYTES = 131072;
constexpr int LDSCTL_OFF = RING_BYTES, MISC_OFF = LDSCTL_OFF + 320;
constexpr int LDS_BYTES = 147456;

#define RLX_AGENT __ATOMIC_RELAXED, __HIP_MEMORY_SCOPE_AGENT
__device__ __forceinline__ unsigned pk2(float lo, float hi) { f32x2 v = {lo, hi}; bf16x2_t b = __builtin_convertvector(v, bf16x2_t); return __builtin_bit_cast(unsigned, b); }
__device__ __forceinline__ float bf2f(unsigned short u) { return __uint_as_float((unsigned)u << 16); }
__device__ __forceinline__ float bflo(unsigned u) { return __uint_as_float(u << 16); }
__device__ __forceinline__ float bfhi(unsigned u) { return __uint_as_float(u & 0xffff0000u); }
__device__ __forceinline__ float fexp2(float x) { return __builtin_amdgcn_exp2f(x); }
__device__ __forceinline__ float frcp(float x) { return __builtin_amdgcn_rcpf(x); }
__device__ __forceinline__ float sigmoidf_(float x) { return frcp(1.0f + fexp2(-x * LOG2E)); }
__device__ __forceinline__ float siluf_(float x) { return x * sigmoidf_(x); }
template <int O> __device__ __forceinline__ float lane_xor(float v) {
    if constexpr (O < 32) return __int_as_float(__builtin_amdgcn_ds_swizzle(__float_as_int(v), (O << 10) | 0x1f));
    else { auto rr = __builtin_amdgcn_permlane32_swap(__float_as_uint(v), __float_as_uint(v), false, false); return __uint_as_float(rr[0]) == v ? __uint_as_float(rr[1]) : __uint_as_float(rr[0]); }
}
__device__ __forceinline__ float wave_sum(float v) {
    v += lane_xor<1>(v); v += lane_xor<2>(v); v += lane_xor<4>(v); v += lane_xor<8>(v); v += lane_xor<16>(v);
    { auto rr = __builtin_amdgcn_permlane32_swap(__float_as_uint(v), __float_as_uint(v), false, false); v = __uint_as_float(rr[0]) + __uint_as_float(rr[1]); }
    return v;
}
__device__ __forceinline__ int wave_sum_i(int v) {
    v += __builtin_amdgcn_ds_swizzle(v, (1 << 10) | 0x1f); v += __builtin_amdgcn_ds_swizzle(v, (2 << 10) | 0x1f); v += __builtin_amdgcn_ds_swizzle(v, (4 << 10) | 0x1f);
    v += __builtin_amdgcn_ds_swizzle(v, (8 << 10) | 0x1f); v += __builtin_amdgcn_ds_swizzle(v, (16 << 10) | 0x1f);
    { auto rr = __builtin_amdgcn_permlane32_swap((unsigned)v, (unsigned)v, false, false); v = (int)(rr[0] + rr[1]); }
    return v;
}
__device__ __forceinline__ u32x4 pack8(const f32x4 a, const f32x4 b) { u32x4 w; w.x = pk2(a[0], a[1]); w.y = pk2(a[2], a[3]); w.z = pk2(b[0], b[1]); w.w = pk2(b[2], b[3]); return w; }

#define XB_TMO      128
#define XB_XCNT(j)  (256  + 64 * (j))
#define XB_XSUB(j)  (1280 + 64 * (j))
#define XB_XGEN(j)  (2304 + 64 * (j))
#define XB_TOP      3328
#define XB_TOPGEN   3392
#define XCD_BAR_WORDS 3456
#define XB_SPIN_CAP (1u << 18)
__device__ __forceinline__ unsigned xb_ld(unsigned* p)              { return __hip_atomic_load(p, __ATOMIC_RELAXED, __HIP_MEMORY_SCOPE_AGENT); }
__device__ __forceinline__ unsigned xb_add(unsigned* p, unsigned v) { return __hip_atomic_fetch_add(p, v, __ATOMIC_RELAXED, __HIP_MEMORY_SCOPE_AGENT); }
__device__ __forceinline__ unsigned xb_xcc_id() { return (unsigned)__builtin_amdgcn_s_getreg((3 << 11) | 20) & 0xFu; }
#define XB_SPIN(cond, bar) do { unsigned _sp = 0; while (cond) { __builtin_amdgcn_s_sleep(1); \
    if ((++_sp & 255u) == 0u) { if (xb_ld(&(bar)[XB_TMO])) break; if (_sp > XB_SPIN_CAP) { atomicAdd(&(bar)[XB_TMO], 1u); break; } } } } while (0)
struct XcdBarrier { unsigned* bar; unsigned x; volatile LAS unsigned* st; };
__device__ __forceinline__ bool xb_is_t0(int wave0) { unsigned ones = ~0u; asm volatile("" : "+s"(ones)); return wave0 == 0 && __builtin_amdgcn_mbcnt_hi(ones, __builtin_amdgcn_mbcnt_lo(ones, 0u)) == 0u; }
__device__ __forceinline__ XcdBarrier xcd_barrier_post(unsigned* bar, volatile LAS unsigned* st, int wave0) {
    XcdBarrier b; b.bar = bar; b.x = xb_xcc_id(); b.st = st;
    if (xb_is_t0(wave0)) (void)xb_add(&bar[XB_XCNT(b.x)], 1u);
    return b;
}
__device__ __forceinline__ void xcd_barrier_complete(unsigned* bar, unsigned x, unsigned& nloc, unsigned& nx) {
    const unsigned G = gridDim.x * gridDim.y * gridDim.z;
    unsigned sum, cnt, mine, sp = 0u;
    for (;;) {
        sum = 0u; cnt = 0u; mine = 0u;
#pragma unroll
        for (unsigned j = 0; j < 16; ++j) { const unsigned c = xb_ld(&bar[XB_XCNT(j)]); sum += c; cnt += (c > 0u) ? 1u : 0u; mine = (j == x) ? c : mine; }
        if (sum == G) break;
        __builtin_amdgcn_s_sleep(1);
        if ((++sp & 255u) == 0u) { if (xb_ld(&bar[XB_TMO])) break; if (sp > XB_SPIN_CAP) { atomicAdd(&bar[XB_TMO], 1u); break; } }
    }
    nloc = mine > 0u ? mine : 1u; nx = cnt > 0u ? cnt : 1u;
}
template <bool FIRST>
__device__ __forceinline__ void xcd_barrier(const XcdBarrier& b, int wave0) {
    asm volatile("s_waitcnt vmcnt(0)" ::: "memory");
    __syncthreads();
    if (xb_is_t0(wave0)) {
        unsigned* bar = b.bar;
        __builtin_amdgcn_s_waitcnt(0);
        unsigned nloc = b.st[0], nx = b.st[1];
        if constexpr (FIRST) { if (nloc == 0u) { xcd_barrier_complete(bar, b.x, nloc, nx); b.st[0] = nloc; b.st[1] = nx; } }
        const unsigned old = xb_add(&bar[XB_XSUB(b.x)], 1u);
        const unsigned gen = old / nloc;
        if (old + 1u == (gen + 1u) * nloc) {
            __builtin_amdgcn_fence(__ATOMIC_RELEASE, "agent");
            asm volatile("s_waitcnt vmcnt(0)" ::: "memory");
            const unsigned og = xb_add(&bar[XB_TOP], 1u);
            const unsigned tg = og / nx;
            if (og + 1u == (tg + 1u) * nx) xb_add(&bar[XB_TOPGEN], 1u);
            else XB_SPIN(xb_ld(&bar[XB_TOPGEN]) == tg, bar);
            __builtin_amdgcn_fence(__ATOMIC_ACQUIRE, "agent");
            xb_add(&bar[XB_XGEN(b.x)], 1u);
            asm volatile("s_waitcnt vmcnt(0)" ::: "memory");
        } else {
            XB_SPIN(xb_ld(&bar[XB_XGEN(b.x)]) == gen, bar);
            __builtin_amdgcn_fence(__ATOMIC_ACQUIRE, "agent");
            asm volatile("s_waitcnt vmcnt(0)" ::: "memory");
        }
    }
    __syncthreads();
}

namespace pg8 {
constexpr int BM = 256, BK = 64, HALF = 128, HTB = HALF * BK * 2, STAGE_BYTES = 8 * HTB, NXCD = 8, WGM = 8;
__host__ __device__ __forceinline__ int lds_byte(int r, int c) { const int st = (r >> 4) * 2 + (c >> 5), rr = r & 15, cc = c & 31, ob = rr * 64 + cc * 2; return st * 1024 + (ob ^ (((ob >> 9) & 1) << 5)); }
__host__ __device__ __forceinline__ void stage_rc(int b, int& R, int& C) { const int st = b / 1024, sb = b % 1024, swz = sb ^ (((sb >> 9) & 1) << 5); R = (st >> 1) * 16 + swz / 64; C = (st & 1) * 32 + (swz % 64) / 2; }
__host__ __device__ __forceinline__ int perm32(int rho) { const int n = rho >> 4, i = rho & 15; return 8 * (i >> 2) + 4 * n + (i & 3); }
struct Unit { int pm, pn; };

__device__ __forceinline__ bool tile_order(long L, int nM, int nN, int& pm, int& pn) {
    const int nwg = nM * nN; if (L >= nwg) return false;
    int wgid = (int)L; { const int q = nwg / NXCD, r = nwg % NXCD, xcd = wgid % NXCD, off = wgid / NXCD; wgid = (xcd < r ? xcd * (q + 1) : r * (q + 1) + (xcd - r) * q) + off; }
    const int nig = WGM * nN, gid = wgid / nig, fm = gid * WGM, gsz = (nM - fm) < WGM ? (nM - fm) : WGM;
    pm = fm + ((wgid % nig) % gsz); pn = (wgid % nig) / gsz; return true;
}
__device__ __forceinline__ bool tile_order_rep(int i, int G, int c, int nM, int nN, int rep, int& pm, int& pn) {
    if (rep == 1) return tile_order((long)i * G + c, nM, nN, pm, pn);
    const int nwg = nM * nN, per = c < nwg ? (nwg - c + G - 1) / G : 0; if (i >= per * rep) return false;
    return tile_order((long)(i % per) * G + c, nM, nN, pm, pn);
}
struct DenseOrder {
    const bf16* A; const bf16* Bt; int lda, ldb, nM, nN, G, c, rep;
    __device__ __forceinline__ bool next(int i, Unit& u) const { return tile_order_rep(i, G, c, nM, nN, rep, u.pm, u.pn); }
    __device__ __forceinline__ const char* a_base(const Unit& u) const { return (const char*)A + (size_t)u.pm * BM * lda * 2; }
    __device__ __forceinline__ const char* b_base(const Unit& u) const { return (const char*)Bt + (size_t)u.pn * BM * ldb * 2; }
    __device__ __forceinline__ int tok(const Unit&, int) const { return 0; }
};

template <class Epi, class Sched, bool GATHER, int K, int lda, int ldb>
__device__ __forceinline__ void gemm_phase(LAS unsigned char* lds, const int tid, const Sched& S, const Epi& E) {
    const int wid = __builtin_amdgcn_readfirstlane(tid >> 6), lane = tid & 63, wr = wid >> 2, wc = wid & 3, fr = lane & 15, fq = lane >> 4;
    constexpr int nt = K / BK;
    unsigned voffA[2], voffB[2];
#pragma unroll
    for (int i = 0; i < 2; ++i) { int R, C; stage_rc(tid * 16 + i * 8192, R, C); const int Rb = Epi::PERM ? ((R & ~31) + perm32(R & 31)) : R;
        voffA[i] = (unsigned)(R * lda + C) * 2u; voffB[i] = (unsigned)(Rb * ldb + C) * 2u; }
#define PG8_GOFF(u_, h_, o0_, o1_) do { unsigned ones_ = ~0u; asm volatile("" : "+s"(ones_)); const int t_ = wid * 64 + (int)__builtin_amdgcn_mbcnt_hi(ones_, __builtin_amdgcn_mbcnt_lo(ones_, 0u)); \
        int R0_, C0_, R1_, C1_; stage_rc(t_ * 16, R0_, C0_); stage_rc(t_ * 16 + 8192, R1_, C1_); \
        o0_ = (unsigned)S.tok(u_, (h_) * HALF + R0_) * (unsigned)(lda * 2) + (unsigned)(C0_ * 2); o1_ = (unsigned)S.tok(u_, (h_) * HALF + R1_) * (unsigned)(lda * 2) + (unsigned)(C1_ * 2); } while (0)
    const size_t kstep = (size_t)(BK * 2);
    constexpr size_t hstepA = (size_t)HALF * lda * 2, hstepB = (size_t)HALF * ldb * 2;
    const unsigned ldsw = (unsigned)wid * 1024u;
    const int aoff = lds_byte(wr * 64 + fr, fq * 8), boff = lds_byte(wc * 32 + fr, fq * 8);
#define PG8_SA(b, h) (((b) * 2 + (h)) * HTB)
#define PG8_SB(b, h) ((4 + (b) * 2 + (h)) * HTB)
#define PG8_STAGE(bufoff, gbase, v0, v1) do { \
        __builtin_amdgcn_global_load_lds((const unsigned*)((const char*)(gbase) + (v0)), (LAS unsigned*)(lds + (bufoff) + ldsw), 16, 0, 0); \
        __builtin_amdgcn_global_load_lds((const unsigned*)((const char*)(gbase) + (v1)), (LAS unsigned*)(lds + (bufoff) + ldsw + 8192), 16, 0, 0); } while (0)
#define PG8_STB(bufoff, gbase) PG8_STAGE(bufoff, gbase, voffB[0], voffB[1])
#define PG8_STA(bufoff, gbase, h, G0, G1) do { if constexpr (GATHER) PG8_STAGE(bufoff, gbase, G0, G1); else PG8_STAGE(bufoff, (gbase) + (h) * hstepA, voffA[0], voffA[1]); } while (0)
#define PG8_LDA(dst, b, h) do { _Pragma("unroll") for (int m = 0; m < 4; ++m) _Pragma("unroll") for (int k = 0; k < 2; ++k) dst[m][k] = *(const LAS bf16x8*)(lds + PG8_SA(b, h) + aoff + m * 2048 + k * 1024); } while (0)
#define PG8_LDB(dst, b, h) do { _Pragma("unroll") for (int n = 0; n < 2; ++n) _Pragma("unroll") for (int k = 0; k < 2; ++k) dst[n][k] = *(const LAS bf16x8*)(lds + PG8_SB(b, h) + boff + n * 2048 + k * 1024); } while (0)
#define PG8_MMA(ai, bj, At, Bt) do { __builtin_amdgcn_s_setprio(1); _Pragma("unroll") for (int m = 0; m < 4; ++m) _Pragma("unroll") for (int n = 0; n < 2; ++n) _Pragma("unroll") for (int k = 0; k < 2; ++k) \
        acc[ai][bj][m][n] = __builtin_amdgcn_mfma_f32_16x16x32_bf16(Bt[n][k], At[m][k], acc[ai][bj][m][n], 0, 0, 0); __builtin_amdgcn_s_setprio(0); } while (0)
#define PG8_WAIT_V(n) asm volatile("s_waitcnt vmcnt(" #n ")" ::: "memory")
#define PG8_WAIT_L(n) asm volatile("s_waitcnt lgkmcnt(" #n ")" ::: "memory")
#define PG8_BAR __builtin_amdgcn_s_barrier()
#define PG8_SCHED __builtin_amdgcn_sched_barrier(0)
    Unit cur, nxt; int ui = 0;
    if (!S.next(0, cur)) return;
    f32x4 acc[2][2][4][2];
#pragma unroll
    for (int a = 0; a < 2; ++a)
#pragma unroll
        for (int b = 0; b < 2; ++b)
#pragma unroll
            for (int m = 0; m < 4; ++m)
#pragma unroll
                for (int n = 0; n < 2; ++n) acc[a][b][m][n] = (f32x4){0.f, 0.f, 0.f, 0.f};
    bf16x8 At[4][2], B0[2][2], B1[2][2];
    const char* cA = S.a_base(cur); const char* cB = S.b_base(cur);
    unsigned gc00 = 0, gc01 = 0, gc10 = 0, gc11 = 0, gn00 = 0, gn01 = 0, gn10 = 0, gn11 = 0;
    if constexpr (GATHER) { PG8_GOFF(cur, 0, gc00, gc01); PG8_GOFF(cur, 1, gc10, gc11); }
    PG8_STB(PG8_SB(0, 0), cB); PG8_STB(PG8_SB(0, 1), cB + hstepB); PG8_STA(PG8_SA(0, 0), cA, 0, gc00, gc01); PG8_STA(PG8_SA(0, 1), cA, 1, gc10, gc11);
    if (wr == 1) PG8_BAR;
    PG8_WAIT_V(2); PG8_BAR;
    PG8_STB(PG8_SB(1, 0), cB + kstep); PG8_STA(PG8_SA(1, 0), cA + kstep, 0, gc00, gc01); PG8_STB(PG8_SB(1, 1), cB + hstepB + kstep);
    PG8_WAIT_V(6); PG8_BAR;
    for (;;) {
        const bool has_next = S.next(ui + 1, nxt);
        const char* nA = has_next ? S.a_base(nxt) : cA; const char* nB = has_next ? S.b_base(nxt) : cB;
        if constexpr (GATHER) {
            if (has_next) { PG8_GOFF(nxt, 0, gn00, gn01); PG8_GOFF(nxt, 1, gn10, gn11); }
            else { gn00 = gc00; gn01 = gc01; gn10 = gc10; gn11 = gc11; }
        }
#pragma nounroll
        for (int t = 0; t < nt; t += 2) {
            const bool last = (t == nt - 2);
            const char* a1 = cA + (size_t)(t + 1) * kstep;
            const char* a2 = last ? nA : cA + (size_t)(t + 2) * kstep; const char* b2 = last ? nB : cB + (size_t)(t + 2) * kstep;
            const char* a3 = a2 + kstep; const char* b3 = b2 + kstep;
            const unsigned g00 = last ? gn00 : gc00, g01 = last ? gn01 : gc01, g10 = last ? gn10 : gc10, g11 = last ? gn11 : gc11;
            PG8_LDB(B0, 0, 0); PG8_LDB(B1, 0, 1); PG8_SCHED; PG8_LDA(At, 0, 0); PG8_STA(PG8_SA(1, 1), a1, 1, gc10, gc11);
            PG8_WAIT_V(8); PG8_WAIT_L(0); PG8_BAR; PG8_MMA(0, 0, At, B0); PG8_MMA(0, 1, At, B1); PG8_BAR; PG8_SCHED;
            PG8_LDA(At, 0, 1); PG8_STB(PG8_SB(0, 0), b2); PG8_STB(PG8_SB(0, 1), b2 + hstepB); PG8_STA(PG8_SA(0, 0), a2, 0, g00, g01);
            PG8_WAIT_V(8); PG8_WAIT_L(0); PG8_BAR; PG8_MMA(1, 0, At, B0); PG8_MMA(1, 1, At, B1); PG8_BAR; PG8_SCHED;
            PG8_LDB(B0, 1, 0); PG8_LDB(B1, 1, 1); PG8_SCHED; PG8_LDA(At, 1, 0); PG8_STA(PG8_SA(0, 1), a2, 1, g10, g11);
            PG8_WAIT_V(8); PG8_WAIT_L(0); PG8_BAR; PG8_MMA(0, 0, At, B0); PG8_MMA(0, 1, At, B1); PG8_BAR; PG8_SCHED;
            PG8_LDA(At, 1, 1); PG8_STB(PG8_SB(1, 0), b3); PG8_STB(PG8_SB(1, 1), b3 + hstepB); PG8_STA(PG8_SA(1, 0), a3, 0, g00, g01);
            PG8_WAIT_V(8); PG8_WAIT_L(0); PG8_BAR; PG8_MMA(1, 0, At, B0); PG8_MMA(1, 1, At, B1); PG8_BAR; PG8_SCHED;
        }
        if (wr == 0) PG8_BAR;
        { unsigned ones_ = ~0u; asm volatile("" : "+s"(ones_)); const int l_ = (int)__builtin_amdgcn_mbcnt_hi(ones_, __builtin_amdgcn_mbcnt_lo(ones_, 0u)); E(acc, cur, wr, wc, l_ & 15, l_ >> 4); }
        if (!has_next) break;
#pragma unroll
        for (int a = 0; a < 2; ++a)
#pragma unroll
            for (int b = 0; b < 2; ++b)
#pragma unroll
                for (int m = 0; m < 4; ++m)
#pragma unroll
                    for (int n = 0; n < 2; ++n) acc[a][b][m][n] = (f32x4){0.f, 0.f, 0.f, 0.f};
        cur = nxt; cA = nA; cB = nB; ++ui;
        if constexpr (GATHER) { gc00 = gn00; gc01 = gn01; gc10 = gn10; gc11 = gn11; }
        if (wr == 1) PG8_BAR;
    }
    PG8_WAIT_V(0);
    PG8_BAR;
#undef PG8_GOFF
#undef PG8_SA
#undef PG8_SB
#undef PG8_STAGE
#undef PG8_STB
#undef PG8_STA
#undef PG8_LDA
#undef PG8_LDB
#undef PG8_MMA
#undef PG8_WAIT_V
#undef PG8_WAIT_L
#undef PG8_BAR
#undef PG8_SCHED
}
}

#define EPI_ROWS_BEGIN _Pragma("unroll") for (int ai = 0; ai < 2; ++ai) _Pragma("unroll") for (int m = 0; m < 4; ++m) { const unsigned row = (unsigned)(u.pm * 256 + ai * 128 + wr * 64 + m * 16 + fr);
#define EPI_ROWS_END asm volatile("" ::: "memory"); }
__device__ __forceinline__ void st16(void* base, unsigned off, u32x4 v) { *(u32x4*)((char*)base + off) = v; }
struct EpiInProj {
    static constexpr bool PERM = true;
    bf16* CQ; bf16* CKV; float* KR; float* FL; bf16* FQ; bf16* CI;
    __device__ __forceinline__ void operator()(const f32x4 (&acc)[2][2][4][2], const pg8::Unit& u, int wr, int wc, int fr, int fq) const {
        const int t = u.pn; const unsigned c8 = (unsigned)(wc * 32 + 8 * fq);
        if (t != 1) {
            bf16* base; unsigned ld;
            if (t == 0) { base = CQ; ld = 256; } else if (t <= 4) { base = FQ + (size_t)(t - 2) * M * 256; ld = 256; } else { base = CI + (t - 5) * 256; ld = 512; }
            EPI_ROWS_BEGIN
                const unsigned off = (row * ld + c8) * 2u;
                st16(base, off, pack8(acc[ai][0][m][0], acc[ai][0][m][1]));
                st16(base, off + 256u, pack8(acc[ai][1][m][0], acc[ai][1][m][1]));
            EPI_ROWS_END
        } else {
            EPI_ROWS_BEGIN
                const unsigned off = (row * 256u + c8) * 2u;
                st16(CKV, off, pack8(acc[ai][0][m][0], acc[ai][0][m][1]));
                st16(CKV, off + 256u, (u32x4){0u, 0u, 0u, 0u});
                if (c8 < 32) { const unsigned ko = (row * 32u + c8) * 4u; *(f32x4*)((char*)KR + ko) = acc[ai][1][m][0]; *(f32x4*)((char*)KR + ko + 16) = acc[ai][1][m][1]; }
                else if (c8 == 32) { *(f32x4*)((char*)FL + row * 16u) = acc[ai][1][m][0]; }
            EPI_ROWS_END
        }
    }
};
struct EpiQKV {
    static constexpr bool PERM = true;
    bf16* QM; bf16* KM; bf16* VM; const float* COS; const float* SIN;
    __device__ __forceinline__ void operator()(const f32x4 (&acc)[2][2][4][2], const pg8::Unit& u, int wr, int wc, int fr, int fq) const {
        const int t = u.pn; const unsigned c8 = (unsigned)(wc * 32 + 8 * fq);
        if (t < 3) {
#pragma unroll
            for (int bj = 0; bj < 2; ++bj) {
                const unsigned col = (unsigned)(t * 256 + bj * 128) + c8, h = col / 96u, d = col - h * 96u;
                const bool rope = d >= 64; const unsigned f4 = rope ? ((d - 64) >> 1) : 0u;
                EPI_ROWS_BEGIN
                    f32x4 v0 = acc[ai][bj][m][0], v1 = acc[ai][bj][m][1];
                    if (rope) {
                        const unsigned to = (row * 16u + f4) * 4u;
                        const f32x4 c = *(const f32x4*)((const char*)COS + to), s = *(const f32x4*)((const char*)SIN + to);
                        const f32x4 a = v0, b = v1;
                        v0 = (f32x4){a[0] * c[0] - a[2] * s[0], a[1] * c[1] - a[3] * s[1], a[0] * s[0] + a[2] * c[0], a[1] * s[1] + a[3] * c[1]};
                        v1 = (f32x4){b[0] * c[2] - b[2] * s[2], b[1] * c[3] - b[3] * s[3], b[0] * s[2] + b[2] * c[2], b[1] * s[3] + b[3] * c[3]};
                    }
                    st16(QM, (row * 768u + col) * 2u, pack8(v0, v1));
                EPI_ROWS_END
            }
        } else if (t < 5) {
#pragma unroll
            for (int bj = 0; bj < 2; ++bj) {
                const unsigned kc = (unsigned)((t - 3) * 256 + bj * 128) + c8, h = kc >> 6, d = kc & 63;
                EPI_ROWS_BEGIN
                    st16(KM, (row * 768u + h * 96u + d) * 2u, pack8(acc[ai][bj][m][0], acc[ai][bj][m][1]));
                EPI_ROWS_END
            }
        } else {
#pragma unroll
            for (int bj = 0; bj < 2; ++bj) {
                const unsigned vc = (unsigned)((t - 5) * 256 + bj * 128) + c8;
                EPI_ROWS_BEGIN
                    st16(VM, (row * 512u + vc) * 2u, pack8(acc[ai][bj][m][0], acc[ai][bj][m][1]));
                EPI_ROWS_END
            }
        }
    }
};
template <int LDC, bool SCALE>
struct EpiBf16 {
    static constexpr bool PERM = true;
    bf16* O; int ntn; const float* rowscale;
    __device__ __forceinline__ void operator()(const f32x4 (&acc)[2][2][4][2], const pg8::Unit& u, int wr, int wc, int fr, int fq) const {
        const unsigned col = (unsigned)((u.pn % ntn) * 256 + wc * 32 + 8 * fq);
        EPI_ROWS_BEGIN
            float s = 1.0f; if constexpr (SCALE) s = *(const float*)((const char*)rowscale + row * 4u);
            const unsigned off = (row * (unsigned)LDC + col) * 2u;
            st16(O, off, pack8(acc[ai][0][m][0] * s, acc[ai][0][m][1] * s));
            st16(O, off + 256u, pack8(acc[ai][1][m][0] * s, acc[ai][1][m][1] * s));
        EPI_ROWS_END
    }
};
template <int LDH>
struct EpiSwiGLU {
    static constexpr bool PERM = true;
    bf16* H; int ntn;
    __device__ __forceinline__ void operator()(const f32x4 (&acc)[2][2][4][2], const pg8::Unit& u, int wr, int wc, int fr, int fq) const {
        const unsigned col = (unsigned)((u.pn % ntn) * 128 + wc * 32 + 8 * fq);
        EPI_ROWS_BEGIN
            f32x4 a0 = acc[ai][0][m][0], a1 = acc[ai][0][m][1]; const f32x4 b0 = acc[ai][1][m][0], b1 = acc[ai][1][m][1];
#pragma unroll
            for (int j = 0; j < 4; ++j) { a0[j] = siluf_(a0[j]) * b0[j]; a1[j] = siluf_(a1[j]) * b1[j]; }
            st16(H, (row * (unsigned)LDH + col) * 2u, pack8(a0, a1));
        EPI_ROWS_END
    }
};
struct MoeOrder {
    const bf16* A; const bf16* Bt; int lda, ldb, nM, nN, G, c, rep; const int* slot_tok; int s1, s2, s3, s4, s5, s6, s7;
    __device__ __forceinline__ int expert_of(int rt) const { const int r = rt * 256; return (r >= s1) + (r >= s2) + (r >= s3) + (r >= s4) + (r >= s5) + (r >= s6) + (r >= s7); }
    __device__ __forceinline__ bool next(int i, pg8::Unit& u) const { int pm, pn; if (!pg8::tile_order_rep(i, G, c, nM, nN, rep, pm, pn)) return false; u.pm = pm; u.pn = expert_of(pm) * nN + pn; return true; }
    __device__ __forceinline__ const char* a_base(const pg8::Unit& u) const { return slot_tok ? (const char*)A : (const char*)A + (size_t)u.pm * 256 * lda * 2; }
    __device__ __forceinline__ const char* b_base(const pg8::Unit& u) const { return (const char*)Bt + (size_t)u.pn * 256 * ldb * 2; }
    __device__ __forceinline__ int tok(const pg8::Unit& u, int r) const { return slot_tok[u.pm * 256 + r]; }
};

namespace att {
__device__ __forceinline__ int crow(int r, int hi) { return (r & 3) + 8 * (r >> 2) + 4 * hi; }
__device__ __forceinline__ s16x4 vtr(const LAS unsigned char* p) { typedef short v4i16_t __attribute__((ext_vector_type(4))); return __builtin_bit_cast(s16x4, __builtin_amdgcn_ds_read_tr16_b64_v4i16((LAS v4i16_t*)p)); }
#define ATT_WAITBAR() asm volatile("s_waitcnt vmcnt(0) lgkmcnt(0)\n\ts_barrier" ::: "memory")

template <int DQK, bool BIAS>
__device__ __forceinline__ void attn_unit(int b, int h, int qb, const bf16* Q, int pq, const bf16* K, int pk, const bf16* V, int pv,
                                          bf16* O, int po, int ocol, const float* cum, LAS unsigned char* shm, const int tid) {
    constexpr int NCH = DQK / 8, KSLOT = NCH * 1024, ND0 = DQK / 16;
    constexpr int LK = 0, LV = 2 * KSLOT, LWS = LV + 2 * 8192, LOST = LWS + NWAVES * 256, LCUM = LOST + NWAVES * 4096;
    static_assert(LCUM + SEQ * 4 <= RING_BYTES, "attention LDS");
    const int lane = tid & 63, r32 = lane & 31, hi = lane >> 5; const int wid = __builtin_amdgcn_readfirstlane(tid >> 6);
    const long rowbase = (long)b * SEQ; const int q0 = qb * 256;
    const bf16* Qw = Q + (rowbase + q0 + wid * 32) * pq + h * DQK;
    const bf16* Kh = K + rowbase * pk + h * DQK; const bf16* Vh = V + rowbase * pv + h * 64;
    const int NT = (q0 + 256) / 64;
    LAS float* wsf = (LAS float*)(shm + LWS) + wid * 64;
    LAS float* cumL = (LAS float*)(shm + LCUM);
    if constexpr (BIAS) { const float* cs = cum + (size_t)(b * 4 + h) * SEQ; for (int i = tid * 4; i < q0 + 256; i += NTHR * 4) *(LAS f32x4*)(cumL + i) = *(const f32x4*)(cs + i); }
    const bf16* ksrc = Kh + (long)lane * pk + wid * 8;
    const bf16* vsrc = Vh + (long)(16 * (wid & 3) + (lane >> 2)) * pv + (wid >> 2) * 32 + (lane & 3) * 8;
#define ATT_DMA(t, slot) do { \
        __builtin_amdgcn_global_load_lds((const unsigned*)(ksrc + (long)(t) * 64 * pk), (LAS unsigned*)(shm + LK + (slot) * KSLOT + wid * 1024), 16, 0, 0); \
        if (NCH > 8 && wid + 8 < NCH) __builtin_amdgcn_global_load_lds((const unsigned*)(ksrc + (long)(t) * 64 * pk + 64), (LAS unsigned*)(shm + LK + (slot) * KSLOT + (wid + 8) * 1024), 16, 0, 0); \
        __builtin_amdgcn_global_load_lds((const unsigned*)(vsrc + (long)(t) * 64 * pv), (LAS unsigned*)(shm + LV + (slot) * 8192 + wid * 1024), 16, 0, 0); } while (0)
    ATT_DMA(0, 0);
    bf16x8 qr[ND0];
#pragma unroll
    for (int d0 = 0; d0 < ND0; ++d0) qr[d0] = *(const bf16x8*)(Qw + (long)r32 * pq + d0 * 16 + hi * 8);
    float mrow = -1e30f, lrow = 0.f; f32x16 o0 = {}, o1 = {};
    const int qrel = wid * 32 + r32;
    ATT_WAITBAR();
    float fqb = 0.f; if constexpr (BIAS) fqb = cumL[q0 + qrel];
    for (int t = 0; t < NT; ++t) {
        const int cur = t & 1;
        if (t + 1 < NT) ATT_DMA(t + 1, cur ^ 1);
        f32x16 p0 = {}, p1 = {};
        const LAS unsigned char* kp = shm + LK + cur * KSLOT + hi * 1024 + r32 * 16;
#pragma unroll
        for (int d0 = 0; d0 < ND0; ++d0) {
            const bf16x8 a0 = *(const LAS bf16x8*)(kp + d0 * 2048), a1 = *(const LAS bf16x8*)(kp + d0 * 2048 + 512);
            p0 = __builtin_amdgcn_mfma_f32_32x32x16_bf16(a0, qr[d0], p0, 0, 0, 0);
            p1 = __builtin_amdgcn_mfma_f32_32x32x16_bf16(a1, qr[d0], p1, 0, 0, 0);
        }
        if constexpr (BIAS) {
#pragma unroll
            for (int g = 0; g < 4; ++g) {
                const f32x4 f0 = *(const LAS f32x4*)(cumL + t * 64 + 8 * g + 4 * hi), f1 = *(const LAS f32x4*)(cumL + t * 64 + 32 + 8 * g + 4 * hi);
#pragma unroll
                for (int j = 0; j < 4; ++j) { p0[4 * g + j] += fqb - f0[j]; p1[4 * g + j] += fqb - f1[j]; }
            }
        }
        if (t >= NT - 4) {
            const int kb = 64 * (t - (NT - 4)) + 4 * hi;
#pragma unroll
            for (int r = 0; r < 16; ++r) { const int kv = kb + (r & 3) + 8 * (r >> 2); if (kv > qrel) p0[r] = -INFINITY; if (kv + 32 > qrel) p1[r] = -INFINITY; }
        }
        float rm = fmaxf(p0[0], p1[0]);
#pragma unroll
        for (int r = 1; r < 16; ++r) rm = fmaxf(rm, fmaxf(p0[r], p1[r]));
        { auto rr = __builtin_amdgcn_permlane32_swap(__float_as_uint(rm), __float_as_uint(rm), false, false); rm = fmaxf(__uint_as_float(rr[0]), __uint_as_float(rr[1])); }
        const float mnew = fmaxf(mrow, rm);
        const float alpha = fexp2(mrow - mnew);
        const bool grew = mnew > mrow;
        mrow = mnew;
        float ps = 0.f;
#pragma unroll
        for (int r = 0; r < 16; ++r) { p0[r] = fexp2(p0[r] - mnew); p1[r] = fexp2(p1[r] - mnew); ps += p0[r] + p1[r]; }
        lrow = lrow * alpha + ps;
        if (__builtin_amdgcn_ballot_w64(grew) != 0ull) {
            if (hi == 0) wsf[r32] = alpha;
#pragma unroll
            for (int g = 0; g < 4; ++g) { const f32x4 a4 = *(const LAS f32x4*)(wsf + 8 * g + 4 * hi);
#pragma unroll
                for (int j = 0; j < 4; ++j) { o0[4 * g + j] *= a4[j]; o1[4 * g + j] *= a4[j]; } }
        }
        u32x4 pw[4];
        pw[0] = (u32x4){pk2(p0[0], p0[1]), pk2(p0[2], p0[3]), pk2(p0[4], p0[5]), pk2(p0[6], p0[7])};
        pw[1] = (u32x4){pk2(p0[8], p0[9]), pk2(p0[10], p0[11]), pk2(p0[12], p0[13]), pk2(p0[14], p0[15])};
        pw[2] = (u32x4){pk2(p1[0], p1[1]), pk2(p1[2], p1[3]), pk2(p1[4], p1[5]), pk2(p1[6], p1[7])};
        pw[3] = (u32x4){pk2(p1[8], p1[9]), pk2(p1[10], p1[11]), pk2(p1[12], p1[13]), pk2(p1[14], p1[15])};
        const LAS unsigned char* vp = shm + LV + cur * 8192 + ((lane >> 4) & 1) * 32 + (lane & 3) * 8 + (4 * hi + ((lane & 15) >> 2)) * 64;
#pragma unroll
        for (int ks = 0; ks < 4; ++ks) {
            const s16x4 l0 = vtr(vp + ks * 1024), h0 = vtr(vp + ks * 1024 + 512), l1 = vtr(vp + 4096 + ks * 1024), h1 = vtr(vp + 4096 + ks * 1024 + 512);
            const bf16x8 v0 = (bf16x8){l0[0], l0[1], l0[2], l0[3], h0[0], h0[1], h0[2], h0[3]}, v1 = (bf16x8){l1[0], l1[1], l1[2], l1[3], h1[0], h1[1], h1[2], h1[3]};
            o0 = __builtin_amdgcn_mfma_f32_32x32x16_bf16(__builtin_bit_cast(bf16x8, pw[ks]), v0, o0, 0, 0, 0);
            o1 = __builtin_amdgcn_mfma_f32_32x32x16_bf16(__builtin_bit_cast(bf16x8, pw[ks]), v1, o1, 0, 0, 0);
        }
        ATT_WAITBAR();
    }
    { auto rr = __builtin_amdgcn_permlane32_swap(__float_as_uint(lrow), __float_as_uint(lrow), false, false); lrow = __uint_as_float(rr[0]) + __uint_as_float(rr[1]); }
    if (hi == 0) wsf[32 + r32] = lrow;
    LAS bf16* stg = (LAS bf16*)(shm + LOST) + wid * 2048;
#pragma unroll
    for (int g = 0; g < 4; ++g) { const f32x4 l4 = *(const LAS f32x4*)(wsf + 32 + 8 * g + 4 * hi);
#pragma unroll
        for (int j = 0; j < 4; ++j) { const int r = 4 * g + j, orow = crow(r, hi); const float rl = frcp(l4[j]);
            stg[orow * 64 + r32] = (bf16)(pk2(o0[r] * rl, 0.f) & 0xffffu); stg[orow * 64 + 32 + r32] = (bf16)(pk2(o1[r] * rl, 0.f) & 0xffffu); } }
    asm volatile("s_waitcnt lgkmcnt(0)" ::: "memory");
    bf16* Ow = O + (rowbase + q0 + wid * 32) * po + ocol;
#pragma unroll
    for (int i = 0; i < 4; ++i) { const int row = i * 8 + (lane >> 3), ch = lane & 7; const u32x4 v = *(const LAS u32x4*)(stg + row * 64 + ch * 8); *(u32x4*)(Ow + (long)row * po + ch * 8) = v; }
    asm volatile("s_waitcnt lgkmcnt(0)\n\ts_barrier" ::: "memory");
#undef ATT_DMA
}
}

struct Args { const float* in[26]; float* out; unsigned char* ws; int ph_lo, ph_hi; };
typedef const __attribute__((address_space(4))) Args* kargs_t;
struct Ctx {
    LAS unsigned char* lds; unsigned* ctl; unsigned char* ws; float* out;
    int tid, lane, wave, vcu, G, gw, NGW, bx;
};
__device__ __forceinline__ kargs_t opaque_args() { kargs_t p = (kargs_t)__builtin_amdgcn_kernarg_segment_ptr(); asm volatile("" : "+s"(p)); return p; }
__device__ __forceinline__ Ctx make_ctx(kargs_t A, LAS unsigned char* lds, int wave0) {
    Ctx C; unsigned ones = ~0u; asm volatile("" : "+s"(ones));
    int t = wave0 * 64 + (int)__builtin_amdgcn_mbcnt_hi(ones, __builtin_amdgcn_mbcnt_lo(ones, 0u)); asm volatile("" : "+v"(t));
    C.lds = lds; C.ws = A->ws; C.ctl = (unsigned*)(C.ws + WS_CTL); C.out = A->out;
    C.tid = t; C.lane = t & 63; C.wave = __builtin_amdgcn_readfirstlane(t >> 6);
    { int g_ = gridDim.x, b_ = blockIdx.x; asm volatile("" : "+s"(g_), "+s"(b_)); C.G = g_; C.bx = b_; } C.vcu = (C.bx % 8) * (C.G / 8) + C.bx / 8;
    C.gw = C.vcu * NWAVES + C.wave; C.NGW = C.G * NWAVES;
    return C;
}
#define LDS_WAIT() asm volatile("s_waitcnt lgkmcnt(0)" ::: "memory")

struct MapWin { __device__ __forceinline__ int row(int n) const {
        if (n < 256) return PC_CQ + n; if (n < 384) return PC_CKV + (n - 256); if (n < 416) return PC_KR + (n - 384); if (n < 672) return PC_FQ + (n - 416);
        if (n < 928) return PC_FK + (n - 672); if (n < 1184) return PC_FV + (n - 928); if (n < 1188) return PC_FL + (n - 1184); return PC_CI + (n - 1188); }
    __device__ __forceinline__ float scale(int, int n) const { return (n >= 416 && n < 672) ? C2_FOX : 1.0f; } };
struct MapUq { const float* g; __device__ __forceinline__ int row(int n) const { const int h = n / 96, d = n - h * 96; if (d < 64) return n; const int i = d - 64;
        const int s = (i < 16) ? (4 * (i >> 1) + (i & 1)) : (4 * ((i - 16) >> 1) + 2 + (i & 1)); return h * 96 + 64 + s; }
    __device__ __forceinline__ float scale(int k, int) const { return g[k] * C2_MLA; } };
struct MapUkv { const float* g; __device__ __forceinline__ int row(int n) const { const int h = n >> 7, d = n & 127; return d < 64 ? (768 + h * 64 + d) : (1280 + h * 64 + (d - 64)); }
    __device__ __forceinline__ float scale(int k, int) const { return g[k]; } };
struct MapWout { const float* gm; const float* gf; __device__ __forceinline__ int row(int n) const { return n; }
    __device__ __forceinline__ float scale(int k, int) const { return k < 512 ? gm[k] : (k < 768 ? gf[k - 512] : 1.0f); } };
struct MapW13 { int which; __device__ __forceinline__ int row(int n) const { return (n >> 7) * 256 + which * 128 + (n & 127); }
    __device__ __forceinline__ float scale(int, int) const { return 1.0f; } };
struct MapId { __device__ __forceinline__ int row(int n) const { return n; } __device__ __forceinline__ float scale(int, int) const { return 1.0f; } };

template <class Map>
__device__ __forceinline__ void transpose_item(const float* W, int Nsrc, bf16* WT, int ldk, LAS float* scr, int kb, int nb, int lane, const Map mp) {
    const int k0 = 64 * kb, n0 = 32 * nb, r8 = lane >> 3, nn = n0 + 4 * (lane & 7); const bool nok = nn < Nsrc;
    f32x4 v[8];
#pragma unroll
    for (int i = 0; i < 8; ++i) { v[i] = (f32x4){0.f, 0.f, 0.f, 0.f}; if (nok) v[i] = *(const f32x4*)(W + (size_t)(k0 + 8 * i + r8) * Nsrc + nn); }
#pragma unroll
    for (int i = 0; i < 8; ++i) { const int kk = 8 * i + r8; LAS float* d = scr + kk * 33 + 4 * (lane & 7);
#pragma unroll
        for (int j = 0; j < 4; ++j) d[j] = v[i][j] * mp.scale(k0 + kk, nn + j); }
    LDS_WAIT(); asm volatile("" ::: "memory");
    const int c = lane & 7;
#pragma unroll
    for (int j = 0; j < 4; ++j) { const int n = (lane >> 3) + 8 * j; const LAS float* s = scr + (8 * c) * 33 + n;
        if (n0 + n < Nsrc) { u32x4 o; o.x = pk2(s[0 * 33], s[1 * 33]); o.y = pk2(s[2 * 33], s[3 * 33]); o.z = pk2(s[4 * 33], s[5 * 33]); o.w = pk2(s[6 * 33], s[7 * 33]);
            *(u32x4*)(WT + (size_t)mp.row(n0 + n) * ldk + k0 + 8 * c) = o; } }
    LDS_WAIT(); asm volatile("" ::: "memory");
}

__device__ __forceinline__ void sincos_acc(float ang, float& c, float& s) {
    const double a = (double)ang, q = __builtin_rint(a * 0.63661977236758134308);
    const double y = (a - q * 1.57079632679489655800) - q * 6.12323399573676603587e-17, y2 = y * y;
    const double sp = y * (1.0 + y2 * (-1.0 / 6 + y2 * (1.0 / 120 + y2 * (-1.0 / 5040 + y2 * (1.0 / 362880 + y2 * (-1.0 / 39916800 + y2 * (1.0 / 6227020800.0)))))));
    const double cp = 1.0 + y2 * (-0.5 + y2 * (1.0 / 24 + y2 * (-1.0 / 720 + y2 * (1.0 / 40320 + y2 * (-1.0 / 3628800 + y2 * (1.0 / 479001600 + y2 * (-1.0 / 87178291200.0)))))));
    const int quad = (int)((long long)q & 3);
    const double ss = (quad == 0) ? sp : (quad == 1) ? cp : (quad == 2) ? -sp : -cp;
    const double cc = (quad == 0) ? cp : (quad == 1) ? -sp : (quad == 2) ? -cp : sp;
    c = (float)cc; s = (float)ss;
}
__device__ __forceinline__ float inv_freq(int f) {
    const int a = f >> 2, b = f & 3;
    const float p = (a == 0) ? 1.0f : (a == 1) ? 0.1f : (a == 2) ? 0.01f : 0.001f;
    const float m = (b == 0) ? 1.0f : (b == 1) ? 0.56234132519034908f : (b == 2) ? 0.31622776601683794f : 0.17782794100389228f;
    return (b == 0) ? p : (float)((double)p * (double)m);
}

__device__ __forceinline__ void p0_prologue(Ctx& C, kargs_t A) {
    LAS float* scr = (LAS float*)(C.lds + C.wave * 16384);
    bf16* WIN = (bf16*)(C.ws + WS_WIN); bf16* WQ2 = (bf16*)(C.ws + WS_WQ2); bf16* WOUT = (bf16*)(C.ws + WS_WOUT);
    constexpr int I_IN = 16 * 54, I_UQ = 4 * 24, I_UKV = 2 * 32, I_OUT = 16 * 32, I_L = I_IN + I_UQ + I_UKV + I_OUT;
    REPS(12) for (int it = C.gw; it < DEPTH * I_L; it += C.NGW) {
        const int l = it / I_L; int r = it - l * I_L;
        if (r < I_IN) { transpose_item(A->in[2] + (size_t)l * DM * IN_COLS, IN_COLS, WIN + (size_t)l * NP1 * DM, DM, scr, r / 54, r % 54, C.lane, MapWin{}); continue; } r -= I_IN;
        if (r < I_UQ) { transpose_item(A->in[4] + (size_t)l * 256 * 768, 768, WQ2 + (size_t)l * NP1 * 256, 256, scr, r / 24, r % 24, C.lane, MapUq{A->in[3] + l * 256}); continue; } r -= I_UQ;
        if (r < I_UKV) { transpose_item(A->in[6] + (size_t)l * 128 * 1024, 1024, WQ2 + (size_t)l * NP1 * 256, 256, scr, r / 32, r % 32, C.lane, MapUkv{A->in[5] + l * 128}); continue; } r -= I_UKV;
        transpose_item(A->in[14] + (size_t)l * DM * DM, DM, WOUT + (size_t)l * DM * DM, DM, scr, r / 32, r % 32, C.lane, MapWout{A->in[12] + l * 512, A->in[13] + l * 256});
    }
    const int gt = C.vcu * NTHR + C.tid, NGT = C.G * NTHR;
    for (int i = gt; i < DEPTH * 92 * 128; i += NGT) { const int l = i / (92 * 128), r = i % (92 * 128); *(u32x4*)(WIN + (size_t)l * NP1 * DM + (size_t)(420 + r / 128) * DM + (r % 128) * 8) = (u32x4){0u, 0u, 0u, 0u}; }
    for (int i = gt; i < DEPTH * 1024 * 16; i += NGT) { const int l = i / (1024 * 16), r = i % (1024 * 16); *(u32x4*)(WQ2 + (size_t)l * NP1 * 256 + (size_t)(768 + r / 16) * 256 + 128 + (r % 16) * 8) = (u32x4){0u, 0u, 0u, 0u}; }
    bf16* XB = (bf16*)(C.ws + WS_XB); const float* x = A->in[0];
    for (int m = C.gw; m < M; m += C.NGW) { const f32x4* xr = (const f32x4*)(x + (size_t)m * DM) + C.lane; u32x2* o = (u32x2*)(XB + (size_t)m * DM) + C.lane;
#pragma unroll
        for (int j = 0; j < 4; ++j) { const f32x4 v = xr[64 * j]; o[64 * j] = (u32x2){pk2(v[0], v[1]), pk2(v[2], v[3])}; } }
    float* COS = (float*)(C.ws + WS_TAB); float* SIN = COS + (size_t)M * 16; const int* pos = (const int*)A->in[1];
    for (int i = gt; i < M * 16; i += NGT) { const float ang = (float)pos[i >> 4] * inv_freq(i & 15); float c, s; sincos_acc(ang, c, s); COS[i] = c; SIN[i] = s; }
}

__device__ __forceinline__ void ffn_weights(Ctx& C, kargs_t A, int layer) {
    LAS float* scr = (LAS float*)(C.lds + C.wave * 16384);
    bf16* W13 = (bf16*)(C.ws + WS_WFFN); bf16* W2T = W13 + WF_W13_ELEMS; const int j = layer >> 1;
    if ((layer & 1) == 0) {
        constexpr int I1 = 16 * 88, I2 = 44 * 32;
        const float* w1 = A->in[17] + (size_t)j * DM * DFF; const float* w3 = A->in[18] + (size_t)j * DM * DFF; const float* w2 = A->in[19] + (size_t)j * DFF * DM;
        for (int it = C.gw; it < 2 * I1 + I2; it += C.NGW) {
            int r = it;
            if (r < I1) { transpose_item(w1, DFF, W13, DM, scr, r / 88, r % 88, C.lane, MapW13{0}); continue; } r -= I1;
            if (r < I1) { transpose_item(w3, DFF, W13, DM, scr, r / 88, r % 88, C.lane, MapW13{1}); continue; } r -= I1;
            transpose_item(w2, DM, W2T, DFF, scr, r / 32, r % 32, C.lane, MapId{});
        }
    } else {
        constexpr int I1 = 16 * 44, I2 = 22 * 32, IE = 2 * I1 + I2;
        for (int it = C.gw; it < NEXP * IE; it += C.NGW) {
            const int e = it / IE; int r = it - e * IE;
            const float* w1 = A->in[21] + ((size_t)j * NEXP + e) * DM * DFE; const float* w3 = A->in[22] + ((size_t)j * NEXP + e) * DM * DFE; const float* w2 = A->in[23] + ((size_t)j * NEXP + e) * DFE * DM;
            bf16* W13e = W13 + (size_t)e * 2 * DFE * DM; bf16* W2Te = W2T + (size_t)e * DM * DFE;
            if (r < I1) { transpose_item(w1, DFE, W13e, DM, scr, r / 44, r % 44, C.lane, MapW13{0}); continue; } r -= I1;
            if (r < I1) { transpose_item(w3, DFE, W13e, DM, scr, r / 44, r % 44, C.lane, MapW13{1}); continue; } r -= I1;
            transpose_item(w2, DM, W2Te, DFE, scr, r / 32, r % 32, C.lane, MapId{});
        }
    }
}

__device__ __forceinline__ void p2_thin(Ctx& C, kargs_t A, int layer) {
    unsigned char* sc = C.ws + WS_SCR;
    bf16* CQ = (bf16*)(sc + SC_CQKV); bf16* CKV = CQ + (size_t)M * 256; const float* KR = (const float*)(sc + SC_KR); const float* FL = (const float*)(sc + SC_FL);
    float* CUM = (float*)(sc + SC_CUM); const bf16* CI = (const bf16*)(sc + SC_CI); bf16* KM = (bf16*)(sc + SC_KM); bf16* MIXED = (bf16*)(sc + SC_MIXED);
    const float* COS = (const float*)(C.ws + WS_TAB); const float* SIN = COS + (size_t)M * 16;
    if (C.gw < BATCH * 4) {
        const int b = C.gw >> 2, h = C.gw & 3; const float bias = A->in[7][layer * 4 + h];
        float v[64]; float run = 0.f;
#pragma unroll
        for (int i = 0; i < 64; ++i) { const float z = FL[((size_t)b * SEQ + C.lane * 64 + i) * 4 + h] + bias; const float e = fexp2(-fabsf(z) * LOG2E);
            const float ls = fminf(z, 0.f) - __builtin_amdgcn_logf(1.0f + e) * 0.6931471805599453f; run += ls * LOG2E; v[i] = run; }
        float incl = run;
#pragma unroll
        for (int o = 1; o < 64; o <<= 1) { const float t = __int_as_float(__builtin_amdgcn_ds_bpermute((C.lane - o) << 2, __float_as_int(incl))); if (C.lane >= o) incl += t; }
        const float excl = incl - run; float* dst = CUM + (size_t)C.gw * SEQ + C.lane * 64;
#pragma unroll
        for (int i = 0; i < 64; i += 4) *(f32x4*)(dst + i) = (f32x4){v[i] + excl, v[i + 1] + excl, v[i + 2] + excl, v[i + 3] + excl};
    }
    for (int m = C.gw; m < M; m += C.NGW) {
        { u32x2* p = (u32x2*)(CQ + (size_t)m * 256) + C.lane; const u32x2 w = *p; const float a0 = bflo(w.x), a1 = bfhi(w.x), a2 = bflo(w.y), a3 = bfhi(w.y);
          const float ss = wave_sum((a0 * a0 + a1 * a1) + (a2 * a2 + a3 * a3)); const float r = 1.0f / sqrtf(ss * (1.0f / 256) + EPS); *p = (u32x2){pk2(a0 * r, a1 * r), pk2(a2 * r, a3 * r)}; }
        { unsigned* p = (unsigned*)(CKV + (size_t)m * 256) + C.lane; const unsigned w = *p; const float a0 = bflo(w), a1 = bfhi(w);
          const float ss = wave_sum(a0 * a0 + a1 * a1); const float r = 1.0f / sqrtf(ss * (1.0f / 128) + EPS); *p = pk2(a0 * r, a1 * r); }
        { const int h = C.lane >> 3, g4 = C.lane & 7; const f32x2 x1 = *(const f32x2*)(KR + (size_t)m * 32 + 2 * g4), x2 = *(const f32x2*)(KR + (size_t)m * 32 + 16 + 2 * g4);
          const f32x2 c = *(const f32x2*)(COS + (size_t)m * 16 + 2 * g4), s = *(const f32x2*)(SIN + (size_t)m * 16 + 2 * g4);
          *(u32x2*)(KM + (size_t)m * 768 + h * 96 + 64 + 4 * g4) = (u32x2){pk2(x1.x * c.x - x2.x * s.x, x1.y * c.y - x2.y * s.y), pk2(x1.x * s.x + x2.x * c.x, x1.y * s.y + x2.y * c.y)}; }
    }
    {
        LAS float* hL = (LAS float*)C.lds; LAS float* yL = hL + 62 * 256;
        const int cch = (C.wave & 3) * 64 + C.lane, tt0 = (C.wave >> 2) * 16;
        float wj[31];
#pragma unroll
        for (int j = 0; j < 31; ++j) wj[j] = A->in[8][((size_t)layer * 31 + j) * 256 + cch];
        const float cb = A->in[9][layer * 256 + cch];
        const int ntok = C.tid >> 4, ngrp = (C.tid >> 2) & 3, nqt = C.tid & 3, nc0 = ngrp * 64 + nqt * 16;
        REPS(10) for (int tile = C.vcu; tile < M / 32; tile += C.G) {
            const int t0 = tile * 32, seq0 = (t0 / SEQ) * SEQ;
            for (int it = C.tid; it < 62 * 32; it += NTHR) { const int r = it >> 5, ch = it & 31, tok = t0 - 30 + r; f32x4 o0 = {0.f, 0.f, 0.f, 0.f}, o1 = o0;
                if (tok >= seq0) { const u32x4 a = *(const u32x4*)(CI + (size_t)tok * 512 + ch * 8), g = *(const u32x4*)(CI + (size_t)tok * 512 + 256 + ch * 8);
                    o0 = (f32x4){bflo(a.x) * sigmoidf_(bflo(g.x)), bfhi(a.x) * sigmoidf_(bfhi(g.x)), bflo(a.y) * sigmoidf_(bflo(g.y)), bfhi(a.y) * sigmoidf_(bfhi(g.y))};
                    o1 = (f32x4){bflo(a.z) * sigmoidf_(bflo(g.z)), bfhi(a.z) * sigmoidf_(bfhi(g.z)), bflo(a.w) * sigmoidf_(bflo(g.w)), bfhi(a.w) * sigmoidf_(bfhi(g.w))}; }
                *(LAS f32x4*)(hL + r * 256 + ch * 8) = o0; *(LAS f32x4*)(hL + r * 256 + ch * 8 + 4) = o1; }
            __syncthreads();
#pragma unroll
            for (int chunk = 0; chunk < 2; ++chunk) { const int base = tt0 + chunk * 8; float hv[38];
#pragma unroll
                for (int i = 0; i < 38; ++i) hv[i] = hL[(base + i) * 256 + cch];
#pragma unroll
                for (int tt = 0; tt < 8; ++tt) { float acc = cb;
#pragma unroll
                    for (int j = 0; j < 31; ++j) acc += wj[j] * hv[tt + j];
                    yL[(base + tt) * 256 + cch] = acc; } }
            __syncthreads();
            { float v[16]; float s = 0.f;
#pragma unroll
              for (int i = 0; i < 16; i += 4) { const f32x4 t4 = *(const LAS f32x4*)(yL + ntok * 256 + nc0 + i); v[i] = t4[0]; v[i + 1] = t4[1]; v[i + 2] = t4[2]; v[i + 3] = t4[3]; s += (t4[0] + t4[1]) + (t4[2] + t4[3]); }
              s += lane_xor<1>(s); s += lane_xor<2>(s); const float mean = s * (1.0f / 64); float q = 0.f;
#pragma unroll
              for (int i = 0; i < 16; ++i) { v[i] -= mean; q += v[i] * v[i]; }
              q += lane_xor<1>(q); q += lane_xor<2>(q); const float rstd = 1.0f / sqrtf(q * (1.0f / 64) + EPS);
              const float* gg = A->in[10] + layer * 256 + nc0; const float* gb = A->in[11] + layer * 256 + nc0; float o[16];
#pragma unroll
              for (int i = 0; i < 16; ++i) o[i] = siluf_(v[i] * rstd * gg[i] + gb[i]);
              bf16* dst = MIXED + (size_t)(t0 + ntok) * 1024 + 768 + nc0;
              *(u32x4*)dst = (u32x4){pk2(o[0], o[1]), pk2(o[2], o[3]), pk2(o[4], o[5]), pk2(o[6], o[7])};
              *(u32x4*)(dst + 8) = (u32x4){pk2(o[8], o[9]), pk2(o[10], o[11]), pk2(o[12], o[13]), pk2(o[14], o[15])}; }
        }
        __syncthreads();
    }
    REPS(11) ffn_weights(C, A, layer);
}

__device__ __forceinline__ void p5_rms(Ctx& C) {
    bf16* MIXED = (bf16*)(C.ws + WS_SCR + SC_MIXED);
    for (int m = C.gw; m < M; m += C.NGW) {
        bf16* r = MIXED + (size_t)m * 1024;
        { u32x4* p = (u32x4*)r + C.lane; const u32x4 w = *p; float a[8] = {bflo(w.x), bfhi(w.x), bflo(w.y), bfhi(w.y), bflo(w.z), bfhi(w.z), bflo(w.w), bfhi(w.w)}; float ss = 0.f;
#pragma unroll
          for (int i = 0; i < 8; ++i) ss += a[i] * a[i];
          ss = wave_sum(ss); const float rs = 1.0f / sqrtf(ss * (1.0f / 512) + EPS);
          *p = (u32x4){pk2(a[0] * rs, a[1] * rs), pk2(a[2] * rs, a[3] * rs), pk2(a[4] * rs, a[5] * rs), pk2(a[6] * rs, a[7] * rs)}; }
        { u32x2* p = (u32x2*)(r + 512) + C.lane; const u32x2 w = *p; const float a0 = bflo(w.x), a1 = bfhi(w.x), a2 = bflo(w.y), a3 = bfhi(w.y);
          const float ss = wave_sum((a0 * a0 + a1 * a1) + (a2 * a2 + a3 * a3)); const float rs = 1.0f / sqrtf(ss * (1.0f / 256) + EPS); *p = (u32x2){pk2(a0 * rs, a1 * rs), pk2(a2 * rs, a3 * rs)}; }
    }
}

template <int MODE>
__device__ __forceinline__ void ln_pass(Ctx& C, const bool final, const bf16* add, const float* gam, const float* bet, const float* router_w) {
    bf16* XB = (bf16*)(C.ws + WS_XB); float* out = C.out;
    REPS(14) {
    const bool dry = ((REP_MASK >> 14) & 1) && rep_ == 0; float* jf = (float*)(C.ws + WS_SCR); bf16* jb = (bf16*)(C.ws + WS_SCR + 40 * MiB);
    int* TOPE = (int*)(C.ws + WS_MOE + MT_TOPE); float* TOPG = (float*)(C.ws + WS_MOE + MT_TOPG); const int* TOKSLOT = (const int*)(C.ws + WS_MOE + MT_TOKSLOT);
    LAS float* RW = (LAS float*)C.lds; LAS unsigned* CNT = (LAS unsigned*)(C.lds + 32768);
    if constexpr (MODE == 1) {
        for (int i = C.tid; i < 1024 * 8 / 4; i += NTHR) *(LAS f32x4*)(RW + 4 * i) = *(const f32x4*)(router_w + 4 * i);
        if (C.tid < 8) CNT[C.tid] = 0u;
        __syncthreads();
    }
    f32x4 g4[4], b4[4];
#pragma unroll
    for (int j = 0; j < 4; ++j) { g4[j] = ((const f32x4*)gam)[64 * j + C.lane]; b4[j] = ((const f32x4*)bet)[64 * j + C.lane]; }
    const int RPB = M / C.G, row0 = C.bx * RPB;
    unsigned cnt0 = 0, cnt1 = 0, cnt2 = 0, cnt3 = 0, cnt4 = 0, cnt5 = 0, cnt6 = 0, cnt7 = 0;
#pragma unroll 2
    for (int rr = C.wave; rr < RPB; rr += NWAVES) {
        const int m = row0 + rr;
        f32x4 v[4];
#pragma unroll
        for (int j = 0; j < 4; ++j) { const u32x2 w = ((const u32x2*)(XB + (size_t)m * DM))[64 * j + C.lane]; v[j] = (f32x4){bflo(w.x), bfhi(w.x), bflo(w.y), bfhi(w.y)} * ALPHA; }
        if constexpr (MODE == 2) {
            const int s0 = TOKSLOT[2 * m], s1 = TOKSLOT[2 * m + 1];
#pragma unroll
            for (int j = 0; j < 4; ++j) { const u32x2 w0 = ((const u32x2*)(add + (size_t)s0 * DM))[64 * j + C.lane], w1 = ((const u32x2*)(add + (size_t)s1 * DM))[64 * j + C.lane];
                v[j] += (f32x4){bflo(w0.x) + bflo(w1.x), bfhi(w0.x) + bfhi(w1.x), bflo(w0.y) + bflo(w1.y), bfhi(w0.y) + bfhi(w1.y)}; }
        } else {
#pragma unroll
            for (int j = 0; j < 4; ++j) { const u32x2 w0 = ((const u32x2*)(add + (size_t)m * DM))[64 * j + C.lane]; v[j] += (f32x4){bflo(w0.x), bfhi(w0.x), bflo(w0.y), bfhi(w0.y)}; }
        }
        float s = 0.f;
#pragma unroll
        for (int j = 0; j < 4; ++j) s += (v[j][0] + v[j][1]) + (v[j][2] + v[j][3]);
        const float mean = wave_sum(s) * (1.0f / DM); float q = 0.f;
#pragma unroll
        for (int j = 0; j < 4; ++j) { v[j] = v[j] - mean; q += (v[j][0] * v[j][0] + v[j][1] * v[j][1]) + (v[j][2] * v[j][2] + v[j][3] * v[j][3]); }
        const float rstd = 1.0f / sqrtf(wave_sum(q) * (1.0f / DM) + EPS);
#pragma unroll
        for (int j = 0; j < 4; ++j) { v[j] = v[j] * rstd * g4[j] + b4[j]; if (final) ((f32x4*)((dry ? jf + (size_t)(m & 8191) * DM : out + (size_t)m * DM)))[64 * j + C.lane] = v[j];
            ((u32x2*)((dry ? jb + (size_t)(m & 8191) * DM : XB + (size_t)m * DM)))[64 * j + C.lane] = (u32x2){pk2(v[j][0], v[j][1]), pk2(v[j][2], v[j][3])}; }
        if constexpr (MODE == 1) {
            float lg[8] = {0.f, 0.f, 0.f, 0.f, 0.f, 0.f, 0.f, 0.f};
#pragma unroll
            for (int j = 0; j < 4; ++j)
#pragma unroll
                for (int i = 0; i < 4; ++i) { const int col = 256 * j + 4 * C.lane + i; const f32x4 w0 = *(const LAS f32x4*)(RW + col * 8), w1 = *(const LAS f32x4*)(RW + col * 8 + 4); const float xv = v[j][i];
                    lg[0] += xv * w0[0]; lg[1] += xv * w0[1]; lg[2] += xv * w0[2]; lg[3] += xv * w0[3]; lg[4] += xv * w1[0]; lg[5] += xv * w1[1]; lg[6] += xv * w1[2]; lg[7] += xv * w1[3]; }
#pragma unroll
            for (int e = 0; e < 8; ++e) lg[e] = wave_sum(lg[e]);
            int e1 = 0; float v1 = lg[0];
#pragma unroll
            for (int e = 1; e < 8; ++e) if (lg[e] > v1) { v1 = lg[e]; e1 = e; }
            int e2 = -1; float v2 = -INFINITY;
#pragma unroll
            for (int e = 0; e < 8; ++e) if (e != e1 && lg[e] > v2) { v2 = lg[e]; e2 = e; }
            const float ex = fexp2((v2 - v1) * LOG2E), gA = 1.0f / (1.0f + ex), gB = ex * gA;
            if (C.lane == 0) { TOPE[2 * m] = e1; TOPE[2 * m + 1] = e2; TOPG[2 * m] = gA; TOPG[2 * m + 1] = gB; }
            cnt0 += (e1 == 0) + (e2 == 0); cnt1 += (e1 == 1) + (e2 == 1); cnt2 += (e1 == 2) + (e2 == 2); cnt3 += (e1 == 3) + (e2 == 3);
            cnt4 += (e1 == 4) + (e2 == 4); cnt5 += (e1 == 5) + (e2 == 5); cnt6 += (e1 == 6) + (e2 == 6); cnt7 += (e1 == 7) + (e2 == 7);
        }
    }
    if constexpr (MODE == 1) {
        if (C.lane == 0) { atomicAdd((unsigned*)&CNT[0], cnt0); atomicAdd((unsigned*)&CNT[1], cnt1); atomicAdd((unsigned*)&CNT[2], cnt2); atomicAdd((unsigned*)&CNT[3], cnt3);
                           atomicAdd((unsigned*)&CNT[4], cnt4); atomicAdd((unsigned*)&CNT[5], cnt5); atomicAdd((unsigned*)&CNT[6], cnt6); atomicAdd((unsigned*)&CNT[7], cnt7); }
        __syncthreads();
        if (C.tid < 8) C.ctl[CW_CNTB + C.bx * 8 + C.tid] = CNT[C.tid];
        __syncthreads();
    }
    }
}

__device__ __forceinline__ void moe_assign(Ctx& C) {
    if (C.wave != 0) return;
    const int* TOPE = (const int*)(C.ws + WS_MOE + MT_TOPE); const float* TOPG = (const float*)(C.ws + WS_MOE + MT_TOPG);
    int* TOKSLOT = (int*)(C.ws + WS_MOE + MT_TOKSLOT); int* SLOTTOK = (int*)(C.ws + WS_MOE + MT_SLOTTOK); float* SLOTGATE = (float*)(C.ws + WS_MOE + MT_SLOTGATE);
    const int blk = C.bx, RPB = M / C.G, row0 = blk * RPB;
    int tot[8], pre[8];
#pragma unroll
    for (int e = 0; e < 8; ++e) { int t = 0, p = 0; for (int bb = C.lane; bb < C.G; bb += 64) { const int c = (int)C.ctl[CW_CNTB + bb * 8 + e]; t += c; if (bb < blk) p += c; }
        tot[e] = wave_sum_i(t); pre[e] = wave_sum_i(p); }
    int seg[9]; seg[0] = 0;
#pragma unroll
    for (int e = 0; e < 8; ++e) seg[e + 1] = seg[e] + ((tot[e] + 255) & ~255);
    int run[8];
#pragma unroll
    for (int e = 0; e < 8; ++e) run[e] = seg[e] + pre[e];
    const unsigned long long ltmask = (1ull << C.lane) - 1ull;
    for (int base = 0; base < RPB * 2; base += 64) {
        const int idx = base + C.lane, token = row0 + (idx >> 1), choice = idx & 1;
        const int ex = TOPE[2 * token + choice]; const float gate = TOPG[2 * token + choice]; int slot = 0;
#pragma unroll
        for (int e = 0; e < 8; ++e) { const unsigned long long mk = __builtin_amdgcn_ballot_w64(ex == e); if (ex == e) slot = run[e] + __popcll(mk & ltmask); run[e] += __popcll(mk); }
        SLOTTOK[slot] = token; SLOTGATE[slot] = gate; TOKSLOT[2 * token + choice] = slot;
    }
    if (blk < 8) {
        int lo = 0, hi = 0;
#pragma unroll
        for (int e = 0; e < 8; ++e) if (e == blk) { lo = seg[e] + tot[e]; hi = seg[e + 1]; }
        for (int s = lo + C.lane; s < hi; s += 64) { SLOTTOK[s] = 0; SLOTGATE[s] = 0.f; }
    }
    if (blk == 0 && C.lane == 0) {
#pragma unroll
        for (int e = 0; e < 9; ++e) C.ctl[CW_SEG + e] = (unsigned)seg[e];
    }
}

#ifndef MK_PER_PHASE
#define MK_PER_PHASE 0
#endif
#ifndef PH_ENABLE
#define PH_ENABLE 0xFFFF
#endif
constexpr int PH_PER_LAYER = 12, N_PHASES = 1 + DEPTH * PH_PER_LAYER;

__global__ void __launch_bounds__(NTHR, 2) fwd_kernel(Args args) {
    extern __shared__ __attribute__((aligned(16))) unsigned char lds_raw[];
    LAS unsigned char* const lds = (LAS unsigned char*)lds_raw;
    volatile LAS unsigned* MISC = (volatile LAS unsigned*)(lds + MISC_OFF);
    for (int u = threadIdx.x; u < (LDS_BYTES - LDSCTL_OFF) / 4; u += NTHR) ((LAS unsigned*)(lds + LDSCTL_OFF))[u] = 0u;
    __syncthreads();
    const int wave0 = __builtin_amdgcn_readfirstlane((int)threadIdx.x >> 6);
    XcdBarrier bar; bar.bar = (unsigned*)(args.ws + WS_CTL) + CW_BAR; bar.x = 0; bar.st = nullptr;
    if (!MK_PER_PHASE) bar = xcd_barrier_post((unsigned*)(args.ws + WS_CTL) + CW_BAR, MISC + 8, wave0);
    const int lo = args.ph_lo, hi = args.ph_hi;
#define IN(k) (lo <= (k) && (k) < hi)
#define EN(p) ((PH_ENABLE >> (p)) & 1)
#define SEAM(k) do { if (IN((k) + 1)) { if (!MK_PER_PHASE) { xcd_barrier<false>(bar, wave0); if ((REP_MASK >> 13) & 1) xcd_barrier<false>(bar, wave0); } } } while (0)
#define SEAM0(k) do { if (IN((k) + 1)) { if (!MK_PER_PHASE) xcd_barrier<true>(bar, wave0); } } while (0)
#define PHASE_CTX kargs_t A = opaque_args(); Ctx C = make_ctx(A, lds, wave0); unsigned char* sc = C.ws + WS_SCR; (void)sc

    if (EN(15) && IN(0)) { PHASE_CTX; p0_prologue(C, A); }
    SEAM0(0);

    for (int layer = 0; layer < DEPTH; ++layer) {
        const int P = 1 + layer * PH_PER_LAYER;
#ifdef FORCE_MOE
        const bool moe = FORCE_MOE != 0;
#else
        const bool moe = (layer & 1) != 0;
#endif
        if (EN(0) && IN(P + 0)) {
            PHASE_CTX;
            pg8::DenseOrder S{(const bf16*)(C.ws + WS_XB), (const bf16*)(C.ws + WS_WIN) + (size_t)layer * NP1 * DM, DM, DM, M / 256, NP1 / 256, C.G, C.bx, REPN(0)};
            EpiInProj E{(bf16*)(sc + SC_CQKV), (bf16*)(sc + SC_CQKV) + (size_t)M * 256, (float*)(sc + SC_KR), (float*)(sc + SC_FL), (bf16*)(sc + SC_FQ), (bf16*)(sc + SC_CI)};
            pg8::gemm_phase<EpiInProj, pg8::DenseOrder, false, DM, DM, DM>(C.lds, C.tid, S, E);
            SEAM(P + 0);
        }
        if (EN(1) && IN(P + 1)) { PHASE_CTX; p2_thin(C, A, layer); SEAM(P + 1); }
        if (EN(2) && IN(P + 2)) {
            PHASE_CTX;
            struct QkvOrder { const bf16* A; const bf16* Bt; int G, c, rep;
                __device__ __forceinline__ bool next(int i, pg8::Unit& u) const { return pg8::tile_order_rep(i, G, c, M / 256, 7, rep, u.pm, u.pn); }
                __device__ __forceinline__ const char* a_base(const pg8::Unit& u) const { return (const char*)(A + (u.pn < 3 ? (size_t)0 : (size_t)M * 256)) + (size_t)u.pm * 256 * 256 * 2; }
                __device__ __forceinline__ const char* b_base(const pg8::Unit& u) const { return (const char*)Bt + (size_t)u.pn * 256 * 256 * 2; }
                __device__ __forceinline__ int tok(const pg8::Unit&, int) const { return 0; } };
            QkvOrder S{(const bf16*)(sc + SC_CQKV), (const bf16*)(C.ws + WS_WQ2) + (size_t)layer * NP1 * 256, C.G, C.bx, REPN(2)};
            EpiQKV E{(bf16*)(sc + SC_QM), (bf16*)(sc + SC_KM), (bf16*)(sc + SC_VM), (const float*)(C.ws + WS_TAB), (const float*)(C.ws + WS_TAB) + (size_t)M * 16};
            pg8::gemm_phase<EpiQKV, QkvOrder, false, 256, 256, 256>(C.lds, C.tid, S, E);
            SEAM(P + 2);
        }
        if (EN(3) && IN(P + 3)) {
            PHASE_CTX;
            bf16* MIXED = (bf16*)(sc + SC_MIXED);
            REPS(3) for (int p = C.vcu; p < 768; p += C.G) {
                if (p < 512) { const int bh = p >> 3, s = p & 7;
                    for (int i = 0; i < 2; ++i) att::attn_unit<96, false>(bh >> 3, bh & 7, i == 0 ? 15 - s : s, (const bf16*)(sc + SC_QM), 768, (const bf16*)(sc + SC_KM), 768, (const bf16*)(sc + SC_VM), 512, MIXED, 1024, (bh & 7) * 64, nullptr, C.lds, C.tid);
                } else { const int f = p - 512, bh = f >> 3, s = f & 7; const bf16* FQ = (const bf16*)(sc + SC_FQ);
                    for (int i = 0; i < 2; ++i) att::attn_unit<64, true>(bh >> 2, bh & 3, i == 0 ? 15 - s : s, FQ, 256, FQ + (size_t)M * 256, 256, FQ + (size_t)2 * M * 256, 256, MIXED, 1024, 512 + (bh & 3) * 64, (const float*)(sc + SC_CUM), C.lds, C.tid);
                }
            }
            SEAM(P + 3);
        }
        if (EN(4) && IN(P + 4)) { PHASE_CTX; p5_rms(C); SEAM(P + 4); }
        if (EN(5) && IN(P + 5)) {
            PHASE_CTX;
            pg8::DenseOrder S{(const bf16*)(sc + SC_MIXED), (const bf16*)(C.ws + WS_WOUT) + (size_t)layer * DM * DM, DM, DM, M / 256, DM / 256, C.G, C.bx, REPN(5)};
            EpiBf16<DM, false> E{(bf16*)(sc + SC_MIXOUT), DM / 256, nullptr};
            pg8::gemm_phase<EpiBf16<DM, false>, pg8::DenseOrder, false, DM, DM, DM>(C.lds, C.tid, S, E);
            SEAM(P + 5);
        }
        if (EN(6) && IN(P + 6)) {
            if (moe) { PHASE_CTX; ln_pass<1>(C, false, (const bf16*)(sc + SC_MIXOUT), A->in[15] + layer * DM, A->in[16] + layer * DM, A->in[20] + (size_t)(layer >> 1) * DM * NEXP); }
            else     { PHASE_CTX; ln_pass<0>(C, false, (const bf16*)(sc + SC_MIXOUT), A->in[15] + layer * DM, A->in[16] + layer * DM, nullptr); }
            SEAM(P + 6);
        }
        if (EN(7) && IN(P + 7)) { if (moe) { PHASE_CTX; moe_assign(C); } SEAM(P + 7); }
        if (EN(8) && IN(P + 8)) {
            if (moe) {
                PHASE_CTX; bf16* W13 = (bf16*)(C.ws + WS_WFFN); bf16* HID = (bf16*)(sc + SC_HID);
                const int* seg = (const int*)(C.ctl + CW_SEG);
                MoeOrder S{(const bf16*)(C.ws + WS_XB), W13, DM, DM, seg[8] / 256, 11, C.G, C.bx, REPN(8), (const int*)(C.ws + WS_MOE + MT_SLOTTOK), seg[1], seg[2], seg[3], seg[4], seg[5], seg[6], seg[7]};
                EpiSwiGLU<DFE> E{HID, 11};
                pg8::gemm_phase<EpiSwiGLU<DFE>, MoeOrder, true, DM, DM, DM>(C.lds, C.tid, S, E);
            } else {
                PHASE_CTX; bf16* W13 = (bf16*)(C.ws + WS_WFFN); bf16* HID = (bf16*)(sc + SC_HID);
                pg8::DenseOrder S{(const bf16*)(C.ws + WS_XB), W13, DM, DM, M / 256, 2 * DFF / 256, C.G, C.bx, REPN(8)};
                EpiSwiGLU<DFF> E{HID, 1 << 30};
                pg8::gemm_phase<EpiSwiGLU<DFF>, pg8::DenseOrder, false, DM, DM, DM>(C.lds, C.tid, S, E);
            }
            SEAM(P + 8);
        }
        if (EN(9) && IN(P + 9)) {
            if (moe) {
                PHASE_CTX; bf16* W2T = (bf16*)(C.ws + WS_WFFN) + WF_W13_ELEMS; bf16* HID = (bf16*)(sc + SC_HID); bf16* FF = (bf16*)(sc + SC_FF);
                const int* seg = (const int*)(C.ctl + CW_SEG);
                MoeOrder S{HID, W2T, DFE, DFE, seg[8] / 256, 4, C.G, C.bx, REPN(9), nullptr, seg[1], seg[2], seg[3], seg[4], seg[5], seg[6], seg[7]};
                EpiBf16<DM, true> E{FF, 4, (const float*)(C.ws + WS_MOE + MT_SLOTGATE)};
                pg8::gemm_phase<EpiBf16<DM, true>, MoeOrder, false, DFE, DFE, DFE>(C.lds, C.tid, S, E);
            } else {
                PHASE_CTX; bf16* W2T = (bf16*)(C.ws + WS_WFFN) + WF_W13_ELEMS; bf16* HID = (bf16*)(sc + SC_HID); bf16* FF = (bf16*)(sc + SC_FF);
                pg8::DenseOrder S{HID, W2T, DFF, DFF, M / 256, DM / 256, C.G, C.bx, REPN(9)};
                EpiBf16<DM, false> E{FF, DM / 256, nullptr};
                pg8::gemm_phase<EpiBf16<DM, false>, pg8::DenseOrder, false, DFF, DFF, DFF>(C.lds, C.tid, S, E);
            }
            SEAM(P + 9);
        }
        if (EN(10) && IN(P + 10)) {
            if (moe) { PHASE_CTX; ln_pass<2>(C, layer == DEPTH - 1, (const bf16*)(sc + SC_FF), A->in[24] + layer * DM, A->in[25] + layer * DM, nullptr); }
            else     { PHASE_CTX; ln_pass<0>(C, layer == DEPTH - 1, (const bf16*)(sc + SC_FF), A->in[24] + layer * DM, A->in[25] + layer * DM, nullptr); }
            SEAM(P + 10);
        }
        if (IN(P + 11)) { SEAM(P + 11); }
    }
#undef IN
#undef SEAM
}

extern "C" void kernel_launch(void* const* d_in, const int* in_sizes, int n_in, void* d_out, int out_size, void* d_ws, size_t ws_size, hipStream_t stream) {
    static int grid = 0;
    if (grid == 0) {
        if (n_in != 26 || out_size != M * DM || ws_size < WS_END) { fprintf(stderr, "kernel_launch: unexpected problem (n_in %d, out %d, ws %zu < %zu)\n", n_in, out_size, ws_size, (size_t)WS_END); grid = -1; return; }
        int dev = 0, cus = 0, per_cu = 0;
        if (hipGetDevice(&dev) != hipSuccess || hipDeviceGetAttribute(&cus, hipDeviceAttributeMultiprocessorCount, dev) != hipSuccess) { grid = -1; return; }
        if (hipFuncSetAttribute((const void*)fwd_kernel, hipFuncAttributeMaxDynamicSharedMemorySize, LDS_BYTES) != hipSuccess) { fprintf(stderr, "kernel_launch: hipFuncSetAttribute failed\n"); grid = -1; return; }
        if (hipOccupancyMaxActiveBlocksPerMultiprocessor(&per_cu, (const void*)fwd_kernel, NTHR, LDS_BYTES) != hipSuccess || per_cu < 1) fprintf(stderr, "kernel_launch: occupancy query says %d\n", per_cu);
        (void)hipGetLastError();
        grid = 256; while (grid > cus && grid > 8) grid >>= 1;
    }
    if (grid < 0) return;
    (void)hipMemsetAsync((char*)d_ws + WS_CTL, 0, CTL_ZERO_BYTES, stream);
    Args a{};
    for (int i = 0; i < 26; ++i) a.in[i] = (const float*)d_in[i];
    a.out = (float*)d_out; a.ws = (unsigned char*)d_ws;
#if MK_PER_PHASE
    for (int p = 0; p < N_PHASES; ++p) { a.ph_lo = p; a.ph_hi = p + 1; hipLaunchKernelGGL(fwd_kernel, dim3(grid), dim3(NTHR), LDS_BYTES, stream, a); }
#else
    a.ph_lo = 0; a.ph_hi = N_PHASES;
    hipLaunchKernelGGL(fwd_kernel, dim3(grid), dim3(NTHR), LDS_BYTES, stream, a);
#endif
}
```

```cpp
#include <hip/hip_runtime.h>
#include <cstdio>
#include <cstdint>
#include <cmath>

#ifndef REP_MASK
#define REP_MASK 0x0
#endif
#define REPN(p) (1 + ((REP_MASK >> (p)) & 1))
#define REPS(p) for (int rep_ = 0; rep_ < 1 + ((REP_MASK >> (p)) & 1); ++rep_)
#define GAS __attribute__((address_space(1)))
#define LAS __attribute__((address_space(3)))
typedef unsigned short bf16;
typedef short bf16x8 __attribute__((ext_vector_type(8)));
typedef short s16x4 __attribute__((ext_vector_type(4)));
typedef float f32x2 __attribute__((ext_vector_type(2)));
typedef float f32x4 __attribute__((ext_vector_type(4)));
typedef float f32x16 __attribute__((ext_vector_type(16)));
typedef unsigned u32x2 __attribute__((ext_vector_type(2)));
typedef unsigned u32x4 __attribute__((ext_vector_type(4)));
typedef __bf16 bf16x2_t __attribute__((ext_vector_type(2)));

constexpr int BATCH = 8, SEQ = 4096, DM = 1024, M = BATCH * SEQ, DEPTH = 4;
constexpr int IN_COLS = 1700, NP1 = 1792;
constexpr int DFF = 2816, DFE = 1408, NEXP = 8;
constexpr int NWAVES = 8, NTHR = 512;
constexpr float ALPHA = 1.6817928305074290f;
constexpr float EPS = 1e-5f;
constexpr float LOG2E = 1.4426950408889634f;
constexpr float C2_MLA = 0.10206207261596577f * LOG2E;
constexpr float C2_FOX = 0.125f * LOG2E;
constexpr int PC_CQ = 0, PC_CKV = 256, PC_KR = 384, PC_FL = 416, PC_FQ = 512, PC_FK = 768, PC_FV = 1024, PC_CI = 1280;
constexpr int MOE_ROWS_MAX = 2 * M + NEXP * 256;

constexpr size_t MiB = 1u << 20;
constexpr size_t WS_CTL = 0, CTL_ZERO_BYTES = 1 * MiB;
constexpr size_t WS_WIN = 1 * MiB;
constexpr size_t WS_WQ2 = WS_WIN + 14 * MiB;
constexpr size_t WS_WOUT = WS_WQ2 + 4 * MiB;
constexpr size_t WS_TAB = WS_WOUT + 8 * MiB;
constexpr size_t WS_MOE = WS_TAB + 4 * MiB;
constexpr size_t WS_WFFN = WS_MOE + 2 * MiB;
constexpr size_t WS_XB = WS_WFFN + 68 * MiB;
constexpr size_t WS_SCR = WS_XB + 64 * MiB;
constexpr size_t SC_CQKV = 0;
constexpr size_t SC_KR = SC_CQKV + 32 * MiB;
constexpr size_t SC_FL = SC_KR + 4 * MiB;
constexpr size_t SC_CUM = SC_FL + MiB / 2;
constexpr size_t SC_FQ = SC_CUM + MiB / 2;
constexpr size_t SC_CI = SC_FQ + 48 * MiB;
constexpr size_t SC_QM = SC_CI + 32 * MiB;
constexpr size_t SC_KM = SC_QM + 48 * MiB;
constexpr size_t SC_VM = SC_KM + 48 * MiB;
constexpr size_t SC_MIXED = SC_VM + 32 * MiB;
constexpr size_t SC_MIXOUT = SC_QM;
constexpr size_t SC_MIX_END = SC_MIXED + 64 * MiB;
constexpr size_t SC_HID = 0;
constexpr size_t SC_FF = 182 * MiB;
constexpr size_t SC_END = 316 * MiB;
constexpr size_t WS_END = WS_SCR + SC_END;
static_assert(SC_MIX_END <= SC_END && SC_FF + (size_t)MOE_ROWS_MAX * 1024 * 2 <= SC_END && (size_t)MOE_ROWS_MAX * DFE * 2 <= SC_FF, "scratch map");
static_assert(WS_END <= 512 * MiB, "workspace map");
constexpr size_t WF_W13_ELEMS = (size_t)NEXP * 2 * DFE * DM;
constexpr size_t MT_TOPE = 0;
constexpr size_t MT_TOPG = 256 * 1024;
constexpr size_t MT_TOKSLOT = 512 * 1024;
constexpr size_t MT_SLOTTOK = 768 * 1024;
constexpr size_t MT_SLOTGATE = 768 * 1024 + 272 * 1024;
static_assert((size_t)MOE_ROWS_MAX * 4 <= 272 * 1024 && MT_SLOTGATE + 272 * 1024 <= 2 * MiB, "moe tables");
constexpr int CW_BAR = 4096;
constexpr int CW_CNTB = 16384;
constexpr int CW_SEG = 20480;

constexpr int RING_BYTES = 131072;
constexpr int LDSCTL_OFF = RING_BYTES, MISC_OFF = LDSCTL_OFF + 320;
constexpr int LDS_BYTES = 147456;

#define RLX_AGENT __ATOMIC_RELAXED, __HIP_MEMORY_SCOPE_AGENT
__device__ __forceinline__ unsigned pk2(float lo, float hi) { f32x2 v = {lo, hi}; bf16x2_t b = __builtin_convertvector(v, bf16x2_t); return __builtin_bit_cast(unsigned, b); }
__device__ __forceinline__ float bf2f(unsigned short u) { return __uint_as_float((unsigned)u << 16); }
__device__ __forceinline__ float bflo(unsigned u) { return __uint_as_float(u << 16); }
__device__ __forceinline__ float bfhi(unsigned u) { return __uint_as_float(u & 0xffff0000u); }
__device__ __forceinline__ float fexp2(float x) { return __builtin_amdgcn_exp2f(x); }
__device__ __forceinline__ float frcp(float x) { return __builtin_amdgcn_rcpf(x); }
__device__ __forceinline__ float sigmoidf_(float x) { return frcp(1.0f + fexp2(-x * LOG2E)); }
__device__ __forceinline__ float siluf_(float x) { return x * sigmoidf_(x); }
template <int O> __device__ __forceinline__ float lane_xor(float v) {
    if constexpr (O < 32) return __int_as_float(__builtin_amdgcn_ds_swizzle(__float_as_int(v), (O << 10) | 0x1f));
    else { auto rr = __builtin_amdgcn_permlane32_swap(__float_as_uint(v), __float_as_uint(v), false, false); return __uint_as_float(rr[0]) == v ? __uint_as_float(rr[1]) : __uint_as_float(rr[0]); }
}
__device__ __forceinline__ float wave_sum(float v) {
    v += lane_xor<1>(v); v += lane_xor<2>(v); v += lane_xor<4>(v); v += lane_xor<8>(v); v += lane_xor<16>(v);
    { auto rr = __builtin_amdgcn_permlane32_swap(__float_as_uint(v), __float_as_uint(v), false, false); v = __uint_as_float(rr[0]) + __uint_as_float(rr[1]); }
    return v;
}
__device__ __forceinline__ int wave_sum_i(int v) {
    v += __builtin_amdgcn_ds_swizzle(v, (1 << 10) | 0x1f); v += __builtin_amdgcn_ds_swizzle(v, (2 << 10) | 0x1f); v += __builtin_amdgcn_ds_swizzle(v, (4 << 10) | 0x1f);
    v += __builtin_amdgcn_ds_swizzle(v, (8 << 10) | 0x1f); v += __builtin_amdgcn_ds_swizzle(v, (16 << 10) | 0x1f);
    { auto rr = __builtin_amdgcn_permlane32_swap((unsigned)v, (unsigned)v, false, false); v = (int)(rr[0] + rr[1]); }
    return v;
}
__device__ __forceinline__ u32x4 pack8(const f32x4 a, const f32x4 b) { u32x4 w; w.x = pk2(a[0], a[1]); w.y = pk2(a[2], a[3]); w.z = pk2(b[0], b[1]); w.w = pk2(b[2], b[3]); return w; }

#define XB_TMO      128
#define XB_XCNT(j)  (256  + 64 * (j))
#define XB_XSUB(j)  (1280 + 64 * (j))
#define XB_XGEN(j)  (2304 + 64 * (j))
#define XB_TOP      3328
#define XB_TOPGEN   3392
#define XCD_BAR_WORDS 3456
#define XB_SPIN_CAP (1u << 18)
__device__ __forceinline__ unsigned xb_ld(unsigned* p)              { return __hip_atomic_load(p, __ATOMIC_RELAXED, __HIP_MEMORY_SCOPE_AGENT); }
__device__ __forceinline__ unsigned xb_add(unsigned* p, unsigned v) { return __hip_atomic_fetch_add(p, v, __ATOMIC_RELAXED, __HIP_MEMORY_SCOPE_AGENT); }
__device__ __forceinline__ unsigned xb_xcc_id() { return (unsigned)__builtin_amdgcn_s_getreg((3 << 11) | 20) & 0xFu; }
#define XB_SPIN(cond, bar) do { unsigned _sp = 0; while (cond) { __builtin_amdgcn_s_sleep(1); \
    if ((++_sp & 255u) == 0u) { if (xb_ld(&(bar)[XB_TMO])) break; if (_sp > XB_SPIN_CAP) { atomicAdd(&(bar)[XB_TMO], 1u); break; } } } } while (0)
struct XcdBarrier { unsigned* bar; unsigned x; volatile LAS unsigned* st; };
__device__ __forceinline__ bool xb_is_t0(int wave0) { unsigned ones = ~0u; asm volatile("" : "+s"(ones)); return wave0 == 0 && __builtin_amdgcn_mbcnt_hi(ones, __builtin_amdgcn_mbcnt_lo(ones, 0u)) == 0u; }
__device__ __forceinline__ XcdBarrier xcd_barrier_post(unsigned* bar, volatile LAS unsigned* st, int wave0) {
    XcdBarrier b; b.bar = bar; b.x = xb_xcc_id(); b.st = st;
    if (xb_is_t0(wave0)) (void)xb_add(&bar[XB_XCNT(b.x)], 1u);
    return b;
}
__device__ __forceinline__ void xcd_barrier_complete(unsigned* bar, unsigned x, unsigned& nloc, unsigned& nx) {
    const unsigned G = gridDim.x * gridDim.y * gridDim.z;
    unsigned sum, cnt, mine, sp = 0u;
    for (;;) {
        sum = 0u; cnt = 0u; mine = 0u;
#pragma unroll
        for (unsigned j = 0; j < 16; ++j) { const unsigned c = xb_ld(&bar[XB_XCNT(j)]); sum += c; cnt += (c > 0u) ? 1u : 0u; mine = (j == x) ? c : mine; }
        if (sum == G) break;
        __builtin_amdgcn_s_sleep(1);
        if ((++sp & 255u) == 0u) { if (xb_ld(&bar[XB_TMO])) break; if (sp > XB_SPIN_CAP) { atomicAdd(&bar[XB_TMO], 1u); break; } }
    }
    nloc = mine > 0u ? mine : 1u; nx = cnt > 0u ? cnt : 1u;
}
template <bool FIRST>
__device__ __forceinline__ void xcd_barrier(const XcdBarrier& b, int wave0) {
    asm volatile("s_waitcnt vmcnt(0)" ::: "memory");
    __syncthreads();
    if (xb_is_t0(wave0)) {
        unsigned* bar = b.bar;
        __builtin_amdgcn_s_waitcnt(0);
        unsigned nloc = b.st[0], nx = b.st[1];
        if constexpr (FIRST) { if (nloc == 0u) { xcd_barrier_complete(bar, b.x, nloc, nx); b.st[0] = nloc; b.st[1] = nx; } }
        const unsigned old = xb_add(&bar[XB_XSUB(b.x)], 1u);
        const unsigned gen = old / nloc;
        if (old + 1u == (gen + 1u) * nloc) {
            __builtin_amdgcn_fence(__ATOMIC_RELEASE, "agent");
            asm volatile("s_waitcnt vmcnt(0)" ::: "memory");
            const unsigned og = xb_add(&bar[XB_TOP], 1u);
            const unsigned tg = og / nx;
            if (og + 1u == (tg + 1u) * nx) xb_add(&bar[XB_TOPGEN], 1u);
            else XB_SPIN(xb_ld(&bar[XB_TOPGEN]) == tg, bar);
            __builtin_amdgcn_fence(__ATOMIC_ACQUIRE, "agent");
            xb_add(&bar[XB_XGEN(b.x)], 1u);
            asm volatile("s_waitcnt vmcnt(0)" ::: "memory");
        } else {
            XB_SPIN(xb_ld(&bar[XB_XGEN(b.x)]) == gen, bar);
            __builtin_amdgcn_fence(__ATOMIC_ACQUIRE, "agent");
            asm volatile("s_waitcnt vmcnt(0)" ::: "memory");
        }
    }
    __syncthreads();
}

namespace pg8 {
constexpr int BM = 256, BK = 64, HALF = 128, HTB = HALF * BK * 2, STAGE_BYTES = 8 * HTB, NXCD = 8, WGM = 8;
__host__ __device__ __forceinline__ int lds_byte(int r, int c) { const int st = (r >> 4) * 2 + (c >> 5), rr = r & 15, cc = c & 31, ob = rr * 64 + cc * 2; return st * 1024 + (ob ^ (((ob >> 9) & 1) << 5)); }
__host__ __device__ __forceinline__ void stage_rc(int b, int& R, int& C) { const int st = b / 1024, sb = b % 1024, swz = sb ^ (((sb >> 9) & 1) << 5); R = (st >> 1) * 16 + swz / 64; C = (st & 1) * 32 + (swz % 64) / 2; }
__host__ __device__ __forceinline__ int perm32(int rho) { const int n = rho >> 4, i = rho & 15; return 8 * (i >> 2) + 4 * n + (i & 3); }
struct Unit { int pm, pn; };

__device__ __forceinline__ bool tile_order(long L, int nM, int nN, int& pm, int& pn) {
    const int nwg = nM * nN; if (L >= nwg) return false;
    int wgid = (int)L; { const int q = nwg / NXCD, r = nwg % NXCD, xcd = wgid % NXCD, off = wgid / NXCD; wgid = (xcd < r ? xcd * (q + 1) : r * (q + 1) + (xcd - r) * q) + off; }
    const int nig = WGM * nN, gid = wgid / nig, fm = gid * WGM, gsz = (nM - fm) < WGM ? (nM - fm) : WGM;
    pm = fm + ((wgid % nig) % gsz); pn = (wgid % nig) / gsz; return true;
}
__device__ __forceinline__ bool tile_order_rep(int i, int G, int c, int nM, int nN, int rep, int& pm, int& pn) {
    if (rep == 1) return tile_order((long)i * G + c, nM, nN, pm, pn);
    const int nwg = nM * nN, per = c < nwg ? (nwg - c + G - 1) / G : 0; if (i >= per * rep) return false;
    return tile_order((long)(i % per) * G + c, nM, nN, pm, pn);
}
struct DenseOrder {
    const bf16* A; const bf16* Bt; int lda, ldb, nM, nN, G, c, rep;
    __device__ __forceinline__ bool next(int i, Unit& u) const { return tile_order_rep(i, G, c, nM, nN, rep, u.pm, u.pn); }
    __device__ __forceinline__ const char* a_base(const Unit& u) const { return (const char*)A + (size_t)u.pm * BM * lda * 2; }
    __device__ __forceinline__ const char* b_base(const Unit& u) const { return (const char*)Bt + (size_t)u.pn * BM * ldb * 2; }
    __device__ __forceinline__ int tok(const Unit&, int) const { return 0; }
};

template <class Epi, class Sched, bool GATHER, int K, int lda, int ldb>
__device__ __forceinline__ void gemm_phase(LAS unsigned char* lds, const int tid, const Sched& S, const Epi& E) {
    const int wid = __builtin_amdgcn_readfirstlane(tid >> 6), lane = tid & 63, wr = wid >> 2, wc = wid & 3, fr = lane & 15, fq = lane >> 4;
    constexpr int nt = K / BK;
    unsigned voffA[2], voffB[2];
#pragma unroll
    for (int i = 0; i < 2; ++i) { int R, C; stage_rc(tid * 16 + i * 8192, R, C); const int Rb = Epi::PERM ? ((R & ~31) + perm32(R & 31)) : R;
        voffA[i] = (unsigned)(R * lda + C) * 2u; voffB[i] = (unsigned)(Rb * ldb + C) * 2u; }
#define PG8_GOFF(u_, h_, o0_, o1_) do { unsigned ones_ = ~0u; asm volatile("" : "+s"(ones_)); const int t_ = wid * 64 + (int)__builtin_amdgcn_mbcnt_hi(ones_, __builtin_amdgcn_mbcnt_lo(ones_, 0u)); \
        int R0_, C0_, R1_, C1_; stage_rc(t_ * 16, R0_, C0_); stage_rc(t_ * 16 + 8192, R1_, C1_); \
        o0_ = (unsigned)S.tok(u_, (h_) * HALF + R0_) * (unsigned)(lda * 2) + (unsigned)(C0_ * 2); o1_ = (unsigned)S.tok(u_, (h_) * HALF + R1_) * (unsigned)(lda * 2) + (unsigned)(C1_ * 2); } while (0)
    const size_t kstep = (size_t)(BK * 2);
    constexpr size_t hstepA = (size_t)HALF * lda * 2, hstepB = (size_t)HALF * ldb * 2;
    const unsigned ldsw = (unsigned)wid * 1024u;
    const int aoff = lds_byte(wr * 64 + fr, fq * 8), boff = lds_byte(wc * 32 + fr, fq * 8);
#define PG8_SA(b, h) (((b) * 2 + (h)) * HTB)
#define PG8_SB(b, h) ((4 + (b) * 2 + (h)) * HTB)
#define PG8_STAGE(bufoff, gbase, v0, v1) do { \
        __builtin_amdgcn_global_load_lds((const unsigned*)((const char*)(gbase) + (v0)), (LAS unsigned*)(lds + (bufoff) + ldsw), 16, 0, 0); \
        __builtin_amdgcn_global_load_lds((const unsigned*)((const char*)(gbase) + (v1)), (LAS unsigned*)(lds + (bufoff) + ldsw + 8192), 16, 0, 0); } while (0)
#define PG8_STB(bufoff, gbase) PG8_STAGE(bufoff, gbase, voffB[0], voffB[1])
#define PG8_STA(bufoff, gbase, h, G0, G1) do { if constexpr (GATHER) PG8_STAGE(bufoff, gbase, G0, G1); else PG8_STAGE(bufoff, (gbase) + (h) * hstepA, voffA[0], voffA[1]); } while (0)
#define PG8_LDA(dst, b, h) do { _Pragma("unroll") for (int m = 0; m < 4; ++m) _Pragma("unroll") for (int k = 0; k < 2; ++k) dst[m][k] = *(const LAS bf16x8*)(lds + PG8_SA(b, h) + aoff + m * 2048 + k * 1024); } while (0)
#define PG8_LDB(dst, b, h) do { _Pragma("unroll") for (int n = 0; n < 2; ++n) _Pragma("unroll") for (int k = 0; k < 2; ++k) dst[n][k] = *(const LAS bf16x8*)(lds + PG8_SB(b, h) + boff + n * 2048 + k * 1024); } while (0)
#define PG8_MMA(ai, bj, At, Bt) do { __builtin_amdgcn_s_setprio(1); _Pragma("unroll") for (int m = 0; m < 4; ++m) _Pragma("unroll") for (int n = 0; n < 2; ++n) _Pragma("unroll") for (int k = 0; k < 2; ++k) \
        acc[ai][bj][m][n] = __builtin_amdgcn_mfma_f32_16x16x32_bf16(Bt[n][k], At[m][k], acc[ai][bj][m][n], 0, 0, 0); __builtin_amdgcn_s_setprio(0); } while (0)
#define PG8_WAIT_V(n) asm volatile("s_waitcnt vmcnt(" #n ")" ::: "memory")
#define PG8_WAIT_L(n) asm volatile("s_waitcnt lgkmcnt(" #n ")" ::: "memory")
#define PG8_BAR __builtin_amdgcn_s_barrier()
#define PG8_SCHED __builtin_amdgcn_sched_barrier(0)
    Unit cur, nxt; int ui = 0;
    if (!S.next(0, cur)) return;
    f32x4 acc[2][2][4][2];
#pragma unroll
    for (int a = 0; a < 2; ++a)
#pragma unroll
        for (int b = 0; b < 2; ++b)
#pragma unroll
            for (int m = 0; m < 4; ++m)
#pragma unroll
                for (int n = 0; n < 2; ++n) acc[a][b][m][n] = (f32x4){0.f, 0.f, 0.f, 0.f};
    bf16x8 At[4][2], B0[2][2], B1[2][2];
    const char* cA = S.a_base(cur); const char* cB = S.b_base(cur);
    unsigned gc00 = 0, gc01 = 0, gc10 = 0, gc11 = 0, gn00 = 0, gn01 = 0, gn10 = 0, gn11 = 0;
    if constexpr (GATHER) { PG8_GOFF(cur, 0, gc00, gc01); PG8_GOFF(cur, 1, gc10, gc11); }
    PG8_STB(PG8_SB(0, 0), cB); PG8_STB(PG8_SB(0, 1), cB + hstepB); PG8_STA(PG8_SA(0, 0), cA, 0, gc00, gc01); PG8_STA(PG8_SA(0, 1), cA, 1, gc10, gc11);
    if (wr == 1) PG8_BAR;
    PG8_WAIT_V(2); PG8_BAR;
    PG8_STB(PG8_SB(1, 0), cB + kstep); PG8_STA(PG8_SA(1, 0), cA + kstep, 0, gc00, gc01); PG8_STB(PG8_SB(1, 1), cB + hstepB + kstep);
    PG8_WAIT_V(6); PG8_BAR;
    for (;;) {
        const bool has_next = S.next(ui + 1, nxt);
        const char* nA = has_next ? S.a_base(nxt) : cA; const char* nB = has_next ? S.b_base(nxt) : cB;
        if constexpr (GATHER) {
            if (has_next) { PG8_GOFF(nxt, 0, gn00, gn01); PG8_GOFF(nxt, 1, gn10, gn11); }
            else { gn00 = gc00; gn01 = gc01; gn10 = gc10; gn11 = gc11; }
        }
#pragma nounroll
        for (int t = 0; t < nt; t += 2) {
            const bool last = (t == nt - 2);
            const char* a1 = cA + (size_t)(t + 1) * kstep;
            const char* a2 = last ? nA : cA + (size_t)(t + 2) * kstep; const char* b2 = last ? nB : cB + (size_t)(t + 2) * kstep;
            const char* a3 = a2 + kstep; const char* b3 = b2 + kstep;
            const unsigned g00 = last ? gn00 : gc00, g01 = last ? gn01 : gc01, g10 = last ? gn10 : gc10, g11 = last ? gn11 : gc11;
            PG8_LDB(B0, 0, 0); PG8_LDB(B1, 0, 1); PG8_SCHED; PG8_LDA(At, 0, 0); PG8_STA(PG8_SA(1, 1), a1, 1, gc10, gc11);
            PG8_WAIT_V(8); PG8_WAIT_L(0); PG8_BAR; PG8_MMA(0, 0, At, B0); PG8_MMA(0, 1, At, B1); PG8_BAR; PG8_SCHED;
            PG8_LDA(At, 0, 1); PG8_STB(PG8_SB(0, 0), b2); PG8_STB(PG8_SB(0, 1), b2 + hstepB); PG8_STA(PG8_SA(0, 0), a2, 0, g00, g01);
            PG8_WAIT_V(8); PG8_WAIT_L(0); PG8_BAR; PG8_MMA(1, 0, At, B0); PG8_MMA(1, 1, At, B1); PG8_BAR; PG8_SCHED;
            PG8_LDB(B0, 1, 0); PG8_LDB(B1, 1, 1); PG8_SCHED; PG8_LDA(At, 1, 0); PG8_STA(PG8_SA(0, 1), a2, 1, g10, g11);
            PG8_WAIT_V(8); PG8_WAIT_L(0); PG8_BAR; PG8_MMA(0, 0, At, B0); PG8_MMA(0, 1, At, B1); PG8_BAR; PG8_SCHED;
            PG8_LDA(At, 1, 1); PG8_STB(PG8_SB(1, 0), b3); PG8_STB(PG8_SB(1, 1), b3 + hstepB); PG8_STA(PG8_SA(1, 0), a3, 0, g00, g01);
            PG8_WAIT_V(8); PG8_WAIT_L(0); PG8_BAR; PG8_MMA(1, 0, At, B0); PG8_MMA(1, 1, At, B1); PG8_BAR; PG8_SCHED;
        }
        if (wr == 0) PG8_BAR;
        { unsigned ones_ = ~0u; asm volatile("" : "+s"(ones_)); const int l_ = (int)__builtin_amdgcn_mbcnt_hi(ones_, __builtin_amdgcn_mbcnt_lo(ones_, 0u)); E(acc, cur, wr, wc, l_ & 15, l_ >> 4); }
        if (!has_next) break;
#pragma unroll
        for (int a = 0; a < 2; ++a)
#pragma unroll
            for (int b = 0; b < 2; ++b)
#pragma unroll
                for (int m = 0; m < 4; ++m)
#pragma unroll
                    for (int n = 0; n < 2; ++n) acc[a][b][m][n] = (f32x4){0.f, 0.f, 0.f, 0.f};
        cur = nxt; cA = nA; cB = nB; ++ui;
        if constexpr (GATHER) { gc00 = gn00; gc01 = gn01; gc10 = gn10; gc11 = gn11; }
        if (wr == 1) PG8_BAR;
    }
    PG8_WAIT_V(0);
    PG8_BAR;
#undef PG8_GOFF
#undef PG8_SA
#undef PG8_SB
#undef PG8_STAGE
#undef PG8_STB
#undef PG8_STA
#undef PG8_LDA
#undef PG8_LDB
#undef PG8_MMA
#undef PG8_WAIT_V
#undef PG8_WAIT_L
#undef PG8_BAR
#undef PG8_SCHED
}
}

#define EPI_ROWS_BEGIN _Pragma("unroll") for (int ai = 0; ai < 2; ++ai) _Pragma("unroll") for (int m = 0; m < 4; ++m) { const unsigned row = (unsigned)(u.pm * 256 + ai * 128 + wr * 64 + m * 16 + fr);
#define EPI_ROWS_END asm volatile("" ::: "memory"); }
__device__ __forceinline__ void st16(void* base, unsigned off, u32x4 v) { *(u32x4*)((char*)base + off) = v; }
struct EpiInProj {
    static constexpr bool PERM = true;
    bf16* CQ; bf16* CKV; float* KR; float* FL; bf16* FQ; bf16* CI;
    __device__ __forceinline__ void operator()(const f32x4 (&acc)[2][2][4][2], const pg8::Unit& u, int wr, int wc, int fr, int fq) const {
        const int t = u.pn; const unsigned c8 = (unsigned)(wc * 32 + 8 * fq);
        if (t != 1) {
            bf16* base; unsigned ld;
            if (t == 0) { base = CQ; ld = 256; } else if (t <= 4) { base = FQ + (size_t)(t - 2) * M * 256; ld = 256; } else { base = CI + (t - 5) * 256; ld = 512; }
            EPI_ROWS_BEGIN
                const unsigned off = (row * ld + c8) * 2u;
                st16(base, off, pack8(acc[ai][0][m][0], acc[ai][0][m][1]));
                st16(base, off + 256u, pack8(acc[ai][1][m][0], acc[ai][1][m][1]));
            EPI_ROWS_END
        } else {
            EPI_ROWS_BEGIN
                const unsigned off = (row * 256u + c8) * 2u;
                st16(CKV, off, pack8(acc[ai][0][m][0], acc[ai][0][m][1]));
                if (c8 < 32) { const unsigned ko = (row * 32u + c8) * 4u; *(f32x4*)((char*)KR + ko) = acc[ai][1][m][0]; *(f32x4*)((char*)KR + ko + 16) = acc[ai][1][m][1]; }
                else if (c8 == 32) { *(f32x4*)((char*)FL + row * 16u) = acc[ai][1][m][0]; }
            EPI_ROWS_END
        }
    }
};
struct EpiQKV {
    static constexpr bool PERM = true;
    bf16* QM; bf16* KM; bf16* VM; const float* COS; const float* SIN;
    __device__ __forceinline__ void operator()(const f32x4 (&acc)[2][2][4][2], const pg8::Unit& u, int wr, int wc, int fr, int fq) const {
        const int t = u.pn; const unsigned c8 = (unsigned)(wc * 32 + 8 * fq);
        if (t < 3) {
#pragma unroll
            for (int bj = 0; bj < 2; ++bj) {
                const unsigned col = (unsigned)(t * 256 + bj * 128) + c8, h = col / 96u, d = col - h * 96u;
                const bool rope = d >= 64; const unsigned f4 = rope ? ((d - 64) >> 1) : 0u;
                EPI_ROWS_BEGIN
                    f32x4 v0 = acc[ai][bj][m][0], v1 = acc[ai][bj][m][1];
                    if (rope) {
                        const unsigned to = (row * 16u + f4) * 4u;
                        const f32x4 c = *(const f32x4*)((const char*)COS + to), s = *(const f32x4*)((const char*)SIN + to);
                        const f32x4 a = v0, b = v1;
                        v0 = (f32x4){a[0] * c[0] - a[2] * s[0], a[1] * c[1] - a[3] * s[1], a[0] * s[0] + a[2] * c[0], a[1] * s[1] + a[3] * c[1]};
                        v1 = (f32x4){b[0] * c[2] - b[2] * s[2], b[1] * c[3] - b[3] * s[3], b[0] * s[2] + b[2] * c[2], b[1] * s[3] + b[3] * c[3]};
                    }
                    st16(QM, (row * 768u + col) * 2u, pack8(v0, v1));
                EPI_ROWS_END
            }
        } else if (t < 5) {
#pragma unroll
            for (int bj = 0; bj < 2; ++bj) {
                const unsigned kc = (unsigned)((t - 3) * 256 + bj * 128) + c8, h = kc >> 6, d = kc & 63;
                EPI_ROWS_BEGIN
                    st16(KM, (row * 768u + h * 96u + d) * 2u, pack8(acc[ai][bj][m][0], acc[ai][bj][m][1]));
                EPI_ROWS_END
            }
        } else {
#pragma unroll
            for (int bj = 0; bj < 2; ++bj) {
                const unsigned vc = (unsigned)((t - 5) * 256 + bj * 128) + c8;
                EPI_ROWS_BEGIN
                    st16(VM, (row * 512u + vc) * 2u, pack8(acc[ai][bj][m][0], acc[ai][bj][m][1]));
                EPI_ROWS_END
            }
        }
    }
};
template <int LDC, bool SCALE>
struct EpiBf16 {
    static constexpr bool PERM = true;
    bf16* O; int ntn; const float* rowscale;
    __device__ __forceinline__ void operator()(const f32x4 (&acc)[2][2][4][2], const pg8::Unit& u, int wr, int wc, int fr, int fq) const {
        const unsigned col = (unsigned)((u.pn % ntn) * 256 + wc * 32 + 8 * fq);
        EPI_ROWS_BEGIN
            float s = 1.0f; if constexpr (SCALE) s = *(const float*)((const char*)rowscale + row * 4u);
            const unsigned off = (row * (unsigned)LDC + col) * 2u;
            st16(O, off, pack8(acc[ai][0][m][0] * s, acc[ai][0][m][1] * s));
            st16(O, off + 256u, pack8(acc[ai][1][m][0] * s, acc[ai][1][m][1] * s));
        EPI_ROWS_END
    }
};
template <int LDH>
struct EpiSwiGLU {
    static constexpr bool PERM = true;
    bf16* H; int ntn;
    __device__ __forceinline__ void operator()(const f32x4 (&acc)[2][2][4][2], const pg8::Unit& u, int wr, int wc, int fr, int fq) const {
        const unsigned col = (unsigned)((u.pn % ntn) * 128 + wc * 32 + 8 * fq);
        EPI_ROWS_BEGIN
            f32x4 a0 = acc[ai][0][m][0], a1 = acc[ai][0][m][1]; const f32x4 b0 = acc[ai][1][m][0], b1 = acc[ai][1][m][1];
#pragma unroll
            for (int j = 0; j < 4; ++j) { a0[j] = siluf_(a0[j]) * b0[j]; a1[j] = siluf_(a1[j]) * b1[j]; }
            st16(H, (row * (unsigned)LDH + col) * 2u, pack8(a0, a1));
        EPI_ROWS_END
    }
};
struct MoeOrder {
    const bf16* A; const bf16* Bt; int lda, ldb, nM, nN, G, c, rep; const int* slot_tok; int s1, s2, s3, s4, s5, s6, s7;
    __device__ __forceinline__ int expert_of(int rt) const { const int r = rt * 256; return (r >= s1) + (r >= s2) + (r >= s3) + (r >= s4) + (r >= s5) + (r >= s6) + (r >= s7); }
    __device__ __forceinline__ bool next(int i, pg8::Unit& u) const { int pm, pn; if (!pg8::tile_order_rep(i, G, c, nM, nN, rep, pm, pn)) return false; u.pm = pm; u.pn = expert_of(pm) * nN + pn; return true; }
    __device__ __forceinline__ const char* a_base(const pg8::Unit& u) const { return slot_tok ? (const char*)A : (const char*)A + (size_t)u.pm * 256 * lda * 2; }
    __device__ __forceinline__ const char* b_base(const pg8::Unit& u) const { return (const char*)Bt + (size_t)u.pn * 256 * ldb * 2; }
    __device__ __forceinline__ int tok(const pg8::Unit& u, int r) const { return slot_tok[u.pm * 256 + r]; }
};

namespace att {
__device__ __forceinline__ int crow(int r, int hi) { return (r & 3) + 8 * (r >> 2) + 4 * hi; }
__device__ __forceinline__ s16x4 vtr(const LAS unsigned char* p) { typedef short v4i16_t __attribute__((ext_vector_type(4))); return __builtin_bit_cast(s16x4, __builtin_amdgcn_ds_read_tr16_b64_v4i16((LAS v4i16_t*)p)); }
#define ATT_WAITBAR() asm volatile("s_waitcnt vmcnt(0) lgkmcnt(0)\n\ts_barrier" ::: "memory")
__device__ __forceinline__ void glds16(const void* gsrc, unsigned lds_dst) { unsigned keep;
    asm volatile("s_mov_b32 %0, m0\n\ts_mov_b32 m0, %2\n\ts_nop 0\n\tglobal_load_lds_dwordx4 %1, off\n\ts_mov_b32 m0, %0" : "=&s"(keep) : "v"(gsrc), "s"(lds_dst) : "memory"); }

#define MX3(a, b, c) __builtin_fmaxf(__builtin_fmaxf((a), (b)), (c))
template <int DQK> struct AttLds { static constexpr int NCH = DQK / 8, KSLOT = NCH * 1024, ND0 = DQK / 16, LK = 0, LV = 3 * KSLOT, LOST = LV + 3 * 8192, LCUM = LOST + NWAVES * 4608, END = LCUM + SEQ * 4; };

template <int DQK>
__device__ __forceinline__ void att_qk(f32x16& n0, f32x16& n1, const bf16x8 (&qr)[DQK / 16], const LAS unsigned char* kp) {
    constexpr int ND0 = DQK / 16;
    bf16x8 kf[2 * ND0];
#pragma unroll
    for (int d0 = 0; d0 < ND0; ++d0) { kf[2 * d0] = *(const LAS bf16x8*)(kp + d0 * 2048); kf[2 * d0 + 1] = *(const LAS bf16x8*)(kp + d0 * 2048 + 512); }
    n0 = (f32x16){}; n1 = (f32x16){};
#pragma unroll
    for (int d0 = 0; d0 < ND0; ++d0) {
        n0 = __builtin_amdgcn_mfma_f32_32x32x16_bf16(kf[2 * d0], qr[d0], n0, 0, 0, 0);
        n1 = __builtin_amdgcn_mfma_f32_32x32x16_bf16(kf[2 * d0 + 1], qr[d0], n1, 0, 0, 0);
    }
}
template <bool BIAS, bool MASK>
__device__ __forceinline__ void att_bias_mask(f32x16& n0, f32x16& n1, int t, int NT, int qrel, int hi, float fqb, const LAS float* cumL) {
    if constexpr (BIAS) {
#pragma unroll
        for (int g = 0; g < 4; ++g) {
            const f32x4 f0 = *(const LAS f32x4*)(cumL + t * 64 + 8 * g + 4 * hi), f1 = *(const LAS f32x4*)(cumL + t * 64 + 32 + 8 * g + 4 * hi);
#pragma unroll
            for (int j = 0; j < 4; ++j) { n0[4 * g + j] += fqb - f0[j]; n1[4 * g + j] += fqb - f1[j]; }
        }
    }
    if constexpr (MASK) {
        const int kb = 64 * (t - (NT - 4)) + 4 * hi;
#pragma unroll
        for (int r = 0; r < 16; ++r) { const int kv = kb + (r & 3) + 8 * (r >> 2); if (kv > qrel) n0[r] = -INFINITY; if (kv + 32 > qrel) n1[r] = -INFINITY; }
    }
}
template <int DQK, bool BIAS, bool MASK, bool MORE>
__device__ __forceinline__ void att_step(f32x16& s0, f32x16& s1, f32x16& o0, f32x16& o1, float& mrow, float& lrow, const bf16x8 (&qr)[DQK / 16],
                                         int t, int NT, int qrel, int lane, int hi, int r32, float fqb, const LAS unsigned char* shm, int vslot, int kslot) {
    typedef AttLds<DQK> L;
    constexpr int ND0 = DQK / 16;
    const LAS unsigned char* vp = shm + L::LV + vslot * 8192 + ((lane >> 4) & 1) * 32 + (lane & 3) * 8 + (4 * hi + ((lane & 15) >> 2)) * 64;
    const LAS unsigned char* kp = shm + L::LK + kslot * L::KSLOT + hi * 1024 + r32 * 16;
    bf16x8 kf[2 * ND0];
    if constexpr (MORE) {
#pragma unroll
        for (int d0 = 0; d0 < ND0; ++d0) { kf[2 * d0] = *(const LAS bf16x8*)(kp + d0 * 2048); kf[2 * d0 + 1] = *(const LAS bf16x8*)(kp + d0 * 2048 + 512); }
    }
    float a = MX3(s0[0], s0[1], s1[0]), b = MX3(s0[2], s0[3], s1[1]); a = MX3(a, s1[2], s1[3]);
#pragma unroll
    for (int r = 4; r < 16; r += 4) { a = MX3(a, s0[r], s0[r + 1]); b = MX3(b, s0[r + 2], s0[r + 3]); a = MX3(a, s1[r], s1[r + 1]); b = MX3(b, s1[r + 2], s1[r + 3]); }
    float rm = __builtin_fmaxf(a, b);
    { auto rr = __builtin_amdgcn_permlane32_swap(__float_as_uint(rm), __float_as_uint(rm), false, false); rm = __builtin_fmaxf(__uint_as_float(rr[0]), __uint_as_float(rr[1])); }
    const float mnew = __builtin_fmaxf(mrow, rm), alpha = fexp2(mrow - mnew);
    mrow = mnew;
    f32x16 n0 = {}, n1 = {};
    if constexpr (MORE) {
#pragma unroll
        for (int d0 = 0; d0 < ND0; ++d0) {
            n0 = __builtin_amdgcn_mfma_f32_32x32x16_bf16(kf[2 * d0], qr[d0], n0, 0, 0, 0);
            n1 = __builtin_amdgcn_mfma_f32_32x32x16_bf16(kf[2 * d0 + 1], qr[d0], n1, 0, 0, 0);
        }
    }
    float ps = 0.f;
#pragma unroll
    for (int r = 0; r < 16; ++r) { s0[r] = fexp2(s0[r] - mnew); s1[r] = fexp2(s1[r] - mnew); ps += s0[r] + s1[r]; o0[r] *= alpha; o1[r] *= alpha; }
    lrow = lrow * alpha + ps;
    __builtin_amdgcn_sched_barrier(0);
    s16x4 vl[8], vh[8];
#pragma unroll
    for (int i = 0; i < 8; ++i) { vl[i] = vtr(vp + (i >> 2) * 4096 + (i & 3) * 1024); vh[i] = vtr(vp + (i >> 2) * 4096 + (i & 3) * 1024 + 512); }
    u32x4 pw[4];
    pw[0] = (u32x4){pk2(s0[0], s0[1]), pk2(s0[2], s0[3]), pk2(s0[4], s0[5]), pk2(s0[6], s0[7])};
    pw[1] = (u32x4){pk2(s0[8], s0[9]), pk2(s0[10], s0[11]), pk2(s0[12], s0[13]), pk2(s0[14], s0[15])};
    pw[2] = (u32x4){pk2(s1[0], s1[1]), pk2(s1[2], s1[3]), pk2(s1[4], s1[5]), pk2(s1[6], s1[7])};
    pw[3] = (u32x4){pk2(s1[8], s1[9]), pk2(s1[10], s1[11]), pk2(s1[12], s1[13]), pk2(s1[14], s1[15])};
#pragma unroll
    for (int ks = 0; ks < 4; ++ks) {
        const bf16x8 v0 = (bf16x8){vl[ks][0], vl[ks][1], vl[ks][2], vl[ks][3], vh[ks][0], vh[ks][1], vh[ks][2], vh[ks][3]};
        const bf16x8 v1 = (bf16x8){vl[4 + ks][0], vl[4 + ks][1], vl[4 + ks][2], vl[4 + ks][3], vh[4 + ks][0], vh[4 + ks][1], vh[4 + ks][2], vh[4 + ks][3]};
        o0 = __builtin_amdgcn_mfma_f32_32x32x16_bf16(v0, __builtin_bit_cast(bf16x8, pw[ks]), o0, 0, 0, 0);
        o1 = __builtin_amdgcn_mfma_f32_32x32x16_bf16(v1, __builtin_bit_cast(bf16x8, pw[ks]), o1, 0, 0, 0);
    }
    if constexpr (MORE) { att_bias_mask<BIAS, MASK>(n0, n1, t + 1, NT, qrel, hi, fqb, (const LAS float*)(shm + L::LCUM)); s0 = n0; s1 = n1; }
}

template <int DQK, bool BIAS>
__device__ __forceinline__ void attn_unit(int b, int h, int qb, const bf16* Q, int pq, const bf16* K, int pk, const bf16* V, int pv,
                                          bf16* O, int po, int ocol, const float* cum, LAS unsigned char* shm, const int tid) {
    typedef AttLds<DQK> L;
    constexpr int NCH = L::NCH, KSLOT = L::KSLOT, ND0 = L::ND0, LK = L::LK, LV = L::LV, LOST = L::LOST;
    static_assert(L::END <= RING_BYTES, "attention LDS");
    const int lane = tid & 63, r32 = lane & 31, hi = lane >> 5; const int wid = __builtin_amdgcn_readfirstlane(tid >> 6);
    const long rowbase = (long)b * SEQ; const int q0 = qb * 256;
    const bf16* Qw = Q + (rowbase + q0 + wid * 32) * pq + h * DQK;
    const bf16* Kh = K + rowbase * pk + h * DQK; const bf16* Vh = V + rowbase * pv + h * 64;
    const int NT = (q0 + 256) / 64;
    LAS float* cumL = (LAS float*)(shm + L::LCUM);
    if constexpr (BIAS) { const float* cs = cum + (size_t)(b * 4 + h) * SEQ; for (int i = tid * 4; i < q0 + 256; i += NTHR * 4) *(LAS f32x4*)(cumL + i) = *(const f32x4*)(cs + i); }
    const bf16* ksrc = Kh + (long)lane * pk + wid * 8;
    const bf16* vsrc = Vh + (long)(16 * (wid & 3) + (lane >> 2)) * pv + (wid >> 2) * 32 + (lane & 3) * 8;
    const unsigned lds0 = (unsigned)(size_t)shm;
#define ATT_DMA_K(t, slot) do { \
        glds16(ksrc + (long)(t) * 64 * pk, (unsigned)__builtin_amdgcn_readfirstlane((int)(lds0 + LK + (slot) * KSLOT + wid * 1024))); \
        if (NCH > 8 && wid + 8 < NCH) glds16(ksrc + (long)(t) * 64 * pk + 64, (unsigned)__builtin_amdgcn_readfirstlane((int)(lds0 + LK + (slot) * KSLOT + (wid + 8) * 1024))); } while (0)
#define ATT_DMA_V(t, slot) glds16(vsrc + (long)(t) * 64 * pv, (unsigned)__builtin_amdgcn_readfirstlane((int)(lds0 + LV + (slot) * 8192 + wid * 1024)))
    const int nK = (NCH > 8 && wid + 8 < NCH) ? 2 : 1;
#define ATT_WAITBAR_N(n) do { const int n_ = (n); if (n_ == 0) asm volatile("s_waitcnt vmcnt(0) lgkmcnt(0)\n\ts_barrier" ::: "memory"); else if (n_ == 1) asm volatile("s_waitcnt vmcnt(1) lgkmcnt(0)\n\ts_barrier" ::: "memory"); \
        else if (n_ == 2) asm volatile("s_waitcnt vmcnt(2) lgkmcnt(0)\n\ts_barrier" ::: "memory"); else asm volatile("s_waitcnt vmcnt(3) lgkmcnt(0)\n\ts_barrier" ::: "memory"); } while (0)
    ATT_DMA_K(0, 0); ATT_DMA_V(0, 0); ATT_DMA_K(1, 1);
    bf16x8 qr[ND0];
#pragma unroll
    for (int d0 = 0; d0 < ND0; ++d0) qr[d0] = *(const bf16x8*)(Qw + (long)r32 * pq + d0 * 16 + hi * 8);
    float mrow = -1e30f, lrow = 0.f; f32x16 o0 = {}, o1 = {};
    const int qrel = wid * 32 + r32;
    ATT_WAITBAR();
#pragma unroll
    for (int d0 = 0; d0 < ND0; ++d0) asm volatile("" : "+v"(qr[d0]));
    ATT_DMA_K(2, 2); ATT_DMA_V(1, 1);
    float fqb = 0.f; if constexpr (BIAS) fqb = cumL[q0 + qrel];
    f32x16 s0, s1;
    att_qk<DQK>(s0, s1, qr, shm + LK + hi * 1024 + r32 * 16);
    asm volatile("s_waitcnt lgkmcnt(0)\n\ts_barrier" ::: "memory");
    if (NT == 4) att_bias_mask<BIAS, true>(s0, s1, 0, NT, qrel, hi, fqb, cumL); else att_bias_mask<BIAS, false>(s0, s1, 0, NT, qrel, hi, fqb, cumL);
    int t = 0, sl0 = 0, sl1 = 1, sl2 = 2;
#define ATT_ROT() do { const int x_ = sl0; sl0 = sl1; sl1 = sl2; sl2 = x_; } while (0)
    for (; t < NT - 5; ++t) {
        ATT_DMA_K(t + 3, sl0); ATT_DMA_V(t + 2, sl2);
        att_step<DQK, BIAS, false, true>(s0, s1, o0, o1, mrow, lrow, qr, t, NT, qrel, lane, hi, r32, fqb, shm, sl0, sl1);
        ATT_WAITBAR_N(nK + 1); ATT_ROT();
    }
    for (; t < NT - 1; ++t) {
        int nis = 0;
        if (t + 3 < NT) { ATT_DMA_K(t + 3, sl0); nis += nK; }
        if (t + 2 < NT) { ATT_DMA_V(t + 2, sl2); nis += 1; }
        att_step<DQK, BIAS, true, true>(s0, s1, o0, o1, mrow, lrow, qr, t, NT, qrel, lane, hi, r32, fqb, shm, sl0, sl1);
        ATT_WAITBAR_N(nis); ATT_ROT();
    }
    att_step<DQK, BIAS, false, false>(s0, s1, o0, o1, mrow, lrow, qr, t, NT, qrel, lane, hi, r32, fqb, shm, sl0, sl1);
#undef ATT_ROT
#undef ATT_WAITBAR_N
    { auto rr = __builtin_amdgcn_permlane32_swap(__float_as_uint(lrow), __float_as_uint(lrow), false, false); lrow = __uint_as_float(rr[0]) + __uint_as_float(rr[1]); }
    const float rl = frcp(lrow);
    LAS unsigned char* stg = shm + LOST + wid * 4608;
#pragma unroll
    for (int g = 0; g < 4; ++g) {
        *(LAS u32x2*)(stg + r32 * 144 + (8 * g + 4 * hi) * 2) = (u32x2){pk2(o0[4 * g] * rl, o0[4 * g + 1] * rl), pk2(o0[4 * g + 2] * rl, o0[4 * g + 3] * rl)};
        *(LAS u32x2*)(stg + r32 * 144 + (32 + 8 * g + 4 * hi) * 2) = (u32x2){pk2(o1[4 * g] * rl, o1[4 * g + 1] * rl), pk2(o1[4 * g + 2] * rl, o1[4 * g + 3] * rl)};
    }
    asm volatile("s_waitcnt lgkmcnt(0)" ::: "memory");
    bf16* Ow = O + (rowbase + q0 + wid * 32) * po + ocol;
#pragma unroll
    for (int i = 0; i < 4; ++i) { const int row = i * 8 + (lane >> 3), ch = lane & 7; const u32x4 v = *(const LAS u32x4*)(stg + row * 144 + ch * 16); *(u32x4*)(Ow + (long)row * po + ch * 8) = v; }
    asm volatile("s_waitcnt lgkmcnt(0)\n\ts_barrier" ::: "memory");
#undef ATT_DMA_K
#undef ATT_DMA_V
}
}

struct Args { const float* in[26]; float* out; unsigned char* ws; int ph_lo, ph_hi; };
typedef const __attribute__((address_space(4))) Args* kargs_t;
struct Ctx {
    LAS unsigned char* lds; unsigned* ctl; unsigned char* ws; float* out;
    int tid, lane, wave, vcu, G, gw, NGW, bx;
};
__device__ __forceinline__ kargs_t opaque_args() { kargs_t p = (kargs_t)__builtin_amdgcn_kernarg_segment_ptr(); asm volatile("" : "+s"(p)); return p; }
__device__ __forceinline__ Ctx make_ctx(kargs_t A, LAS unsigned char* lds, int wave0) {
    Ctx C; unsigned ones = ~0u; asm volatile("" : "+s"(ones));
    int t = wave0 * 64 + (int)__builtin_amdgcn_mbcnt_hi(ones, __builtin_amdgcn_mbcnt_lo(ones, 0u)); asm volatile("" : "+v"(t));
    C.lds = lds; C.ws = A->ws; C.ctl = (unsigned*)(C.ws + WS_CTL); C.out = A->out;
    C.tid = t; C.lane = t & 63; C.wave = __builtin_amdgcn_readfirstlane(t >> 6);
    { int g_ = gridDim.x, b_ = blockIdx.x; asm volatile("" : "+s"(g_), "+s"(b_)); C.G = g_; C.bx = b_; } C.vcu = (C.bx % 8) * (C.G / 8) + C.bx / 8;
    C.gw = C.vcu * NWAVES + C.wave; C.NGW = C.G * NWAVES;
    return C;
}
#define LDS_WAIT() asm volatile("s_waitcnt lgkmcnt(0)" ::: "memory")

struct MapWin { __device__ __forceinline__ int row(int n) const {
        if (n < 256) return PC_CQ + n; if (n < 384) return PC_CKV + (n - 256); if (n < 416) return PC_KR + (n - 384); if (n < 672) return PC_FQ + (n - 416);
        if (n < 928) return PC_FK + (n - 672); if (n < 1184) return PC_FV + (n - 928); if (n < 1188) return PC_FL + (n - 1184); return PC_CI + (n - 1188); }
    __device__ __forceinline__ float scale(int, int n) const { return (n >= 416 && n < 672) ? C2_FOX : 1.0f; } };
struct MapUq { const float* g; __device__ __forceinline__ int row(int n) const { const int h = n / 96, d = n - h * 96; if (d < 64) return n; const int i = d - 64;
        const int s = (i < 16) ? (4 * (i >> 1) + (i & 1)) : (4 * ((i - 16) >> 1) + 2 + (i & 1)); return h * 96 + 64 + s; }
    __device__ __forceinline__ float scale(int k, int) const { return g[k] * C2_MLA; } };
struct MapUkv { const float* g; __device__ __forceinline__ int row(int n) const { const int h = n >> 7, d = n & 127; return d < 64 ? (768 + h * 64 + d) : (1280 + h * 64 + (d - 64)); }
    __device__ __forceinline__ float scale(int k, int) const { return g[k]; } };
struct MapWout { const float* gm; const float* gf; __device__ __forceinline__ int row(int n) const { return n; }
    __device__ __forceinline__ float scale(int k, int) const { return k < 512 ? gm[k] : (k < 768 ? gf[k - 512] : 1.0f); } };
struct MapW13 { int which; __device__ __forceinline__ int row(int n) const { return (n >> 7) * 256 + which * 128 + (n & 127); }
    __device__ __forceinline__ float scale(int, int) const { return 1.0f; } };
struct MapId { __device__ __forceinline__ int row(int n) const { return n; } __device__ __forceinline__ float scale(int, int) const { return 1.0f; } };

template <class Map>
__device__ __forceinline__ void transpose_item(const float* W, int Nsrc, bf16* WT, int ldk, LAS float* scr, int kb, int nb, int lane, const Map mp) {
    const int k0 = 64 * kb, n0 = 32 * nb, r8 = lane >> 3, nn = n0 + 4 * (lane & 7); const bool nok = nn < Nsrc;
    f32x4 v[8];
#pragma unroll
    for (int i = 0; i < 8; ++i) { v[i] = (f32x4){0.f, 0.f, 0.f, 0.f}; if (nok) v[i] = *(const f32x4*)(W + (size_t)(k0 + 8 * i + r8) * Nsrc + nn); }
#pragma unroll
    for (int i = 0; i < 8; ++i) { const int kk = 8 * i + r8; LAS float* d = scr + kk * 33 + 4 * (lane & 7);
#pragma unroll
        for (int j = 0; j < 4; ++j) d[j] = v[i][j] * mp.scale(k0 + kk, nn + j); }
    LDS_WAIT(); asm volatile("" ::: "memory");
    const int c = lane & 7;
#pragma unroll
    for (int j = 0; j < 4; ++j) { const int n = (lane >> 3) + 8 * j; const LAS float* s = scr + (8 * c) * 33 + n;
        if (n0 + n < Nsrc) { u32x4 o; o.x = pk2(s[0 * 33], s[1 * 33]); o.y = pk2(s[2 * 33], s[3 * 33]); o.z = pk2(s[4 * 33], s[5 * 33]); o.w = pk2(s[6 * 33], s[7 * 33]);
            *(u32x4*)(WT + (size_t)mp.row(n0 + n) * ldk + k0 + 8 * c) = o; } }
    LDS_WAIT(); asm volatile("" ::: "memory");
}

__device__ __forceinline__ void sincos_acc(float ang, float& c, float& s) {
    const double a = (double)ang, q = __builtin_rint(a * 0.63661977236758134308);
    const double y = (a - q * 1.57079632679489655800) - q * 6.12323399573676603587e-17, y2 = y * y;
    const double sp = y * (1.0 + y2 * (-1.0 / 6 + y2 * (1.0 / 120 + y2 * (-1.0 / 5040 + y2 * (1.0 / 362880 + y2 * (-1.0 / 39916800 + y2 * (1.0 / 6227020800.0)))))));
    const double cp = 1.0 + y2 * (-0.5 + y2 * (1.0 / 24 + y2 * (-1.0 / 720 + y2 * (1.0 / 40320 + y2 * (-1.0 / 3628800 + y2 * (1.0 / 479001600 + y2 * (-1.0 / 87178291200.0)))))));
    const int quad = (int)((long long)q & 3);
    const double ss = (quad == 0) ? sp : (quad == 1) ? cp : (quad == 2) ? -sp : -cp;
    const double cc = (quad == 0) ? cp : (quad == 1) ? -sp : (quad == 2) ? -cp : sp;
    c = (float)cc; s = (float)ss;
}
__device__ __forceinline__ float inv_freq(int f) {
    const int a = f >> 2, b = f & 3;
    const float p = (a == 0) ? 1.0f : (a == 1) ? 0.1f : (a == 2) ? 0.01f : 0.001f;
    const float m = (b == 0) ? 1.0f : (b == 1) ? 0.56234132519034908f : (b == 2) ? 0.31622776601683794f : 0.17782794100389228f;
    return (b == 0) ? p : (float)((double)p * (double)m);
}

__device__ __forceinline__ void p0_prologue(Ctx& C, kargs_t A) {
    LAS float* scr = (LAS float*)(C.lds + C.wave * 16384);
    bf16* WIN = (bf16*)(C.ws + WS_WIN); bf16* WQ2 = (bf16*)(C.ws + WS_WQ2); bf16* WOUT = (bf16*)(C.ws + WS_WOUT);
    constexpr int I_IN = 16 * 54, I_UQ = 4 * 24, I_UKV = 2 * 32, I_OUT = 16 * 32, I_L = I_IN + I_UQ + I_UKV + I_OUT;
    REPS(12) for (int it = C.gw; it < DEPTH * I_L; it += C.NGW) {
        const int l = it / I_L; int r = it - l * I_L;
        if (r < I_IN) { transpose_item(A->in[2] + (size_t)l * DM * IN_COLS, IN_COLS, WIN + (size_t)l * NP1 * DM, DM, scr, r / 54, r % 54, C.lane, MapWin{}); continue; } r -= I_IN;
        if (r < I_UQ) { transpose_item(A->in[4] + (size_t)l * 256 * 768, 768, WQ2 + (size_t)l * NP1 * 256, 256, scr, r / 24, r % 24, C.lane, MapUq{A->in[3] + l * 256}); continue; } r -= I_UQ;
        if (r < I_UKV) { transpose_item(A->in[6] + (size_t)l * 128 * 1024, 1024, WQ2 + (size_t)l * NP1 * 256, 256, scr, r / 32, r % 32, C.lane, MapUkv{A->in[5] + l * 128}); continue; } r -= I_UKV;
        transpose_item(A->in[14] + (size_t)l * DM * DM, DM, WOUT + (size_t)l * DM * DM, DM, scr, r / 32, r % 32, C.lane, MapWout{A->in[12] + l * 512, A->in[13] + l * 256});
    }
    const int gt = C.vcu * NTHR + C.tid, NGT = C.G * NTHR;
    for (int i = gt; i < DEPTH * 92 * 128; i += NGT) { const int l = i / (92 * 128), r = i % (92 * 128); *(u32x4*)(WIN + (size_t)l * NP1 * DM + (size_t)(420 + r / 128) * DM + (r % 128) * 8) = (u32x4){0u, 0u, 0u, 0u}; }
    for (int i = gt; i < DEPTH * 1024 * 16; i += NGT) { const int l = i / (1024 * 16), r = i % (1024 * 16); *(u32x4*)(WQ2 + (size_t)l * NP1 * 256 + (size_t)(768 + r / 16) * 256 + 128 + (r % 16) * 8) = (u32x4){0u, 0u, 0u, 0u}; }
    REPS(4) {
    bf16* XB = (bf16*)(C.ws + WS_XB); const float* x = A->in[0];
    for (int m = C.gw; m < M; m += C.NGW) { const f32x4* xr = (const f32x4*)(x + (size_t)m * DM) + C.lane; u32x2* o = (u32x2*)(XB + (size_t)m * DM) + C.lane;
#pragma unroll
        for (int j = 0; j < 4; ++j) { const f32x4 v = xr[64 * j]; o[64 * j] = (u32x2){pk2(v[0], v[1]), pk2(v[2], v[3])}; } }
    float* COS = (float*)(C.ws + WS_TAB); float* SIN = COS + (size_t)M * 16; const int* pos = (const int*)A->in[1];
    for (int i = gt; i < M * 16; i += NGT) { const float ang = (float)pos[i >> 4] * inv_freq(i & 15); float c, s; sincos_acc(ang, c, s); COS[i] = c; SIN[i] = s; }
    }
}

__device__ __forceinline__ void ffn_weights(Ctx& C, kargs_t A, int layer) {
    LAS float* scr = (LAS float*)(C.lds + C.wave * 16384);
    bf16* W13 = (bf16*)(C.ws + WS_WFFN); bf16* W2T = W13 + WF_W13_ELEMS; const int j = layer >> 1;
    if ((layer & 1) == 0) {
        constexpr int I1 = 16 * 88, I2 = 44 * 32;
        const float* w1 = A->in[17] + (size_t)j * DM * DFF; const float* w3 = A->in[18] + (size_t)j * DM * DFF; const float* w2 = A->in[19] + (size_t)j * DFF * DM;
        for (int it = C.gw; it < 2 * I1 + I2; it += C.NGW) {
            int r = it;
            if (r < I1) { transpose_item(w1, DFF, W13, DM, scr, r / 88, r % 88, C.lane, MapW13{0}); continue; } r -= I1;
            if (r < I1) { transpose_item(w3, DFF, W13, DM, scr, r / 88, r % 88, C.lane, MapW13{1}); continue; } r -= I1;
            transpose_item(w2, DM, W2T, DFF, scr, r / 32, r % 32, C.lane, MapId{});
        }
    } else {
        constexpr int I1 = 16 * 44, I2 = 22 * 32, IE = 2 * I1 + I2;
        for (int it = C.gw; it < NEXP * IE; it += C.NGW) {
            const int e = it / IE; int r = it - e * IE;
            const float* w1 = A->in[21] + ((size_t)j * NEXP + e) * DM * DFE; const float* w3 = A->in[22] + ((size_t)j * NEXP + e) * DM * DFE; const float* w2 = A->in[23] + ((size_t)j * NEXP + e) * DFE * DM;
            bf16* W13e = W13 + (size_t)e * 2 * DFE * DM; bf16* W2Te = W2T + (size_t)e * DM * DFE;
            if (r < I1) { transpose_item(w1, DFE, W13e, DM, scr, r / 44, r % 44, C.lane, MapW13{0}); continue; } r -= I1;
            if (r < I1) { transpose_item(w3, DFE, W13e, DM, scr, r / 44, r % 44, C.lane, MapW13{1}); continue; } r -= I1;
            transpose_item(w2, DM, W2Te, DFE, scr, r / 32, r % 32, C.lane, MapId{});
        }
    }
}

__device__ __forceinline__ void p2_thin(Ctx& C, kargs_t A, int layer) {
    unsigned char* sc = C.ws + WS_SCR;
    bf16* CQ = (bf16*)(sc + SC_CQKV); bf16* CKV = CQ + (size_t)M * 256; const float* KR = (const float*)(sc + SC_KR); const float* FL = (const float*)(sc + SC_FL);
    float* CUM = (float*)(sc + SC_CUM); const bf16* CI = (const bf16*)(sc + SC_CI); bf16* KM = (bf16*)(sc + SC_KM); bf16* MIXED = (bf16*)(sc + SC_MIXED);
    const float* COS = (const float*)(C.ws + WS_TAB); const float* SIN = COS + (size_t)M * 16;
    REPS(6) {
    if (C.gw < BATCH * 4) {
        const int b = C.gw >> 2, h = C.gw & 3; const float bias = A->in[7][layer * 4 + h];
        float v[64]; float run = 0.f;
#pragma unroll
        for (int i = 0; i < 64; ++i) { const float z = FL[((size_t)b * SEQ + C.lane * 64 + i) * 4 + h] + bias; const float e = fexp2(-fabsf(z) * LOG2E);
            const float ls = fminf(z, 0.f) - __builtin_amdgcn_logf(1.0f + e) * 0.6931471805599453f; run += ls * LOG2E; v[i] = run; }
        float incl = run;
#pragma unroll
        for (int o = 1; o < 64; o <<= 1) { const float t = __int_as_float(__builtin_amdgcn_ds_bpermute((C.lane - o) << 2, __float_as_int(incl))); if (C.lane >= o) incl += t; }
        const float excl = incl - run; float* dst = CUM + (size_t)C.gw * SEQ + C.lane * 64;
#pragma unroll
        for (int i = 0; i < 64; i += 4) *(f32x4*)(dst + i) = (f32x4){v[i] + excl, v[i + 1] + excl, v[i + 2] + excl, v[i + 3] + excl};
    }
    for (int mb = C.gw; mb < M; mb += 4 * C.NGW) {
        u32x2 wq[4]; unsigned wk[4]; f32x2 x1[4], x2[4], cs[4], sn[4]; const int g4 = C.lane & 7, h = C.lane >> 3;
#pragma unroll
        for (int k = 0; k < 4; ++k) { const size_t m = (size_t)mb + (size_t)k * C.NGW;
            wq[k] = ((const u32x2*)(CQ + m * 256))[C.lane]; wk[k] = ((const unsigned*)(CKV + m * 256))[C.lane];
            x1[k] = *(const f32x2*)(KR + m * 32 + 2 * g4); x2[k] = *(const f32x2*)(KR + m * 32 + 16 + 2 * g4);
            cs[k] = *(const f32x2*)(COS + m * 16 + 2 * g4); sn[k] = *(const f32x2*)(SIN + m * 16 + 2 * g4); }
#pragma unroll
        for (int k = 0; k < 4; ++k) { const size_t m = (size_t)mb + (size_t)k * C.NGW;
            { const float a0 = bflo(wq[k].x), a1 = bfhi(wq[k].x), a2 = bflo(wq[k].y), a3 = bfhi(wq[k].y);
              const float ss = wave_sum((a0 * a0 + a1 * a1) + (a2 * a2 + a3 * a3)); const float r = 1.0f / sqrtf(ss * (1.0f / 256) + EPS); ((u32x2*)(CQ + m * 256))[C.lane] = (u32x2){pk2(a0 * r, a1 * r), pk2(a2 * r, a3 * r)}; }
            { const float a0 = bflo(wk[k]), a1 = bfhi(wk[k]); unsigned* p = (unsigned*)(CKV + m * 256) + C.lane;
              const float ss = wave_sum(a0 * a0 + a1 * a1); const float r = 1.0f / sqrtf(ss * (1.0f / 128) + EPS); *p = pk2(a0 * r, a1 * r); p[64] = 0u; }
            *(u32x2*)(KM + m * 768 + h * 96 + 64 + 4 * g4) = (u32x2){pk2(x1[k].x * cs[k].x - x2[k].x * sn[k].x, x1[k].y * cs[k].y - x2[k].y * sn[k].y), pk2(x1[k].x * sn[k].x + x2[k].x * cs[k].x, x1[k].y * sn[k].y + x2[k].y * cs[k].y)}; }
    }
    }
    {
        LAS float* hL = (LAS float*)C.lds; LAS float* yL = hL + 62 * 256;
        const int cch = (C.wave & 3) * 64 + C.lane, tt0 = (C.wave >> 2) * 16;
        float wj[31];
#pragma unroll
        for (int j = 0; j < 31; ++j) wj[j] = A->in[8][((size_t)layer * 31 + j) * 256 + cch];
        const float cb = A->in[9][layer * 256 + cch];
        const int ntok = C.tid >> 4, ngrp = (C.tid >> 2) & 3, nqt = C.tid & 3, nc0 = ngrp * 64 + nqt * 16;
        REPS(10) for (int tile = C.vcu; tile < M / 32; tile += C.G) {
            const int t0 = tile * 32, seq0 = (t0 / SEQ) * SEQ;
            for (int it = C.tid; it < 62 * 32; it += NTHR) { const int r = it >> 5, ch = it & 31, tok = t0 - 30 + r; f32x4 o0 = {0.f, 0.f, 0.f, 0.f}, o1 = o0;
                if (tok >= seq0) { const u32x4 a = *(const u32x4*)(CI + (size_t)tok * 512 + ch * 8), g = *(const u32x4*)(CI + (size_t)tok * 512 + 256 + ch * 8);
                    o0 = (f32x4){bflo(a.x) * sigmoidf_(bflo(g.x)), bfhi(a.x) * sigmoidf_(bfhi(g.x)), bflo(a.y) * sigmoidf_(bflo(g.y)), bfhi(a.y) * sigmoidf_(bfhi(g.y))};
                    o1 = (f32x4){bflo(a.z) * sigmoidf_(bflo(g.z)), bfhi(a.z) * sigmoidf_(bfhi(g.z)), bflo(a.w) * sigmoidf_(bflo(g.w)), bfhi(a.w) * sigmoidf_(bfhi(g.w))}; }
                *(LAS f32x4*)(hL + r * 256 + ch * 8) = o0; *(LAS f32x4*)(hL + r * 256 + ch * 8 + 4) = o1; }
            __syncthreads();
#pragma unroll
            for (int chunk = 0; chunk < 2; ++chunk) { const int base = tt0 + chunk * 8; float hv[38];
#pragma unroll
                for (int i = 0; i < 38; ++i) hv[i] = hL[(base + i) * 256 + cch];
#pragma unroll
                for (int tt = 0; tt < 8; ++tt) { float acc = cb;
#pragma unroll
                    for (int j = 0; j < 31; ++j) acc += wj[j] * hv[tt + j];
                    yL[(base + tt) * 256 + cch] = acc; } }
            __syncthreads();
            { float v[16]; float s = 0.f;
#pragma unroll
              for (int i = 0; i < 16; i += 4) { const f32x4 t4 = *(const LAS f32x4*)(yL + ntok * 256 + nc0 + i); v[i] = t4[0]; v[i + 1] = t4[1]; v[i + 2] = t4[2]; v[i + 3] = t4[3]; s += (t4[0] + t4[1]) + (t4[2] + t4[3]); }
              s += lane_xor<1>(s); s += lane_xor<2>(s); const float mean = s * (1.0f / 64); float q = 0.f;
#pragma unroll
              for (int i = 0; i < 16; ++i) { v[i] -= mean; q += v[i] * v[i]; }
              q += lane_xor<1>(q); q += lane_xor<2>(q); const float rstd = 1.0f / sqrtf(q * (1.0f / 64) + EPS);
              const float* gg = A->in[10] + layer * 256 + nc0; const float* gb = A->in[11] + layer * 256 + nc0; float o[16];
#pragma unroll
              for (int i = 0; i < 16; ++i) o[i] = siluf_(v[i] * rstd * gg[i] + gb[i]);
              bf16* dst = MIXED + (size_t)(t0 + ntok) * 1024 + 768 + nc0;
              *(u32x4*)dst = (u32x4){pk2(o[0], o[1]), pk2(o[2], o[3]), pk2(o[4], o[5]), pk2(o[6], o[7])};
              *(u32x4*)(dst + 8) = (u32x4){pk2(o[8], o[9]), pk2(o[10], o[11]), pk2(o[12], o[13]), pk2(o[14], o[15])}; }
        }
        __syncthreads();
    }
    REPS(11) ffn_weights(C, A, layer);
}

__device__ __forceinline__ void p5_rms(Ctx& C) {
    bf16* MIXED = (bf16*)(C.ws + WS_SCR + SC_MIXED);
    REPS(7) for (int mb = C.gw; mb < M; mb += 4 * C.NGW) {
        u32x4 wa[4]; u32x2 wb[4];
#pragma unroll
        for (int k = 0; k < 4; ++k) { const bf16* r = MIXED + ((size_t)mb + (size_t)k * C.NGW) * 1024; wa[k] = ((const u32x4*)r)[C.lane]; wb[k] = ((const u32x2*)(r + 512))[C.lane]; }
#pragma unroll
        for (int k = 0; k < 4; ++k) { bf16* r = MIXED + ((size_t)mb + (size_t)k * C.NGW) * 1024;
            { const u32x4 w = wa[k]; float a[8] = {bflo(w.x), bfhi(w.x), bflo(w.y), bfhi(w.y), bflo(w.z), bfhi(w.z), bflo(w.w), bfhi(w.w)}; float ss = 0.f;
#pragma unroll
              for (int i = 0; i < 8; ++i) ss += a[i] * a[i];
              ss = wave_sum(ss); const float rs = 1.0f / sqrtf(ss * (1.0f / 512) + EPS);
              ((u32x4*)r)[C.lane] = (u32x4){pk2(a[0] * rs, a[1] * rs), pk2(a[2] * rs, a[3] * rs), pk2(a[4] * rs, a[5] * rs), pk2(a[6] * rs, a[7] * rs)}; }
            { const u32x2 w = wb[k]; const float a0 = bflo(w.x), a1 = bfhi(w.x), a2 = bflo(w.y), a3 = bfhi(w.y);
              const float ss = wave_sum((a0 * a0 + a1 * a1) + (a2 * a2 + a3 * a3)); const float rs = 1.0f / sqrtf(ss * (1.0f / 256) + EPS); ((u32x2*)(r + 512))[C.lane] = (u32x2){pk2(a0 * rs, a1 * rs), pk2(a2 * rs, a3 * rs)}; }
        }
    }
}

template <int MODE>
__device__ __forceinline__ void ln_pass(Ctx& C, const bool final, const bf16* add, const float* gam, const float* bet, const float* router_w) {
    bf16* XB = (bf16*)(C.ws + WS_XB); float* out = C.out;
    REPS(14) {
    const bool dry = ((REP_MASK >> 14) & 1) && rep_ == 0; float* jf = (float*)(C.ws + WS_SCR); bf16* jb = (bf16*)(C.ws + WS_SCR + 40 * MiB);
    int* TOPE = (int*)(C.ws + WS_MOE + MT_TOPE); float* TOPG = (float*)(C.ws + WS_MOE + MT_TOPG); const int* TOKSLOT = (const int*)(C.ws + WS_MOE + MT_TOKSLOT);
    LAS float* RW = (LAS float*)C.lds; LAS unsigned* CNT = (LAS unsigned*)(C.lds + 32768);
    if constexpr (MODE == 1) {
        for (int i = C.tid; i < 1024 * 8 / 4; i += NTHR) *(LAS f32x4*)(RW + 4 * i) = *(const f32x4*)(router_w + 4 * i);
        if (C.tid < 8) CNT[C.tid] = 0u;
        __syncthreads();
    }
    f32x4 g4[4], b4[4];
#pragma unroll
    for (int j = 0; j < 4; ++j) { g4[j] = ((const f32x4*)gam)[64 * j + C.lane]; b4[j] = ((const f32x4*)bet)[64 * j + C.lane]; }
    const int RPB = M / C.G, row0 = C.bx * RPB;
    unsigned cnt0 = 0, cnt1 = 0, cnt2 = 0, cnt3 = 0, cnt4 = 0, cnt5 = 0, cnt6 = 0, cnt7 = 0;
    u32x2 nx[4], na[4], nb[4]; int sl0 = 0, sl1 = 0;
#define LN_LOAD(mm) do { _Pragma("unroll") for (int j = 0; j < 4; ++j) { nx[j] = ((const u32x2*)(XB + (size_t)(mm) * DM))[64 * j + C.lane]; \
        if constexpr (MODE == 2) { na[j] = ((const u32x2*)(add + (size_t)sl0 * DM))[64 * j + C.lane]; nb[j] = ((const u32x2*)(add + (size_t)sl1 * DM))[64 * j + C.lane]; } \
        else { na[j] = ((const u32x2*)(add + (size_t)(mm) * DM))[64 * j + C.lane]; nb[j] = (u32x2){0u, 0u}; } } } while (0)
    if constexpr (MODE == 2) { sl0 = TOKSLOT[2 * (row0 + C.wave)]; sl1 = TOKSLOT[2 * (row0 + C.wave) + 1]; }
    LN_LOAD(row0 + C.wave);
    if constexpr (MODE == 2) { if (C.wave + NWAVES < RPB) { sl0 = TOKSLOT[2 * (row0 + C.wave + NWAVES)]; sl1 = TOKSLOT[2 * (row0 + C.wave + NWAVES) + 1]; } }
    for (int rr = C.wave; rr < RPB; rr += NWAVES) {
        const int m = row0 + rr;
        f32x4 v[4];
#pragma unroll
        for (int j = 0; j < 4; ++j) { v[j] = (f32x4){bflo(nx[j].x), bfhi(nx[j].x), bflo(nx[j].y), bfhi(nx[j].y)} * ALPHA + (f32x4){bflo(na[j].x), bfhi(na[j].x), bflo(na[j].y), bfhi(na[j].y)};
            if constexpr (MODE == 2) v[j] += (f32x4){bflo(nb[j].x), bfhi(nb[j].x), bflo(nb[j].y), bfhi(nb[j].y)}; }
        if (rr + NWAVES < RPB) {
            LN_LOAD(m + NWAVES);
            if constexpr (MODE == 2) { if (rr + 2 * NWAVES < RPB) { sl0 = TOKSLOT[2 * (m + 2 * NWAVES)]; sl1 = TOKSLOT[2 * (m + 2 * NWAVES) + 1]; } }
        }
        float s = 0.f;
#pragma unroll
        for (int j = 0; j < 4; ++j) s += (v[j][0] + v[j][1]) + (v[j][2] + v[j][3]);
        const float mean = wave_sum(s) * (1.0f / DM); float q = 0.f;
#pragma unroll
        for (int j = 0; j < 4; ++j) { v[j] = v[j] - mean; q += (v[j][0] * v[j][0] + v[j][1] * v[j][1]) + (v[j][2] * v[j][2] + v[j][3] * v[j][3]); }
        const float rstd = 1.0f / sqrtf(wave_sum(q) * (1.0f / DM) + EPS);
#pragma unroll
        for (int j = 0; j < 4; ++j) { v[j] = v[j] * rstd * g4[j] + b4[j]; if (final) ((f32x4*)((dry ? jf + (size_t)(m & 8191) * DM : out + (size_t)m * DM)))[64 * j + C.lane] = v[j];
            ((u32x2*)((dry ? jb + (size_t)(m & 8191) * DM : XB + (size_t)m * DM)))[64 * j + C.lane] = (u32x2){pk2(v[j][0], v[j][1]), pk2(v[j][2], v[j][3])}; }
        if constexpr (MODE == 1) {
            float lg[8] = {0.f, 0.f, 0.f, 0.f, 0.f, 0.f, 0.f, 0.f};
#pragma unroll
            for (int j = 0; j < 4; ++j)
#pragma unroll
                for (int i = 0; i < 4; ++i) { const int col = 256 * j + 4 * C.lane + i; const f32x4 w0 = *(const LAS f32x4*)(RW + col * 8), w1 = *(const LAS f32x4*)(RW + col * 8 + 4); const float xv = v[j][i];
                    lg[0] += xv * w0[0]; lg[1] += xv * w0[1]; lg[2] += xv * w0[2]; lg[3] += xv * w0[3]; lg[4] += xv * w1[0]; lg[5] += xv * w1[1]; lg[6] += xv * w1[2]; lg[7] += xv * w1[3]; }
#pragma unroll
            for (int e = 0; e < 8; ++e) lg[e] = wave_sum(lg[e]);
            int e1 = 0; float v1 = lg[0];
#pragma unroll
            for (int e = 1; e < 8; ++e) if (lg[e] > v1) { v1 = lg[e]; e1 = e; }
            int e2 = -1; float v2 = -INFINITY;
#pragma unroll
            for (int e = 0; e < 8; ++e) if (e != e1 && lg[e] > v2) { v2 = lg[e]; e2 = e; }
            const float ex = fexp2((v2 - v1) * LOG2E), gA = 1.0f / (1.0f + ex), gB = ex * gA;
            if (C.lane == 0) { TOPE[2 * m] = e1; TOPE[2 * m + 1] = e2; TOPG[2 * m] = gA; TOPG[2 * m + 1] = gB; }
            cnt0 += (e1 == 0) + (e2 == 0); cnt1 += (e1 == 1) + (e2 == 1); cnt2 += (e1 == 2) + (e2 == 2); cnt3 += (e1 == 3) + (e2 == 3);
            cnt4 += (e1 == 4) + (e2 == 4); cnt5 += (e1 == 5) + (e2 == 5); cnt6 += (e1 == 6) + (e2 == 6); cnt7 += (e1 == 7) + (e2 == 7);
        }
    }
    if constexpr (MODE == 1) {
        if (C.lane == 0) { atomicAdd((unsigned*)&CNT[0], cnt0); atomicAdd((unsigned*)&CNT[1], cnt1); atomicAdd((unsigned*)&CNT[2], cnt2); atomicAdd((unsigned*)&CNT[3], cnt3);
                           atomicAdd((unsigned*)&CNT[4], cnt4); atomicAdd((unsigned*)&CNT[5], cnt5); atomicAdd((unsigned*)&CNT[6], cnt6); atomicAdd((unsigned*)&CNT[7], cnt7); }
        __syncthreads();
        if (C.tid < 8) C.ctl[CW_CNTB + C.bx * 8 + C.tid] = CNT[C.tid];
        __syncthreads();
    }
    }
#undef LN_LOAD
}

__device__ __forceinline__ void moe_assign(Ctx& C) {
    if (C.wave != 0) return;
    const int* TOPE = (const int*)(C.ws + WS_MOE + MT_TOPE); const float* TOPG = (const float*)(C.ws + WS_MOE + MT_TOPG);
    int* TOKSLOT = (int*)(C.ws + WS_MOE + MT_TOKSLOT); int* SLOTTOK = (int*)(C.ws + WS_MOE + MT_SLOTTOK); float* SLOTGATE = (float*)(C.ws + WS_MOE + MT_SLOTGATE);
    const int blk = C.bx, RPB = M / C.G, row0 = blk * RPB;
    int tot[8] = {0, 0, 0, 0, 0, 0, 0, 0}, pre[8] = {0, 0, 0, 0, 0, 0, 0, 0};
    for (int bb = C.lane; bb < C.G; bb += 64) {
        const u32x4* cp = (const u32x4*)(C.ctl + CW_CNTB + bb * 8); const u32x4 ca = cp[0], cb = cp[1]; const int lt = bb < blk ? 1 : 0;
        const int c[8] = {(int)ca.x, (int)ca.y, (int)ca.z, (int)ca.w, (int)cb.x, (int)cb.y, (int)cb.z, (int)cb.w};
#pragma unroll
        for (int e = 0; e < 8; ++e) { tot[e] += c[e]; pre[e] += lt * c[e]; }
    }
#pragma unroll
    for (int e = 0; e < 8; ++e) { tot[e] = wave_sum_i(tot[e]); pre[e] = wave_sum_i(pre[e]); }
    int seg[9]; seg[0] = 0;
#pragma unroll
    for (int e = 0; e < 8; ++e) seg[e + 1] = seg[e] + ((tot[e] + 255) & ~255);
    int run[8];
#pragma unroll
    for (int e = 0; e < 8; ++e) run[e] = seg[e] + pre[e];
    const unsigned long long ltmask = (1ull << C.lane) - 1ull;
    for (int base = 0; base < RPB * 2; base += 64) {
        const int idx = base + C.lane, token = row0 + (idx >> 1), choice = idx & 1;
        const int ex = TOPE[2 * token + choice]; const float gate = TOPG[2 * token + choice]; int slot = 0;
#pragma unroll
        for (int e = 0; e < 8; ++e) { const unsigned long long mk = __builtin_amdgcn_ballot_w64(ex == e); if (ex == e) slot = run[e] + __popcll(mk & ltmask); run[e] += __popcll(mk); }
        SLOTTOK[slot] = token; SLOTGATE[slot] = gate; TOKSLOT[2 * token + choice] = slot;
    }
    if (blk < 8) {
        int lo = 0, hi = 0;
#pragma unroll
        for (int e = 0; e < 8; ++e) if (e == blk) { lo = seg[e] + tot[e]; hi = seg[e + 1]; }
        for (int s = lo + C.lane; s < hi; s += 64) { SLOTTOK[s] = 0; SLOTGATE[s] = 0.f; }
    }
    if (blk == 0 && C.lane == 0) {
#pragma unroll
        for (int e = 0; e < 9; ++e) C.ctl[CW_SEG + e] = (unsigned)seg[e];
    }
}

#ifndef MK_PER_PHASE
#define MK_PER_PHASE 0
#endif
#ifndef PH_ENABLE
#define PH_ENABLE 0xFFFF
#endif
constexpr int PH_PER_LAYER = 12, N_PHASES = 1 + DEPTH * PH_PER_LAYER;

__global__ void __launch_bounds__(NTHR, 2) fwd_kernel(Args args) {
    extern __shared__ __attribute__((aligned(16))) unsigned char lds_raw[];
    LAS unsigned char* const lds = (LAS unsigned char*)lds_raw;
    volatile LAS unsigned* MISC = (volatile LAS unsigned*)(lds + MISC_OFF);
    for (int u = threadIdx.x; u < (LDS_BYTES - LDSCTL_OFF) / 4; u += NTHR) ((LAS unsigned*)(lds + LDSCTL_OFF))[u] = 0u;
    __syncthreads();
    const int wave0 = __builtin_amdgcn_readfirstlane((int)threadIdx.x >> 6);
    XcdBarrier bar; bar.bar = (unsigned*)(args.ws + WS_CTL) + CW_BAR; bar.x = 0; bar.st = nullptr;
    if (!MK_PER_PHASE) bar = xcd_barrier_post((unsigned*)(args.ws + WS_CTL) + CW_BAR, MISC + 8, wave0);
    const int lo = args.ph_lo, hi = args.ph_hi;
#define IN(k) (lo <= (k) && (k) < hi)
#define EN(p) ((PH_ENABLE >> (p)) & 1)
#define SEAM(k) do { if (IN((k) + 1)) { if (!MK_PER_PHASE) { xcd_barrier<false>(bar, wave0); if ((REP_MASK >> 13) & 1) xcd_barrier<false>(bar, wave0); } } } while (0)
#define SEAM0(k) do { if (IN((k) + 1)) { if (!MK_PER_PHASE) xcd_barrier<true>(bar, wave0); } } while (0)
#define PHASE_CTX kargs_t A = opaque_args(); Ctx C = make_ctx(A, lds, wave0); unsigned char* sc = C.ws + WS_SCR; (void)sc

    if (EN(15) && IN(0)) { PHASE_CTX; p0_prologue(C, A); }
    SEAM0(0);

    for (int layer = 0; layer < DEPTH; ++layer) {
        const int P = 1 + layer * PH_PER_LAYER;
#ifdef FORCE_MOE
        const bool moe = FORCE_MOE != 0;
#else
        const bool moe = (layer & 1) != 0;
#endif
        if (EN(0) && IN(P + 0)) {
            PHASE_CTX;
            pg8::DenseOrder S{(const bf16*)(C.ws + WS_XB), (const bf16*)(C.ws + WS_WIN) + (size_t)layer * NP1 * DM, DM, DM, M / 256, NP1 / 256, C.G, C.bx, REPN(0)};
            EpiInProj E{(bf16*)(sc + SC_CQKV), (bf16*)(sc + SC_CQKV) + (size_t)M * 256, (float*)(sc + SC_KR), (float*)(sc + SC_FL), (bf16*)(sc + SC_FQ), (bf16*)(sc + SC_CI)};
            pg8::gemm_phase<EpiInProj, pg8::DenseOrder, false, DM, DM, DM>(C.lds, C.tid, S, E);
            SEAM(P + 0);
        }
        if (EN(1) && IN(P + 1)) { PHASE_CTX; p2_thin(C, A, layer); SEAM(P + 1); }
        if (EN(2) && IN(P + 2)) {
            PHASE_CTX;
            struct QkvOrder { const bf16* A; const bf16* Bt; int G, c, rep;
                __device__ __forceinline__ bool next(int i, pg8::Unit& u) const { return pg8::tile_order_rep(i, G, c, M / 256, 7, rep, u.pm, u.pn); }
                __device__ __forceinline__ const char* a_base(const pg8::Unit& u) const { return (const char*)(A + (u.pn < 3 ? (size_t)0 : (size_t)M * 256)) + (size_t)u.pm * 256 * 256 * 2; }
                __device__ __forceinline__ const char* b_base(const pg8::Unit& u) const { return (const char*)Bt + (size_t)u.pn * 256 * 256 * 2; }
                __device__ __forceinline__ int tok(const pg8::Unit&, int) const { return 0; } };
            QkvOrder S{(const bf16*)(sc + SC_CQKV), (const bf16*)(C.ws + WS_WQ2) + (size_t)layer * NP1 * 256, C.G, C.bx, REPN(2)};
            EpiQKV E{(bf16*)(sc + SC_QM), (bf16*)(sc + SC_KM), (bf16*)(sc + SC_VM), (const float*)(C.ws + WS_TAB), (const float*)(C.ws + WS_TAB) + (size_t)M * 16};
            pg8::gemm_phase<EpiQKV, QkvOrder, false, 256, 256, 256>(C.lds, C.tid, S, E);
            SEAM(P + 2);
        }
        if (EN(3) && IN(P + 3)) {
            PHASE_CTX;
            bf16* MIXED = (bf16*)(sc + SC_MIXED);
            REPS(3) for (int p = C.vcu; p < 768; p += C.G) {
                if (p < 512) { const int bh = p >> 3, s = p & 7;
                    for (int i = 0; i < 2; ++i) att::attn_unit<96, false>(bh >> 3, bh & 7, i == 0 ? 15 - s : s, (const bf16*)(sc + SC_QM), 768, (const bf16*)(sc + SC_KM), 768, (const bf16*)(sc + SC_VM), 512, MIXED, 1024, (bh & 7) * 64, nullptr, C.lds, C.tid);
                } else { const int f = p - 512, bh = f >> 3, s = f & 7; const bf16* FQ = (const bf16*)(sc + SC_FQ);
                    for (int i = 0; i < 2; ++i) att::attn_unit<64, true>(bh >> 2, bh & 3, i == 0 ? 15 - s : s, FQ, 256, FQ + (size_t)M * 256, 256, FQ + (size_t)2 * M * 256, 256, MIXED, 1024, 512 + (bh & 3) * 64, (const float*)(sc + SC_CUM), C.lds, C.tid);
                }
            }
            SEAM(P + 3);
        }
        if (EN(4) && IN(P + 4)) { PHASE_CTX; p5_rms(C); SEAM(P + 4); }
        if (EN(5) && IN(P + 5)) {
            PHASE_CTX;
            pg8::DenseOrder S{(const bf16*)(sc + SC_MIXED), (const bf16*)(C.ws + WS_WOUT) + (size_t)layer * DM * DM, DM, DM, M / 256, DM / 256, C.G, C.bx, REPN(5)};
            EpiBf16<DM, false> E{(bf16*)(sc + SC_MIXOUT), DM / 256, nullptr};
            pg8::gemm_phase<EpiBf16<DM, false>, pg8::DenseOrder, false, DM, DM, DM>(C.lds, C.tid, S, E);
            SEAM(P + 5);
        }
        if (EN(6) && IN(P + 6)) {
            if (moe) { PHASE_CTX; ln_pass<1>(C, false, (const bf16*)(sc + SC_MIXOUT), A->in[15] + layer * DM, A->in[16] + layer * DM, A->in[20] + (size_t)(layer >> 1) * DM * NEXP); }
            else     { PHASE_CTX; ln_pass<0>(C, false, (const bf16*)(sc + SC_MIXOUT), A->in[15] + layer * DM, A->in[16] + layer * DM, nullptr); }
            SEAM(P + 6);
        }
        if (EN(7) && IN(P + 7)) { if (moe) { PHASE_CTX; moe_assign(C); } SEAM(P + 7); }
        if (EN(8) && IN(P + 8)) {
            if (moe) {
                PHASE_CTX; bf16* W13 = (bf16*)(C.ws + WS_WFFN); bf16* HID = (bf16*)(sc + SC_HID);
                const int* seg = (const int*)(C.ctl + CW_SEG);
                MoeOrder S{(const bf16*)(C.ws + WS_XB), W13, DM, DM, seg[8] / 256, 11, C.G, C.bx, REPN(8), (const int*)(C.ws + WS_MOE + MT_SLOTTOK), seg[1], seg[2], seg[3], seg[4], seg[5], seg[6], seg[7]};
                EpiSwiGLU<DFE> E{HID, 11};
                pg8::gemm_phase<EpiSwiGLU<DFE>, MoeOrder, true, DM, DM, DM>(C.lds, C.tid, S, E);
            } else {
                PHASE_CTX; bf16* W13 = (bf16*)(C.ws + WS_WFFN); bf16* HID = (bf16*)(sc + SC_HID);
                pg8::DenseOrder S{(const bf16*)(C.ws + WS_XB), W13, DM, DM, M / 256, 2 * DFF / 256, C.G, C.bx, REPN(8)};
                EpiSwiGLU<DFF> E{HID, 1 << 30};
                pg8::gemm_phase<EpiSwiGLU<DFF>, pg8::DenseOrder, false, DM, DM, DM>(C.lds, C.tid, S, E);
            }
            SEAM(P + 8);
        }
        if (EN(9) && IN(P + 9)) {
            if (moe) {
                PHASE_CTX; bf16* W2T = (bf16*)(C.ws + WS_WFFN) + WF_W13_ELEMS; bf16* HID = (bf16*)(sc + SC_HID); bf16* FF = (bf16*)(sc + SC_FF);
                const int* seg = (const int*)(C.ctl + CW_SEG);
                MoeOrder S{HID, W2T, DFE, DFE, seg[8] / 256, 4, C.G, C.bx, REPN(9), nullptr, seg[1], seg[2], seg[3], seg[4], seg[5], seg[6], seg[7]};
                EpiBf16<DM, true> E{FF, 4, (const float*)(C.ws + WS_MOE + MT_SLOTGATE)};
                pg8::gemm_phase<EpiBf16<DM, true>, MoeOrder, false, DFE, DFE, DFE>(C.lds, C.tid, S, E);
            } else {
                PHASE_CTX; bf16* W2T = (bf16*)(C.ws + WS_WFFN) + WF_W13_ELEMS; bf16* HID = (bf16*)(sc + SC_HID); bf16* FF = (bf16*)(sc + SC_FF);
                pg8::DenseOrder S{HID, W2T, DFF, DFF, M / 256, DM / 256, C.G, C.bx, REPN(9)};
                EpiBf16<DM, false> E{FF, DM / 256, nullptr};
                pg8::gemm_phase<EpiBf16<DM, false>, pg8::DenseOrder, false, DFF, DFF, DFF>(C.lds, C.tid, S, E);
            }
            SEAM(P + 9);
        }
        if (EN(10) && IN(P + 10)) {
            if (moe) { PHASE_CTX; ln_pass<2>(C, layer == DEPTH - 1, (const bf16*)(sc + SC_FF), A->in[24] + layer * DM, A->in[25] + layer * DM, nullptr); }
            else     { PHASE_CTX; ln_pass<0>(C, layer == DEPTH - 1, (const bf16*)(sc + SC_FF), A->in[24] + layer * DM, A->in[25] + layer * DM, nullptr); }
            SEAM(P + 10);
        }
        if (IN(P + 11)) { SEAM(P + 11); }
    }
#undef IN
#undef SEAM
}

extern "C" void kernel_launch(void* const* d_in, const int* in_sizes, int n_in, void* d_out, int out_size, void* d_ws, size_t ws_size, hipStream_t stream) {
    static int grid = 0;
    if (grid == 0) {
        if (n_in != 26 || out_size != M * DM || ws_size < WS_END) { fprintf(stderr, "kernel_launch: unexpected problem (n_in %d, out %d, ws %zu < %zu)\n", n_in, out_size, ws_size, (size_t)WS_END); grid = -1; return; }
        int dev = 0, cus = 0, per_cu = 0;
        if (hipGetDevice(&dev) != hipSuccess || hipDeviceGetAttribute(&cus, hipDeviceAttributeMultiprocessorCount, dev) != hipSuccess) { grid = -1; return; }
        if (hipFuncSetAttribute((const void*)fwd_kernel, hipFuncAttributeMaxDynamicSharedMemorySize, LDS_BYTES) != hipSuccess) { fprintf(stderr, "kernel_launch: hipFuncSetAttribute failed\n"); grid = -1; return; }
        if (hipOccupancyMaxActiveBlocksPerMultiprocessor(&per_cu, (const void*)fwd_kernel, NTHR, LDS_BYTES) != hipSuccess || per_cu < 1) fprintf(stderr, "kernel_launch: occupancy query says %d\n", per_cu);
        (void)hipGetLastError();
        grid = 256; while (grid > cus && grid > 8) grid >>= 1;
    }
    if (grid < 0) return;
    (void)hipMemsetAsync((char*)d_ws + WS_CTL, 0, CTL_ZERO_BYTES, stream);
    Args a{};
    for (int i = 0; i < 26; ++i) a.in[i] = (const float*)d_in[i];
    a.out = (float*)d_out; a.ws = (unsigned char*)d_ws;
#if MK_PER_PHASE
    for (int p = 0; p < N_PHASES; ++p) { a.ph_lo = p; a.ph_hi = p + 1; hipLaunchKernelGGL(fwd_kernel, dim3(grid), dim3(NTHR), LDS_BYTES, stream, a); }
#else
    a.ph_lo = 0; a.ph_hi = N_PHASES;
    hipLaunchKernelGGL(fwd_kernel, dim3(grid), dim3(NTHR), LDS_BYTES, stream, a);
#endif
}
```

```cpp
#include <hip/hip_runtime.h>
#include <cstdio>
#include <cstdint>
#include <cmath>

#ifndef REP_MASK
#define REP_MASK 0x0
#endif
#ifndef PROBE_MASK
#define PROBE_MASK 0x0
#endif
#define PROBE_ON(k) ((PROBE_MASK >> (k)) & 1)
#define PT0(k) unsigned long long pt0_ = 0ull; if (PROBE_ON(k)) pt0_ = __builtin_amdgcn_s_memrealtime()
#ifndef PROBE_BEFORE
#define PROBE_BEFORE 0
#endif
#define PSPIN(d) do { const unsigned long long pt1_ = __builtin_amdgcn_s_memrealtime(); while (__builtin_amdgcn_s_memrealtime() - pt1_ < (d)) __builtin_amdgcn_s_sleep(8); } while (0)
#define PEND(k, seamexpr) do { unsigned long long pd_ = 0ull; if (PROBE_ON(k)) { pd_ = __builtin_amdgcn_s_memrealtime() - pt0_; if (PROBE_BEFORE) PSPIN(pd_); } seamexpr; \
        if (PROBE_ON(k) && !PROBE_BEFORE) PSPIN(pd_); } while (0)
#define REPN(p) (1 + ((REP_MASK >> (p)) & 1))
#define REPS(p) for (int rep_ = 0; rep_ < 1 + ((REP_MASK >> (p)) & 1); ++rep_)
#define GAS __attribute__((address_space(1)))
#define LAS __attribute__((address_space(3)))
typedef unsigned short bf16;
typedef short bf16x8 __attribute__((ext_vector_type(8)));
typedef short s16x4 __attribute__((ext_vector_type(4)));
typedef float f32x2 __attribute__((ext_vector_type(2)));
typedef float f32x4 __attribute__((ext_vector_type(4)));
typedef float f32x16 __attribute__((ext_vector_type(16)));
typedef unsigned u32x2 __attribute__((ext_vector_type(2)));
typedef unsigned u32x4 __attribute__((ext_vector_type(4)));
typedef __bf16 bf16x2_t __attribute__((ext_vector_type(2)));

constexpr int BATCH = 8, SEQ = 4096, DM = 1024, M = BATCH * SEQ, DEPTH = 4;
constexpr int IN_COLS = 1700, NP1 = 1792;
constexpr int DFF = 2816, DFE = 1408, NEXP = 8;
constexpr int NWAVES = 8, NTHR = 512;
constexpr float ALPHA = 1.6817928305074290f;
constexpr float EPS = 1e-5f;
constexpr float LOG2E = 1.4426950408889634f;
constexpr float C2_MLA = 0.10206207261596577f * LOG2E;
constexpr float C2_FOX = 0.125f * LOG2E;
constexpr int PC_CQ = 0, PC_CKV = 256, PC_KR = 384, PC_FL = 416, PC_FQ = 512, PC_FK = 768, PC_FV = 1024, PC_CI = 1280;
constexpr int MOE_ROWS_MAX = 2 * M + NEXP * 256;

constexpr size_t MiB = 1u << 20;
constexpr size_t WS_CTL = 0, CTL_ZERO_BYTES = 1 * MiB;
constexpr size_t WS_WIN = 1 * MiB;
constexpr size_t WS_WQ2 = WS_WIN + 14 * MiB;
constexpr size_t WS_WOUT = WS_WQ2 + 4 * MiB;
constexpr size_t WS_TAB = WS_WOUT + 8 * MiB;
constexpr size_t WS_MOE = WS_TAB + 4 * MiB;
constexpr size_t WS_WFFN = WS_MOE + 2 * MiB;
constexpr size_t WS_XB = WS_WFFN + 68 * MiB;
constexpr size_t WS_SCR = WS_XB + 64 * MiB;
constexpr size_t SC_CQKV = 0;
constexpr size_t SC_KR = SC_CQKV + 32 * MiB;
constexpr size_t SC_FL = SC_KR + 4 * MiB;
constexpr size_t SC_CUM = SC_FL + MiB / 2;
constexpr size_t SC_FQ = SC_CUM + MiB / 2;
constexpr size_t SC_CI = SC_FQ + 48 * MiB;
constexpr size_t SC_QM = SC_CI + 32 * MiB;
constexpr size_t SC_KM = SC_QM + 48 * MiB;
constexpr size_t SC_VM = SC_KM + 48 * MiB;
constexpr size_t SC_MIXED = SC_VM + 32 * MiB;
constexpr size_t SC_MIXOUT = SC_QM;
constexpr size_t SC_SSQ = SC_MIXED + 64 * MiB;
constexpr size_t SC_MIX_END = SC_SSQ + 2 * MiB;
constexpr size_t SC_HID = 0;
constexpr size_t SC_FF = 182 * MiB;
constexpr size_t SC_END = 316 * MiB;
constexpr size_t WS_END = WS_SCR + SC_END;
static_assert(SC_MIX_END <= SC_END && SC_FF + (size_t)MOE_ROWS_MAX * 1024 * 2 <= SC_END && (size_t)MOE_ROWS_MAX * DFE * 2 <= SC_FF, "scratch map");
static_assert(WS_END <= 512 * MiB, "workspace map");
constexpr size_t WF_W13_ELEMS = (size_t)NEXP * 2 * DFE * DM;
constexpr size_t MT_TOPE = 0;
constexpr size_t MT_TOPG = 256 * 1024;
constexpr size_t MT_TOKSLOT = 512 * 1024;
constexpr size_t MT_SLOTTOK = 768 * 1024;
constexpr size_t MT_SLOTGATE = 768 * 1024 + 272 * 1024;
static_assert((size_t)MOE_ROWS_MAX * 4 <= 272 * 1024 && MT_SLOTGATE + 272 * 1024 <= 2 * MiB, "moe tables");
constexpr int CW_BAR = 4096;
constexpr int CW_CNTB = 16384;
constexpr int CW_SEG = 20480;
constexpr int CW_ATTQ = 2048;
constexpr int CW_QKMAX = 1024;

constexpr int RING_BYTES = 131072;
constexpr int LDSCTL_OFF = RING_BYTES, MISC_OFF = LDSCTL_OFF + 320;
constexpr int LDS_BYTES = 147456;

#define RLX_AGENT __ATOMIC_RELAXED, __HIP_MEMORY_SCOPE_AGENT
__device__ __forceinline__ unsigned pk2(float lo, float hi) { f32x2 v = {lo, hi}; bf16x2_t b = __builtin_convertvector(v, bf16x2_t); return __builtin_bit_cast(unsigned, b); }
__device__ __forceinline__ float bf2f(unsigned short u) { return __uint_as_float((unsigned)u << 16); }
__device__ __forceinline__ float bflo(unsigned u) { return __uint_as_float(u << 16); }
__device__ __forceinline__ float bfhi(unsigned u) { return __uint_as_float(u & 0xffff0000u); }
__device__ __forceinline__ float fexp2(float x) { return __builtin_amdgcn_exp2f(x); }
__device__ __forceinline__ float frcp(float x) { return __builtin_amdgcn_rcpf(x); }
__device__ __forceinline__ float sigmoidf_(float x) { return frcp(1.0f + fexp2(-x * LOG2E)); }
__device__ __forceinline__ float siluf_(float x) { return x * sigmoidf_(x); }
template <int O> __device__ __forceinline__ float lane_xor(float v) {
    if constexpr (O < 32) return __int_as_float(__builtin_amdgcn_ds_swizzle(__float_as_int(v), (O << 10) | 0x1f));
    else { auto rr = __builtin_amdgcn_permlane32_swap(__float_as_uint(v), __float_as_uint(v), false, false); return __uint_as_float(rr[0]) == v ? __uint_as_float(rr[1]) : __uint_as_float(rr[0]); }
}
__device__ __forceinline__ float wave_sum(float v) {
    v += lane_xor<1>(v); v += lane_xor<2>(v); v += lane_xor<4>(v); v += lane_xor<8>(v); v += lane_xor<16>(v);
    { auto rr = __builtin_amdgcn_permlane32_swap(__float_as_uint(v), __float_as_uint(v), false, false); v = __uint_as_float(rr[0]) + __uint_as_float(rr[1]); }
    return v;
}
__device__ __forceinline__ int wave_sum_i(int v) {
    v += __builtin_amdgcn_ds_swizzle(v, (1 << 10) | 0x1f); v += __builtin_amdgcn_ds_swizzle(v, (2 << 10) | 0x1f); v += __builtin_amdgcn_ds_swizzle(v, (4 << 10) | 0x1f);
    v += __builtin_amdgcn_ds_swizzle(v, (8 << 10) | 0x1f); v += __builtin_amdgcn_ds_swizzle(v, (16 << 10) | 0x1f);
    { auto rr = __builtin_amdgcn_permlane32_swap((unsigned)v, (unsigned)v, false, false); v = (int)(rr[0] + rr[1]); }
    return v;
}
__device__ __forceinline__ u32x4 pack8(const f32x4 a, const f32x4 b) { u32x4 w; w.x = pk2(a[0], a[1]); w.y = pk2(a[2], a[3]); w.z = pk2(b[0], b[1]); w.w = pk2(b[2], b[3]); return w; }

#define XB_TMO      128
#define XB_XCNT(j)  (256  + 64 * (j))
#define XB_XSUB(j)  (1280 + 64 * (j))
#define XB_XGEN(j)  (2304 + 64 * (j))
#define XB_TOP      3328
#define XB_TOPGEN   3392
#define XCD_BAR_WORDS 3456
#define XB_SPIN_CAP (1u << 18)
__device__ __forceinline__ unsigned xb_ld(unsigned* p)              { return __hip_atomic_load(p, __ATOMIC_RELAXED, __HIP_MEMORY_SCOPE_AGENT); }
__device__ __forceinline__ unsigned xb_add(unsigned* p, unsigned v) { return __hip_atomic_fetch_add(p, v, __ATOMIC_RELAXED, __HIP_MEMORY_SCOPE_AGENT); }
__device__ __forceinline__ unsigned xb_xcc_id() { return (unsigned)__builtin_amdgcn_s_getreg((3 << 11) | 20) & 0xFu; }
#define XB_SPIN(cond, bar) do { unsigned _sp = 0; while (cond) { __builtin_amdgcn_s_sleep(1); \
    if ((++_sp & 255u) == 0u) { if (xb_ld(&(bar)[XB_TMO])) break; if (_sp > XB_SPIN_CAP) { atomicAdd(&(bar)[XB_TMO], 1u); break; } } } } while (0)
struct XcdBarrier { unsigned* bar; unsigned x; volatile LAS unsigned* st; };
__device__ __forceinline__ bool xb_is_t0(int wave0) { unsigned ones = ~0u; asm volatile("" : "+s"(ones)); return wave0 == 0 && __builtin_amdgcn_mbcnt_hi(ones, __builtin_amdgcn_mbcnt_lo(ones, 0u)) == 0u; }
__device__ __forceinline__ XcdBarrier xcd_barrier_post(unsigned* bar, volatile LAS unsigned* st, int wave0) {
    XcdBarrier b; b.bar = bar; b.x = xb_xcc_id(); b.st = st;
    if (xb_is_t0(wave0)) (void)xb_add(&bar[XB_XCNT(b.x)], 1u);
    return b;
}
__device__ __forceinline__ void xcd_barrier_complete(unsigned* bar, unsigned x, unsigned& nloc, unsigned& nx) {
    const unsigned G = gridDim.x * gridDim.y * gridDim.z;
    unsigned sum, cnt, mine, sp = 0u;
    for (;;) {
        sum = 0u; cnt = 0u; mine = 0u;
#pragma unroll
        for (unsigned j = 0; j < 16; ++j) { const unsigned c = xb_ld(&bar[XB_XCNT(j)]); sum += c; cnt += (c > 0u) ? 1u : 0u; mine = (j == x) ? c : mine; }
        if (sum == G) break;
        __builtin_amdgcn_s_sleep(1);
        if ((++sp & 255u) == 0u) { if (xb_ld(&bar[XB_TMO])) break; if (sp > XB_SPIN_CAP) { atomicAdd(&bar[XB_TMO], 1u); break; } }
    }
    nloc = mine > 0u ? mine : 1u; nx = cnt > 0u ? cnt : 1u;
}
template <bool FIRST>
__device__ __forceinline__ void xcd_barrier(const XcdBarrier& b, int wave0) {
    asm volatile("s_waitcnt vmcnt(0)" ::: "memory");
    __syncthreads();
    if (xb_is_t0(wave0)) {
        unsigned* bar = b.bar;
        __builtin_amdgcn_s_waitcnt(0);
        unsigned nloc = b.st[0], nx = b.st[1];
        if constexpr (FIRST) { if (nloc == 0u) { xcd_barrier_complete(bar, b.x, nloc, nx); b.st[0] = nloc; b.st[1] = nx; } }
        const unsigned old = xb_add(&bar[XB_XSUB(b.x)], 1u);
        const unsigned gen = old / nloc;
        if (old + 1u == (gen + 1u) * nloc) {
            __builtin_amdgcn_fence(__ATOMIC_RELEASE, "agent");
            asm volatile("s_waitcnt vmcnt(0)" ::: "memory");
            const unsigned og = xb_add(&bar[XB_TOP], 1u);
            const unsigned tg = og / nx;
            if (og + 1u == (tg + 1u) * nx) xb_add(&bar[XB_TOPGEN], 1u);
            else XB_SPIN(xb_ld(&bar[XB_TOPGEN]) == tg, bar);
            __builtin_amdgcn_fence(__ATOMIC_ACQUIRE, "agent");
            xb_add(&bar[XB_XGEN(b.x)], 1u);
            asm volatile("s_waitcnt vmcnt(0)" ::: "memory");
        } else {
            XB_SPIN(xb_ld(&bar[XB_XGEN(b.x)]) == gen, bar);
            __builtin_amdgcn_fence(__ATOMIC_ACQUIRE, "agent");
            asm volatile("s_waitcnt vmcnt(0)" ::: "memory");
        }
    }
    __syncthreads();
}

namespace pg8 {
constexpr int BM = 256, BK = 64, HALF = 128, HTB = HALF * BK * 2, STAGE_BYTES = 8 * HTB, NXCD = 8, WGM = 8;
__host__ __device__ __forceinline__ int lds_byte(int r, int c) { const int st = (r >> 4) * 2 + (c >> 5), rr = r & 15, cc = c & 31, ob = rr * 64 + cc * 2; return st * 1024 + (ob ^ (((ob >> 9) & 1) << 5)); }
__host__ __device__ __forceinline__ void stage_rc(int b, int& R, int& C) { const int st = b / 1024, sb = b % 1024, swz = sb ^ (((sb >> 9) & 1) << 5); R = (st >> 1) * 16 + swz / 64; C = (st & 1) * 32 + (swz % 64) / 2; }
__host__ __device__ __forceinline__ int perm32(int rho) { const int n = rho >> 4, i = rho & 15; return 8 * (i >> 2) + 4 * n + (i & 3); }
struct Unit { int pm, pn; };

__device__ __forceinline__ bool tile_order(long L, int nM, int nN, int& pm, int& pn) {
    const int nwg = nM * nN; if (L >= nwg) return false;
    int wgid = (int)L; { const int q = nwg / NXCD, r = nwg % NXCD, xcd = wgid % NXCD, off = wgid / NXCD; wgid = (xcd < r ? xcd * (q + 1) : r * (q + 1) + (xcd - r) * q) + off; }
    const int nig = WGM * nN, gid = wgid / nig, fm = gid * WGM, gsz = (nM - fm) < WGM ? (nM - fm) : WGM;
    pm = fm + ((wgid % nig) % gsz); pn = (wgid % nig) / gsz; return true;
}
__device__ __forceinline__ bool tile_order_rep(int i, int G, int c, int nM, int nN, int rep, int& pm, int& pn) {
    if (rep == 1) return tile_order((long)i * G + c, nM, nN, pm, pn);
    const int nwg = nM * nN, per = c < nwg ? (nwg - c + G - 1) / G : 0; if (i >= per * rep) return false;
    return tile_order((long)(i % per) * G + c, nM, nN, pm, pn);
}
struct DenseOrder {
    const bf16* A; const bf16* Bt; int lda, ldb, nM, nN, G, c, rep;
    __device__ __forceinline__ bool next(int i, Unit& u) const { return tile_order_rep(i, G, c, nM, nN, rep, u.pm, u.pn); }
    __device__ __forceinline__ const char* a_base(const Unit& u) const { return (const char*)A + (size_t)u.pm * BM * lda * 2; }
    __device__ __forceinline__ const char* b_base(const Unit& u) const { return (const char*)Bt + (size_t)u.pn * BM * ldb * 2; }
    __device__ __forceinline__ int tok(const Unit&, int) const { return 0; }
    __device__ __forceinline__ int ktiles(const Unit&, int nt) const { return nt; }
};

template <class Epi, class Sched, bool GATHER, int K, int lda, int ldb, bool SEGSCALE = false>
__device__ __forceinline__ void gemm_phase(LAS unsigned char* lds, const int tid, const Sched& S, const Epi& E, const float* ssq = nullptr) {
    const int wid = __builtin_amdgcn_readfirstlane(tid >> 6), lane = tid & 63, wr = wid >> 2, wc = wid & 3, fr = lane & 15, fq = lane >> 4;
    constexpr int nt = K / BK;
    unsigned voffA[2], voffB[2];
#pragma unroll
    for (int i = 0; i < 2; ++i) { int R, C; stage_rc(tid * 16 + i * 8192, R, C); const int Rb = Epi::PERM ? ((R & ~31) + perm32(R & 31)) : R;
        voffA[i] = (unsigned)(R * lda + C) * 2u; voffB[i] = (unsigned)(Rb * ldb + C) * 2u; }
#define PG8_GOFF(u_, h_, o0_, o1_) do { unsigned ones_ = ~0u; asm volatile("" : "+s"(ones_)); const int t_ = wid * 64 + (int)__builtin_amdgcn_mbcnt_hi(ones_, __builtin_amdgcn_mbcnt_lo(ones_, 0u)); \
        int R0_, C0_, R1_, C1_; stage_rc(t_ * 16, R0_, C0_); stage_rc(t_ * 16 + 8192, R1_, C1_); \
        o0_ = (unsigned)S.tok(u_, (h_) * HALF + R0_) * (unsigned)(lda * 2) + (unsigned)(C0_ * 2); o1_ = (unsigned)S.tok(u_, (h_) * HALF + R1_) * (unsigned)(lda * 2) + (unsigned)(C1_ * 2); } while (0)
    const size_t kstep = (size_t)(BK * 2);
    constexpr size_t hstepA = (size_t)HALF * lda * 2, hstepB = (size_t)HALF * ldb * 2;
    const unsigned ldsw = (unsigned)wid * 1024u;
    const int aoff = lds_byte(wr * 64 + fr, fq * 8), boff = lds_byte(wc * 32 + fr, fq * 8);
#define PG8_SA(b, h) (((b) * 2 + (h)) * HTB)
#define PG8_SB(b, h) ((4 + (b) * 2 + (h)) * HTB)
#define PG8_STAGE(bufoff, gbase, v0, v1) do { \
        __builtin_amdgcn_global_load_lds((const unsigned*)((const char*)(gbase) + (v0)), (LAS unsigned*)(lds + (bufoff) + ldsw), 16, 0, 0); \
        __builtin_amdgcn_global_load_lds((const unsigned*)((const char*)(gbase) + (v1)), (LAS unsigned*)(lds + (bufoff) + ldsw + 8192), 16, 0, 0); } while (0)
#define PG8_STB(bufoff, gbase) PG8_STAGE(bufoff, gbase, voffB[0], voffB[1])
#define PG8_STA(bufoff, gbase, h, G0, G1) do { if constexpr (GATHER) PG8_STAGE(bufoff, gbase, G0, G1); else PG8_STAGE(bufoff, (gbase) + (h) * hstepA, voffA[0], voffA[1]); } while (0)
#define PG8_LDA(dst, b, h) do { _Pragma("unroll") for (int m = 0; m < 4; ++m) _Pragma("unroll") for (int k = 0; k < 2; ++k) dst[m][k] = *(const LAS bf16x8*)(lds + PG8_SA(b, h) + aoff + m * 2048 + k * 1024); } while (0)
#define PG8_LDB(dst, b, h) do { _Pragma("unroll") for (int n = 0; n < 2; ++n) _Pragma("unroll") for (int k = 0; k < 2; ++k) dst[n][k] = *(const LAS bf16x8*)(lds + PG8_SB(b, h) + boff + n * 2048 + k * 1024); } while (0)
#define PG8_MMA(ai, bj, At, Bt) do { __builtin_amdgcn_s_setprio(1); _Pragma("unroll") for (int m = 0; m < 4; ++m) _Pragma("unroll") for (int n = 0; n < 2; ++n) _Pragma("unroll") for (int k = 0; k < 2; ++k) \
        acc[ai][bj][m][n] = __builtin_amdgcn_mfma_f32_16x16x32_bf16(Bt[n][k], At[m][k], acc[ai][bj][m][n], 0, 0, 0); __builtin_amdgcn_s_setprio(0); } while (0)
#define PG8_WAIT_V(n) asm volatile("s_waitcnt vmcnt(" #n ")" ::: "memory")
#define PG8_WAIT_L(n) asm volatile("s_waitcnt lgkmcnt(" #n ")" ::: "memory")
#define PG8_BAR __builtin_amdgcn_s_barrier()
#define PG8_SCHED __builtin_amdgcn_sched_barrier(0)
    Unit cur, nxt; int ui = 0;
    if (!S.next(0, cur)) return;
    f32x4 acc[2][2][4][2];
#pragma unroll
    for (int a = 0; a < 2; ++a)
#pragma unroll
        for (int b = 0; b < 2; ++b)
#pragma unroll
            for (int m = 0; m < 4; ++m)
#pragma unroll
                for (int n = 0; n < 2; ++n) acc[a][b][m][n] = (f32x4){0.f, 0.f, 0.f, 0.f};
    bf16x8 At[4][2], B0[2][2], B1[2][2];
    const char* cA = S.a_base(cur); const char* cB = S.b_base(cur);
    unsigned gc00 = 0, gc01 = 0, gc10 = 0, gc11 = 0, gn00 = 0, gn01 = 0, gn10 = 0, gn11 = 0;
    if constexpr (GATHER) { PG8_GOFF(cur, 0, gc00, gc01); PG8_GOFF(cur, 1, gc10, gc11); }
    PG8_STB(PG8_SB(0, 0), cB); PG8_STB(PG8_SB(0, 1), cB + hstepB); PG8_STA(PG8_SA(0, 0), cA, 0, gc00, gc01); PG8_STA(PG8_SA(0, 1), cA, 1, gc10, gc11);
    if (wr == 1) PG8_BAR;
    PG8_WAIT_V(2); PG8_BAR;
    PG8_STB(PG8_SB(1, 0), cB + kstep); PG8_STA(PG8_SA(1, 0), cA + kstep, 0, gc00, gc01); PG8_STB(PG8_SB(1, 1), cB + hstepB + kstep);
    PG8_WAIT_V(6); PG8_BAR;
    for (;;) {
        const bool has_next = S.next(ui + 1, nxt);
        const char* nA = has_next ? S.a_base(nxt) : cA; const char* nB = has_next ? S.b_base(nxt) : cB;
        if constexpr (SEGSCALE) {
            if (tid < 256) { const f32x4* sp = (const f32x4*)(ssq + (size_t)(cur.pm * 256 + tid) * 12); const f32x4 a = sp[0], b = sp[1], c = sp[2];
                const float sm = ((a[0] + a[1]) + (a[2] + a[3])) + ((b[0] + b[1]) + (b[2] + b[3])), sf = (c[0] + c[1]) + (c[2] + c[3]);
                const float rm = 1.0f / sqrtf(sm * (1.0f / 512) + EPS), rf = 1.0f / sqrtf(sf * (1.0f / 256) + EPS);
                *(LAS f32x2*)(lds + STAGE_BYTES + 1024 + tid * 8) = (f32x2){rm / rf, rf}; }
        }
        if constexpr (GATHER) {
            if (has_next) { PG8_GOFF(nxt, 0, gn00, gn01); PG8_GOFF(nxt, 1, gn10, gn11); }
            else { gn00 = gc00; gn01 = gc01; gn10 = gc10; gn11 = gc11; }
        }
        const int ntu = S.ktiles(cur, nt);
#pragma nounroll
        for (int t = 0; t < ntu; t += 2) {
            const bool last = (t == ntu - 2);
            const char* a1 = cA + (size_t)(t + 1) * kstep;
            const char* a2 = last ? nA : cA + (size_t)(t + 2) * kstep; const char* b2 = last ? nB : cB + (size_t)(t + 2) * kstep;
            const char* a3 = a2 + kstep; const char* b3 = b2 + kstep;
            const unsigned g00 = last ? gn00 : gc00, g01 = last ? gn01 : gc01, g10 = last ? gn10 : gc10, g11 = last ? gn11 : gc11;
            PG8_LDB(B0, 0, 0); PG8_LDB(B1, 0, 1); PG8_SCHED; PG8_LDA(At, 0, 0); PG8_STA(PG8_SA(1, 1), a1, 1, gc10, gc11);
            PG8_WAIT_V(8); PG8_WAIT_L(0); PG8_BAR; PG8_MMA(0, 0, At, B0); PG8_MMA(0, 1, At, B1); PG8_BAR; PG8_SCHED;
            PG8_LDA(At, 0, 1); PG8_STB(PG8_SB(0, 0), b2); PG8_STB(PG8_SB(0, 1), b2 + hstepB); PG8_STA(PG8_SA(0, 0), a2, 0, g00, g01);
            PG8_WAIT_V(8); PG8_WAIT_L(0); PG8_BAR; PG8_MMA(1, 0, At, B0); PG8_MMA(1, 1, At, B1); PG8_BAR; PG8_SCHED;
            PG8_LDB(B0, 1, 0); PG8_LDB(B1, 1, 1); PG8_SCHED; PG8_LDA(At, 1, 0); PG8_STA(PG8_SA(0, 1), a2, 1, g10, g11);
            PG8_WAIT_V(8); PG8_WAIT_L(0); PG8_BAR; PG8_MMA(0, 0, At, B0); PG8_MMA(0, 1, At, B1); PG8_BAR; PG8_SCHED;
            PG8_LDA(At, 1, 1); PG8_STB(PG8_SB(1, 0), b3); PG8_STB(PG8_SB(1, 1), b3 + hstepB); PG8_STA(PG8_SA(1, 0), a3, 0, g00, g01);
            PG8_WAIT_V(8); PG8_WAIT_L(0); PG8_BAR; PG8_MMA(1, 0, At, B0); PG8_MMA(1, 1, At, B1); PG8_BAR; PG8_SCHED;
            if constexpr (SEGSCALE) {
                if (t == 6 || t == 10) {
                    unsigned ones_ = ~0u; asm volatile("" : "+s"(ones_)); const int fr_ = (int)__builtin_amdgcn_mbcnt_hi(ones_, __builtin_amdgcn_mbcnt_lo(ones_, 0u)) & 15;
                    const LAS float* fp = (const LAS float*)(lds + STAGE_BYTES + 1024) + (wr * 64 + fr_) * 2 + (t == 10 ? 1 : 0);
#pragma unroll
                    for (int ai = 0; ai < 2; ++ai)
#pragma unroll
                        for (int m = 0; m < 4; ++m) { const float f = fp[(ai * 128 + m * 16) * 2];
#pragma unroll
                            for (int bj = 0; bj < 2; ++bj)
#pragma unroll
                                for (int n = 0; n < 2; ++n) acc[ai][bj][m][n] *= f; }
                    PG8_SCHED;
                }
            }
        }
        if (wr == 0) PG8_BAR;
        { unsigned ones_ = ~0u; asm volatile("" : "+s"(ones_)); const int l_ = (int)__builtin_amdgcn_mbcnt_hi(ones_, __builtin_amdgcn_mbcnt_lo(ones_, 0u)); E(acc, cur, wr, wc, l_ & 15, l_ >> 4); }
        if (!has_next) break;
#pragma unroll
        for (int a = 0; a < 2; ++a)
#pragma unroll
            for (int b = 0; b < 2; ++b)
#pragma unroll
                for (int m = 0; m < 4; ++m)
#pragma unroll
                    for (int n = 0; n < 2; ++n) acc[a][b][m][n] = (f32x4){0.f, 0.f, 0.f, 0.f};
        cur = nxt; cA = nA; cB = nB; ++ui;
        if constexpr (GATHER) { gc00 = gn00; gc01 = gn01; gc10 = gn10; gc11 = gn11; }
        if (wr == 1) PG8_BAR;
    }
    PG8_WAIT_V(0);
    PG8_BAR;
#undef PG8_GOFF
#undef PG8_SA
#undef PG8_SB
#undef PG8_STAGE
#undef PG8_STB
#undef PG8_STA
#undef PG8_LDA
#undef PG8_LDB
#undef PG8_MMA
#undef PG8_WAIT_V
#undef PG8_WAIT_L
#undef PG8_BAR
#undef PG8_SCHED
}
}

#define EPI_ROWS_BEGIN _Pragma("unroll") for (int ai = 0; ai < 2; ++ai) _Pragma("unroll") for (int m = 0; m < 4; ++m) { const unsigned row = (unsigned)(u.pm * 256 + ai * 128 + wr * 64 + m * 16 + fr);
#define EPI_ROWS_END asm volatile("" ::: "memory"); }
__device__ __forceinline__ void st16(void* base, unsigned off, u32x4 v) { *(u32x4*)((char*)base + off) = v; }
struct EpiInProj {
    static constexpr bool PERM = true;
    bf16* CQ; bf16* CKV; float* KR; float* FL; bf16* FQ; bf16* CI;
    __device__ __forceinline__ void operator()(const f32x4 (&acc)[2][2][4][2], const pg8::Unit& u, int wr, int wc, int fr, int fq) const {
        const int t = u.pn; const unsigned c8 = (unsigned)(wc * 32 + 8 * fq);
        if (t != 1) {
            bf16* base; unsigned ld;
            if (t == 0) { base = CQ; ld = 256; } else if (t <= 4) { base = FQ + (size_t)(t - 2) * M * 256; ld = 256; } else { base = CI + (t - 5) * 256; ld = 512; }
            EPI_ROWS_BEGIN
                const unsigned off = (row * ld + c8) * 2u;
                st16(base, off, pack8(acc[ai][0][m][0], acc[ai][0][m][1]));
                st16(base, off + 256u, pack8(acc[ai][1][m][0], acc[ai][1][m][1]));
            EPI_ROWS_END
        } else {
            EPI_ROWS_BEGIN
                const unsigned off = (row * 256u + c8) * 2u;
                st16(CKV, off, pack8(acc[ai][0][m][0], acc[ai][0][m][1]));
                if (c8 < 32) { const unsigned ko = (row * 32u + c8) * 4u; *(f32x4*)((char*)KR + ko) = acc[ai][1][m][0]; *(f32x4*)((char*)KR + ko + 16) = acc[ai][1][m][1]; }
                else if (c8 == 32) { *(f32x4*)((char*)FL + row * 16u) = acc[ai][1][m][0]; }
            EPI_ROWS_END
        }
    }
};
struct EpiQKV {
    static constexpr bool PERM = true;
    bf16* QM; bf16* KM; bf16* VM; const float* COS; const float* SIN;
    __device__ __forceinline__ void operator()(const f32x4 (&acc)[2][2][4][2], const pg8::Unit& u, int wr, int wc, int fr, int fq) const {
        const int t = u.pn; const unsigned c8 = (unsigned)(wc * 32 + 8 * fq);
        if (t < 3) {
#pragma unroll
            for (int bj = 0; bj < 2; ++bj) {
                const unsigned col = (unsigned)(t * 256 + bj * 128) + c8, h = col / 96u, d = col - h * 96u;
                const bool rope = d >= 64; const unsigned f4 = rope ? ((d - 64) >> 1) : 0u;
#pragma unroll
                for (int ai = 0; ai < 2; ++ai) {
                    f32x4 cc[4], ss[4];
                    if (rope) {
#pragma unroll
                        for (int m = 0; m < 4; ++m) { const unsigned to = ((unsigned)(u.pm * 256 + ai * 128 + wr * 64 + m * 16 + fr) * 16u + f4) * 4u;
                            cc[m] = *(const f32x4*)((const char*)COS + to); ss[m] = *(const f32x4*)((const char*)SIN + to); }
                    }
#pragma unroll
                    for (int m = 0; m < 4; ++m) { const unsigned row = (unsigned)(u.pm * 256 + ai * 128 + wr * 64 + m * 16 + fr);
                        f32x4 v0 = acc[ai][bj][m][0], v1 = acc[ai][bj][m][1];
                        if (rope) {
                            const f32x4 c = cc[m], s = ss[m], a = v0, b = v1;
                            v0 = (f32x4){a[0] * c[0] - a[2] * s[0], a[1] * c[1] - a[3] * s[1], a[0] * s[0] + a[2] * c[0], a[1] * s[1] + a[3] * c[1]};
                            v1 = (f32x4){b[0] * c[2] - b[2] * s[2], b[1] * c[3] - b[3] * s[3], b[0] * s[2] + b[2] * c[2], b[1] * s[3] + b[3] * c[3]};
                        }
                        st16(QM, (row * 768u + col) * 2u, pack8(v0, v1));
                    }
                    asm volatile("" ::: "memory");
                }
            }
        } else if (t < 5) {
#pragma unroll
            for (int bj = 0; bj < 2; ++bj) {
                const unsigned kc = (unsigned)((t - 3) * 256 + bj * 128) + c8, h = kc >> 6, d = kc & 63;
                EPI_ROWS_BEGIN
                    st16(KM, (row * 768u + h * 96u + d) * 2u, pack8(acc[ai][bj][m][0], acc[ai][bj][m][1]));
                EPI_ROWS_END
            }
        } else {
#pragma unroll
            for (int bj = 0; bj < 2; ++bj) {
                const unsigned vc = (unsigned)((t - 5) * 256 + bj * 128) + c8;
                EPI_ROWS_BEGIN
                    st16(VM, (row * 512u + vc) * 2u, pack8(acc[ai][bj][m][0], acc[ai][bj][m][1]));
                EPI_ROWS_END
            }
        }
    }
};
template <int LDC, bool SCALE>
struct EpiBf16 {
    static constexpr bool PERM = true;
    bf16* O; int ntn; const float* rowscale;
    __device__ __forceinline__ void operator()(const f32x4 (&acc)[2][2][4][2], const pg8::Unit& u, int wr, int wc, int fr, int fq) const {
        const unsigned col = (unsigned)((u.pn % ntn) * 256 + wc * 32 + 8 * fq);
        float sc8[8];
        if constexpr (SCALE) {
#pragma unroll
            for (int i = 0; i < 8; ++i) sc8[i] = *(const float*)((const char*)rowscale + (unsigned)(u.pm * 256 + (i >> 2) * 128 + wr * 64 + (i & 3) * 16 + fr) * 4u);
        }
        EPI_ROWS_BEGIN
            float s = 1.0f; if constexpr (SCALE) s = sc8[ai * 4 + m];
            const unsigned off = (row * (unsigned)LDC + col) * 2u;
            st16(O, off, pack8(acc[ai][0][m][0] * s, acc[ai][0][m][1] * s));
            st16(O, off + 256u, pack8(acc[ai][1][m][0] * s, acc[ai][1][m][1] * s));
        EPI_ROWS_END
    }
};
template <int LDH>
struct EpiSwiGLU {
    static constexpr bool PERM = true;
    bf16* H; int ntn;
    __device__ __forceinline__ void operator()(const f32x4 (&acc)[2][2][4][2], const pg8::Unit& u, int wr, int wc, int fr, int fq) const {
        const unsigned col = (unsigned)((u.pn % ntn) * 128 + wc * 32 + 8 * fq);
        EPI_ROWS_BEGIN
            f32x4 a0 = acc[ai][0][m][0], a1 = acc[ai][0][m][1]; const f32x4 b0 = acc[ai][1][m][0], b1 = acc[ai][1][m][1];
#pragma unroll
            for (int j = 0; j < 4; ++j) { a0[j] = siluf_(a0[j]) * b0[j]; a1[j] = siluf_(a1[j]) * b1[j]; }
            st16(H, (row * (unsigned)LDH + col) * 2u, pack8(a0, a1));
        EPI_ROWS_END
    }
};
struct MoeOrder {
    const bf16* A; const bf16* Bt; int lda, ldb, nM, nN, G, c, rep; const int* slot_tok; int s1, s2, s3, s4, s5, s6, s7;
    __device__ __forceinline__ int expert_of(int rt) const { const int r = rt * 256; return (r >= s1) + (r >= s2) + (r >= s3) + (r >= s4) + (r >= s5) + (r >= s6) + (r >= s7); }
    __device__ __forceinline__ bool next(int i, pg8::Unit& u) const { int pm, pn; if (!pg8::tile_order_rep(i, G, c, nM, nN, rep, pm, pn)) return false; u.pm = pm; u.pn = expert_of(pm) * nN + pn; return true; }
    __device__ __forceinline__ const char* a_base(const pg8::Unit& u) const { return slot_tok ? (const char*)A : (const char*)A + (size_t)u.pm * 256 * lda * 2; }
    __device__ __forceinline__ const char* b_base(const pg8::Unit& u) const { return (const char*)Bt + (size_t)u.pn * 256 * ldb * 2; }
    __device__ __forceinline__ int tok(const pg8::Unit& u, int r) const { return slot_tok[u.pm * 256 + r]; }
    __device__ __forceinline__ int ktiles(const pg8::Unit&, int nt) const { return nt; }
};

namespace att {
__device__ __forceinline__ int crow(int r, int hi) { return (r & 3) + 8 * (r >> 2) + 4 * hi; }
__device__ __forceinline__ s16x4 vtr(const LAS unsigned char* p) { typedef short v4i16_t __attribute__((ext_vector_type(4))); return __builtin_bit_cast(s16x4, __builtin_amdgcn_ds_read_tr16_b64_v4i16((LAS v4i16_t*)p)); }
#define ATT_WAITBAR() asm volatile("s_waitcnt vmcnt(0) lgkmcnt(0)\n\ts_barrier" ::: "memory")
__device__ __forceinline__ void glds16(const void* gsrc, unsigned lds_dst) { unsigned keep;
    asm volatile("s_mov_b32 %0, m0\n\ts_mov_b32 m0, %2\n\ts_nop 0\n\tglobal_load_lds_dwordx4 %1, off\n\ts_mov_b32 m0, %0" : "=&s"(keep) : "v"(gsrc), "s"(lds_dst) : "memory"); }

#define MX3(a, b, c) __builtin_fmaxf(__builtin_fmaxf((a), (b)), (c))
template <int DQK> struct AttLds { static constexpr int NCH = DQK / 8, KSLOT = NCH * 1024, ND0 = DQK / 16, LK = 0, LV = 3 * KSLOT, LOST = LV + 3 * 8192, LCUM = LOST + NWAVES * 4608, END = LCUM + SEQ * 4; };

template <int DQK>
__device__ __forceinline__ void att_qk(f32x16& n0, f32x16& n1, const bf16x8 (&qr)[DQK / 16], const LAS unsigned char* kp) {
    constexpr int ND0 = DQK / 16;
    bf16x8 kf[2 * ND0];
#pragma unroll
    for (int d0 = 0; d0 < ND0; ++d0) { kf[2 * d0] = *(const LAS bf16x8*)(kp + d0 * 2048); kf[2 * d0 + 1] = *(const LAS bf16x8*)(kp + d0 * 2048 + 512); }
    n0 = (f32x16){}; n1 = (f32x16){};
#pragma unroll
    for (int d0 = 0; d0 < ND0; ++d0) {
        n0 = __builtin_amdgcn_mfma_f32_32x32x16_bf16(kf[2 * d0], qr[d0], n0, 0, 0, 0);
        n1 = __builtin_amdgcn_mfma_f32_32x32x16_bf16(kf[2 * d0 + 1], qr[d0], n1, 0, 0, 0);
    }
}
template <bool BIAS, bool MASK>
__device__ __forceinline__ void att_bias_mask(f32x16& n0, f32x16& n1, int t, int NT, int qrel, int hi, float fqb, const LAS float* cumL) {
    if constexpr (BIAS) {
#pragma unroll
        for (int g = 0; g < 4; ++g) {
            const f32x4 f0 = *(const LAS f32x4*)(cumL + t * 64 + 8 * g + 4 * hi), f1 = *(const LAS f32x4*)(cumL + t * 64 + 32 + 8 * g + 4 * hi);
#pragma unroll
            for (int j = 0; j < 4; ++j) { n0[4 * g + j] += fqb - f0[j]; n1[4 * g + j] += fqb - f1[j]; }
        }
    }
    if constexpr (MASK) {
        const int kb = 64 * (t - (NT - 4)) + 4 * hi;
#pragma unroll
        for (int r = 0; r < 16; ++r) { const int kv = kb + (r & 3) + 8 * (r >> 2); if (kv > qrel) n0[r] = -INFINITY; if (kv + 32 > qrel) n1[r] = -INFINITY; }
    }
}
template <int DQK, bool BIAS, bool MASK, bool MORE>
__device__ __forceinline__ void att_step(f32x16& s0, f32x16& s1, f32x16& n0, f32x16& n1, f32x16& o0, f32x16& o1, float& mrow, float& lrow, const bf16x8 (&qr)[DQK / 16],
                                         int t, int NT, int qrel, int lane, int hi, int r32, float fqb, const LAS unsigned char* shm, int vslot, int kslot) {
    typedef AttLds<DQK> L;
    constexpr int ND0 = DQK / 16;
    const LAS unsigned char* vp = shm + L::LV + vslot * 8192 + ((lane >> 4) & 1) * 32 + (lane & 3) * 8 + (4 * hi + ((lane & 15) >> 2)) * 64;
    const LAS unsigned char* kp = shm + L::LK + kslot * L::KSLOT + hi * 1024 + r32 * 16;
    bf16x8 kf[2 * ND0];
    if constexpr (MORE) {
#pragma unroll
        for (int d0 = 0; d0 < ND0; ++d0) { kf[2 * d0] = *(const LAS bf16x8*)(kp + d0 * 2048); kf[2 * d0 + 1] = *(const LAS bf16x8*)(kp + d0 * 2048 + 512); }
    }
    float a = MX3(s0[0], s0[1], s1[0]), b = MX3(s0[2], s0[3], s1[1]); a = MX3(a, s1[2], s1[3]);
#pragma unroll
    for (int r = 4; r < 16; r += 4) { a = MX3(a, s0[r], s0[r + 1]); b = MX3(b, s0[r + 2], s0[r + 3]); a = MX3(a, s1[r], s1[r + 1]); b = MX3(b, s1[r + 2], s1[r + 3]); }
    float rm = __builtin_fmaxf(a, b);
    { auto rr = __builtin_amdgcn_permlane32_swap(__float_as_uint(rm), __float_as_uint(rm), false, false); rm = __builtin_fmaxf(__uint_as_float(rr[0]), __uint_as_float(rr[1])); }
    if (__builtin_amdgcn_ballot_w64(rm > mrow + 8.0f) != 0ull) {
        const float mnew = __builtin_fmaxf(mrow, rm), alpha = fexp2(mrow - mnew);
        mrow = mnew; lrow *= alpha;
#pragma unroll
        for (int r = 0; r < 16; ++r) { o0[r] *= alpha; o1[r] *= alpha; }
    }
    if constexpr (MORE) {
        n0 = (f32x16){}; n1 = (f32x16){};
#pragma unroll
        for (int d0 = 0; d0 < ND0; ++d0) {
            n0 = __builtin_amdgcn_mfma_f32_32x32x16_bf16(kf[2 * d0], qr[d0], n0, 0, 0, 0);
            n1 = __builtin_amdgcn_mfma_f32_32x32x16_bf16(kf[2 * d0 + 1], qr[d0], n1, 0, 0, 0);
        }
    }
    float ps = 0.f;
#pragma unroll
    for (int r = 0; r < 16; ++r) { s0[r] = fexp2(s0[r] - mrow); s1[r] = fexp2(s1[r] - mrow); ps += s0[r] + s1[r]; }
    lrow += ps;
    __builtin_amdgcn_sched_barrier(0);
    s16x4 vl[8], vh[8];
#pragma unroll
    for (int i = 0; i < 8; ++i) { vl[i] = vtr(vp + (i >> 2) * 4096 + (i & 3) * 1024); vh[i] = vtr(vp + (i >> 2) * 4096 + (i & 3) * 1024 + 512); }
    u32x4 pw[4];
    pw[0] = (u32x4){pk2(s0[0], s0[1]), pk2(s0[2], s0[3]), pk2(s0[4], s0[5]), pk2(s0[6], s0[7])};
    pw[1] = (u32x4){pk2(s0[8], s0[9]), pk2(s0[10], s0[11]), pk2(s0[12], s0[13]), pk2(s0[14], s0[15])};
    pw[2] = (u32x4){pk2(s1[0], s1[1]), pk2(s1[2], s1[3]), pk2(s1[4], s1[5]), pk2(s1[6], s1[7])};
    pw[3] = (u32x4){pk2(s1[8], s1[9]), pk2(s1[10], s1[11]), pk2(s1[12], s1[13]), pk2(s1[14], s1[15])};
#pragma unroll
    for (int ks = 0; ks < 4; ++ks) {
        const bf16x8 v0 = (bf16x8){vl[ks][0], vl[ks][1], vl[ks][2], vl[ks][3], vh[ks][0], vh[ks][1], vh[ks][2], vh[ks][3]};
        const bf16x8 v1 = (bf16x8){vl[4 + ks][0], vl[4 + ks][1], vl[4 + ks][2], vl[4 + ks][3], vh[4 + ks][0], vh[4 + ks][1], vh[4 + ks][2], vh[4 + ks][3]};
        o0 = __builtin_amdgcn_mfma_f32_32x32x16_bf16(v0, __builtin_bit_cast(bf16x8, pw[ks]), o0, 0, 0, 0);
        o1 = __builtin_amdgcn_mfma_f32_32x32x16_bf16(v1, __builtin_bit_cast(bf16x8, pw[ks]), o1, 0, 0, 0);
    }
    if constexpr (MORE) att_bias_mask<BIAS, MASK>(n0, n1, t + 1, NT, qrel, hi, fqb, (const LAS float*)(shm + L::LCUM));
}

template <int DQK, bool BIAS>
__device__ __forceinline__ void attn_unit(int b, int h, int qb, const bf16* Q, int pq, const bf16* K, int pk, const bf16* V, int pv,
                                          bf16* O, int po, int ocol, const float* cum, LAS unsigned char* shm, const int tid_in, float* ssqp, int hidx, const unsigned* qkmax) {
    int tid = tid_in; asm volatile("" : "+v"(tid));
    typedef AttLds<DQK> L;
    constexpr int NCH = L::NCH, KSLOT = L::KSLOT, ND0 = L::ND0, LK = L::LK, LV = L::LV, LOST = L::LOST;
    static_assert(L::END <= RING_BYTES, "attention LDS");
    const int lane = tid & 63, r32 = lane & 31, hi = lane >> 5; const int wid = __builtin_amdgcn_readfirstlane(tid >> 6);
    const long rowbase = (long)b * SEQ; const int q0 = qb * 256;
    const bf16* Qw = Q + (rowbase + q0 + wid * 32) * pq + h * DQK;
    const bf16* Kh = K + rowbase * pk + h * DQK; const bf16* Vh = V + rowbase * pv + h * 64;
    const int NT = (q0 + 256) / 64;
    LAS float* cumL = (LAS float*)(shm + L::LCUM);
    if constexpr (BIAS) { const float* cs = cum + (size_t)(b * 4 + h) * SEQ; for (int i = tid * 4; i < q0 + 256; i += NTHR * 4) *(LAS f32x4*)(cumL + i) = *(const f32x4*)(cs + i); }
    const bf16* ksrc = Kh + (long)lane * pk + wid * 8;
    const bf16* vsrc = Vh + (long)(16 * (wid & 3) + (lane >> 2)) * pv + (wid >> 2) * 32 + (lane & 3) * 8;
    const unsigned lds0 = (unsigned)(size_t)shm;
#define ATT_DMA_K(t, slot) do { \
        glds16(ksrc + (long)(t) * 64 * pk, (unsigned)__builtin_amdgcn_readfirstlane((int)(lds0 + LK + (slot) * KSLOT + wid * 1024))); \
        if (NCH > 8 && wid + 8 < NCH) glds16(ksrc + (long)(t) * 64 * pk + 64, (unsigned)__builtin_amdgcn_readfirstlane((int)(lds0 + LK + (slot) * KSLOT + (wid + 8) * 1024))); } while (0)
#define ATT_DMA_V(t, slot) glds16(vsrc + (long)(t) * 64 * pv, (unsigned)__builtin_amdgcn_readfirstlane((int)(lds0 + LV + (slot) * 8192 + wid * 1024)))
    const int nK = (NCH > 8 && wid + 8 < NCH) ? 2 : 1;
#define ATT_WAITBAR_N(n) do { const int n_ = (n); if (n_ == 0) asm volatile("s_waitcnt vmcnt(0) lgkmcnt(0)\n\ts_barrier" ::: "memory"); else if (n_ == 1) asm volatile("s_waitcnt vmcnt(1) lgkmcnt(0)\n\ts_barrier" ::: "memory"); \
        else if (n_ == 2) asm volatile("s_waitcnt vmcnt(2) lgkmcnt(0)\n\ts_barrier" ::: "memory"); else asm volatile("s_waitcnt vmcnt(3) lgkmcnt(0)\n\ts_barrier" ::: "memory"); } while (0)
    int tb = 0;
    if constexpr (BIAS) {
        const float qk = sqrtf(__uint_as_float(qkmax[0]) * __uint_as_float(qkmax[1])) * 1.01f + 1.0f, thr = -(150.0f + 2.0f * qk);
        const float* cs = cum + (size_t)(b * 4 + h) * SEQ; const float f0 = cs[q0]; const float fj = lane < NT ? cs[64 * lane + 63] : f0;
        const unsigned long long keep = __builtin_amdgcn_ballot_w64(lane < NT && (f0 - fj) >= thr);
        tb = keep ? (int)__builtin_ctzll(keep) : NT - 4; if (tb > NT - 4) tb = NT - 4;
        tb = __builtin_amdgcn_readfirstlane(tb);
    }
    ATT_DMA_K(tb, 0); ATT_DMA_V(tb, 0); ATT_DMA_K(tb + 1, 1);
    bf16x8 qr[ND0];
#pragma unroll
    for (int d0 = 0; d0 < ND0; ++d0) qr[d0] = *(const bf16x8*)(Qw + (long)r32 * pq + d0 * 16 + hi * 8);
    float mrow = -1e30f, lrow = 0.f; f32x16 o0 = {}, o1 = {};
    const int qrel = wid * 32 + r32;
    ATT_WAITBAR();
#pragma unroll
    for (int d0 = 0; d0 < ND0; ++d0) asm volatile("" : "+v"(qr[d0]));
    ATT_DMA_K(tb + 2, 2); ATT_DMA_V(tb + 1, 1);
    float fqb = 0.f; if constexpr (BIAS) fqb = cumL[q0 + qrel];
    f32x16 s0, s1;
    att_qk<DQK>(s0, s1, qr, shm + LK + hi * 1024 + r32 * 16);
    asm volatile("s_waitcnt lgkmcnt(0)\n\ts_barrier" ::: "memory");
    if (tb == NT - 4) att_bias_mask<BIAS, true>(s0, s1, tb, NT, qrel, hi, fqb, cumL); else att_bias_mask<BIAS, false>(s0, s1, tb, NT, qrel, hi, fqb, cumL);
    int t = tb, sl0 = 0, sl1 = 1, sl2 = 2;
#define ATT_ROT() do { const int x_ = sl0; sl0 = sl1; sl1 = sl2; sl2 = x_; } while (0)
    f32x16 u0, u1;
    for (; t + 1 < NT - 5; t += 2) {
        ATT_DMA_K(t + 3, sl0); ATT_DMA_V(t + 2, sl2);
        att_step<DQK, BIAS, false, true>(s0, s1, u0, u1, o0, o1, mrow, lrow, qr, t, NT, qrel, lane, hi, r32, fqb, shm, sl0, sl1);
        ATT_WAITBAR_N(nK + 1); ATT_ROT();
        ATT_DMA_K(t + 4, sl0); ATT_DMA_V(t + 3, sl2);
        att_step<DQK, BIAS, false, true>(u0, u1, s0, s1, o0, o1, mrow, lrow, qr, t + 1, NT, qrel, lane, hi, r32, fqb, shm, sl0, sl1);
        ATT_WAITBAR_N(nK + 1); ATT_ROT();
    }
    for (; t < NT - 5; ++t) {
        ATT_DMA_K(t + 3, sl0); ATT_DMA_V(t + 2, sl2);
        att_step<DQK, BIAS, false, true>(s0, s1, u0, u1, o0, o1, mrow, lrow, qr, t, NT, qrel, lane, hi, r32, fqb, shm, sl0, sl1);
        s0 = u0; s1 = u1;
        ATT_WAITBAR_N(nK + 1); ATT_ROT();
    }
    for (; t < NT - 1; ++t) {
        int nis = 0;
        if (t + 3 < NT) { ATT_DMA_K(t + 3, sl0); nis += nK; }
        if (t + 2 < NT) { ATT_DMA_V(t + 2, sl2); nis += 1; }
        const int jbc = t - (NT - 4); const bool docur = !(jbc >= 0 && 2 * jbc > wid), donext = !(2 * (jbc + 1) > wid);
        if (docur && donext) { att_step<DQK, BIAS, true, true>(s0, s1, u0, u1, o0, o1, mrow, lrow, qr, t, NT, qrel, lane, hi, r32, fqb, shm, sl0, sl1); s0 = u0; s1 = u1; }
        else if (docur) att_step<DQK, BIAS, false, false>(s0, s1, u0, u1, o0, o1, mrow, lrow, qr, t, NT, qrel, lane, hi, r32, fqb, shm, sl0, sl1);
        ATT_WAITBAR_N(nis); ATT_ROT();
    }
    if (!(2 * 3 > wid)) att_step<DQK, BIAS, false, false>(s0, s1, u0, u1, o0, o1, mrow, lrow, qr, t, NT, qrel, lane, hi, r32, fqb, shm, sl0, sl1);
#undef ATT_ROT
#undef ATT_WAITBAR_N
    { auto rr = __builtin_amdgcn_permlane32_swap(__float_as_uint(lrow), __float_as_uint(lrow), false, false); lrow = __uint_as_float(rr[0]) + __uint_as_float(rr[1]); }
    const float rl = frcp(lrow);
    { float ssq = 0.f;
#pragma unroll
      for (int r = 0; r < 16; ++r) { const float a = o0[r] * rl, b2 = o1[r] * rl; ssq += a * a + b2 * b2; }
      auto rr = __builtin_amdgcn_permlane32_swap(__float_as_uint(ssq), __float_as_uint(ssq), false, false); ssq = __uint_as_float(rr[0]) + __uint_as_float(rr[1]);
      if (hi == 0) ssqp[(size_t)(rowbase + q0 + wid * 32 + r32) * 12 + hidx] = ssq; }
    LAS unsigned char* stg = shm + LOST + wid * 4608;
#pragma unroll
    for (int g = 0; g < 4; ++g) {
        *(LAS u32x2*)(stg + r32 * 144 + (8 * g + 4 * hi) * 2) = (u32x2){pk2(o0[4 * g] * rl, o0[4 * g + 1] * rl), pk2(o0[4 * g + 2] * rl, o0[4 * g + 3] * rl)};
        *(LAS u32x2*)(stg + r32 * 144 + (32 + 8 * g + 4 * hi) * 2) = (u32x2){pk2(o1[4 * g] * rl, o1[4 * g + 1] * rl), pk2(o1[4 * g + 2] * rl, o1[4 * g + 3] * rl)};
    }
    asm volatile("s_waitcnt lgkmcnt(0)" ::: "memory");
    bf16* Ow = O + (rowbase + q0 + wid * 32) * po + ocol;
#pragma unroll
    for (int i = 0; i < 4; ++i) { const int row = i * 8 + (lane >> 3), ch = lane & 7; const u32x4 v = *(const LAS u32x4*)(stg + row * 144 + ch * 16); *(u32x4*)(Ow + (long)row * po + ch * 8) = v; }
    asm volatile("s_waitcnt lgkmcnt(0)\n\ts_barrier" ::: "memory");
#undef ATT_DMA_K
#undef ATT_DMA_V
}
}

struct Args { const float* in[26]; float* out; unsigned char* ws; int ph_lo, ph_hi; };
typedef const __attribute__((address_space(4))) Args* kargs_t;
struct Ctx {
    LAS unsigned char* lds; unsigned* ctl; unsigned char* ws; float* out;
    int tid, lane, wave, vcu, G, gw, NGW, bx;
};
__device__ __forceinline__ kargs_t opaque_args() { kargs_t p = (kargs_t)__builtin_amdgcn_kernarg_segment_ptr(); asm volatile("" : "+s"(p)); return p; }
__device__ __forceinline__ Ctx make_ctx(kargs_t A, LAS unsigned char* lds, int wave0) {
    Ctx C; unsigned ones = ~0u; asm volatile("" : "+s"(ones));
    int t = wave0 * 64 + (int)__builtin_amdgcn_mbcnt_hi(ones, __builtin_amdgcn_mbcnt_lo(ones, 0u)); asm volatile("" : "+v"(t));
    C.lds = lds; C.ws = A->ws; C.ctl = (unsigned*)(C.ws + WS_CTL); C.out = A->out;
    C.tid = t; C.lane = t & 63; C.wave = __builtin_amdgcn_readfirstlane(t >> 6);
    { int g_ = gridDim.x, b_ = blockIdx.x; asm volatile("" : "+s"(g_), "+s"(b_)); C.G = g_; C.bx = b_; } C.vcu = (C.bx % 8) * (C.G / 8) + C.bx / 8;
    C.gw = C.vcu * NWAVES + C.wave; C.NGW = C.G * NWAVES;
    return C;
}
#define LDS_WAIT() asm volatile("s_waitcnt lgkmcnt(0)" ::: "memory")

struct MapWin { __device__ __forceinline__ int row(int n) const {
        if (n < 256) return PC_CQ + n; if (n < 384) return PC_CKV + (n - 256); if (n < 416) return PC_KR + (n - 384); if (n < 672) return PC_FQ + (n - 416);
        if (n < 928) return PC_FK + (n - 672); if (n < 1184) return PC_FV + (n - 928); if (n < 1188) return PC_FL + (n - 1184); return PC_CI + (n - 1188); }
    __device__ __forceinline__ float scale(int, int n) const { return (n >= 416 && n < 672) ? C2_FOX : 1.0f; } };
struct MapUq { const float* g; __device__ __forceinline__ int row(int n) const { const int h = n / 96, d = n - h * 96; if (d < 64) return n; const int i = d - 64;
        const int s = (i < 16) ? (4 * (i >> 1) + (i & 1)) : (4 * ((i - 16) >> 1) + 2 + (i & 1)); return h * 96 + 64 + s; }
    __device__ __forceinline__ float scale(int k, int) const { return g[k] * C2_MLA; } };
struct MapUkv { const float* g; __device__ __forceinline__ int row(int n) const { const int h = n >> 7, d = n & 127; return d < 64 ? (768 + h * 64 + d) : (1280 + h * 64 + (d - 64)); }
    __device__ __forceinline__ float scale(int k, int) const { return g[k]; } };
struct MapWout { const float* gm; const float* gf; __device__ __forceinline__ int row(int n) const { return n; }
    __device__ __forceinline__ float scale(int k, int) const { return k < 512 ? gm[k] : (k < 768 ? gf[k - 512] : 1.0f); } };
struct MapW13 { int which; __device__ __forceinline__ int row(int n) const { return (n >> 7) * 256 + which * 128 + (n & 127); }
    __device__ __forceinline__ float scale(int, int) const { return 1.0f; } };
struct MapId { __device__ __forceinline__ int row(int n) const { return n; } __device__ __forceinline__ float scale(int, int) const { return 1.0f; } };

template <class Map>
__device__ __forceinline__ void transpose_item(const float* W, int Nsrc, bf16* WT, int ldk, LAS float* scr, int kb, int nb, int lane, const Map mp) {
    const int k0 = 64 * kb, n0 = 32 * nb, r8 = lane >> 3, nn = n0 + 4 * (lane & 7); const bool nok = nn < Nsrc;
    f32x4 v[8];
#pragma unroll
    for (int i = 0; i < 8; ++i) { v[i] = (f32x4){0.f, 0.f, 0.f, 0.f}; if (nok) v[i] = *(const f32x4*)(W + (size_t)(k0 + 8 * i + r8) * Nsrc + nn); }
#pragma unroll
    for (int i = 0; i < 8; ++i) { const int kk = 8 * i + r8; LAS float* d = scr + kk * 33 + 4 * (lane & 7);
#pragma unroll
        for (int j = 0; j < 4; ++j) d[j] = v[i][j] * mp.scale(k0 + kk, nn + j); }
    LDS_WAIT(); asm volatile("" ::: "memory");
    const int c = lane & 7;
#pragma unroll
    for (int j = 0; j < 4; ++j) { const int n = (lane >> 3) + 8 * j; const LAS float* s = scr + (8 * c) * 33 + n;
        if (n0 + n < Nsrc) { u32x4 o; o.x = pk2(s[0 * 33], s[1 * 33]); o.y = pk2(s[2 * 33], s[3 * 33]); o.z = pk2(s[4 * 33], s[5 * 33]); o.w = pk2(s[6 * 33], s[7 * 33]);
            *(u32x4*)(WT + (size_t)mp.row(n0 + n) * ldk + k0 + 8 * c) = o; } }
    LDS_WAIT(); asm volatile("" ::: "memory");
}

__device__ __forceinline__ void sincos_acc(float ang, float& c, float& s) {
    const double a = (double)ang, q = __builtin_rint(a * 0.63661977236758134308);
    const double y = (a - q * 1.57079632679489655800) - q * 6.12323399573676603587e-17, y2 = y * y;
    const double sp = y * (1.0 + y2 * (-1.0 / 6 + y2 * (1.0 / 120 + y2 * (-1.0 / 5040 + y2 * (1.0 / 362880 + y2 * (-1.0 / 39916800 + y2 * (1.0 / 6227020800.0)))))));
    const double cp = 1.0 + y2 * (-0.5 + y2 * (1.0 / 24 + y2 * (-1.0 / 720 + y2 * (1.0 / 40320 + y2 * (-1.0 / 3628800 + y2 * (1.0 / 479001600 + y2 * (-1.0 / 87178291200.0)))))));
    const int quad = (int)((long long)q & 3);
    const double ss = (quad == 0) ? sp : (quad == 1) ? cp : (quad == 2) ? -sp : -cp;
    const double cc = (quad == 0) ? cp : (quad == 1) ? -sp : (quad == 2) ? -cp : sp;
    c = (float)cc; s = (float)ss;
}
__device__ __forceinline__ float inv_freq(int f) {
    const int a = f >> 2, b = f & 3;
    const float p = (a == 0) ? 1.0f : (a == 1) ? 0.1f : (a == 2) ? 0.01f : 0.001f;
    const float m = (b == 0) ? 1.0f : (b == 1) ? 0.56234132519034908f : (b == 2) ? 0.31622776601683794f : 0.17782794100389228f;
    return (b == 0) ? p : (float)((double)p * (double)m);
}

__device__ __forceinline__ void p0_prologue(Ctx& C, kargs_t A) {
    LAS float* scr = (LAS float*)(C.lds + C.wave * 16384);
    bf16* WIN = (bf16*)(C.ws + WS_WIN); bf16* WQ2 = (bf16*)(C.ws + WS_WQ2); bf16* WOUT = (bf16*)(C.ws + WS_WOUT);
    constexpr int I_IN = 16 * 54, I_UQ = 4 * 24, I_UKV = 2 * 32, I_OUT = 16 * 32, I_L = I_IN + I_UQ + I_UKV + I_OUT;
    REPS(12) for (int it = C.gw; it < DEPTH * I_L; it += C.NGW) {
        const int l = it / I_L; int r = it - l * I_L;
        if (r < I_IN) { transpose_item(A->in[2] + (size_t)l * DM * IN_COLS, IN_COLS, WIN + (size_t)l * NP1 * DM, DM, scr, r / 54, r % 54, C.lane, MapWin{}); continue; } r -= I_IN;
        if (r < I_UQ) { transpose_item(A->in[4] + (size_t)l * 256 * 768, 768, WQ2 + (size_t)l * NP1 * 256, 256, scr, r / 24, r % 24, C.lane, MapUq{A->in[3] + l * 256}); continue; } r -= I_UQ;
        if (r < I_UKV) { transpose_item(A->in[6] + (size_t)l * 128 * 1024, 1024, WQ2 + (size_t)l * NP1 * 256, 256, scr, r / 32, r % 32, C.lane, MapUkv{A->in[5] + l * 128}); continue; } r -= I_UKV;
        transpose_item(A->in[14] + (size_t)l * DM * DM, DM, WOUT + (size_t)l * DM * DM, DM, scr, r / 32, r % 32, C.lane, MapWout{A->in[12] + l * 512, A->in[13] + l * 256});
    }
    const int gt = C.vcu * NTHR + C.tid, NGT = C.G * NTHR;
    for (int i = gt; i < DEPTH * 92 * 128; i += NGT) { const int l = i / (92 * 128), r = i % (92 * 128); *(u32x4*)(WIN + (size_t)l * NP1 * DM + (size_t)(420 + r / 128) * DM + (r % 128) * 8) = (u32x4){0u, 0u, 0u, 0u}; }
    REPS(4) {
    bf16* XB = (bf16*)(C.ws + WS_XB); const float* x = A->in[0];
    for (int m = C.gw; m < M; m += C.NGW) { const f32x4* xr = (const f32x4*)(x + (size_t)m * DM) + C.lane; u32x2* o = (u32x2*)(XB + (size_t)m * DM) + C.lane;
#pragma unroll
        for (int j = 0; j < 4; ++j) { const f32x4 v = xr[64 * j]; o[64 * j] = (u32x2){pk2(v[0], v[1]), pk2(v[2], v[3])}; } }
    float* COS = (float*)(C.ws + WS_TAB); float* SIN = COS + (size_t)M * 16; const int* pos = (const int*)A->in[1];
    for (int i = gt; i < M * 16; i += NGT) { const float ang = (float)pos[i >> 4] * inv_freq(i & 15); float c, s; sincos_acc(ang, c, s); COS[i] = c; SIN[i] = s; }
    }
}

__device__ __forceinline__ int ffn_split(int layer) { return (layer & 1) ? 7744 : 4224; }
__device__ __forceinline__ void ffn_weights(Ctx& C, kargs_t A, int layer, int first, int stride, int lo, int hi) {
    LAS float* scr = (LAS float*)(C.lds + C.wave * 16384);
    bf16* W13 = (bf16*)(C.ws + WS_WFFN); bf16* W2T = W13 + WF_W13_ELEMS; const int j = layer >> 1;
    if ((layer & 1) == 0) {
        constexpr int I1 = 16 * 88, I2 = 44 * 32;
        const float* w1 = A->in[17] + (size_t)j * DM * DFF; const float* w3 = A->in[18] + (size_t)j * DM * DFF; const float* w2 = A->in[19] + (size_t)j * DFF * DM;
        const int end = hi < 2 * I1 + I2 ? hi : 2 * I1 + I2;
        for (int it = lo + first; it < end; it += stride) {
            int r = it;
            if (r < I1) { transpose_item(w1, DFF, W13, DM, scr, r / 88, r % 88, C.lane, MapW13{0}); continue; } r -= I1;
            if (r < I1) { transpose_item(w3, DFF, W13, DM, scr, r / 88, r % 88, C.lane, MapW13{1}); continue; } r -= I1;
            transpose_item(w2, DM, W2T, DFF, scr, r / 32, r % 32, C.lane, MapId{});
        }
    } else {
        constexpr int I1 = 16 * 44, I2 = 22 * 32, IE = 2 * I1 + I2;
        const int end = hi < NEXP * IE ? hi : NEXP * IE;
        for (int it = lo + first; it < end; it += stride) {
            const int e = it / IE; int r = it - e * IE;
            const float* w1 = A->in[21] + ((size_t)j * NEXP + e) * DM * DFE; const float* w3 = A->in[22] + ((size_t)j * NEXP + e) * DM * DFE; const float* w2 = A->in[23] + ((size_t)j * NEXP + e) * DFE * DM;
            bf16* W13e = W13 + (size_t)e * 2 * DFE * DM; bf16* W2Te = W2T + (size_t)e * DM * DFE;
            if (r < I1) { transpose_item(w1, DFE, W13e, DM, scr, r / 44, r % 44, C.lane, MapW13{0}); continue; } r -= I1;
            if (r < I1) { transpose_item(w3, DFE, W13e, DM, scr, r / 44, r % 44, C.lane, MapW13{1}); continue; } r -= I1;
            transpose_item(w2, DM, W2Te, DFE, scr, r / 32, r % 32, C.lane, MapId{});
        }
    }
}

__device__ __forceinline__ void p2_thin(Ctx& C, kargs_t A, int layer) {
    unsigned char* sc = C.ws + WS_SCR;
    bf16* CQ = (bf16*)(sc + SC_CQKV); bf16* CKV = CQ + (size_t)M * 256; const float* KR = (const float*)(sc + SC_KR); const float* FL = (const float*)(sc + SC_FL);
    float* CUM = (float*)(sc + SC_CUM); const bf16* CI = (const bf16*)(sc + SC_CI); const bf16* FQn = (const bf16*)(sc + SC_FQ); bf16* KM = (bf16*)(sc + SC_KM); bf16* MIXED = (bf16*)(sc + SC_MIXED);
    const float* COS = (const float*)(C.ws + WS_TAB); const float* SIN = COS + (size_t)M * 16;
    LAS unsigned* NT2 = (LAS unsigned*)(C.lds + RING_BYTES + 4096);
    if (C.tid < 64) NT2[C.tid] = 0u;
    LAS unsigned* RQ = (LAS unsigned*)(C.lds + RING_BYTES + 8192 + 64);
    if (C.tid == 0) RQ[0] = 0u;
    __syncthreads();
    {
    if (C.wave == 0 && C.vcu < BATCH * 4) {
        const int sq = C.vcu, b = sq >> 2, h = sq & 3; const float bias = A->in[7][layer * 4 + h];
        float v[64]; float run = 0.f;
#pragma unroll
        for (int i = 0; i < 64; ++i) { const float z = FL[((size_t)b * SEQ + C.lane * 64 + i) * 4 + h] + bias; const float e = fexp2(-fabsf(z) * LOG2E);
            const float ls = fminf(z, 0.f) - __builtin_amdgcn_logf(1.0f + e) * 0.6931471805599453f; run += ls * LOG2E; v[i] = run; }
        float incl = run;
#pragma unroll
        for (int o = 1; o < 64; o <<= 1) { const float t = __int_as_float(__builtin_amdgcn_ds_bpermute((C.lane - o) << 2, __float_as_int(incl))); if (C.lane >= o) incl += t; }
        const float excl = incl - run; float* dst = CUM + (size_t)sq * SEQ + C.lane * 64;
#pragma unroll
        for (int i = 0; i < 64; i += 4) *(f32x4*)(dst + i) = (f32x4){v[i] + excl, v[i + 1] + excl, v[i + 2] + excl, v[i + 3] + excl};
    }
    const int rpw = M / C.G;
    for (;;) {
        unsigned jb = 0u; if (C.lane == 0) jb = __hip_atomic_fetch_add(RQ, 1u, __ATOMIC_RELAXED, __HIP_MEMORY_SCOPE_WORKGROUP);
        jb = (unsigned)__builtin_amdgcn_readfirstlane((int)jb);
        if ((int)jb * 4 >= rpw) break;
        const size_t mb = (size_t)C.vcu * rpw + 4 * jb;
        u32x2 wq[4]; unsigned wk[4]; f32x2 x1[4], x2[4], cs[4], sn[4]; u32x2 fqv[4], fkv[4]; const int g4 = C.lane & 7, h = C.lane >> 3;
#pragma unroll
        for (int k = 0; k < 4; ++k) { const size_t m = mb + k;
            wq[k] = ((const u32x2*)(CQ + m * 256))[C.lane]; wk[k] = ((const unsigned*)(CKV + m * 256))[C.lane];
            x1[k] = *(const f32x2*)(KR + m * 32 + 2 * g4); x2[k] = *(const f32x2*)(KR + m * 32 + 16 + 2 * g4);
            cs[k] = *(const f32x2*)(COS + m * 16 + 2 * g4); sn[k] = *(const f32x2*)(SIN + m * 16 + 2 * g4);
            fqv[k] = ((const u32x2*)(FQn + m * 256))[C.lane]; fkv[k] = ((const u32x2*)(FQn + (size_t)M * 256 + m * 256))[C.lane]; }
#pragma unroll
        for (int k = 0; k < 4; ++k) { const size_t m = mb + k;
            { const float a0 = bflo(wq[k].x), a1 = bfhi(wq[k].x), a2 = bflo(wq[k].y), a3 = bfhi(wq[k].y);
              const float ss = wave_sum((a0 * a0 + a1 * a1) + (a2 * a2 + a3 * a3)); const float r = 1.0f / sqrtf(ss * (1.0f / 256) + EPS); ((u32x2*)(CQ + m * 256))[C.lane] = (u32x2){pk2(a0 * r, a1 * r), pk2(a2 * r, a3 * r)}; }
            { const float a0 = bflo(wk[k]), a1 = bfhi(wk[k]); unsigned* p = (unsigned*)(CKV + m * 256) + C.lane;
              const float ss = wave_sum(a0 * a0 + a1 * a1); const float r = 1.0f / sqrtf(ss * (1.0f / 128) + EPS); *p = pk2(a0 * r, a1 * r); }
            {
              float nq = 0.f, nk = 0.f; { const float a0 = bflo(fqv[k].x), a1 = bfhi(fqv[k].x), a2 = bflo(fqv[k].y), a3 = bfhi(fqv[k].y); nq = (a0 * a0 + a1 * a1) + (a2 * a2 + a3 * a3); }
              { const float a0 = bflo(fkv[k].x), a1 = bfhi(fkv[k].x), a2 = bflo(fkv[k].y), a3 = bfhi(fkv[k].y); nk = (a0 * a0 + a1 * a1) + (a2 * a2 + a3 * a3); }
              nq += lane_xor<1>(nq); nq += lane_xor<2>(nq); nq += lane_xor<4>(nq); nq += lane_xor<8>(nq); nk += lane_xor<1>(nk); nk += lane_xor<2>(nk); nk += lane_xor<4>(nk); nk += lane_xor<8>(nk);
              if ((C.lane & 15) == 0) { const int bi = (int)(m >> 12) * 8 + (C.lane >> 4) * 2; atomicMax((unsigned*)&NT2[bi], __float_as_uint(nq)); atomicMax((unsigned*)&NT2[bi + 1], __float_as_uint(nk)); } }
            *(u32x2*)(KM + m * 768 + h * 96 + 64 + 4 * g4) = (u32x2){pk2(x1[k].x * cs[k].x - x2[k].x * sn[k].x, x1[k].y * cs[k].y - x2[k].y * sn[k].y), pk2(x1[k].x * sn[k].x + x2[k].x * cs[k].x, x1[k].y * sn[k].y + x2[k].y * cs[k].y)}; }
    }
    }
    __syncthreads();
    if (C.tid < 64) atomicMax(C.ctl + CW_QKMAX + layer * 64 + C.tid, NT2[C.tid]);
    {
        LAS float* hL = (LAS float*)C.lds; LAS float* yL = hL + 62 * 256;
        const int cch = (C.wave & 3) * 64 + C.lane, tt0 = (C.wave >> 2) * 16;
        float wj[31];
#pragma unroll
        for (int j = 0; j < 31; ++j) wj[j] = A->in[8][((size_t)layer * 31 + j) * 256 + cch];
        const float cb = A->in[9][layer * 256 + cch];
        const int ntok = C.tid >> 4, ngrp = (C.tid >> 2) & 3, nqt = C.tid & 3, nc0 = ngrp * 64 + nqt * 16;
        u32x4 pa[4], pg[4];
#define CONV_LOAD(tl) do { const int t0_ = (tl) * 32, seq0_ = (t0_ / SEQ) * SEQ; _Pragma("unroll") for (int k = 0; k < 4; ++k) { const int it = C.tid + NTHR * k, r = it >> 5, ch = it & 31, tok = t0_ - 30 + r; \
            pa[k] = (u32x4){0u, 0u, 0u, 0u}; pg[k] = pa[k]; \
            if (it < 62 * 32 && tok >= seq0_) { pa[k] = *(const u32x4*)(CI + (size_t)tok * 512 + ch * 8); pg[k] = *(const u32x4*)(CI + (size_t)tok * 512 + 256 + ch * 8); } } } while (0)
        if (C.vcu < M / 32) CONV_LOAD(C.vcu);
        for (int tile = C.vcu; tile < M / 32; tile += C.G) {
            const int t0 = tile * 32;
#pragma unroll
            for (int k = 0; k < 4; ++k) { const int it = C.tid + NTHR * k, r = it >> 5, ch = it & 31;
                if (it < 62 * 32) { const u32x4 a = pa[k], g = pg[k];
                    const f32x4 o0 = (f32x4){bflo(a.x) * sigmoidf_(bflo(g.x)), bfhi(a.x) * sigmoidf_(bfhi(g.x)), bflo(a.y) * sigmoidf_(bflo(g.y)), bfhi(a.y) * sigmoidf_(bfhi(g.y))};
                    const f32x4 o1 = (f32x4){bflo(a.z) * sigmoidf_(bflo(g.z)), bfhi(a.z) * sigmoidf_(bfhi(g.z)), bflo(a.w) * sigmoidf_(bflo(g.w)), bfhi(a.w) * sigmoidf_(bfhi(g.w))};
                    *(LAS f32x4*)(hL + r * 256 + ch * 8) = o0; *(LAS f32x4*)(hL + r * 256 + ch * 8 + 4) = o1; } }
            __syncthreads();
            if (tile + C.G < M / 32) CONV_LOAD(tile + C.G);
#pragma unroll
            for (int chunk = 0; chunk < 2; ++chunk) { const int base = tt0 + chunk * 8; float hv[38];
#pragma unroll
                for (int i = 0; i < 38; ++i) hv[i] = hL[(base + i) * 256 + cch];
#pragma unroll
                for (int tt = 0; tt < 8; ++tt) { float acc = cb;
#pragma unroll
                    for (int j = 0; j < 31; ++j) acc += wj[j] * hv[tt + j];
                    yL[(base + tt) * 256 + cch] = acc; } }
            __syncthreads();
            { float v[16]; float s = 0.f;
#pragma unroll
              for (int i = 0; i < 16; i += 4) { const f32x4 t4 = *(const LAS f32x4*)(yL + ntok * 256 + nc0 + i); v[i] = t4[0]; v[i + 1] = t4[1]; v[i + 2] = t4[2]; v[i + 3] = t4[3]; s += (t4[0] + t4[1]) + (t4[2] + t4[3]); }
              s += lane_xor<1>(s); s += lane_xor<2>(s); const float mean = s * (1.0f / 64); float q = 0.f;
#pragma unroll
              for (int i = 0; i < 16; ++i) { v[i] -= mean; q += v[i] * v[i]; }
              q += lane_xor<1>(q); q += lane_xor<2>(q); const float rstd = 1.0f / sqrtf(q * (1.0f / 64) + EPS);
              const float* gg = A->in[10] + layer * 256 + nc0; const float* gb = A->in[11] + layer * 256 + nc0; float o[16];
#pragma unroll
              for (int i = 0; i < 16; ++i) o[i] = siluf_(v[i] * rstd * gg[i] + gb[i]);
              bf16* dst = MIXED + (size_t)(t0 + ntok) * 1024 + 768 + nc0;
              *(u32x4*)dst = (u32x4){pk2(o[0], o[1]), pk2(o[2], o[3]), pk2(o[4], o[5]), pk2(o[6], o[7])};
              *(u32x4*)(dst + 8) = (u32x4){pk2(o[8], o[9]), pk2(o[10], o[11]), pk2(o[12], o[13]), pk2(o[14], o[15])}; }
        }
        __syncthreads();
    }
    REPS(11) ffn_weights(C, A, layer, C.gw, C.NGW, ffn_split(layer), 1 << 30);
}

__device__ __forceinline__ void p5_rms(Ctx& C) {
    bf16* MIXED = (bf16*)(C.ws + WS_SCR + SC_MIXED);
    REPS(7) for (int mb = C.gw; mb < M; mb += 4 * C.NGW) {
        u32x4 wa[4]; u32x2 wb[4];
#pragma unroll
        for (int k = 0; k < 4; ++k) { const bf16* r = MIXED + ((size_t)mb + (size_t)k * C.NGW) * 1024; wa[k] = ((const u32x4*)r)[C.lane]; wb[k] = ((const u32x2*)(r + 512))[C.lane]; }
#pragma unroll
        for (int k = 0; k < 4; ++k) { bf16* r = MIXED + ((size_t)mb + (size_t)k * C.NGW) * 1024;
            { const u32x4 w = wa[k]; float a[8] = {bflo(w.x), bfhi(w.x), bflo(w.y), bfhi(w.y), bflo(w.z), bfhi(w.z), bflo(w.w), bfhi(w.w)}; float ss = 0.f;
#pragma unroll
              for (int i = 0; i < 8; ++i) ss += a[i] * a[i];
              ss = wave_sum(ss); const float rs = 1.0f / sqrtf(ss * (1.0f / 512) + EPS);
              ((u32x4*)r)[C.lane] = (u32x4){pk2(a[0] * rs, a[1] * rs), pk2(a[2] * rs, a[3] * rs), pk2(a[4] * rs, a[5] * rs), pk2(a[6] * rs, a[7] * rs)}; }
            { const u32x2 w = wb[k]; const float a0 = bflo(w.x), a1 = bfhi(w.x), a2 = bflo(w.y), a3 = bfhi(w.y);
              const float ss = wave_sum((a0 * a0 + a1 * a1) + (a2 * a2 + a3 * a3)); const float rs = 1.0f / sqrtf(ss * (1.0f / 256) + EPS); ((u32x2*)(r + 512))[C.lane] = (u32x2){pk2(a0 * rs, a1 * rs), pk2(a2 * rs, a3 * rs)}; }
        }
    }
}

template <int MODE>
__device__ __forceinline__ void ln_pass(Ctx& C, const bool final, const bf16* add, const float* gam, const float* bet, const float* router_w) {
    bf16* XB = (bf16*)(C.ws + WS_XB); float* out = C.out;
    REPS(14) {
    const bool dry = ((REP_MASK >> 14) & 1) && rep_ == 0; float* jf = (float*)(C.ws + WS_SCR); bf16* jb = (bf16*)(C.ws + WS_SCR + 40 * MiB);
    int* TOPE = (int*)(C.ws + WS_MOE + MT_TOPE); float* TOPG = (float*)(C.ws + WS_MOE + MT_TOPG); const int* TOKSLOT = (const int*)(C.ws + WS_MOE + MT_TOKSLOT);
    LAS float* RW = (LAS float*)C.lds; LAS unsigned* CNT = (LAS unsigned*)(C.lds + 32768);
    if constexpr (MODE == 1) {
        for (int i = C.tid; i < 1024 * 8 / 4; i += NTHR) *(LAS f32x4*)(RW + 4 * i) = *(const f32x4*)(router_w + 4 * i);
        if (C.tid < 8) CNT[C.tid] = 0u;
        __syncthreads();
    }
    f32x4 g4[4], b4[4];
#pragma unroll
    for (int j = 0; j < 4; ++j) { g4[j] = ((const f32x4*)gam)[64 * j + C.lane]; b4[j] = ((const f32x4*)bet)[64 * j + C.lane]; }
    const int RPB = M / C.G, row0 = C.bx * RPB;
    unsigned cnt0 = 0, cnt1 = 0, cnt2 = 0, cnt3 = 0, cnt4 = 0, cnt5 = 0, cnt6 = 0, cnt7 = 0;
    u32x2 nx[4], na[4], nb[4]; int sl0 = 0, sl1 = 0;
#define LN_LOAD(mm) do { _Pragma("unroll") for (int j = 0; j < 4; ++j) { nx[j] = ((const u32x2*)(XB + (size_t)(mm) * DM))[64 * j + C.lane]; \
        if constexpr (MODE == 2) { na[j] = ((const u32x2*)(add + (size_t)sl0 * DM))[64 * j + C.lane]; nb[j] = ((const u32x2*)(add + (size_t)sl1 * DM))[64 * j + C.lane]; } \
        else { na[j] = ((const u32x2*)(add + (size_t)(mm) * DM))[64 * j + C.lane]; nb[j] = (u32x2){0u, 0u}; } } } while (0)
    if constexpr (MODE == 2) { sl0 = TOKSLOT[2 * (row0 + C.wave)]; sl1 = TOKSLOT[2 * (row0 + C.wave) + 1]; }
    LN_LOAD(row0 + C.wave);
    if constexpr (MODE == 2) { if (C.wave + NWAVES < RPB) { sl0 = TOKSLOT[2 * (row0 + C.wave + NWAVES)]; sl1 = TOKSLOT[2 * (row0 + C.wave + NWAVES) + 1]; } }
    for (int rr = C.wave; rr < RPB; rr += NWAVES) {
        const int m = row0 + rr;
        f32x4 v[4];
#pragma unroll
        for (int j = 0; j < 4; ++j) { v[j] = (f32x4){bflo(nx[j].x), bfhi(nx[j].x), bflo(nx[j].y), bfhi(nx[j].y)} * ALPHA + (f32x4){bflo(na[j].x), bfhi(na[j].x), bflo(na[j].y), bfhi(na[j].y)};
            if constexpr (MODE == 2) v[j] += (f32x4){bflo(nb[j].x), bfhi(nb[j].x), bflo(nb[j].y), bfhi(nb[j].y)}; }
        if (rr + NWAVES < RPB) {
            LN_LOAD(m + NWAVES);
            if constexpr (MODE == 2) { if (rr + 2 * NWAVES < RPB) { sl0 = TOKSLOT[2 * (m + 2 * NWAVES)]; sl1 = TOKSLOT[2 * (m + 2 * NWAVES) + 1]; } }
        }
        float s = 0.f;
#pragma unroll
        for (int j = 0; j < 4; ++j) s += (v[j][0] + v[j][1]) + (v[j][2] + v[j][3]);
        const float mean = wave_sum(s) * (1.0f / DM); float q = 0.f;
#pragma unroll
        for (int j = 0; j < 4; ++j) { v[j] = v[j] - mean; q += (v[j][0] * v[j][0] + v[j][1] * v[j][1]) + (v[j][2] * v[j][2] + v[j][3] * v[j][3]); }
        const float rstd = 1.0f / sqrtf(wave_sum(q) * (1.0f / DM) + EPS);
#pragma unroll
        for (int j = 0; j < 4; ++j) { v[j] = v[j] * rstd * g4[j] + b4[j]; if (final) ((f32x4*)((dry ? jf + (size_t)(m & 8191) * DM : out + (size_t)m * DM)))[64 * j + C.lane] = v[j];
            ((u32x2*)((dry ? jb + (size_t)(m & 8191) * DM : XB + (size_t)m * DM)))[64 * j + C.lane] = (u32x2){pk2(v[j][0], v[j][1]), pk2(v[j][2], v[j][3])}; }
        if constexpr (MODE == 1) {
            float lg[8] = {0.f, 0.f, 0.f, 0.f, 0.f, 0.f, 0.f, 0.f};
#pragma unroll
            for (int j = 0; j < 4; ++j)
#pragma unroll
                for (int i = 0; i < 4; ++i) { const int col = 256 * j + 4 * C.lane + i; const f32x4 w0 = *(const LAS f32x4*)(RW + col * 8), w1 = *(const LAS f32x4*)(RW + col * 8 + 4); const float xv = v[j][i];
                    lg[0] += xv * w0[0]; lg[1] += xv * w0[1]; lg[2] += xv * w0[2]; lg[3] += xv * w0[3]; lg[4] += xv * w1[0]; lg[5] += xv * w1[1]; lg[6] += xv * w1[2]; lg[7] += xv * w1[3]; }
#pragma unroll
            for (int e = 0; e < 8; ++e) lg[e] = wave_sum(lg[e]);
            int e1 = 0; float v1 = lg[0];
#pragma unroll
            for (int e = 1; e < 8; ++e) if (lg[e] > v1) { v1 = lg[e]; e1 = e; }
            int e2 = -1; float v2 = -INFINITY;
#pragma unroll
            for (int e = 0; e < 8; ++e) if (e != e1 && lg[e] > v2) { v2 = lg[e]; e2 = e; }
            const float ex = fexp2((v2 - v1) * LOG2E), gA = 1.0f / (1.0f + ex), gB = ex * gA;
            if (C.lane == 0) { TOPE[2 * m] = e1; TOPE[2 * m + 1] = e2; TOPG[2 * m] = gA; TOPG[2 * m + 1] = gB; }
            cnt0 += (e1 == 0) + (e2 == 0); cnt1 += (e1 == 1) + (e2 == 1); cnt2 += (e1 == 2) + (e2 == 2); cnt3 += (e1 == 3) + (e2 == 3);
            cnt4 += (e1 == 4) + (e2 == 4); cnt5 += (e1 == 5) + (e2 == 5); cnt6 += (e1 == 6) + (e2 == 6); cnt7 += (e1 == 7) + (e2 == 7);
        }
    }
    if constexpr (MODE == 1) {
        if (C.lane == 0) { atomicAdd((unsigned*)&CNT[0], cnt0); atomicAdd((unsigned*)&CNT[1], cnt1); atomicAdd((unsigned*)&CNT[2], cnt2); atomicAdd((unsigned*)&CNT[3], cnt3);
                           atomicAdd((unsigned*)&CNT[4], cnt4); atomicAdd((unsigned*)&CNT[5], cnt5); atomicAdd((unsigned*)&CNT[6], cnt6); atomicAdd((unsigned*)&CNT[7], cnt7); }
        __syncthreads();
        if (C.tid < 8) C.ctl[CW_CNTB + C.bx * 8 + C.tid] = CNT[C.tid];
        __syncthreads();
    }
    }
#undef LN_LOAD
}

__device__ __forceinline__ void moe_assign(Ctx& C) {
    if (C.wave != 0) return;
    const int* TOPE = (const int*)(C.ws + WS_MOE + MT_TOPE); const float* TOPG = (const float*)(C.ws + WS_MOE + MT_TOPG);
    int* TOKSLOT = (int*)(C.ws + WS_MOE + MT_TOKSLOT); int* SLOTTOK = (int*)(C.ws + WS_MOE + MT_SLOTTOK); float* SLOTGATE = (float*)(C.ws + WS_MOE + MT_SLOTGATE);
    const int blk = C.bx, RPB = M / C.G, row0 = blk * RPB;
    int tot[8] = {0, 0, 0, 0, 0, 0, 0, 0}, pre[8] = {0, 0, 0, 0, 0, 0, 0, 0};
    for (int bb = C.lane; bb < C.G; bb += 64) {
        const u32x4* cp = (const u32x4*)(C.ctl + CW_CNTB + bb * 8); const u32x4 ca = cp[0], cb = cp[1]; const int lt = bb < blk ? 1 : 0;
        const int c[8] = {(int)ca.x, (int)ca.y, (int)ca.z, (int)ca.w, (int)cb.x, (int)cb.y, (int)cb.z, (int)cb.w};
#pragma unroll
        for (int e = 0; e < 8; ++e) { tot[e] += c[e]; pre[e] += lt * c[e]; }
    }
#pragma unroll
    for (int e = 0; e < 8; ++e) { tot[e] = wave_sum_i(tot[e]); pre[e] = wave_sum_i(pre[e]); }
    int seg[9]; seg[0] = 0;
#pragma unroll
    for (int e = 0; e < 8; ++e) seg[e + 1] = seg[e] + ((tot[e] + 255) & ~255);
    int run[8];
#pragma unroll
    for (int e = 0; e < 8; ++e) run[e] = seg[e] + pre[e];
    const unsigned long long ltmask = (1ull << C.lane) - 1ull;
    for (int base = 0; base < RPB * 2; base += 64) {
        const int idx = base + C.lane, token = row0 + (idx >> 1), choice = idx & 1;
        const int ex = TOPE[2 * token + choice]; const float gate = TOPG[2 * token + choice]; int slot = 0;
#pragma unroll
        for (int e = 0; e < 8; ++e) { const unsigned long long mk = __builtin_amdgcn_ballot_w64(ex == e); if (ex == e) slot = run[e] + __popcll(mk & ltmask); run[e] += __popcll(mk); }
        SLOTTOK[slot] = token; SLOTGATE[slot] = gate; TOKSLOT[2 * token + choice] = slot;
    }
    if (blk < 8) {
        int lo = 0, hi = 0;
#pragma unroll
        for (int e = 0; e < 8; ++e) if (e == blk) { lo = seg[e] + tot[e]; hi = seg[e + 1]; }
        for (int s = lo + C.lane; s < hi; s += 64) { SLOTTOK[s] = 0; SLOTGATE[s] = 0.f; }
    }
    if (blk == 0 && C.lane == 0) {
#pragma unroll
        for (int e = 0; e < 9; ++e) C.ctl[CW_SEG + e] = (unsigned)seg[e];
    }
}

#ifndef MK_PER_PHASE
#define MK_PER_PHASE 0
#endif
#ifndef PH_ENABLE
#define PH_ENABLE 0xFFFF
#endif
constexpr int PH_PER_LAYER = 12, N_PHASES = 1 + DEPTH * PH_PER_LAYER;

__global__ void __launch_bounds__(NTHR, 2) fwd_kernel(Args args) {
    extern __shared__ __attribute__((aligned(16))) unsigned char lds_raw[];
    LAS unsigned char* const lds = (LAS unsigned char*)lds_raw;
    volatile LAS unsigned* MISC = (volatile LAS unsigned*)(lds + MISC_OFF);
    for (int u = threadIdx.x; u < (LDS_BYTES - LDSCTL_OFF) / 4; u += NTHR) ((LAS unsigned*)(lds + LDSCTL_OFF))[u] = 0u;
    __syncthreads();
    const int wave0 = __builtin_amdgcn_readfirstlane((int)threadIdx.x >> 6);
    XcdBarrier bar; bar.bar = (unsigned*)(args.ws + WS_CTL) + CW_BAR; bar.x = 0; bar.st = nullptr;
    if (!MK_PER_PHASE) bar = xcd_barrier_post((unsigned*)(args.ws + WS_CTL) + CW_BAR, MISC + 8, wave0);
    const int lo = args.ph_lo, hi = args.ph_hi;
#define IN(k) (lo <= (k) && (k) < hi)
#define EN(p) ((PH_ENABLE >> (p)) & 1)
#define SEAM(k) do { if (IN((k) + 1)) { if (!MK_PER_PHASE) { unsigned long long bw0_ = 0ull; if (PROBE_ON(14)) bw0_ = __builtin_amdgcn_s_memrealtime(); xcd_barrier<false>(bar, wave0); if ((REP_MASK >> 13) & 1) xcd_barrier<false>(bar, wave0); \
        if (PROBE_ON(14)) { const unsigned long long bw1_ = __builtin_amdgcn_s_memrealtime(), bd_ = bw1_ - bw0_; while (__builtin_amdgcn_s_memrealtime() - bw1_ < bd_) __builtin_amdgcn_s_sleep(8); } \
        if (PROBE_ON(13)) { const unsigned long long bw1_ = __builtin_amdgcn_s_memrealtime(); while (__builtin_amdgcn_s_memrealtime() - bw1_ < 2000ull) __builtin_amdgcn_s_sleep(8); } } } } while (0)
#define SEAM0(k) do { if (IN((k) + 1)) { if (!MK_PER_PHASE) xcd_barrier<true>(bar, wave0); } } while (0)
#define PHASE_CTX kargs_t A = opaque_args(); Ctx C = make_ctx(A, lds, wave0); unsigned char* sc = C.ws + WS_SCR; (void)sc

    PT0(15); if (EN(15) && IN(0)) { PHASE_CTX; p0_prologue(C, A); }
    PEND(15, SEAM0(0));

    for (int layer = 0; layer < DEPTH; ++layer) {
        const int P = 1 + layer * PH_PER_LAYER;
#ifdef FORCE_MOE
        const bool moe = FORCE_MOE != 0;
#else
        const bool moe = (layer & 1) != 0;
#endif
        if (EN(0) && IN(P + 0)) { PT0(0);
            PHASE_CTX;
            pg8::DenseOrder S{(const bf16*)(C.ws + WS_XB), (const bf16*)(C.ws + WS_WIN) + (size_t)layer * NP1 * DM, DM, DM, M / 256, NP1 / 256, C.G, C.bx, REPN(0)};
            EpiInProj E{(bf16*)(sc + SC_CQKV), (bf16*)(sc + SC_CQKV) + (size_t)M * 256, (float*)(sc + SC_KR), (float*)(sc + SC_FL), (bf16*)(sc + SC_FQ), (bf16*)(sc + SC_CI)};
            pg8::gemm_phase<EpiInProj, pg8::DenseOrder, false, DM, DM, DM>(C.lds, C.tid, S, E);
            if (C.bx >= C.G / 2) ffn_weights(C, A, layer, (C.bx - C.G / 2) * NWAVES + C.wave, (C.G / 2) * NWAVES, 0, ffn_split(layer));
            PEND(0, SEAM(P + 0));
        }
        if (EN(1) && IN(P + 1)) { PT0(1); PHASE_CTX; p2_thin(C, A, layer); PEND(1, SEAM(P + 1)); }
        if (EN(2) && IN(P + 2)) { PT0(2);
            PHASE_CTX;
            struct QkvOrder { const bf16* A; const bf16* Bt; int G, c, rep;
                __device__ __forceinline__ bool next(int i, pg8::Unit& u) const { return pg8::tile_order_rep(i, G, c, M / 256, 7, rep, u.pm, u.pn); }
                __device__ __forceinline__ const char* a_base(const pg8::Unit& u) const { return (const char*)(A + (u.pn < 3 ? (size_t)0 : (size_t)M * 256)) + (size_t)u.pm * 256 * 256 * 2; }
                __device__ __forceinline__ const char* b_base(const pg8::Unit& u) const { return (const char*)Bt + (size_t)u.pn * 256 * 256 * 2; }
                __device__ __forceinline__ int tok(const pg8::Unit&, int) const { return 0; }
                __device__ __forceinline__ int ktiles(const pg8::Unit& u, int nt) const { return u.pn < 3 ? nt : nt / 2; } };
            QkvOrder S{(const bf16*)(sc + SC_CQKV), (const bf16*)(C.ws + WS_WQ2) + (size_t)layer * NP1 * 256, C.G, C.bx, REPN(2)};
            EpiQKV E{(bf16*)(sc + SC_QM), (bf16*)(sc + SC_KM), (bf16*)(sc + SC_VM), (const float*)(C.ws + WS_TAB), (const float*)(C.ws + WS_TAB) + (size_t)M * 16};
            pg8::gemm_phase<EpiQKV, QkvOrder, false, 256, 256, 256>(C.lds, C.tid, S, E);
            PEND(2, SEAM(P + 2));
        }
        if (EN(3) && IN(P + 3)) { PT0(3);
            PHASE_CTX;
            bf16* MIXED = (bf16*)(sc + SC_MIXED);
            for (int p = C.vcu; p < 512; p += C.G) { const int bh = p >> 3, s = p & 7;
                for (int i = 0; i < 2; ++i) att::attn_unit<96, false>(bh >> 3, bh & 7, i == 0 ? 15 - s : s, (const bf16*)(sc + SC_QM), 768, (const bf16*)(sc + SC_KM), 768, (const bf16*)(sc + SC_VM), 512, MIXED, 1024, (bh & 7) * 64, nullptr, C.lds, C.tid, (float*)(sc + SC_SSQ), bh & 7, nullptr);
            }
            { volatile LAS unsigned* qw = (volatile LAS unsigned*)(C.lds + RING_BYTES + 8192); const int xb = C.bx & 7; unsigned* qctr = C.ctl + CW_ATTQ + layer * 8 + xb;
              const bf16* FQ = (const bf16*)(sc + SC_FQ);
              for (;;) {
                if (C.tid == 0) qw[0] = __hip_atomic_fetch_add(qctr, 1u, RLX_AGENT);
                asm volatile("s_waitcnt vmcnt(0) lgkmcnt(0)\n\ts_barrier" ::: "memory");
                const int idx = __builtin_amdgcn_readfirstlane((int)qw[0]);
                if (idx >= 64) break;
                const int hd = idx & 3, qb = 15 - (idx >> 2), bh = xb * 4 + hd;
                att::attn_unit<64, true>(xb, hd, qb, FQ, 256, FQ + (size_t)M * 256, 256, FQ + (size_t)2 * M * 256, 256, MIXED, 1024, 512 + hd * 64, (const float*)(sc + SC_CUM), C.lds, C.tid, (float*)(sc + SC_SSQ), 8 + hd, C.ctl + CW_QKMAX + layer * 64 + bh * 2);
              }
            }
            PEND(3, SEAM(P + 3));
        }
        if (EN(5) && IN(P + 5)) { PT0(5);
            PHASE_CTX;
            pg8::DenseOrder S{(const bf16*)(sc + SC_MIXED), (const bf16*)(C.ws + WS_WOUT) + (size_t)layer * DM * DM, DM, DM, M / 256, DM / 256, C.G, C.bx, REPN(5)};
            EpiBf16<DM, false> E{(bf16*)(sc + SC_MIXOUT), DM / 256, nullptr};
            pg8::gemm_phase<EpiBf16<DM, false>, pg8::DenseOrder, false, DM, DM, DM, true>(C.lds, C.tid, S, E, (const float*)(sc + SC_SSQ));
            PEND(5, SEAM(P + 5));
        }
        if (EN(6) && IN(P + 6)) { PT0(6);
            if (moe) { PHASE_CTX; ln_pass<1>(C, false, (const bf16*)(sc + SC_MIXOUT), A->in[15] + layer * DM, A->in[16] + layer * DM, A->in[20] + (size_t)(layer >> 1) * DM * NEXP); }
            else     { PHASE_CTX; ln_pass<0>(C, false, (const bf16*)(sc + SC_MIXOUT), A->in[15] + layer * DM, A->in[16] + layer * DM, nullptr); }
            PEND(6, SEAM(P + 6));
        }
        if (EN(7) && IN(P + 7) && moe) { PT0(7); { PHASE_CTX; moe_assign(C); } PEND(7, SEAM(P + 7)); }
        if (EN(8) && IN(P + 8)) { PT0(8);
            if (moe) {
                PHASE_CTX; bf16* W13 = (bf16*)(C.ws + WS_WFFN); bf16* HID = (bf16*)(sc + SC_HID);
                const int* seg = (const int*)(C.ctl + CW_SEG);
                MoeOrder S{(const bf16*)(C.ws + WS_XB), W13, DM, DM, seg[8] / 256, 11, C.G, C.bx, REPN(8), (const int*)(C.ws + WS_MOE + MT_SLOTTOK), seg[1], seg[2], seg[3], seg[4], seg[5], seg[6], seg[7]};
                EpiSwiGLU<DFE> E{HID, 11};
                pg8::gemm_phase<EpiSwiGLU<DFE>, MoeOrder, true, DM, DM, DM>(C.lds, C.tid, S, E);
            } else {
                PHASE_CTX; bf16* W13 = (bf16*)(C.ws + WS_WFFN); bf16* HID = (bf16*)(sc + SC_HID);
                pg8::DenseOrder S{(const bf16*)(C.ws + WS_XB), W13, DM, DM, M / 256, 2 * DFF / 256, C.G, C.bx, REPN(8)};
                EpiSwiGLU<DFF> E{HID, 1 << 30};
                pg8::gemm_phase<EpiSwiGLU<DFF>, pg8::DenseOrder, false, DM, DM, DM>(C.lds, C.tid, S, E);
            }
            PEND(8, SEAM(P + 8));
        }
        if (EN(9) && IN(P + 9)) { PT0(9);
            if (moe) {
                PHASE_CTX; bf16* W2T = (bf16*)(C.ws + WS_WFFN) + WF_W13_ELEMS; bf16* HID = (bf16*)(sc + SC_HID); bf16* FF = (bf16*)(sc + SC_FF);
                const int* seg = (const int*)(C.ctl + CW_SEG);
                MoeOrder S{HID, W2T, DFE, DFE, seg[8] / 256, 4, C.G, C.bx, REPN(9), nullptr, seg[1], seg[2], seg[3], seg[4], seg[5], seg[6], seg[7]};
                EpiBf16<DM, true> E{FF, 4, (const float*)(C.ws + WS_MOE + MT_SLOTGATE)};
                pg8::gemm_phase<EpiBf16<DM, true>, MoeOrder, false, DFE, DFE, DFE>(C.lds, C.tid, S, E);
            } else {
                PHASE_CTX; bf16* W2T = (bf16*)(C.ws + WS_WFFN) + WF_W13_ELEMS; bf16* HID = (bf16*)(sc + SC_HID); bf16* FF = (bf16*)(sc + SC_FF);
                pg8::DenseOrder S{HID, W2T, DFF, DFF, M / 256, DM / 256, C.G, C.bx, REPN(9)};
                EpiBf16<DM, false> E{FF, DM / 256, nullptr};
                pg8::gemm_phase<EpiBf16<DM, false>, pg8::DenseOrder, false, DFF, DFF, DFF>(C.lds, C.tid, S, E);
            }
            PEND(9, SEAM(P + 9));
        }
        if (EN(10) && IN(P + 10)) { PT0(10);
            if (moe) { PHASE_CTX; ln_pass<2>(C, layer == DEPTH - 1, (const bf16*)(sc + SC_FF), A->in[24] + layer * DM, A->in[25] + layer * DM, nullptr); }
            else     { PHASE_CTX; ln_pass<0>(C, layer == DEPTH - 1, (const bf16*)(sc + SC_FF), A->in[24] + layer * DM, A->in[25] + layer * DM, nullptr); }
            PEND(10, if (layer < DEPTH - 1) SEAM(P + 10));
        }
    }
#undef IN
#undef SEAM
}

extern "C" void kernel_launch(void* const* d_in, const int* in_sizes, int n_in, void* d_out, int out_size, void* d_ws, size_t ws_size, hipStream_t stream) {
    static int grid = 0;
    if (grid == 0) {
        if (n_in != 26 || out_size != M * DM || ws_size < WS_END) { fprintf(stderr, "kernel_launch: unexpected problem (n_in %d, out %d, ws %zu < %zu)\n", n_in, out_size, ws_size, (size_t)WS_END); grid = -1; return; }
        int dev = 0, cus = 0, per_cu = 0;
        if (hipGetDevice(&dev) != hipSuccess || hipDeviceGetAttribute(&cus, hipDeviceAttributeMultiprocessorCount, dev) != hipSuccess) { grid = -1; return; }
        if (hipFuncSetAttribute((const void*)fwd_kernel, hipFuncAttributeMaxDynamicSharedMemorySize, LDS_BYTES) != hipSuccess) { fprintf(stderr, "kernel_launch: hipFuncSetAttribute failed\n"); grid = -1; return; }
        if (hipOccupancyMaxActiveBlocksPerMultiprocessor(&per_cu, (const void*)fwd_kernel, NTHR, LDS_BYTES) != hipSuccess || per_cu < 1) fprintf(stderr, "kernel_launch: occupancy query says %d\n", per_cu);
        (void)hipGetLastError();
        grid = 256; while (grid > cus && grid > 8) grid >>= 1;
    }
    if (grid < 0) return;
    (void)hipMemsetAsync((char*)d_ws + WS_CTL, 0, CTL_ZERO_BYTES, stream);
    Args a{};
    for (int i = 0; i < 26; ++i) a.in[i] = (const float*)d_in[i];
    a.out = (float*)d_out; a.ws = (unsigned char*)d_ws;
#if MK_PER_PHASE
    for (int p = 0; p < N_PHASES; ++p) { a.ph_lo = p; a.ph_hi = p + 1; hipLaunchKernelGGL(fwd_kernel, dim3(grid), dim3(NTHR), LDS_BYTES, stream, a); }
#else
    a.ph_lo = 0; a.ph_hi = N_PHASES;
    hipLaunchKernelGGL(fwd_kernel, dim3(grid), dim3(NTHR), LDS_BYTES, stream, a);
#endif
}
```

```cpp
#include <hip/hip_runtime.h>
#include <cstdio>
#include <cstdint>
#include <cmath>

#ifndef REP_MASK
#define REP_MASK 0x0
#endif
#ifndef PROBE_MASK
#define PROBE_MASK 0x0
#endif
#define PROBE_ON(k) ((PROBE_MASK >> (k)) & 1)
#define PT0(k) unsigned long long pt0_ = 0ull; if (PROBE_ON(k)) pt0_ = __builtin_amdgcn_s_memrealtime()
#ifndef PROBE_BEFORE
#define PROBE_BEFORE 0
#endif
#define PSPIN(d) do { const unsigned long long pt1_ = __builtin_amdgcn_s_memrealtime(); while (__builtin_amdgcn_s_memrealtime() - pt1_ < (d)) __builtin_amdgcn_s_sleep(8); } while (0)
#define PEND(k, seamexpr) do { unsigned long long pd_ = 0ull; if (PROBE_ON(k)) { pd_ = __builtin_amdgcn_s_memrealtime() - pt0_; if (PROBE_BEFORE) PSPIN(pd_); } seamexpr; \
        if (PROBE_ON(k) && !PROBE_BEFORE) PSPIN(pd_); } while (0)
#define REPN(p) (1 + ((REP_MASK >> (p)) & 1))
#define REPS(p) for (int rep_ = 0; rep_ < 1 + ((REP_MASK >> (p)) & 1); ++rep_)
#define GAS __attribute__((address_space(1)))
#define LAS __attribute__((address_space(3)))
typedef unsigned short bf16;
typedef short bf16x8 __attribute__((ext_vector_type(8)));
typedef short s16x4 __attribute__((ext_vector_type(4)));
typedef float f32x2 __attribute__((ext_vector_type(2)));
typedef float f32x4 __attribute__((ext_vector_type(4)));
typedef float f32x16 __attribute__((ext_vector_type(16)));
typedef unsigned u32x2 __attribute__((ext_vector_type(2)));
typedef unsigned u32x4 __attribute__((ext_vector_type(4)));
typedef __bf16 bf16x2_t __attribute__((ext_vector_type(2)));

constexpr int BATCH = 8, SEQ = 4096, DM = 1024, M = BATCH * SEQ, DEPTH = 4;
constexpr int IN_COLS = 1700, NP1 = 1792;
constexpr int DFF = 2816, DFE = 1408, NEXP = 8;
constexpr int NWAVES = 8, NTHR = 512;
constexpr float ALPHA = 1.6817928305074290f;
constexpr float EPS = 1e-5f;
constexpr float LOG2E = 1.4426950408889634f;
constexpr float C2_MLA = 0.10206207261596577f * LOG2E;
constexpr float C2_FOX = 0.125f * LOG2E;
constexpr int PC_CQ = 0, PC_CKV = 256, PC_KR = 384, PC_FL = 416, PC_FQ = 512, PC_FK = 768, PC_FV = 1024, PC_CI = 1280;
constexpr int MOE_ROWS_MAX = 2 * M + NEXP * 256;

constexpr size_t MiB = 1u << 20;
constexpr size_t WS_CTL = 0, CTL_ZERO_BYTES = 1 * MiB;
constexpr size_t WS_WIN = 1 * MiB;
constexpr size_t WS_WQ2 = WS_WIN + 14 * MiB;
constexpr size_t WS_WOUT = WS_WQ2 + 4 * MiB;
constexpr size_t WS_TAB = WS_WOUT + 8 * MiB;
constexpr size_t WS_MOE = WS_TAB + 4 * MiB;
constexpr size_t WS_WFFN = WS_MOE + 2 * MiB;
constexpr size_t WS_XB = WS_WFFN + 68 * MiB;
constexpr size_t WS_SCR = WS_XB + 64 * MiB;
constexpr size_t SC_CQKV = 0;
constexpr size_t SC_KR = SC_CQKV + 32 * MiB;
constexpr size_t SC_FL = SC_KR + 4 * MiB;
constexpr size_t SC_CUM = SC_FL + MiB / 2;
constexpr size_t SC_FQ = SC_CUM + MiB / 2;
constexpr size_t SC_CI = SC_FQ + 48 * MiB;
constexpr size_t SC_QM = SC_CI + 32 * MiB;
constexpr size_t SC_KM = SC_QM + 48 * MiB;
constexpr size_t SC_VM = SC_KM + 48 * MiB;
constexpr size_t SC_MIXED = SC_VM + 32 * MiB;
constexpr size_t SC_MIXOUT = SC_QM;
constexpr size_t SC_SSQ = SC_MIXED + 64 * MiB;
constexpr size_t SC_MIX_END = SC_SSQ + 2 * MiB;
constexpr size_t SC_HID = 0;
constexpr size_t SC_FF = 182 * MiB;
constexpr size_t SC_END = 316 * MiB;
constexpr size_t WS_END = WS_SCR + SC_END;
static_assert(SC_MIX_END <= SC_END && SC_FF + (size_t)MOE_ROWS_MAX * 1024 * 2 <= SC_END && (size_t)MOE_ROWS_MAX * DFE * 2 <= SC_FF, "scratch map");
static_assert(WS_END <= 512 * MiB, "workspace map");
constexpr size_t WF_W13_ELEMS = (size_t)NEXP * 2 * DFE * DM;
constexpr size_t MT_TOPE = 0;
constexpr size_t MT_TOPG = 256 * 1024;
constexpr size_t MT_TOKSLOT = 512 * 1024;
constexpr size_t MT_SLOTTOK = 768 * 1024;
constexpr size_t MT_SLOTGATE = 768 * 1024 + 272 * 1024;
static_assert((size_t)MOE_ROWS_MAX * 4 <= 272 * 1024 && MT_SLOTGATE + 272 * 1024 <= 2 * MiB, "moe tables");
constexpr int CW_BAR = 4096;
constexpr int CW_CNTB = 16384;
constexpr int CW_SEG = 20480;
constexpr int CW_ATTQ = 2048;
constexpr int CW_LEFT = 2112;
constexpr int CW_QKMAX = 1024;

constexpr int RING_BYTES = 131072;
constexpr int LDSCTL_OFF = RING_BYTES, MISC_OFF = LDSCTL_OFF + 320;
constexpr int LDS_BYTES = 147456;

#define RLX_AGENT __ATOMIC_RELAXED, __HIP_MEMORY_SCOPE_AGENT
__device__ __forceinline__ unsigned pk2(float lo, float hi) { f32x2 v = {lo, hi}; bf16x2_t b = __builtin_convertvector(v, bf16x2_t); return __builtin_bit_cast(unsigned, b); }
__device__ __forceinline__ float bf2f(unsigned short u) { return __uint_as_float((unsigned)u << 16); }
__device__ __forceinline__ float bflo(unsigned u) { return __uint_as_float(u << 16); }
__device__ __forceinline__ float bfhi(unsigned u) { return __uint_as_float(u & 0xffff0000u); }
__device__ __forceinline__ float fexp2(float x) { return __builtin_amdgcn_exp2f(x); }
__device__ __forceinline__ float frcp(float x) { return __builtin_amdgcn_rcpf(x); }
__device__ __forceinline__ float sigmoidf_(float x) { return frcp(1.0f + fexp2(-x * LOG2E)); }
__device__ __forceinline__ float siluf_(float x) { return x * sigmoidf_(x); }
template <int O> __device__ __forceinline__ float lane_xor(float v) {
    if constexpr (O < 32) return __int_as_float(__builtin_amdgcn_ds_swizzle(__float_as_int(v), (O << 10) | 0x1f));
    else { auto rr = __builtin_amdgcn_permlane32_swap(__float_as_uint(v), __float_as_uint(v), false, false); return __uint_as_float(rr[0]) == v ? __uint_as_float(rr[1]) : __uint_as_float(rr[0]); }
}
__device__ __forceinline__ float wave_sum(float v) {
    v += lane_xor<1>(v); v += lane_xor<2>(v); v += lane_xor<4>(v); v += lane_xor<8>(v); v += lane_xor<16>(v);
    { auto rr = __builtin_amdgcn_permlane32_swap(__float_as_uint(v), __float_as_uint(v), false, false); v = __uint_as_float(rr[0]) + __uint_as_float(rr[1]); }
    return v;
}
__device__ __forceinline__ int wave_sum_i(int v) {
    v += __builtin_amdgcn_ds_swizzle(v, (1 << 10) | 0x1f); v += __builtin_amdgcn_ds_swizzle(v, (2 << 10) | 0x1f); v += __builtin_amdgcn_ds_swizzle(v, (4 << 10) | 0x1f);
    v += __builtin_amdgcn_ds_swizzle(v, (8 << 10) | 0x1f); v += __builtin_amdgcn_ds_swizzle(v, (16 << 10) | 0x1f);
    { auto rr = __builtin_amdgcn_permlane32_swap((unsigned)v, (unsigned)v, false, false); v = (int)(rr[0] + rr[1]); }
    return v;
}
__device__ __forceinline__ u32x4 pack8(const f32x4 a, const f32x4 b) { u32x4 w; w.x = pk2(a[0], a[1]); w.y = pk2(a[2], a[3]); w.z = pk2(b[0], b[1]); w.w = pk2(b[2], b[3]); return w; }

#define XB_TMO      128
#define XB_XCNT(j)  (256  + 64 * (j))
#define XB_XSUB(j)  (1280 + 64 * (j))
#define XB_XGEN(j)  (2304 + 64 * (j))
#define XB_TOP      3328
#define XB_TOPGEN   3392
#define XCD_BAR_WORDS 3456
#define XB_SPIN_CAP (1u << 18)
__device__ __forceinline__ unsigned xb_ld(unsigned* p)              { return __hip_atomic_load(p, __ATOMIC_RELAXED, __HIP_MEMORY_SCOPE_AGENT); }
__device__ __forceinline__ unsigned xb_add(unsigned* p, unsigned v) { return __hip_atomic_fetch_add(p, v, __ATOMIC_RELAXED, __HIP_MEMORY_SCOPE_AGENT); }
__device__ __forceinline__ unsigned xb_xcc_id() { return (unsigned)__builtin_amdgcn_s_getreg((3 << 11) | 20) & 0xFu; }
#define XB_SPIN(cond, bar) do { unsigned _sp = 0; while (cond) { __builtin_amdgcn_s_sleep(1); \
    if ((++_sp & 255u) == 0u) { if (xb_ld(&(bar)[XB_TMO])) break; if (_sp > XB_SPIN_CAP) { atomicAdd(&(bar)[XB_TMO], 1u); break; } } } } while (0)
struct XcdBarrier { unsigned* bar; unsigned x; volatile LAS unsigned* st; };
__device__ __forceinline__ bool xb_is_t0(int wave0) { unsigned ones = ~0u; asm volatile("" : "+s"(ones)); return wave0 == 0 && __builtin_amdgcn_mbcnt_hi(ones, __builtin_amdgcn_mbcnt_lo(ones, 0u)) == 0u; }
__device__ __forceinline__ XcdBarrier xcd_barrier_post(unsigned* bar, volatile LAS unsigned* st, int wave0) {
    XcdBarrier b; b.bar = bar; b.x = xb_xcc_id(); b.st = st;
    if (xb_is_t0(wave0)) (void)xb_add(&bar[XB_XCNT(b.x)], 1u);
    return b;
}
__device__ __forceinline__ void xcd_barrier_complete(unsigned* bar, unsigned x, unsigned& nloc, unsigned& nx) {
    const unsigned G = gridDim.x * gridDim.y * gridDim.z;
    unsigned sum, cnt, mine, sp = 0u;
    for (;;) {
        sum = 0u; cnt = 0u; mine = 0u;
#pragma unroll
        for (unsigned j = 0; j < 16; ++j) { const unsigned c = xb_ld(&bar[XB_XCNT(j)]); sum += c; cnt += (c > 0u) ? 1u : 0u; mine = (j == x) ? c : mine; }
        if (sum == G) break;
        __builtin_amdgcn_s_sleep(1);
        if ((++sp & 255u) == 0u) { if (xb_ld(&bar[XB_TMO])) break; if (sp > XB_SPIN_CAP) { atomicAdd(&bar[XB_TMO], 1u); break; } }
    }
    nloc = mine > 0u ? mine : 1u; nx = cnt > 0u ? cnt : 1u;
}
template <bool FIRST>
__device__ __forceinline__ void xcd_barrier(const XcdBarrier& b, int wave0) {
    asm volatile("s_waitcnt vmcnt(0)" ::: "memory");
    __syncthreads();
    if (xb_is_t0(wave0)) {
        unsigned* bar = b.bar;
        __builtin_amdgcn_s_waitcnt(0);
        unsigned nloc = b.st[0], nx = b.st[1];
        if constexpr (FIRST) { if (nloc == 0u) { xcd_barrier_complete(bar, b.x, nloc, nx); b.st[0] = nloc; b.st[1] = nx; } }
        const unsigned old = xb_add(&bar[XB_XSUB(b.x)], 1u);
        const unsigned gen = old / nloc;
        if (old + 1u == (gen + 1u) * nloc) {
            __builtin_amdgcn_fence(__ATOMIC_RELEASE, "agent");
            asm volatile("s_waitcnt vmcnt(0)" ::: "memory");
            const unsigned og = xb_add(&bar[XB_TOP], 1u);
            const unsigned tg = og / nx;
            if (og + 1u == (tg + 1u) * nx) xb_add(&bar[XB_TOPGEN], 1u);
            else XB_SPIN(xb_ld(&bar[XB_TOPGEN]) == tg, bar);
            __builtin_amdgcn_fence(__ATOMIC_ACQUIRE, "agent");
            xb_add(&bar[XB_XGEN(b.x)], 1u);
            asm volatile("s_waitcnt vmcnt(0)" ::: "memory");
        } else {
            XB_SPIN(xb_ld(&bar[XB_XGEN(b.x)]) == gen, bar);
            __builtin_amdgcn_fence(__ATOMIC_ACQUIRE, "agent");
            asm volatile("s_waitcnt vmcnt(0)" ::: "memory");
        }
    }
    __syncthreads();
}

namespace pg8 {
constexpr int BM = 256, BK = 64, HALF = 128, HTB = HALF * BK * 2, STAGE_BYTES = 8 * HTB, NXCD = 8, WGM = 8;
__host__ __device__ __forceinline__ int lds_byte(int r, int c) { const int st = (r >> 4) * 2 + (c >> 5), rr = r & 15, cc = c & 31, ob = rr * 64 + cc * 2; return st * 1024 + (ob ^ (((ob >> 9) & 1) << 5)); }
__host__ __device__ __forceinline__ void stage_rc(int b, int& R, int& C) { const int st = b / 1024, sb = b % 1024, swz = sb ^ (((sb >> 9) & 1) << 5); R = (st >> 1) * 16 + swz / 64; C = (st & 1) * 32 + (swz % 64) / 2; }
__host__ __device__ __forceinline__ int perm32(int rho) { const int n = rho >> 4, i = rho & 15; return 8 * (i >> 2) + 4 * n + (i & 3); }
struct Unit { int pm, pn; };

__device__ __forceinline__ bool tile_order(long L, int nM, int nN, int& pm, int& pn) {
    const int nwg = nM * nN; if (L >= nwg) return false;
    int wgid = (int)L; { const int q = nwg / NXCD, r = nwg % NXCD, xcd = wgid % NXCD, off = wgid / NXCD; wgid = (xcd < r ? xcd * (q + 1) : r * (q + 1) + (xcd - r) * q) + off; }
    const int nig = WGM * nN, gid = wgid / nig, fm = gid * WGM, gsz = (nM - fm) < WGM ? (nM - fm) : WGM;
    pm = fm + ((wgid % nig) % gsz); pn = (wgid % nig) / gsz; return true;
}
__device__ __forceinline__ bool tile_order_rep(int i, int G, int c, int nM, int nN, int rep, int& pm, int& pn) {
    if (rep == 1) return tile_order((long)i * G + c, nM, nN, pm, pn);
    const int nwg = nM * nN, per = c < nwg ? (nwg - c + G - 1) / G : 0; if (i >= per * rep) return false;
    return tile_order((long)(i % per) * G + c, nM, nN, pm, pn);
}
struct DenseOrder {
    const bf16* A; const bf16* Bt; int lda, ldb, nM, nN, G, c, rep;
    __device__ __forceinline__ bool next(int i, Unit& u) const { return tile_order_rep(i, G, c, nM, nN, rep, u.pm, u.pn); }
    __device__ __forceinline__ const char* a_base(const Unit& u) const { return (const char*)A + (size_t)u.pm * BM * lda * 2; }
    __device__ __forceinline__ const char* b_base(const Unit& u) const { return (const char*)Bt + (size_t)u.pn * BM * ldb * 2; }
    __device__ __forceinline__ int tok(const Unit&, int) const { return 0; }
    __device__ __forceinline__ int ktiles(const Unit&, int nt) const { return nt; }
};

template <class Epi, class Sched, bool GATHER, int K, int lda, int ldb, bool SEGSCALE = false>
__device__ __forceinline__ void gemm_phase(LAS unsigned char* lds, const int tid, const Sched& S, const Epi& E, const float* ssq = nullptr) {
    const int wid = __builtin_amdgcn_readfirstlane(tid >> 6), lane = tid & 63, wr = wid >> 2, wc = wid & 3, fr = lane & 15, fq = lane >> 4;
    constexpr int nt = K / BK;
    unsigned voffA[2], voffB[2];
#pragma unroll
    for (int i = 0; i < 2; ++i) { int R, C; stage_rc(tid * 16 + i * 8192, R, C); const int Rb = Epi::PERM ? ((R & ~31) + perm32(R & 31)) : R;
        voffA[i] = (unsigned)(R * lda + C) * 2u; voffB[i] = (unsigned)(Rb * ldb + C) * 2u; }
#define PG8_GOFF(u_, h_, o0_, o1_) do { unsigned ones_ = ~0u; asm volatile("" : "+s"(ones_)); const int t_ = wid * 64 + (int)__builtin_amdgcn_mbcnt_hi(ones_, __builtin_amdgcn_mbcnt_lo(ones_, 0u)); \
        int R0_, C0_, R1_, C1_; stage_rc(t_ * 16, R0_, C0_); stage_rc(t_ * 16 + 8192, R1_, C1_); \
        o0_ = (unsigned)S.tok(u_, (h_) * HALF + R0_) * (unsigned)(lda * 2) + (unsigned)(C0_ * 2); o1_ = (unsigned)S.tok(u_, (h_) * HALF + R1_) * (unsigned)(lda * 2) + (unsigned)(C1_ * 2); } while (0)
    const size_t kstep = (size_t)(BK * 2);
    constexpr size_t hstepA = (size_t)HALF * lda * 2, hstepB = (size_t)HALF * ldb * 2;
    const unsigned ldsw = (unsigned)wid * 1024u;
    const int aoff = lds_byte(wr * 64 + fr, fq * 8), boff = lds_byte(wc * 32 + fr, fq * 8);
#define PG8_SA(b, h) (((b) * 2 + (h)) * HTB)
#define PG8_SB(b, h) ((4 + (b) * 2 + (h)) * HTB)
#define PG8_STAGE(bufoff, gbase, v0, v1) do { \
        __builtin_amdgcn_global_load_lds((const unsigned*)((const char*)(gbase) + (v0)), (LAS unsigned*)(lds + (bufoff) + ldsw), 16, 0, 0); \
        __builtin_amdgcn_global_load_lds((const unsigned*)((const char*)(gbase) + (v1)), (LAS unsigned*)(lds + (bufoff) + ldsw + 8192), 16, 0, 0); } while (0)
#define PG8_STB(bufoff, gbase) PG8_STAGE(bufoff, gbase, voffB[0], voffB[1])
#define PG8_STA(bufoff, gbase, h, G0, G1) do { if constexpr (GATHER) PG8_STAGE(bufoff, gbase, G0, G1); else PG8_STAGE(bufoff, (gbase) + (h) * hstepA, voffA[0], voffA[1]); } while (0)
#define PG8_LDA(dst, b, h) do { _Pragma("unroll") for (int m = 0; m < 4; ++m) _Pragma("unroll") for (int k = 0; k < 2; ++k) dst[m][k] = *(const LAS bf16x8*)(lds + PG8_SA(b, h) + aoff + m * 2048 + k * 1024); } while (0)
#define PG8_LDB(dst, b, h) do { _Pragma("unroll") for (int n = 0; n < 2; ++n) _Pragma("unroll") for (int k = 0; k < 2; ++k) dst[n][k] = *(const LAS bf16x8*)(lds + PG8_SB(b, h) + boff + n * 2048 + k * 1024); } while (0)
#define PG8_MMA(ai, bj, At, Bt) do { __builtin_amdgcn_s_setprio(1); _Pragma("unroll") for (int m = 0; m < 4; ++m) _Pragma("unroll") for (int n = 0; n < 2; ++n) _Pragma("unroll") for (int k = 0; k < 2; ++k) \
        acc[ai][bj][m][n] = __builtin_amdgcn_mfma_f32_16x16x32_bf16(Bt[n][k], At[m][k], acc[ai][bj][m][n], 0, 0, 0); __builtin_amdgcn_s_setprio(0); } while (0)
#define PG8_WAIT_V(n) asm volatile("s_waitcnt vmcnt(" #n ")" ::: "memory")
#define PG8_WAIT_L(n) asm volatile("s_waitcnt lgkmcnt(" #n ")" ::: "memory")
#define PG8_BAR __builtin_amdgcn_s_barrier()
#define PG8_SCHED __builtin_amdgcn_sched_barrier(0)
    Unit cur, nxt; int ui = 0;
    if (!S.next(0, cur)) return;
    f32x4 acc[2][2][4][2];
#pragma unroll
    for (int a = 0; a < 2; ++a)
#pragma unroll
        for (int b = 0; b < 2; ++b)
#pragma unroll
            for (int m = 0; m < 4; ++m)
#pragma unroll
                for (int n = 0; n < 2; ++n) acc[a][b][m][n] = (f32x4){0.f, 0.f, 0.f, 0.f};
    bf16x8 At[4][2], B0[2][2], B1[2][2];
    const char* cA = S.a_base(cur); const char* cB = S.b_base(cur);
    unsigned gc00 = 0, gc01 = 0, gc10 = 0, gc11 = 0, gn00 = 0, gn01 = 0, gn10 = 0, gn11 = 0;
    if constexpr (GATHER) { PG8_GOFF(cur, 0, gc00, gc01); PG8_GOFF(cur, 1, gc10, gc11); }
    PG8_STB(PG8_SB(0, 0), cB); PG8_STB(PG8_SB(0, 1), cB + hstepB); PG8_STA(PG8_SA(0, 0), cA, 0, gc00, gc01); PG8_STA(PG8_SA(0, 1), cA, 1, gc10, gc11);
    if (wr == 1) PG8_BAR;
    PG8_WAIT_V(2); PG8_BAR;
    PG8_STB(PG8_SB(1, 0), cB + kstep); PG8_STA(PG8_SA(1, 0), cA + kstep, 0, gc00, gc01); PG8_STB(PG8_SB(1, 1), cB + hstepB + kstep);
    PG8_WAIT_V(6); PG8_BAR;
    for (;;) {
        const bool has_next = S.next(ui + 1, nxt);
        const char* nA = has_next ? S.a_base(nxt) : cA; const char* nB = has_next ? S.b_base(nxt) : cB;
        if constexpr (SEGSCALE) {
            if (tid < 256) { const f32x4* sp = (const f32x4*)(ssq + (size_t)(cur.pm * 256 + tid) * 12); const f32x4 a = sp[0], b = sp[1], c = sp[2];
                const float sm = ((a[0] + a[1]) + (a[2] + a[3])) + ((b[0] + b[1]) + (b[2] + b[3])), sf = (c[0] + c[1]) + (c[2] + c[3]);
                const float rm = 1.0f / sqrtf(sm * (1.0f / 512) + EPS), rf = 1.0f / sqrtf(sf * (1.0f / 256) + EPS);
                *(LAS f32x2*)(lds + STAGE_BYTES + 1024 + tid * 8) = (f32x2){rm / rf, rf}; }
        }
        if constexpr (GATHER) {
            if (has_next) { PG8_GOFF(nxt, 0, gn00, gn01); PG8_GOFF(nxt, 1, gn10, gn11); }
            else { gn00 = gc00; gn01 = gc01; gn10 = gc10; gn11 = gc11; }
        }
        const int ntu = S.ktiles(cur, nt);
#pragma nounroll
        for (int t = 0; t < ntu; t += 2) {
            const bool last = (t == ntu - 2);
            const char* a1 = cA + (size_t)(t + 1) * kstep;
            const char* a2 = last ? nA : cA + (size_t)(t + 2) * kstep; const char* b2 = last ? nB : cB + (size_t)(t + 2) * kstep;
            const char* a3 = a2 + kstep; const char* b3 = b2 + kstep;
            const unsigned g00 = last ? gn00 : gc00, g01 = last ? gn01 : gc01, g10 = last ? gn10 : gc10, g11 = last ? gn11 : gc11;
            PG8_LDB(B0, 0, 0); PG8_LDB(B1, 0, 1); PG8_SCHED; PG8_LDA(At, 0, 0); PG8_STA(PG8_SA(1, 1), a1, 1, gc10, gc11);
            PG8_WAIT_V(8); PG8_WAIT_L(0); PG8_BAR; PG8_MMA(0, 0, At, B0); PG8_MMA(0, 1, At, B1); PG8_BAR; PG8_SCHED;
            PG8_LDA(At, 0, 1); PG8_STB(PG8_SB(0, 0), b2); PG8_STB(PG8_SB(0, 1), b2 + hstepB); PG8_STA(PG8_SA(0, 0), a2, 0, g00, g01);
            PG8_WAIT_V(8); PG8_WAIT_L(0); PG8_BAR; PG8_MMA(1, 0, At, B0); PG8_MMA(1, 1, At, B1); PG8_BAR; PG8_SCHED;
            PG8_LDB(B0, 1, 0); PG8_LDB(B1, 1, 1); PG8_SCHED; PG8_LDA(At, 1, 0); PG8_STA(PG8_SA(0, 1), a2, 1, g10, g11);
            PG8_WAIT_V(8); PG8_WAIT_L(0); PG8_BAR; PG8_MMA(0, 0, At, B0); PG8_MMA(0, 1, At, B1); PG8_BAR; PG8_SCHED;
            PG8_LDA(At, 1, 1); PG8_STB(PG8_SB(1, 0), b3); PG8_STB(PG8_SB(1, 1), b3 + hstepB); PG8_STA(PG8_SA(1, 0), a3, 0, g00, g01);
            PG8_WAIT_V(8); PG8_WAIT_L(0); PG8_BAR; PG8_MMA(1, 0, At, B0); PG8_MMA(1, 1, At, B1); PG8_BAR; PG8_SCHED;
            if constexpr (SEGSCALE) {
                if (t == 6 || t == 10) {
                    unsigned ones_ = ~0u; asm volatile("" : "+s"(ones_)); const int fr_ = (int)__builtin_amdgcn_mbcnt_hi(ones_, __builtin_amdgcn_mbcnt_lo(ones_, 0u)) & 15;
                    const LAS float* fp = (const LAS float*)(lds + STAGE_BYTES + 1024) + (wr * 64 + fr_) * 2 + (t == 10 ? 1 : 0);
#pragma unroll
                    for (int ai = 0; ai < 2; ++ai)
#pragma unroll
                        for (int m = 0; m < 4; ++m) { const float f = fp[(ai * 128 + m * 16) * 2];
#pragma unroll
                            for (int bj = 0; bj < 2; ++bj)
#pragma unroll
                                for (int n = 0; n < 2; ++n) acc[ai][bj][m][n] *= f; }
                    PG8_SCHED;
                }
            }
        }
        if (wr == 0) PG8_BAR;
        { unsigned ones_ = ~0u; asm volatile("" : "+s"(ones_)); const int l_ = (int)__builtin_amdgcn_mbcnt_hi(ones_, __builtin_amdgcn_mbcnt_lo(ones_, 0u)); E(acc, cur, wr, wc, l_ & 15, l_ >> 4); }
        if (!has_next) break;
#pragma unroll
        for (int a = 0; a < 2; ++a)
#pragma unroll
            for (int b = 0; b < 2; ++b)
#pragma unroll
                for (int m = 0; m < 4; ++m)
#pragma unroll
                    for (int n = 0; n < 2; ++n) acc[a][b][m][n] = (f32x4){0.f, 0.f, 0.f, 0.f};
        cur = nxt; cA = nA; cB = nB; ++ui;
        if constexpr (GATHER) { gc00 = gn00; gc01 = gn01; gc10 = gn10; gc11 = gn11; }
        if (wr == 1) PG8_BAR;
    }
    PG8_WAIT_V(0);
    PG8_BAR;
#undef PG8_GOFF
#undef PG8_SA
#undef PG8_SB
#undef PG8_STAGE
#undef PG8_STB
#undef PG8_STA
#undef PG8_LDA
#undef PG8_LDB
#undef PG8_MMA
#undef PG8_WAIT_V
#undef PG8_WAIT_L
#undef PG8_BAR
#undef PG8_SCHED
}
}

#define EPI_ROWS_BEGIN _Pragma("unroll") for (int ai = 0; ai < 2; ++ai) _Pragma("unroll") for (int m = 0; m < 4; ++m) { const unsigned row = (unsigned)(u.pm * 256 + ai * 128 + wr * 64 + m * 16 + fr);
#define EPI_ROWS_END asm volatile("" ::: "memory"); }
__device__ __forceinline__ void st16(void* base, unsigned off, u32x4 v) { *(u32x4*)((char*)base + off) = v; }
struct EpiInProj {
    static constexpr bool PERM = true;
    bf16* CQ; bf16* CKV; float* KR; float* FL; bf16* FQ; bf16* CI;
    __device__ __forceinline__ void operator()(const f32x4 (&acc)[2][2][4][2], const pg8::Unit& u, int wr, int wc, int fr, int fq) const {
        const int t = u.pn; const unsigned c8 = (unsigned)(wc * 32 + 8 * fq);
        if (t != 1) {
            bf16* base; unsigned ld;
            if (t == 0) { base = CQ; ld = 256; } else if (t <= 4) { base = FQ + (size_t)(t - 2) * M * 256; ld = 256; } else { base = CI + (t - 5) * 256; ld = 512; }
            EPI_ROWS_BEGIN
                const unsigned off = (row * ld + c8) * 2u;
                st16(base, off, pack8(acc[ai][0][m][0], acc[ai][0][m][1]));
                st16(base, off + 256u, pack8(acc[ai][1][m][0], acc[ai][1][m][1]));
            EPI_ROWS_END
        } else {
            EPI_ROWS_BEGIN
                const unsigned off = (row * 256u + c8) * 2u;
                st16(CKV, off, pack8(acc[ai][0][m][0], acc[ai][0][m][1]));
                if (c8 < 32) { const unsigned ko = (row * 32u + c8) * 4u; *(f32x4*)((char*)KR + ko) = acc[ai][1][m][0]; *(f32x4*)((char*)KR + ko + 16) = acc[ai][1][m][1]; }
                else if (c8 == 32) { *(f32x4*)((char*)FL + row * 16u) = acc[ai][1][m][0]; }
            EPI_ROWS_END
        }
    }
};
struct EpiQKV {
    static constexpr bool PERM = true;
    bf16* QM; bf16* KM; bf16* VM; const float* COS; const float* SIN;
    __device__ __forceinline__ void operator()(const f32x4 (&acc)[2][2][4][2], const pg8::Unit& u, int wr, int wc, int fr, int fq) const {
        const int t = u.pn; const unsigned c8 = (unsigned)(wc * 32 + 8 * fq);
        if (t < 3) {
#pragma unroll
            for (int bj = 0; bj < 2; ++bj) {
                const unsigned col = (unsigned)(t * 256 + bj * 128) + c8, h = col / 96u, d = col - h * 96u;
                const bool rope = d >= 64; const unsigned f4 = rope ? ((d - 64) >> 1) : 0u;
#pragma unroll
                for (int ai = 0; ai < 2; ++ai) {
                    f32x4 cc[4], ss[4];
                    if (rope) {
#pragma unroll
                        for (int m = 0; m < 4; ++m) { const unsigned to = ((unsigned)(u.pm * 256 + ai * 128 + wr * 64 + m * 16 + fr) * 16u + f4) * 4u;
                            cc[m] = *(const f32x4*)((const char*)COS + to); ss[m] = *(const f32x4*)((const char*)SIN + to); }
                    }
#pragma unroll
                    for (int m = 0; m < 4; ++m) { const unsigned row = (unsigned)(u.pm * 256 + ai * 128 + wr * 64 + m * 16 + fr);
                        f32x4 v0 = acc[ai][bj][m][0], v1 = acc[ai][bj][m][1];
                        if (rope) {
                            const f32x4 c = cc[m], s = ss[m], a = v0, b = v1;
                            v0 = (f32x4){a[0] * c[0] - a[2] * s[0], a[1] * c[1] - a[3] * s[1], a[0] * s[0] + a[2] * c[0], a[1] * s[1] + a[3] * c[1]};
                            v1 = (f32x4){b[0] * c[2] - b[2] * s[2], b[1] * c[3] - b[3] * s[3], b[0] * s[2] + b[2] * c[2], b[1] * s[3] + b[3] * c[3]};
                        }
                        st16(QM, (row * 768u + col) * 2u, pack8(v0, v1));
                    }
                    asm volatile("" ::: "memory");
                }
            }
        } else if (t < 5) {
#pragma unroll
            for (int bj = 0; bj < 2; ++bj) {
                const unsigned kc = (unsigned)((t - 3) * 256 + bj * 128) + c8, h = kc >> 6, d = kc & 63;
                EPI_ROWS_BEGIN
                    st16(KM, (row * 768u + h * 96u + d) * 2u, pack8(acc[ai][bj][m][0], acc[ai][bj][m][1]));
                EPI_ROWS_END
            }
        } else {
#pragma unroll
            for (int bj = 0; bj < 2; ++bj) {
                const unsigned vc = (unsigned)((t - 5) * 256 + bj * 128) + c8;
                EPI_ROWS_BEGIN
                    st16(VM, (row * 512u + vc) * 2u, pack8(acc[ai][bj][m][0], acc[ai][bj][m][1]));
                EPI_ROWS_END
            }
        }
    }
};
template <int LDC, bool SCALE>
struct EpiBf16 {
    static constexpr bool PERM = true;
    bf16* O; int ntn; const float* rowscale;
    __device__ __forceinline__ void operator()(const f32x4 (&acc)[2][2][4][2], const pg8::Unit& u, int wr, int wc, int fr, int fq) const {
        const unsigned col = (unsigned)((u.pn % ntn) * 256 + wc * 32 + 8 * fq);
        float sc8[8];
        if constexpr (SCALE) {
#pragma unroll
            for (int i = 0; i < 8; ++i) sc8[i] = *(const float*)((const char*)rowscale + (unsigned)(u.pm * 256 + (i >> 2) * 128 + wr * 64 + (i & 3) * 16 + fr) * 4u);
        }
        EPI_ROWS_BEGIN
            float s = 1.0f; if constexpr (SCALE) s = sc8[ai * 4 + m];
            const unsigned off = (row * (unsigned)LDC + col) * 2u;
            st16(O, off, pack8(acc[ai][0][m][0] * s, acc[ai][0][m][1] * s));
            st16(O, off + 256u, pack8(acc[ai][1][m][0] * s, acc[ai][1][m][1] * s));
        EPI_ROWS_END
    }
};
template <int LDH>
struct EpiSwiGLU {
    static constexpr bool PERM = true;
    bf16* H; int ntn;
    __device__ __forceinline__ void operator()(const f32x4 (&acc)[2][2][4][2], const pg8::Unit& u, int wr, int wc, int fr, int fq) const {
        const unsigned col = (unsigned)((u.pn % ntn) * 128 + wc * 32 + 8 * fq);
        EPI_ROWS_BEGIN
            f32x4 a0 = acc[ai][0][m][0], a1 = acc[ai][0][m][1]; const f32x4 b0 = acc[ai][1][m][0], b1 = acc[ai][1][m][1];
#pragma unroll
            for (int j = 0; j < 4; ++j) { a0[j] = siluf_(a0[j]) * b0[j]; a1[j] = siluf_(a1[j]) * b1[j]; }
            st16(H, (row * (unsigned)LDH + col) * 2u, pack8(a0, a1));
        EPI_ROWS_END
    }
};
struct MoeOrder {
    const bf16* A; const bf16* Bt; int lda, ldb, nM, nN, G, c, rep; const int* slot_tok; int s1, s2, s3, s4, s5, s6, s7;
    __device__ __forceinline__ int expert_of(int rt) const { const int r = rt * 256; return (r >= s1) + (r >= s2) + (r >= s3) + (r >= s4) + (r >= s5) + (r >= s6) + (r >= s7); }
    __device__ __forceinline__ bool next(int i, pg8::Unit& u) const { int pm, pn; if (!pg8::tile_order_rep(i, G, c, nM, nN, rep, pm, pn)) return false; u.pm = pm; u.pn = expert_of(pm) * nN + pn; return true; }
    __device__ __forceinline__ const char* a_base(const pg8::Unit& u) const { return slot_tok ? (const char*)A : (const char*)A + (size_t)u.pm * 256 * lda * 2; }
    __device__ __forceinline__ const char* b_base(const pg8::Unit& u) const { return (const char*)Bt + (size_t)u.pn * 256 * ldb * 2; }
    __device__ __forceinline__ int tok(const pg8::Unit& u, int r) const { return slot_tok[u.pm * 256 + r]; }
    __device__ __forceinline__ int ktiles(const pg8::Unit&, int nt) const { return nt; }
};

template <int NN>
struct MoeIdxOrder {
    const bf16* A; const bf16* Bt; int lda, ldb, first, stride, end; const int* slot_tok; int s1, s2, s3, s4, s5, s6, s7;
    __device__ __forceinline__ int expert_of(int rt) const { const int r = rt * 256; return (r >= s1) + (r >= s2) + (r >= s3) + (r >= s4) + (r >= s5) + (r >= s6) + (r >= s7); }
    __device__ __forceinline__ bool next(int i, pg8::Unit& u) const { const int idx = first + i * stride; if (idx >= end) return false; const int pm = idx / NN; u.pm = pm; u.pn = expert_of(pm) * NN + (idx - pm * NN); return true; }
    __device__ __forceinline__ const char* a_base(const pg8::Unit& u) const { return slot_tok ? (const char*)A : (const char*)A + (size_t)u.pm * 256 * lda * 2; }
    __device__ __forceinline__ const char* b_base(const pg8::Unit& u) const { return (const char*)Bt + (size_t)u.pn * 256 * ldb * 2; }
    __device__ __forceinline__ int tok(const pg8::Unit& u, int r) const { return slot_tok[u.pm * 256 + r]; }
    __device__ __forceinline__ int ktiles(const pg8::Unit&, int nt) const { return nt; }
};

namespace att {
__device__ __forceinline__ int crow(int r, int hi) { return (r & 3) + 8 * (r >> 2) + 4 * hi; }
__device__ __forceinline__ s16x4 vtr(const LAS unsigned char* p) { typedef short v4i16_t __attribute__((ext_vector_type(4))); return __builtin_bit_cast(s16x4, __builtin_amdgcn_ds_read_tr16_b64_v4i16((LAS v4i16_t*)p)); }
#define ATT_WAITBAR() asm volatile("s_waitcnt vmcnt(0) lgkmcnt(0)\n\ts_barrier" ::: "memory")
__device__ __forceinline__ void glds16(const void* gsrc, unsigned lds_dst) { unsigned keep;
    asm volatile("s_mov_b32 %0, m0\n\ts_mov_b32 m0, %2\n\ts_nop 0\n\tglobal_load_lds_dwordx4 %1, off\n\ts_mov_b32 m0, %0" : "=&s"(keep) : "v"(gsrc), "s"(lds_dst) : "memory"); }

#define MX3(a, b, c) __builtin_fmaxf(__builtin_fmaxf((a), (b)), (c))
template <int DQK> struct AttLds { static constexpr int NCH = DQK / 8, KSLOT = NCH * 1024, ND0 = DQK / 16, LK = 0, LV = 3 * KSLOT, LOST = LV + 3 * 8192, LCUM = LOST + NWAVES * 4608, END = LCUM + SEQ * 4; };

template <int DQK>
__device__ __forceinline__ void att_qk(f32x16& n0, f32x16& n1, const bf16x8 (&qr)[DQK / 16], const LAS unsigned char* kp) {
    constexpr int ND0 = DQK / 16;
    bf16x8 kf[2 * ND0];
#pragma unroll
    for (int d0 = 0; d0 < ND0; ++d0) { kf[2 * d0] = *(const LAS bf16x8*)(kp + d0 * 2048); kf[2 * d0 + 1] = *(const LAS bf16x8*)(kp + d0 * 2048 + 512); }
    n0 = (f32x16){}; n1 = (f32x16){};
#pragma unroll
    for (int d0 = 0; d0 < ND0; ++d0) {
        n0 = __builtin_amdgcn_mfma_f32_32x32x16_bf16(kf[2 * d0], qr[d0], n0, 0, 0, 0);
        n1 = __builtin_amdgcn_mfma_f32_32x32x16_bf16(kf[2 * d0 + 1], qr[d0], n1, 0, 0, 0);
    }
}
template <bool BIAS, bool MASK>
__device__ __forceinline__ void att_bias_mask(f32x16& n0, f32x16& n1, int t, int NT, int qrel, int hi, float fqb, const LAS float* cumL) {
    if constexpr (BIAS) {
#pragma unroll
        for (int g = 0; g < 4; ++g) {
            const f32x4 f0 = *(const LAS f32x4*)(cumL + t * 64 + 8 * g + 4 * hi), f1 = *(const LAS f32x4*)(cumL + t * 64 + 32 + 8 * g + 4 * hi);
#pragma unroll
            for (int j = 0; j < 4; ++j) { n0[4 * g + j] += fqb - f0[j]; n1[4 * g + j] += fqb - f1[j]; }
        }
    }
    if constexpr (MASK) {
        const int kb = 64 * (t - (NT - 4)) + 4 * hi;
#pragma unroll
        for (int r = 0; r < 16; ++r) { const int kv = kb + (r & 3) + 8 * (r >> 2); if (kv > qrel) n0[r] = -INFINITY; if (kv + 32 > qrel) n1[r] = -INFINITY; }
    }
}
template <int DQK, bool BIAS, bool MASK, bool MORE>
__device__ __forceinline__ void att_step(f32x16& s0, f32x16& s1, f32x16& n0, f32x16& n1, f32x16& o0, f32x16& o1, float& mrow, float& lrow, const bf16x8 (&qr)[DQK / 16],
                                         int t, int NT, int qrel, int lane, int hi, int r32, float fqb, const LAS unsigned char* shm, int vslot, int kslot) {
    typedef AttLds<DQK> L;
    constexpr int ND0 = DQK / 16;
    const LAS unsigned char* vp = shm + L::LV + vslot * 8192 + ((lane >> 4) & 1) * 32 + (lane & 3) * 8 + (4 * hi + ((lane & 15) >> 2)) * 64;
    const LAS unsigned char* kp = shm + L::LK + kslot * L::KSLOT + hi * 1024 + r32 * 16;
    bf16x8 kf[2 * ND0];
    if constexpr (MORE) {
#pragma unroll
        for (int d0 = 0; d0 < ND0; ++d0) { kf[2 * d0] = *(const LAS bf16x8*)(kp + d0 * 2048); kf[2 * d0 + 1] = *(const LAS bf16x8*)(kp + d0 * 2048 + 512); }
    }
    float a = MX3(s0[0], s0[1], s1[0]), b = MX3(s0[2], s0[3], s1[1]); a = MX3(a, s1[2], s1[3]);
#pragma unroll
    for (int r = 4; r < 16; r += 4) { a = MX3(a, s0[r], s0[r + 1]); b = MX3(b, s0[r + 2], s0[r + 3]); a = MX3(a, s1[r], s1[r + 1]); b = MX3(b, s1[r + 2], s1[r + 3]); }
    float rm = __builtin_fmaxf(a, b);
    { auto rr = __builtin_amdgcn_permlane32_swap(__float_as_uint(rm), __float_as_uint(rm), false, false); rm = __builtin_fmaxf(__uint_as_float(rr[0]), __uint_as_float(rr[1])); }
    if (__builtin_amdgcn_ballot_w64(rm > mrow + 8.0f) != 0ull) {
        const float mnew = __builtin_fmaxf(mrow, rm), alpha = fexp2(mrow - mnew);
        mrow = mnew; lrow *= alpha;
#pragma unroll
        for (int r = 0; r < 16; ++r) { o0[r] *= alpha; o1[r] *= alpha; }
    }
    if constexpr (MORE) {
        n0 = (f32x16){}; n1 = (f32x16){};
#pragma unroll
        for (int d0 = 0; d0 < ND0; ++d0) {
            n0 = __builtin_amdgcn_mfma_f32_32x32x16_bf16(kf[2 * d0], qr[d0], n0, 0, 0, 0);
            n1 = __builtin_amdgcn_mfma_f32_32x32x16_bf16(kf[2 * d0 + 1], qr[d0], n1, 0, 0, 0);
        }
    }
    float ps = 0.f;
#pragma unroll
    for (int r = 0; r < 16; ++r) { s0[r] = fexp2(s0[r] - mrow); s1[r] = fexp2(s1[r] - mrow); ps += s0[r] + s1[r]; }
    lrow += ps;
    __builtin_amdgcn_sched_barrier(0);
    s16x4 vl[8], vh[8];
#pragma unroll
    for (int i = 0; i < 8; ++i) { vl[i] = vtr(vp + (i >> 2) * 4096 + (i & 3) * 1024); vh[i] = vtr(vp + (i >> 2) * 4096 + (i & 3) * 1024 + 512); }
    u32x4 pw[4];
    pw[0] = (u32x4){pk2(s0[0], s0[1]), pk2(s0[2], s0[3]), pk2(s0[4], s0[5]), pk2(s0[6], s0[7])};
    pw[1] = (u32x4){pk2(s0[8], s0[9]), pk2(s0[10], s0[11]), pk2(s0[12], s0[13]), pk2(s0[14], s0[15])};
    pw[2] = (u32x4){pk2(s1[0], s1[1]), pk2(s1[2], s1[3]), pk2(s1[4], s1[5]), pk2(s1[6], s1[7])};
    pw[3] = (u32x4){pk2(s1[8], s1[9]), pk2(s1[10], s1[11]), pk2(s1[12], s1[13]), pk2(s1[14], s1[15])};
#pragma unroll
    for (int ks = 0; ks < 4; ++ks) {
        const bf16x8 v0 = (bf16x8){vl[ks][0], vl[ks][1], vl[ks][2], vl[ks][3], vh[ks][0], vh[ks][1], vh[ks][2], vh[ks][3]};
        const bf16x8 v1 = (bf16x8){vl[4 + ks][0], vl[4 + ks][1], vl[4 + ks][2], vl[4 + ks][3], vh[4 + ks][0], vh[4 + ks][1], vh[4 + ks][2], vh[4 + ks][3]};
        o0 = __builtin_amdgcn_mfma_f32_32x32x16_bf16(v0, __builtin_bit_cast(bf16x8, pw[ks]), o0, 0, 0, 0);
        o1 = __builtin_amdgcn_mfma_f32_32x32x16_bf16(v1, __builtin_bit_cast(bf16x8, pw[ks]), o1, 0, 0, 0);
    }
    if constexpr (MORE) att_bias_mask<BIAS, MASK>(n0, n1, t + 1, NT, qrel, hi, fqb, (const LAS float*)(shm + L::LCUM));
}

template <int DQK, bool BIAS>
__device__ __forceinline__ void attn_unit(int b, int h, int qb, const bf16* Q, int pq, const bf16* K, int pk, const bf16* V, int pv,
                                          bf16* O, int po, int ocol, const float* cum, LAS unsigned char* shm, const int tid_in, float* ssqp, int hidx, const unsigned* qkmax) {
    int tid = tid_in; asm volatile("" : "+v"(tid));
    typedef AttLds<DQK> L;
    constexpr int NCH = L::NCH, KSLOT = L::KSLOT, ND0 = L::ND0, LK = L::LK, LV = L::LV, LOST = L::LOST;
    static_assert(L::END <= RING_BYTES, "attention LDS");
    const int lane = tid & 63, r32 = lane & 31, hi = lane >> 5; const int wid = __builtin_amdgcn_readfirstlane(tid >> 6);
    const long rowbase = (long)b * SEQ; const int q0 = qb * 256;
    const bf16* Qw = Q + (rowbase + q0 + wid * 32) * pq + h * DQK;
    const bf16* Kh = K + rowbase * pk + h * DQK; const bf16* Vh = V + rowbase * pv + h * 64;
    const int NT = (q0 + 256) / 64;
    LAS float* cumL = (LAS float*)(shm + L::LCUM);
    if constexpr (BIAS) { const float* cs = cum + (size_t)(b * 4 + h) * SEQ; for (int i = tid * 4; i < q0 + 256; i += NTHR * 4) *(LAS f32x4*)(cumL + i) = *(const f32x4*)(cs + i); }
    const bf16* ksrc = Kh + (long)lane * pk + wid * 8;
    const bf16* vsrc = Vh + (long)(16 * (wid & 3) + (lane >> 2)) * pv + (wid >> 2) * 32 + (lane & 3) * 8;
    const unsigned lds0 = (unsigned)(size_t)shm;
#define ATT_DMA_K(t, slot) do { \
        glds16(ksrc + (long)(t) * 64 * pk, (unsigned)__builtin_amdgcn_readfirstlane((int)(lds0 + LK + (slot) * KSLOT + wid * 1024))); \
        if (NCH > 8 && wid + 8 < NCH) glds16(ksrc + (long)(t) * 64 * pk + 64, (unsigned)__builtin_amdgcn_readfirstlane((int)(lds0 + LK + (slot) * KSLOT + (wid + 8) * 1024))); } while (0)
#define ATT_DMA_V(t, slot) glds16(vsrc + (long)(t) * 64 * pv, (unsigned)__builtin_amdgcn_readfirstlane((int)(lds0 + LV + (slot) * 8192 + wid * 1024)))
    const int nK = (NCH > 8 && wid + 8 < NCH) ? 2 : 1;
#define ATT_WAITBAR_N(n) do { const int n_ = (n); if (n_ == 0) asm volatile("s_waitcnt vmcnt(0) lgkmcnt(0)\n\ts_barrier" ::: "memory"); else if (n_ == 1) asm volatile("s_waitcnt vmcnt(1) lgkmcnt(0)\n\ts_barrier" ::: "memory"); \
        else if (n_ == 2) asm volatile("s_waitcnt vmcnt(2) lgkmcnt(0)\n\ts_barrier" ::: "memory"); else asm volatile("s_waitcnt vmcnt(3) lgkmcnt(0)\n\ts_barrier" ::: "memory"); } while (0)
    int tb = 0;
    if constexpr (BIAS) {
        const float qk = sqrtf(__uint_as_float(qkmax[0]) * __uint_as_float(qkmax[1])) * 1.01f + 1.0f, thr = -(150.0f + 2.0f * qk);
        const float* cs = cum + (size_t)(b * 4 + h) * SEQ; const float f0 = cs[q0]; const float fj = lane < NT ? cs[64 * lane + 63] : f0;
        const unsigned long long keep = __builtin_amdgcn_ballot_w64(lane < NT && (f0 - fj) >= thr);
        tb = keep ? (int)__builtin_ctzll(keep) : NT - 4; if (tb > NT - 4) tb = NT - 4;
        tb = __builtin_amdgcn_readfirstlane(tb);
    }
    ATT_DMA_K(tb, 0); ATT_DMA_V(tb, 0); ATT_DMA_K(tb + 1, 1);
    bf16x8 qr[ND0];
#pragma unroll
    for (int d0 = 0; d0 < ND0; ++d0) qr[d0] = *(const bf16x8*)(Qw + (long)r32 * pq + d0 * 16 + hi * 8);
    float mrow = -1e30f, lrow = 0.f; f32x16 o0 = {}, o1 = {};
    const int qrel = wid * 32 + r32;
    ATT_WAITBAR();
#pragma unroll
    for (int d0 = 0; d0 < ND0; ++d0) asm volatile("" : "+v"(qr[d0]));
    ATT_DMA_K(tb + 2, 2); ATT_DMA_V(tb + 1, 1);
    float fqb = 0.f; if constexpr (BIAS) fqb = cumL[q0 + qrel];
    f32x16 s0, s1;
    att_qk<DQK>(s0, s1, qr, shm + LK + hi * 1024 + r32 * 16);
    asm volatile("s_waitcnt lgkmcnt(0)\n\ts_barrier" ::: "memory");
    if (tb == NT - 4) att_bias_mask<BIAS, true>(s0, s1, tb, NT, qrel, hi, fqb, cumL); else att_bias_mask<BIAS, false>(s0, s1, tb, NT, qrel, hi, fqb, cumL);
    int t = tb, sl0 = 0, sl1 = 1, sl2 = 2;
#define ATT_ROT() do { const int x_ = sl0; sl0 = sl1; sl1 = sl2; sl2 = x_; } while (0)
    f32x16 u0, u1;
    for (; t + 1 < NT - 5; t += 2) {
        ATT_DMA_K(t + 3, sl0); ATT_DMA_V(t + 2, sl2);
        att_step<DQK, BIAS, false, true>(s0, s1, u0, u1, o0, o1, mrow, lrow, qr, t, NT, qrel, lane, hi, r32, fqb, shm, sl0, sl1);
        ATT_WAITBAR_N(nK + 1); ATT_ROT();
        ATT_DMA_K(t + 4, sl0); ATT_DMA_V(t + 3, sl2);
        att_step<DQK, BIAS, false, true>(u0, u1, s0, s1, o0, o1, mrow, lrow, qr, t + 1, NT, qrel, lane, hi, r32, fqb, shm, sl0, sl1);
        ATT_WAITBAR_N(nK + 1); ATT_ROT();
    }
    for (; t < NT - 5; ++t) {
        ATT_DMA_K(t + 3, sl0); ATT_DMA_V(t + 2, sl2);
        att_step<DQK, BIAS, false, true>(s0, s1, u0, u1, o0, o1, mrow, lrow, qr, t, NT, qrel, lane, hi, r32, fqb, shm, sl0, sl1);
        s0 = u0; s1 = u1;
        ATT_WAITBAR_N(nK + 1); ATT_ROT();
    }
    for (; t < NT - 1; ++t) {
        int nis = 0;
        if (t + 3 < NT) { ATT_DMA_K(t + 3, sl0); nis += nK; }
        if (t + 2 < NT) { ATT_DMA_V(t + 2, sl2); nis += 1; }
        const int jbc = t - (NT - 4); const bool docur = !(jbc >= 0 && 2 * jbc > wid), donext = !(2 * (jbc + 1) > wid);
        if (docur && donext) { att_step<DQK, BIAS, true, true>(s0, s1, u0, u1, o0, o1, mrow, lrow, qr, t, NT, qrel, lane, hi, r32, fqb, shm, sl0, sl1); s0 = u0; s1 = u1; }
        else if (docur) att_step<DQK, BIAS, false, false>(s0, s1, u0, u1, o0, o1, mrow, lrow, qr, t, NT, qrel, lane, hi, r32, fqb, shm, sl0, sl1);
        ATT_WAITBAR_N(nis); ATT_ROT();
    }
    if (!(2 * 3 > wid)) att_step<DQK, BIAS, false, false>(s0, s1, u0, u1, o0, o1, mrow, lrow, qr, t, NT, qrel, lane, hi, r32, fqb, shm, sl0, sl1);
#undef ATT_ROT
#undef ATT_WAITBAR_N
    { auto rr = __builtin_amdgcn_permlane32_swap(__float_as_uint(lrow), __float_as_uint(lrow), false, false); lrow = __uint_as_float(rr[0]) + __uint_as_float(rr[1]); }
    const float rl = frcp(lrow);
    { float ssq = 0.f;
#pragma unroll
      for (int r = 0; r < 16; ++r) { const float a = o0[r] * rl, b2 = o1[r] * rl; ssq += a * a + b2 * b2; }
      auto rr = __builtin_amdgcn_permlane32_swap(__float_as_uint(ssq), __float_as_uint(ssq), false, false); ssq = __uint_as_float(rr[0]) + __uint_as_float(rr[1]);
      if (hi == 0) ssqp[(size_t)(rowbase + q0 + wid * 32 + r32) * 12 + hidx] = ssq; }
    LAS unsigned char* stg = shm + LOST + wid * 4608;
#pragma unroll
    for (int g = 0; g < 4; ++g) {
        *(LAS u32x2*)(stg + r32 * 144 + (8 * g + 4 * hi) * 2) = (u32x2){pk2(o0[4 * g] * rl, o0[4 * g + 1] * rl), pk2(o0[4 * g + 2] * rl, o0[4 * g + 3] * rl)};
        *(LAS u32x2*)(stg + r32 * 144 + (32 + 8 * g + 4 * hi) * 2) = (u32x2){pk2(o1[4 * g] * rl, o1[4 * g + 1] * rl), pk2(o1[4 * g + 2] * rl, o1[4 * g + 3] * rl)};
    }
    asm volatile("s_waitcnt lgkmcnt(0)" ::: "memory");
    bf16* Ow = O + (rowbase + q0 + wid * 32) * po + ocol;
#pragma unroll
    for (int i = 0; i < 4; ++i) { const int row = i * 8 + (lane >> 3), ch = lane & 7; const u32x4 v = *(const LAS u32x4*)(stg + row * 144 + ch * 16); *(u32x4*)(Ow + (long)row * po + ch * 8) = v; }
    asm volatile("s_waitcnt lgkmcnt(0)\n\ts_barrier" ::: "memory");
#undef ATT_DMA_K
#undef ATT_DMA_V
}
}

struct Args { const float* in[26]; float* out; unsigned char* ws; int ph_lo, ph_hi; };
typedef const __attribute__((address_space(4))) Args* kargs_t;
struct Ctx {
    LAS unsigned char* lds; unsigned* ctl; unsigned char* ws; float* out;
    int tid, lane, wave, vcu, G, gw, NGW, bx;
};
__device__ __forceinline__ kargs_t opaque_args() { kargs_t p = (kargs_t)__builtin_amdgcn_kernarg_segment_ptr(); asm volatile("" : "+s"(p)); return p; }
__device__ __forceinline__ Ctx make_ctx(kargs_t A, LAS unsigned char* lds, int wave0) {
    Ctx C; unsigned ones = ~0u; asm volatile("" : "+s"(ones));
    int t = wave0 * 64 + (int)__builtin_amdgcn_mbcnt_hi(ones, __builtin_amdgcn_mbcnt_lo(ones, 0u)); asm volatile("" : "+v"(t));
    C.lds = lds; C.ws = A->ws; C.ctl = (unsigned*)(C.ws + WS_CTL); C.out = A->out;
    C.tid = t; C.lane = t & 63; C.wave = __builtin_amdgcn_readfirstlane(t >> 6);
    { int g_ = gridDim.x, b_ = blockIdx.x; asm volatile("" : "+s"(g_), "+s"(b_)); C.G = g_; C.bx = b_; } C.vcu = (C.bx % 8) * (C.G / 8) + C.bx / 8;
    C.gw = C.vcu * NWAVES + C.wave; C.NGW = C.G * NWAVES;
    return C;
}
#define LDS_WAIT() asm volatile("s_waitcnt lgkmcnt(0)" ::: "memory")

struct MapWin { __device__ __forceinline__ int row(int n) const {
        if (n < 256) return PC_CQ + n; if (n < 384) return PC_CKV + (n - 256); if (n < 416) return PC_KR + (n - 384); if (n < 672) return PC_FQ + (n - 416);
        if (n < 928) return PC_FK + (n - 672); if (n < 1184) return PC_FV + (n - 928); if (n < 1188) return PC_FL + (n - 1184); return PC_CI + (n - 1188); }
    __device__ __forceinline__ float scale(int, int n) const { return (n >= 416 && n < 672) ? C2_FOX : 1.0f; } };
struct MapUq { const float* g; __device__ __forceinline__ int row(int n) const { const int h = n / 96, d = n - h * 96; if (d < 64) return n; const int i = d - 64;
        const int s = (i < 16) ? (4 * (i >> 1) + (i & 1)) : (4 * ((i - 16) >> 1) + 2 + (i & 1)); return h * 96 + 64 + s; }
    __device__ __forceinline__ float scale(int k, int) const { return g[k] * C2_MLA; } };
struct MapUkv { const float* g; __device__ __forceinline__ int row(int n) const { const int h = n >> 7, d = n & 127; return d < 64 ? (768 + h * 64 + d) : (1280 + h * 64 + (d - 64)); }
    __device__ __forceinline__ float scale(int k, int) const { return g[k]; } };
struct MapWout { const float* gm; const float* gf; __device__ __forceinline__ int row(int n) const { return n; }
    __device__ __forceinline__ float scale(int k, int) const { return k < 512 ? gm[k] : (k < 768 ? gf[k - 512] : 1.0f); } };
struct MapW13 { int which; __device__ __forceinline__ int row(int n) const { return (n >> 7) * 256 + which * 128 + (n & 127); }
    __device__ __forceinline__ float scale(int, int) const { return 1.0f; } };
struct MapId { __device__ __forceinline__ int row(int n) const { return n; } __device__ __forceinline__ float scale(int, int) const { return 1.0f; } };

template <class Map>
__device__ __forceinline__ void transpose_item(const float* W, int Nsrc, bf16* WT, int ldk, LAS float* scr, int kb, int nb, int lane, const Map mp) {
    const int k0 = 64 * kb, n0 = 32 * nb, r8 = lane >> 3, nn = n0 + 4 * (lane & 7); const bool nok = nn < Nsrc;
    f32x4 v[8];
#pragma unroll
    for (int i = 0; i < 8; ++i) { v[i] = (f32x4){0.f, 0.f, 0.f, 0.f}; if (nok) v[i] = *(const f32x4*)(W + (size_t)(k0 + 8 * i + r8) * Nsrc + nn); }
#pragma unroll
    for (int i = 0; i < 8; ++i) { const int kk = 8 * i + r8; LAS float* d = scr + kk * 33 + 4 * (lane & 7);
#pragma unroll
        for (int j = 0; j < 4; ++j) d[j] = v[i][j] * mp.scale(k0 + kk, nn + j); }
    LDS_WAIT(); asm volatile("" ::: "memory");
    const int c = lane & 7;
#pragma unroll
    for (int j = 0; j < 4; ++j) { const int n = (lane >> 3) + 8 * j; const LAS float* s = scr + (8 * c) * 33 + n;
        if (n0 + n < Nsrc) { u32x4 o; o.x = pk2(s[0 * 33], s[1 * 33]); o.y = pk2(s[2 * 33], s[3 * 33]); o.z = pk2(s[4 * 33], s[5 * 33]); o.w = pk2(s[6 * 33], s[7 * 33]);
            *(u32x4*)(WT + (size_t)mp.row(n0 + n) * ldk + k0 + 8 * c) = o; } }
    LDS_WAIT(); asm volatile("" ::: "memory");
}

__device__ __forceinline__ void sincos_acc(float ang, float& c, float& s) {
    const double a = (double)ang, q = __builtin_rint(a * 0.63661977236758134308);
    const double y = (a - q * 1.57079632679489655800) - q * 6.12323399573676603587e-17, y2 = y * y;
    const double sp = y * (1.0 + y2 * (-1.0 / 6 + y2 * (1.0 / 120 + y2 * (-1.0 / 5040 + y2 * (1.0 / 362880 + y2 * (-1.0 / 39916800 + y2 * (1.0 / 6227020800.0)))))));
    const double cp = 1.0 + y2 * (-0.5 + y2 * (1.0 / 24 + y2 * (-1.0 / 720 + y2 * (1.0 / 40320 + y2 * (-1.0 / 3628800 + y2 * (1.0 / 479001600 + y2 * (-1.0 / 87178291200.0)))))));
    const int quad = (int)((long long)q & 3);
    const double ss = (quad == 0) ? sp : (quad == 1) ? cp : (quad == 2) ? -sp : -cp;
    const double cc = (quad == 0) ? cp : (quad == 1) ? -sp : (quad == 2) ? -cp : sp;
    c = (float)cc; s = (float)ss;
}
__device__ __forceinline__ float inv_freq(int f) {
    const int a = f >> 2, b = f & 3;
    const float p = (a == 0) ? 1.0f : (a == 1) ? 0.1f : (a == 2) ? 0.01f : 0.001f;
    const float m = (b == 0) ? 1.0f : (b == 1) ? 0.56234132519034908f : (b == 2) ? 0.31622776601683794f : 0.17782794100389228f;
    return (b == 0) ? p : (float)((double)p * (double)m);
}

__device__ __forceinline__ void p0_prologue(Ctx& C, kargs_t A) {
    LAS float* scr = (LAS float*)(C.lds + C.wave * 16384);
    bf16* WIN = (bf16*)(C.ws + WS_WIN); bf16* WQ2 = (bf16*)(C.ws + WS_WQ2); bf16* WOUT = (bf16*)(C.ws + WS_WOUT);
    constexpr int I_IN = 16 * 54, I_UQ = 4 * 24, I_UKV = 2 * 32, I_OUT = 16 * 32, I_L = I_IN + I_UQ + I_UKV + I_OUT;
    REPS(12) for (int it = C.gw; it < DEPTH * I_L; it += C.NGW) {
        const int l = it / I_L; int r = it - l * I_L;
        if (r < I_IN) { transpose_item(A->in[2] + (size_t)l * DM * IN_COLS, IN_COLS, WIN + (size_t)l * NP1 * DM, DM, scr, r / 54, r % 54, C.lane, MapWin{}); continue; } r -= I_IN;
        if (r < I_UQ) { transpose_item(A->in[4] + (size_t)l * 256 * 768, 768, WQ2 + (size_t)l * NP1 * 256, 256, scr, r / 24, r % 24, C.lane, MapUq{A->in[3] + l * 256}); continue; } r -= I_UQ;
        if (r < I_UKV) { transpose_item(A->in[6] + (size_t)l * 128 * 1024, 1024, WQ2 + (size_t)l * NP1 * 256, 256, scr, r / 32, r % 32, C.lane, MapUkv{A->in[5] + l * 128}); continue; } r -= I_UKV;
        transpose_item(A->in[14] + (size_t)l * DM * DM, DM, WOUT + (size_t)l * DM * DM, DM, scr, r / 32, r % 32, C.lane, MapWout{A->in[12] + l * 512, A->in[13] + l * 256});
    }
    const int gt = C.vcu * NTHR + C.tid, NGT = C.G * NTHR;
    for (int i = gt; i < DEPTH * 92 * 128; i += NGT) { const int l = i / (92 * 128), r = i % (92 * 128); *(u32x4*)(WIN + (size_t)l * NP1 * DM + (size_t)(420 + r / 128) * DM + (r % 128) * 8) = (u32x4){0u, 0u, 0u, 0u}; }
    REPS(4) {
    bf16* XB = (bf16*)(C.ws + WS_XB); const float* x = A->in[0];
    for (int m = C.gw; m < M; m += C.NGW) { const f32x4* xr = (const f32x4*)(x + (size_t)m * DM) + C.lane; u32x2* o = (u32x2*)(XB + (size_t)m * DM) + C.lane;
#pragma unroll
        for (int j = 0; j < 4; ++j) { const f32x4 v = xr[64 * j]; o[64 * j] = (u32x2){pk2(v[0], v[1]), pk2(v[2], v[3])}; } }
    float* COS = (float*)(C.ws + WS_TAB); float* SIN = COS + (size_t)M * 16; const int* pos = (const int*)A->in[1];
    for (int i = gt; i < M * 16; i += NGT) { const float ang = (float)pos[i >> 4] * inv_freq(i & 15); float c, s; sincos_acc(ang, c, s); COS[i] = c; SIN[i] = s; }
    }
}

__device__ __forceinline__ int ffn_split(int layer) { return (layer & 1) ? 7744 : 4224; }
__device__ __forceinline__ void ffn_weights(Ctx& C, kargs_t A, int layer, int first, int stride, int lo, int hi) {
    LAS float* scr = (LAS float*)(C.lds + C.wave * 16384);
    bf16* W13 = (bf16*)(C.ws + WS_WFFN); bf16* W2T = W13 + WF_W13_ELEMS; const int j = layer >> 1;
    if ((layer & 1) == 0) {
        constexpr int I1 = 16 * 88, I2 = 44 * 32;
        const float* w1 = A->in[17] + (size_t)j * DM * DFF; const float* w3 = A->in[18] + (size_t)j * DM * DFF; const float* w2 = A->in[19] + (size_t)j * DFF * DM;
        const int end = hi < 2 * I1 + I2 ? hi : 2 * I1 + I2;
        for (int it = lo + first; it < end; it += stride) {
            int r = it;
            if (r < I1) { transpose_item(w1, DFF, W13, DM, scr, r / 88, r % 88, C.lane, MapW13{0}); continue; } r -= I1;
            if (r < I1) { transpose_item(w3, DFF, W13, DM, scr, r / 88, r % 88, C.lane, MapW13{1}); continue; } r -= I1;
            transpose_item(w2, DM, W2T, DFF, scr, r / 32, r % 32, C.lane, MapId{});
        }
    } else {
        constexpr int I1 = 16 * 44, I2 = 22 * 32, IE = 2 * I1 + I2;
        const int end = hi < NEXP * IE ? hi : NEXP * IE;
        for (int it = lo + first; it < end; it += stride) {
            const int e = it / IE; int r = it - e * IE;
            const float* w1 = A->in[21] + ((size_t)j * NEXP + e) * DM * DFE; const float* w3 = A->in[22] + ((size_t)j * NEXP + e) * DM * DFE; const float* w2 = A->in[23] + ((size_t)j * NEXP + e) * DFE * DM;
            bf16* W13e = W13 + (size_t)e * 2 * DFE * DM; bf16* W2Te = W2T + (size_t)e * DM * DFE;
            if (r < I1) { transpose_item(w1, DFE, W13e, DM, scr, r / 44, r % 44, C.lane, MapW13{0}); continue; } r -= I1;
            if (r < I1) { transpose_item(w3, DFE, W13e, DM, scr, r / 44, r % 44, C.lane, MapW13{1}); continue; } r -= I1;
            transpose_item(w2, DM, W2Te, DFE, scr, r / 32, r % 32, C.lane, MapId{});
        }
    }
}

__device__ __forceinline__ void p2_thin(Ctx& C, kargs_t A, int layer) {
    unsigned char* sc = C.ws + WS_SCR;
    bf16* CQ = (bf16*)(sc + SC_CQKV); bf16* CKV = CQ + (size_t)M * 256; const float* KR = (const float*)(sc + SC_KR); const float* FL = (const float*)(sc + SC_FL);
    float* CUM = (float*)(sc + SC_CUM); const bf16* CI = (const bf16*)(sc + SC_CI); const bf16* FQn = (const bf16*)(sc + SC_FQ); bf16* KM = (bf16*)(sc + SC_KM); bf16* MIXED = (bf16*)(sc + SC_MIXED);
    const float* COS = (const float*)(C.ws + WS_TAB); const float* SIN = COS + (size_t)M * 16;
    LAS unsigned* NT2 = (LAS unsigned*)(C.lds + RING_BYTES + 4096);
    if (C.tid < 64) NT2[C.tid] = 0u;
    LAS unsigned* RQ = (LAS unsigned*)(C.lds + RING_BYTES + 8192 + 64);
    if (C.tid == 0) RQ[0] = 0u;
    __syncthreads();
    {
    if (C.wave == 0 && C.vcu < BATCH * 4) {
        const int sq = C.vcu, b = sq >> 2, h = sq & 3; const float bias = A->in[7][layer * 4 + h];
        float v[64]; float run = 0.f;
#pragma unroll
        for (int i = 0; i < 64; ++i) { const float z = FL[((size_t)b * SEQ + C.lane * 64 + i) * 4 + h] + bias; const float e = fexp2(-fabsf(z) * LOG2E);
            const float ls = fminf(z, 0.f) - __builtin_amdgcn_logf(1.0f + e) * 0.6931471805599453f; run += ls * LOG2E; v[i] = run; }
        float incl = run;
#pragma unroll
        for (int o = 1; o < 64; o <<= 1) { const float t = __int_as_float(__builtin_amdgcn_ds_bpermute((C.lane - o) << 2, __float_as_int(incl))); if (C.lane >= o) incl += t; }
        const float excl = incl - run; float* dst = CUM + (size_t)sq * SEQ + C.lane * 64;
#pragma unroll
        for (int i = 0; i < 64; i += 4) *(f32x4*)(dst + i) = (f32x4){v[i] + excl, v[i + 1] + excl, v[i + 2] + excl, v[i + 3] + excl};
    }
    const int rpw = M / C.G;
    for (;;) {
        unsigned jb = 0u; if (C.lane == 0) jb = __hip_atomic_fetch_add(RQ, 1u, __ATOMIC_RELAXED, __HIP_MEMORY_SCOPE_WORKGROUP);
        jb = (unsigned)__builtin_amdgcn_readfirstlane((int)jb);
        if ((int)jb * 4 >= rpw) break;
        const size_t mb = (size_t)C.vcu * rpw + 4 * jb;
        u32x2 wq[4]; unsigned wk[4]; f32x2 x1[4], x2[4], cs[4], sn[4]; u32x2 fqv[4], fkv[4]; const int g4 = C.lane & 7, h = C.lane >> 3;
#pragma unroll
        for (int k = 0; k < 4; ++k) { const size_t m = mb + k;
            wq[k] = ((const u32x2*)(CQ + m * 256))[C.lane]; wk[k] = ((const unsigned*)(CKV + m * 256))[C.lane];
            x1[k] = *(const f32x2*)(KR + m * 32 + 2 * g4); x2[k] = *(const f32x2*)(KR + m * 32 + 16 + 2 * g4);
            cs[k] = *(const f32x2*)(COS + m * 16 + 2 * g4); sn[k] = *(const f32x2*)(SIN + m * 16 + 2 * g4);
            fqv[k] = ((const u32x2*)(FQn + m * 256))[C.lane]; fkv[k] = ((const u32x2*)(FQn + (size_t)M * 256 + m * 256))[C.lane]; }
#pragma unroll
        for (int k = 0; k < 4; ++k) { const size_t m = mb + k;
            { const float a0 = bflo(wq[k].x), a1 = bfhi(wq[k].x), a2 = bflo(wq[k].y), a3 = bfhi(wq[k].y);
              const float ss = wave_sum((a0 * a0 + a1 * a1) + (a2 * a2 + a3 * a3)); const float r = 1.0f / sqrtf(ss * (1.0f / 256) + EPS); ((u32x2*)(CQ + m * 256))[C.lane] = (u32x2){pk2(a0 * r, a1 * r), pk2(a2 * r, a3 * r)}; }
            { const float a0 = bflo(wk[k]), a1 = bfhi(wk[k]); unsigned* p = (unsigned*)(CKV + m * 256) + C.lane;
              const float ss = wave_sum(a0 * a0 + a1 * a1); const float r = 1.0f / sqrtf(ss * (1.0f / 128) + EPS); *p = pk2(a0 * r, a1 * r); }
            {
              float nq = 0.f, nk = 0.f; { const float a0 = bflo(fqv[k].x), a1 = bfhi(fqv[k].x), a2 = bflo(fqv[k].y), a3 = bfhi(fqv[k].y); nq = (a0 * a0 + a1 * a1) + (a2 * a2 + a3 * a3); }
              { const float a0 = bflo(fkv[k].x), a1 = bfhi(fkv[k].x), a2 = bflo(fkv[k].y), a3 = bfhi(fkv[k].y); nk = (a0 * a0 + a1 * a1) + (a2 * a2 + a3 * a3); }
              nq += lane_xor<1>(nq); nq += lane_xor<2>(nq); nq += lane_xor<4>(nq); nq += lane_xor<8>(nq); nk += lane_xor<1>(nk); nk += lane_xor<2>(nk); nk += lane_xor<4>(nk); nk += lane_xor<8>(nk);
              if ((C.lane & 15) == 0) { const int bi = (int)(m >> 12) * 8 + (C.lane >> 4) * 2; atomicMax((unsigned*)&NT2[bi], __float_as_uint(nq)); atomicMax((unsigned*)&NT2[bi + 1], __float_as_uint(nk)); } }
            *(u32x2*)(KM + m * 768 + h * 96 + 64 + 4 * g4) = (u32x2){pk2(x1[k].x * cs[k].x - x2[k].x * sn[k].x, x1[k].y * cs[k].y - x2[k].y * sn[k].y), pk2(x1[k].x * sn[k].x + x2[k].x * cs[k].x, x1[k].y * sn[k].y + x2[k].y * cs[k].y)}; }
    }
    }
    __syncthreads();
    if (C.tid < 64) atomicMax(C.ctl + CW_QKMAX + layer * 64 + C.tid, NT2[C.tid]);
    {
        LAS float* hL = (LAS float*)C.lds; LAS float* yL = hL + 62 * 256;
        const int cch = (C.wave & 3) * 64 + C.lane, tt0 = (C.wave >> 2) * 16;
        float wj[31];
#pragma unroll
        for (int j = 0; j < 31; ++j) wj[j] = A->in[8][((size_t)layer * 31 + j) * 256 + cch];
        const float cb = A->in[9][layer * 256 + cch];
        const int ntok = C.tid >> 4, ngrp = (C.tid >> 2) & 3, nqt = C.tid & 3, nc0 = ngrp * 64 + nqt * 16;
        u32x4 pa[4], pg[4];
#define CONV_LOAD(tl) do { const int t0_ = (tl) * 32, seq0_ = (t0_ / SEQ) * SEQ; _Pragma("unroll") for (int k = 0; k < 4; ++k) { const int it = C.tid + NTHR * k, r = it >> 5, ch = it & 31, tok = t0_ - 30 + r; \
            pa[k] = (u32x4){0u, 0u, 0u, 0u}; pg[k] = pa[k]; \
            if (it < 62 * 32 && tok >= seq0_) { pa[k] = *(const u32x4*)(CI + (size_t)tok * 512 + ch * 8); pg[k] = *(const u32x4*)(CI + (size_t)tok * 512 + 256 + ch * 8); } } } while (0)
        if (C.vcu < M / 32) CONV_LOAD(C.vcu);
        for (int tile = C.vcu; tile < M / 32; tile += C.G) {
            const int t0 = tile * 32;
#pragma unroll
            for (int k = 0; k < 4; ++k) { const int it = C.tid + NTHR * k, r = it >> 5, ch = it & 31;
                if (it < 62 * 32) { const u32x4 a = pa[k], g = pg[k];
                    const f32x4 o0 = (f32x4){bflo(a.x) * sigmoidf_(bflo(g.x)), bfhi(a.x) * sigmoidf_(bfhi(g.x)), bflo(a.y) * sigmoidf_(bflo(g.y)), bfhi(a.y) * sigmoidf_(bfhi(g.y))};
                    const f32x4 o1 = (f32x4){bflo(a.z) * sigmoidf_(bflo(g.z)), bfhi(a.z) * sigmoidf_(bfhi(g.z)), bflo(a.w) * sigmoidf_(bflo(g.w)), bfhi(a.w) * sigmoidf_(bfhi(g.w))};
                    *(LAS f32x4*)(hL + r * 256 + ch * 8) = o0; *(LAS f32x4*)(hL + r * 256 + ch * 8 + 4) = o1; } }
            __syncthreads();
            if (tile + C.G < M / 32) CONV_LOAD(tile + C.G);
#pragma unroll
            for (int chunk = 0; chunk < 2; ++chunk) { const int base = tt0 + chunk * 8; float hv[38];
#pragma unroll
                for (int i = 0; i < 38; ++i) hv[i] = hL[(base + i) * 256 + cch];
#pragma unroll
                for (int tt = 0; tt < 8; ++tt) { float acc = cb;
#pragma unroll
                    for (int j = 0; j < 31; ++j) acc += wj[j] * hv[tt + j];
                    yL[(base + tt) * 256 + cch] = acc; } }
            __syncthreads();
            { float v[16]; float s = 0.f;
#pragma unroll
              for (int i = 0; i < 16; i += 4) { const f32x4 t4 = *(const LAS f32x4*)(yL + ntok * 256 + nc0 + i); v[i] = t4[0]; v[i + 1] = t4[1]; v[i + 2] = t4[2]; v[i + 3] = t4[3]; s += (t4[0] + t4[1]) + (t4[2] + t4[3]); }
              s += lane_xor<1>(s); s += lane_xor<2>(s); const float mean = s * (1.0f / 64); float q = 0.f;
#pragma unroll
              for (int i = 0; i < 16; ++i) { v[i] -= mean; q += v[i] * v[i]; }
              q += lane_xor<1>(q); q += lane_xor<2>(q); const float rstd = 1.0f / sqrtf(q * (1.0f / 64) + EPS);
              const float* gg = A->in[10] + layer * 256 + nc0; const float* gb = A->in[11] + layer * 256 + nc0; float o[16];
#pragma unroll
              for (int i = 0; i < 16; ++i) o[i] = siluf_(v[i] * rstd * gg[i] + gb[i]);
              bf16* dst = MIXED + (size_t)(t0 + ntok) * 1024 + 768 + nc0;
              *(u32x4*)dst = (u32x4){pk2(o[0], o[1]), pk2(o[2], o[3]), pk2(o[4], o[5]), pk2(o[6], o[7])};
              *(u32x4*)(dst + 8) = (u32x4){pk2(o[8], o[9]), pk2(o[10], o[11]), pk2(o[12], o[13]), pk2(o[14], o[15])}; }
        }
        __syncthreads();
    }
    REPS(11) ffn_weights(C, A, layer, C.gw, C.NGW, ffn_split(layer), 1 << 30);
}

__device__ __forceinline__ void p5_rms(Ctx& C) {
    bf16* MIXED = (bf16*)(C.ws + WS_SCR + SC_MIXED);
    REPS(7) for (int mb = C.gw; mb < M; mb += 4 * C.NGW) {
        u32x4 wa[4]; u32x2 wb[4];
#pragma unroll
        for (int k = 0; k < 4; ++k) { const bf16* r = MIXED + ((size_t)mb + (size_t)k * C.NGW) * 1024; wa[k] = ((const u32x4*)r)[C.lane]; wb[k] = ((const u32x2*)(r + 512))[C.lane]; }
#pragma unroll
        for (int k = 0; k < 4; ++k) { bf16* r = MIXED + ((size_t)mb + (size_t)k * C.NGW) * 1024;
            { const u32x4 w = wa[k]; float a[8] = {bflo(w.x), bfhi(w.x), bflo(w.y), bfhi(w.y), bflo(w.z), bfhi(w.z), bflo(w.w), bfhi(w.w)}; float ss = 0.f;
#pragma unroll
              for (int i = 0; i < 8; ++i) ss += a[i] * a[i];
              ss = wave_sum(ss); const float rs = 1.0f / sqrtf(ss * (1.0f / 512) + EPS);
              ((u32x4*)r)[C.lane] = (u32x4){pk2(a[0] * rs, a[1] * rs), pk2(a[2] * rs, a[3] * rs), pk2(a[4] * rs, a[5] * rs), pk2(a[6] * rs, a[7] * rs)}; }
            { const u32x2 w = wb[k]; const float a0 = bflo(w.x), a1 = bfhi(w.x), a2 = bflo(w.y), a3 = bfhi(w.y);
              const float ss = wave_sum((a0 * a0 + a1 * a1) + (a2 * a2 + a3 * a3)); const float rs = 1.0f / sqrtf(ss * (1.0f / 256) + EPS); ((u32x2*)(r + 512))[C.lane] = (u32x2){pk2(a0 * rs, a1 * rs), pk2(a2 * rs, a3 * rs)}; }
        }
    }
}

template <int MODE>
__device__ __forceinline__ void ln_pass(Ctx& C, const bool final, const bf16* add, const float* gam, const float* bet, const float* router_w) {
    bf16* XB = (bf16*)(C.ws + WS_XB); float* out = C.out;
    REPS(14) {
    const bool dry = ((REP_MASK >> 14) & 1) && rep_ == 0; float* jf = (float*)(C.ws + WS_SCR); bf16* jb = (bf16*)(C.ws + WS_SCR + 40 * MiB);
    int* TOPE = (int*)(C.ws + WS_MOE + MT_TOPE); float* TOPG = (float*)(C.ws + WS_MOE + MT_TOPG); const int* TOKSLOT = (const int*)(C.ws + WS_MOE + MT_TOKSLOT);
    LAS float* RW = (LAS float*)C.lds; LAS unsigned* CNT = (LAS unsigned*)(C.lds + 32768);
    if constexpr (MODE == 1) {
        for (int i = C.tid; i < 1024 * 8 / 4; i += NTHR) *(LAS f32x4*)(RW + 4 * i) = *(const f32x4*)(router_w + 4 * i);
        if (C.tid < 8) CNT[C.tid] = 0u;
        __syncthreads();
    }
    f32x4 g4[4], b4[4];
#pragma unroll
    for (int j = 0; j < 4; ++j) { g4[j] = ((const f32x4*)gam)[64 * j + C.lane]; b4[j] = ((const f32x4*)bet)[64 * j + C.lane]; }
    const int RPB = M / C.G, row0 = C.bx * RPB;
    unsigned cnt0 = 0, cnt1 = 0, cnt2 = 0, cnt3 = 0, cnt4 = 0, cnt5 = 0, cnt6 = 0, cnt7 = 0;
    u32x2 nx[4], na[4], nb[4]; int sl0 = 0, sl1 = 0;
#define LN_LOAD(mm) do { _Pragma("unroll") for (int j = 0; j < 4; ++j) { nx[j] = ((const u32x2*)(XB + (size_t)(mm) * DM))[64 * j + C.lane]; \
        if constexpr (MODE == 2) { na[j] = ((const u32x2*)(add + (size_t)sl0 * DM))[64 * j + C.lane]; nb[j] = ((const u32x2*)(add + (size_t)sl1 * DM))[64 * j + C.lane]; } \
        else { na[j] = ((const u32x2*)(add + (size_t)(mm) * DM))[64 * j + C.lane]; nb[j] = (u32x2){0u, 0u}; } } } while (0)
    if constexpr (MODE == 2) { sl0 = TOKSLOT[2 * (row0 + C.wave)]; sl1 = TOKSLOT[2 * (row0 + C.wave) + 1]; }
    LN_LOAD(row0 + C.wave);
    if constexpr (MODE == 2) { if (C.wave + NWAVES < RPB) { sl0 = TOKSLOT[2 * (row0 + C.wave + NWAVES)]; sl1 = TOKSLOT[2 * (row0 + C.wave + NWAVES) + 1]; } }
    for (int rr = C.wave; rr < RPB; rr += NWAVES) {
        const int m = row0 + rr;
        f32x4 v[4];
#pragma unroll
        for (int j = 0; j < 4; ++j) { v[j] = (f32x4){bflo(nx[j].x), bfhi(nx[j].x), bflo(nx[j].y), bfhi(nx[j].y)} * ALPHA + (f32x4){bflo(na[j].x), bfhi(na[j].x), bflo(na[j].y), bfhi(na[j].y)};
            if constexpr (MODE == 2) v[j] += (f32x4){bflo(nb[j].x), bfhi(nb[j].x), bflo(nb[j].y), bfhi(nb[j].y)}; }
        if (rr + NWAVES < RPB) {
            LN_LOAD(m + NWAVES);
            if constexpr (MODE == 2) { if (rr + 2 * NWAVES < RPB) { sl0 = TOKSLOT[2 * (m + 2 * NWAVES)]; sl1 = TOKSLOT[2 * (m + 2 * NWAVES) + 1]; } }
        }
        float s = 0.f;
#pragma unroll
        for (int j = 0; j < 4; ++j) s += (v[j][0] + v[j][1]) + (v[j][2] + v[j][3]);
        const float mean = wave_sum(s) * (1.0f / DM); float q = 0.f;
#pragma unroll
        for (int j = 0; j < 4; ++j) { v[j] = v[j] - mean; q += (v[j][0] * v[j][0] + v[j][1] * v[j][1]) + (v[j][2] * v[j][2] + v[j][3] * v[j][3]); }
        const float rstd = 1.0f / sqrtf(wave_sum(q) * (1.0f / DM) + EPS);
#pragma unroll
        for (int j = 0; j < 4; ++j) { v[j] = v[j] * rstd * g4[j] + b4[j]; if (final) ((f32x4*)((dry ? jf + (size_t)(m & 8191) * DM : out + (size_t)m * DM)))[64 * j + C.lane] = v[j];
            ((u32x2*)((dry ? jb + (size_t)(m & 8191) * DM : XB + (size_t)m * DM)))[64 * j + C.lane] = (u32x2){pk2(v[j][0], v[j][1]), pk2(v[j][2], v[j][3])}; }
        if constexpr (MODE == 1) {
            float lg[8] = {0.f, 0.f, 0.f, 0.f, 0.f, 0.f, 0.f, 0.f};
#pragma unroll
            for (int j = 0; j < 4; ++j)
#pragma unroll
                for (int i = 0; i < 4; ++i) { const int col = 256 * j + 4 * C.lane + i; const f32x4 w0 = *(const LAS f32x4*)(RW + col * 8), w1 = *(const LAS f32x4*)(RW + col * 8 + 4); const float xv = v[j][i];
                    lg[0] += xv * w0[0]; lg[1] += xv * w0[1]; lg[2] += xv * w0[2]; lg[3] += xv * w0[3]; lg[4] += xv * w1[0]; lg[5] += xv * w1[1]; lg[6] += xv * w1[2]; lg[7] += xv * w1[3]; }
#pragma unroll
            for (int e = 0; e < 8; ++e) lg[e] = wave_sum(lg[e]);
            int e1 = 0; float v1 = lg[0];
#pragma unroll
            for (int e = 1; e < 8; ++e) if (lg[e] > v1) { v1 = lg[e]; e1 = e; }
            int e2 = -1; float v2 = -INFINITY;
#pragma unroll
            for (int e = 0; e < 8; ++e) if (e != e1 && lg[e] > v2) { v2 = lg[e]; e2 = e; }
            const float ex = fexp2((v2 - v1) * LOG2E), gA = 1.0f / (1.0f + ex), gB = ex * gA;
            if (C.lane == 0) { TOPE[2 * m] = e1; TOPE[2 * m + 1] = e2; TOPG[2 * m] = gA; TOPG[2 * m + 1] = gB; }
            cnt0 += (e1 == 0) + (e2 == 0); cnt1 += (e1 == 1) + (e2 == 1); cnt2 += (e1 == 2) + (e2 == 2); cnt3 += (e1 == 3) + (e2 == 3);
            cnt4 += (e1 == 4) + (e2 == 4); cnt5 += (e1 == 5) + (e2 == 5); cnt6 += (e1 == 6) + (e2 == 6); cnt7 += (e1 == 7) + (e2 == 7);
        }
    }
    if constexpr (MODE == 1) {
        if (C.lane == 0) { atomicAdd((unsigned*)&CNT[0], cnt0); atomicAdd((unsigned*)&CNT[1], cnt1); atomicAdd((unsigned*)&CNT[2], cnt2); atomicAdd((unsigned*)&CNT[3], cnt3);
                           atomicAdd((unsigned*)&CNT[4], cnt4); atomicAdd((unsigned*)&CNT[5], cnt5); atomicAdd((unsigned*)&CNT[6], cnt6); atomicAdd((unsigned*)&CNT[7], cnt7); }
        __syncthreads();
        if (C.tid < 8) C.ctl[CW_CNTB + C.bx * 8 + C.tid] = CNT[C.tid];
        __syncthreads();
    }
    }
#undef LN_LOAD
}

__device__ __forceinline__ void moe_assign(Ctx& C) {
    if (C.wave != 0) return;
    const int* TOPE = (const int*)(C.ws + WS_MOE + MT_TOPE); const float* TOPG = (const float*)(C.ws + WS_MOE + MT_TOPG);
    int* TOKSLOT = (int*)(C.ws + WS_MOE + MT_TOKSLOT); int* SLOTTOK = (int*)(C.ws + WS_MOE + MT_SLOTTOK); float* SLOTGATE = (float*)(C.ws + WS_MOE + MT_SLOTGATE);
    const int blk = C.bx, RPB = M / C.G, row0 = blk * RPB;
    int tot[8] = {0, 0, 0, 0, 0, 0, 0, 0}, pre[8] = {0, 0, 0, 0, 0, 0, 0, 0};
    for (int bb = C.lane; bb < C.G; bb += 64) {
        const u32x4* cp = (const u32x4*)(C.ctl + CW_CNTB + bb * 8); const u32x4 ca = cp[0], cb = cp[1]; const int lt = bb < blk ? 1 : 0;
        const int c[8] = {(int)ca.x, (int)ca.y, (int)ca.z, (int)ca.w, (int)cb.x, (int)cb.y, (int)cb.z, (int)cb.w};
#pragma unroll
        for (int e = 0; e < 8; ++e) { tot[e] += c[e]; pre[e] += lt * c[e]; }
    }
#pragma unroll
    for (int e = 0; e < 8; ++e) { tot[e] = wave_sum_i(tot[e]); pre[e] = wave_sum_i(pre[e]); }
    int seg[9]; seg[0] = 0;
#pragma unroll
    for (int e = 0; e < 8; ++e) seg[e + 1] = seg[e] + ((tot[e] + 255) & ~255);
    int run[8];
#pragma unroll
    for (int e = 0; e < 8; ++e) run[e] = seg[e] + pre[e];
    const unsigned long long ltmask = (1ull << C.lane) - 1ull;
    for (int base = 0; base < RPB * 2; base += 64) {
        const int idx = base + C.lane, token = row0 + (idx >> 1), choice = idx & 1;
        const int ex = TOPE[2 * token + choice]; const float gate = TOPG[2 * token + choice]; int slot = 0;
#pragma unroll
        for (int e = 0; e < 8; ++e) { const unsigned long long mk = __builtin_amdgcn_ballot_w64(ex == e); if (ex == e) slot = run[e] + __popcll(mk & ltmask); run[e] += __popcll(mk); }
        SLOTTOK[slot] = token; SLOTGATE[slot] = gate; TOKSLOT[2 * token + choice] = slot;
    }
    if (blk < 8) {
        int lo = 0, hi = 0;
#pragma unroll
        for (int e = 0; e < 8; ++e) if (e == blk) { lo = seg[e] + tot[e]; hi = seg[e + 1]; }
        for (int s = lo + C.lane; s < hi; s += 64) { SLOTTOK[s] = 0; SLOTGATE[s] = 0.f; }
    }
    if (blk == 0 && C.lane == 0) {
#pragma unroll
        for (int e = 0; e < 9; ++e) C.ctl[CW_SEG + e] = (unsigned)seg[e];
    }
}

#ifndef MK_PER_PHASE
#define MK_PER_PHASE 0
#endif
#ifndef PH_ENABLE
#define PH_ENABLE 0xFFFF
#endif
constexpr int PH_PER_LAYER = 12, N_PHASES = 1 + DEPTH * PH_PER_LAYER;

__global__ void __launch_bounds__(NTHR, 2) fwd_kernel(Args args) {
    extern __shared__ __attribute__((aligned(16))) unsigned char lds_raw[];
    LAS unsigned char* const lds = (LAS unsigned char*)lds_raw;
    volatile LAS unsigned* MISC = (volatile LAS unsigned*)(lds + MISC_OFF);
    for (int u = threadIdx.x; u < (LDS_BYTES - LDSCTL_OFF) / 4; u += NTHR) ((LAS unsigned*)(lds + LDSCTL_OFF))[u] = 0u;
    __syncthreads();
    const int wave0 = __builtin_amdgcn_readfirstlane((int)threadIdx.x >> 6);
    XcdBarrier bar; bar.bar = (unsigned*)(args.ws + WS_CTL) + CW_BAR; bar.x = 0; bar.st = nullptr;
    if (!MK_PER_PHASE) bar = xcd_barrier_post((unsigned*)(args.ws + WS_CTL) + CW_BAR, MISC + 8, wave0);
    const int lo = args.ph_lo, hi = args.ph_hi;
#define IN(k) (lo <= (k) && (k) < hi)
#define EN(p) ((PH_ENABLE >> (p)) & 1)
#define SEAM(k) do { if (IN((k) + 1)) { if (!MK_PER_PHASE) { unsigned long long bw0_ = 0ull; if (PROBE_ON(14)) bw0_ = __builtin_amdgcn_s_memrealtime(); xcd_barrier<false>(bar, wave0); if ((REP_MASK >> 13) & 1) xcd_barrier<false>(bar, wave0); \
        if (PROBE_ON(14)) { const unsigned long long bw1_ = __builtin_amdgcn_s_memrealtime(), bd_ = bw1_ - bw0_; while (__builtin_amdgcn_s_memrealtime() - bw1_ < bd_) __builtin_amdgcn_s_sleep(8); } \
        if (PROBE_ON(13)) { const unsigned long long bw1_ = __builtin_amdgcn_s_memrealtime(); while (__builtin_amdgcn_s_memrealtime() - bw1_ < 2000ull) __builtin_amdgcn_s_sleep(8); } } } } while (0)
#define SEAM0(k) do { if (IN((k) + 1)) { if (!MK_PER_PHASE) xcd_barrier<true>(bar, wave0); } } while (0)
#define PHASE_CTX kargs_t A = opaque_args(); Ctx C = make_ctx(A, lds, wave0); unsigned char* sc = C.ws + WS_SCR; (void)sc

    PT0(15); if (EN(15) && IN(0)) { PHASE_CTX; p0_prologue(C, A); }
    PEND(15, SEAM0(0));

    for (int layer = 0; layer < DEPTH; ++layer) {
        const int P = 1 + layer * PH_PER_LAYER;
#ifdef FORCE_MOE
        const bool moe = FORCE_MOE != 0;
#else
        const bool moe = (layer & 1) != 0;
#endif
        if (EN(0) && IN(P + 0)) { PT0(0);
            PHASE_CTX;
            pg8::DenseOrder S{(const bf16*)(C.ws + WS_XB), (const bf16*)(C.ws + WS_WIN) + (size_t)layer * NP1 * DM, DM, DM, M / 256, NP1 / 256, C.G, C.bx, REPN(0)};
            EpiInProj E{(bf16*)(sc + SC_CQKV), (bf16*)(sc + SC_CQKV) + (size_t)M * 256, (float*)(sc + SC_KR), (float*)(sc + SC_FL), (bf16*)(sc + SC_FQ), (bf16*)(sc + SC_CI)};
            pg8::gemm_phase<EpiInProj, pg8::DenseOrder, false, DM, DM, DM>(C.lds, C.tid, S, E);
            if (C.bx >= C.G / 2) ffn_weights(C, A, layer, (C.bx - C.G / 2) * NWAVES + C.wave, (C.G / 2) * NWAVES, 0, ffn_split(layer));
            PEND(0, SEAM(P + 0));
        }
        if (EN(1) && IN(P + 1)) { PT0(1); PHASE_CTX; p2_thin(C, A, layer); PEND(1, SEAM(P + 1)); }
        if (EN(2) && IN(P + 2)) { PT0(2);
            PHASE_CTX;
            struct QkvOrder { const bf16* A; const bf16* Bt; int G, c, rep;
                __device__ __forceinline__ bool next(int i, pg8::Unit& u) const { return pg8::tile_order_rep(i, G, c, M / 256, 7, rep, u.pm, u.pn); }
                __device__ __forceinline__ const char* a_base(const pg8::Unit& u) const { return (const char*)(A + (u.pn < 3 ? (size_t)0 : (size_t)M * 256)) + (size_t)u.pm * 256 * 256 * 2; }
                __device__ __forceinline__ const char* b_base(const pg8::Unit& u) const { return (const char*)Bt + (size_t)u.pn * 256 * 256 * 2; }
                __device__ __forceinline__ int tok(const pg8::Unit&, int) const { return 0; }
                __device__ __forceinline__ int ktiles(const pg8::Unit& u, int nt) const { return u.pn < 3 ? nt : nt / 2; } };
            QkvOrder S{(const bf16*)(sc + SC_CQKV), (const bf16*)(C.ws + WS_WQ2) + (size_t)layer * NP1 * 256, C.G, C.bx, REPN(2)};
            EpiQKV E{(bf16*)(sc + SC_QM), (bf16*)(sc + SC_KM), (bf16*)(sc + SC_VM), (const float*)(C.ws + WS_TAB), (const float*)(C.ws + WS_TAB) + (size_t)M * 16};
            pg8::gemm_phase<EpiQKV, QkvOrder, false, 256, 256, 256>(C.lds, C.tid, S, E);
            PEND(2, SEAM(P + 2));
        }
        if (EN(3) && IN(P + 3)) { PT0(3);
            PHASE_CTX;
            bf16* MIXED = (bf16*)(sc + SC_MIXED);
            for (int p = C.vcu; p < 512; p += C.G) { const int bh = p >> 3, s = p & 7;
                for (int i = 0; i < 2; ++i) att::attn_unit<96, false>(bh >> 3, bh & 7, i == 0 ? 15 - s : s, (const bf16*)(sc + SC_QM), 768, (const bf16*)(sc + SC_KM), 768, (const bf16*)(sc + SC_VM), 512, MIXED, 1024, (bh & 7) * 64, nullptr, C.lds, C.tid, (float*)(sc + SC_SSQ), bh & 7, nullptr);
            }
            { volatile LAS unsigned* qw = (volatile LAS unsigned*)(C.lds + RING_BYTES + 8192); const int xb = C.bx & 7; unsigned* qctr = C.ctl + CW_ATTQ + layer * 8 + xb;
              const bf16* FQ = (const bf16*)(sc + SC_FQ);
              for (;;) {
                if (C.tid == 0) qw[0] = __hip_atomic_fetch_add(qctr, 1u, RLX_AGENT);
                asm volatile("s_waitcnt vmcnt(0) lgkmcnt(0)\n\ts_barrier" ::: "memory");
                const int idx = __builtin_amdgcn_readfirstlane((int)qw[0]);
                if (idx >= 64) break;
                const int hd = idx & 3, qb = 15 - (idx >> 2), bh = xb * 4 + hd;
                att::attn_unit<64, true>(xb, hd, qb, FQ, 256, FQ + (size_t)M * 256, 256, FQ + (size_t)2 * M * 256, 256, MIXED, 1024, 512 + hd * 64, (const float*)(sc + SC_CUM), C.lds, C.tid, (float*)(sc + SC_SSQ), 8 + hd, C.ctl + CW_QKMAX + layer * 64 + bh * 2);
              }
            }
            PEND(3, SEAM(P + 3));
        }
        if (EN(5) && IN(P + 5)) { PT0(5);
            PHASE_CTX;
            pg8::DenseOrder S{(const bf16*)(sc + SC_MIXED), (const bf16*)(C.ws + WS_WOUT) + (size_t)layer * DM * DM, DM, DM, M / 256, DM / 256, C.G, C.bx, REPN(5)};
            EpiBf16<DM, false> E{(bf16*)(sc + SC_MIXOUT), DM / 256, nullptr};
            pg8::gemm_phase<EpiBf16<DM, false>, pg8::DenseOrder, false, DM, DM, DM, true>(C.lds, C.tid, S, E, (const float*)(sc + SC_SSQ));
            PEND(5, SEAM(P + 5));
        }
        if (EN(6) && IN(P + 6)) { PT0(6);
            if (moe) { PHASE_CTX; ln_pass<1>(C, false, (const bf16*)(sc + SC_MIXOUT), A->in[15] + layer * DM, A->in[16] + layer * DM, A->in[20] + (size_t)(layer >> 1) * DM * NEXP); }
            else     { PHASE_CTX; ln_pass<0>(C, false, (const bf16*)(sc + SC_MIXOUT), A->in[15] + layer * DM, A->in[16] + layer * DM, nullptr); }
            PEND(6, SEAM(P + 6));
        }
        if (EN(7) && IN(P + 7) && moe) { PT0(7); { PHASE_CTX; moe_assign(C); } PEND(7, SEAM(P + 7)); }
        if (EN(8) && IN(P + 8)) { PT0(8);
            if (moe) {
                PHASE_CTX; bf16* W13 = (bf16*)(C.ws + WS_WFFN); bf16* HID = (bf16*)(sc + SC_HID);
                const int* seg = (const int*)(C.ctl + CW_SEG);
                const int U = (seg[8] / 256) * 11;
                MoeIdxOrder<11> S{(const bf16*)(C.ws + WS_XB), W13, DM, DM, C.vcu, C.G, (U / C.G) * C.G, (const int*)(C.ws + WS_MOE + MT_SLOTTOK), seg[1], seg[2], seg[3], seg[4], seg[5], seg[6], seg[7]};
                EpiSwiGLU<DFE> E{HID, 11};
                pg8::gemm_phase<EpiSwiGLU<DFE>, MoeIdxOrder<11>, true, DM, DM, DM>(C.lds, C.tid, S, E);
            } else {
                PHASE_CTX; bf16* W13 = (bf16*)(C.ws + WS_WFFN); bf16* HID = (bf16*)(sc + SC_HID);
                pg8::DenseOrder S{(const bf16*)(C.ws + WS_XB), W13, DM, DM, M / 256, 2 * DFF / 256, C.G, C.bx, REPN(8)};
                EpiSwiGLU<DFF> E{HID, 1 << 30};
                pg8::gemm_phase<EpiSwiGLU<DFF>, pg8::DenseOrder, false, DM, DM, DM>(C.lds, C.tid, S, E);
            }
            PEND(8, SEAM(P + 8));
        }
        if (EN(9) && IN(P + 9)) { PT0(9);
            if (moe) {
                { PHASE_CTX; bf16* W13 = (bf16*)(C.ws + WS_WFFN); bf16* HID = (bf16*)(sc + SC_HID); const int* seg = (const int*)(C.ctl + CW_SEG);
                  const int U = (seg[8] / 256) * 11, UF = (U / C.G) * C.G;
                  if (UF + C.vcu < U) {
                      MoeIdxOrder<11> S{(const bf16*)(C.ws + WS_XB), W13, DM, DM, UF + C.vcu, C.G, U, (const int*)(C.ws + WS_MOE + MT_SLOTTOK), seg[1], seg[2], seg[3], seg[4], seg[5], seg[6], seg[7]};
                      EpiSwiGLU<DFE> E{HID, 11};
                      pg8::gemm_phase<EpiSwiGLU<DFE>, MoeIdxOrder<11>, true, DM, DM, DM>(C.lds, C.tid, S, E);
                      if (C.tid == 0) { __builtin_amdgcn_fence(__ATOMIC_RELEASE, "agent"); asm volatile("s_waitcnt vmcnt(0)" ::: "memory"); __hip_atomic_fetch_add(C.ctl + CW_LEFT + layer, 1u, RLX_AGENT); }
                  } }
                { PHASE_CTX; bf16* W2T = (bf16*)(C.ws + WS_WFFN) + WF_W13_ELEMS; bf16* HID = (bf16*)(sc + SC_HID); bf16* FF = (bf16*)(sc + SC_FF); const int* seg = (const int*)(C.ctl + CW_SEG);
                  const int U = (seg[8] / 256) * 11, UF = (U / C.G) * C.G, DF = (UF / 11) * 4;
                  MoeIdxOrder<4> S{HID, W2T, DFE, DFE, C.vcu, C.G, DF, nullptr, seg[1], seg[2], seg[3], seg[4], seg[5], seg[6], seg[7]};
                  EpiBf16<DM, true> E{FF, 4, (const float*)(C.ws + WS_MOE + MT_SLOTGATE)};
                  pg8::gemm_phase<EpiBf16<DM, true>, MoeIdxOrder<4>, false, DFE, DFE, DFE>(C.lds, C.tid, S, E); }
                { PHASE_CTX; bf16* W2T = (bf16*)(C.ws + WS_WFFN) + WF_W13_ELEMS; bf16* HID = (bf16*)(sc + SC_HID); bf16* FF = (bf16*)(sc + SC_FF); const int* seg = (const int*)(C.ctl + CW_SEG);
                  const int nM = seg[8] / 256, U = nM * 11, UF = (U / C.G) * C.G, DF = (UF / 11) * 4;
                  if (DF + (C.G - 1 - C.vcu) < nM * 4) {
                      if (C.wave == 0) { const unsigned need = (unsigned)(U - UF); unsigned* cw = C.ctl + CW_LEFT + layer;
                          while ((unsigned)__builtin_amdgcn_readfirstlane((int)__hip_atomic_load(cw, RLX_AGENT)) < need) __builtin_amdgcn_s_sleep(4);
                          __builtin_amdgcn_fence(__ATOMIC_ACQUIRE, "agent"); asm volatile("s_waitcnt vmcnt(0)" ::: "memory"); }
                      __syncthreads();
                      MoeIdxOrder<4> S{HID, W2T, DFE, DFE, DF + (C.G - 1 - C.vcu), C.G, nM * 4, nullptr, seg[1], seg[2], seg[3], seg[4], seg[5], seg[6], seg[7]};
                      EpiBf16<DM, true> E{FF, 4, (const float*)(C.ws + WS_MOE + MT_SLOTGATE)};
                      pg8::gemm_phase<EpiBf16<DM, true>, MoeIdxOrder<4>, false, DFE, DFE, DFE>(C.lds, C.tid, S, E);
                  } }
            } else {
                PHASE_CTX; bf16* W2T = (bf16*)(C.ws + WS_WFFN) + WF_W13_ELEMS; bf16* HID = (bf16*)(sc + SC_HID); bf16* FF = (bf16*)(sc + SC_FF);
                pg8::DenseOrder S{HID, W2T, DFF, DFF, M / 256, DM / 256, C.G, C.bx, REPN(9)};
                EpiBf16<DM, false> E{FF, DM / 256, nullptr};
                pg8::gemm_phase<EpiBf16<DM, false>, pg8::DenseOrder, false, DFF, DFF, DFF>(C.lds, C.tid, S, E);
            }
            PEND(9, SEAM(P + 9));
        }
        if (EN(10) && IN(P + 10)) { PT0(10);
            if (moe) { PHASE_CTX; ln_pass<2>(C, layer == DEPTH - 1, (const bf16*)(sc + SC_FF), A->in[24] + layer * DM, A->in[25] + layer * DM, nullptr); }
            else     { PHASE_CTX; ln_pass<0>(C, layer == DEPTH - 1, (const bf16*)(sc + SC_FF), A->in[24] + layer * DM, A->in[25] + layer * DM, nullptr); }
            PEND(10, if (layer < DEPTH - 1) SEAM(P + 10));
        }
    }
#undef IN
#undef SEAM
}

extern "C" void kernel_launch(void* const* d_in, const int* in_sizes, int n_in, void* d_out, int out_size, void* d_ws, size_t ws_size, hipStream_t stream) {
    static int grid = 0;
    if (grid == 0) {
        if (n_in != 26 || out_size != M * DM || ws_size < WS_END) { fprintf(stderr, "kernel_launch: unexpected problem (n_in %d, out %d, ws %zu < %zu)\n", n_in, out_size, ws_size, (size_t)WS_END); grid = -1; return; }
        int dev = 0, cus = 0, per_cu = 0;
        if (hipGetDevice(&dev) != hipSuccess || hipDeviceGetAttribute(&cus, hipDeviceAttributeMultiprocessorCount, dev) != hipSuccess) { grid = -1; return; }
        if (hipFuncSetAttribute((const void*)fwd_kernel, hipFuncAttributeMaxDynamicSharedMemorySize, LDS_BYTES) != hipSuccess) { fprintf(stderr, "kernel_launch: hipFuncSetAttribute failed\n"); grid = -1; return; }
        if (hipOccupancyMaxActiveBlocksPerMultiprocessor(&per_cu, (const void*)fwd_kernel, NTHR, LDS_BYTES) != hipSuccess || per_cu < 1) fprintf(stderr, "kernel_launch: occupancy query says %d\n", per_cu);
        (void)hipGetLastError();
        grid = 256; while (grid > cus && grid > 8) grid >>= 1;
    }
    if (grid < 0) return;
    (void)hipMemsetAsync((char*)d_ws + WS_CTL, 0, CTL_ZERO_BYTES, stream);
    Args a{};
    for (int i = 0; i < 26; ++i) a.in[i] = (const float*)d_in[i];
    a.out = (float*)d_out; a.ws = (unsigned char*)d_ws;
#if MK_PER_PHASE
    for (int p = 0; p < N_PHASES; ++p) { a.ph_lo = p; a.ph_hi = p + 1; hipLaunchKernelGGL(fwd_kernel, dim3(grid), dim3(NTHR), LDS_BYTES, stream, a); }
#else
    a.ph_lo = 0; a.ph_hi = N_PHASES;
    hipLaunchKernelGGL(fwd_kernel, dim3(grid), dim3(NTHR), LDS_BYTES, stream, a);
#endif
}
```

```cpp
#include <hip/hip_runtime.h>
#include <cstdio>
#include <cstdint>
#include <cmath>

#ifndef REP_MASK
#define REP_MASK 0x0
#endif
#ifndef PROBE_MASK
#define PROBE_MASK 0x0
#endif
#define PROBE_ON(k) ((PROBE_MASK >> (k)) & 1)
#define PT0(k) unsigned long long pt0_ = 0ull; if (PROBE_ON(k)) pt0_ = __builtin_amdgcn_s_memrealtime()
#ifndef PROBE_BEFORE
#define PROBE_BEFORE 0
#endif
#define PSPIN(d) do { const unsigned long long pt1_ = __builtin_amdgcn_s_memrealtime(); while (__builtin_amdgcn_s_memrealtime() - pt1_ < (d)) __builtin_amdgcn_s_sleep(8); } while (0)
#define PEND(k, seamexpr) do { unsigned long long pd_ = 0ull; if (PROBE_ON(k)) { pd_ = __builtin_amdgcn_s_memrealtime() - pt0_; if (PROBE_BEFORE) PSPIN(pd_); } seamexpr; \
        if (PROBE_ON(k) && !PROBE_BEFORE) PSPIN(pd_); } while (0)
#define REPN(p) (1 + ((REP_MASK >> (p)) & 1))
#define REPS(p) for (int rep_ = 0; rep_ < 1 + ((REP_MASK >> (p)) & 1); ++rep_)
#define GAS __attribute__((address_space(1)))
#define LAS __attribute__((address_space(3)))
typedef unsigned short bf16;
typedef short bf16x8 __attribute__((ext_vector_type(8)));
typedef short s16x4 __attribute__((ext_vector_type(4)));
typedef float f32x2 __attribute__((ext_vector_type(2)));
typedef float f32x4 __attribute__((ext_vector_type(4)));
typedef float f32x16 __attribute__((ext_vector_type(16)));
typedef unsigned u32x2 __attribute__((ext_vector_type(2)));
typedef unsigned u32x4 __attribute__((ext_vector_type(4)));
typedef __bf16 bf16x2_t __attribute__((ext_vector_type(2)));

constexpr int BATCH = 8, SEQ = 4096, DM = 1024, M = BATCH * SEQ, DEPTH = 4;
constexpr int IN_COLS = 1700, NP1 = 1792;
constexpr int DFF = 2816, DFE = 1408, NEXP = 8;
constexpr int NWAVES = 8, NTHR = 512;
constexpr float ALPHA = 1.6817928305074290f;
constexpr float EPS = 1e-5f;
constexpr float LOG2E = 1.4426950408889634f;
constexpr float C2_MLA = 0.10206207261596577f * LOG2E;
constexpr float C2_FOX = 0.125f * LOG2E;
constexpr int PC_CQ = 0, PC_CKV = 256, PC_KR = 384, PC_FL = 416, PC_FQ = 512, PC_FK = 768, PC_FV = 1024, PC_CI = 1280;
constexpr int MOE_ROWS_MAX = 2 * M + NEXP * 256;

constexpr size_t MiB = 1u << 20;
constexpr size_t WS_CTL = 0, CTL_ZERO_BYTES = 1 * MiB;
constexpr size_t WS_WIN = 1 * MiB;
constexpr size_t WS_WQ2 = WS_WIN + 14 * MiB;
constexpr size_t WS_WOUT = WS_WQ2 + 4 * MiB;
constexpr size_t WS_TAB = WS_WOUT + 8 * MiB;
constexpr size_t WS_MOE = WS_TAB + 4 * MiB;
constexpr size_t WS_WFFN = WS_MOE + 2 * MiB;
constexpr size_t WS_XB = WS_WFFN + 68 * MiB;
constexpr size_t WS_SCR = WS_XB + 64 * MiB;
constexpr size_t SC_CQKV = 0;
constexpr size_t SC_KR = SC_CQKV + 32 * MiB;
constexpr size_t SC_FL = SC_KR + 4 * MiB;
constexpr size_t SC_CUM = SC_FL + MiB / 2;
constexpr size_t SC_FQ = SC_CUM + MiB / 2;
constexpr size_t SC_CI = SC_FQ + 48 * MiB;
constexpr size_t SC_QM = SC_CI + 32 * MiB;
constexpr size_t SC_KM = SC_QM + 48 * MiB;
constexpr size_t SC_VM = SC_KM + 48 * MiB;
constexpr size_t SC_MIXED = SC_VM + 32 * MiB;
constexpr size_t SC_MIXOUT = SC_QM;
constexpr size_t SC_SSQ = SC_MIXED + 64 * MiB;
constexpr size_t SC_MIX_END = SC_SSQ + 2 * MiB;
constexpr size_t SC_HID = 0;
constexpr size_t SC_FF = 182 * MiB;
constexpr size_t SC_END = 316 * MiB;
constexpr size_t WS_END = WS_SCR + SC_END;
static_assert(SC_MIX_END <= SC_END && SC_FF + (size_t)MOE_ROWS_MAX * 1024 * 2 <= SC_END && (size_t)MOE_ROWS_MAX * DFE * 2 <= SC_FF, "scratch map");
static_assert(WS_END <= 512 * MiB, "workspace map");
constexpr size_t WF_W13_ELEMS = (size_t)NEXP * 2 * DFE * DM;
constexpr size_t MT_TOPE = 0;
constexpr size_t MT_TOPG = 256 * 1024;
constexpr size_t MT_TOKSLOT = 512 * 1024;
constexpr size_t MT_SLOTTOK = 768 * 1024;
constexpr size_t MT_SLOTGATE = 768 * 1024 + 272 * 1024;
static_assert((size_t)MOE_ROWS_MAX * 4 <= 272 * 1024 && MT_SLOTGATE + 272 * 1024 <= 2 * MiB, "moe tables");
constexpr int CW_BAR = 4096;
constexpr int CW_CNTB = 16384;
constexpr int CW_SEG = 20480;
constexpr int CW_ATTQ = 2048;
constexpr int CW_LEFT = 2112;
constexpr int CW_QKMAX = 1024;

constexpr int RING_BYTES = 131072;
constexpr int LDSCTL_OFF = RING_BYTES, MISC_OFF = LDSCTL_OFF + 320;
constexpr int LDS_BYTES = 147456;

#define RLX_AGENT __ATOMIC_RELAXED, __HIP_MEMORY_SCOPE_AGENT
__device__ __forceinline__ unsigned pk2(float lo, float hi) { f32x2 v = {lo, hi}; bf16x2_t b = __builtin_convertvector(v, bf16x2_t); return __builtin_bit_cast(unsigned, b); }
__device__ __forceinline__ float bf2f(unsigned short u) { return __uint_as_float((unsigned)u << 16); }
__device__ __forceinline__ float bflo(unsigned u) { return __uint_as_float(u << 16); }
__device__ __forceinline__ float bfhi(unsigned u) { return __uint_as_float(u & 0xffff0000u); }
__device__ __forceinline__ float fexp2(float x) { return __builtin_amdgcn_exp2f(x); }
__device__ __forceinline__ float frcp(float x) { return __builtin_amdgcn_rcpf(x); }
__device__ __forceinline__ float sigmoidf_(float x) { return frcp(1.0f + fexp2(-x * LOG2E)); }
__device__ __forceinline__ float siluf_(float x) { return x * sigmoidf_(x); }
template <int O> __device__ __forceinline__ float lane_xor(float v) {
    if constexpr (O < 32) return __int_as_float(__builtin_amdgcn_ds_swizzle(__float_as_int(v), (O << 10) | 0x1f));
    else { auto rr = __builtin_amdgcn_permlane32_swap(__float_as_uint(v), __float_as_uint(v), false, false); return __uint_as_float(rr[0]) == v ? __uint_as_float(rr[1]) : __uint_as_float(rr[0]); }
}
__device__ __forceinline__ float wave_sum(float v) {
    v += lane_xor<1>(v); v += lane_xor<2>(v); v += lane_xor<4>(v); v += lane_xor<8>(v); v += lane_xor<16>(v);
    { auto rr = __builtin_amdgcn_permlane32_swap(__float_as_uint(v), __float_as_uint(v), false, false); v = __uint_as_float(rr[0]) + __uint_as_float(rr[1]); }
    return v;
}
__device__ __forceinline__ int wave_sum_i(int v) {
    v += __builtin_amdgcn_ds_swizzle(v, (1 << 10) | 0x1f); v += __builtin_amdgcn_ds_swizzle(v, (2 << 10) | 0x1f); v += __builtin_amdgcn_ds_swizzle(v, (4 << 10) | 0x1f);
    v += __builtin_amdgcn_ds_swizzle(v, (8 << 10) | 0x1f); v += __builtin_amdgcn_ds_swizzle(v, (16 << 10) | 0x1f);
    { auto rr = __builtin_amdgcn_permlane32_swap((unsigned)v, (unsigned)v, false, false); v = (int)(rr[0] + rr[1]); }
    return v;
}
__device__ __forceinline__ u32x4 pack8(const f32x4 a, const f32x4 b) { u32x4 w; w.x = pk2(a[0], a[1]); w.y = pk2(a[2], a[3]); w.z = pk2(b[0], b[1]); w.w = pk2(b[2], b[3]); return w; }

#define XB_TMO      128
#define XB_XCNT(j)  (256  + 64 * (j))
#define XB_XSUB(j)  (1280 + 64 * (j))
#define XB_XGEN(j)  (2304 + 64 * (j))
#define XB_TOP      3328
#define XB_TOPGEN   3392
#define XCD_BAR_WORDS 3456
#define XB_SPIN_CAP (1u << 18)
__device__ __forceinline__ unsigned xb_ld(unsigned* p)              { return __hip_atomic_load(p, __ATOMIC_RELAXED, __HIP_MEMORY_SCOPE_AGENT); }
__device__ __forceinline__ unsigned xb_add(unsigned* p, unsigned v) { return __hip_atomic_fetch_add(p, v, __ATOMIC_RELAXED, __HIP_MEMORY_SCOPE_AGENT); }
__device__ __forceinline__ unsigned xb_xcc_id() { return (unsigned)__builtin_amdgcn_s_getreg((3 << 11) | 20) & 0xFu; }
#define XB_SPIN(cond, bar) do { unsigned _sp = 0; while (cond) { __builtin_amdgcn_s_sleep(1); \
    if ((++_sp & 255u) == 0u) { if (xb_ld(&(bar)[XB_TMO])) break; if (_sp > XB_SPIN_CAP) { atomicAdd(&(bar)[XB_TMO], 1u); break; } } } } while (0)
struct XcdBarrier { unsigned* bar; unsigned x; volatile LAS unsigned* st; };
__device__ __forceinline__ bool xb_is_t0(int wave0) { unsigned ones = ~0u; asm volatile("" : "+s"(ones)); return wave0 == 0 && __builtin_amdgcn_mbcnt_hi(ones, __builtin_amdgcn_mbcnt_lo(ones, 0u)) == 0u; }
__device__ __forceinline__ XcdBarrier xcd_barrier_post(unsigned* bar, volatile LAS unsigned* st, int wave0) {
    XcdBarrier b; b.bar = bar; b.x = xb_xcc_id(); b.st = st;
    if (xb_is_t0(wave0)) (void)xb_add(&bar[XB_XCNT(b.x)], 1u);
    return b;
}
__device__ __forceinline__ void xcd_barrier_complete(unsigned* bar, unsigned x, unsigned& nloc, unsigned& nx) {
    const unsigned G = gridDim.x * gridDim.y * gridDim.z;
    unsigned sum, cnt, mine, sp = 0u;
    for (;;) {
        sum = 0u; cnt = 0u; mine = 0u;
#pragma unroll
        for (unsigned j = 0; j < 16; ++j) { const unsigned c = xb_ld(&bar[XB_XCNT(j)]); sum += c; cnt += (c > 0u) ? 1u : 0u; mine = (j == x) ? c : mine; }
        if (sum == G) break;
        __builtin_amdgcn_s_sleep(1);
        if ((++sp & 255u) == 0u) { if (xb_ld(&bar[XB_TMO])) break; if (sp > XB_SPIN_CAP) { atomicAdd(&bar[XB_TMO], 1u); break; } }
    }
    nloc = mine > 0u ? mine : 1u; nx = cnt > 0u ? cnt : 1u;
}
template <bool FIRST>
__device__ __forceinline__ void xcd_barrier(const XcdBarrier& b, int wave0) {
    asm volatile("s_waitcnt vmcnt(0)" ::: "memory");
    __syncthreads();
    if (xb_is_t0(wave0)) {
        unsigned* bar = b.bar;
        __builtin_amdgcn_s_waitcnt(0);
        unsigned nloc = b.st[0], nx = b.st[1];
        if constexpr (FIRST) { if (nloc == 0u) { xcd_barrier_complete(bar, b.x, nloc, nx); b.st[0] = nloc; b.st[1] = nx; } }
        const unsigned old = xb_add(&bar[XB_XSUB(b.x)], 1u);
        const unsigned gen = old / nloc;
        if (old + 1u == (gen + 1u) * nloc) {
            __builtin_amdgcn_fence(__ATOMIC_RELEASE, "agent");
            asm volatile("s_waitcnt vmcnt(0)" ::: "memory");
            const unsigned og = xb_add(&bar[XB_TOP], 1u);
            const unsigned tg = og / nx;
            if (og + 1u == (tg + 1u) * nx) xb_add(&bar[XB_TOPGEN], 1u);
            else XB_SPIN(xb_ld(&bar[XB_TOPGEN]) == tg, bar);
            __builtin_amdgcn_fence(__ATOMIC_ACQUIRE, "agent");
            xb_add(&bar[XB_XGEN(b.x)], 1u);
            asm volatile("s_waitcnt vmcnt(0)" ::: "memory");
        } else {
            XB_SPIN(xb_ld(&bar[XB_XGEN(b.x)]) == gen, bar);
            __builtin_amdgcn_fence(__ATOMIC_ACQUIRE, "agent");
            asm volatile("s_waitcnt vmcnt(0)" ::: "memory");
        }
    }
    __syncthreads();
}

namespace pg8 {
constexpr int BM = 256, BK = 64, HALF = 128, HTB = HALF * BK * 2, STAGE_BYTES = 8 * HTB, NXCD = 8, WGM = 8;
__host__ __device__ __forceinline__ int lds_byte(int r, int c) { const int st = (r >> 4) * 2 + (c >> 5), rr = r & 15, cc = c & 31, ob = rr * 64 + cc * 2; return st * 1024 + (ob ^ (((ob >> 9) & 1) << 5)); }
__host__ __device__ __forceinline__ void stage_rc(int b, int& R, int& C) { const int st = b / 1024, sb = b % 1024, swz = sb ^ (((sb >> 9) & 1) << 5); R = (st >> 1) * 16 + swz / 64; C = (st & 1) * 32 + (swz % 64) / 2; }
__host__ __device__ __forceinline__ int perm32(int rho) { const int n = rho >> 4, i = rho & 15; return 8 * (i >> 2) + 4 * n + (i & 3); }
struct Unit { int pm, pn; };

__device__ __forceinline__ bool tile_order(long L, int nM, int nN, int& pm, int& pn) {
    const int nwg = nM * nN; if (L >= nwg) return false;
    int wgid = (int)L; { const int q = nwg / NXCD, r = nwg % NXCD, xcd = wgid % NXCD, off = wgid / NXCD; wgid = (xcd < r ? xcd * (q + 1) : r * (q + 1) + (xcd - r) * q) + off; }
    const int nig = WGM * nN, gid = wgid / nig, fm = gid * WGM, gsz = (nM - fm) < WGM ? (nM - fm) : WGM;
    pm = fm + ((wgid % nig) % gsz); pn = (wgid % nig) / gsz; return true;
}
__device__ __forceinline__ bool tile_order_rep(int i, int G, int c, int nM, int nN, int rep, int& pm, int& pn) {
    if (rep == 1) return tile_order((long)i * G + c, nM, nN, pm, pn);
    const int nwg = nM * nN, per = c < nwg ? (nwg - c + G - 1) / G : 0; if (i >= per * rep) return false;
    return tile_order((long)(i % per) * G + c, nM, nN, pm, pn);
}
struct DenseOrder {
    const bf16* A; const bf16* Bt; int lda, ldb, nM, nN, G, c, rep;
    __device__ __forceinline__ bool next(int i, Unit& u) const { return tile_order_rep(i, G, c, nM, nN, rep, u.pm, u.pn); }
    __device__ __forceinline__ const char* a_base(const Unit& u) const { return (const char*)A + (size_t)u.pm * BM * lda * 2; }
    __device__ __forceinline__ const char* b_base(const Unit& u) const { return (const char*)Bt + (size_t)u.pn * BM * ldb * 2; }
    __device__ __forceinline__ int tok(const Unit&, int) const { return 0; }
    __device__ __forceinline__ int ktiles(const Unit&, int nt) const { return nt; }
};

template <class Epi, class Sched, bool GATHER, int K, int lda, int ldb, bool SEGSCALE = false>
__device__ __forceinline__ void gemm_phase(LAS unsigned char* lds, const int tid, const Sched& S, const Epi& E, const float* ssq = nullptr) {
    const int wid = __builtin_amdgcn_readfirstlane(tid >> 6), lane = tid & 63, wr = wid >> 2, wc = wid & 3, fr = lane & 15, fq = lane >> 4;
    constexpr int nt = K / BK;
    unsigned voffA[2], voffB[2];
#pragma unroll
    for (int i = 0; i < 2; ++i) { int R, C; stage_rc(tid * 16 + i * 8192, R, C); const int Rb = Epi::PERM ? ((R & ~31) + perm32(R & 31)) : R;
        voffA[i] = (unsigned)(R * lda + C) * 2u; voffB[i] = (unsigned)(Rb * ldb + C) * 2u; }
#define PG8_GOFF(u_, h_, o0_, o1_) do { unsigned ones_ = ~0u; asm volatile("" : "+s"(ones_)); const int t_ = wid * 64 + (int)__builtin_amdgcn_mbcnt_hi(ones_, __builtin_amdgcn_mbcnt_lo(ones_, 0u)); \
        int R0_, C0_, R1_, C1_; stage_rc(t_ * 16, R0_, C0_); stage_rc(t_ * 16 + 8192, R1_, C1_); \
        o0_ = (unsigned)S.tok(u_, (h_) * HALF + R0_) * (unsigned)(lda * 2) + (unsigned)(C0_ * 2); o1_ = (unsigned)S.tok(u_, (h_) * HALF + R1_) * (unsigned)(lda * 2) + (unsigned)(C1_ * 2); } while (0)
    const size_t kstep = (size_t)(BK * 2);
    constexpr size_t hstepA = (size_t)HALF * lda * 2, hstepB = (size_t)HALF * ldb * 2;
    const unsigned ldsw = (unsigned)wid * 1024u;
    const int aoff = lds_byte(wr * 64 + fr, fq * 8), boff = lds_byte(wc * 32 + fr, fq * 8);
#define PG8_SA(b, h) (((b) * 2 + (h)) * HTB)
#define PG8_SB(b, h) ((4 + (b) * 2 + (h)) * HTB)
#define PG8_STAGE(bufoff, gbase, v0, v1) do { \
        __builtin_amdgcn_global_load_lds((const unsigned*)((const char*)(gbase) + (v0)), (LAS unsigned*)(lds + (bufoff) + ldsw), 16, 0, 0); \
        __builtin_amdgcn_global_load_lds((const unsigned*)((const char*)(gbase) + (v1)), (LAS unsigned*)(lds + (bufoff) + ldsw + 8192), 16, 0, 0); } while (0)
#define PG8_STB(bufoff, gbase) PG8_STAGE(bufoff, gbase, voffB[0], voffB[1])
#define PG8_STA(bufoff, gbase, h, G0, G1) do { if constexpr (GATHER) PG8_STAGE(bufoff, gbase, G0, G1); else PG8_STAGE(bufoff, (gbase) + (h) * hstepA, voffA[0], voffA[1]); } while (0)
#define PG8_LDA(dst, b, h) do { _Pragma("unroll") for (int m = 0; m < 4; ++m) _Pragma("unroll") for (int k = 0; k < 2; ++k) dst[m][k] = *(const LAS bf16x8*)(lds + PG8_SA(b, h) + aoff + m * 2048 + k * 1024); } while (0)
#define PG8_LDB(dst, b, h) do { _Pragma("unroll") for (int n = 0; n < 2; ++n) _Pragma("unroll") for (int k = 0; k < 2; ++k) dst[n][k] = *(const LAS bf16x8*)(lds + PG8_SB(b, h) + boff + n * 2048 + k * 1024); } while (0)
#define PG8_MMA(ai, bj, At, Bt) do { __builtin_amdgcn_s_setprio(1); _Pragma("unroll") for (int m = 0; m < 4; ++m) _Pragma("unroll") for (int n = 0; n < 2; ++n) _Pragma("unroll") for (int k = 0; k < 2; ++k) \
        acc[ai][bj][m][n] = __builtin_amdgcn_mfma_f32_16x16x32_bf16(Bt[n][k], At[m][k], acc[ai][bj][m][n], 0, 0, 0); __builtin_amdgcn_s_setprio(0); } while (0)
#define PG8_WAIT_V(n) asm volatile("s_waitcnt vmcnt(" #n ")" ::: "memory")
#define PG8_WAIT_L(n) asm volatile("s_waitcnt lgkmcnt(" #n ")" ::: "memory")
#define PG8_BAR __builtin_amdgcn_s_barrier()
#define PG8_SCHED __builtin_amdgcn_sched_barrier(0)
    Unit cur, nxt; int ui = 0;
    if (!S.next(0, cur)) return;
    f32x4 acc[2][2][4][2];
#pragma unroll
    for (int a = 0; a < 2; ++a)
#pragma unroll
        for (int b = 0; b < 2; ++b)
#pragma unroll
            for (int m = 0; m < 4; ++m)
#pragma unroll
                for (int n = 0; n < 2; ++n) acc[a][b][m][n] = (f32x4){0.f, 0.f, 0.f, 0.f};
    bf16x8 At[4][2], B0[2][2], B1[2][2];
    const char* cA = S.a_base(cur); const char* cB = S.b_base(cur);
    unsigned gc00 = 0, gc01 = 0, gc10 = 0, gc11 = 0, gn00 = 0, gn01 = 0, gn10 = 0, gn11 = 0;
    if constexpr (GATHER) { PG8_GOFF(cur, 0, gc00, gc01); PG8_GOFF(cur, 1, gc10, gc11); }
    PG8_STB(PG8_SB(0, 0), cB); PG8_STB(PG8_SB(0, 1), cB + hstepB); PG8_STA(PG8_SA(0, 0), cA, 0, gc00, gc01); PG8_STA(PG8_SA(0, 1), cA, 1, gc10, gc11);
    if (wr == 1) PG8_BAR;
    PG8_WAIT_V(2); PG8_BAR;
    PG8_STB(PG8_SB(1, 0), cB + kstep); PG8_STA(PG8_SA(1, 0), cA + kstep, 0, gc00, gc01); PG8_STB(PG8_SB(1, 1), cB + hstepB + kstep);
    PG8_WAIT_V(6); PG8_BAR;
    for (;;) {
        const bool has_next = S.next(ui + 1, nxt);
        const char* nA = has_next ? S.a_base(nxt) : cA; const char* nB = has_next ? S.b_base(nxt) : cB;
        if constexpr (SEGSCALE) {
            if (tid < 256) { const f32x4* sp = (const f32x4*)(ssq + (size_t)(cur.pm * 256 + tid) * 12); const f32x4 a = sp[0], b = sp[1], c = sp[2];
                const float sm = ((a[0] + a[1]) + (a[2] + a[3])) + ((b[0] + b[1]) + (b[2] + b[3])), sf = (c[0] + c[1]) + (c[2] + c[3]);
                const float rm = 1.0f / sqrtf(sm * (1.0f / 512) + EPS), rf = 1.0f / sqrtf(sf * (1.0f / 256) + EPS);
                *(LAS f32x2*)(lds + STAGE_BYTES + 1024 + tid * 8) = (f32x2){rm / rf, rf}; }
        }
        if constexpr (GATHER) {
            if (has_next) { PG8_GOFF(nxt, 0, gn00, gn01); PG8_GOFF(nxt, 1, gn10, gn11); }
            else { gn00 = gc00; gn01 = gc01; gn10 = gc10; gn11 = gc11; }
        }
        const int ntu = S.ktiles(cur, nt);
#pragma nounroll
        for (int t = 0; t < ntu; t += 2) {
            const bool last = (t == ntu - 2);
            const char* a1 = cA + (size_t)(t + 1) * kstep;
            const char* a2 = last ? nA : cA + (size_t)(t + 2) * kstep; const char* b2 = last ? nB : cB + (size_t)(t + 2) * kstep;
            const char* a3 = a2 + kstep; const char* b3 = b2 + kstep;
            const unsigned g00 = last ? gn00 : gc00, g01 = last ? gn01 : gc01, g10 = last ? gn10 : gc10, g11 = last ? gn11 : gc11;
            PG8_LDB(B0, 0, 0); PG8_LDB(B1, 0, 1); PG8_SCHED; PG8_LDA(At, 0, 0); PG8_STA(PG8_SA(1, 1), a1, 1, gc10, gc11);
            PG8_WAIT_V(8); PG8_WAIT_L(0); PG8_BAR; PG8_MMA(0, 0, At, B0); PG8_MMA(0, 1, At, B1); PG8_BAR; PG8_SCHED;
            PG8_LDA(At, 0, 1); PG8_STB(PG8_SB(0, 0), b2); PG8_STB(PG8_SB(0, 1), b2 + hstepB); PG8_STA(PG8_SA(0, 0), a2, 0, g00, g01);
            PG8_WAIT_V(8); PG8_WAIT_L(0); PG8_BAR; PG8_MMA(1, 0, At, B0); PG8_MMA(1, 1, At, B1); PG8_BAR; PG8_SCHED;
            PG8_LDB(B0, 1, 0); PG8_LDB(B1, 1, 1); PG8_SCHED; PG8_LDA(At, 1, 0); PG8_STA(PG8_SA(0, 1), a2, 1, g10, g11);
            PG8_WAIT_V(8); PG8_WAIT_L(0); PG8_BAR; PG8_MMA(0, 0, At, B0); PG8_MMA(0, 1, At, B1); PG8_BAR; PG8_SCHED;
            PG8_LDA(At, 1, 1); PG8_STB(PG8_SB(1, 0), b3); PG8_STB(PG8_SB(1, 1), b3 + hstepB); PG8_STA(PG8_SA(1, 0), a3, 0, g00, g01);
            PG8_WAIT_V(8); PG8_WAIT_L(0); PG8_BAR; PG8_MMA(1, 0, At, B0); PG8_MMA(1, 1, At, B1); PG8_BAR; PG8_SCHED;
            if constexpr (SEGSCALE) {
                if (t == 6 || t == 10) {
                    unsigned ones_ = ~0u; asm volatile("" : "+s"(ones_)); const int fr_ = (int)__builtin_amdgcn_mbcnt_hi(ones_, __builtin_amdgcn_mbcnt_lo(ones_, 0u)) & 15;
                    const LAS float* fp = (const LAS float*)(lds + STAGE_BYTES + 1024) + (wr * 64 + fr_) * 2 + (t == 10 ? 1 : 0);
#pragma unroll
                    for (int ai = 0; ai < 2; ++ai)
#pragma unroll
                        for (int m = 0; m < 4; ++m) { const float f = fp[(ai * 128 + m * 16) * 2];
#pragma unroll
                            for (int bj = 0; bj < 2; ++bj)
#pragma unroll
                                for (int n = 0; n < 2; ++n) acc[ai][bj][m][n] *= f; }
                    PG8_SCHED;
                }
            }
        }
        if (wr == 0) PG8_BAR;
        { unsigned ones_ = ~0u; asm volatile("" : "+s"(ones_)); const int l_ = (int)__builtin_amdgcn_mbcnt_hi(ones_, __builtin_amdgcn_mbcnt_lo(ones_, 0u)); E(acc, cur, wr, wc, l_ & 15, l_ >> 4); }
        if (!has_next) break;
#pragma unroll
        for (int a = 0; a < 2; ++a)
#pragma unroll
            for (int b = 0; b < 2; ++b)
#pragma unroll
                for (int m = 0; m < 4; ++m)
#pragma unroll
                    for (int n = 0; n < 2; ++n) acc[a][b][m][n] = (f32x4){0.f, 0.f, 0.f, 0.f};
        cur = nxt; cA = nA; cB = nB; ++ui;
        if constexpr (GATHER) { gc00 = gn00; gc01 = gn01; gc10 = gn10; gc11 = gn11; }
        if (wr == 1) PG8_BAR;
    }
    PG8_WAIT_V(0);
    PG8_BAR;
#undef PG8_GOFF
#undef PG8_SA
#undef PG8_SB
#undef PG8_STAGE
#undef PG8_STB
#undef PG8_STA
#undef PG8_LDA
#undef PG8_LDB
#undef PG8_MMA
#undef PG8_WAIT_V
#undef PG8_WAIT_L
#undef PG8_BAR
#undef PG8_SCHED
}
}

#define EPI_ROWS_BEGIN _Pragma("unroll") for (int ai = 0; ai < 2; ++ai) _Pragma("unroll") for (int m = 0; m < 4; ++m) { const unsigned row = (unsigned)(u.pm * 256 + ai * 128 + wr * 64 + m * 16 + fr);
#define EPI_ROWS_END asm volatile("" ::: "memory"); }
__device__ __forceinline__ void st16(void* base, unsigned off, u32x4 v) { *(u32x4*)((char*)base + off) = v; }
struct EpiInProj {
    static constexpr bool PERM = true;
    bf16* CQ; bf16* CKV; float* KR; float* FL; bf16* FQ; bf16* CI;
    __device__ __forceinline__ void operator()(const f32x4 (&acc)[2][2][4][2], const pg8::Unit& u, int wr, int wc, int fr, int fq) const {
        const int t = u.pn; const unsigned c8 = (unsigned)(wc * 32 + 8 * fq);
        if (t != 1) {
            bf16* base; unsigned ld;
            if (t == 0) { base = CQ; ld = 256; } else if (t <= 4) { base = FQ + (size_t)(t - 2) * M * 256; ld = 256; } else { base = CI + (t - 5) * 256; ld = 512; }
            EPI_ROWS_BEGIN
                const unsigned off = (row * ld + c8) * 2u;
                st16(base, off, pack8(acc[ai][0][m][0], acc[ai][0][m][1]));
                st16(base, off + 256u, pack8(acc[ai][1][m][0], acc[ai][1][m][1]));
            EPI_ROWS_END
        } else {
            EPI_ROWS_BEGIN
                const unsigned off = (row * 256u + c8) * 2u;
                st16(CKV, off, pack8(acc[ai][0][m][0], acc[ai][0][m][1]));
                if (c8 < 32) { const unsigned ko = (row * 32u + c8) * 4u; *(f32x4*)((char*)KR + ko) = acc[ai][1][m][0]; *(f32x4*)((char*)KR + ko + 16) = acc[ai][1][m][1]; }
                else if (c8 == 32) { *(f32x4*)((char*)FL + row * 16u) = acc[ai][1][m][0]; }
            EPI_ROWS_END
        }
    }
};
struct EpiQKV {
    static constexpr bool PERM = true;
    bf16* QM; bf16* KM; bf16* VM; const float* COS; const float* SIN;
    __device__ __forceinline__ void operator()(const f32x4 (&acc)[2][2][4][2], const pg8::Unit& u, int wr, int wc, int fr, int fq) const {
        const int t = u.pn; const unsigned c8 = (unsigned)(wc * 32 + 8 * fq);
        if (t < 3) {
#pragma unroll
            for (int bj = 0; bj < 2; ++bj) {
                const unsigned col = (unsigned)(t * 256 + bj * 128) + c8, h = col / 96u, d = col - h * 96u;
                const bool rope = d >= 64; const unsigned f4 = rope ? ((d - 64) >> 1) : 0u;
#pragma unroll
                for (int ai = 0; ai < 2; ++ai) {
                    f32x4 cc[4], ss[4];
                    if (rope) {
#pragma unroll
                        for (int m = 0; m < 4; ++m) { const unsigned to = ((unsigned)(u.pm * 256 + ai * 128 + wr * 64 + m * 16 + fr) * 16u + f4) * 4u;
                            cc[m] = *(const f32x4*)((const char*)COS + to); ss[m] = *(const f32x4*)((const char*)SIN + to); }
                    }
#pragma unroll
                    for (int m = 0; m < 4; ++m) { const unsigned row = (unsigned)(u.pm * 256 + ai * 128 + wr * 64 + m * 16 + fr);
                        f32x4 v0 = acc[ai][bj][m][0], v1 = acc[ai][bj][m][1];
                        if (rope) {
                            const f32x4 c = cc[m], s = ss[m], a = v0, b = v1;
                            v0 = (f32x4){a[0] * c[0] - a[2] * s[0], a[1] * c[1] - a[3] * s[1], a[0] * s[0] + a[2] * c[0], a[1] * s[1] + a[3] * c[1]};
                            v1 = (f32x4){b[0] * c[2] - b[2] * s[2], b[1] * c[3] - b[3] * s[3], b[0] * s[2] + b[2] * c[2], b[1] * s[3] + b[3] * c[3]};
                        }
                        st16(QM, (row * 768u + col) * 2u, pack8(v0, v1));
                    }
                    asm volatile("" ::: "memory");
                }
            }
        } else if (t < 5) {
#pragma unroll
            for (int bj = 0; bj < 2; ++bj) {
                const unsigned kc = (unsigned)((t - 3) * 256 + bj * 128) + c8, h = kc >> 6, d = kc & 63;
                EPI_ROWS_BEGIN
                    st16(KM, (row * 768u + h * 96u + d) * 2u, pack8(acc[ai][bj][m][0], acc[ai][bj][m][1]));
                EPI_ROWS_END
            }
        } else {
#pragma unroll
            for (int bj = 0; bj < 2; ++bj) {
                const unsigned vc = (unsigned)((t - 5) * 256 + bj * 128) + c8;
                EPI_ROWS_BEGIN
                    st16(VM, (row * 512u + vc) * 2u, pack8(acc[ai][bj][m][0], acc[ai][bj][m][1]));
                EPI_ROWS_END
            }
        }
    }
};
template <int LDC, bool SCALE>
struct EpiBf16 {
    static constexpr bool PERM = true;
    bf16* O; int ntn; const float* rowscale;
    __device__ __forceinline__ void operator()(const f32x4 (&acc)[2][2][4][2], const pg8::Unit& u, int wr, int wc, int fr, int fq) const {
        const unsigned col = (unsigned)((u.pn % ntn) * 256 + wc * 32 + 8 * fq);
        float sc8[8];
        if constexpr (SCALE) {
#pragma unroll
            for (int i = 0; i < 8; ++i) sc8[i] = *(const float*)((const char*)rowscale + (unsigned)(u.pm * 256 + (i >> 2) * 128 + wr * 64 + (i & 3) * 16 + fr) * 4u);
        }
        EPI_ROWS_BEGIN
            float s = 1.0f; if constexpr (SCALE) s = sc8[ai * 4 + m];
            const unsigned off = (row * (unsigned)LDC + col) * 2u;
            st16(O, off, pack8(acc[ai][0][m][0] * s, acc[ai][0][m][1] * s));
            st16(O, off + 256u, pack8(acc[ai][1][m][0] * s, acc[ai][1][m][1] * s));
        EPI_ROWS_END
    }
};
template <int LDH>
struct EpiSwiGLU {
    static constexpr bool PERM = true;
    bf16* H; int ntn;
    __device__ __forceinline__ void operator()(const f32x4 (&acc)[2][2][4][2], const pg8::Unit& u, int wr, int wc, int fr, int fq) const {
        const unsigned col = (unsigned)((u.pn % ntn) * 128 + wc * 32 + 8 * fq);
        EPI_ROWS_BEGIN
            f32x4 a0 = acc[ai][0][m][0], a1 = acc[ai][0][m][1]; const f32x4 b0 = acc[ai][1][m][0], b1 = acc[ai][1][m][1];
#pragma unroll
            for (int j = 0; j < 4; ++j) { a0[j] = siluf_(a0[j]) * b0[j]; a1[j] = siluf_(a1[j]) * b1[j]; }
            st16(H, (row * (unsigned)LDH + col) * 2u, pack8(a0, a1));
        EPI_ROWS_END
    }
};
struct MoeOrder {
    const bf16* A; const bf16* Bt; int lda, ldb, nM, nN, G, c, rep; const int* slot_tok; int s1, s2, s3, s4, s5, s6, s7;
    __device__ __forceinline__ int expert_of(int rt) const { const int r = rt * 256; return (r >= s1) + (r >= s2) + (r >= s3) + (r >= s4) + (r >= s5) + (r >= s6) + (r >= s7); }
    __device__ __forceinline__ bool next(int i, pg8::Unit& u) const { int pm, pn; if (!pg8::tile_order_rep(i, G, c, nM, nN, rep, pm, pn)) return false; u.pm = pm; u.pn = expert_of(pm) * nN + pn; return true; }
    __device__ __forceinline__ const char* a_base(const pg8::Unit& u) const { return slot_tok ? (const char*)A : (const char*)A + (size_t)u.pm * 256 * lda * 2; }
    __device__ __forceinline__ const char* b_base(const pg8::Unit& u) const { return (const char*)Bt + (size_t)u.pn * 256 * ldb * 2; }
    __device__ __forceinline__ int tok(const pg8::Unit& u, int r) const { return slot_tok[u.pm * 256 + r]; }
    __device__ __forceinline__ int ktiles(const pg8::Unit&, int nt) const { return nt; }
};

template <int NN>
struct MoeIdxOrder {
    const bf16* A; const bf16* Bt; int lda, ldb, first, stride, end; const int* slot_tok; int s1, s2, s3, s4, s5, s6, s7;
    __device__ __forceinline__ int expert_of(int rt) const { const int r = rt * 256; return (r >= s1) + (r >= s2) + (r >= s3) + (r >= s4) + (r >= s5) + (r >= s6) + (r >= s7); }
    __device__ __forceinline__ bool next(int i, pg8::Unit& u) const { const int idx = first + i * stride; if (idx >= end) return false; const int pm = idx / NN; u.pm = pm; u.pn = expert_of(pm) * NN + (idx - pm * NN); return true; }
    __device__ __forceinline__ const char* a_base(const pg8::Unit& u) const { return slot_tok ? (const char*)A : (const char*)A + (size_t)u.pm * 256 * lda * 2; }
    __device__ __forceinline__ const char* b_base(const pg8::Unit& u) const { return (const char*)Bt + (size_t)u.pn * 256 * ldb * 2; }
    __device__ __forceinline__ int tok(const pg8::Unit& u, int r) const { return slot_tok[u.pm * 256 + r]; }
    __device__ __forceinline__ int ktiles(const pg8::Unit&, int nt) const { return nt; }
};

namespace att {
__device__ __forceinline__ int crow(int r, int hi) { return (r & 3) + 8 * (r >> 2) + 4 * hi; }
__device__ __forceinline__ s16x4 vtr(const LAS unsigned char* p) { typedef short v4i16_t __attribute__((ext_vector_type(4))); return __builtin_bit_cast(s16x4, __builtin_amdgcn_ds_read_tr16_b64_v4i16((LAS v4i16_t*)p)); }
#define ATT_WAITBAR() asm volatile("s_waitcnt vmcnt(0) lgkmcnt(0)\n\ts_barrier" ::: "memory")
__device__ __forceinline__ void glds16(const void* gsrc, unsigned lds_dst) { unsigned keep;
    asm volatile("s_mov_b32 %0, m0\n\ts_mov_b32 m0, %2\n\ts_nop 0\n\tglobal_load_lds_dwordx4 %1, off\n\ts_mov_b32 m0, %0" : "=&s"(keep) : "v"(gsrc), "s"(lds_dst) : "memory"); }

#define MX3(a, b, c) __builtin_fmaxf(__builtin_fmaxf((a), (b)), (c))
template <int DQK> struct AttLds { static constexpr int NCH = DQK / 8, KSLOT = NCH * 1024, ND0 = DQK / 16, LK = 0, LV = 3 * KSLOT, LOST = LV + 3 * 8192, LCUM = LOST + NWAVES * 4608, END = LCUM + SEQ * 4; };

template <int DQK>
__device__ __forceinline__ void att_qk(f32x16& n0, f32x16& n1, const bf16x8 (&qr)[DQK / 16], const LAS unsigned char* kp) {
    constexpr int ND0 = DQK / 16;
    bf16x8 kf[2 * ND0];
#pragma unroll
    for (int d0 = 0; d0 < ND0; ++d0) { kf[2 * d0] = *(const LAS bf16x8*)(kp + d0 * 2048); kf[2 * d0 + 1] = *(const LAS bf16x8*)(kp + d0 * 2048 + 512); }
    n0 = (f32x16){}; n1 = (f32x16){};
#pragma unroll
    for (int d0 = 0; d0 < ND0; ++d0) {
        n0 = __builtin_amdgcn_mfma_f32_32x32x16_bf16(kf[2 * d0], qr[d0], n0, 0, 0, 0);
        n1 = __builtin_amdgcn_mfma_f32_32x32x16_bf16(kf[2 * d0 + 1], qr[d0], n1, 0, 0, 0);
    }
}
template <bool BIAS, bool MASK>
__device__ __forceinline__ void att_bias_mask(f32x16& n0, f32x16& n1, int t, int NT, int qrel, int hi, float fqb, const LAS float* cumL) {
    if constexpr (BIAS) {
#pragma unroll
        for (int g = 0; g < 4; ++g) {
            const f32x4 f0 = *(const LAS f32x4*)(cumL + t * 64 + 8 * g + 4 * hi), f1 = *(const LAS f32x4*)(cumL + t * 64 + 32 + 8 * g + 4 * hi);
#pragma unroll
            for (int j = 0; j < 4; ++j) { n0[4 * g + j] += fqb - f0[j]; n1[4 * g + j] += fqb - f1[j]; }
        }
    }
    if constexpr (MASK) {
        const int kb = 64 * (t - (NT - 4)) + 4 * hi;
#pragma unroll
        for (int r = 0; r < 16; ++r) { const int kv = kb + (r & 3) + 8 * (r >> 2); if (kv > qrel) n0[r] = -INFINITY; if (kv + 32 > qrel) n1[r] = -INFINITY; }
    }
}
template <int DQK, bool BIAS, bool MASK, bool MORE>
__device__ __forceinline__ void att_step(f32x16& s0, f32x16& s1, f32x16& n0, f32x16& n1, f32x16& o0, f32x16& o1, float& mrow, float& lrow, const bf16x8 (&qr)[DQK / 16],
                                         int t, int NT, int qrel, int lane, int hi, int r32, float fqb, const LAS unsigned char* shm, int vslot, int kslot) {
    typedef AttLds<DQK> L;
    constexpr int ND0 = DQK / 16;
    const LAS unsigned char* vp = shm + L::LV + vslot * 8192 + ((lane >> 4) & 1) * 32 + (lane & 3) * 8 + (4 * hi + ((lane & 15) >> 2)) * 64;
    const LAS unsigned char* kp = shm + L::LK + kslot * L::KSLOT + hi * 1024 + r32 * 16;
    bf16x8 kf[2 * ND0];
    if constexpr (MORE) {
#pragma unroll
        for (int d0 = 0; d0 < ND0; ++d0) { kf[2 * d0] = *(const LAS bf16x8*)(kp + d0 * 2048); kf[2 * d0 + 1] = *(const LAS bf16x8*)(kp + d0 * 2048 + 512); }
    }
    float a = MX3(s0[0], s0[1], s1[0]), b = MX3(s0[2], s0[3], s1[1]); a = MX3(a, s1[2], s1[3]);
#pragma unroll
    for (int r = 4; r < 16; r += 4) { a = MX3(a, s0[r], s0[r + 1]); b = MX3(b, s0[r + 2], s0[r + 3]); a = MX3(a, s1[r], s1[r + 1]); b = MX3(b, s1[r + 2], s1[r + 3]); }
    float rm = __builtin_fmaxf(a, b);
    { auto rr = __builtin_amdgcn_permlane32_swap(__float_as_uint(rm), __float_as_uint(rm), false, false); rm = __builtin_fmaxf(__uint_as_float(rr[0]), __uint_as_float(rr[1])); }
    if (__builtin_amdgcn_ballot_w64(rm > mrow + 8.0f) != 0ull) {
        const float mnew = __builtin_fmaxf(mrow, rm), alpha = fexp2(mrow - mnew);
        mrow = mnew; lrow *= alpha;
#pragma unroll
        for (int r = 0; r < 16; ++r) { o0[r] *= alpha; o1[r] *= alpha; }
    }
    if constexpr (MORE) {
        n0 = (f32x16){}; n1 = (f32x16){};
#pragma unroll
        for (int d0 = 0; d0 < ND0; ++d0) {
            n0 = __builtin_amdgcn_mfma_f32_32x32x16_bf16(kf[2 * d0], qr[d0], n0, 0, 0, 0);
            n1 = __builtin_amdgcn_mfma_f32_32x32x16_bf16(kf[2 * d0 + 1], qr[d0], n1, 0, 0, 0);
        }
    }
    float ps = 0.f;
#pragma unroll
    for (int r = 0; r < 16; ++r) { s0[r] = fexp2(s0[r] - mrow); s1[r] = fexp2(s1[r] - mrow); ps += s0[r] + s1[r]; }
    lrow += ps;
    __builtin_amdgcn_sched_barrier(0);
    s16x4 vl[8], vh[8];
#pragma unroll
    for (int i = 0; i < 8; ++i) { vl[i] = vtr(vp + (i >> 2) * 4096 + (i & 3) * 1024); vh[i] = vtr(vp + (i >> 2) * 4096 + (i & 3) * 1024 + 512); }
    u32x4 pw[4];
    pw[0] = (u32x4){pk2(s0[0], s0[1]), pk2(s0[2], s0[3]), pk2(s0[4], s0[5]), pk2(s0[6], s0[7])};
    pw[1] = (u32x4){pk2(s0[8], s0[9]), pk2(s0[10], s0[11]), pk2(s0[12], s0[13]), pk2(s0[14], s0[15])};
    pw[2] = (u32x4){pk2(s1[0], s1[1]), pk2(s1[2], s1[3]), pk2(s1[4], s1[5]), pk2(s1[6], s1[7])};
    pw[3] = (u32x4){pk2(s1[8], s1[9]), pk2(s1[10], s1[11]), pk2(s1[12], s1[13]), pk2(s1[14], s1[15])};
#pragma unroll
    for (int ks = 0; ks < 4; ++ks) {
        const bf16x8 v0 = (bf16x8){vl[ks][0], vl[ks][1], vl[ks][2], vl[ks][3], vh[ks][0], vh[ks][1], vh[ks][2], vh[ks][3]};
        const bf16x8 v1 = (bf16x8){vl[4 + ks][0], vl[4 + ks][1], vl[4 + ks][2], vl[4 + ks][3], vh[4 + ks][0], vh[4 + ks][1], vh[4 + ks][2], vh[4 + ks][3]};
        o0 = __builtin_amdgcn_mfma_f32_32x32x16_bf16(v0, __builtin_bit_cast(bf16x8, pw[ks]), o0, 0, 0, 0);
        o1 = __builtin_amdgcn_mfma_f32_32x32x16_bf16(v1, __builtin_bit_cast(bf16x8, pw[ks]), o1, 0, 0, 0);
    }
    if constexpr (MORE) att_bias_mask<BIAS, MASK>(n0, n1, t + 1, NT, qrel, hi, fqb, (const LAS float*)(shm + L::LCUM));
}

template <int DQK, bool BIAS>
__device__ __forceinline__ void attn_unit(int b, int h, int qb, const bf16* Q, int pq, const bf16* K, int pk, const bf16* V, int pv,
                                          bf16* O, int po, int ocol, const float* cum, LAS unsigned char* shm, const int tid_in, float* ssqp, int hidx, const unsigned* qkmax) {
    int tid = tid_in; asm volatile("" : "+v"(tid));
    typedef AttLds<DQK> L;
    constexpr int NCH = L::NCH, KSLOT = L::KSLOT, ND0 = L::ND0, LK = L::LK, LV = L::LV, LOST = L::LOST;
    static_assert(L::END <= RING_BYTES, "attention LDS");
    const int lane = tid & 63, r32 = lane & 31, hi = lane >> 5; const int wid = __builtin_amdgcn_readfirstlane(tid >> 6);
    const long rowbase = (long)b * SEQ; const int q0 = qb * 256;
    const bf16* Qw = Q + (rowbase + q0 + wid * 32) * pq + h * DQK;
    const bf16* Kh = K + rowbase * pk + h * DQK; const bf16* Vh = V + rowbase * pv + h * 64;
    const int NT = (q0 + 256) / 64;
    LAS float* cumL = (LAS float*)(shm + L::LCUM);
    if constexpr (BIAS) { const float* cs = cum + (size_t)(b * 4 + h) * SEQ; for (int i = tid * 4; i < q0 + 256; i += NTHR * 4) *(LAS f32x4*)(cumL + i) = *(const f32x4*)(cs + i); }
    const bf16* ksrc = Kh + (long)lane * pk + wid * 8;
    const bf16* vsrc = Vh + (long)(16 * (wid & 3) + (lane >> 2)) * pv + (wid >> 2) * 32 + (lane & 3) * 8;
    const unsigned lds0 = (unsigned)(size_t)shm;
#define ATT_DMA_K(t, slot) do { \
        glds16(ksrc + (long)(t) * 64 * pk, (unsigned)__builtin_amdgcn_readfirstlane((int)(lds0 + LK + (slot) * KSLOT + wid * 1024))); \
        if (NCH > 8 && wid + 8 < NCH) glds16(ksrc + (long)(t) * 64 * pk + 64, (unsigned)__builtin_amdgcn_readfirstlane((int)(lds0 + LK + (slot) * KSLOT + (wid + 8) * 1024))); } while (0)
#define ATT_DMA_V(t, slot) glds16(vsrc + (long)(t) * 64 * pv, (unsigned)__builtin_amdgcn_readfirstlane((int)(lds0 + LV + (slot) * 8192 + wid * 1024)))
    const int nK = (NCH > 8 && wid + 8 < NCH) ? 2 : 1;
#define ATT_WAITBAR_N(n) do { const int n_ = (n); if (n_ == 0) asm volatile("s_waitcnt vmcnt(0) lgkmcnt(0)\n\ts_barrier" ::: "memory"); else if (n_ == 1) asm volatile("s_waitcnt vmcnt(1) lgkmcnt(0)\n\ts_barrier" ::: "memory"); \
        else if (n_ == 2) asm volatile("s_waitcnt vmcnt(2) lgkmcnt(0)\n\ts_barrier" ::: "memory"); else asm volatile("s_waitcnt vmcnt(3) lgkmcnt(0)\n\ts_barrier" ::: "memory"); } while (0)
    int tb = 0;
    if constexpr (BIAS) {
        const float qk = sqrtf(__uint_as_float(qkmax[0]) * __uint_as_float(qkmax[1])) * 1.01f + 1.0f, thr = -(150.0f + 2.0f * qk);
        const float* cs = cum + (size_t)(b * 4 + h) * SEQ; const float f0 = cs[q0]; const float fj = lane < NT ? cs[64 * lane + 63] : f0;
        const unsigned long long keep = __builtin_amdgcn_ballot_w64(lane < NT && (f0 - fj) >= thr);
        tb = keep ? (int)__builtin_ctzll(keep) : NT - 4; if (tb > NT - 4) tb = NT - 4;
        tb = __builtin_amdgcn_readfirstlane(tb);
    }
    ATT_DMA_K(tb, 0); ATT_DMA_V(tb, 0); ATT_DMA_K(tb + 1, 1);
    bf16x8 qr[ND0];
#pragma unroll
    for (int d0 = 0; d0 < ND0; ++d0) qr[d0] = *(const bf16x8*)(Qw + (long)r32 * pq + d0 * 16 + hi * 8);
    float mrow = -1e30f, lrow = 0.f; f32x16 o0 = {}, o1 = {};
    const int qrel = wid * 32 + r32;
    ATT_WAITBAR();
#pragma unroll
    for (int d0 = 0; d0 < ND0; ++d0) asm volatile("" : "+v"(qr[d0]));
    ATT_DMA_K(tb + 2, 2); ATT_DMA_V(tb + 1, 1);
    float fqb = 0.f; if constexpr (BIAS) fqb = cumL[q0 + qrel];
    f32x16 s0, s1;
    att_qk<DQK>(s0, s1, qr, shm + LK + hi * 1024 + r32 * 16);
    asm volatile("s_waitcnt lgkmcnt(0)\n\ts_barrier" ::: "memory");
    if (tb == NT - 4) att_bias_mask<BIAS, true>(s0, s1, tb, NT, qrel, hi, fqb, cumL); else att_bias_mask<BIAS, false>(s0, s1, tb, NT, qrel, hi, fqb, cumL);
    int t = tb, sl0 = 0, sl1 = 1, sl2 = 2;
#define ATT_ROT() do { const int x_ = sl0; sl0 = sl1; sl1 = sl2; sl2 = x_; } while (0)
    f32x16 u0, u1;
    for (; t + 1 < NT - 5; t += 2) {
        ATT_DMA_K(t + 3, sl0); ATT_DMA_V(t + 2, sl2);
        att_step<DQK, BIAS, false, true>(s0, s1, u0, u1, o0, o1, mrow, lrow, qr, t, NT, qrel, lane, hi, r32, fqb, shm, sl0, sl1);
        ATT_WAITBAR_N(nK + 1); ATT_ROT();
        ATT_DMA_K(t + 4, sl0); ATT_DMA_V(t + 3, sl2);
        att_step<DQK, BIAS, false, true>(u0, u1, s0, s1, o0, o1, mrow, lrow, qr, t + 1, NT, qrel, lane, hi, r32, fqb, shm, sl0, sl1);
        ATT_WAITBAR_N(nK + 1); ATT_ROT();
    }
    for (; t < NT - 5; ++t) {
        ATT_DMA_K(t + 3, sl0); ATT_DMA_V(t + 2, sl2);
        att_step<DQK, BIAS, false, true>(s0, s1, u0, u1, o0, o1, mrow, lrow, qr, t, NT, qrel, lane, hi, r32, fqb, shm, sl0, sl1);
        s0 = u0; s1 = u1;
        ATT_WAITBAR_N(nK + 1); ATT_ROT();
    }
    for (; t < NT - 1; ++t) {
        int nis = 0;
        if (t + 3 < NT) { ATT_DMA_K(t + 3, sl0); nis += nK; }
        if (t + 2 < NT) { ATT_DMA_V(t + 2, sl2); nis += 1; }
        const int jbc = t - (NT - 4); const bool docur = !(jbc >= 0 && 2 * jbc > wid), donext = !(2 * (jbc + 1) > wid);
        if (docur && donext) { att_step<DQK, BIAS, true, true>(s0, s1, u0, u1, o0, o1, mrow, lrow, qr, t, NT, qrel, lane, hi, r32, fqb, shm, sl0, sl1); s0 = u0; s1 = u1; }
        else if (docur) att_step<DQK, BIAS, false, false>(s0, s1, u0, u1, o0, o1, mrow, lrow, qr, t, NT, qrel, lane, hi, r32, fqb, shm, sl0, sl1);
        ATT_WAITBAR_N(nis); ATT_ROT();
    }
    if (!(2 * 3 > wid)) att_step<DQK, BIAS, false, false>(s0, s1, u0, u1, o0, o1, mrow, lrow, qr, t, NT, qrel, lane, hi, r32, fqb, shm, sl0, sl1);
#undef ATT_ROT
#undef ATT_WAITBAR_N
    { auto rr = __builtin_amdgcn_permlane32_swap(__float_as_uint(lrow), __float_as_uint(lrow), false, false); lrow = __uint_as_float(rr[0]) + __uint_as_float(rr[1]); }
    const float rl = frcp(lrow);
    { float ssq = 0.f;
#pragma unroll
      for (int r = 0; r < 16; ++r) { const float a = o0[r] * rl, b2 = o1[r] * rl; ssq += a * a + b2 * b2; }
      auto rr = __builtin_amdgcn_permlane32_swap(__float_as_uint(ssq), __float_as_uint(ssq), false, false); ssq = __uint_as_float(rr[0]) + __uint_as_float(rr[1]);
      if (hi == 0) ssqp[(size_t)(rowbase + q0 + wid * 32 + r32) * 12 + hidx] = ssq; }
    LAS unsigned char* stg = shm + LOST + wid * 4608;
#pragma unroll
    for (int g = 0; g < 4; ++g) {
        *(LAS u32x2*)(stg + r32 * 144 + (8 * g + 4 * hi) * 2) = (u32x2){pk2(o0[4 * g] * rl, o0[4 * g + 1] * rl), pk2(o0[4 * g + 2] * rl, o0[4 * g + 3] * rl)};
        *(LAS u32x2*)(stg + r32 * 144 + (32 + 8 * g + 4 * hi) * 2) = (u32x2){pk2(o1[4 * g] * rl, o1[4 * g + 1] * rl), pk2(o1[4 * g + 2] * rl, o1[4 * g + 3] * rl)};
    }
    asm volatile("s_waitcnt lgkmcnt(0)" ::: "memory");
    bf16* Ow = O + (rowbase + q0 + wid * 32) * po + ocol;
#pragma unroll
    for (int i = 0; i < 4; ++i) { const int row = i * 8 + (lane >> 3), ch = lane & 7; const u32x4 v = *(const LAS u32x4*)(stg + row * 144 + ch * 16); *(u32x4*)(Ow + (long)row * po + ch * 8) = v; }
    asm volatile("s_waitcnt lgkmcnt(0)\n\ts_barrier" ::: "memory");
#undef ATT_DMA_K
#undef ATT_DMA_V
}
}

struct Args { const float* in[26]; float* out; unsigned char* ws; int ph_lo, ph_hi; };
typedef const __attribute__((address_space(4))) Args* kargs_t;
struct Ctx {
    LAS unsigned char* lds; unsigned* ctl; unsigned char* ws; float* out;
    int tid, lane, wave, vcu, G, gw, NGW, bx;
};
__device__ __forceinline__ kargs_t opaque_args() { kargs_t p = (kargs_t)__builtin_amdgcn_kernarg_segment_ptr(); asm volatile("" : "+s"(p)); return p; }
__device__ __forceinline__ Ctx make_ctx(kargs_t A, LAS unsigned char* lds, int wave0) {
    Ctx C; unsigned ones = ~0u; asm volatile("" : "+s"(ones));
    int t = wave0 * 64 + (int)__builtin_amdgcn_mbcnt_hi(ones, __builtin_amdgcn_mbcnt_lo(ones, 0u)); asm volatile("" : "+v"(t));
    C.lds = lds; C.ws = A->ws; C.ctl = (unsigned*)(C.ws + WS_CTL); C.out = A->out;
    C.tid = t; C.lane = t & 63; C.wave = __builtin_amdgcn_readfirstlane(t >> 6);
    { int g_ = gridDim.x, b_ = blockIdx.x; asm volatile("" : "+s"(g_), "+s"(b_)); C.G = g_; C.bx = b_; } C.vcu = (C.bx % 8) * (C.G / 8) + C.bx / 8;
    C.gw = C.vcu * NWAVES + C.wave; C.NGW = C.G * NWAVES;
    return C;
}
#define LDS_WAIT() asm volatile("s_waitcnt lgkmcnt(0)" ::: "memory")

struct MapWin { __device__ __forceinline__ int row(int n) const {
        if (n < 256) return PC_CQ + n; if (n < 384) return PC_CKV + (n - 256); if (n < 416) return PC_KR + (n - 384); if (n < 672) return PC_FQ + (n - 416);
        if (n < 928) return PC_FK + (n - 672); if (n < 1184) return PC_FV + (n - 928); if (n < 1188) return PC_FL + (n - 1184); return PC_CI + (n - 1188); }
    __device__ __forceinline__ float scale(int, int n) const { return (n >= 416 && n < 672) ? C2_FOX : 1.0f; } };
struct MapUq { const float* g; __device__ __forceinline__ int row(int n) const { const int h = n / 96, d = n - h * 96; if (d < 64) return n; const int i = d - 64;
        const int s = (i < 16) ? (4 * (i >> 1) + (i & 1)) : (4 * ((i - 16) >> 1) + 2 + (i & 1)); return h * 96 + 64 + s; }
    __device__ __forceinline__ float scale(int k, int) const { return g[k] * C2_MLA; } };
struct MapUkv { const float* g; __device__ __forceinline__ int row(int n) const { const int h = n >> 7, d = n & 127; return d < 64 ? (768 + h * 64 + d) : (1280 + h * 64 + (d - 64)); }
    __device__ __forceinline__ float scale(int k, int) const { return g[k]; } };
struct MapWout { const float* gm; const float* gf; __device__ __forceinline__ int row(int n) const { return n; }
    __device__ __forceinline__ float scale(int k, int) const { return k < 512 ? gm[k] : (k < 768 ? gf[k - 512] : 1.0f); } };
struct MapW13 { int which; __device__ __forceinline__ int row(int n) const { return (n >> 7) * 256 + which * 128 + (n & 127); }
    __device__ __forceinline__ float scale(int, int) const { return 1.0f; } };
struct MapId { __device__ __forceinline__ int row(int n) const { return n; } __device__ __forceinline__ float scale(int, int) const { return 1.0f; } };

template <class Map>
__device__ __forceinline__ void transpose_item(const float* W, int Nsrc, bf16* WT, int ldk, LAS float* scr, int kb, int nb, int lane, const Map mp) {
    const int k0 = 64 * kb, n0 = 32 * nb, r8 = lane >> 3, nn = n0 + 4 * (lane & 7); const bool nok = nn < Nsrc;
    f32x4 v[8];
#pragma unroll
    for (int i = 0; i < 8; ++i) { v[i] = (f32x4){0.f, 0.f, 0.f, 0.f}; if (nok) v[i] = *(const f32x4*)(W + (size_t)(k0 + 8 * i + r8) * Nsrc + nn); }
#pragma unroll
    for (int i = 0; i < 8; ++i) { const int kk = 8 * i + r8; LAS float* d = scr + kk * 33 + 4 * (lane & 7);
#pragma unroll
        for (int j = 0; j < 4; ++j) d[j] = v[i][j] * mp.scale(k0 + kk, nn + j); }
    LDS_WAIT(); asm volatile("" ::: "memory");
    const int c = lane & 7;
#pragma unroll
    for (int j = 0; j < 4; ++j) { const int n = (lane >> 3) + 8 * j; const LAS float* s = scr + (8 * c) * 33 + n;
        if (n0 + n < Nsrc) { u32x4 o; o.x = pk2(s[0 * 33], s[1 * 33]); o.y = pk2(s[2 * 33], s[3 * 33]); o.z = pk2(s[4 * 33], s[5 * 33]); o.w = pk2(s[6 * 33], s[7 * 33]);
            *(u32x4*)(WT + (size_t)mp.row(n0 + n) * ldk + k0 + 8 * c) = o; } }
    LDS_WAIT(); asm volatile("" ::: "memory");
}

__device__ __forceinline__ void sincos_acc(float ang, float& c, float& s) {
    const double a = (double)ang, q = __builtin_rint(a * 0.63661977236758134308);
    const double y = (a - q * 1.57079632679489655800) - q * 6.12323399573676603587e-17, y2 = y * y;
    const double sp = y * (1.0 + y2 * (-1.0 / 6 + y2 * (1.0 / 120 + y2 * (-1.0 / 5040 + y2 * (1.0 / 362880 + y2 * (-1.0 / 39916800 + y2 * (1.0 / 6227020800.0)))))));
    const double cp = 1.0 + y2 * (-0.5 + y2 * (1.0 / 24 + y2 * (-1.0 / 720 + y2 * (1.0 / 40320 + y2 * (-1.0 / 3628800 + y2 * (1.0 / 479001600 + y2 * (-1.0 / 87178291200.0)))))));
    const int quad = (int)((long long)q & 3);
    const double ss = (quad == 0) ? sp : (quad == 1) ? cp : (quad == 2) ? -sp : -cp;
    const double cc = (quad == 0) ? cp : (quad == 1) ? -sp : (quad == 2) ? -cp : sp;
    c = (float)cc; s = (float)ss;
}
__device__ __forceinline__ float inv_freq(int f) {
    const int a = f >> 2, b = f & 3;
    const float p = (a == 0) ? 1.0f : (a == 1) ? 0.1f : (a == 2) ? 0.01f : 0.001f;
    const float m = (b == 0) ? 1.0f : (b == 1) ? 0.56234132519034908f : (b == 2) ? 0.31622776601683794f : 0.17782794100389228f;
    return (b == 0) ? p : (float)((double)p * (double)m);
}

__device__ __forceinline__ void p0_prologue(Ctx& C, kargs_t A) {
    LAS float* scr = (LAS float*)(C.lds + C.wave * 16384);
    bf16* WIN = (bf16*)(C.ws + WS_WIN); bf16* WQ2 = (bf16*)(C.ws + WS_WQ2); bf16* WOUT = (bf16*)(C.ws + WS_WOUT);
    constexpr int I_IN = 16 * 54, I_UQ = 4 * 24, I_UKV = 2 * 32, I_OUT = 16 * 32, I_L = I_IN + I_UQ + I_UKV + I_OUT;
    REPS(12) for (int it = C.gw; it < DEPTH * I_L; it += C.NGW) {
        const int l = it / I_L; int r = it - l * I_L;
        if (r < I_IN) { transpose_item(A->in[2] + (size_t)l * DM * IN_COLS, IN_COLS, WIN + (size_t)l * NP1 * DM, DM, scr, r / 54, r % 54, C.lane, MapWin{}); continue; } r -= I_IN;
        if (r < I_UQ) { transpose_item(A->in[4] + (size_t)l * 256 * 768, 768, WQ2 + (size_t)l * NP1 * 256, 256, scr, r / 24, r % 24, C.lane, MapUq{A->in[3] + l * 256}); continue; } r -= I_UQ;
        if (r < I_UKV) { transpose_item(A->in[6] + (size_t)l * 128 * 1024, 1024, WQ2 + (size_t)l * NP1 * 256, 256, scr, r / 32, r % 32, C.lane, MapUkv{A->in[5] + l * 128}); continue; } r -= I_UKV;
        transpose_item(A->in[14] + (size_t)l * DM * DM, DM, WOUT + (size_t)l * DM * DM, DM, scr, r / 32, r % 32, C.lane, MapWout{A->in[12] + l * 512, A->in[13] + l * 256});
    }
    const int gt = C.vcu * NTHR + C.tid, NGT = C.G * NTHR;
    for (int i = gt; i < DEPTH * 92 * 128; i += NGT) { const int l = i / (92 * 128), r = i % (92 * 128); *(u32x4*)(WIN + (size_t)l * NP1 * DM + (size_t)(420 + r / 128) * DM + (r % 128) * 8) = (u32x4){0u, 0u, 0u, 0u}; }
    REPS(4) {
    bf16* XB = (bf16*)(C.ws + WS_XB); const float* x = A->in[0];
    for (int m = C.gw; m < M; m += C.NGW) { const f32x4* xr = (const f32x4*)(x + (size_t)m * DM) + C.lane; u32x2* o = (u32x2*)(XB + (size_t)m * DM) + C.lane;
#pragma unroll
        for (int j = 0; j < 4; ++j) { const f32x4 v = xr[64 * j]; o[64 * j] = (u32x2){pk2(v[0], v[1]), pk2(v[2], v[3])}; } }
    float* COS = (float*)(C.ws + WS_TAB); float* SIN = COS + (size_t)M * 16; const int* pos = (const int*)A->in[1];
    for (int i = gt; i < M * 16; i += NGT) { const float ang = (float)pos[i >> 4] * inv_freq(i & 15); float c, s; sincos_acc(ang, c, s); COS[i] = c; SIN[i] = s; }
    }
}

__device__ __forceinline__ int ffn_split(int layer) { return (layer & 1) ? 7744 : 4224; }
__device__ __forceinline__ void ffn_weights(Ctx& C, kargs_t A, int layer, int first, int stride, int lo, int hi) {
    LAS float* scr = (LAS float*)(C.lds + C.wave * 16384);
    bf16* W13 = (bf16*)(C.ws + WS_WFFN); bf16* W2T = W13 + WF_W13_ELEMS; const int j = layer >> 1;
    if ((layer & 1) == 0) {
        constexpr int I1 = 16 * 88, I2 = 44 * 32;
        const float* w1 = A->in[17] + (size_t)j * DM * DFF; const float* w3 = A->in[18] + (size_t)j * DM * DFF; const float* w2 = A->in[19] + (size_t)j * DFF * DM;
        const int end = hi < 2 * I1 + I2 ? hi : 2 * I1 + I2;
        for (int it = lo + first; it < end; it += stride) {
            int r = it;
            if (r < I1) { transpose_item(w1, DFF, W13, DM, scr, r / 88, r % 88, C.lane, MapW13{0}); continue; } r -= I1;
            if (r < I1) { transpose_item(w3, DFF, W13, DM, scr, r / 88, r % 88, C.lane, MapW13{1}); continue; } r -= I1;
            transpose_item(w2, DM, W2T, DFF, scr, r / 32, r % 32, C.lane, MapId{});
        }
    } else {
        constexpr int I1 = 16 * 44, I2 = 22 * 32, IE = 2 * I1 + I2;
        const int end = hi < NEXP * IE ? hi : NEXP * IE;
        for (int it = lo + first; it < end; it += stride) {
            const int e = it / IE; int r = it - e * IE;
            const float* w1 = A->in[21] + ((size_t)j * NEXP + e) * DM * DFE; const float* w3 = A->in[22] + ((size_t)j * NEXP + e) * DM * DFE; const float* w2 = A->in[23] + ((size_t)j * NEXP + e) * DFE * DM;
            bf16* W13e = W13 + (size_t)e * 2 * DFE * DM; bf16* W2Te = W2T + (size_t)e * DM * DFE;
            if (r < I1) { transpose_item(w1, DFE, W13e, DM, scr, r / 44, r % 44, C.lane, MapW13{0}); continue; } r -= I1;
            if (r < I1) { transpose_item(w3, DFE, W13e, DM, scr, r / 44, r % 44, C.lane, MapW13{1}); continue; } r -= I1;
            transpose_item(w2, DM, W2Te, DFE, scr, r / 32, r % 32, C.lane, MapId{});
        }
    }
}

__device__ __forceinline__ void p2_thin(Ctx& C, kargs_t A, int layer) {
    unsigned char* sc = C.ws + WS_SCR;
    bf16* CQ = (bf16*)(sc + SC_CQKV); bf16* CKV = CQ + (size_t)M * 256; const float* KR = (const float*)(sc + SC_KR); const float* FL = (const float*)(sc + SC_FL);
    float* CUM = (float*)(sc + SC_CUM); const bf16* CI = (const bf16*)(sc + SC_CI); const bf16* FQn = (const bf16*)(sc + SC_FQ); bf16* KM = (bf16*)(sc + SC_KM); bf16* MIXED = (bf16*)(sc + SC_MIXED);
    const float* COS = (const float*)(C.ws + WS_TAB); const float* SIN = COS + (size_t)M * 16;
    LAS unsigned* NT2 = (LAS unsigned*)(C.lds + RING_BYTES + 4096);
    if (C.tid < 64) NT2[C.tid] = 0u;
    LAS unsigned* RQ = (LAS unsigned*)(C.lds + RING_BYTES + 8192 + 64);
    if (C.tid == 0) RQ[0] = 0u;
    __syncthreads();
    {
    if (C.wave == 0 && C.vcu < BATCH * 4) {
        const int sq = C.vcu, b = sq >> 2, h = sq & 3; const float bias = A->in[7][layer * 4 + h];
        float v[64]; float run = 0.f;
#pragma unroll
        for (int i = 0; i < 64; ++i) { const float z = FL[((size_t)b * SEQ + C.lane * 64 + i) * 4 + h] + bias; const float e = fexp2(-fabsf(z) * LOG2E);
            const float ls = fminf(z, 0.f) - __builtin_amdgcn_logf(1.0f + e) * 0.6931471805599453f; run += ls * LOG2E; v[i] = run; }
        float incl = run;
#pragma unroll
        for (int o = 1; o < 64; o <<= 1) { const float t = __int_as_float(__builtin_amdgcn_ds_bpermute((C.lane - o) << 2, __float_as_int(incl))); if (C.lane >= o) incl += t; }
        const float excl = incl - run; float* dst = CUM + (size_t)sq * SEQ + C.lane * 64;
#pragma unroll
        for (int i = 0; i < 64; i += 4) *(f32x4*)(dst + i) = (f32x4){v[i] + excl, v[i + 1] + excl, v[i + 2] + excl, v[i + 3] + excl};
    }
    const int rpw = M / C.G;
    for (;;) {
        unsigned jb = 0u; if (C.lane == 0) jb = __hip_atomic_fetch_add(RQ, 1u, __ATOMIC_RELAXED, __HIP_MEMORY_SCOPE_WORKGROUP);
        jb = (unsigned)__builtin_amdgcn_readfirstlane((int)jb);
        if ((int)jb * 4 >= rpw) break;
        const size_t mb = (size_t)C.vcu * rpw + 4 * jb;
        u32x2 wq[4]; unsigned wk[4]; f32x2 x1[4], x2[4], cs[4], sn[4]; u32x2 fqv[4], fkv[4]; const int g4 = C.lane & 7, h = C.lane >> 3;
#pragma unroll
        for (int k = 0; k < 4; ++k) { const size_t m = mb + k;
            wq[k] = ((const u32x2*)(CQ + m * 256))[C.lane]; wk[k] = ((const unsigned*)(CKV + m * 256))[C.lane];
            x1[k] = *(const f32x2*)(KR + m * 32 + 2 * g4); x2[k] = *(const f32x2*)(KR + m * 32 + 16 + 2 * g4);
            cs[k] = *(const f32x2*)(COS + m * 16 + 2 * g4); sn[k] = *(const f32x2*)(SIN + m * 16 + 2 * g4);
            fqv[k] = ((const u32x2*)(FQn + m * 256))[C.lane]; fkv[k] = ((const u32x2*)(FQn + (size_t)M * 256 + m * 256))[C.lane]; }
#pragma unroll
        for (int k = 0; k < 4; ++k) { const size_t m = mb + k;
            { const float a0 = bflo(wq[k].x), a1 = bfhi(wq[k].x), a2 = bflo(wq[k].y), a3 = bfhi(wq[k].y);
              const float ss = wave_sum((a0 * a0 + a1 * a1) + (a2 * a2 + a3 * a3)); const float r = 1.0f / sqrtf(ss * (1.0f / 256) + EPS); ((u32x2*)(CQ + m * 256))[C.lane] = (u32x2){pk2(a0 * r, a1 * r), pk2(a2 * r, a3 * r)}; }
            { const float a0 = bflo(wk[k]), a1 = bfhi(wk[k]); unsigned* p = (unsigned*)(CKV + m * 256) + C.lane;
              const float ss = wave_sum(a0 * a0 + a1 * a1); const float r = 1.0f / sqrtf(ss * (1.0f / 128) + EPS); *p = pk2(a0 * r, a1 * r); }
            {
              float nq = 0.f, nk = 0.f; { const float a0 = bflo(fqv[k].x), a1 = bfhi(fqv[k].x), a2 = bflo(fqv[k].y), a3 = bfhi(fqv[k].y); nq = (a0 * a0 + a1 * a1) + (a2 * a2 + a3 * a3); }
              { const float a0 = bflo(fkv[k].x), a1 = bfhi(fkv[k].x), a2 = bflo(fkv[k].y), a3 = bfhi(fkv[k].y); nk = (a0 * a0 + a1 * a1) + (a2 * a2 + a3 * a3); }
              nq += lane_xor<1>(nq); nq += lane_xor<2>(nq); nq += lane_xor<4>(nq); nq += lane_xor<8>(nq); nk += lane_xor<1>(nk); nk += lane_xor<2>(nk); nk += lane_xor<4>(nk); nk += lane_xor<8>(nk);
              if ((C.lane & 15) == 0) { const int bi = (int)(m >> 12) * 8 + (C.lane >> 4) * 2; atomicMax((unsigned*)&NT2[bi], __float_as_uint(nq)); atomicMax((unsigned*)&NT2[bi + 1], __float_as_uint(nk)); } }
            *(u32x2*)(KM + m * 768 + h * 96 + 64 + 4 * g4) = (u32x2){pk2(x1[k].x * cs[k].x - x2[k].x * sn[k].x, x1[k].y * cs[k].y - x2[k].y * sn[k].y), pk2(x1[k].x * sn[k].x + x2[k].x * cs[k].x, x1[k].y * sn[k].y + x2[k].y * cs[k].y)}; }
    }
    }
    __syncthreads();
    if (C.tid < 64) atomicMax(C.ctl + CW_QKMAX + layer * 64 + C.tid, NT2[C.tid]);
    {
        LAS float* hL = (LAS float*)C.lds; LAS float* yL = hL + 62 * 256;
        const int cch = (C.wave & 3) * 64 + C.lane, tt0 = (C.wave >> 2) * 16;
        float wj[31];
#pragma unroll
        for (int j = 0; j < 31; ++j) wj[j] = A->in[8][((size_t)layer * 31 + j) * 256 + cch];
        const float cb = A->in[9][layer * 256 + cch];
        const int ntok = C.tid >> 4, ngrp = (C.tid >> 2) & 3, nqt = C.tid & 3, nc0 = ngrp * 64 + nqt * 16;
        u32x4 pa[4], pg[4];
#define CONV_LOAD(tl) do { const int t0_ = (tl) * 32, seq0_ = (t0_ / SEQ) * SEQ; _Pragma("unroll") for (int k = 0; k < 4; ++k) { const int it = C.tid + NTHR * k, r = it >> 5, ch = it & 31, tok = t0_ - 30 + r; \
            pa[k] = (u32x4){0u, 0u, 0u, 0u}; pg[k] = pa[k]; \
            if (it < 62 * 32 && tok >= seq0_) { pa[k] = *(const u32x4*)(CI + (size_t)tok * 512 + ch * 8); pg[k] = *(const u32x4*)(CI + (size_t)tok * 512 + 256 + ch * 8); } } } while (0)
        if (C.vcu < M / 32) CONV_LOAD(C.vcu);
        for (int tile = C.vcu; tile < M / 32; tile += C.G) {
            const int t0 = tile * 32;
#pragma unroll
            for (int k = 0; k < 4; ++k) { const int it = C.tid + NTHR * k, r = it >> 5, ch = it & 31;
                if (it < 62 * 32) { const u32x4 a = pa[k], g = pg[k];
                    const f32x4 o0 = (f32x4){bflo(a.x) * sigmoidf_(bflo(g.x)), bfhi(a.x) * sigmoidf_(bfhi(g.x)), bflo(a.y) * sigmoidf_(bflo(g.y)), bfhi(a.y) * sigmoidf_(bfhi(g.y))};
                    const f32x4 o1 = (f32x4){bflo(a.z) * sigmoidf_(bflo(g.z)), bfhi(a.z) * sigmoidf_(bfhi(g.z)), bflo(a.w) * sigmoidf_(bflo(g.w)), bfhi(a.w) * sigmoidf_(bfhi(g.w))};
                    *(LAS f32x4*)(hL + r * 256 + ch * 8) = o0; *(LAS f32x4*)(hL + r * 256 + ch * 8 + 4) = o1; } }
            __syncthreads();
            if (tile + C.G < M / 32) CONV_LOAD(tile + C.G);
#pragma unroll
            for (int chunk = 0; chunk < 2; ++chunk) { const int base = tt0 + chunk * 8; float hv[38];
#pragma unroll
                for (int i = 0; i < 38; ++i) hv[i] = hL[(base + i) * 256 + cch];
#pragma unroll
                for (int tt = 0; tt < 8; ++tt) { float acc = cb;
#pragma unroll
                    for (int j = 0; j < 31; ++j) acc += wj[j] * hv[tt + j];
                    yL[(base + tt) * 256 + cch] = acc; } }
            __syncthreads();
            { float v[16]; float s = 0.f;
#pragma unroll
              for (int i = 0; i < 16; i += 4) { const f32x4 t4 = *(const LAS f32x4*)(yL + ntok * 256 + nc0 + i); v[i] = t4[0]; v[i + 1] = t4[1]; v[i + 2] = t4[2]; v[i + 3] = t4[3]; s += (t4[0] + t4[1]) + (t4[2] + t4[3]); }
              s += lane_xor<1>(s); s += lane_xor<2>(s); const float mean = s * (1.0f / 64); float q = 0.f;
#pragma unroll
              for (int i = 0; i < 16; ++i) { v[i] -= mean; q += v[i] * v[i]; }
              q += lane_xor<1>(q); q += lane_xor<2>(q); const float rstd = 1.0f / sqrtf(q * (1.0f / 64) + EPS);
              const float* gg = A->in[10] + layer * 256 + nc0; const float* gb = A->in[11] + layer * 256 + nc0; float o[16];
#pragma unroll
              for (int i = 0; i < 16; ++i) o[i] = siluf_(v[i] * rstd * gg[i] + gb[i]);
              bf16* dst = MIXED + (size_t)(t0 + ntok) * 1024 + 768 + nc0;
              *(u32x4*)dst = (u32x4){pk2(o[0], o[1]), pk2(o[2], o[3]), pk2(o[4], o[5]), pk2(o[6], o[7])};
              *(u32x4*)(dst + 8) = (u32x4){pk2(o[8], o[9]), pk2(o[10], o[11]), pk2(o[12], o[13]), pk2(o[14], o[15])}; }
        }
        __syncthreads();
    }
    REPS(11) ffn_weights(C, A, layer, C.gw, C.NGW, ffn_split(layer), 1 << 30);
}

__device__ __forceinline__ void p5_rms(Ctx& C) {
    bf16* MIXED = (bf16*)(C.ws + WS_SCR + SC_MIXED);
    REPS(7) for (int mb = C.gw; mb < M; mb += 4 * C.NGW) {
        u32x4 wa[4]; u32x2 wb[4];
#pragma unroll
        for (int k = 0; k < 4; ++k) { const bf16* r = MIXED + ((size_t)mb + (size_t)k * C.NGW) * 1024; wa[k] = ((const u32x4*)r)[C.lane]; wb[k] = ((const u32x2*)(r + 512))[C.lane]; }
#pragma unroll
        for (int k = 0; k < 4; ++k) { bf16* r = MIXED + ((size_t)mb + (size_t)k * C.NGW) * 1024;
            { const u32x4 w = wa[k]; float a[8] = {bflo(w.x), bfhi(w.x), bflo(w.y), bfhi(w.y), bflo(w.z), bfhi(w.z), bflo(w.w), bfhi(w.w)}; float ss = 0.f;
#pragma unroll
              for (int i = 0; i < 8; ++i) ss += a[i] * a[i];
              ss = wave_sum(ss); const float rs = 1.0f / sqrtf(ss * (1.0f / 512) + EPS);
              ((u32x4*)r)[C.lane] = (u32x4){pk2(a[0] * rs, a[1] * rs), pk2(a[2] * rs, a[3] * rs), pk2(a[4] * rs, a[5] * rs), pk2(a[6] * rs, a[7] * rs)}; }
            { const u32x2 w = wb[k]; const float a0 = bflo(w.x), a1 = bfhi(w.x), a2 = bflo(w.y), a3 = bfhi(w.y);
              const float ss = wave_sum((a0 * a0 + a1 * a1) + (a2 * a2 + a3 * a3)); const float rs = 1.0f / sqrtf(ss * (1.0f / 256) + EPS); ((u32x2*)(r + 512))[C.lane] = (u32x2){pk2(a0 * rs, a1 * rs), pk2(a2 * rs, a3 * rs)}; }
        }
    }
}

template <int MODE>
__device__ __forceinline__ void ln_pass(Ctx& C, const bool final, const bf16* add, const float* gam, const float* bet, const float* router_w) {
    bf16* XB = (bf16*)(C.ws + WS_XB); float* out = C.out;
    REPS(14) {
    const bool dry = ((REP_MASK >> 14) & 1) && rep_ == 0; float* jf = (float*)(C.ws + WS_SCR); bf16* jb = (bf16*)(C.ws + WS_SCR + 40 * MiB);
    int* TOPE = (int*)(C.ws + WS_MOE + MT_TOPE); float* TOPG = (float*)(C.ws + WS_MOE + MT_TOPG); const int* TOKSLOT = (const int*)(C.ws + WS_MOE + MT_TOKSLOT);
    LAS float* RW = (LAS float*)C.lds; LAS unsigned* CNT = (LAS unsigned*)(C.lds + 32768);
    if constexpr (MODE == 1) {
        for (int i = C.tid; i < 1024 * 8 / 4; i += NTHR) *(LAS f32x4*)(RW + 4 * i) = *(const f32x4*)(router_w + 4 * i);
        if (C.tid < 8) CNT[C.tid] = 0u;
        __syncthreads();
    }
    f32x4 g4[4], b4[4];
#pragma unroll
    for (int j = 0; j < 4; ++j) { g4[j] = ((const f32x4*)gam)[64 * j + C.lane]; b4[j] = ((const f32x4*)bet)[64 * j + C.lane]; }
    const int RPB = M / C.G, row0 = C.bx * RPB;
    unsigned cnt0 = 0, cnt1 = 0, cnt2 = 0, cnt3 = 0, cnt4 = 0, cnt5 = 0, cnt6 = 0, cnt7 = 0;
    u32x2 nx[4], na[4], nb[4]; int sl0 = 0, sl1 = 0;
#define LN_LOAD(mm) do { _Pragma("unroll") for (int j = 0; j < 4; ++j) { nx[j] = ((const u32x2*)(XB + (size_t)(mm) * DM))[64 * j + C.lane]; \
        if constexpr (MODE == 2) { na[j] = ((const u32x2*)(add + (size_t)sl0 * DM))[64 * j + C.lane]; nb[j] = ((const u32x2*)(add + (size_t)sl1 * DM))[64 * j + C.lane]; } \
        else { na[j] = ((const u32x2*)(add + (size_t)(mm) * DM))[64 * j + C.lane]; nb[j] = (u32x2){0u, 0u}; } } } while (0)
    if constexpr (MODE == 2) { sl0 = TOKSLOT[2 * (row0 + C.wave)]; sl1 = TOKSLOT[2 * (row0 + C.wave) + 1]; }
    LN_LOAD(row0 + C.wave);
    if constexpr (MODE == 2) { if (C.wave + NWAVES < RPB) { sl0 = TOKSLOT[2 * (row0 + C.wave + NWAVES)]; sl1 = TOKSLOT[2 * (row0 + C.wave + NWAVES) + 1]; } }
    for (int rr = C.wave; rr < RPB; rr += NWAVES) {
        const int m = row0 + rr;
        f32x4 v[4];
#pragma unroll
        for (int j = 0; j < 4; ++j) { v[j] = (f32x4){bflo(nx[j].x), bfhi(nx[j].x), bflo(nx[j].y), bfhi(nx[j].y)} * ALPHA + (f32x4){bflo(na[j].x), bfhi(na[j].x), bflo(na[j].y), bfhi(na[j].y)};
            if constexpr (MODE == 2) v[j] += (f32x4){bflo(nb[j].x), bfhi(nb[j].x), bflo(nb[j].y), bfhi(nb[j].y)}; }
        if (rr + NWAVES < RPB) {
            LN_LOAD(m + NWAVES);
            if constexpr (MODE == 2) { if (rr + 2 * NWAVES < RPB) { sl0 = TOKSLOT[2 * (m + 2 * NWAVES)]; sl1 = TOKSLOT[2 * (m + 2 * NWAVES) + 1]; } }
        }
        float s = 0.f;
#pragma unroll
        for (int j = 0; j < 4; ++j) s += (v[j][0] + v[j][1]) + (v[j][2] + v[j][3]);
        const float mean = wave_sum(s) * (1.0f / DM); float q = 0.f;
#pragma unroll
        for (int j = 0; j < 4; ++j) { v[j] = v[j] - mean; q += (v[j][0] * v[j][0] + v[j][1] * v[j][1]) + (v[j][2] * v[j][2] + v[j][3] * v[j][3]); }
        const float rstd = 1.0f / sqrtf(wave_sum(q) * (1.0f / DM) + EPS);
#pragma unroll
        for (int j = 0; j < 4; ++j) { v[j] = v[j] * rstd * g4[j] + b4[j]; if (final) ((f32x4*)((dry ? jf + (size_t)(m & 8191) * DM : out + (size_t)m * DM)))[64 * j + C.lane] = v[j];
            ((u32x2*)((dry ? jb + (size_t)(m & 8191) * DM : XB + (size_t)m * DM)))[64 * j + C.lane] = (u32x2){pk2(v[j][0], v[j][1]), pk2(v[j][2], v[j][3])}; }
        if constexpr (MODE == 1) {
            float lg[8] = {0.f, 0.f, 0.f, 0.f, 0.f, 0.f, 0.f, 0.f};
#pragma unroll
            for (int j = 0; j < 4; ++j)
#pragma unroll
                for (int i = 0; i < 4; ++i) { const int col = 256 * j + 4 * C.lane + i; const f32x4 w0 = *(const LAS f32x4*)(RW + col * 8), w1 = *(const LAS f32x4*)(RW + col * 8 + 4); const float xv = v[j][i];
                    lg[0] += xv * w0[0]; lg[1] += xv * w0[1]; lg[2] += xv * w0[2]; lg[3] += xv * w0[3]; lg[4] += xv * w1[0]; lg[5] += xv * w1[1]; lg[6] += xv * w1[2]; lg[7] += xv * w1[3]; }
#pragma unroll
            for (int e = 0; e < 8; ++e) lg[e] = wave_sum(lg[e]);
            int e1 = 0; float v1 = lg[0];
#pragma unroll
            for (int e = 1; e < 8; ++e) if (lg[e] > v1) { v1 = lg[e]; e1 = e; }
            int e2 = -1; float v2 = -INFINITY;
#pragma unroll
            for (int e = 0; e < 8; ++e) if (e != e1 && lg[e] > v2) { v2 = lg[e]; e2 = e; }
            const float ex = fexp2((v2 - v1) * LOG2E), gA = 1.0f / (1.0f + ex), gB = ex * gA;
            if (C.lane == 0) { TOPE[2 * m] = e1; TOPE[2 * m + 1] = e2; TOPG[2 * m] = gA; TOPG[2 * m + 1] = gB; }
            cnt0 += (e1 == 0) + (e2 == 0); cnt1 += (e1 == 1) + (e2 == 1); cnt2 += (e1 == 2) + (e2 == 2); cnt3 += (e1 == 3) + (e2 == 3);
            cnt4 += (e1 == 4) + (e2 == 4); cnt5 += (e1 == 5) + (e2 == 5); cnt6 += (e1 == 6) + (e2 == 6); cnt7 += (e1 == 7) + (e2 == 7);
        }
    }
    if constexpr (MODE == 1) {
        if (C.lane == 0) { atomicAdd((unsigned*)&CNT[0], cnt0); atomicAdd((unsigned*)&CNT[1], cnt1); atomicAdd((unsigned*)&CNT[2], cnt2); atomicAdd((unsigned*)&CNT[3], cnt3);
                           atomicAdd((unsigned*)&CNT[4], cnt4); atomicAdd((unsigned*)&CNT[5], cnt5); atomicAdd((unsigned*)&CNT[6], cnt6); atomicAdd((unsigned*)&CNT[7], cnt7); }
        __syncthreads();
        if (C.tid < 8) C.ctl[CW_CNTB + C.bx * 8 + C.tid] = CNT[C.tid];
        __syncthreads();
    }
    }
#undef LN_LOAD
}

__device__ __forceinline__ void moe_assign(Ctx& C) {
    if (C.wave != 0) return;
    const int* TOPE = (const int*)(C.ws + WS_MOE + MT_TOPE); const float* TOPG = (const float*)(C.ws + WS_MOE + MT_TOPG);
    int* TOKSLOT = (int*)(C.ws + WS_MOE + MT_TOKSLOT); int* SLOTTOK = (int*)(C.ws + WS_MOE + MT_SLOTTOK); float* SLOTGATE = (float*)(C.ws + WS_MOE + MT_SLOTGATE);
    const int blk = C.bx, RPB = M / C.G, row0 = blk * RPB;
    int tot[8] = {0, 0, 0, 0, 0, 0, 0, 0}, pre[8] = {0, 0, 0, 0, 0, 0, 0, 0};
    for (int bb = C.lane; bb < C.G; bb += 64) {
        const u32x4* cp = (const u32x4*)(C.ctl + CW_CNTB + bb * 8); const u32x4 ca = cp[0], cb = cp[1]; const int lt = bb < blk ? 1 : 0;
        const int c[8] = {(int)ca.x, (int)ca.y, (int)ca.z, (int)ca.w, (int)cb.x, (int)cb.y, (int)cb.z, (int)cb.w};
#pragma unroll
        for (int e = 0; e < 8; ++e) { tot[e] += c[e]; pre[e] += lt * c[e]; }
    }
#pragma unroll
    for (int e = 0; e < 8; ++e) { tot[e] = wave_sum_i(tot[e]); pre[e] = wave_sum_i(pre[e]); }
    int seg[9]; seg[0] = 0;
#pragma unroll
    for (int e = 0; e < 8; ++e) seg[e + 1] = seg[e] + ((tot[e] + 255) & ~255);
    int run[8];
#pragma unroll
    for (int e = 0; e < 8; ++e) run[e] = seg[e] + pre[e];
    const unsigned long long ltmask = (1ull << C.lane) - 1ull;
    for (int base = 0; base < RPB * 2; base += 64) {
        const int idx = base + C.lane, token = row0 + (idx >> 1), choice = idx & 1;
        const int ex = TOPE[2 * token + choice]; const float gate = TOPG[2 * token + choice]; int slot = 0;
#pragma unroll
        for (int e = 0; e < 8; ++e) { const unsigned long long mk = __builtin_amdgcn_ballot_w64(ex == e); if (ex == e) slot = run[e] + __popcll(mk & ltmask); run[e] += __popcll(mk); }
        SLOTTOK[slot] = token; SLOTGATE[slot] = gate; TOKSLOT[2 * token + choice] = slot;
    }
    if (blk < 8) {
        int lo = 0, hi = 0;
#pragma unroll
        for (int e = 0; e < 8; ++e) if (e == blk) { lo = seg[e] + tot[e]; hi = seg[e + 1]; }
        for (int s = lo + C.lane; s < hi; s += 64) { SLOTTOK[s] = 0; SLOTGATE[s] = 0.f; }
    }
    if (blk == 0 && C.lane == 0) {
#pragma unroll
        for (int e = 0; e < 9; ++e) C.ctl[CW_SEG + e] = (unsigned)seg[e];
    }
}

#ifndef MK_PER_PHASE
#define MK_PER_PHASE 0
#endif
#ifndef PH_ENABLE
#define PH_ENABLE 0xFFFF
#endif
constexpr int PH_PER_LAYER = 12, N_PHASES = 1 + DEPTH * PH_PER_LAYER;

__global__ void __launch_bounds__(NTHR, 2) fwd_kernel(Args args) {
    extern __shared__ __attribute__((aligned(16))) unsigned char lds_raw[];
    LAS unsigned char* const lds = (LAS unsigned char*)lds_raw;
    volatile LAS unsigned* MISC = (volatile LAS unsigned*)(lds + MISC_OFF);
    for (int u = threadIdx.x; u < (LDS_BYTES - LDSCTL_OFF) / 4; u += NTHR) ((LAS unsigned*)(lds + LDSCTL_OFF))[u] = 0u;
    __syncthreads();
    const int wave0 = __builtin_amdgcn_readfirstlane((int)threadIdx.x >> 6);
    XcdBarrier bar; bar.bar = (unsigned*)(args.ws + WS_CTL) + CW_BAR; bar.x = 0; bar.st = nullptr;
    if (!MK_PER_PHASE) bar = xcd_barrier_post((unsigned*)(args.ws + WS_CTL) + CW_BAR, MISC + 8, wave0);
    const int lo = args.ph_lo, hi = args.ph_hi;
#define IN(k) (lo <= (k) && (k) < hi)
#define EN(p) ((PH_ENABLE >> (p)) & 1)
#define SEAM(k) do { if (IN((k) + 1)) { if (!MK_PER_PHASE) { unsigned long long bw0_ = 0ull; if (PROBE_ON(14)) bw0_ = __builtin_amdgcn_s_memrealtime(); xcd_barrier<false>(bar, wave0); if ((REP_MASK >> 13) & 1) xcd_barrier<false>(bar, wave0); \
        if (PROBE_ON(14)) { const unsigned long long bw1_ = __builtin_amdgcn_s_memrealtime(), bd_ = bw1_ - bw0_; while (__builtin_amdgcn_s_memrealtime() - bw1_ < bd_) __builtin_amdgcn_s_sleep(8); } \
        if (PROBE_ON(13)) { const unsigned long long bw1_ = __builtin_amdgcn_s_memrealtime(); while (__builtin_amdgcn_s_memrealtime() - bw1_ < 2000ull) __builtin_amdgcn_s_sleep(8); } } } } while (0)
#define SEAM0(k) do { if (IN((k) + 1)) { if (!MK_PER_PHASE) xcd_barrier<true>(bar, wave0); } } while (0)
#define PHASE_CTX kargs_t A = opaque_args(); Ctx C = make_ctx(A, lds, wave0); unsigned char* sc = C.ws + WS_SCR; (void)sc

    PT0(15); if (EN(15) && IN(0)) { PHASE_CTX; p0_prologue(C, A); }
    PEND(15, SEAM0(0));

    for (int layer = 0; layer < DEPTH; ++layer) {
        const int P = 1 + layer * PH_PER_LAYER;
#ifdef FORCE_MOE
        const bool moe = FORCE_MOE != 0;
#else
        const bool moe = (layer & 1) != 0;
#endif
        if (EN(0) && IN(P + 0)) { PT0(0);
            PHASE_CTX;
            pg8::DenseOrder S{(const bf16*)(C.ws + WS_XB), (const bf16*)(C.ws + WS_WIN) + (size_t)layer * NP1 * DM, DM, DM, M / 256, NP1 / 256, C.G, C.bx, REPN(0)};
            EpiInProj E{(bf16*)(sc + SC_CQKV), (bf16*)(sc + SC_CQKV) + (size_t)M * 256, (float*)(sc + SC_KR), (float*)(sc + SC_FL), (bf16*)(sc + SC_FQ), (bf16*)(sc + SC_CI)};
            if (C.bx >= C.G / 2) { ffn_weights(C, A, layer, (C.bx - C.G / 2) * NWAVES + C.wave, (C.G / 2) * NWAVES, 0, ffn_split(layer)); __syncthreads(); }
            pg8::gemm_phase<EpiInProj, pg8::DenseOrder, false, DM, DM, DM>(C.lds, C.tid, S, E);
            PEND(0, SEAM(P + 0));
        }
        if (EN(1) && IN(P + 1)) { PT0(1); PHASE_CTX; p2_thin(C, A, layer); PEND(1, SEAM(P + 1)); }
        if (EN(2) && IN(P + 2)) { PT0(2);
            PHASE_CTX;
            struct QkvOrder { const bf16* A; const bf16* Bt; int G, c, rep;
                __device__ __forceinline__ bool next(int i, pg8::Unit& u) const { return pg8::tile_order_rep(i, G, c, M / 256, 7, rep, u.pm, u.pn); }
                __device__ __forceinline__ const char* a_base(const pg8::Unit& u) const { return (const char*)(A + (u.pn < 3 ? (size_t)0 : (size_t)M * 256)) + (size_t)u.pm * 256 * 256 * 2; }
                __device__ __forceinline__ const char* b_base(const pg8::Unit& u) const { return (const char*)Bt + (size_t)u.pn * 256 * 256 * 2; }
                __device__ __forceinline__ int tok(const pg8::Unit&, int) const { return 0; }
                __device__ __forceinline__ int ktiles(const pg8::Unit& u, int nt) const { return u.pn < 3 ? nt : nt / 2; } };
            QkvOrder S{(const bf16*)(sc + SC_CQKV), (const bf16*)(C.ws + WS_WQ2) + (size_t)layer * NP1 * 256, C.G, C.bx, REPN(2)};
            EpiQKV E{(bf16*)(sc + SC_QM), (bf16*)(sc + SC_KM), (bf16*)(sc + SC_VM), (const float*)(C.ws + WS_TAB), (const float*)(C.ws + WS_TAB) + (size_t)M * 16};
            pg8::gemm_phase<EpiQKV, QkvOrder, false, 256, 256, 256>(C.lds, C.tid, S, E);
            PEND(2, SEAM(P + 2));
        }
        if (EN(3) && IN(P + 3)) { PT0(3);
            PHASE_CTX;
            bf16* MIXED = (bf16*)(sc + SC_MIXED);
            for (int p = C.vcu; p < 512; p += C.G) { const int bh = p >> 3, s = p & 7;
                for (int i = 0; i < 2; ++i) att::attn_unit<96, false>(bh >> 3, bh & 7, i == 0 ? 15 - s : s, (const bf16*)(sc + SC_QM), 768, (const bf16*)(sc + SC_KM), 768, (const bf16*)(sc + SC_VM), 512, MIXED, 1024, (bh & 7) * 64, nullptr, C.lds, C.tid, (float*)(sc + SC_SSQ), bh & 7, nullptr);
            }
            { volatile LAS unsigned* qw = (volatile LAS unsigned*)(C.lds + RING_BYTES + 8192); const int xb = C.bx & 7; unsigned* qctr = C.ctl + CW_ATTQ + layer * 8 + xb;
              const bf16* FQ = (const bf16*)(sc + SC_FQ);
              for (;;) {
                if (C.tid == 0) qw[0] = __hip_atomic_fetch_add(qctr, 1u, RLX_AGENT);
                asm volatile("s_waitcnt vmcnt(0) lgkmcnt(0)\n\ts_barrier" ::: "memory");
                const int idx = __builtin_amdgcn_readfirstlane((int)qw[0]);
                if (idx >= 64) break;
                const int hd = idx & 3, qb = 15 - (idx >> 2), bh = xb * 4 + hd;
                att::attn_unit<64, true>(xb, hd, qb, FQ, 256, FQ + (size_t)M * 256, 256, FQ + (size_t)2 * M * 256, 256, MIXED, 1024, 512 + hd * 64, (const float*)(sc + SC_CUM), C.lds, C.tid, (float*)(sc + SC_SSQ), 8 + hd, C.ctl + CW_QKMAX + layer * 64 + bh * 2);
              }
            }
            PEND(3, SEAM(P + 3));
        }
        if (EN(5) && IN(P + 5)) { PT0(5);
            PHASE_CTX;
            pg8::DenseOrder S{(const bf16*)(sc + SC_MIXED), (const bf16*)(C.ws + WS_WOUT) + (size_t)layer * DM * DM, DM, DM, M / 256, DM / 256, C.G, C.bx, REPN(5)};
            EpiBf16<DM, false> E{(bf16*)(sc + SC_MIXOUT), DM / 256, nullptr};
            pg8::gemm_phase<EpiBf16<DM, false>, pg8::DenseOrder, false, DM, DM, DM, true>(C.lds, C.tid, S, E, (const float*)(sc + SC_SSQ));
            PEND(5, SEAM(P + 5));
        }
        if (EN(6) && IN(P + 6)) { PT0(6);
            if (moe) { PHASE_CTX; ln_pass<1>(C, false, (const bf16*)(sc + SC_MIXOUT), A->in[15] + layer * DM, A->in[16] + layer * DM, A->in[20] + (size_t)(layer >> 1) * DM * NEXP); }
            else     { PHASE_CTX; ln_pass<0>(C, false, (const bf16*)(sc + SC_MIXOUT), A->in[15] + layer * DM, A->in[16] + layer * DM, nullptr); }
            PEND(6, SEAM(P + 6));
        }
        if (EN(7) && IN(P + 7) && moe) { PT0(7); { PHASE_CTX; moe_assign(C); } PEND(7, SEAM(P + 7)); }
        if (EN(8) && IN(P + 8)) { PT0(8);
            if (moe) {
                PHASE_CTX; bf16* W13 = (bf16*)(C.ws + WS_WFFN); bf16* HID = (bf16*)(sc + SC_HID);
                const int* seg = (const int*)(C.ctl + CW_SEG);
                const int U = (seg[8] / 256) * 11;
                MoeIdxOrder<11> S{(const bf16*)(C.ws + WS_XB), W13, DM, DM, C.vcu, C.G, (U / C.G) * C.G, (const int*)(C.ws + WS_MOE + MT_SLOTTOK), seg[1], seg[2], seg[3], seg[4], seg[5], seg[6], seg[7]};
                EpiSwiGLU<DFE> E{HID, 11};
                pg8::gemm_phase<EpiSwiGLU<DFE>, MoeIdxOrder<11>, true, DM, DM, DM>(C.lds, C.tid, S, E);
            } else {
                PHASE_CTX; bf16* W13 = (bf16*)(C.ws + WS_WFFN); bf16* HID = (bf16*)(sc + SC_HID);
                pg8::DenseOrder S{(const bf16*)(C.ws + WS_XB), W13, DM, DM, M / 256, 2 * DFF / 256, C.G, C.bx, REPN(8)};
                EpiSwiGLU<DFF> E{HID, 1 << 30};
                pg8::gemm_phase<EpiSwiGLU<DFF>, pg8::DenseOrder, false, DM, DM, DM>(C.lds, C.tid, S, E);
            }
            PEND(8, SEAM(P + 8));
        }
        if (EN(9) && IN(P + 9)) { PT0(9);
            if (moe) {
                { PHASE_CTX; bf16* W13 = (bf16*)(C.ws + WS_WFFN); bf16* HID = (bf16*)(sc + SC_HID); const int* seg = (const int*)(C.ctl + CW_SEG);
                  const int U = (seg[8] / 256) * 11, UF = (U / C.G) * C.G;
                  if (UF + C.vcu < U) {
                      MoeIdxOrder<11> S{(const bf16*)(C.ws + WS_XB), W13, DM, DM, UF + C.vcu, C.G, U, (const int*)(C.ws + WS_MOE + MT_SLOTTOK), seg[1], seg[2], seg[3], seg[4], seg[5], seg[6], seg[7]};
                      EpiSwiGLU<DFE> E{HID, 11};
                      pg8::gemm_phase<EpiSwiGLU<DFE>, MoeIdxOrder<11>, true, DM, DM, DM>(C.lds, C.tid, S, E);
                      if (C.tid == 0) { __builtin_amdgcn_fence(__ATOMIC_RELEASE, "agent"); asm volatile("s_waitcnt vmcnt(0)" ::: "memory"); __hip_atomic_fetch_add(C.ctl + CW_LEFT + layer, 1u, RLX_AGENT); }
                  } }
                { PHASE_CTX; bf16* W2T = (bf16*)(C.ws + WS_WFFN) + WF_W13_ELEMS; bf16* HID = (bf16*)(sc + SC_HID); bf16* FF = (bf16*)(sc + SC_FF); const int* seg = (const int*)(C.ctl + CW_SEG);
                  const int U = (seg[8] / 256) * 11, UF = (U / C.G) * C.G, DF = (UF / 11) * 4;
                  MoeIdxOrder<4> S{HID, W2T, DFE, DFE, C.vcu, C.G, DF, nullptr, seg[1], seg[2], seg[3], seg[4], seg[5], seg[6], seg[7]};
                  EpiBf16<DM, true> E{FF, 4, (const float*)(C.ws + WS_MOE + MT_SLOTGATE)};
                  pg8::gemm_phase<EpiBf16<DM, true>, MoeIdxOrder<4>, false, DFE, DFE, DFE>(C.lds, C.tid, S, E); }
                { PHASE_CTX; bf16* W2T = (bf16*)(C.ws + WS_WFFN) + WF_W13_ELEMS; bf16* HID = (bf16*)(sc + SC_HID); bf16* FF = (bf16*)(sc + SC_FF); const int* seg = (const int*)(C.ctl + CW_SEG);
                  const int nM = seg[8] / 256, U = nM * 11, UF = (U / C.G) * C.G, DF = (UF / 11) * 4;
                  if (DF + (C.G - 1 - C.vcu) < nM * 4) {
                      if (C.wave == 0) { const unsigned need = (unsigned)(U - UF); unsigned* cw = C.ctl + CW_LEFT + layer;
                          while ((unsigned)__builtin_amdgcn_readfirstlane((int)__hip_atomic_load(cw, RLX_AGENT)) < need) __builtin_amdgcn_s_sleep(4);
                          __builtin_amdgcn_fence(__ATOMIC_ACQUIRE, "agent"); asm volatile("s_waitcnt vmcnt(0)" ::: "memory"); }
                      __syncthreads();
                      MoeIdxOrder<4> S{HID, W2T, DFE, DFE, DF + (C.G - 1 - C.vcu), C.G, nM * 4, nullptr, seg[1], seg[2], seg[3], seg[4], seg[5], seg[6], seg[7]};
                      EpiBf16<DM, true> E{FF, 4, (const float*)(C.ws + WS_MOE + MT_SLOTGATE)};
                      pg8::gemm_phase<EpiBf16<DM, true>, MoeIdxOrder<4>, false, DFE, DFE, DFE>(C.lds, C.tid, S, E);
                  } }
            } else {
                PHASE_CTX; bf16* W2T = (bf16*)(C.ws + WS_WFFN) + WF_W13_ELEMS; bf16* HID = (bf16*)(sc + SC_HID); bf16* FF = (bf16*)(sc + SC_FF);
                pg8::DenseOrder S{HID, W2T, DFF, DFF, M / 256, DM / 256, C.G, C.bx, REPN(9)};
                EpiBf16<DM, false> E{FF, DM / 256, nullptr};
                pg8::gemm_phase<EpiBf16<DM, false>, pg8::DenseOrder, false, DFF, DFF, DFF>(C.lds, C.tid, S, E);
            }
            PEND(9, SEAM(P + 9));
        }
        if (EN(10) && IN(P + 10)) { PT0(10);
            if (moe) { PHASE_CTX; ln_pass<2>(C, layer == DEPTH - 1, (const bf16*)(sc + SC_FF), A->in[24] + layer * DM, A->in[25] + layer * DM, nullptr); }
            else     { PHASE_CTX; ln_pass<0>(C, layer == DEPTH - 1, (const bf16*)(sc + SC_FF), A->in[24] + layer * DM, A->in[25] + layer * DM, nullptr); }
            PEND(10, if (layer < DEPTH - 1) SEAM(P + 10));
        }
    }
#undef IN
#undef SEAM
}

extern "C" void kernel_launch(void* const* d_in, const int* in_sizes, int n_in, void* d_out, int out_size, void* d_ws, size_t ws_size, hipStream_t stream) {
    static int grid = 0;
    if (grid == 0) {
        if (n_in != 26 || out_size != M * DM || ws_size < WS_END) { fprintf(stderr, "kernel_launch: unexpected problem (n_in %d, out %d, ws %zu < %zu)\n", n_in, out_size, ws_size, (size_t)WS_END); grid = -1; return; }
        int dev = 0, cus = 0, per_cu = 0;
        if (hipGetDevice(&dev) != hipSuccess || hipDeviceGetAttribute(&cus, hipDeviceAttributeMultiprocessorCount, dev) != hipSuccess) { grid = -1; return; }
        if (hipFuncSetAttribute((const void*)fwd_kernel, hipFuncAttributeMaxDynamicSharedMemorySize, LDS_BYTES) != hipSuccess) { fprintf(stderr, "kernel_launch: hipFuncSetAttribute failed\n"); grid = -1; return; }
        if (hipOccupancyMaxActiveBlocksPerMultiprocessor(&per_cu, (const void*)fwd_kernel, NTHR, LDS_BYTES) != hipSuccess || per_cu < 1) fprintf(stderr, "kernel_launch: occupancy query says %d\n", per_cu);
        (void)hipGetLastError();
        grid = 256; while (grid > cus && grid > 8) grid >>= 1;
    }
    if (grid < 0) return;
    (void)hipMemsetAsync((char*)d_ws + WS_CTL, 0, CTL_ZERO_BYTES, stream);
    Args a{};
    for (int i = 0; i < 26; ++i) a.in[i] = (const float*)d_in[i];
    a.out = (float*)d_out; a.ws = (unsigned char*)d_ws;
#if MK_PER_PHASE
    for (int p = 0; p < N_PHASES; ++p) { a.ph_lo = p; a.ph_hi = p + 1; hipLaunchKernelGGL(fwd_kernel, dim3(grid), dim3(NTHR), LDS_BYTES, stream, a); }
#else
    a.ph_lo = 0; a.ph_hi = N_PHASES;
    hipLaunchKernelGGL(fwd_kernel, dim3(grid), dim3(NTHR), LDS_BYTES, stream, a);
#endif
}
```

```cpp
#include <hip/hip_runtime.h>
#include <cstdio>
#include <cstdint>
#include <cmath>

#ifndef REP_MASK
#define REP_MASK 0x0
#endif
#ifndef PROBE_MASK
#define PROBE_MASK 0x0
#endif
#define PROBE_ON(k) ((PROBE_MASK >> (k)) & 1)
#define PT0(k) unsigned long long pt0_ = 0ull; if (PROBE_ON(k)) pt0_ = __builtin_amdgcn_s_memrealtime()
#ifndef PROBE_BEFORE
#define PROBE_BEFORE 0
#endif
#define PSPIN(d) do { const unsigned long long pt1_ = __builtin_amdgcn_s_memrealtime(); while (__builtin_amdgcn_s_memrealtime() - pt1_ < (d)) __builtin_amdgcn_s_sleep(8); } while (0)
#define PEND(k, seamexpr) do { unsigned long long pd_ = 0ull; if (PROBE_ON(k)) { pd_ = __builtin_amdgcn_s_memrealtime() - pt0_; if (PROBE_BEFORE) PSPIN(pd_); } seamexpr; \
        if (PROBE_ON(k) && !PROBE_BEFORE) PSPIN(pd_); } while (0)
#define REPN(p) (1 + ((REP_MASK >> (p)) & 1))
#define REPS(p) for (int rep_ = 0; rep_ < 1 + ((REP_MASK >> (p)) & 1); ++rep_)
#define GAS __attribute__((address_space(1)))
#define LAS __attribute__((address_space(3)))
typedef unsigned short bf16;
typedef short bf16x8 __attribute__((ext_vector_type(8)));
typedef short s16x4 __attribute__((ext_vector_type(4)));
typedef float f32x2 __attribute__((ext_vector_type(2)));
typedef float f32x4 __attribute__((ext_vector_type(4)));
typedef float f32x16 __attribute__((ext_vector_type(16)));
typedef unsigned u32x2 __attribute__((ext_vector_type(2)));
typedef unsigned u32x4 __attribute__((ext_vector_type(4)));
typedef __bf16 bf16x2_t __attribute__((ext_vector_type(2)));

constexpr int BATCH = 8, SEQ = 4096, DM = 1024, M = BATCH * SEQ, DEPTH = 4;
constexpr int IN_COLS = 1700, NP1 = 1792;
constexpr int DFF = 2816, DFE = 1408, NEXP = 8;
constexpr int NWAVES = 8, NTHR = 512;
constexpr float ALPHA = 1.6817928305074290f;
constexpr float EPS = 1e-5f;
constexpr float LOG2E = 1.4426950408889634f;
constexpr float C2_MLA = 0.10206207261596577f * LOG2E;
constexpr float C2_FOX = 0.125f * LOG2E;
constexpr int PC_CQ = 0, PC_CKV = 256, PC_KR = 384, PC_FL = 416, PC_FQ = 512, PC_FK = 768, PC_FV = 1024, PC_CI = 1280;
constexpr int MOE_ROWS_MAX = 2 * M + NEXP * 256;

constexpr size_t MiB = 1u << 20;
constexpr size_t WS_CTL = 0, CTL_ZERO_BYTES = 1 * MiB;
constexpr size_t WS_WIN = 1 * MiB;
constexpr size_t WS_WQ2 = WS_WIN + 14 * MiB;
constexpr size_t WS_WOUT = WS_WQ2 + 4 * MiB;
constexpr size_t WS_TAB = WS_WOUT + 8 * MiB;
constexpr size_t WS_MOE = WS_TAB + 4 * MiB;
constexpr size_t WS_WFFN = WS_MOE + 2 * MiB;
constexpr size_t WS_XB = WS_WFFN + 68 * MiB;
constexpr size_t WS_SCR = WS_XB + 64 * MiB;
constexpr size_t SC_CQKV = 0;
constexpr size_t SC_KR = SC_CQKV + 32 * MiB;
constexpr size_t SC_FL = SC_KR + 4 * MiB;
constexpr size_t SC_CUM = SC_FL + MiB / 2;
constexpr size_t SC_FQ = SC_CUM + MiB / 2;
constexpr size_t SC_CI = SC_FQ + 48 * MiB;
constexpr size_t SC_QM = SC_CI + 32 * MiB;
constexpr size_t SC_KM = SC_QM + 48 * MiB;
constexpr size_t SC_VM = SC_KM + 48 * MiB;
constexpr size_t SC_MIXED = SC_VM + 32 * MiB;
constexpr size_t SC_MIXOUT = SC_QM;
constexpr size_t SC_SSQ = SC_MIXED + 64 * MiB;
constexpr size_t SC_MIX_END = SC_SSQ + 2 * MiB;
constexpr size_t SC_HID = 0;
constexpr size_t SC_FF = 182 * MiB;
constexpr size_t SC_END = 316 * MiB;
constexpr size_t WS_END = WS_SCR + SC_END;
static_assert(SC_MIX_END <= SC_END && SC_FF + (size_t)MOE_ROWS_MAX * 1024 * 2 <= SC_END && (size_t)MOE_ROWS_MAX * DFE * 2 <= SC_FF, "scratch map");
static_assert(WS_END <= 512 * MiB, "workspace map");
constexpr size_t WF_W13_ELEMS = (size_t)NEXP * 2 * DFE * DM;
constexpr size_t MT_TOPE = 0;
constexpr size_t MT_TOPG = 256 * 1024;
constexpr size_t MT_TOKSLOT = 512 * 1024;
constexpr size_t MT_SLOTTOK = 768 * 1024;
constexpr size_t MT_SLOTGATE = 768 * 1024 + 272 * 1024;
static_assert((size_t)MOE_ROWS_MAX * 4 <= 272 * 1024 && MT_SLOTGATE + 272 * 1024 <= 2 * MiB, "moe tables");
constexpr int CW_BAR = 4096;
constexpr int CW_CNTB = 16384;
constexpr int CW_SEG = 20480;
constexpr int CW_ATTQ = 2048;
constexpr int CW_LEFT = 2112;
constexpr int CW_QKMAX = 1024;

constexpr int RING_BYTES = 131072;
constexpr int LDSCTL_OFF = RING_BYTES, MISC_OFF = LDSCTL_OFF + 320;
constexpr int LDS_BYTES = 147456;

#define RLX_AGENT __ATOMIC_RELAXED, __HIP_MEMORY_SCOPE_AGENT
__device__ __forceinline__ unsigned pk2(float lo, float hi) { f32x2 v = {lo, hi}; bf16x2_t b = __builtin_convertvector(v, bf16x2_t); return __builtin_bit_cast(unsigned, b); }
__device__ __forceinline__ float bf2f(unsigned short u) { return __uint_as_float((unsigned)u << 16); }
__device__ __forceinline__ float bflo(unsigned u) { return __uint_as_float(u << 16); }
__device__ __forceinline__ float bfhi(unsigned u) { return __uint_as_float(u & 0xffff0000u); }
__device__ __forceinline__ float fexp2(float x) { return __builtin_amdgcn_exp2f(x); }
__device__ __forceinline__ float frcp(float x) { return __builtin_amdgcn_rcpf(x); }
__device__ __forceinline__ float sigmoidf_(float x) { return frcp(1.0f + fexp2(-x * LOG2E)); }
__device__ __forceinline__ float siluf_(float x) { return x * sigmoidf_(x); }
template <int O> __device__ __forceinline__ float lane_xor(float v) {
    if constexpr (O < 32) return __int_as_float(__builtin_amdgcn_ds_swizzle(__float_as_int(v), (O << 10) | 0x1f));
    else { auto rr = __builtin_amdgcn_permlane32_swap(__float_as_uint(v), __float_as_uint(v), false, false); return __uint_as_float(rr[0]) == v ? __uint_as_float(rr[1]) : __uint_as_float(rr[0]); }
}
__device__ __forceinline__ float wave_sum(float v) {
    v += lane_xor<1>(v); v += lane_xor<2>(v); v += lane_xor<4>(v); v += lane_xor<8>(v); v += lane_xor<16>(v);
    { auto rr = __builtin_amdgcn_permlane32_swap(__float_as_uint(v), __float_as_uint(v), false, false); v = __uint_as_float(rr[0]) + __uint_as_float(rr[1]); }
    return v;
}
__device__ __forceinline__ int wave_sum_i(int v) {
    v += __builtin_amdgcn_ds_swizzle(v, (1 << 10) | 0x1f); v += __builtin_amdgcn_ds_swizzle(v, (2 << 10) | 0x1f); v += __builtin_amdgcn_ds_swizzle(v, (4 << 10) | 0x1f);
    v += __builtin_amdgcn_ds_swizzle(v, (8 << 10) | 0x1f); v += __builtin_amdgcn_ds_swizzle(v, (16 << 10) | 0x1f);
    { auto rr = __builtin_amdgcn_permlane32_swap((unsigned)v, (unsigned)v, false, false); v = (int)(rr[0] + rr[1]); }
    return v;
}
__device__ __forceinline__ u32x4 pack8(const f32x4 a, const f32x4 b) { u32x4 w; w.x = pk2(a[0], a[1]); w.y = pk2(a[2], a[3]); w.z = pk2(b[0], b[1]); w.w = pk2(b[2], b[3]); return w; }

#define XB_TMO      128
#define XB_XCNT(j)  (256  + 64 * (j))
#define XB_XSUB(j)  (1280 + 64 * (j))
#define XB_XGEN(j)  (2304 + 64 * (j))
#define XB_TOP      3328
#define XB_TOPGEN   3392
#define XCD_BAR_WORDS 3456
#define XB_SPIN_CAP (1u << 18)
__device__ __forceinline__ unsigned xb_ld(unsigned* p)              { return __hip_atomic_load(p, __ATOMIC_RELAXED, __HIP_MEMORY_SCOPE_AGENT); }
__device__ __forceinline__ unsigned xb_add(unsigned* p, unsigned v) { return __hip_atomic_fetch_add(p, v, __ATOMIC_RELAXED, __HIP_MEMORY_SCOPE_AGENT); }
__device__ __forceinline__ unsigned xb_xcc_id() { return (unsigned)__builtin_amdgcn_s_getreg((3 << 11) | 20) & 0xFu; }
#define XB_SPIN(cond, bar) do { unsigned _sp = 0; while (cond) { __builtin_amdgcn_s_sleep(1); \
    if ((++_sp & 255u) == 0u) { if (xb_ld(&(bar)[XB_TMO])) break; if (_sp > XB_SPIN_CAP) { atomicAdd(&(bar)[XB_TMO], 1u); break; } } } } while (0)
struct XcdBarrier { unsigned* bar; unsigned x; volatile LAS unsigned* st; };
__device__ __forceinline__ bool xb_is_t0(int wave0) { unsigned ones = ~0u; asm volatile("" : "+s"(ones)); return wave0 == 0 && __builtin_amdgcn_mbcnt_hi(ones, __builtin_amdgcn_mbcnt_lo(ones, 0u)) == 0u; }
__device__ __forceinline__ XcdBarrier xcd_barrier_post(unsigned* bar, volatile LAS unsigned* st, int wave0) {
    XcdBarrier b; b.bar = bar; b.x = xb_xcc_id(); b.st = st;
    if (xb_is_t0(wave0)) (void)xb_add(&bar[XB_XCNT(b.x)], 1u);
    return b;
}
__device__ __forceinline__ void xcd_barrier_complete(unsigned* bar, unsigned x, unsigned& nloc, unsigned& nx) {
    const unsigned G = gridDim.x * gridDim.y * gridDim.z;
    unsigned sum, cnt, mine, sp = 0u;
    for (;;) {
        sum = 0u; cnt = 0u; mine = 0u;
#pragma unroll
        for (unsigned j = 0; j < 16; ++j) { const unsigned c = xb_ld(&bar[XB_XCNT(j)]); sum += c; cnt += (c > 0u) ? 1u : 0u; mine = (j == x) ? c : mine; }
        if (sum == G) break;
        __builtin_amdgcn_s_sleep(1);
        if ((++sp & 255u) == 0u) { if (xb_ld(&bar[XB_TMO])) break; if (sp > XB_SPIN_CAP) { atomicAdd(&bar[XB_TMO], 1u); break; } }
    }
    nloc = mine > 0u ? mine : 1u; nx = cnt > 0u ? cnt : 1u;
}
template <bool FIRST>
__device__ __forceinline__ void xcd_barrier(const XcdBarrier& b, int wave0) {
    asm volatile("s_waitcnt vmcnt(0)" ::: "memory");
    __syncthreads();
    if (xb_is_t0(wave0)) {
        unsigned* bar = b.bar;
        __builtin_amdgcn_s_waitcnt(0);
        unsigned nloc = b.st[0], nx = b.st[1];
        if constexpr (FIRST) { if (nloc == 0u) { xcd_barrier_complete(bar, b.x, nloc, nx); b.st[0] = nloc; b.st[1] = nx; } }
        const unsigned old = xb_add(&bar[XB_XSUB(b.x)], 1u);
        const unsigned gen = old / nloc;
        if (old + 1u == (gen + 1u) * nloc) {
            __builtin_amdgcn_fence(__ATOMIC_RELEASE, "agent");
            asm volatile("s_waitcnt vmcnt(0)" ::: "memory");
            const unsigned og = xb_add(&bar[XB_TOP], 1u);
            const unsigned tg = og / nx;
            if (og + 1u == (tg + 1u) * nx) xb_add(&bar[XB_TOPGEN], 1u);
            else XB_SPIN(xb_ld(&bar[XB_TOPGEN]) == tg, bar);
            __builtin_amdgcn_fence(__ATOMIC_ACQUIRE, "agent");
            xb_add(&bar[XB_XGEN(b.x)], 1u);
            asm volatile("s_waitcnt vmcnt(0)" ::: "memory");
        } else {
            XB_SPIN(xb_ld(&bar[XB_XGEN(b.x)]) == gen, bar);
            __builtin_amdgcn_fence(__ATOMIC_ACQUIRE, "agent");
            asm volatile("s_waitcnt vmcnt(0)" ::: "memory");
        }
    }
    __syncthreads();
}

namespace pg8 {
constexpr int BM = 256, BK = 64, HALF = 128, HTB = HALF * BK * 2, STAGE_BYTES = 8 * HTB, NXCD = 8, WGM = 8;
__host__ __device__ __forceinline__ int lds_byte(int r, int c) { const int st = (r >> 4) * 2 + (c >> 5), rr = r & 15, cc = c & 31, ob = rr * 64 + cc * 2; return st * 1024 + (ob ^ (((ob >> 9) & 1) << 5)); }
__host__ __device__ __forceinline__ void stage_rc(int b, int& R, int& C) { const int st = b / 1024, sb = b % 1024, swz = sb ^ (((sb >> 9) & 1) << 5); R = (st >> 1) * 16 + swz / 64; C = (st & 1) * 32 + (swz % 64) / 2; }
__host__ __device__ __forceinline__ int perm32(int rho) { const int n = rho >> 4, i = rho & 15; return 8 * (i >> 2) + 4 * n + (i & 3); }
struct Unit { int pm, pn; };

__device__ __forceinline__ bool tile_order(long L, int nM, int nN, int& pm, int& pn) {
    const int nwg = nM * nN; if (L >= nwg) return false;
    int wgid = (int)L; { const int q = nwg / NXCD, r = nwg % NXCD, xcd = wgid % NXCD, off = wgid / NXCD; wgid = (xcd < r ? xcd * (q + 1) : r * (q + 1) + (xcd - r) * q) + off; }
    const int nig = WGM * nN, gid = wgid / nig, fm = gid * WGM, gsz = (nM - fm) < WGM ? (nM - fm) : WGM;
    pm = fm + ((wgid % nig) % gsz); pn = (wgid % nig) / gsz; return true;
}
__device__ __forceinline__ bool tile_order_rep(int i, int G, int c, int nM, int nN, int rep, int& pm, int& pn) {
    if (rep == 1) return tile_order((long)i * G + c, nM, nN, pm, pn);
    const int nwg = nM * nN, per = c < nwg ? (nwg - c + G - 1) / G : 0; if (i >= per * rep) return false;
    return tile_order((long)(i % per) * G + c, nM, nN, pm, pn);
}
struct DenseOrder {
    const bf16* A; const bf16* Bt; int lda, ldb, nM, nN, G, c, rep;
    __device__ __forceinline__ bool next(int i, Unit& u) const { return tile_order_rep(i, G, c, nM, nN, rep, u.pm, u.pn); }
    __device__ __forceinline__ const char* a_base(const Unit& u) const { return (const char*)A + (size_t)u.pm * BM * lda * 2; }
    __device__ __forceinline__ const char* b_base(const Unit& u) const { return (const char*)Bt + (size_t)u.pn * BM * ldb * 2; }
    __device__ __forceinline__ int tok(const Unit&, int) const { return 0; }
    __device__ __forceinline__ int ktiles(const Unit&, int nt) const { return nt; }
};

template <class Epi, class Sched, bool GATHER, int K, int lda, int ldb, bool SEGSCALE = false>
__device__ __forceinline__ void gemm_phase(LAS unsigned char* lds, const int tid, const Sched& S, const Epi& E, const float* ssq = nullptr) {
    const int wid = __builtin_amdgcn_readfirstlane(tid >> 6), lane = tid & 63, wr = wid >> 2, wc = wid & 3, fr = lane & 15, fq = lane >> 4;
    constexpr int nt = K / BK;
    unsigned voffA[2], voffB[2];
#pragma unroll
    for (int i = 0; i < 2; ++i) { int R, C; stage_rc(tid * 16 + i * 8192, R, C); const int Rb = Epi::PERM ? ((R & ~31) + perm32(R & 31)) : R;
        voffA[i] = (unsigned)(R * lda + C) * 2u; voffB[i] = (unsigned)(Rb * ldb + C) * 2u; }
#define PG8_GOFF(u_, h_, o0_, o1_) do { unsigned ones_ = ~0u; asm volatile("" : "+s"(ones_)); const int t_ = wid * 64 + (int)__builtin_amdgcn_mbcnt_hi(ones_, __builtin_amdgcn_mbcnt_lo(ones_, 0u)); \
        int R0_, C0_, R1_, C1_; stage_rc(t_ * 16, R0_, C0_); stage_rc(t_ * 16 + 8192, R1_, C1_); \
        o0_ = (unsigned)S.tok(u_, (h_) * HALF + R0_) * (unsigned)(lda * 2) + (unsigned)(C0_ * 2); o1_ = (unsigned)S.tok(u_, (h_) * HALF + R1_) * (unsigned)(lda * 2) + (unsigned)(C1_ * 2); } while (0)
    const size_t kstep = (size_t)(BK * 2);
    constexpr size_t hstepA = (size_t)HALF * lda * 2, hstepB = (size_t)HALF * ldb * 2;
    const unsigned ldsw = (unsigned)wid * 1024u;
    const int aoff = lds_byte(wr * 64 + fr, fq * 8), boff = lds_byte(wc * 32 + fr, fq * 8);
#define PG8_SA(b, h) (((b) * 2 + (h)) * HTB)
#define PG8_SB(b, h) ((4 + (b) * 2 + (h)) * HTB)
#define PG8_STAGE(bufoff, gbase, v0, v1) do { \
        __builtin_amdgcn_global_load_lds((const unsigned*)((const char*)(gbase) + (v0)), (LAS unsigned*)(lds + (bufoff) + ldsw), 16, 0, 0); \
        __builtin_amdgcn_global_load_lds((const unsigned*)((const char*)(gbase) + (v1)), (LAS unsigned*)(lds + (bufoff) + ldsw + 8192), 16, 0, 0); } while (0)
#define PG8_STB(bufoff, gbase) PG8_STAGE(bufoff, gbase, voffB[0], voffB[1])
#define PG8_STA(bufoff, gbase, h, G0, G1) do { if constexpr (GATHER) PG8_STAGE(bufoff, gbase, G0, G1); else PG8_STAGE(bufoff, (gbase) + (h) * hstepA, voffA[0], voffA[1]); } while (0)
#define PG8_LDA(dst, b, h) do { _Pragma("unroll") for (int m = 0; m < 4; ++m) _Pragma("unroll") for (int k = 0; k < 2; ++k) dst[m][k] = *(const LAS bf16x8*)(lds + PG8_SA(b, h) + aoff + m * 2048 + k * 1024); } while (0)
#define PG8_LDB(dst, b, h) do { _Pragma("unroll") for (int n = 0; n < 2; ++n) _Pragma("unroll") for (int k = 0; k < 2; ++k) dst[n][k] = *(const LAS bf16x8*)(lds + PG8_SB(b, h) + boff + n * 2048 + k * 1024); } while (0)
#define PG8_MMA(ai, bj, At, Bt) do { __builtin_amdgcn_s_setprio(1); _Pragma("unroll") for (int m = 0; m < 4; ++m) _Pragma("unroll") for (int n = 0; n < 2; ++n) _Pragma("unroll") for (int k = 0; k < 2; ++k) \
        acc[ai][bj][m][n] = __builtin_amdgcn_mfma_f32_16x16x32_bf16(Bt[n][k], At[m][k], acc[ai][bj][m][n], 0, 0, 0); __builtin_amdgcn_s_setprio(0); } while (0)
#define PG8_WAIT_V(n) asm volatile("s_waitcnt vmcnt(" #n ")" ::: "memory")
#define PG8_WAIT_L(n) asm volatile("s_waitcnt lgkmcnt(" #n ")" ::: "memory")
#define PG8_BAR __builtin_amdgcn_s_barrier()
#define PG8_SCHED __builtin_amdgcn_sched_barrier(0)
    Unit cur, nxt; int ui = 0;
    if (!S.next(0, cur)) return;
    f32x4 acc[2][2][4][2];
#pragma unroll
    for (int a = 0; a < 2; ++a)
#pragma unroll
        for (int b = 0; b < 2; ++b)
#pragma unroll
            for (int m = 0; m < 4; ++m)
#pragma unroll
                for (int n = 0; n < 2; ++n) acc[a][b][m][n] = (f32x4){0.f, 0.f, 0.f, 0.f};
    bf16x8 At[4][2], B0[2][2], B1[2][2];
    const char* cA = S.a_base(cur); const char* cB = S.b_base(cur);
    unsigned gc00 = 0, gc01 = 0, gc10 = 0, gc11 = 0, gn00 = 0, gn01 = 0, gn10 = 0, gn11 = 0;
    if constexpr (GATHER) { PG8_GOFF(cur, 0, gc00, gc01); PG8_GOFF(cur, 1, gc10, gc11); }
    PG8_STB(PG8_SB(0, 0), cB); PG8_STB(PG8_SB(0, 1), cB + hstepB); PG8_STA(PG8_SA(0, 0), cA, 0, gc00, gc01); PG8_STA(PG8_SA(0, 1), cA, 1, gc10, gc11);
    if (wr == 1) PG8_BAR;
    PG8_WAIT_V(2); PG8_BAR;
    PG8_STB(PG8_SB(1, 0), cB + kstep); PG8_STA(PG8_SA(1, 0), cA + kstep, 0, gc00, gc01); PG8_STB(PG8_SB(1, 1), cB + hstepB + kstep);
    PG8_WAIT_V(6); PG8_BAR;
    for (;;) {
        const bool has_next = S.next(ui + 1, nxt);
        const char* nA = has_next ? S.a_base(nxt) : cA; const char* nB = has_next ? S.b_base(nxt) : cB;
        if constexpr (SEGSCALE) {
            if (tid < 256) { const f32x4* sp = (const f32x4*)(ssq + (size_t)(cur.pm * 256 + tid) * 12); const f32x4 a = sp[0], b = sp[1], c = sp[2];
                const float sm = ((a[0] + a[1]) + (a[2] + a[3])) + ((b[0] + b[1]) + (b[2] + b[3])), sf = (c[0] + c[1]) + (c[2] + c[3]);
                const float rm = 1.0f / sqrtf(sm * (1.0f / 512) + EPS), rf = 1.0f / sqrtf(sf * (1.0f / 256) + EPS);
                *(LAS f32x2*)(lds + STAGE_BYTES + 1024 + tid * 8) = (f32x2){rm / rf, rf}; }
        }
        if constexpr (GATHER) {
            if (has_next) { PG8_GOFF(nxt, 0, gn00, gn01); PG8_GOFF(nxt, 1, gn10, gn11); }
            else { gn00 = gc00; gn01 = gc01; gn10 = gc10; gn11 = gc11; }
        }
        const int ntu = S.ktiles(cur, nt);
#pragma nounroll
        for (int t = 0; t < ntu; t += 2) {
            const bool last = (t == ntu - 2);
            const char* a1 = cA + (size_t)(t + 1) * kstep;
            const char* a2 = last ? nA : cA + (size_t)(t + 2) * kstep; const char* b2 = last ? nB : cB + (size_t)(t + 2) * kstep;
            const char* a3 = a2 + kstep; const char* b3 = b2 + kstep;
            const unsigned g00 = last ? gn00 : gc00, g01 = last ? gn01 : gc01, g10 = last ? gn10 : gc10, g11 = last ? gn11 : gc11;
            PG8_LDB(B0, 0, 0); PG8_LDB(B1, 0, 1); PG8_SCHED; PG8_LDA(At, 0, 0); PG8_STA(PG8_SA(1, 1), a1, 1, gc10, gc11);
            PG8_WAIT_V(8); PG8_WAIT_L(0); PG8_BAR; PG8_MMA(0, 0, At, B0); PG8_MMA(0, 1, At, B1); PG8_BAR; PG8_SCHED;
            PG8_LDA(At, 0, 1); PG8_STB(PG8_SB(0, 0), b2); PG8_STB(PG8_SB(0, 1), b2 + hstepB); PG8_STA(PG8_SA(0, 0), a2, 0, g00, g01);
            PG8_WAIT_V(8); PG8_WAIT_L(0); PG8_BAR; PG8_MMA(1, 0, At, B0); PG8_MMA(1, 1, At, B1); PG8_BAR; PG8_SCHED;
            PG8_LDB(B0, 1, 0); PG8_LDB(B1, 1, 1); PG8_SCHED; PG8_LDA(At, 1, 0); PG8_STA(PG8_SA(0, 1), a2, 1, g10, g11);
            PG8_WAIT_V(8); PG8_WAIT_L(0); PG8_BAR; PG8_MMA(0, 0, At, B0); PG8_MMA(0, 1, At, B1); PG8_BAR; PG8_SCHED;
            PG8_LDA(At, 1, 1); PG8_STB(PG8_SB(1, 0), b3); PG8_STB(PG8_SB(1, 1), b3 + hstepB); PG8_STA(PG8_SA(1, 0), a3, 0, g00, g01);
            PG8_WAIT_V(8); PG8_WAIT_L(0); PG8_BAR; PG8_MMA(1, 0, At, B0); PG8_MMA(1, 1, At, B1); PG8_BAR; PG8_SCHED;
            if constexpr (SEGSCALE) {
                if (t == 6 || t == 10) {
                    unsigned ones_ = ~0u; asm volatile("" : "+s"(ones_)); const int fr_ = (int)__builtin_amdgcn_mbcnt_hi(ones_, __builtin_amdgcn_mbcnt_lo(ones_, 0u)) & 15;
                    const LAS float* fp = (const LAS float*)(lds + STAGE_BYTES + 1024) + (wr * 64 + fr_) * 2 + (t == 10 ? 1 : 0);
#pragma unroll
                    for (int ai = 0; ai < 2; ++ai)
#pragma unroll
                        for (int m = 0; m < 4; ++m) { const float f = fp[(ai * 128 + m * 16) * 2];
#pragma unroll
                            for (int bj = 0; bj < 2; ++bj)
#pragma unroll
                                for (int n = 0; n < 2; ++n) acc[ai][bj][m][n] *= f; }
                    PG8_SCHED;
                }
            }
        }
        if (wr == 0) PG8_BAR;
        { unsigned ones_ = ~0u; asm volatile("" : "+s"(ones_)); const int l_ = (int)__builtin_amdgcn_mbcnt_hi(ones_, __builtin_amdgcn_mbcnt_lo(ones_, 0u)); E(acc, cur, wr, wc, l_ & 15, l_ >> 4); }
        if (!has_next) break;
#pragma unroll
        for (int a = 0; a < 2; ++a)
#pragma unroll
            for (int b = 0; b < 2; ++b)
#pragma unroll
                for (int m = 0; m < 4; ++m)
#pragma unroll
                    for (int n = 0; n < 2; ++n) acc[a][b][m][n] = (f32x4){0.f, 0.f, 0.f, 0.f};
        cur = nxt; cA = nA; cB = nB; ++ui;
        if constexpr (GATHER) { gc00 = gn00; gc01 = gn01; gc10 = gn10; gc11 = gn11; }
        if (wr == 1) PG8_BAR;
    }
    PG8_WAIT_V(0);
    PG8_BAR;
#undef PG8_GOFF
#undef PG8_SA
#undef PG8_SB
#undef PG8_STAGE
#undef PG8_STB
#undef PG8_STA
#undef PG8_LDA
#undef PG8_LDB
#undef PG8_MMA
#undef PG8_WAIT_V
#undef PG8_WAIT_L
#undef PG8_BAR
#undef PG8_SCHED
}
}

#define EPI_ROWS_BEGIN _Pragma("unroll") for (int ai = 0; ai < 2; ++ai) _Pragma("unroll") for (int m = 0; m < 4; ++m) { const unsigned row = (unsigned)(u.pm * 256 + ai * 128 + wr * 64 + m * 16 + fr);
#define EPI_ROWS_END asm volatile("" ::: "memory"); }
__device__ __forceinline__ void st16(void* base, unsigned off, u32x4 v) { *(u32x4*)((char*)base + off) = v; }
struct EpiInProj {
    static constexpr bool PERM = true;
    bf16* CQ; bf16* CKV; float* KR; float* FL; bf16* FQ; bf16* CI;
    __device__ __forceinline__ void operator()(const f32x4 (&acc)[2][2][4][2], const pg8::Unit& u, int wr, int wc, int fr, int fq) const {
        const int t = u.pn; const unsigned c8 = (unsigned)(wc * 32 + 8 * fq);
        if (t != 1) {
            bf16* base; unsigned ld;
            if (t >= 5) {
                bf16* hb = CI + (t - 5) * 128;
                EPI_ROWS_BEGIN
                    f32x4 a0 = acc[ai][0][m][0], a1 = acc[ai][0][m][1]; const f32x4 g0 = acc[ai][1][m][0], g1 = acc[ai][1][m][1];
#pragma unroll
                    for (int j = 0; j < 4; ++j) { a0[j] *= sigmoidf_(g0[j]); a1[j] *= sigmoidf_(g1[j]); }
                    st16(hb, (row * 256u + c8) * 2u, pack8(a0, a1));
                EPI_ROWS_END
                return;
            }
            if (t == 0) { base = CQ; ld = 256; } else { base = FQ + (size_t)(t - 2) * M * 256; ld = 256; }
            EPI_ROWS_BEGIN
                const unsigned off = (row * ld + c8) * 2u;
                st16(base, off, pack8(acc[ai][0][m][0], acc[ai][0][m][1]));
                st16(base, off + 256u, pack8(acc[ai][1][m][0], acc[ai][1][m][1]));
            EPI_ROWS_END
        } else {
            EPI_ROWS_BEGIN
                const unsigned off = (row * 256u + c8) * 2u;
                st16(CKV, off, pack8(acc[ai][0][m][0], acc[ai][0][m][1]));
                if (c8 < 32) { const unsigned ko = (row * 32u + c8) * 4u; *(f32x4*)((char*)KR + ko) = acc[ai][1][m][0]; *(f32x4*)((char*)KR + ko + 16) = acc[ai][1][m][1]; }
                else if (c8 == 32) { *(f32x4*)((char*)FL + row * 16u) = acc[ai][1][m][0]; }
            EPI_ROWS_END
        }
    }
};
struct EpiQKV {
    static constexpr bool PERM = true;
    bf16* QM; bf16* KM; bf16* VM; const float* COS; const float* SIN;
    __device__ __forceinline__ void operator()(const f32x4 (&acc)[2][2][4][2], const pg8::Unit& u, int wr, int wc, int fr, int fq) const {
        const int t = u.pn; const unsigned c8 = (unsigned)(wc * 32 + 8 * fq);
        if (t < 3) {
#pragma unroll
            for (int bj = 0; bj < 2; ++bj) {
                const unsigned col = (unsigned)(t * 256 + bj * 128) + c8, h = col / 96u, d = col - h * 96u;
                const bool rope = d >= 64; const unsigned f4 = rope ? ((d - 64) >> 1) : 0u;
#pragma unroll
                for (int ai = 0; ai < 2; ++ai) {
                    f32x4 cc[4], ss[4];
                    if (rope) {
#pragma unroll
                        for (int m = 0; m < 4; ++m) { const unsigned to = ((unsigned)(u.pm * 256 + ai * 128 + wr * 64 + m * 16 + fr) * 16u + f4) * 4u;
                            cc[m] = *(const f32x4*)((const char*)COS + to); ss[m] = *(const f32x4*)((const char*)SIN + to); }
                    }
#pragma unroll
                    for (int m = 0; m < 4; ++m) { const unsigned row = (unsigned)(u.pm * 256 + ai * 128 + wr * 64 + m * 16 + fr);
                        f32x4 v0 = acc[ai][bj][m][0], v1 = acc[ai][bj][m][1];
                        if (rope) {
                            const f32x4 c = cc[m], s = ss[m], a = v0, b = v1;
                            v0 = (f32x4){a[0] * c[0] - a[2] * s[0], a[1] * c[1] - a[3] * s[1], a[0] * s[0] + a[2] * c[0], a[1] * s[1] + a[3] * c[1]};
                            v1 = (f32x4){b[0] * c[2] - b[2] * s[2], b[1] * c[3] - b[3] * s[3], b[0] * s[2] + b[2] * c[2], b[1] * s[3] + b[3] * c[3]};
                        }
                        st16(QM, (row * 768u + col) * 2u, pack8(v0, v1));
                    }
                    asm volatile("" ::: "memory");
                }
            }
        } else if (t < 5) {
#pragma unroll
            for (int bj = 0; bj < 2; ++bj) {
                const unsigned kc = (unsigned)((t - 3) * 256 + bj * 128) + c8, h = kc >> 6, d = kc & 63;
                EPI_ROWS_BEGIN
                    st16(KM, (row * 768u + h * 96u + d) * 2u, pack8(acc[ai][bj][m][0], acc[ai][bj][m][1]));
                EPI_ROWS_END
            }
        } else {
#pragma unroll
            for (int bj = 0; bj < 2; ++bj) {
                const unsigned vc = (unsigned)((t - 5) * 256 + bj * 128) + c8;
                EPI_ROWS_BEGIN
                    st16(VM, (row * 512u + vc) * 2u, pack8(acc[ai][bj][m][0], acc[ai][bj][m][1]));
                EPI_ROWS_END
            }
        }
    }
};
template <int LDC, bool SCALE>
struct EpiBf16 {
    static constexpr bool PERM = true;
    bf16* O; int ntn; const float* rowscale;
    __device__ __forceinline__ void operator()(const f32x4 (&acc)[2][2][4][2], const pg8::Unit& u, int wr, int wc, int fr, int fq) const {
        const unsigned col = (unsigned)((u.pn % ntn) * 256 + wc * 32 + 8 * fq);
        float sc8[8];
        if constexpr (SCALE) {
#pragma unroll
            for (int i = 0; i < 8; ++i) sc8[i] = *(const float*)((const char*)rowscale + (unsigned)(u.pm * 256 + (i >> 2) * 128 + wr * 64 + (i & 3) * 16 + fr) * 4u);
        }
        EPI_ROWS_BEGIN
            float s = 1.0f; if constexpr (SCALE) s = sc8[ai * 4 + m];
            const unsigned off = (row * (unsigned)LDC + col) * 2u;
            st16(O, off, pack8(acc[ai][0][m][0] * s, acc[ai][0][m][1] * s));
            st16(O, off + 256u, pack8(acc[ai][1][m][0] * s, acc[ai][1][m][1] * s));
        EPI_ROWS_END
    }
};
template <int LDH>
struct EpiSwiGLU {
    static constexpr bool PERM = true;
    bf16* H; int ntn;
    __device__ __forceinline__ void operator()(const f32x4 (&acc)[2][2][4][2], const pg8::Unit& u, int wr, int wc, int fr, int fq) const {
        const unsigned col = (unsigned)((u.pn % ntn) * 128 + wc * 32 + 8 * fq);
        EPI_ROWS_BEGIN
            f32x4 a0 = acc[ai][0][m][0], a1 = acc[ai][0][m][1]; const f32x4 b0 = acc[ai][1][m][0], b1 = acc[ai][1][m][1];
#pragma unroll
            for (int j = 0; j < 4; ++j) { a0[j] = siluf_(a0[j]) * b0[j]; a1[j] = siluf_(a1[j]) * b1[j]; }
            st16(H, (row * (unsigned)LDH + col) * 2u, pack8(a0, a1));
        EPI_ROWS_END
    }
};
struct MoeOrder {
    const bf16* A; const bf16* Bt; int lda, ldb, nM, nN, G, c, rep; const int* slot_tok; int s1, s2, s3, s4, s5, s6, s7;
    __device__ __forceinline__ int expert_of(int rt) const { const int r = rt * 256; return (r >= s1) + (r >= s2) + (r >= s3) + (r >= s4) + (r >= s5) + (r >= s6) + (r >= s7); }
    __device__ __forceinline__ bool next(int i, pg8::Unit& u) const { int pm, pn; if (!pg8::tile_order_rep(i, G, c, nM, nN, rep, pm, pn)) return false; u.pm = pm; u.pn = expert_of(pm) * nN + pn; return true; }
    __device__ __forceinline__ const char* a_base(const pg8::Unit& u) const { return slot_tok ? (const char*)A : (const char*)A + (size_t)u.pm * 256 * lda * 2; }
    __device__ __forceinline__ const char* b_base(const pg8::Unit& u) const { return (const char*)Bt + (size_t)u.pn * 256 * ldb * 2; }
    __device__ __forceinline__ int tok(const pg8::Unit& u, int r) const { return slot_tok[u.pm * 256 + r]; }
    __device__ __forceinline__ int ktiles(const pg8::Unit&, int nt) const { return nt; }
};

template <int NN>
struct MoeIdxOrder {
    const bf16* A; const bf16* Bt; int lda, ldb, first, stride, end; const int* slot_tok; int s1, s2, s3, s4, s5, s6, s7;
    __device__ __forceinline__ int expert_of(int rt) const { const int r = rt * 256; return (r >= s1) + (r >= s2) + (r >= s3) + (r >= s4) + (r >= s5) + (r >= s6) + (r >= s7); }
    __device__ __forceinline__ bool next(int i, pg8::Unit& u) const { const int idx = first + i * stride; if (idx >= end) return false; const int pm = idx / NN; u.pm = pm; u.pn = expert_of(pm) * NN + (idx - pm * NN); return true; }
    __device__ __forceinline__ const char* a_base(const pg8::Unit& u) const { return slot_tok ? (const char*)A : (const char*)A + (size_t)u.pm * 256 * lda * 2; }
    __device__ __forceinline__ const char* b_base(const pg8::Unit& u) const { return (const char*)Bt + (size_t)u.pn * 256 * ldb * 2; }
    __device__ __forceinline__ int tok(const pg8::Unit& u, int r) const { return slot_tok[u.pm * 256 + r]; }
    __device__ __forceinline__ int ktiles(const pg8::Unit&, int nt) const { return nt; }
};

namespace att {
__device__ __forceinline__ int crow(int r, int hi) { return (r & 3) + 8 * (r >> 2) + 4 * hi; }
__device__ __forceinline__ s16x4 vtr(const LAS unsigned char* p) { typedef short v4i16_t __attribute__((ext_vector_type(4))); return __builtin_bit_cast(s16x4, __builtin_amdgcn_ds_read_tr16_b64_v4i16((LAS v4i16_t*)p)); }
#define ATT_WAITBAR() asm volatile("s_waitcnt vmcnt(0) lgkmcnt(0)\n\ts_barrier" ::: "memory")
__device__ __forceinline__ void glds16(const void* gsrc, unsigned lds_dst) { unsigned keep;
    asm volatile("s_mov_b32 %0, m0\n\ts_mov_b32 m0, %2\n\ts_nop 0\n\tglobal_load_lds_dwordx4 %1, off\n\ts_mov_b32 m0, %0" : "=&s"(keep) : "v"(gsrc), "s"(lds_dst) : "memory"); }

#define MX3(a, b, c) __builtin_fmaxf(__builtin_fmaxf((a), (b)), (c))
template <int DQK> struct AttLds { static constexpr int NCH = DQK / 8, KSLOT = NCH * 1024, ND0 = DQK / 16, LK = 0, LV = 3 * KSLOT, LOST = LV + 3 * 8192, LCUM = LOST + NWAVES * 4608, END = LCUM + SEQ * 4; };

template <int DQK>
__device__ __forceinline__ void att_qk(f32x16& n0, f32x16& n1, const bf16x8 (&qr)[DQK / 16], const LAS unsigned char* kp) {
    constexpr int ND0 = DQK / 16;
    bf16x8 kf[2 * ND0];
#pragma unroll
    for (int d0 = 0; d0 < ND0; ++d0) { kf[2 * d0] = *(const LAS bf16x8*)(kp + d0 * 2048); kf[2 * d0 + 1] = *(const LAS bf16x8*)(kp + d0 * 2048 + 512); }
    n0 = (f32x16){}; n1 = (f32x16){};
#pragma unroll
    for (int d0 = 0; d0 < ND0; ++d0) {
        n0 = __builtin_amdgcn_mfma_f32_32x32x16_bf16(kf[2 * d0], qr[d0], n0, 0, 0, 0);
        n1 = __builtin_amdgcn_mfma_f32_32x32x16_bf16(kf[2 * d0 + 1], qr[d0], n1, 0, 0, 0);
    }
}
template <bool BIAS, bool MASK>
__device__ __forceinline__ void att_bias_mask(f32x16& n0, f32x16& n1, int t, int NT, int qrel, int hi, float fqb, const LAS float* cumL) {
    if constexpr (BIAS) {
#pragma unroll
        for (int g = 0; g < 4; ++g) {
            const f32x4 f0 = *(const LAS f32x4*)(cumL + t * 64 + 8 * g + 4 * hi), f1 = *(const LAS f32x4*)(cumL + t * 64 + 32 + 8 * g + 4 * hi);
#pragma unroll
            for (int j = 0; j < 4; ++j) { n0[4 * g + j] += fqb - f0[j]; n1[4 * g + j] += fqb - f1[j]; }
        }
    }
    if constexpr (MASK) {
        const int kb = 64 * (t - (NT - 4)) + 4 * hi;
#pragma unroll
        for (int r = 0; r < 16; ++r) { const int kv = kb + (r & 3) + 8 * (r >> 2); if (kv > qrel) n0[r] = -INFINITY; if (kv + 32 > qrel) n1[r] = -INFINITY; }
    }
}
template <int DQK, bool BIAS, bool MASK, bool MORE>
__device__ __forceinline__ void att_step(f32x16& s0, f32x16& s1, f32x16& n0, f32x16& n1, f32x16& o0, f32x16& o1, float& mrow, float& lrow, const bf16x8 (&qr)[DQK / 16],
                                         int t, int NT, int qrel, int lane, int hi, int r32, float fqb, const LAS unsigned char* shm, int vslot, int kslot) {
    typedef AttLds<DQK> L;
    constexpr int ND0 = DQK / 16;
    const LAS unsigned char* vp = shm + L::LV + vslot * 8192 + ((lane >> 4) & 1) * 32 + (lane & 3) * 8 + (4 * hi + ((lane & 15) >> 2)) * 64;
    const LAS unsigned char* kp = shm + L::LK + kslot * L::KSLOT + hi * 1024 + r32 * 16;
    bf16x8 kf[2 * ND0];
    if constexpr (MORE) {
#pragma unroll
        for (int d0 = 0; d0 < ND0; ++d0) { kf[2 * d0] = *(const LAS bf16x8*)(kp + d0 * 2048); kf[2 * d0 + 1] = *(const LAS bf16x8*)(kp + d0 * 2048 + 512); }
    }
    float a = MX3(s0[0], s0[1], s1[0]), b = MX3(s0[2], s0[3], s1[1]); a = MX3(a, s1[2], s1[3]);
#pragma unroll
    for (int r = 4; r < 16; r += 4) { a = MX3(a, s0[r], s0[r + 1]); b = MX3(b, s0[r + 2], s0[r + 3]); a = MX3(a, s1[r], s1[r + 1]); b = MX3(b, s1[r + 2], s1[r + 3]); }
    float rm = __builtin_fmaxf(a, b);
    { auto rr = __builtin_amdgcn_permlane32_swap(__float_as_uint(rm), __float_as_uint(rm), false, false); rm = __builtin_fmaxf(__uint_as_float(rr[0]), __uint_as_float(rr[1])); }
    if (__builtin_amdgcn_ballot_w64(rm > mrow + 8.0f) != 0ull) {
        const float mnew = __builtin_fmaxf(mrow, rm), alpha = fexp2(mrow - mnew);
        mrow = mnew; lrow *= alpha;
#pragma unroll
        for (int r = 0; r < 16; ++r) { o0[r] *= alpha; o1[r] *= alpha; }
    }
    if constexpr (MORE) {
        n0 = (f32x16){}; n1 = (f32x16){};
#pragma unroll
        for (int d0 = 0; d0 < ND0; ++d0) {
            n0 = __builtin_amdgcn_mfma_f32_32x32x16_bf16(kf[2 * d0], qr[d0], n0, 0, 0, 0);
            n1 = __builtin_amdgcn_mfma_f32_32x32x16_bf16(kf[2 * d0 + 1], qr[d0], n1, 0, 0, 0);
        }
    }
    float ps = 0.f;
#pragma unroll
    for (int r = 0; r < 16; ++r) { s0[r] = fexp2(s0[r] - mrow); s1[r] = fexp2(s1[r] - mrow); ps += s0[r] + s1[r]; }
    lrow += ps;
    __builtin_amdgcn_sched_barrier(0);
    s16x4 vl[8], vh[8];
#pragma unroll
    for (int i = 0; i < 8; ++i) { vl[i] = vtr(vp + (i >> 2) * 4096 + (i & 3) * 1024); vh[i] = vtr(vp + (i >> 2) * 4096 + (i & 3) * 1024 + 512); }
    u32x4 pw[4];
    pw[0] = (u32x4){pk2(s0[0], s0[1]), pk2(s0[2], s0[3]), pk2(s0[4], s0[5]), pk2(s0[6], s0[7])};
    pw[1] = (u32x4){pk2(s0[8], s0[9]), pk2(s0[10], s0[11]), pk2(s0[12], s0[13]), pk2(s0[14], s0[15])};
    pw[2] = (u32x4){pk2(s1[0], s1[1]), pk2(s1[2], s1[3]), pk2(s1[4], s1[5]), pk2(s1[6], s1[7])};
    pw[3] = (u32x4){pk2(s1[8], s1[9]), pk2(s1[10], s1[11]), pk2(s1[12], s1[13]), pk2(s1[14], s1[15])};
#pragma unroll
    for (int ks = 0; ks < 4; ++ks) {
        const bf16x8 v0 = (bf16x8){vl[ks][0], vl[ks][1], vl[ks][2], vl[ks][3], vh[ks][0], vh[ks][1], vh[ks][2], vh[ks][3]};
        const bf16x8 v1 = (bf16x8){vl[4 + ks][0], vl[4 + ks][1], vl[4 + ks][2], vl[4 + ks][3], vh[4 + ks][0], vh[4 + ks][1], vh[4 + ks][2], vh[4 + ks][3]};
        o0 = __builtin_amdgcn_mfma_f32_32x32x16_bf16(v0, __builtin_bit_cast(bf16x8, pw[ks]), o0, 0, 0, 0);
        o1 = __builtin_amdgcn_mfma_f32_32x32x16_bf16(v1, __builtin_bit_cast(bf16x8, pw[ks]), o1, 0, 0, 0);
    }
    if constexpr (MORE) att_bias_mask<BIAS, MASK>(n0, n1, t + 1, NT, qrel, hi, fqb, (const LAS float*)(shm + L::LCUM));
}

template <int DQK, bool BIAS>
__device__ __forceinline__ void attn_unit(int b, int h, int qb, const bf16* Q, int pq, const bf16* K, int pk, const bf16* V, int pv,
                                          bf16* O, int po, int ocol, const float* cum, LAS unsigned char* shm, const int tid_in, float* ssqp, int hidx, const unsigned* qkmax) {
    int tid = tid_in; asm volatile("" : "+v"(tid));
    typedef AttLds<DQK> L;
    constexpr int NCH = L::NCH, KSLOT = L::KSLOT, ND0 = L::ND0, LK = L::LK, LV = L::LV, LOST = L::LOST;
    static_assert(L::END <= RING_BYTES, "attention LDS");
    const int lane = tid & 63, r32 = lane & 31, hi = lane >> 5; const int wid = __builtin_amdgcn_readfirstlane(tid >> 6);
    const long rowbase = (long)b * SEQ; const int q0 = qb * 256;
    const bf16* Qw = Q + (rowbase + q0 + wid * 32) * pq + h * DQK;
    const bf16* Kh = K + rowbase * pk + h * DQK; const bf16* Vh = V + rowbase * pv + h * 64;
    const int NT = (q0 + 256) / 64;
    LAS float* cumL = (LAS float*)(shm + L::LCUM);
    if constexpr (BIAS) { const float* cs = cum + (size_t)(b * 4 + h) * SEQ; for (int i = tid * 4; i < q0 + 256; i += NTHR * 4) *(LAS f32x4*)(cumL + i) = *(const f32x4*)(cs + i); }
    const bf16* ksrc = Kh + (long)lane * pk + wid * 8;
    const bf16* vsrc = Vh + (long)(16 * (wid & 3) + (lane >> 2)) * pv + (wid >> 2) * 32 + (lane & 3) * 8;
    const unsigned lds0 = (unsigned)(size_t)shm;
#define ATT_DMA_K(t, slot) do { \
        glds16(ksrc + (long)(t) * 64 * pk, (unsigned)__builtin_amdgcn_readfirstlane((int)(lds0 + LK + (slot) * KSLOT + wid * 1024))); \
        if (NCH > 8 && wid + 8 < NCH) glds16(ksrc + (long)(t) * 64 * pk + 64, (unsigned)__builtin_amdgcn_readfirstlane((int)(lds0 + LK + (slot) * KSLOT + (wid + 8) * 1024))); } while (0)
#define ATT_DMA_V(t, slot) glds16(vsrc + (long)(t) * 64 * pv, (unsigned)__builtin_amdgcn_readfirstlane((int)(lds0 + LV + (slot) * 8192 + wid * 1024)))
    const int nK = (NCH > 8 && wid + 8 < NCH) ? 2 : 1;
#define ATT_WAITBAR_N(n) do { const int n_ = (n); if (n_ == 0) asm volatile("s_waitcnt vmcnt(0) lgkmcnt(0)\n\ts_barrier" ::: "memory"); else if (n_ == 1) asm volatile("s_waitcnt vmcnt(1) lgkmcnt(0)\n\ts_barrier" ::: "memory"); \
        else if (n_ == 2) asm volatile("s_waitcnt vmcnt(2) lgkmcnt(0)\n\ts_barrier" ::: "memory"); else asm volatile("s_waitcnt vmcnt(3) lgkmcnt(0)\n\ts_barrier" ::: "memory"); } while (0)
    int tb = 0;
    if constexpr (BIAS) {
        const float qk = sqrtf(__uint_as_float(qkmax[0]) * __uint_as_float(qkmax[1])) * 1.01f + 1.0f, thr = -(150.0f + 2.0f * qk);
        const float* cs = cum + (size_t)(b * 4 + h) * SEQ; const float f0 = cs[q0]; const float fj = lane < NT ? cs[64 * lane + 63] : f0;
        const unsigned long long keep = __builtin_amdgcn_ballot_w64(lane < NT && (f0 - fj) >= thr);
        tb = keep ? (int)__builtin_ctzll(keep) : NT - 4; if (tb > NT - 4) tb = NT - 4;
        tb = __builtin_amdgcn_readfirstlane(tb);
    }
    ATT_DMA_K(tb, 0); ATT_DMA_V(tb, 0); ATT_DMA_K(tb + 1, 1);
    bf16x8 qr[ND0];
#pragma unroll
    for (int d0 = 0; d0 < ND0; ++d0) qr[d0] = *(const bf16x8*)(Qw + (long)r32 * pq + d0 * 16 + hi * 8);
    float mrow = -1e30f, lrow = 0.f; f32x16 o0 = {}, o1 = {};
    const int qrel = wid * 32 + r32;
    ATT_WAITBAR();
#pragma unroll
    for (int d0 = 0; d0 < ND0; ++d0) asm volatile("" : "+v"(qr[d0]));
    ATT_DMA_K(tb + 2, 2); ATT_DMA_V(tb + 1, 1);
    float fqb = 0.f; if constexpr (BIAS) fqb = cumL[q0 + qrel];
    f32x16 s0, s1;
    att_qk<DQK>(s0, s1, qr, shm + LK + hi * 1024 + r32 * 16);
    asm volatile("s_waitcnt lgkmcnt(0)\n\ts_barrier" ::: "memory");
    if (tb == NT - 4) att_bias_mask<BIAS, true>(s0, s1, tb, NT, qrel, hi, fqb, cumL); else att_bias_mask<BIAS, false>(s0, s1, tb, NT, qrel, hi, fqb, cumL);
    int t = tb, sl0 = 0, sl1 = 1, sl2 = 2;
#define ATT_ROT() do { const int x_ = sl0; sl0 = sl1; sl1 = sl2; sl2 = x_; } while (0)
    f32x16 u0, u1;
    for (; t + 1 < NT - 5; t += 2) {
        ATT_DMA_K(t + 3, sl0); ATT_DMA_V(t + 2, sl2);
        att_step<DQK, BIAS, false, true>(s0, s1, u0, u1, o0, o1, mrow, lrow, qr, t, NT, qrel, lane, hi, r32, fqb, shm, sl0, sl1);
        ATT_WAITBAR_N(nK + 1); ATT_ROT();
        ATT_DMA_K(t + 4, sl0); ATT_DMA_V(t + 3, sl2);
        att_step<DQK, BIAS, false, true>(u0, u1, s0, s1, o0, o1, mrow, lrow, qr, t + 1, NT, qrel, lane, hi, r32, fqb, shm, sl0, sl1);
        ATT_WAITBAR_N(nK + 1); ATT_ROT();
    }
    for (; t < NT - 5; ++t) {
        ATT_DMA_K(t + 3, sl0); ATT_DMA_V(t + 2, sl2);
        att_step<DQK, BIAS, false, true>(s0, s1, u0, u1, o0, o1, mrow, lrow, qr, t, NT, qrel, lane, hi, r32, fqb, shm, sl0, sl1);
        s0 = u0; s1 = u1;
        ATT_WAITBAR_N(nK + 1); ATT_ROT();
    }
    for (; t < NT - 1; ++t) {
        int nis = 0;
        if (t + 3 < NT) { ATT_DMA_K(t + 3, sl0); nis += nK; }
        if (t + 2 < NT) { ATT_DMA_V(t + 2, sl2); nis += 1; }
        const int jbc = t - (NT - 4); const bool docur = !(jbc >= 0 && 2 * jbc > wid), donext = !(2 * (jbc + 1) > wid);
        if (docur && donext) { att_step<DQK, BIAS, true, true>(s0, s1, u0, u1, o0, o1, mrow, lrow, qr, t, NT, qrel, lane, hi, r32, fqb, shm, sl0, sl1); s0 = u0; s1 = u1; }
        else if (docur) att_step<DQK, BIAS, false, false>(s0, s1, u0, u1, o0, o1, mrow, lrow, qr, t, NT, qrel, lane, hi, r32, fqb, shm, sl0, sl1);
        ATT_WAITBAR_N(nis); ATT_ROT();
    }
    if (!(2 * 3 > wid)) att_step<DQK, BIAS, false, false>(s0, s1, u0, u1, o0, o1, mrow, lrow, qr, t, NT, qrel, lane, hi, r32, fqb, shm, sl0, sl1);
#undef ATT_ROT
#undef ATT_WAITBAR_N
    { auto rr = __builtin_amdgcn_permlane32_swap(__float_as_uint(lrow), __float_as_uint(lrow), false, false); lrow = __uint_as_float(rr[0]) + __uint_as_float(rr[1]); }
    const float rl = frcp(lrow);
    { float ssq = 0.f;
#pragma unroll
      for (int r = 0; r < 16; ++r) { const float a = o0[r] * rl, b2 = o1[r] * rl; ssq += a * a + b2 * b2; }
      auto rr = __builtin_amdgcn_permlane32_swap(__float_as_uint(ssq), __float_as_uint(ssq), false, false); ssq = __uint_as_float(rr[0]) + __uint_as_float(rr[1]);
      if (hi == 0) ssqp[(size_t)(rowbase + q0 + wid * 32 + r32) * 12 + hidx] = ssq; }
    LAS unsigned char* stg = shm + LOST + wid * 4608;
#pragma unroll
    for (int g = 0; g < 4; ++g) {
        *(LAS u32x2*)(stg + r32 * 144 + (8 * g + 4 * hi) * 2) = (u32x2){pk2(o0[4 * g] * rl, o0[4 * g + 1] * rl), pk2(o0[4 * g + 2] * rl, o0[4 * g + 3] * rl)};
        *(LAS u32x2*)(stg + r32 * 144 + (32 + 8 * g + 4 * hi) * 2) = (u32x2){pk2(o1[4 * g] * rl, o1[4 * g + 1] * rl), pk2(o1[4 * g + 2] * rl, o1[4 * g + 3] * rl)};
    }
    asm volatile("s_waitcnt lgkmcnt(0)" ::: "memory");
    bf16* Ow = O + (rowbase + q0 + wid * 32) * po + ocol;
#pragma unroll
    for (int i = 0; i < 4; ++i) { const int row = i * 8 + (lane >> 3), ch = lane & 7; const u32x4 v = *(const LAS u32x4*)(stg + row * 144 + ch * 16); *(u32x4*)(Ow + (long)row * po + ch * 8) = v; }
    asm volatile("s_waitcnt lgkmcnt(0)\n\ts_barrier" ::: "memory");
#undef ATT_DMA_K
#undef ATT_DMA_V
}
}

struct Args { const float* in[26]; float* out; unsigned char* ws; int ph_lo, ph_hi; };
typedef const __attribute__((address_space(4))) Args* kargs_t;
struct Ctx {
    LAS unsigned char* lds; unsigned* ctl; unsigned char* ws; float* out;
    int tid, lane, wave, vcu, G, gw, NGW, bx;
};
__device__ __forceinline__ kargs_t opaque_args() { kargs_t p = (kargs_t)__builtin_amdgcn_kernarg_segment_ptr(); asm volatile("" : "+s"(p)); return p; }
__device__ __forceinline__ Ctx make_ctx(kargs_t A, LAS unsigned char* lds, int wave0) {
    Ctx C; unsigned ones = ~0u; asm volatile("" : "+s"(ones));
    int t = wave0 * 64 + (int)__builtin_amdgcn_mbcnt_hi(ones, __builtin_amdgcn_mbcnt_lo(ones, 0u)); asm volatile("" : "+v"(t));
    C.lds = lds; C.ws = A->ws; C.ctl = (unsigned*)(C.ws + WS_CTL); C.out = A->out;
    C.tid = t; C.lane = t & 63; C.wave = __builtin_amdgcn_readfirstlane(t >> 6);
    { int g_ = gridDim.x, b_ = blockIdx.x; asm volatile("" : "+s"(g_), "+s"(b_)); C.G = g_; C.bx = b_; } C.vcu = (C.bx % 8) * (C.G / 8) + C.bx / 8;
    C.gw = C.vcu * NWAVES + C.wave; C.NGW = C.G * NWAVES;
    return C;
}
#define LDS_WAIT() asm volatile("s_waitcnt lgkmcnt(0)" ::: "memory")

struct MapWin { __device__ __forceinline__ int row(int n) const {
        if (n < 256) return PC_CQ + n; if (n < 384) return PC_CKV + (n - 256); if (n < 416) return PC_KR + (n - 384); if (n < 672) return PC_FQ + (n - 416);
        if (n < 928) return PC_FK + (n - 672); if (n < 1184) return PC_FV + (n - 928); if (n < 1188) return PC_FL + (n - 1184);
        { const int c = n - 1188, ch = c & 255; return PC_CI + (ch >> 7) * 256 + (c >> 8) * 128 + (ch & 127); } }
    __device__ __forceinline__ float scale(int, int n) const { return (n >= 416 && n < 672) ? C2_FOX : 1.0f; } };
struct MapUq { const float* g; __device__ __forceinline__ int row(int n) const { const int h = n / 96, d = n - h * 96; if (d < 64) return n; const int i = d - 64;
        const int s = (i < 16) ? (4 * (i >> 1) + (i & 1)) : (4 * ((i - 16) >> 1) + 2 + (i & 1)); return h * 96 + 64 + s; }
    __device__ __forceinline__ float scale(int k, int) const { return g[k] * C2_MLA; } };
struct MapUkv { const float* g; __device__ __forceinline__ int row(int n) const { const int h = n >> 7, d = n & 127; return d < 64 ? (768 + h * 64 + d) : (1280 + h * 64 + (d - 64)); }
    __device__ __forceinline__ float scale(int k, int) const { return g[k]; } };
struct MapWout { const float* gm; const float* gf; __device__ __forceinline__ int row(int n) const { return n; }
    __device__ __forceinline__ float scale(int k, int) const { return k < 512 ? gm[k] : (k < 768 ? gf[k - 512] : 1.0f); } };
struct MapW13 { int which; __device__ __forceinline__ int row(int n) const { return (n >> 7) * 256 + which * 128 + (n & 127); }
    __device__ __forceinline__ float scale(int, int) const { return 1.0f; } };
struct MapId { __device__ __forceinline__ int row(int n) const { return n; } __device__ __forceinline__ float scale(int, int) const { return 1.0f; } };

template <class Map>
__device__ __forceinline__ void transpose_item(const float* W, int Nsrc, bf16* WT, int ldk, LAS float* scr, int kb, int nb, int lane, const Map mp) {
    const int k0 = 64 * kb, n0 = 32 * nb, r8 = lane >> 3, nn = n0 + 4 * (lane & 7); const bool nok = nn < Nsrc;
    f32x4 v[8];
#pragma unroll
    for (int i = 0; i < 8; ++i) { v[i] = (f32x4){0.f, 0.f, 0.f, 0.f}; if (nok) v[i] = *(const f32x4*)(W + (size_t)(k0 + 8 * i + r8) * Nsrc + nn); }
#pragma unroll
    for (int i = 0; i < 8; ++i) { const int kk = 8 * i + r8; LAS float* d = scr + kk * 33 + 4 * (lane & 7);
#pragma unroll
        for (int j = 0; j < 4; ++j) d[j] = v[i][j] * mp.scale(k0 + kk, nn + j); }
    LDS_WAIT(); asm volatile("" ::: "memory");
    const int c = lane & 7;
#pragma unroll
    for (int j = 0; j < 4; ++j) { const int n = (lane >> 3) + 8 * j; const LAS float* s = scr + (8 * c) * 33 + n;
        if (n0 + n < Nsrc) { u32x4 o; o.x = pk2(s[0 * 33], s[1 * 33]); o.y = pk2(s[2 * 33], s[3 * 33]); o.z = pk2(s[4 * 33], s[5 * 33]); o.w = pk2(s[6 * 33], s[7 * 33]);
            *(u32x4*)(WT + (size_t)mp.row(n0 + n) * ldk + k0 + 8 * c) = o; } }
    LDS_WAIT(); asm volatile("" ::: "memory");
}

__device__ __forceinline__ void sincos_acc(float ang, float& c, float& s) {
    const double a = (double)ang, q = __builtin_rint(a * 0.63661977236758134308);
    const double y = (a - q * 1.57079632679489655800) - q * 6.12323399573676603587e-17, y2 = y * y;
    const double sp = y * (1.0 + y2 * (-1.0 / 6 + y2 * (1.0 / 120 + y2 * (-1.0 / 5040 + y2 * (1.0 / 362880 + y2 * (-1.0 / 39916800 + y2 * (1.0 / 6227020800.0)))))));
    const double cp = 1.0 + y2 * (-0.5 + y2 * (1.0 / 24 + y2 * (-1.0 / 720 + y2 * (1.0 / 40320 + y2 * (-1.0 / 3628800 + y2 * (1.0 / 479001600 + y2 * (-1.0 / 87178291200.0)))))));
    const int quad = (int)((long long)q & 3);
    const double ss = (quad == 0) ? sp : (quad == 1) ? cp : (quad == 2) ? -sp : -cp;
    const double cc = (quad == 0) ? cp : (quad == 1) ? -sp : (quad == 2) ? -cp : sp;
    c = (float)cc; s = (float)ss;
}
__device__ __forceinline__ float inv_freq(int f) {
    const int a = f >> 2, b = f & 3;
    const float p = (a == 0) ? 1.0f : (a == 1) ? 0.1f : (a == 2) ? 0.01f : 0.001f;
    const float m = (b == 0) ? 1.0f : (b == 1) ? 0.56234132519034908f : (b == 2) ? 0.31622776601683794f : 0.17782794100389228f;
    return (b == 0) ? p : (float)((double)p * (double)m);
}

__device__ __forceinline__ void p0_prologue(Ctx& C, kargs_t A) {
    LAS float* scr = (LAS float*)(C.lds + C.wave * 16384);
    bf16* WIN = (bf16*)(C.ws + WS_WIN); bf16* WQ2 = (bf16*)(C.ws + WS_WQ2); bf16* WOUT = (bf16*)(C.ws + WS_WOUT);
    constexpr int I_IN = 16 * 54, I_UQ = 4 * 24, I_UKV = 2 * 32, I_OUT = 16 * 32, I_L = I_IN + I_UQ + I_UKV + I_OUT;
    REPS(12) for (int it = C.gw; it < DEPTH * I_L; it += C.NGW) {
        const int l = it / I_L; int r = it - l * I_L;
        if (r < I_IN) { transpose_item(A->in[2] + (size_t)l * DM * IN_COLS, IN_COLS, WIN + (size_t)l * NP1 * DM, DM, scr, r / 54, r % 54, C.lane, MapWin{}); continue; } r -= I_IN;
        if (r < I_UQ) { transpose_item(A->in[4] + (size_t)l * 256 * 768, 768, WQ2 + (size_t)l * NP1 * 256, 256, scr, r / 24, r % 24, C.lane, MapUq{A->in[3] + l * 256}); continue; } r -= I_UQ;
        if (r < I_UKV) { transpose_item(A->in[6] + (size_t)l * 128 * 1024, 1024, WQ2 + (size_t)l * NP1 * 256, 256, scr, r / 32, r % 32, C.lane, MapUkv{A->in[5] + l * 128}); continue; } r -= I_UKV;
        transpose_item(A->in[14] + (size_t)l * DM * DM, DM, WOUT + (size_t)l * DM * DM, DM, scr, r / 32, r % 32, C.lane, MapWout{A->in[12] + l * 512, A->in[13] + l * 256});
    }
    const int gt = C.vcu * NTHR + C.tid, NGT = C.G * NTHR;
    for (int i = gt; i < DEPTH * 92 * 128; i += NGT) { const int l = i / (92 * 128), r = i % (92 * 128); *(u32x4*)(WIN + (size_t)l * NP1 * DM + (size_t)(420 + r / 128) * DM + (r % 128) * 8) = (u32x4){0u, 0u, 0u, 0u}; }
    REPS(4) {
    bf16* XB = (bf16*)(C.ws + WS_XB); const float* x = A->in[0];
    for (int m = C.gw; m < M; m += C.NGW) { const f32x4* xr = (const f32x4*)(x + (size_t)m * DM) + C.lane; u32x2* o = (u32x2*)(XB + (size_t)m * DM) + C.lane;
#pragma unroll
        for (int j = 0; j < 4; ++j) { const f32x4 v = xr[64 * j]; o[64 * j] = (u32x2){pk2(v[0], v[1]), pk2(v[2], v[3])}; } }
    float* COS = (float*)(C.ws + WS_TAB); float* SIN = COS + (size_t)M * 16; const int* pos = (const int*)A->in[1];
    for (int i = gt; i < M * 16; i += NGT) { const float ang = (float)pos[i >> 4] * inv_freq(i & 15); float c, s; sincos_acc(ang, c, s); COS[i] = c; SIN[i] = s; }
    }
}

__device__ __forceinline__ int ffn_split(int layer) { return (layer & 1) ? 7744 : 4224; }
__device__ __forceinline__ void ffn_weights(Ctx& C, kargs_t A, int layer, int first, int stride, int lo, int hi) {
    LAS float* scr = (LAS float*)(C.lds + C.wave * 16384);
    bf16* W13 = (bf16*)(C.ws + WS_WFFN); bf16* W2T = W13 + WF_W13_ELEMS; const int j = layer >> 1;
    if ((layer & 1) == 0) {
        constexpr int I1 = 16 * 88, I2 = 44 * 32;
        const float* w1 = A->in[17] + (size_t)j * DM * DFF; const float* w3 = A->in[18] + (size_t)j * DM * DFF; const float* w2 = A->in[19] + (size_t)j * DFF * DM;
        const int end = hi < 2 * I1 + I2 ? hi : 2 * I1 + I2;
        for (int it = lo + first; it < end; it += stride) {
            int r = it;
            if (r < I1) { transpose_item(w1, DFF, W13, DM, scr, r / 88, r % 88, C.lane, MapW13{0}); continue; } r -= I1;
            if (r < I1) { transpose_item(w3, DFF, W13, DM, scr, r / 88, r % 88, C.lane, MapW13{1}); continue; } r -= I1;
            transpose_item(w2, DM, W2T, DFF, scr, r / 32, r % 32, C.lane, MapId{});
        }
    } else {
        constexpr int I1 = 16 * 44, I2 = 22 * 32, IE = 2 * I1 + I2;
        const int end = hi < NEXP * IE ? hi : NEXP * IE;
        for (int it = lo + first; it < end; it += stride) {
            const int e = it / IE; int r = it - e * IE;
            const float* w1 = A->in[21] + ((size_t)j * NEXP + e) * DM * DFE; const float* w3 = A->in[22] + ((size_t)j * NEXP + e) * DM * DFE; const float* w2 = A->in[23] + ((size_t)j * NEXP + e) * DFE * DM;
            bf16* W13e = W13 + (size_t)e * 2 * DFE * DM; bf16* W2Te = W2T + (size_t)e * DM * DFE;
            if (r < I1) { transpose_item(w1, DFE, W13e, DM, scr, r / 44, r % 44, C.lane, MapW13{0}); continue; } r -= I1;
            if (r < I1) { transpose_item(w3, DFE, W13e, DM, scr, r / 44, r % 44, C.lane, MapW13{1}); continue; } r -= I1;
            transpose_item(w2, DM, W2Te, DFE, scr, r / 32, r % 32, C.lane, MapId{});
        }
    }
}

__device__ __forceinline__ void p2_thin(Ctx& C, kargs_t A, int layer) {
    unsigned char* sc = C.ws + WS_SCR;
    bf16* CQ = (bf16*)(sc + SC_CQKV); bf16* CKV = CQ + (size_t)M * 256; const float* KR = (const float*)(sc + SC_KR); const float* FL = (const float*)(sc + SC_FL);
    float* CUM = (float*)(sc + SC_CUM); const bf16* CI = (const bf16*)(sc + SC_CI); const bf16* FQn = (const bf16*)(sc + SC_FQ); bf16* KM = (bf16*)(sc + SC_KM); bf16* MIXED = (bf16*)(sc + SC_MIXED);
    const float* COS = (const float*)(C.ws + WS_TAB); const float* SIN = COS + (size_t)M * 16;
    LAS unsigned* NT2 = (LAS unsigned*)(C.lds + RING_BYTES + 4096);
    if (C.tid < 64) NT2[C.tid] = 0u;
    LAS unsigned* RQ = (LAS unsigned*)(C.lds + RING_BYTES + 8192 + 64);
    if (C.tid == 0) RQ[0] = 0u;
    __syncthreads();
    {
    if (C.wave == 0 && C.vcu < BATCH * 4) {
        const int sq = C.vcu, b = sq >> 2, h = sq & 3; const float bias = A->in[7][layer * 4 + h];
        float v[64]; float run = 0.f;
#pragma unroll
        for (int i = 0; i < 64; ++i) { const float z = FL[((size_t)b * SEQ + C.lane * 64 + i) * 4 + h] + bias; const float e = fexp2(-fabsf(z) * LOG2E);
            const float ls = fminf(z, 0.f) - __builtin_amdgcn_logf(1.0f + e) * 0.6931471805599453f; run += ls * LOG2E; v[i] = run; }
        float incl = run;
#pragma unroll
        for (int o = 1; o < 64; o <<= 1) { const float t = __int_as_float(__builtin_amdgcn_ds_bpermute((C.lane - o) << 2, __float_as_int(incl))); if (C.lane >= o) incl += t; }
        const float excl = incl - run; float* dst = CUM + (size_t)sq * SEQ + C.lane * 64;
#pragma unroll
        for (int i = 0; i < 64; i += 4) *(f32x4*)(dst + i) = (f32x4){v[i] + excl, v[i + 1] + excl, v[i + 2] + excl, v[i + 3] + excl};
    }
    const int rpw = M / C.G;
    for (;;) {
        unsigned jb = 0u; if (C.lane == 0) jb = __hip_atomic_fetch_add(RQ, 1u, __ATOMIC_RELAXED, __HIP_MEMORY_SCOPE_WORKGROUP);
        jb = (unsigned)__builtin_amdgcn_readfirstlane((int)jb);
        if ((int)jb * 4 >= rpw) break;
        const size_t mb = (size_t)C.vcu * rpw + 4 * jb;
        u32x2 wq[4]; unsigned wk[4]; f32x2 x1[4], x2[4], cs[4], sn[4]; u32x2 fqv[4], fkv[4]; const int g4 = C.lane & 7, h = C.lane >> 3;
#pragma unroll
        for (int k = 0; k < 4; ++k) { const size_t m = mb + k;
            wq[k] = ((const u32x2*)(CQ + m * 256))[C.lane]; wk[k] = ((const unsigned*)(CKV + m * 256))[C.lane];
            x1[k] = *(const f32x2*)(KR + m * 32 + 2 * g4); x2[k] = *(const f32x2*)(KR + m * 32 + 16 + 2 * g4);
            cs[k] = *(const f32x2*)(COS + m * 16 + 2 * g4); sn[k] = *(const f32x2*)(SIN + m * 16 + 2 * g4);
            fqv[k] = ((const u32x2*)(FQn + m * 256))[C.lane]; fkv[k] = ((const u32x2*)(FQn + (size_t)M * 256 + m * 256))[C.lane]; }
#pragma unroll
        for (int k = 0; k < 4; ++k) { const size_t m = mb + k;
            { const float a0 = bflo(wq[k].x), a1 = bfhi(wq[k].x), a2 = bflo(wq[k].y), a3 = bfhi(wq[k].y);
              const float ss = wave_sum((a0 * a0 + a1 * a1) + (a2 * a2 + a3 * a3)); const float r = 1.0f / sqrtf(ss * (1.0f / 256) + EPS); ((u32x2*)(CQ + m * 256))[C.lane] = (u32x2){pk2(a0 * r, a1 * r), pk2(a2 * r, a3 * r)}; }
            { const float a0 = bflo(wk[k]), a1 = bfhi(wk[k]); unsigned* p = (unsigned*)(CKV + m * 256) + C.lane;
              const float ss = wave_sum(a0 * a0 + a1 * a1); const float r = 1.0f / sqrtf(ss * (1.0f / 128) + EPS); *p = pk2(a0 * r, a1 * r); }
            {
              float nq = 0.f, nk = 0.f; { const float a0 = bflo(fqv[k].x), a1 = bfhi(fqv[k].x), a2 = bflo(fqv[k].y), a3 = bfhi(fqv[k].y); nq = (a0 * a0 + a1 * a1) + (a2 * a2 + a3 * a3); }
              { const float a0 = bflo(fkv[k].x), a1 = bfhi(fkv[k].x), a2 = bflo(fkv[k].y), a3 = bfhi(fkv[k].y); nk = (a0 * a0 + a1 * a1) + (a2 * a2 + a3 * a3); }
              nq += lane_xor<1>(nq); nq += lane_xor<2>(nq); nq += lane_xor<4>(nq); nq += lane_xor<8>(nq); nk += lane_xor<1>(nk); nk += lane_xor<2>(nk); nk += lane_xor<4>(nk); nk += lane_xor<8>(nk);
              if ((C.lane & 15) == 0) { const int bi = (int)(m >> 12) * 8 + (C.lane >> 4) * 2; atomicMax((unsigned*)&NT2[bi], __float_as_uint(nq)); atomicMax((unsigned*)&NT2[bi + 1], __float_as_uint(nk)); } }
            *(u32x2*)(KM + m * 768 + h * 96 + 64 + 4 * g4) = (u32x2){pk2(x1[k].x * cs[k].x - x2[k].x * sn[k].x, x1[k].y * cs[k].y - x2[k].y * sn[k].y), pk2(x1[k].x * sn[k].x + x2[k].x * cs[k].x, x1[k].y * sn[k].y + x2[k].y * cs[k].y)}; }
    }
    }
    __syncthreads();
    if (C.tid < 64) atomicMax(C.ctl + CW_QKMAX + layer * 64 + C.tid, NT2[C.tid]);
    {
        LAS float* hL = (LAS float*)C.lds; LAS float* yL = hL + 62 * 256;
        const int cch = (C.wave & 3) * 64 + C.lane, tt0 = (C.wave >> 2) * 16;
        float wj[31];
#pragma unroll
        for (int j = 0; j < 31; ++j) wj[j] = A->in[8][((size_t)layer * 31 + j) * 256 + cch];
        const float cb = A->in[9][layer * 256 + cch];
        const int ntok = C.tid >> 4, ngrp = (C.tid >> 2) & 3, nqt = C.tid & 3, nc0 = ngrp * 64 + nqt * 16;
        u32x4 pa[4];
#define CONV_LOAD(tl) do { const int t0_ = (tl) * 32, seq0_ = (t0_ / SEQ) * SEQ; _Pragma("unroll") for (int k = 0; k < 4; ++k) { const int it = C.tid + NTHR * k, r = it >> 5, ch = it & 31, tok = t0_ - 30 + r; \
            pa[k] = (u32x4){0u, 0u, 0u, 0u}; \
            if (it < 62 * 32 && tok >= seq0_) pa[k] = *(const u32x4*)(CI + (size_t)tok * 256 + ch * 8); } } while (0)
        if (C.vcu < M / 32) CONV_LOAD(C.vcu);
        for (int tile = C.vcu; tile < M / 32; tile += C.G) {
            const int t0 = tile * 32;
#pragma unroll
            for (int k = 0; k < 4; ++k) { const int it = C.tid + NTHR * k, r = it >> 5, ch = it & 31;
                if (it < 62 * 32) { const u32x4 a = pa[k];
                    *(LAS f32x4*)(hL + r * 256 + ch * 8) = (f32x4){bflo(a.x), bfhi(a.x), bflo(a.y), bfhi(a.y)}; *(LAS f32x4*)(hL + r * 256 + ch * 8 + 4) = (f32x4){bflo(a.z), bfhi(a.z), bflo(a.w), bfhi(a.w)}; } }
            __syncthreads();
            if (tile + C.G < M / 32) CONV_LOAD(tile + C.G);
#pragma unroll
            for (int chunk = 0; chunk < 2; ++chunk) { const int base = tt0 + chunk * 8; float hv[38];
#pragma unroll
                for (int i = 0; i < 38; ++i) hv[i] = hL[(base + i) * 256 + cch];
#pragma unroll
                for (int tt = 0; tt < 8; ++tt) { float acc = cb;
#pragma unroll
                    for (int j = 0; j < 31; ++j) acc += wj[j] * hv[tt + j];
                    yL[(base + tt) * 256 + cch] = acc; } }
            __syncthreads();
            { float v[16]; float s = 0.f;
#pragma unroll
              for (int i = 0; i < 16; i += 4) { const f32x4 t4 = *(const LAS f32x4*)(yL + ntok * 256 + nc0 + i); v[i] = t4[0]; v[i + 1] = t4[1]; v[i + 2] = t4[2]; v[i + 3] = t4[3]; s += (t4[0] + t4[1]) + (t4[2] + t4[3]); }
              s += lane_xor<1>(s); s += lane_xor<2>(s); const float mean = s * (1.0f / 64); float q = 0.f;
#pragma unroll
              for (int i = 0; i < 16; ++i) { v[i] -= mean; q += v[i] * v[i]; }
              q += lane_xor<1>(q); q += lane_xor<2>(q); const float rstd = 1.0f / sqrtf(q * (1.0f / 64) + EPS);
              const float* gg = A->in[10] + layer * 256 + nc0; const float* gb = A->in[11] + layer * 256 + nc0; float o[16];
#pragma unroll
              for (int i = 0; i < 16; ++i) o[i] = siluf_(v[i] * rstd * gg[i] + gb[i]);
              bf16* dst = MIXED + (size_t)(t0 + ntok) * 1024 + 768 + nc0;
              *(u32x4*)dst = (u32x4){pk2(o[0], o[1]), pk2(o[2], o[3]), pk2(o[4], o[5]), pk2(o[6], o[7])};
              *(u32x4*)(dst + 8) = (u32x4){pk2(o[8], o[9]), pk2(o[10], o[11]), pk2(o[12], o[13]), pk2(o[14], o[15])}; }
        }
        __syncthreads();
    }
    REPS(11) ffn_weights(C, A, layer, C.gw, C.NGW, ffn_split(layer), 1 << 30);
}

__device__ __forceinline__ void p5_rms(Ctx& C) {
    bf16* MIXED = (bf16*)(C.ws + WS_SCR + SC_MIXED);
    REPS(7) for (int mb = C.gw; mb < M; mb += 4 * C.NGW) {
        u32x4 wa[4]; u32x2 wb[4];
#pragma unroll
        for (int k = 0; k < 4; ++k) { const bf16* r = MIXED + ((size_t)mb + (size_t)k * C.NGW) * 1024; wa[k] = ((const u32x4*)r)[C.lane]; wb[k] = ((const u32x2*)(r + 512))[C.lane]; }
#pragma unroll
        for (int k = 0; k < 4; ++k) { bf16* r = MIXED + ((size_t)mb + (size_t)k * C.NGW) * 1024;
            { const u32x4 w = wa[k]; float a[8] = {bflo(w.x), bfhi(w.x), bflo(w.y), bfhi(w.y), bflo(w.z), bfhi(w.z), bflo(w.w), bfhi(w.w)}; float ss = 0.f;
#pragma unroll
              for (int i = 0; i < 8; ++i) ss += a[i] * a[i];
              ss = wave_sum(ss); const float rs = 1.0f / sqrtf(ss * (1.0f / 512) + EPS);
              ((u32x4*)r)[C.lane] = (u32x4){pk2(a[0] * rs, a[1] * rs), pk2(a[2] * rs, a[3] * rs), pk2(a[4] * rs, a[5] * rs), pk2(a[6] * rs, a[7] * rs)}; }
            { const u32x2 w = wb[k]; const float a0 = bflo(w.x), a1 = bfhi(w.x), a2 = bflo(w.y), a3 = bfhi(w.y);
              const float ss = wave_sum((a0 * a0 + a1 * a1) + (a2 * a2 + a3 * a3)); const float rs = 1.0f / sqrtf(ss * (1.0f / 256) + EPS); ((u32x2*)(r + 512))[C.lane] = (u32x2){pk2(a0 * rs, a1 * rs), pk2(a2 * rs, a3 * rs)}; }
        }
    }
}

template <int MODE>
__device__ __forceinline__ void ln_pass(Ctx& C, const bool final, const bf16* add, const float* gam, const float* bet, const float* router_w) {
    bf16* XB = (bf16*)(C.ws + WS_XB); float* out = C.out;
    REPS(14) {
    const bool dry = ((REP_MASK >> 14) & 1) && rep_ == 0; float* jf = (float*)(C.ws + WS_SCR); bf16* jb = (bf16*)(C.ws + WS_SCR + 40 * MiB);
    int* TOPE = (int*)(C.ws + WS_MOE + MT_TOPE); float* TOPG = (float*)(C.ws + WS_MOE + MT_TOPG); const int* TOKSLOT = (const int*)(C.ws + WS_MOE + MT_TOKSLOT);
    LAS float* RW = (LAS float*)C.lds; LAS unsigned* CNT = (LAS unsigned*)(C.lds + 32768);
    if constexpr (MODE == 1) {
        for (int i = C.tid; i < 1024 * 8 / 4; i += NTHR) *(LAS f32x4*)(RW + 4 * i) = *(const f32x4*)(router_w + 4 * i);
        if (C.tid < 8) CNT[C.tid] = 0u;
        __syncthreads();
    }
    f32x4 g4[4], b4[4];
#pragma unroll
    for (int j = 0; j < 4; ++j) { g4[j] = ((const f32x4*)gam)[64 * j + C.lane]; b4[j] = ((const f32x4*)bet)[64 * j + C.lane]; }
    const int RPB = M / C.G, row0 = C.bx * RPB;
    unsigned cnt0 = 0, cnt1 = 0, cnt2 = 0, cnt3 = 0, cnt4 = 0, cnt5 = 0, cnt6 = 0, cnt7 = 0;
    u32x2 nx[4], na[4], nb[4]; int sl0 = 0, sl1 = 0;
#define LN_LOAD(mm) do { _Pragma("unroll") for (int j = 0; j < 4; ++j) { nx[j] = ((const u32x2*)(XB + (size_t)(mm) * DM))[64 * j + C.lane]; \
        if constexpr (MODE == 2) { na[j] = ((const u32x2*)(add + (size_t)sl0 * DM))[64 * j + C.lane]; nb[j] = ((const u32x2*)(add + (size_t)sl1 * DM))[64 * j + C.lane]; } \
        else { na[j] = ((const u32x2*)(add + (size_t)(mm) * DM))[64 * j + C.lane]; nb[j] = (u32x2){0u, 0u}; } } } while (0)
    if constexpr (MODE == 2) { sl0 = TOKSLOT[2 * (row0 + C.wave)]; sl1 = TOKSLOT[2 * (row0 + C.wave) + 1]; }
    LN_LOAD(row0 + C.wave);
    if constexpr (MODE == 2) { if (C.wave + NWAVES < RPB) { sl0 = TOKSLOT[2 * (row0 + C.wave + NWAVES)]; sl1 = TOKSLOT[2 * (row0 + C.wave + NWAVES) + 1]; } }
    for (int rr = C.wave; rr < RPB; rr += NWAVES) {
        const int m = row0 + rr;
        f32x4 v[4];
#pragma unroll
        for (int j = 0; j < 4; ++j) { v[j] = (f32x4){bflo(nx[j].x), bfhi(nx[j].x), bflo(nx[j].y), bfhi(nx[j].y)} * ALPHA + (f32x4){bflo(na[j].x), bfhi(na[j].x), bflo(na[j].y), bfhi(na[j].y)};
            if constexpr (MODE == 2) v[j] += (f32x4){bflo(nb[j].x), bfhi(nb[j].x), bflo(nb[j].y), bfhi(nb[j].y)}; }
        if (rr + NWAVES < RPB) {
            LN_LOAD(m + NWAVES);
            if constexpr (MODE == 2) { if (rr + 2 * NWAVES < RPB) { sl0 = TOKSLOT[2 * (m + 2 * NWAVES)]; sl1 = TOKSLOT[2 * (m + 2 * NWAVES) + 1]; } }
        }
        float s = 0.f;
#pragma unroll
        for (int j = 0; j < 4; ++j) s += (v[j][0] + v[j][1]) + (v[j][2] + v[j][3]);
        const float mean = wave_sum(s) * (1.0f / DM); float q = 0.f;
#pragma unroll
        for (int j = 0; j < 4; ++j) { v[j] = v[j] - mean; q += (v[j][0] * v[j][0] + v[j][1] * v[j][1]) + (v[j][2] * v[j][2] + v[j][3] * v[j][3]); }
        const float rstd = 1.0f / sqrtf(wave_sum(q) * (1.0f / DM) + EPS);
#pragma unroll
        for (int j = 0; j < 4; ++j) { v[j] = v[j] * rstd * g4[j] + b4[j]; if (final) ((f32x4*)((dry ? jf + (size_t)(m & 8191) * DM : out + (size_t)m * DM)))[64 * j + C.lane] = v[j];
            ((u32x2*)((dry ? jb + (size_t)(m & 8191) * DM : XB + (size_t)m * DM)))[64 * j + C.lane] = (u32x2){pk2(v[j][0], v[j][1]), pk2(v[j][2], v[j][3])}; }
        if constexpr (MODE == 1) {
            float lg[8] = {0.f, 0.f, 0.f, 0.f, 0.f, 0.f, 0.f, 0.f};
#pragma unroll
            for (int j = 0; j < 4; ++j)
#pragma unroll
                for (int i = 0; i < 4; ++i) { const int col = 256 * j + 4 * C.lane + i; const f32x4 w0 = *(const LAS f32x4*)(RW + col * 8), w1 = *(const LAS f32x4*)(RW + col * 8 + 4); const float xv = v[j][i];
                    lg[0] += xv * w0[0]; lg[1] += xv * w0[1]; lg[2] += xv * w0[2]; lg[3] += xv * w0[3]; lg[4] += xv * w1[0]; lg[5] += xv * w1[1]; lg[6] += xv * w1[2]; lg[7] += xv * w1[3]; }
#pragma unroll
            for (int e = 0; e < 8; ++e) lg[e] = wave_sum(lg[e]);
            int e1 = 0; float v1 = lg[0];
#pragma unroll
            for (int e = 1; e < 8; ++e) if (lg[e] > v1) { v1 = lg[e]; e1 = e; }
            int e2 = -1; float v2 = -INFINITY;
#pragma unroll
            for (int e = 0; e < 8; ++e) if (e != e1 && lg[e] > v2) { v2 = lg[e]; e2 = e; }
            const float ex = fexp2((v2 - v1) * LOG2E), gA = 1.0f / (1.0f + ex), gB = ex * gA;
            if (C.lane == 0) { TOPE[2 * m] = e1; TOPE[2 * m + 1] = e2; TOPG[2 * m] = gA; TOPG[2 * m + 1] = gB; }
            cnt0 += (e1 == 0) + (e2 == 0); cnt1 += (e1 == 1) + (e2 == 1); cnt2 += (e1 == 2) + (e2 == 2); cnt3 += (e1 == 3) + (e2 == 3);
            cnt4 += (e1 == 4) + (e2 == 4); cnt5 += (e1 == 5) + (e2 == 5); cnt6 += (e1 == 6) + (e2 == 6); cnt7 += (e1 == 7) + (e2 == 7);
        }
    }
    if constexpr (MODE == 1) {
        if (C.lane == 0) { atomicAdd((unsigned*)&CNT[0], cnt0); atomicAdd((unsigned*)&CNT[1], cnt1); atomicAdd((unsigned*)&CNT[2], cnt2); atomicAdd((unsigned*)&CNT[3], cnt3);
                           atomicAdd((unsigned*)&CNT[4], cnt4); atomicAdd((unsigned*)&CNT[5], cnt5); atomicAdd((unsigned*)&CNT[6], cnt6); atomicAdd((unsigned*)&CNT[7], cnt7); }
        __syncthreads();
        if (C.tid < 8) C.ctl[CW_CNTB + C.bx * 8 + C.tid] = CNT[C.tid];
        __syncthreads();
    }
    }
#undef LN_LOAD
}

__device__ __forceinline__ void moe_assign(Ctx& C) {
    if (C.wave != 0) return;
    const int* TOPE = (const int*)(C.ws + WS_MOE + MT_TOPE); const float* TOPG = (const float*)(C.ws + WS_MOE + MT_TOPG);
    int* TOKSLOT = (int*)(C.ws + WS_MOE + MT_TOKSLOT); int* SLOTTOK = (int*)(C.ws + WS_MOE + MT_SLOTTOK); float* SLOTGATE = (float*)(C.ws + WS_MOE + MT_SLOTGATE);
    const int blk = C.bx, RPB = M / C.G, row0 = blk * RPB;
    int tot[8] = {0, 0, 0, 0, 0, 0, 0, 0}, pre[8] = {0, 0, 0, 0, 0, 0, 0, 0};
    for (int bb = C.lane; bb < C.G; bb += 64) {
        const u32x4* cp = (const u32x4*)(C.ctl + CW_CNTB + bb * 8); const u32x4 ca = cp[0], cb = cp[1]; const int lt = bb < blk ? 1 : 0;
        const int c[8] = {(int)ca.x, (int)ca.y, (int)ca.z, (int)ca.w, (int)cb.x, (int)cb.y, (int)cb.z, (int)cb.w};
#pragma unroll
        for (int e = 0; e < 8; ++e) { tot[e] += c[e]; pre[e] += lt * c[e]; }
    }
#pragma unroll
    for (int e = 0; e < 8; ++e) { tot[e] = wave_sum_i(tot[e]); pre[e] = wave_sum_i(pre[e]); }
    int seg[9]; seg[0] = 0;
#pragma unroll
    for (int e = 0; e < 8; ++e) seg[e + 1] = seg[e] + ((tot[e] + 255) & ~255);
    int run[8];
#pragma unroll
    for (int e = 0; e < 8; ++e) run[e] = seg[e] + pre[e];
    const unsigned long long ltmask = (1ull << C.lane) - 1ull;
    for (int base = 0; base < RPB * 2; base += 64) {
        const int idx = base + C.lane, token = row0 + (idx >> 1), choice = idx & 1;
        const int ex = TOPE[2 * token + choice]; const float gate = TOPG[2 * token + choice]; int slot = 0;
#pragma unroll
        for (int e = 0; e < 8; ++e) { const unsigned long long mk = __builtin_amdgcn_ballot_w64(ex == e); if (ex == e) slot = run[e] + __popcll(mk & ltmask); run[e] += __popcll(mk); }
        SLOTTOK[slot] = token; SLOTGATE[slot] = gate; TOKSLOT[2 * token + choice] = slot;
    }
    if (blk < 8) {
        int lo = 0, hi = 0;
#pragma unroll
        for (int e = 0; e < 8; ++e) if (e == blk) { lo = seg[e] + tot[e]; hi = seg[e + 1]; }
        for (int s = lo + C.lane; s < hi; s += 64) { SLOTTOK[s] = 0; SLOTGATE[s] = 0.f; }
    }
    if (blk == 0 && C.lane == 0) {
#pragma unroll
        for (int e = 0; e < 9; ++e) C.ctl[CW_SEG + e] = (unsigned)seg[e];
    }
}

#ifndef MK_PER_PHASE
#define MK_PER_PHASE 0
#endif
#ifndef PH_ENABLE
#define PH_ENABLE 0xFFFF
#endif
constexpr int PH_PER_LAYER = 12, N_PHASES = 1 + DEPTH * PH_PER_LAYER;

__global__ void __launch_bounds__(NTHR, 2) fwd_kernel(Args args) {
    extern __shared__ __attribute__((aligned(16))) unsigned char lds_raw[];
    LAS unsigned char* const lds = (LAS unsigned char*)lds_raw;
    volatile LAS unsigned* MISC = (volatile LAS unsigned*)(lds + MISC_OFF);
    for (int u = threadIdx.x; u < (LDS_BYTES - LDSCTL_OFF) / 4; u += NTHR) ((LAS unsigned*)(lds + LDSCTL_OFF))[u] = 0u;
    __syncthreads();
    const int wave0 = __builtin_amdgcn_readfirstlane((int)threadIdx.x >> 6);
    XcdBarrier bar; bar.bar = (unsigned*)(args.ws + WS_CTL) + CW_BAR; bar.x = 0; bar.st = nullptr;
    if (!MK_PER_PHASE) bar = xcd_barrier_post((unsigned*)(args.ws + WS_CTL) + CW_BAR, MISC + 8, wave0);
    const int lo = args.ph_lo, hi = args.ph_hi;
#define IN(k) (lo <= (k) && (k) < hi)
#define EN(p) ((PH_ENABLE >> (p)) & 1)
#define SEAM(k) do { if (IN((k) + 1)) { if (!MK_PER_PHASE) { unsigned long long bw0_ = 0ull; if (PROBE_ON(14)) bw0_ = __builtin_amdgcn_s_memrealtime(); xcd_barrier<false>(bar, wave0); if ((REP_MASK >> 13) & 1) xcd_barrier<false>(bar, wave0); \
        if (PROBE_ON(14)) { const unsigned long long bw1_ = __builtin_amdgcn_s_memrealtime(), bd_ = bw1_ - bw0_; while (__builtin_amdgcn_s_memrealtime() - bw1_ < bd_) __builtin_amdgcn_s_sleep(8); } \
        if (PROBE_ON(13)) { const unsigned long long bw1_ = __builtin_amdgcn_s_memrealtime(); while (__builtin_amdgcn_s_memrealtime() - bw1_ < 2000ull) __builtin_amdgcn_s_sleep(8); } } } } while (0)
#define SEAM0(k) do { if (IN((k) + 1)) { if (!MK_PER_PHASE) xcd_barrier<true>(bar, wave0); } } while (0)
#define PHASE_CTX kargs_t A = opaque_args(); Ctx C = make_ctx(A, lds, wave0); unsigned char* sc = C.ws + WS_SCR; (void)sc

    PT0(15); if (EN(15) && IN(0)) { PHASE_CTX; p0_prologue(C, A); }
    PEND(15, SEAM0(0));

    for (int layer = 0; layer < DEPTH; ++layer) {
        const int P = 1 + layer * PH_PER_LAYER;
#ifdef FORCE_MOE
        const bool moe = FORCE_MOE != 0;
#else
        const bool moe = (layer & 1) != 0;
#endif
        if (EN(0) && IN(P + 0)) { PT0(0);
            PHASE_CTX;
            pg8::DenseOrder S{(const bf16*)(C.ws + WS_XB), (const bf16*)(C.ws + WS_WIN) + (size_t)layer * NP1 * DM, DM, DM, M / 256, NP1 / 256, C.G, C.bx, REPN(0)};
            EpiInProj E{(bf16*)(sc + SC_CQKV), (bf16*)(sc + SC_CQKV) + (size_t)M * 256, (float*)(sc + SC_KR), (float*)(sc + SC_FL), (bf16*)(sc + SC_FQ), (bf16*)(sc + SC_CI)};
            if (C.bx >= C.G / 2) { ffn_weights(C, A, layer, (C.bx - C.G / 2) * NWAVES + C.wave, (C.G / 2) * NWAVES, 0, ffn_split(layer)); __syncthreads(); }
            pg8::gemm_phase<EpiInProj, pg8::DenseOrder, false, DM, DM, DM>(C.lds, C.tid, S, E);
            PEND(0, SEAM(P + 0));
        }
        if (EN(1) && IN(P + 1)) { PT0(1); PHASE_CTX; p2_thin(C, A, layer); PEND(1, SEAM(P + 1)); }
        if (EN(2) && IN(P + 2)) { PT0(2);
            PHASE_CTX;
            struct QkvOrder { const bf16* A; const bf16* Bt; int G, c, rep;
                __device__ __forceinline__ bool next(int i, pg8::Unit& u) const { return pg8::tile_order_rep(i, G, c, M / 256, 7, rep, u.pm, u.pn); }
                __device__ __forceinline__ const char* a_base(const pg8::Unit& u) const { return (const char*)(A + (u.pn < 3 ? (size_t)0 : (size_t)M * 256)) + (size_t)u.pm * 256 * 256 * 2; }
                __device__ __forceinline__ const char* b_base(const pg8::Unit& u) const { return (const char*)Bt + (size_t)u.pn * 256 * 256 * 2; }
                __device__ __forceinline__ int tok(const pg8::Unit&, int) const { return 0; }
                __device__ __forceinline__ int ktiles(const pg8::Unit& u, int nt) const { return u.pn < 3 ? nt : nt / 2; } };
            QkvOrder S{(const bf16*)(sc + SC_CQKV), (const bf16*)(C.ws + WS_WQ2) + (size_t)layer * NP1 * 256, C.G, C.bx, REPN(2)};
            EpiQKV E{(bf16*)(sc + SC_QM), (bf16*)(sc + SC_KM), (bf16*)(sc + SC_VM), (const float*)(C.ws + WS_TAB), (const float*)(C.ws + WS_TAB) + (size_t)M * 16};
            pg8::gemm_phase<EpiQKV, QkvOrder, false, 256, 256, 256>(C.lds, C.tid, S, E);
            PEND(2, SEAM(P + 2));
        }
        if (EN(3) && IN(P + 3)) { PT0(3);
            PHASE_CTX;
            bf16* MIXED = (bf16*)(sc + SC_MIXED);
            for (int p = C.vcu; p < 512; p += C.G) { const int bh = p >> 3, s = p & 7;
                for (int i = 0; i < 2; ++i) att::attn_unit<96, false>(bh >> 3, bh & 7, i == 0 ? 15 - s : s, (const bf16*)(sc + SC_QM), 768, (const bf16*)(sc + SC_KM), 768, (const bf16*)(sc + SC_VM), 512, MIXED, 1024, (bh & 7) * 64, nullptr, C.lds, C.tid, (float*)(sc + SC_SSQ), bh & 7, nullptr);
            }
            { volatile LAS unsigned* qw = (volatile LAS unsigned*)(C.lds + RING_BYTES + 8192); const int xb = C.bx & 7; unsigned* qctr = C.ctl + CW_ATTQ + layer * 8 + xb;
              const bf16* FQ = (const bf16*)(sc + SC_FQ);
              for (;;) {
                if (C.tid == 0) qw[0] = __hip_atomic_fetch_add(qctr, 1u, RLX_AGENT);
                asm volatile("s_waitcnt vmcnt(0) lgkmcnt(0)\n\ts_barrier" ::: "memory");
                const int idx = __builtin_amdgcn_readfirstlane((int)qw[0]);
                if (idx >= 64) break;
                const int hd = idx & 3, qb = 15 - (idx >> 2), bh = xb * 4 + hd;
                att::attn_unit<64, true>(xb, hd, qb, FQ, 256, FQ + (size_t)M * 256, 256, FQ + (size_t)2 * M * 256, 256, MIXED, 1024, 512 + hd * 64, (const float*)(sc + SC_CUM), C.lds, C.tid, (float*)(sc + SC_SSQ), 8 + hd, C.ctl + CW_QKMAX + layer * 64 + bh * 2);
              }
            }
            PEND(3, SEAM(P + 3));
        }
        if (EN(5) && IN(P + 5)) { PT0(5);
            PHASE_CTX;
            pg8::DenseOrder S{(const bf16*)(sc + SC_MIXED), (const bf16*)(C.ws + WS_WOUT) + (size_t)layer * DM * DM, DM, DM, M / 256, DM / 256, C.G, C.bx, REPN(5)};
            EpiBf16<DM, false> E{(bf16*)(sc + SC_MIXOUT), DM / 256, nullptr};
            pg8::gemm_phase<EpiBf16<DM, false>, pg8::DenseOrder, false, DM, DM, DM, true>(C.lds, C.tid, S, E, (const float*)(sc + SC_SSQ));
            PEND(5, SEAM(P + 5));
        }
        if (EN(6) && IN(P + 6)) { PT0(6);
            if (moe) { PHASE_CTX; ln_pass<1>(C, false, (const bf16*)(sc + SC_MIXOUT), A->in[15] + layer * DM, A->in[16] + layer * DM, A->in[20] + (size_t)(layer >> 1) * DM * NEXP); }
            else     { PHASE_CTX; ln_pass<0>(C, false, (const bf16*)(sc + SC_MIXOUT), A->in[15] + layer * DM, A->in[16] + layer * DM, nullptr); }
            PEND(6, SEAM(P + 6));
        }
        if (EN(7) && IN(P + 7) && moe) { PT0(7); { PHASE_CTX; moe_assign(C); } PEND(7, SEAM(P + 7)); }
        if (EN(8) && IN(P + 8)) { PT0(8);
            if (moe) {
                PHASE_CTX; bf16* W13 = (bf16*)(C.ws + WS_WFFN); bf16* HID = (bf16*)(sc + SC_HID);
                const int* seg = (const int*)(C.ctl + CW_SEG);
                const int U = (seg[8] / 256) * 11;
                MoeIdxOrder<11> S{(const bf16*)(C.ws + WS_XB), W13, DM, DM, C.vcu, C.G, (U / C.G) * C.G, (const int*)(C.ws + WS_MOE + MT_SLOTTOK), seg[1], seg[2], seg[3], seg[4], seg[5], seg[6], seg[7]};
                EpiSwiGLU<DFE> E{HID, 11};
                pg8::gemm_phase<EpiSwiGLU<DFE>, MoeIdxOrder<11>, true, DM, DM, DM>(C.lds, C.tid, S, E);
            } else {
                PHASE_CTX; bf16* W13 = (bf16*)(C.ws + WS_WFFN); bf16* HID = (bf16*)(sc + SC_HID);
                pg8::DenseOrder S{(const bf16*)(C.ws + WS_XB), W13, DM, DM, M / 256, 2 * DFF / 256, C.G, C.bx, REPN(8)};
                EpiSwiGLU<DFF> E{HID, 1 << 30};
                pg8::gemm_phase<EpiSwiGLU<DFF>, pg8::DenseOrder, false, DM, DM, DM>(C.lds, C.tid, S, E);
            }
            PEND(8, SEAM(P + 8));
        }
        if (EN(9) && IN(P + 9)) { PT0(9);
            if (moe) {
                { PHASE_CTX; bf16* W13 = (bf16*)(C.ws + WS_WFFN); bf16* HID = (bf16*)(sc + SC_HID); const int* seg = (const int*)(C.ctl + CW_SEG);
                  const int U = (seg[8] / 256) * 11, UF = (U / C.G) * C.G;
                  if (UF + C.vcu < U) {
                      MoeIdxOrder<11> S{(const bf16*)(C.ws + WS_XB), W13, DM, DM, UF + C.vcu, C.G, U, (const int*)(C.ws + WS_MOE + MT_SLOTTOK), seg[1], seg[2], seg[3], seg[4], seg[5], seg[6], seg[7]};
                      EpiSwiGLU<DFE> E{HID, 11};
                      pg8::gemm_phase<EpiSwiGLU<DFE>, MoeIdxOrder<11>, true, DM, DM, DM>(C.lds, C.tid, S, E);
                      if (C.tid == 0) { __builtin_amdgcn_fence(__ATOMIC_RELEASE, "agent"); asm volatile("s_waitcnt vmcnt(0)" ::: "memory"); __hip_atomic_fetch_add(C.ctl + CW_LEFT + layer, 1u, RLX_AGENT); }
                  } }
                { PHASE_CTX; bf16* W2T = (bf16*)(C.ws + WS_WFFN) + WF_W13_ELEMS; bf16* HID = (bf16*)(sc + SC_HID); bf16* FF = (bf16*)(sc + SC_FF); const int* seg = (const int*)(C.ctl + CW_SEG);
                  const int U = (seg[8] / 256) * 11, UF = (U / C.G) * C.G, DF = (UF / 11) * 4;
                  MoeIdxOrder<4> S{HID, W2T, DFE, DFE, C.vcu, C.G, DF, nullptr, seg[1], seg[2], seg[3], seg[4], seg[5], seg[6], seg[7]};
                  EpiBf16<DM, true> E{FF, 4, (const float*)(C.ws + WS_MOE + MT_SLOTGATE)};
                  pg8::gemm_phase<EpiBf16<DM, true>, MoeIdxOrder<4>, false, DFE, DFE, DFE>(C.lds, C.tid, S, E); }
                { PHASE_CTX; bf16* W2T = (bf16*)(C.ws + WS_WFFN) + WF_W13_ELEMS; bf16* HID = (bf16*)(sc + SC_HID); bf16* FF = (bf16*)(sc + SC_FF); const int* seg = (const int*)(C.ctl + CW_SEG);
                  const int nM = seg[8] / 256, U = nM * 11, UF = (U / C.G) * C.G, DF = (UF / 11) * 4;
                  if (DF + (C.G - 1 - C.vcu) < nM * 4) {
                      if (C.wave == 0) { const unsigned need = (unsigned)(U - UF); unsigned* cw = C.ctl + CW_LEFT + layer;
                          while ((unsigned)__builtin_amdgcn_readfirstlane((int)__hip_atomic_load(cw, RLX_AGENT)) < need) __builtin_amdgcn_s_sleep(4);
                          __builtin_amdgcn_fence(__ATOMIC_ACQUIRE, "agent"); asm volatile("s_waitcnt vmcnt(0)" ::: "memory"); }
                      __syncthreads();
                      MoeIdxOrder<4> S{HID, W2T, DFE, DFE, DF + (C.G - 1 - C.vcu), C.G, nM * 4, nullptr, seg[1], seg[2], seg[3], seg[4], seg[5], seg[6], seg[7]};
                      EpiBf16<DM, true> E{FF, 4, (const float*)(C.ws + WS_MOE + MT_SLOTGATE)};
                      pg8::gemm_phase<EpiBf16<DM, true>, MoeIdxOrder<4>, false, DFE, DFE, DFE>(C.lds, C.tid, S, E);
                  } }
            } else {
                PHASE_CTX; bf16* W2T = (bf16*)(C.ws + WS_WFFN) + WF_W13_ELEMS; bf16* HID = (bf16*)(sc + SC_HID); bf16* FF = (bf16*)(sc + SC_FF);
                pg8::DenseOrder S{HID, W2T, DFF, DFF, M / 256, DM / 256, C.G, C.bx, REPN(9)};
                EpiBf16<DM, false> E{FF, DM / 256, nullptr};
                pg8::gemm_phase<EpiBf16<DM, false>, pg8::DenseOrder, false, DFF, DFF, DFF>(C.lds, C.tid, S, E);
            }
            PEND(9, SEAM(P + 9));
        }
        if (EN(10) && IN(P + 10)) { PT0(10);
            if (moe) { PHASE_CTX; ln_pass<2>(C, layer == DEPTH - 1, (const bf16*)(sc + SC_FF), A->in[24] + layer * DM, A->in[25] + layer * DM, nullptr); }
            else     { PHASE_CTX; ln_pass<0>(C, layer == DEPTH - 1, (const bf16*)(sc + SC_FF), A->in[24] + layer * DM, A->in[25] + layer * DM, nullptr); }
            PEND(10, if (layer < DEPTH - 1) SEAM(P + 10));
        }
    }
#undef IN
#undef SEAM
}

extern "C" void kernel_launch(void* const* d_in, const int* in_sizes, int n_in, void* d_out, int out_size, void* d_ws, size_t ws_size, hipStream_t stream) {
    static int grid = 0;
    if (grid == 0) {
        if (n_in != 26 || out_size != M * DM || ws_size < WS_END) { fprintf(stderr, "kernel_launch: unexpected problem (n_in %d, out %d, ws %zu < %zu)\n", n_in, out_size, ws_size, (size_t)WS_END); grid = -1; return; }
        int dev = 0, cus = 0, per_cu = 0;
        if (hipGetDevice(&dev) != hipSuccess || hipDeviceGetAttribute(&cus, hipDeviceAttributeMultiprocessorCount, dev) != hipSuccess) { grid = -1; return; }
        if (hipFuncSetAttribute((const void*)fwd_kernel, hipFuncAttributeMaxDynamicSharedMemorySize, LDS_BYTES) != hipSuccess) { fprintf(stderr, "kernel_launch: hipFuncSetAttribute failed\n"); grid = -1; return; }
        if (hipOccupancyMaxActiveBlocksPerMultiprocessor(&per_cu, (const void*)fwd_kernel, NTHR, LDS_BYTES) != hipSuccess || per_cu < 1) fprintf(stderr, "kernel_launch: occupancy query says %d\n", per_cu);
        (void)hipGetLastError();
        grid = 256; while (grid > cus && grid > 8) grid >>= 1;
    }
    if (grid < 0) return;
    (void)hipMemsetAsync((char*)d_ws + WS_CTL, 0, CTL_ZERO_BYTES, stream);
    Args a{};
    for (int i = 0; i < 26; ++i) a.in[i] = (const float*)d_in[i];
    a.out = (float*)d_out; a.ws = (unsigned char*)d_ws;
#if MK_PER_PHASE
    for (int p = 0; p < N_PHASES; ++p) { a.ph_lo = p; a.ph_hi = p + 1; hipLaunchKernelGGL(fwd_kernel, dim3(grid), dim3(NTHR), LDS_BYTES, stream, a); }
#else
    a.ph_lo = 0; a.ph_hi = N_PHASES;
    hipLaunchKernelGGL(fwd_kernel, dim3(grid), dim3(NTHR), LDS_BYTES, stream, a);
#endif
}
```

```cpp
#include <hip/hip_runtime.h>
#include <cstdio>
#include <cstdint>
#include <cmath>

#ifndef REP_MASK
#define REP_MASK 0x0
#endif
#ifndef PROBE_MASK
#define PROBE_MASK 0x0
#endif
#define PROBE_ON(k) ((PROBE_MASK >> (k)) & 1)
#define PT0(k) unsigned long long pt0_ = 0ull; if (PROBE_ON(k)) pt0_ = __builtin_amdgcn_s_memrealtime()
#ifndef PROBE_BEFORE
#define PROBE_BEFORE 0
#endif
#define PSPIN(d) do { const unsigned long long pt1_ = __builtin_amdgcn_s_memrealtime(); while (__builtin_amdgcn_s_memrealtime() - pt1_ < (d)) __builtin_amdgcn_s_sleep(8); } while (0)
#define PEND(k, seamexpr) do { unsigned long long pd_ = 0ull; if (PROBE_ON(k)) { pd_ = __builtin_amdgcn_s_memrealtime() - pt0_; if (PROBE_BEFORE) PSPIN(pd_); } seamexpr; \
        if (PROBE_ON(k) && !PROBE_BEFORE) PSPIN(pd_); } while (0)
#define REPN(p) (1 + ((REP_MASK >> (p)) & 1))
#define REPS(p) for (int rep_ = 0; rep_ < 1 + ((REP_MASK >> (p)) & 1); ++rep_)
#define GAS __attribute__((address_space(1)))
#define LAS __attribute__((address_space(3)))
typedef unsigned short bf16;
typedef short bf16x8 __attribute__((ext_vector_type(8)));
typedef short s16x4 __attribute__((ext_vector_type(4)));
typedef float f32x2 __attribute__((ext_vector_type(2)));
typedef float f32x4 __attribute__((ext_vector_type(4)));
typedef float f32x16 __attribute__((ext_vector_type(16)));
typedef unsigned u32x2 __attribute__((ext_vector_type(2)));
typedef unsigned u32x4 __attribute__((ext_vector_type(4)));
typedef __bf16 bf16x2_t __attribute__((ext_vector_type(2)));

constexpr int BATCH = 8, SEQ = 4096, DM = 1024, M = BATCH * SEQ, DEPTH = 4;
constexpr int IN_COLS = 1700, NP1 = 1792;
constexpr int DFF = 2816, DFE = 1408, NEXP = 8;
constexpr int NWAVES = 8, NTHR = 512;
constexpr float ALPHA = 1.6817928305074290f;
constexpr float EPS = 1e-5f;
constexpr float LOG2E = 1.4426950408889634f;
constexpr float C2_MLA = 0.10206207261596577f * LOG2E;
constexpr float C2_FOX = 0.125f * LOG2E;
constexpr int PC_CQ = 0, PC_CKV = 256, PC_KR = 384, PC_FL = 416, PC_FQ = 512, PC_FK = 768, PC_FV = 1024, PC_CI = 1280;
constexpr int MOE_ROWS_MAX = 2 * M + NEXP * 256;

constexpr size_t MiB = 1u << 20;
constexpr size_t WS_CTL = 0, CTL_ZERO_BYTES = 1 * MiB;
constexpr size_t WS_WIN = 1 * MiB;
constexpr size_t WS_WQ2 = WS_WIN + 14 * MiB;
constexpr size_t WS_WOUT = WS_WQ2 + 4 * MiB;
constexpr size_t WS_TAB = WS_WOUT + 8 * MiB;
constexpr size_t WS_MOE = WS_TAB + 4 * MiB;
constexpr size_t WS_WFFN = WS_MOE + 2 * MiB;
constexpr size_t WS_XB = WS_WFFN + 68 * MiB;
constexpr size_t WS_SCR = WS_XB + 64 * MiB;
constexpr size_t SC_CQKV = 0;
constexpr size_t SC_KR = SC_CQKV + 32 * MiB;
constexpr size_t SC_FL = SC_KR + 4 * MiB;
constexpr size_t SC_CUM = SC_FL + MiB / 2;
constexpr size_t SC_FQ = SC_CUM + MiB / 2;
constexpr size_t SC_CI = SC_FQ + 48 * MiB;
constexpr size_t SC_QM = SC_CI + 32 * MiB;
constexpr size_t SC_KM = SC_QM + 48 * MiB;
constexpr size_t SC_VM = SC_KM + 48 * MiB;
constexpr size_t SC_MIXED = SC_VM + 32 * MiB;
constexpr size_t SC_MIXOUT = SC_QM;
constexpr size_t SC_SSQ = SC_MIXED + 64 * MiB;
constexpr size_t SC_MIX_END = SC_SSQ + 2 * MiB;
constexpr size_t SC_HID = 0;
constexpr size_t SC_FF = 182 * MiB;
constexpr size_t SC_END = 316 * MiB;
constexpr size_t WS_END = WS_SCR + SC_END;
static_assert(SC_MIX_END <= SC_END && SC_FF + (size_t)MOE_ROWS_MAX * 1024 * 2 <= SC_END && (size_t)MOE_ROWS_MAX * DFE * 2 <= SC_FF, "scratch map");
static_assert(WS_END <= 512 * MiB, "workspace map");
constexpr size_t WF_W13_ELEMS = (size_t)NEXP * 2 * DFE * DM;
constexpr size_t MT_TOPE = 0;
constexpr size_t MT_TOPG = 256 * 1024;
constexpr size_t MT_TOKSLOT = 512 * 1024;
constexpr size_t MT_SLOTTOK = 768 * 1024;
constexpr size_t MT_SLOTGATE = 768 * 1024 + 272 * 1024;
static_assert((size_t)MOE_ROWS_MAX * 4 <= 272 * 1024 && MT_SLOTGATE + 272 * 1024 <= 2 * MiB, "moe tables");
constexpr int CW_BAR = 4096;
constexpr int CW_CNTB = 16384;
constexpr int CW_SEG = 20480;
constexpr int CW_ATTQ = 2048;
constexpr int CW_LEFT = 2112;
constexpr int CW_QKMAX = 1024;

constexpr int RING_BYTES = 131072;
constexpr int LDSCTL_OFF = RING_BYTES, MISC_OFF = LDSCTL_OFF + 320;
constexpr int LDS_BYTES = 147456;

#define RLX_AGENT __ATOMIC_RELAXED, __HIP_MEMORY_SCOPE_AGENT
__device__ __forceinline__ unsigned pk2(float lo, float hi) { f32x2 v = {lo, hi}; bf16x2_t b = __builtin_convertvector(v, bf16x2_t); return __builtin_bit_cast(unsigned, b); }
__device__ __forceinline__ float bf2f(unsigned short u) { return __uint_as_float((unsigned)u << 16); }
__device__ __forceinline__ float bflo(unsigned u) { return __uint_as_float(u << 16); }
__device__ __forceinline__ float bfhi(unsigned u) { return __uint_as_float(u & 0xffff0000u); }
__device__ __forceinline__ float fexp2(float x) { return __builtin_amdgcn_exp2f(x); }
__device__ __forceinline__ float frcp(float x) { return __builtin_amdgcn_rcpf(x); }
__device__ __forceinline__ float sigmoidf_(float x) { return frcp(1.0f + fexp2(-x * LOG2E)); }
__device__ __forceinline__ float siluf_(float x) { return x * sigmoidf_(x); }
template <int O> __device__ __forceinline__ float lane_xor(float v) {
    if constexpr (O < 32) return __int_as_float(__builtin_amdgcn_ds_swizzle(__float_as_int(v), (O << 10) | 0x1f));
    else { auto rr = __builtin_amdgcn_permlane32_swap(__float_as_uint(v), __float_as_uint(v), false, false); return __uint_as_float(rr[0]) == v ? __uint_as_float(rr[1]) : __uint_as_float(rr[0]); }
}
__device__ __forceinline__ float wave_sum(float v) {
    v += lane_xor<1>(v); v += lane_xor<2>(v); v += lane_xor<4>(v); v += lane_xor<8>(v); v += lane_xor<16>(v);
    { auto rr = __builtin_amdgcn_permlane32_swap(__float_as_uint(v), __float_as_uint(v), false, false); v = __uint_as_float(rr[0]) + __uint_as_float(rr[1]); }
    return v;
}
__device__ __forceinline__ int wave_sum_i(int v) {
    v += __builtin_amdgcn_ds_swizzle(v, (1 << 10) | 0x1f); v += __builtin_amdgcn_ds_swizzle(v, (2 << 10) | 0x1f); v += __builtin_amdgcn_ds_swizzle(v, (4 << 10) | 0x1f);
    v += __builtin_amdgcn_ds_swizzle(v, (8 << 10) | 0x1f); v += __builtin_amdgcn_ds_swizzle(v, (16 << 10) | 0x1f);
    { auto rr = __builtin_amdgcn_permlane32_swap((unsigned)v, (unsigned)v, false, false); v = (int)(rr[0] + rr[1]); }
    return v;
}
__device__ __forceinline__ u32x4 pack8(const f32x4 a, const f32x4 b) { u32x4 w; w.x = pk2(a[0], a[1]); w.y = pk2(a[2], a[3]); w.z = pk2(b[0], b[1]); w.w = pk2(b[2], b[3]); return w; }

#define XB_TMO      128
#define XB_XCNT(j)  (256  + 64 * (j))
#define XB_XSUB(j)  (1280 + 64 * (j))
#define XB_XGEN(j)  (2304 + 64 * (j))
#define XB_TOP      3328
#define XB_TOPGEN   3392
#define XCD_BAR_WORDS 3456
#define XB_SPIN_CAP (1u << 18)
__device__ __forceinline__ unsigned xb_ld(unsigned* p)              { return __hip_atomic_load(p, __ATOMIC_RELAXED, __HIP_MEMORY_SCOPE_AGENT); }
__device__ __forceinline__ unsigned xb_add(unsigned* p, unsigned v) { return __hip_atomic_fetch_add(p, v, __ATOMIC_RELAXED, __HIP_MEMORY_SCOPE_AGENT); }
__device__ __forceinline__ unsigned xb_xcc_id() { return (unsigned)__builtin_amdgcn_s_getreg((3 << 11) | 20) & 0xFu; }
#define XB_SPIN(cond, bar) do { unsigned _sp = 0; while (cond) { __builtin_amdgcn_s_sleep(1); \
    if ((++_sp & 255u) == 0u) { if (xb_ld(&(bar)[XB_TMO])) break; if (_sp > XB_SPIN_CAP) { atomicAdd(&(bar)[XB_TMO], 1u); break; } } } } while (0)
struct XcdBarrier { unsigned* bar; unsigned x; volatile LAS unsigned* st; };
__device__ __forceinline__ bool xb_is_t0(int wave0) { unsigned ones = ~0u; asm volatile("" : "+s"(ones)); return wave0 == 0 && __builtin_amdgcn_mbcnt_hi(ones, __builtin_amdgcn_mbcnt_lo(ones, 0u)) == 0u; }
__device__ __forceinline__ XcdBarrier xcd_barrier_post(unsigned* bar, volatile LAS unsigned* st, int wave0) {
    XcdBarrier b; b.bar = bar; b.x = xb_xcc_id(); b.st = st;
    if (xb_is_t0(wave0)) (void)xb_add(&bar[XB_XCNT(b.x)], 1u);
    return b;
}
__device__ __forceinline__ void xcd_barrier_complete(unsigned* bar, unsigned x, unsigned& nloc, unsigned& nx) {
    const unsigned G = gridDim.x * gridDim.y * gridDim.z;
    unsigned sum, cnt, mine, sp = 0u;
    for (;;) {
        sum = 0u; cnt = 0u; mine = 0u;
#pragma unroll
        for (unsigned j = 0; j < 16; ++j) { const unsigned c = xb_ld(&bar[XB_XCNT(j)]); sum += c; cnt += (c > 0u) ? 1u : 0u; mine = (j == x) ? c : mine; }
        if (sum == G) break;
        __builtin_amdgcn_s_sleep(1);
        if ((++sp & 255u) == 0u) { if (xb_ld(&bar[XB_TMO])) break; if (sp > XB_SPIN_CAP) { atomicAdd(&bar[XB_TMO], 1u); break; } }
    }
    nloc = mine > 0u ? mine : 1u; nx = cnt > 0u ? cnt : 1u;
}
template <bool FIRST>
__device__ __forceinline__ void xcd_barrier(const XcdBarrier& b, int wave0) {
    asm volatile("s_waitcnt vmcnt(0)" ::: "memory");
    __syncthreads();
    if (xb_is_t0(wave0)) {
        unsigned* bar = b.bar;
        __builtin_amdgcn_s_waitcnt(0);
        unsigned nloc = b.st[0], nx = b.st[1];
        if constexpr (FIRST) { if (nloc == 0u) { xcd_barrier_complete(bar, b.x, nloc, nx); b.st[0] = nloc; b.st[1] = nx; } }
        const unsigned old = xb_add(&bar[XB_XSUB(b.x)], 1u);
        const unsigned gen = old / nloc;
        if (old + 1u == (gen + 1u) * nloc) {
            __builtin_amdgcn_fence(__ATOMIC_RELEASE, "agent");
            asm volatile("s_waitcnt vmcnt(0)" ::: "memory");
            const unsigned og = xb_add(&bar[XB_TOP], 1u);
            const unsigned tg = og / nx;
            if (og + 1u == (tg + 1u) * nx) xb_add(&bar[XB_TOPGEN], 1u);
            else XB_SPIN(xb_ld(&bar[XB_TOPGEN]) == tg, bar);
            __builtin_amdgcn_fence(__ATOMIC_ACQUIRE, "agent");
            xb_add(&bar[XB_XGEN(b.x)], 1u);
            asm volatile("s_waitcnt vmcnt(0)" ::: "memory");
        } else {
            XB_SPIN(xb_ld(&bar[XB_XGEN(b.x)]) == gen, bar);
            __builtin_amdgcn_fence(__ATOMIC_ACQUIRE, "agent");
            asm volatile("s_waitcnt vmcnt(0)" ::: "memory");
        }
    }
    __syncthreads();
}

namespace pg8 {
constexpr int BM = 256, BK = 64, HALF = 128, HTB = HALF * BK * 2, STAGE_BYTES = 8 * HTB, NXCD = 8, WGM = 8;
__host__ __device__ __forceinline__ int lds_byte(int r, int c) { const int st = (r >> 4) * 2 + (c >> 5), rr = r & 15, cc = c & 31, ob = rr * 64 + cc * 2; return st * 1024 + (ob ^ (((ob >> 9) & 1) << 5)); }
__host__ __device__ __forceinline__ void stage_rc(int b, int& R, int& C) { const int st = b / 1024, sb = b % 1024, swz = sb ^ (((sb >> 9) & 1) << 5); R = (st >> 1) * 16 + swz / 64; C = (st & 1) * 32 + (swz % 64) / 2; }
__host__ __device__ __forceinline__ int perm32(int rho) { const int n = rho >> 4, i = rho & 15; return 8 * (i >> 2) + 4 * n + (i & 3); }
struct Unit { int pm, pn; };

__device__ __forceinline__ bool tile_order(long L, int nM, int nN, int& pm, int& pn) {
    const int nwg = nM * nN; if (L >= nwg) return false;
    int wgid = (int)L; { const int q = nwg / NXCD, r = nwg % NXCD, xcd = wgid % NXCD, off = wgid / NXCD; wgid = (xcd < r ? xcd * (q + 1) : r * (q + 1) + (xcd - r) * q) + off; }
    const int nig = WGM * nN, gid = wgid / nig, fm = gid * WGM, gsz = (nM - fm) < WGM ? (nM - fm) : WGM;
    pm = fm + ((wgid % nig) % gsz); pn = (wgid % nig) / gsz; return true;
}
__device__ __forceinline__ bool tile_order_rep(int i, int G, int c, int nM, int nN, int rep, int& pm, int& pn) {
    if (rep == 1) return tile_order((long)i * G + c, nM, nN, pm, pn);
    const int nwg = nM * nN, per = c < nwg ? (nwg - c + G - 1) / G : 0; if (i >= per * rep) return false;
    return tile_order((long)(i % per) * G + c, nM, nN, pm, pn);
}
struct DenseOrder {
    const bf16* A; const bf16* Bt; int lda, ldb, nM, nN, G, c, rep;
    __device__ __forceinline__ bool next(int i, Unit& u) const { return tile_order_rep(i, G, c, nM, nN, rep, u.pm, u.pn); }
    __device__ __forceinline__ const char* a_base(const Unit& u) const { return (const char*)A + (size_t)u.pm * BM * lda * 2; }
    __device__ __forceinline__ const char* b_base(const Unit& u) const { return (const char*)Bt + (size_t)u.pn * BM * ldb * 2; }
    __device__ __forceinline__ int tok(const Unit&, int) const { return 0; }
    __device__ __forceinline__ int ktiles(const Unit&, int nt) const { return nt; }
};

template <class Epi, class Sched, bool GATHER, int K, int lda, int ldb, bool SEGSCALE = false>
__device__ __forceinline__ void gemm_phase(LAS unsigned char* lds, const int tid, const Sched& S, const Epi& E, const float* ssq = nullptr) {
    const int wid = __builtin_amdgcn_readfirstlane(tid >> 6), lane = tid & 63, wr = wid >> 2, wc = wid & 3, fr = lane & 15, fq = lane >> 4;
    constexpr int nt = K / BK;
    unsigned voffA[2], voffB[2];
#pragma unroll
    for (int i = 0; i < 2; ++i) { int R, C; stage_rc(tid * 16 + i * 8192, R, C); const int Rb = Epi::PERM ? ((R & ~31) + perm32(R & 31)) : R;
        voffA[i] = (unsigned)(R * lda + C) * 2u; voffB[i] = (unsigned)(Rb * ldb + C) * 2u; }
#define PG8_GOFF(u_, h_, o0_, o1_) do { unsigned ones_ = ~0u; asm volatile("" : "+s"(ones_)); const int t_ = wid * 64 + (int)__builtin_amdgcn_mbcnt_hi(ones_, __builtin_amdgcn_mbcnt_lo(ones_, 0u)); \
        int R0_, C0_, R1_, C1_; stage_rc(t_ * 16, R0_, C0_); stage_rc(t_ * 16 + 8192, R1_, C1_); \
        o0_ = (unsigned)S.tok(u_, (h_) * HALF + R0_) * (unsigned)(lda * 2) + (unsigned)(C0_ * 2); o1_ = (unsigned)S.tok(u_, (h_) * HALF + R1_) * (unsigned)(lda * 2) + (unsigned)(C1_ * 2); } while (0)
    const size_t kstep = (size_t)(BK * 2);
    constexpr size_t hstepA = (size_t)HALF * lda * 2, hstepB = (size_t)HALF * ldb * 2;
    const unsigned ldsw = (unsigned)wid * 1024u;
    const int aoff = lds_byte(wr * 64 + fr, fq * 8), boff = lds_byte(wc * 32 + fr, fq * 8);
#define PG8_SA(b, h) (((b) * 2 + (h)) * HTB)
#define PG8_SB(b, h) ((4 + (b) * 2 + (h)) * HTB)
#define PG8_STAGE(bufoff, gbase, v0, v1) do { \
        __builtin_amdgcn_global_load_lds((const unsigned*)((const char*)(gbase) + (v0)), (LAS unsigned*)(lds + (bufoff) + ldsw), 16, 0, 0); \
        __builtin_amdgcn_global_load_lds((const unsigned*)((const char*)(gbase) + (v1)), (LAS unsigned*)(lds + (bufoff) + ldsw + 8192), 16, 0, 0); } while (0)
#define PG8_STB(bufoff, gbase) PG8_STAGE(bufoff, gbase, voffB[0], voffB[1])
#define PG8_STA(bufoff, gbase, h, G0, G1) do { if constexpr (GATHER) PG8_STAGE(bufoff, gbase, G0, G1); else PG8_STAGE(bufoff, (gbase) + (h) * hstepA, voffA[0], voffA[1]); } while (0)
#define PG8_LDA(dst, b, h) do { _Pragma("unroll") for (int m = 0; m < 4; ++m) _Pragma("unroll") for (int k = 0; k < 2; ++k) dst[m][k] = *(const LAS bf16x8*)(lds + PG8_SA(b, h) + aoff + m * 2048 + k * 1024); } while (0)
#define PG8_LDB(dst, b, h) do { _Pragma("unroll") for (int n = 0; n < 2; ++n) _Pragma("unroll") for (int k = 0; k < 2; ++k) dst[n][k] = *(const LAS bf16x8*)(lds + PG8_SB(b, h) + boff + n * 2048 + k * 1024); } while (0)
#define PG8_MMA(ai, bj, At, Bt) do { __builtin_amdgcn_s_setprio(1); _Pragma("unroll") for (int m = 0; m < 4; ++m) _Pragma("unroll") for (int n = 0; n < 2; ++n) _Pragma("unroll") for (int k = 0; k < 2; ++k) \
        acc[ai][bj][m][n] = __builtin_amdgcn_mfma_f32_16x16x32_bf16(Bt[n][k], At[m][k], acc[ai][bj][m][n], 0, 0, 0); __builtin_amdgcn_s_setprio(0); } while (0)
#define PG8_WAIT_V(n) asm volatile("s_waitcnt vmcnt(" #n ")" ::: "memory")
#define PG8_WAIT_L(n) asm volatile("s_waitcnt lgkmcnt(" #n ")" ::: "memory")
#define PG8_BAR __builtin_amdgcn_s_barrier()
#define PG8_SCHED __builtin_amdgcn_sched_barrier(0)
    Unit cur, nxt; int ui = 0;
    if (!S.next(0, cur)) return;
    f32x4 acc[2][2][4][2];
#pragma unroll
    for (int a = 0; a < 2; ++a)
#pragma unroll
        for (int b = 0; b < 2; ++b)
#pragma unroll
            for (int m = 0; m < 4; ++m)
#pragma unroll
                for (int n = 0; n < 2; ++n) acc[a][b][m][n] = (f32x4){0.f, 0.f, 0.f, 0.f};
    bf16x8 At[4][2], B0[2][2], B1[2][2];
    const char* cA = S.a_base(cur); const char* cB = S.b_base(cur);
    unsigned gc00 = 0, gc01 = 0, gc10 = 0, gc11 = 0, gn00 = 0, gn01 = 0, gn10 = 0, gn11 = 0;
    if constexpr (GATHER) { PG8_GOFF(cur, 0, gc00, gc01); PG8_GOFF(cur, 1, gc10, gc11); }
    PG8_STB(PG8_SB(0, 0), cB); PG8_STB(PG8_SB(0, 1), cB + hstepB); PG8_STA(PG8_SA(0, 0), cA, 0, gc00, gc01); PG8_STA(PG8_SA(0, 1), cA, 1, gc10, gc11);
    if (wr == 1) PG8_BAR;
    PG8_WAIT_V(2); PG8_BAR;
    PG8_STB(PG8_SB(1, 0), cB + kstep); PG8_STA(PG8_SA(1, 0), cA + kstep, 0, gc00, gc01); PG8_STB(PG8_SB(1, 1), cB + hstepB + kstep);
    PG8_WAIT_V(6); PG8_BAR;
    for (;;) {
        const bool has_next = S.next(ui + 1, nxt);
        const char* nA = has_next ? S.a_base(nxt) : cA; const char* nB = has_next ? S.b_base(nxt) : cB;
        if constexpr (SEGSCALE) {
            if (tid < 256) { const f32x4* sp = (const f32x4*)(ssq + (size_t)(cur.pm * 256 + tid) * 12); const f32x4 a = sp[0], b = sp[1], c = sp[2];
                const float sm = ((a[0] + a[1]) + (a[2] + a[3])) + ((b[0] + b[1]) + (b[2] + b[3])), sf = (c[0] + c[1]) + (c[2] + c[3]);
                const float rm = 1.0f / sqrtf(sm * (1.0f / 512) + EPS), rf = 1.0f / sqrtf(sf * (1.0f / 256) + EPS);
                *(LAS f32x2*)(lds + STAGE_BYTES + 1024 + tid * 8) = (f32x2){rm / rf, rf}; }
        }
        if constexpr (GATHER) {
            if (has_next) { PG8_GOFF(nxt, 0, gn00, gn01); PG8_GOFF(nxt, 1, gn10, gn11); }
            else { gn00 = gc00; gn01 = gc01; gn10 = gc10; gn11 = gc11; }
        }
        const int ntu = S.ktiles(cur, nt);
#pragma nounroll
        for (int t = 0; t < ntu; t += 2) {
            const bool last = (t == ntu - 2);
            const char* a1 = cA + (size_t)(t + 1) * kstep;
            const char* a2 = last ? nA : cA + (size_t)(t + 2) * kstep; const char* b2 = last ? nB : cB + (size_t)(t + 2) * kstep;
            const char* a3 = a2 + kstep; const char* b3 = b2 + kstep;
            const unsigned g00 = last ? gn00 : gc00, g01 = last ? gn01 : gc01, g10 = last ? gn10 : gc10, g11 = last ? gn11 : gc11;
            PG8_LDB(B0, 0, 0); PG8_LDB(B1, 0, 1); PG8_SCHED; PG8_LDA(At, 0, 0); PG8_STA(PG8_SA(1, 1), a1, 1, gc10, gc11);
            PG8_WAIT_V(8); PG8_WAIT_L(0); PG8_BAR; PG8_MMA(0, 0, At, B0); PG8_MMA(0, 1, At, B1); PG8_BAR; PG8_SCHED;
            PG8_LDA(At, 0, 1); PG8_STB(PG8_SB(0, 0), b2); PG8_STB(PG8_SB(0, 1), b2 + hstepB); PG8_STA(PG8_SA(0, 0), a2, 0, g00, g01);
            PG8_WAIT_V(8); PG8_WAIT_L(0); PG8_BAR; PG8_MMA(1, 0, At, B0); PG8_MMA(1, 1, At, B1); PG8_BAR; PG8_SCHED;
            PG8_LDB(B0, 1, 0); PG8_LDB(B1, 1, 1); PG8_SCHED; PG8_LDA(At, 1, 0); PG8_STA(PG8_SA(0, 1), a2, 1, g10, g11);
            PG8_WAIT_V(8); PG8_WAIT_L(0); PG8_BAR; PG8_MMA(0, 0, At, B0); PG8_MMA(0, 1, At, B1); PG8_BAR; PG8_SCHED;
            PG8_LDA(At, 1, 1); PG8_STB(PG8_SB(1, 0), b3); PG8_STB(PG8_SB(1, 1), b3 + hstepB); PG8_STA(PG8_SA(1, 0), a3, 0, g00, g01);
            PG8_WAIT_V(8); PG8_WAIT_L(0); PG8_BAR; PG8_MMA(1, 0, At, B0); PG8_MMA(1, 1, At, B1); PG8_BAR; PG8_SCHED;
            if constexpr (SEGSCALE) {
                if (t == 6 || t == 10) {
                    unsigned ones_ = ~0u; asm volatile("" : "+s"(ones_)); const int fr_ = (int)__builtin_amdgcn_mbcnt_hi(ones_, __builtin_amdgcn_mbcnt_lo(ones_, 0u)) & 15;
                    const LAS float* fp = (const LAS float*)(lds + STAGE_BYTES + 1024) + (wr * 64 + fr_) * 2 + (t == 10 ? 1 : 0);
#pragma unroll
                    for (int ai = 0; ai < 2; ++ai)
#pragma unroll
                        for (int m = 0; m < 4; ++m) { const float f = fp[(ai * 128 + m * 16) * 2];
#pragma unroll
                            for (int bj = 0; bj < 2; ++bj)
#pragma unroll
                                for (int n = 0; n < 2; ++n) acc[ai][bj][m][n] *= f; }
                    PG8_SCHED;
                }
            }
        }
        if (wr == 0) PG8_BAR;
        { unsigned ones_ = ~0u; asm volatile("" : "+s"(ones_)); const int l_ = (int)__builtin_amdgcn_mbcnt_hi(ones_, __builtin_amdgcn_mbcnt_lo(ones_, 0u)); E(acc, cur, wr, wc, l_ & 15, l_ >> 4); }
        if (!has_next) break;
#pragma unroll
        for (int a = 0; a < 2; ++a)
#pragma unroll
            for (int b = 0; b < 2; ++b)
#pragma unroll
                for (int m = 0; m < 4; ++m)
#pragma unroll
                    for (int n = 0; n < 2; ++n) acc[a][b][m][n] = (f32x4){0.f, 0.f, 0.f, 0.f};
        cur = nxt; cA = nA; cB = nB; ++ui;
        if constexpr (GATHER) { gc00 = gn00; gc01 = gn01; gc10 = gn10; gc11 = gn11; }
        if (wr == 1) PG8_BAR;
    }
    PG8_WAIT_V(0);
    PG8_BAR;
#undef PG8_GOFF
#undef PG8_SA
#undef PG8_SB
#undef PG8_STAGE
#undef PG8_STB
#undef PG8_STA
#undef PG8_LDA
#undef PG8_LDB
#undef PG8_MMA
#undef PG8_WAIT_V
#undef PG8_WAIT_L
#undef PG8_BAR
#undef PG8_SCHED
}
}

#define EPI_ROWS_BEGIN _Pragma("unroll") for (int ai = 0; ai < 2; ++ai) _Pragma("unroll") for (int m = 0; m < 4; ++m) { const unsigned row = (unsigned)(u.pm * 256 + ai * 128 + wr * 64 + m * 16 + fr);
#define EPI_ROWS_END asm volatile("" ::: "memory"); }
__device__ __forceinline__ void st16(void* base, unsigned off, u32x4 v) { *(u32x4*)((char*)base + off) = v; }
struct EpiInProj {
    static constexpr bool PERM = true;
    bf16* CQ; bf16* CKV; float* KR; float* FL; bf16* FQ; bf16* CI;
    __device__ __forceinline__ void operator()(const f32x4 (&acc)[2][2][4][2], const pg8::Unit& u, int wr, int wc, int fr, int fq) const {
        const int t = u.pn; const unsigned c8 = (unsigned)(wc * 32 + 8 * fq);
        if (t != 1) {
            bf16* base; unsigned ld;
            if (t >= 5) {
                bf16* hb = CI + (t - 5) * 128;
                EPI_ROWS_BEGIN
                    f32x4 a0 = acc[ai][0][m][0], a1 = acc[ai][0][m][1]; const f32x4 g0 = acc[ai][1][m][0], g1 = acc[ai][1][m][1];
#pragma unroll
                    for (int j = 0; j < 4; ++j) { a0[j] *= sigmoidf_(g0[j]); a1[j] *= sigmoidf_(g1[j]); }
                    st16(hb, (row * 256u + c8) * 2u, pack8(a0, a1));
                EPI_ROWS_END
                return;
            }
            if (t == 0) { base = CQ; ld = 256; } else { base = FQ + (size_t)(t - 2) * M * 256; ld = 256; }
            EPI_ROWS_BEGIN
                const unsigned off = (row * ld + c8) * 2u;
                st16(base, off, pack8(acc[ai][0][m][0], acc[ai][0][m][1]));
                st16(base, off + 256u, pack8(acc[ai][1][m][0], acc[ai][1][m][1]));
            EPI_ROWS_END
        } else {
            EPI_ROWS_BEGIN
                const unsigned off = (row * 256u + c8) * 2u;
                st16(CKV, off, pack8(acc[ai][0][m][0], acc[ai][0][m][1]));
                if (c8 < 32) { const unsigned ko = (row * 32u + c8) * 4u; *(f32x4*)((char*)KR + ko) = acc[ai][1][m][0]; *(f32x4*)((char*)KR + ko + 16) = acc[ai][1][m][1]; }
                else if (c8 == 32) { *(f32x4*)((char*)FL + row * 16u) = acc[ai][1][m][0]; }
            EPI_ROWS_END
        }
    }
};
struct EpiQKV {
    static constexpr bool PERM = true;
    bf16* QM; bf16* KM; bf16* VM; const float* COS; const float* SIN;
    __device__ __forceinline__ void operator()(const f32x4 (&acc)[2][2][4][2], const pg8::Unit& u, int wr, int wc, int fr, int fq) const {
        const int t = u.pn; const unsigned c8 = (unsigned)(wc * 32 + 8 * fq);
        if (t < 3) {
#pragma unroll
            for (int bj = 0; bj < 2; ++bj) {
                const unsigned col = (unsigned)(t * 256 + bj * 128) + c8, h = col / 96u, d = col - h * 96u;
                const bool rope = d >= 64; const unsigned f4 = rope ? ((d - 64) >> 1) : 0u;
#pragma unroll
                for (int ai = 0; ai < 2; ++ai) {
                    f32x4 cc[4], ss[4];
                    if (rope) {
#pragma unroll
                        for (int m = 0; m < 4; ++m) { const unsigned to = ((unsigned)(u.pm * 256 + ai * 128 + wr * 64 + m * 16 + fr) * 16u + f4) * 4u;
                            cc[m] = *(const f32x4*)((const char*)COS + to); ss[m] = *(const f32x4*)((const char*)SIN + to); }
                    }
#pragma unroll
                    for (int m = 0; m < 4; ++m) { const unsigned row = (unsigned)(u.pm * 256 + ai * 128 + wr * 64 + m * 16 + fr);
                        f32x4 v0 = acc[ai][bj][m][0], v1 = acc[ai][bj][m][1];
                        if (rope) {
                            const f32x4 c = cc[m], s = ss[m], a = v0, b = v1;
                            v0 = (f32x4){a[0] * c[0] - a[2] * s[0], a[1] * c[1] - a[3] * s[1], a[0] * s[0] + a[2] * c[0], a[1] * s[1] + a[3] * c[1]};
                            v1 = (f32x4){b[0] * c[2] - b[2] * s[2], b[1] * c[3] - b[3] * s[3], b[0] * s[2] + b[2] * c[2], b[1] * s[3] + b[3] * c[3]};
                        }
                        st16(QM, (row * 768u + col) * 2u, pack8(v0, v1));
                    }
                    asm volatile("" ::: "memory");
                }
            }
        } else if (t < 5) {
#pragma unroll
            for (int bj = 0; bj < 2; ++bj) {
                const unsigned kc = (unsigned)((t - 3) * 256 + bj * 128) + c8, h = kc >> 6, d = kc & 63;
                EPI_ROWS_BEGIN
                    st16(KM, (row * 768u + h * 96u + d) * 2u, pack8(acc[ai][bj][m][0], acc[ai][bj][m][1]));
                EPI_ROWS_END
            }
        } else {
#pragma unroll
            for (int bj = 0; bj < 2; ++bj) {
                const unsigned vc = (unsigned)((t - 5) * 256 + bj * 128) + c8;
                EPI_ROWS_BEGIN
                    st16(VM, (row * 512u + vc) * 2u, pack8(acc[ai][bj][m][0], acc[ai][bj][m][1]));
                EPI_ROWS_END
            }
        }
    }
};
template <int LDC, bool SCALE>
struct EpiBf16 {
    static constexpr bool PERM = true;
    bf16* O; int ntn; const float* rowscale;
    __device__ __forceinline__ void operator()(const f32x4 (&acc)[2][2][4][2], const pg8::Unit& u, int wr, int wc, int fr, int fq) const {
        const unsigned col = (unsigned)((u.pn % ntn) * 256 + wc * 32 + 8 * fq);
        float sc8[8];
        if constexpr (SCALE) {
#pragma unroll
            for (int i = 0; i < 8; ++i) sc8[i] = *(const float*)((const char*)rowscale + (unsigned)(u.pm * 256 + (i >> 2) * 128 + wr * 64 + (i & 3) * 16 + fr) * 4u);
        }
        EPI_ROWS_BEGIN
            float s = 1.0f; if constexpr (SCALE) s = sc8[ai * 4 + m];
            const unsigned off = (row * (unsigned)LDC + col) * 2u;
            st16(O, off, pack8(acc[ai][0][m][0] * s, acc[ai][0][m][1] * s));
            st16(O, off + 256u, pack8(acc[ai][1][m][0] * s, acc[ai][1][m][1] * s));
        EPI_ROWS_END
    }
};
template <int LDH>
struct EpiSwiGLU {
    static constexpr bool PERM = true;
    bf16* H; int ntn;
    __device__ __forceinline__ void operator()(const f32x4 (&acc)[2][2][4][2], const pg8::Unit& u, int wr, int wc, int fr, int fq) const {
        const unsigned col = (unsigned)((u.pn % ntn) * 128 + wc * 32 + 8 * fq);
        EPI_ROWS_BEGIN
            f32x4 a0 = acc[ai][0][m][0], a1 = acc[ai][0][m][1]; const f32x4 b0 = acc[ai][1][m][0], b1 = acc[ai][1][m][1];
#pragma unroll
            for (int j = 0; j < 4; ++j) { a0[j] = siluf_(a0[j]) * b0[j]; a1[j] = siluf_(a1[j]) * b1[j]; }
            st16(H, (row * (unsigned)LDH + col) * 2u, pack8(a0, a1));
        EPI_ROWS_END
    }
};
struct MoeOrder {
    const bf16* A; const bf16* Bt; int lda, ldb, nM, nN, G, c, rep; const int* slot_tok; int s1, s2, s3, s4, s5, s6, s7;
    __device__ __forceinline__ int expert_of(int rt) const { const int r = rt * 256; return (r >= s1) + (r >= s2) + (r >= s3) + (r >= s4) + (r >= s5) + (r >= s6) + (r >= s7); }
    __device__ __forceinline__ bool next(int i, pg8::Unit& u) const { int pm, pn; if (!pg8::tile_order_rep(i, G, c, nM, nN, rep, pm, pn)) return false; u.pm = pm; u.pn = expert_of(pm) * nN + pn; return true; }
    __device__ __forceinline__ const char* a_base(const pg8::Unit& u) const { return slot_tok ? (const char*)A : (const char*)A + (size_t)u.pm * 256 * lda * 2; }
    __device__ __forceinline__ const char* b_base(const pg8::Unit& u) const { return (const char*)Bt + (size_t)u.pn * 256 * ldb * 2; }
    __device__ __forceinline__ int tok(const pg8::Unit& u, int r) const { return slot_tok[u.pm * 256 + r]; }
    __device__ __forceinline__ int ktiles(const pg8::Unit&, int nt) const { return nt; }
};

template <int NN>
struct MoeIdxOrder {
    const bf16* A; const bf16* Bt; int lda, ldb, first, stride, end; const int* slot_tok; int s1, s2, s3, s4, s5, s6, s7;
    __device__ __forceinline__ int expert_of(int rt) const { const int r = rt * 256; return (r >= s1) + (r >= s2) + (r >= s3) + (r >= s4) + (r >= s5) + (r >= s6) + (r >= s7); }
    __device__ __forceinline__ bool next(int i, pg8::Unit& u) const { const int idx = first + i * stride; if (idx >= end) return false; const int pm = idx / NN; u.pm = pm; u.pn = expert_of(pm) * NN + (idx - pm * NN); return true; }
    __device__ __forceinline__ const char* a_base(const pg8::Unit& u) const { return slot_tok ? (const char*)A : (const char*)A + (size_t)u.pm * 256 * lda * 2; }
    __device__ __forceinline__ const char* b_base(const pg8::Unit& u) const { return (const char*)Bt + (size_t)u.pn * 256 * ldb * 2; }
    __device__ __forceinline__ int tok(const pg8::Unit& u, int r) const { return slot_tok[u.pm * 256 + r]; }
    __device__ __forceinline__ int ktiles(const pg8::Unit&, int nt) const { return nt; }
};

namespace att {
__device__ __forceinline__ int crow(int r, int hi) { return (r & 3) + 8 * (r >> 2) + 4 * hi; }
__device__ __forceinline__ s16x4 vtr(const LAS unsigned char* p) { typedef short v4i16_t __attribute__((ext_vector_type(4))); return __builtin_bit_cast(s16x4, __builtin_amdgcn_ds_read_tr16_b64_v4i16((LAS v4i16_t*)p)); }
#define ATT_WAITBAR() asm volatile("s_waitcnt vmcnt(0) lgkmcnt(0)\n\ts_barrier" ::: "memory")
__device__ __forceinline__ void glds16(const void* gsrc, unsigned lds_dst) { unsigned keep;
    asm volatile("s_mov_b32 %0, m0\n\ts_mov_b32 m0, %2\n\ts_nop 0\n\tglobal_load_lds_dwordx4 %1, off\n\ts_mov_b32 m0, %0" : "=&s"(keep) : "v"(gsrc), "s"(lds_dst) : "memory"); }

#define MX3(a, b, c) __builtin_fmaxf(__builtin_fmaxf((a), (b)), (c))
template <int DQK> struct AttLds { static constexpr int NCH = DQK / 8, KSLOT = NCH * 1024, ND0 = DQK / 16, LK = 0, LV = 3 * KSLOT, LOST = LV + 3 * 8192, LCUM = LOST + NWAVES * 4608, END = LCUM + SEQ * 4; };

template <int DQK>
__device__ __forceinline__ void att_qk(f32x16& n0, f32x16& n1, const bf16x8 (&qr)[DQK / 16], const LAS unsigned char* kp) {
    constexpr int ND0 = DQK / 16;
    bf16x8 kf[2 * ND0];
#pragma unroll
    for (int d0 = 0; d0 < ND0; ++d0) { kf[2 * d0] = *(const LAS bf16x8*)(kp + d0 * 2048); kf[2 * d0 + 1] = *(const LAS bf16x8*)(kp + d0 * 2048 + 512); }
    n0 = (f32x16){}; n1 = (f32x16){};
#pragma unroll
    for (int d0 = 0; d0 < ND0; ++d0) {
        n0 = __builtin_amdgcn_mfma_f32_32x32x16_bf16(kf[2 * d0], qr[d0], n0, 0, 0, 0);
        n1 = __builtin_amdgcn_mfma_f32_32x32x16_bf16(kf[2 * d0 + 1], qr[d0], n1, 0, 0, 0);
    }
}
template <bool BIAS, bool MASK>
__device__ __forceinline__ void att_bias_mask(f32x16& n0, f32x16& n1, int t, int NT, int qrel, int hi, float fqb, const LAS float* cumL) {
    if constexpr (BIAS) {
#pragma unroll
        for (int g = 0; g < 4; ++g) {
            const f32x4 f0 = *(const LAS f32x4*)(cumL + t * 64 + 8 * g + 4 * hi), f1 = *(const LAS f32x4*)(cumL + t * 64 + 32 + 8 * g + 4 * hi);
#pragma unroll
            for (int j = 0; j < 4; ++j) { n0[4 * g + j] += fqb - f0[j]; n1[4 * g + j] += fqb - f1[j]; }
        }
    }
    if constexpr (MASK) {
        const int kb = 64 * (t - (NT - 4)) + 4 * hi;
#pragma unroll
        for (int r = 0; r < 16; ++r) { const int kv = kb + (r & 3) + 8 * (r >> 2); if (kv > qrel) n0[r] = -INFINITY; if (kv + 32 > qrel) n1[r] = -INFINITY; }
    }
}
template <int DQK, bool BIAS, bool MASK, bool MORE>
__device__ __forceinline__ void att_step(f32x16& s0, f32x16& s1, f32x16& n0, f32x16& n1, f32x16& o0, f32x16& o1, float& mrow, float& lrow, const bf16x8 (&qr)[DQK / 16],
                                         int t, int NT, int qrel, int lane, int hi, int r32, float fqb, const LAS unsigned char* shm, int vslot, int kslot) {
    typedef AttLds<DQK> L;
    constexpr int ND0 = DQK / 16;
    const LAS unsigned char* vp = shm + L::LV + vslot * 8192 + ((lane >> 4) & 1) * 32 + (lane & 3) * 8 + (4 * hi + ((lane & 15) >> 2)) * 64;
    const LAS unsigned char* kp = shm + L::LK + kslot * L::KSLOT + hi * 1024 + r32 * 16;
    bf16x8 kf[2 * ND0];
    if constexpr (MORE) {
#pragma unroll
        for (int d0 = 0; d0 < ND0; ++d0) { kf[2 * d0] = *(const LAS bf16x8*)(kp + d0 * 2048); kf[2 * d0 + 1] = *(const LAS bf16x8*)(kp + d0 * 2048 + 512); }
    }
    float a = MX3(s0[0], s0[1], s1[0]), b = MX3(s0[2], s0[3], s1[1]); a = MX3(a, s1[2], s1[3]);
#pragma unroll
    for (int r = 4; r < 16; r += 4) { a = MX3(a, s0[r], s0[r + 1]); b = MX3(b, s0[r + 2], s0[r + 3]); a = MX3(a, s1[r], s1[r + 1]); b = MX3(b, s1[r + 2], s1[r + 3]); }
    float rm = __builtin_fmaxf(a, b);
    { auto rr = __builtin_amdgcn_permlane32_swap(__float_as_uint(rm), __float_as_uint(rm), false, false); rm = __builtin_fmaxf(__uint_as_float(rr[0]), __uint_as_float(rr[1])); }
    if (__builtin_amdgcn_ballot_w64(rm > mrow + 8.0f) != 0ull) {
        const float mnew = __builtin_fmaxf(mrow, rm), alpha = fexp2(mrow - mnew);
        mrow = mnew; lrow *= alpha;
#pragma unroll
        for (int r = 0; r < 16; ++r) { o0[r] *= alpha; o1[r] *= alpha; }
    }
    if constexpr (MORE) {
        n0 = (f32x16){}; n1 = (f32x16){};
#pragma unroll
        for (int d0 = 0; d0 < ND0; ++d0) {
            n0 = __builtin_amdgcn_mfma_f32_32x32x16_bf16(kf[2 * d0], qr[d0], n0, 0, 0, 0);
            n1 = __builtin_amdgcn_mfma_f32_32x32x16_bf16(kf[2 * d0 + 1], qr[d0], n1, 0, 0, 0);
        }
    }
    float ps = 0.f;
#pragma unroll
    for (int r = 0; r < 16; ++r) { s0[r] = fexp2(s0[r] - mrow); s1[r] = fexp2(s1[r] - mrow); ps += s0[r] + s1[r]; }
    lrow += ps;
    __builtin_amdgcn_sched_barrier(0);
    s16x4 vl[8], vh[8];
#pragma unroll
    for (int i = 0; i < 8; ++i) { vl[i] = vtr(vp + (i >> 2) * 4096 + (i & 3) * 1024); vh[i] = vtr(vp + (i >> 2) * 4096 + (i & 3) * 1024 + 512); }
    u32x4 pw[4];
    pw[0] = (u32x4){pk2(s0[0], s0[1]), pk2(s0[2], s0[3]), pk2(s0[4], s0[5]), pk2(s0[6], s0[7])};
    pw[1] = (u32x4){pk2(s0[8], s0[9]), pk2(s0[10], s0[11]), pk2(s0[12], s0[13]), pk2(s0[14], s0[15])};
    pw[2] = (u32x4){pk2(s1[0], s1[1]), pk2(s1[2], s1[3]), pk2(s1[4], s1[5]), pk2(s1[6], s1[7])};
    pw[3] = (u32x4){pk2(s1[8], s1[9]), pk2(s1[10], s1[11]), pk2(s1[12], s1[13]), pk2(s1[14], s1[15])};
#pragma unroll
    for (int ks = 0; ks < 4; ++ks) {
        const bf16x8 v0 = (bf16x8){vl[ks][0], vl[ks][1], vl[ks][2], vl[ks][3], vh[ks][0], vh[ks][1], vh[ks][2], vh[ks][3]};
        const bf16x8 v1 = (bf16x8){vl[4 + ks][0], vl[4 + ks][1], vl[4 + ks][2], vl[4 + ks][3], vh[4 + ks][0], vh[4 + ks][1], vh[4 + ks][2], vh[4 + ks][3]};
        o0 = __builtin_amdgcn_mfma_f32_32x32x16_bf16(v0, __builtin_bit_cast(bf16x8, pw[ks]), o0, 0, 0, 0);
        o1 = __builtin_amdgcn_mfma_f32_32x32x16_bf16(v1, __builtin_bit_cast(bf16x8, pw[ks]), o1, 0, 0, 0);
    }
    if constexpr (MORE) att_bias_mask<BIAS, MASK>(n0, n1, t + 1, NT, qrel, hi, fqb, (const LAS float*)(shm + L::LCUM));
}

template <int DQK, bool BIAS>
__device__ __forceinline__ void attn_unit(int b, int h, int qb, const bf16* Q, int pq, const bf16* K, int pk, const bf16* V, int pv,
                                          bf16* O, int po, int ocol, const float* cum, LAS unsigned char* shm, const int tid_in, float* ssqp, int hidx, const unsigned* qkmax) {
    int tid = tid_in; asm volatile("" : "+v"(tid));
    typedef AttLds<DQK> L;
    constexpr int NCH = L::NCH, KSLOT = L::KSLOT, ND0 = L::ND0, LK = L::LK, LV = L::LV, LOST = L::LOST;
    static_assert(L::END <= RING_BYTES, "attention LDS");
    const int lane = tid & 63, r32 = lane & 31, hi = lane >> 5; const int wid = __builtin_amdgcn_readfirstlane(tid >> 6);
    const long rowbase = (long)b * SEQ; const int q0 = qb * 256;
    const bf16* Qw = Q + (rowbase + q0 + wid * 32) * pq + h * DQK;
    const bf16* Kh = K + rowbase * pk + h * DQK; const bf16* Vh = V + rowbase * pv + h * 64;
    const int NT = (q0 + 256) / 64;
    LAS float* cumL = (LAS float*)(shm + L::LCUM);
    if constexpr (BIAS) { const float* cs = cum + (size_t)(b * 4 + h) * SEQ; for (int i = tid * 4; i < q0 + 256; i += NTHR * 4) *(LAS f32x4*)(cumL + i) = *(const f32x4*)(cs + i); }
    const bf16* ksrc = Kh + (long)lane * pk + wid * 8;
    const bf16* vsrc = Vh + (long)(16 * (wid & 3) + (lane >> 2)) * pv + (wid >> 2) * 32 + (lane & 3) * 8;
    const unsigned lds0 = (unsigned)(size_t)shm;
#define ATT_DMA_K(t, slot) do { \
        glds16(ksrc + (long)(t) * 64 * pk, (unsigned)__builtin_amdgcn_readfirstlane((int)(lds0 + LK + (slot) * KSLOT + wid * 1024))); \
        if (NCH > 8 && wid + 8 < NCH) glds16(ksrc + (long)(t) * 64 * pk + 64, (unsigned)__builtin_amdgcn_readfirstlane((int)(lds0 + LK + (slot) * KSLOT + (wid + 8) * 1024))); } while (0)
#define ATT_DMA_V(t, slot) glds16(vsrc + (long)(t) * 64 * pv, (unsigned)__builtin_amdgcn_readfirstlane((int)(lds0 + LV + (slot) * 8192 + wid * 1024)))
    const int nK = (NCH > 8 && wid + 8 < NCH) ? 2 : 1;
#define ATT_WAITBAR_N(n) do { const int n_ = (n); if (n_ == 0) asm volatile("s_waitcnt vmcnt(0) lgkmcnt(0)\n\ts_barrier" ::: "memory"); else if (n_ == 1) asm volatile("s_waitcnt vmcnt(1) lgkmcnt(0)\n\ts_barrier" ::: "memory"); \
        else if (n_ == 2) asm volatile("s_waitcnt vmcnt(2) lgkmcnt(0)\n\ts_barrier" ::: "memory"); else asm volatile("s_waitcnt vmcnt(3) lgkmcnt(0)\n\ts_barrier" ::: "memory"); } while (0)
    int tb = 0;
    if constexpr (BIAS) {
        const float qk = sqrtf(__uint_as_float(qkmax[0]) * __uint_as_float(qkmax[1])) * 1.01f + 1.0f, thr = -(150.0f + 2.0f * qk);
        const float* cs = cum + (size_t)(b * 4 + h) * SEQ; const float f0 = cs[q0]; const float fj = lane < NT ? cs[64 * lane + 63] : f0;
        const unsigned long long keep = __builtin_amdgcn_ballot_w64(lane < NT && (f0 - fj) >= thr);
        tb = keep ? (int)__builtin_ctzll(keep) : NT - 4; if (tb > NT - 4) tb = NT - 4;
        tb = __builtin_amdgcn_readfirstlane(tb);
    }
    ATT_DMA_K(tb, 0); ATT_DMA_V(tb, 0); ATT_DMA_K(tb + 1, 1);
    bf16x8 qr[ND0];
#pragma unroll
    for (int d0 = 0; d0 < ND0; ++d0) qr[d0] = *(const bf16x8*)(Qw + (long)r32 * pq + d0 * 16 + hi * 8);
    float mrow = -1e30f, lrow = 0.f; f32x16 o0 = {}, o1 = {};
    const int qrel = wid * 32 + r32;
    ATT_WAITBAR();
#pragma unroll
    for (int d0 = 0; d0 < ND0; ++d0) asm volatile("" : "+v"(qr[d0]));
    ATT_DMA_K(tb + 2, 2); ATT_DMA_V(tb + 1, 1);
    float fqb = 0.f; if constexpr (BIAS) fqb = cumL[q0 + qrel];
    f32x16 s0, s1;
    att_qk<DQK>(s0, s1, qr, shm + LK + hi * 1024 + r32 * 16);
    asm volatile("s_waitcnt lgkmcnt(0)\n\ts_barrier" ::: "memory");
    if (tb == NT - 4) att_bias_mask<BIAS, true>(s0, s1, tb, NT, qrel, hi, fqb, cumL); else att_bias_mask<BIAS, false>(s0, s1, tb, NT, qrel, hi, fqb, cumL);
    int t = tb, sl0 = 0, sl1 = 1, sl2 = 2;
#define ATT_ROT() do { const int x_ = sl0; sl0 = sl1; sl1 = sl2; sl2 = x_; } while (0)
    f32x16 u0, u1;
    for (; t + 1 < NT - 5; t += 2) {
        ATT_DMA_K(t + 3, sl0); ATT_DMA_V(t + 2, sl2);
        att_step<DQK, BIAS, false, true>(s0, s1, u0, u1, o0, o1, mrow, lrow, qr, t, NT, qrel, lane, hi, r32, fqb, shm, sl0, sl1);
        ATT_WAITBAR_N(nK + 1); ATT_ROT();
        ATT_DMA_K(t + 4, sl0); ATT_DMA_V(t + 3, sl2);
        att_step<DQK, BIAS, false, true>(u0, u1, s0, s1, o0, o1, mrow, lrow, qr, t + 1, NT, qrel, lane, hi, r32, fqb, shm, sl0, sl1);
        ATT_WAITBAR_N(nK + 1); ATT_ROT();
    }
    for (; t < NT - 5; ++t) {
        ATT_DMA_K(t + 3, sl0); ATT_DMA_V(t + 2, sl2);
        att_step<DQK, BIAS, false, true>(s0, s1, u0, u1, o0, o1, mrow, lrow, qr, t, NT, qrel, lane, hi, r32, fqb, shm, sl0, sl1);
        s0 = u0; s1 = u1;
        ATT_WAITBAR_N(nK + 1); ATT_ROT();
    }
    for (; t < NT - 1; ++t) {
        int nis = 0;
        if (t + 3 < NT) { ATT_DMA_K(t + 3, sl0); nis += nK; }
        if (t + 2 < NT) { ATT_DMA_V(t + 2, sl2); nis += 1; }
        const int jbc = t - (NT - 4); const bool docur = !(jbc >= 0 && 2 * jbc > wid), donext = !(2 * (jbc + 1) > wid);
        if (docur && donext) { att_step<DQK, BIAS, true, true>(s0, s1, u0, u1, o0, o1, mrow, lrow, qr, t, NT, qrel, lane, hi, r32, fqb, shm, sl0, sl1); s0 = u0; s1 = u1; }
        else if (docur) att_step<DQK, BIAS, false, false>(s0, s1, u0, u1, o0, o1, mrow, lrow, qr, t, NT, qrel, lane, hi, r32, fqb, shm, sl0, sl1);
        ATT_WAITBAR_N(nis); ATT_ROT();
    }
    if (!(2 * 3 > wid)) att_step<DQK, BIAS, false, false>(s0, s1, u0, u1, o0, o1, mrow, lrow, qr, t, NT, qrel, lane, hi, r32, fqb, shm, sl0, sl1);
#undef ATT_ROT
#undef ATT_WAITBAR_N
    { auto rr = __builtin_amdgcn_permlane32_swap(__float_as_uint(lrow), __float_as_uint(lrow), false, false); lrow = __uint_as_float(rr[0]) + __uint_as_float(rr[1]); }
    const float rl = frcp(lrow);
    { float ssq = 0.f;
#pragma unroll
      for (int r = 0; r < 16; ++r) { const float a = o0[r] * rl, b2 = o1[r] * rl; ssq += a * a + b2 * b2; }
      auto rr = __builtin_amdgcn_permlane32_swap(__float_as_uint(ssq), __float_as_uint(ssq), false, false); ssq = __uint_as_float(rr[0]) + __uint_as_float(rr[1]);
      if (hi == 0) ssqp[(size_t)(rowbase + q0 + wid * 32 + r32) * 12 + hidx] = ssq; }
    LAS unsigned char* stg = shm + LOST + wid * 4608;
#pragma unroll
    for (int g = 0; g < 4; ++g) {
        *(LAS u32x2*)(stg + r32 * 144 + (8 * g + 4 * hi) * 2) = (u32x2){pk2(o0[4 * g] * rl, o0[4 * g + 1] * rl), pk2(o0[4 * g + 2] * rl, o0[4 * g + 3] * rl)};
        *(LAS u32x2*)(stg + r32 * 144 + (32 + 8 * g + 4 * hi) * 2) = (u32x2){pk2(o1[4 * g] * rl, o1[4 * g + 1] * rl), pk2(o1[4 * g + 2] * rl, o1[4 * g + 3] * rl)};
    }
    asm volatile("s_waitcnt lgkmcnt(0)" ::: "memory");
    bf16* Ow = O + (rowbase + q0 + wid * 32) * po + ocol;
#pragma unroll
    for (int i = 0; i < 4; ++i) { const int row = i * 8 + (lane >> 3), ch = lane & 7; const u32x4 v = *(const LAS u32x4*)(stg + row * 144 + ch * 16); *(u32x4*)(Ow + (long)row * po + ch * 8) = v; }
    asm volatile("s_waitcnt lgkmcnt(0)\n\ts_barrier" ::: "memory");
#undef ATT_DMA_K
#undef ATT_DMA_V
}
}

struct Args { const float* in[26]; float* out; unsigned char* ws; int ph_lo, ph_hi; };
typedef const __attribute__((address_space(4))) Args* kargs_t;
struct Ctx {
    LAS unsigned char* lds; unsigned* ctl; unsigned char* ws; float* out;
    int tid, lane, wave, vcu, G, gw, NGW, bx;
};
__device__ __forceinline__ kargs_t opaque_args() { kargs_t p = (kargs_t)__builtin_amdgcn_kernarg_segment_ptr(); asm volatile("" : "+s"(p)); return p; }
__device__ __forceinline__ Ctx make_ctx(kargs_t A, LAS unsigned char* lds, int wave0) {
    Ctx C; unsigned ones = ~0u; asm volatile("" : "+s"(ones));
    int t = wave0 * 64 + (int)__builtin_amdgcn_mbcnt_hi(ones, __builtin_amdgcn_mbcnt_lo(ones, 0u)); asm volatile("" : "+v"(t));
    C.lds = lds; C.ws = A->ws; C.ctl = (unsigned*)(C.ws + WS_CTL); C.out = A->out;
    C.tid = t; C.lane = t & 63; C.wave = __builtin_amdgcn_readfirstlane(t >> 6);
    { int g_ = gridDim.x, b_ = blockIdx.x; asm volatile("" : "+s"(g_), "+s"(b_)); C.G = g_; C.bx = b_; } C.vcu = (C.bx % 8) * (C.G / 8) + C.bx / 8;
    C.gw = C.vcu * NWAVES + C.wave; C.NGW = C.G * NWAVES;
    return C;
}
#define LDS_WAIT() asm volatile("s_waitcnt lgkmcnt(0)" ::: "memory")

struct MapWin { __device__ __forceinline__ int row(int n) const {
        if (n < 256) return PC_CQ + n; if (n < 384) return PC_CKV + (n - 256); if (n < 416) return PC_KR + (n - 384); if (n < 672) return PC_FQ + (n - 416);
        if (n < 928) return PC_FK + (n - 672); if (n < 1184) return PC_FV + (n - 928); if (n < 1188) return PC_FL + (n - 1184);
        { const int c = n - 1188, ch = c & 255; return PC_CI + (ch >> 7) * 256 + (c >> 8) * 128 + (ch & 127); } }
    __device__ __forceinline__ float scale(int, int n) const { return (n >= 416 && n < 672) ? C2_FOX : 1.0f; } };
struct MapUq { const float* g; __device__ __forceinline__ int row(int n) const { const int h = n / 96, d = n - h * 96; if (d < 64) return n; const int i = d - 64;
        const int s = (i < 16) ? (4 * (i >> 1) + (i & 1)) : (4 * ((i - 16) >> 1) + 2 + (i & 1)); return h * 96 + 64 + s; }
    __device__ __forceinline__ float scale(int k, int) const { return g[k] * C2_MLA; } };
struct MapUkv { const float* g; __device__ __forceinline__ int row(int n) const { const int h = n >> 7, d = n & 127; return d < 64 ? (768 + h * 64 + d) : (1280 + h * 64 + (d - 64)); }
    __device__ __forceinline__ float scale(int k, int) const { return g[k]; } };
struct MapWout { const float* gm; const float* gf; __device__ __forceinline__ int row(int n) const { return n; }
    __device__ __forceinline__ float scale(int k, int) const { return k < 512 ? gm[k] : (k < 768 ? gf[k - 512] : 1.0f); } };
struct MapW13 { int which; __device__ __forceinline__ int row(int n) const { return (n >> 7) * 256 + which * 128 + (n & 127); }
    __device__ __forceinline__ float scale(int, int) const { return 1.0f; } };
struct MapId { __device__ __forceinline__ int row(int n) const { return n; } __device__ __forceinline__ float scale(int, int) const { return 1.0f; } };

template <class Map>
__device__ __forceinline__ void transpose_item(const float* W, int Nsrc, bf16* WT, int ldk, LAS float* scr, int kb, int nb, int lane, const Map mp) {
    const int k0 = 64 * kb, n0 = 32 * nb, r8 = lane >> 3, nn = n0 + 4 * (lane & 7); const bool nok = nn < Nsrc;
    f32x4 v[8];
#pragma unroll
    for (int i = 0; i < 8; ++i) { v[i] = (f32x4){0.f, 0.f, 0.f, 0.f}; if (nok) v[i] = *(const f32x4*)(W + (size_t)(k0 + 8 * i + r8) * Nsrc + nn); }
#pragma unroll
    for (int i = 0; i < 8; ++i) { const int kk = 8 * i + r8; LAS float* d = scr + kk * 33 + 4 * (lane & 7);
#pragma unroll
        for (int j = 0; j < 4; ++j) d[j] = v[i][j] * mp.scale(k0 + kk, nn + j); }
    LDS_WAIT(); asm volatile("" ::: "memory");
    const int c = lane & 7;
#pragma unroll
    for (int j = 0; j < 4; ++j) { const int n = (lane >> 3) + 8 * j; const LAS float* s = scr + (8 * c) * 33 + n;
        if (n0 + n < Nsrc) { u32x4 o; o.x = pk2(s[0 * 33], s[1 * 33]); o.y = pk2(s[2 * 33], s[3 * 33]); o.z = pk2(s[4 * 33], s[5 * 33]); o.w = pk2(s[6 * 33], s[7 * 33]);
            *(u32x4*)(WT + (size_t)mp.row(n0 + n) * ldk + k0 + 8 * c) = o; } }
    LDS_WAIT(); asm volatile("" ::: "memory");
}

__device__ __forceinline__ void sincos_acc(float ang, float& c, float& s) {
    const double a = (double)ang, q = __builtin_rint(a * 0.63661977236758134308);
    const double y = (a - q * 1.57079632679489655800) - q * 6.12323399573676603587e-17, y2 = y * y;
    const double sp = y * (1.0 + y2 * (-1.0 / 6 + y2 * (1.0 / 120 + y2 * (-1.0 / 5040 + y2 * (1.0 / 362880 + y2 * (-1.0 / 39916800 + y2 * (1.0 / 6227020800.0)))))));
    const double cp = 1.0 + y2 * (-0.5 + y2 * (1.0 / 24 + y2 * (-1.0 / 720 + y2 * (1.0 / 40320 + y2 * (-1.0 / 3628800 + y2 * (1.0 / 479001600 + y2 * (-1.0 / 87178291200.0)))))));
    const int quad = (int)((long long)q & 3);
    const double ss = (quad == 0) ? sp : (quad == 1) ? cp : (quad == 2) ? -sp : -cp;
    const double cc = (quad == 0) ? cp : (quad == 1) ? -sp : (quad == 2) ? -cp : sp;
    c = (float)cc; s = (float)ss;
}
__device__ __forceinline__ float inv_freq(int f) {
    const int a = f >> 2, b = f & 3;
    const float p = (a == 0) ? 1.0f : (a == 1) ? 0.1f : (a == 2) ? 0.01f : 0.001f;
    const float m = (b == 0) ? 1.0f : (b == 1) ? 0.56234132519034908f : (b == 2) ? 0.31622776601683794f : 0.17782794100389228f;
    return (b == 0) ? p : (float)((double)p * (double)m);
}

__device__ __forceinline__ void p0_prologue(Ctx& C, kargs_t A) {
    LAS float* scr = (LAS float*)(C.lds + C.wave * 16384);
    bf16* WIN = (bf16*)(C.ws + WS_WIN); bf16* WQ2 = (bf16*)(C.ws + WS_WQ2); bf16* WOUT = (bf16*)(C.ws + WS_WOUT);
    constexpr int I_IN = 16 * 54, I_UQ = 4 * 24, I_UKV = 2 * 32, I_OUT = 16 * 32, I_L = I_IN + I_UQ + I_UKV + I_OUT;
    REPS(12) for (int it = C.gw; it < DEPTH * I_L; it += C.NGW) {
        const int l = it / I_L; int r = it - l * I_L;
        if (r < I_IN) { transpose_item(A->in[2] + (size_t)l * DM * IN_COLS, IN_COLS, WIN + (size_t)l * NP1 * DM, DM, scr, r / 54, r % 54, C.lane, MapWin{}); continue; } r -= I_IN;
        if (r < I_UQ) { transpose_item(A->in[4] + (size_t)l * 256 * 768, 768, WQ2 + (size_t)l * NP1 * 256, 256, scr, r / 24, r % 24, C.lane, MapUq{A->in[3] + l * 256}); continue; } r -= I_UQ;
        if (r < I_UKV) { transpose_item(A->in[6] + (size_t)l * 128 * 1024, 1024, WQ2 + (size_t)l * NP1 * 256, 256, scr, r / 32, r % 32, C.lane, MapUkv{A->in[5] + l * 128}); continue; } r -= I_UKV;
        transpose_item(A->in[14] + (size_t)l * DM * DM, DM, WOUT + (size_t)l * DM * DM, DM, scr, r / 32, r % 32, C.lane, MapWout{A->in[12] + l * 512, A->in[13] + l * 256});
    }
    const int gt = C.vcu * NTHR + C.tid, NGT = C.G * NTHR;
    for (int i = gt; i < DEPTH * 92 * 128; i += NGT) { const int l = i / (92 * 128), r = i % (92 * 128); *(u32x4*)(WIN + (size_t)l * NP1 * DM + (size_t)(420 + r / 128) * DM + (r % 128) * 8) = (u32x4){0u, 0u, 0u, 0u}; }
    REPS(4) {
    bf16* XB = (bf16*)(C.ws + WS_XB); const float* x = A->in[0];
    for (int m = C.gw; m < M; m += C.NGW) { const f32x4* xr = (const f32x4*)(x + (size_t)m * DM) + C.lane; u32x2* o = (u32x2*)(XB + (size_t)m * DM) + C.lane;
#pragma unroll
        for (int j = 0; j < 4; ++j) { const f32x4 v = xr[64 * j]; o[64 * j] = (u32x2){pk2(v[0], v[1]), pk2(v[2], v[3])}; } }
    float* COS = (float*)(C.ws + WS_TAB); float* SIN = COS + (size_t)M * 16; const int* pos = (const int*)A->in[1];
    for (int i = gt; i < M * 16; i += NGT) { const float ang = (float)pos[i >> 4] * inv_freq(i & 15); float c, s; sincos_acc(ang, c, s); COS[i] = c; SIN[i] = s; }
    }
}

__device__ __forceinline__ int ffn_split(int layer) { return (layer & 1) ? 7744 : 4224; }
__device__ __forceinline__ void ffn_weights(Ctx& C, kargs_t A, int layer, int first, int stride, int lo, int hi) {
    LAS float* scr = (LAS float*)(C.lds + C.wave * 16384);
    bf16* W13 = (bf16*)(C.ws + WS_WFFN); bf16* W2T = W13 + WF_W13_ELEMS; const int j = layer >> 1;
    if ((layer & 1) == 0) {
        constexpr int I1 = 16 * 88, I2 = 44 * 32;
        const float* w1 = A->in[17] + (size_t)j * DM * DFF; const float* w3 = A->in[18] + (size_t)j * DM * DFF; const float* w2 = A->in[19] + (size_t)j * DFF * DM;
        const int end = hi < 2 * I1 + I2 ? hi : 2 * I1 + I2;
        for (int it = lo + first; it < end; it += stride) {
            int r = it;
            if (r < I1) { transpose_item(w1, DFF, W13, DM, scr, r / 88, r % 88, C.lane, MapW13{0}); continue; } r -= I1;
            if (r < I1) { transpose_item(w3, DFF, W13, DM, scr, r / 88, r % 88, C.lane, MapW13{1}); continue; } r -= I1;
            transpose_item(w2, DM, W2T, DFF, scr, r / 32, r % 32, C.lane, MapId{});
        }
    } else {
        constexpr int I1 = 16 * 44, I2 = 22 * 32, IE = 2 * I1 + I2;
        const int end = hi < NEXP * IE ? hi : NEXP * IE;
        for (int it = lo + first; it < end; it += stride) {
            const int e = it / IE; int r = it - e * IE;
            const float* w1 = A->in[21] + ((size_t)j * NEXP + e) * DM * DFE; const float* w3 = A->in[22] + ((size_t)j * NEXP + e) * DM * DFE; const float* w2 = A->in[23] + ((size_t)j * NEXP + e) * DFE * DM;
            bf16* W13e = W13 + (size_t)e * 2 * DFE * DM; bf16* W2Te = W2T + (size_t)e * DM * DFE;
            if (r < I1) { transpose_item(w1, DFE, W13e, DM, scr, r / 44, r % 44, C.lane, MapW13{0}); continue; } r -= I1;
            if (r < I1) { transpose_item(w3, DFE, W13e, DM, scr, r / 44, r % 44, C.lane, MapW13{1}); continue; } r -= I1;
            transpose_item(w2, DM, W2Te, DFE, scr, r / 32, r % 32, C.lane, MapId{});
        }
    }
}

__device__ __forceinline__ void p2_thin(Ctx& C, kargs_t A, int layer) {
    unsigned char* sc = C.ws + WS_SCR;
    bf16* CQ = (bf16*)(sc + SC_CQKV); bf16* CKV = CQ + (size_t)M * 256; const float* KR = (const float*)(sc + SC_KR); const float* FL = (const float*)(sc + SC_FL);
    float* CUM = (float*)(sc + SC_CUM); const bf16* CI = (const bf16*)(sc + SC_CI); const bf16* FQn = (const bf16*)(sc + SC_FQ); bf16* KM = (bf16*)(sc + SC_KM); bf16* MIXED = (bf16*)(sc + SC_MIXED);
    const float* COS = (const float*)(C.ws + WS_TAB); const float* SIN = COS + (size_t)M * 16;
    LAS unsigned* NT2 = (LAS unsigned*)(C.lds + RING_BYTES + 4096);
    if (C.tid < 64) NT2[C.tid] = 0u;
    LAS unsigned* RQ = (LAS unsigned*)(C.lds + RING_BYTES + 8192 + 64);
    if (C.tid == 0) RQ[0] = 0u;
    __syncthreads();
    {
    if (C.wave == 0 && C.vcu < BATCH * 4) {
        const int sq = C.vcu, b = sq >> 2, h = sq & 3; const float bias = A->in[7][layer * 4 + h];
        float v[64]; float run = 0.f;
#pragma unroll
        for (int i = 0; i < 64; ++i) { const float z = FL[((size_t)b * SEQ + C.lane * 64 + i) * 4 + h] + bias; const float e = fexp2(-fabsf(z) * LOG2E);
            const float ls = fminf(z, 0.f) - __builtin_amdgcn_logf(1.0f + e) * 0.6931471805599453f; run += ls * LOG2E; v[i] = run; }
        float incl = run;
#pragma unroll
        for (int o = 1; o < 64; o <<= 1) { const float t = __int_as_float(__builtin_amdgcn_ds_bpermute((C.lane - o) << 2, __float_as_int(incl))); if (C.lane >= o) incl += t; }
        const float excl = incl - run; float* dst = CUM + (size_t)sq * SEQ + C.lane * 64;
#pragma unroll
        for (int i = 0; i < 64; i += 4) *(f32x4*)(dst + i) = (f32x4){v[i] + excl, v[i + 1] + excl, v[i + 2] + excl, v[i + 3] + excl};
    }
    const int rpw = M / C.G;
    for (;;) {
        unsigned jb = 0u; if (C.lane == 0) jb = __hip_atomic_fetch_add(RQ, 1u, __ATOMIC_RELAXED, __HIP_MEMORY_SCOPE_WORKGROUP);
        jb = (unsigned)__builtin_amdgcn_readfirstlane((int)jb);
        if ((int)jb * 4 >= rpw) break;
        const size_t mb = (size_t)C.vcu * rpw + 4 * jb;
        u32x2 wq[4]; unsigned wk[4]; f32x2 x1[4], x2[4], cs[4], sn[4]; u32x2 fqv[4], fkv[4]; const int g4 = C.lane & 7, h = C.lane >> 3;
#pragma unroll
        for (int k = 0; k < 4; ++k) { const size_t m = mb + k;
            wq[k] = ((const u32x2*)(CQ + m * 256))[C.lane]; wk[k] = ((const unsigned*)(CKV + m * 256))[C.lane];
            x1[k] = *(const f32x2*)(KR + m * 32 + 2 * g4); x2[k] = *(const f32x2*)(KR + m * 32 + 16 + 2 * g4);
            cs[k] = *(const f32x2*)(COS + m * 16 + 2 * g4); sn[k] = *(const f32x2*)(SIN + m * 16 + 2 * g4);
            fqv[k] = ((const u32x2*)(FQn + m * 256))[C.lane]; fkv[k] = ((const u32x2*)(FQn + (size_t)M * 256 + m * 256))[C.lane]; }
#pragma unroll
        for (int k = 0; k < 4; ++k) { const size_t m = mb + k;
            { const float a0 = bflo(wq[k].x), a1 = bfhi(wq[k].x), a2 = bflo(wq[k].y), a3 = bfhi(wq[k].y);
              const float ss = wave_sum((a0 * a0 + a1 * a1) + (a2 * a2 + a3 * a3)); const float r = 1.0f / sqrtf(ss * (1.0f / 256) + EPS); ((u32x2*)(CQ + m * 256))[C.lane] = (u32x2){pk2(a0 * r, a1 * r), pk2(a2 * r, a3 * r)}; }
            { const float a0 = bflo(wk[k]), a1 = bfhi(wk[k]); unsigned* p = (unsigned*)(CKV + m * 256) + C.lane;
              const float ss = wave_sum(a0 * a0 + a1 * a1); const float r = 1.0f / sqrtf(ss * (1.0f / 128) + EPS); *p = pk2(a0 * r, a1 * r); }
            {
              float nq = 0.f, nk = 0.f; { const float a0 = bflo(fqv[k].x), a1 = bfhi(fqv[k].x), a2 = bflo(fqv[k].y), a3 = bfhi(fqv[k].y); nq = (a0 * a0 + a1 * a1) + (a2 * a2 + a3 * a3); }
              { const float a0 = bflo(fkv[k].x), a1 = bfhi(fkv[k].x), a2 = bflo(fkv[k].y), a3 = bfhi(fkv[k].y); nk = (a0 * a0 + a1 * a1) + (a2 * a2 + a3 * a3); }
              nq += lane_xor<1>(nq); nq += lane_xor<2>(nq); nq += lane_xor<4>(nq); nq += lane_xor<8>(nq); nk += lane_xor<1>(nk); nk += lane_xor<2>(nk); nk += lane_xor<4>(nk); nk += lane_xor<8>(nk);
              if ((C.lane & 15) == 0) { const int bi = (int)(m >> 12) * 8 + (C.lane >> 4) * 2; atomicMax((unsigned*)&NT2[bi], __float_as_uint(nq)); atomicMax((unsigned*)&NT2[bi + 1], __float_as_uint(nk)); } }
            *(u32x2*)(KM + m * 768 + h * 96 + 64 + 4 * g4) = (u32x2){pk2(x1[k].x * cs[k].x - x2[k].x * sn[k].x, x1[k].y * cs[k].y - x2[k].y * sn[k].y), pk2(x1[k].x * sn[k].x + x2[k].x * cs[k].x, x1[k].y * sn[k].y + x2[k].y * cs[k].y)}; }
    }
    }
    __syncthreads();
    if (C.tid < 64) atomicMax(C.ctl + CW_QKMAX + layer * 64 + C.tid, NT2[C.tid]);
    {
        LAS float* hL = (LAS float*)C.lds; LAS float* yL = hL + 62 * 256;
        const int cch = (C.wave & 3) * 64 + C.lane, tt0 = (C.wave >> 2) * 16;
        float wj[31];
#pragma unroll
        for (int j = 0; j < 31; ++j) wj[j] = A->in[8][((size_t)layer * 31 + j) * 256 + cch];
        const float cb = A->in[9][layer * 256 + cch];
        const int ntok = C.tid >> 4, ngrp = (C.tid >> 2) & 3, nqt = C.tid & 3, nc0 = ngrp * 64 + nqt * 16;
        u32x4 pa[4];
#define CONV_LOAD(tl) do { const int t0_ = (tl) * 32, seq0_ = (t0_ / SEQ) * SEQ; _Pragma("unroll") for (int k = 0; k < 4; ++k) { const int it = C.tid + NTHR * k, r = it >> 5, ch = it & 31, tok = t0_ - 30 + r; \
            pa[k] = (u32x4){0u, 0u, 0u, 0u}; \
            if (it < 62 * 32 && tok >= seq0_) pa[k] = *(const u32x4*)(CI + (size_t)tok * 256 + ch * 8); } } while (0)
        if (C.vcu < M / 32) CONV_LOAD(C.vcu);
        for (int tile = C.vcu; tile < M / 32; tile += C.G) {
            const int t0 = tile * 32;
#pragma unroll
            for (int k = 0; k < 4; ++k) { const int it = C.tid + NTHR * k, r = it >> 5, ch = it & 31;
                if (it < 62 * 32) { const u32x4 a = pa[k];
                    *(LAS f32x4*)(hL + r * 256 + ch * 8) = (f32x4){bflo(a.x), bfhi(a.x), bflo(a.y), bfhi(a.y)}; *(LAS f32x4*)(hL + r * 256 + ch * 8 + 4) = (f32x4){bflo(a.z), bfhi(a.z), bflo(a.w), bfhi(a.w)}; } }
            __syncthreads();
            if (tile + C.G < M / 32) CONV_LOAD(tile + C.G);
#pragma unroll
            for (int chunk = 0; chunk < 2; ++chunk) { const int base = tt0 + chunk * 8; float hv[38];
#pragma unroll
                for (int i = 0; i < 38; ++i) hv[i] = hL[(base + i) * 256 + cch];
#pragma unroll
                for (int tt = 0; tt < 8; ++tt) { float acc = cb;
#pragma unroll
                    for (int j = 0; j < 31; ++j) acc += wj[j] * hv[tt + j];
                    yL[(base + tt) * 256 + cch] = acc; } }
            __syncthreads();
            { float v[16]; float s = 0.f;
#pragma unroll
              for (int i = 0; i < 16; i += 4) { const f32x4 t4 = *(const LAS f32x4*)(yL + ntok * 256 + nc0 + i); v[i] = t4[0]; v[i + 1] = t4[1]; v[i + 2] = t4[2]; v[i + 3] = t4[3]; s += (t4[0] + t4[1]) + (t4[2] + t4[3]); }
              s += lane_xor<1>(s); s += lane_xor<2>(s); const float mean = s * (1.0f / 64); float q = 0.f;
#pragma unroll
              for (int i = 0; i < 16; ++i) { v[i] -= mean; q += v[i] * v[i]; }
              q += lane_xor<1>(q); q += lane_xor<2>(q); const float rstd = 1.0f / sqrtf(q * (1.0f / 64) + EPS);
              const float* gg = A->in[10] + layer * 256 + nc0; const float* gb = A->in[11] + layer * 256 + nc0; float o[16];
#pragma unroll
              for (int i = 0; i < 16; ++i) o[i] = siluf_(v[i] * rstd * gg[i] + gb[i]);
              bf16* dst = MIXED + (size_t)(t0 + ntok) * 1024 + 768 + nc0;
              *(u32x4*)dst = (u32x4){pk2(o[0], o[1]), pk2(o[2], o[3]), pk2(o[4], o[5]), pk2(o[6], o[7])};
              *(u32x4*)(dst + 8) = (u32x4){pk2(o[8], o[9]), pk2(o[10], o[11]), pk2(o[12], o[13]), pk2(o[14], o[15])}; }
        }
        __syncthreads();
    }
    REPS(11) ffn_weights(C, A, layer, C.gw, C.NGW, ffn_split(layer), 1 << 30);
}

__device__ __forceinline__ void p5_rms(Ctx& C) {
    bf16* MIXED = (bf16*)(C.ws + WS_SCR + SC_MIXED);
    REPS(7) for (int mb = C.gw; mb < M; mb += 4 * C.NGW) {
        u32x4 wa[4]; u32x2 wb[4];
#pragma unroll
        for (int k = 0; k < 4; ++k) { const bf16* r = MIXED + ((size_t)mb + (size_t)k * C.NGW) * 1024; wa[k] = ((const u32x4*)r)[C.lane]; wb[k] = ((const u32x2*)(r + 512))[C.lane]; }
#pragma unroll
        for (int k = 0; k < 4; ++k) { bf16* r = MIXED + ((size_t)mb + (size_t)k * C.NGW) * 1024;
            { const u32x4 w = wa[k]; float a[8] = {bflo(w.x), bfhi(w.x), bflo(w.y), bfhi(w.y), bflo(w.z), bfhi(w.z), bflo(w.w), bfhi(w.w)}; float ss = 0.f;
#pragma unroll
              for (int i = 0; i < 8; ++i) ss += a[i] * a[i];
              ss = wave_sum(ss); const float rs = 1.0f / sqrtf(ss * (1.0f / 512) + EPS);
              ((u32x4*)r)[C.lane] = (u32x4){pk2(a[0] * rs, a[1] * rs), pk2(a[2] * rs, a[3] * rs), pk2(a[4] * rs, a[5] * rs), pk2(a[6] * rs, a[7] * rs)}; }
            { const u32x2 w = wb[k]; const float a0 = bflo(w.x), a1 = bfhi(w.x), a2 = bflo(w.y), a3 = bfhi(w.y);
              const float ss = wave_sum((a0 * a0 + a1 * a1) + (a2 * a2 + a3 * a3)); const float rs = 1.0f / sqrtf(ss * (1.0f / 256) + EPS); ((u32x2*)(r + 512))[C.lane] = (u32x2){pk2(a0 * rs, a1 * rs), pk2(a2 * rs, a3 * rs)}; }
        }
    }
}

template <int MODE>
__device__ __forceinline__ void ln_pass(Ctx& C, const bool final, const bf16* add, const float* gam, const float* bet, const float* router_w) {
    bf16* XB = (bf16*)(C.ws + WS_XB); float* out = C.out;
    REPS(14) {
    const bool dry = ((REP_MASK >> 14) & 1) && rep_ == 0; float* jf = (float*)(C.ws + WS_SCR); bf16* jb = (bf16*)(C.ws + WS_SCR + 40 * MiB);
    int* TOPE = (int*)(C.ws + WS_MOE + MT_TOPE); float* TOPG = (float*)(C.ws + WS_MOE + MT_TOPG); const int* TOKSLOT = (const int*)(C.ws + WS_MOE + MT_TOKSLOT);
    LAS float* RW = (LAS float*)C.lds; LAS unsigned* CNT = (LAS unsigned*)(C.lds + 32768);
    if constexpr (MODE == 1) {
        for (int i = C.tid; i < 1024 * 8 / 4; i += NTHR) *(LAS f32x4*)(RW + 4 * i) = *(const f32x4*)(router_w + 4 * i);
        if (C.tid < 8) CNT[C.tid] = 0u;
        __syncthreads();
    }
    f32x4 g4[4], b4[4];
#pragma unroll
    for (int j = 0; j < 4; ++j) { g4[j] = ((const f32x4*)gam)[64 * j + C.lane]; b4[j] = ((const f32x4*)bet)[64 * j + C.lane]; }
    const int RPB = M / C.G, row0 = C.bx * RPB;
    unsigned cnt0 = 0, cnt1 = 0, cnt2 = 0, cnt3 = 0, cnt4 = 0, cnt5 = 0, cnt6 = 0, cnt7 = 0;
    u32x2 xA[4], aA[4], bA[4], xB[4], aB[4], bB[4]; int sA0 = 0, sA1 = 0, sB0 = 0, sB1 = 0;
#define LN_LOAD(NX, NA, NB, mm, s0_, s1_) do { _Pragma("unroll") for (int j = 0; j < 4; ++j) { NX[j] = ((const u32x2*)(XB + (size_t)(mm) * DM))[64 * j + C.lane]; \
        if constexpr (MODE == 2) { NA[j] = ((const u32x2*)(add + (size_t)(s0_) * DM))[64 * j + C.lane]; NB[j] = ((const u32x2*)(add + (size_t)(s1_) * DM))[64 * j + C.lane]; } \
        else { NA[j] = ((const u32x2*)(add + (size_t)(mm) * DM))[64 * j + C.lane]; NB[j] = (u32x2){0u, 0u}; } } } while (0)
#define LN_SLOTS(s0_, s1_, rrr) do { if constexpr (MODE == 2) { if ((rrr) < RPB) { s0_ = TOKSLOT[2 * (row0 + (rrr))]; s1_ = TOKSLOT[2 * (row0 + (rrr)) + 1]; } } } while (0)
#define LN_ROW(NX, NA, NB, S0, S1, rr_) do { const int m = row0 + (rr_); \
        f32x4 v[4]; \
        _Pragma("unroll") for (int j = 0; j < 4; ++j) { v[j] = (f32x4){bflo(NX[j].x), bfhi(NX[j].x), bflo(NX[j].y), bfhi(NX[j].y)} * ALPHA + (f32x4){bflo(NA[j].x), bfhi(NA[j].x), bflo(NA[j].y), bfhi(NA[j].y)}; \
            if constexpr (MODE == 2) v[j] += (f32x4){bflo(NB[j].x), bfhi(NB[j].x), bflo(NB[j].y), bfhi(NB[j].y)}; } \
        if ((rr_) + 2 * NWAVES < RPB) { LN_LOAD(NX, NA, NB, m + 2 * NWAVES, S0, S1); LN_SLOTS(S0, S1, (rr_) + 4 * NWAVES); } \
        float s = 0.f; \
        _Pragma("unroll") for (int j = 0; j < 4; ++j) s += (v[j][0] + v[j][1]) + (v[j][2] + v[j][3]); \
        const float mean = wave_sum(s) * (1.0f / DM); float q = 0.f; \
        _Pragma("unroll") for (int j = 0; j < 4; ++j) { v[j] = v[j] - mean; q += (v[j][0] * v[j][0] + v[j][1] * v[j][1]) + (v[j][2] * v[j][2] + v[j][3] * v[j][3]); } \
        const float rstd = 1.0f / sqrtf(wave_sum(q) * (1.0f / DM) + EPS); \
        _Pragma("unroll") for (int j = 0; j < 4; ++j) { v[j] = v[j] * rstd * g4[j] + b4[j]; if (final) ((f32x4*)((dry ? jf + (size_t)(m & 8191) * DM : out + (size_t)m * DM)))[64 * j + C.lane] = v[j]; \
            ((u32x2*)((dry ? jb + (size_t)(m & 8191) * DM : XB + (size_t)m * DM)))[64 * j + C.lane] = (u32x2){pk2(v[j][0], v[j][1]), pk2(v[j][2], v[j][3])}; } \
        if constexpr (MODE == 1) { \
            float lg[8] = {0.f, 0.f, 0.f, 0.f, 0.f, 0.f, 0.f, 0.f}; \
            _Pragma("unroll") for (int j = 0; j < 4; ++j) \
                _Pragma("unroll") for (int i = 0; i < 4; ++i) { const int col = 256 * j + 4 * C.lane + i; const f32x4 w0 = *(const LAS f32x4*)(RW + col * 8), w1 = *(const LAS f32x4*)(RW + col * 8 + 4); const float xv = v[j][i]; \
                    lg[0] += xv * w0[0]; lg[1] += xv * w0[1]; lg[2] += xv * w0[2]; lg[3] += xv * w0[3]; lg[4] += xv * w1[0]; lg[5] += xv * w1[1]; lg[6] += xv * w1[2]; lg[7] += xv * w1[3]; } \
            _Pragma("unroll") for (int e = 0; e < 8; ++e) lg[e] = wave_sum(lg[e]); \
            int e1 = 0; float v1 = lg[0]; \
            _Pragma("unroll") for (int e = 1; e < 8; ++e) if (lg[e] > v1) { v1 = lg[e]; e1 = e; } \
            int e2 = -1; float v2 = -INFINITY; \
            _Pragma("unroll") for (int e = 0; e < 8; ++e) if (e != e1 && lg[e] > v2) { v2 = lg[e]; e2 = e; } \
            const float ex = fexp2((v2 - v1) * LOG2E), gA = 1.0f / (1.0f + ex), gB = ex * gA; \
            if (C.lane == 0) { TOPE[2 * m] = e1; TOPE[2 * m + 1] = e2; TOPG[2 * m] = gA; TOPG[2 * m + 1] = gB; } \
            cnt0 += (e1 == 0) + (e2 == 0); cnt1 += (e1 == 1) + (e2 == 1); cnt2 += (e1 == 2) + (e2 == 2); cnt3 += (e1 == 3) + (e2 == 3); \
            cnt4 += (e1 == 4) + (e2 == 4); cnt5 += (e1 == 5) + (e2 == 5); cnt6 += (e1 == 6) + (e2 == 6); cnt7 += (e1 == 7) + (e2 == 7); \
        } } while (0)
    LN_SLOTS(sA0, sA1, C.wave); LN_SLOTS(sB0, sB1, C.wave + NWAVES);
    LN_LOAD(xA, aA, bA, row0 + C.wave, sA0, sA1); LN_LOAD(xB, aB, bB, row0 + C.wave + NWAVES, sB0, sB1);
    LN_SLOTS(sA0, sA1, C.wave + 2 * NWAVES); LN_SLOTS(sB0, sB1, C.wave + 3 * NWAVES);
    for (int rr = C.wave; rr < RPB; rr += 2 * NWAVES) {
        LN_ROW(xA, aA, bA, sA0, sA1, rr);
        LN_ROW(xB, aB, bB, sB0, sB1, rr + NWAVES);
    }
    if constexpr (MODE == 1) {
        if (C.lane == 0) { atomicAdd((unsigned*)&CNT[0], cnt0); atomicAdd((unsigned*)&CNT[1], cnt1); atomicAdd((unsigned*)&CNT[2], cnt2); atomicAdd((unsigned*)&CNT[3], cnt3);
                           atomicAdd((unsigned*)&CNT[4], cnt4); atomicAdd((unsigned*)&CNT[5], cnt5); atomicAdd((unsigned*)&CNT[6], cnt6); atomicAdd((unsigned*)&CNT[7], cnt7); }
        __syncthreads();
        if (C.tid < 8) C.ctl[CW_CNTB + C.bx * 8 + C.tid] = CNT[C.tid];
        __syncthreads();
    }
    }
#undef LN_LOAD
#undef LN_SLOTS
#undef LN_ROW
}

__device__ __forceinline__ void moe_assign(Ctx& C) {
    if (C.wave != 0) return;
    const int* TOPE = (const int*)(C.ws + WS_MOE + MT_TOPE); const float* TOPG = (const float*)(C.ws + WS_MOE + MT_TOPG);
    int* TOKSLOT = (int*)(C.ws + WS_MOE + MT_TOKSLOT); int* SLOTTOK = (int*)(C.ws + WS_MOE + MT_SLOTTOK); float* SLOTGATE = (float*)(C.ws + WS_MOE + MT_SLOTGATE);
    const int blk = C.bx, RPB = M / C.G, row0 = blk * RPB;
    int tot[8] = {0, 0, 0, 0, 0, 0, 0, 0}, pre[8] = {0, 0, 0, 0, 0, 0, 0, 0};
    for (int bb = C.lane; bb < C.G; bb += 64) {
        const u32x4* cp = (const u32x4*)(C.ctl + CW_CNTB + bb * 8); const u32x4 ca = cp[0], cb = cp[1]; const int lt = bb < blk ? 1 : 0;
        const int c[8] = {(int)ca.x, (int)ca.y, (int)ca.z, (int)ca.w, (int)cb.x, (int)cb.y, (int)cb.z, (int)cb.w};
#pragma unroll
        for (int e = 0; e < 8; ++e) { tot[e] += c[e]; pre[e] += lt * c[e]; }
    }
#pragma unroll
    for (int e = 0; e < 8; ++e) { tot[e] = wave_sum_i(tot[e]); pre[e] = wave_sum_i(pre[e]); }
    int seg[9]; seg[0] = 0;
#pragma unroll
    for (int e = 0; e < 8; ++e) seg[e + 1] = seg[e] + ((tot[e] + 255) & ~255);
    int run[8];
#pragma unroll
    for (int e = 0; e < 8; ++e) run[e] = seg[e] + pre[e];
    const unsigned long long ltmask = (1ull << C.lane) - 1ull;
    for (int base = 0; base < RPB * 2; base += 64) {
        const int idx = base + C.lane, token = row0 + (idx >> 1), choice = idx & 1;
        const int ex = TOPE[2 * token + choice]; const float gate = TOPG[2 * token + choice]; int slot = 0;
#pragma unroll
        for (int e = 0; e < 8; ++e) { const unsigned long long mk = __builtin_amdgcn_ballot_w64(ex == e); if (ex == e) slot = run[e] + __popcll(mk & ltmask); run[e] += __popcll(mk); }
        SLOTTOK[slot] = token; SLOTGATE[slot] = gate; TOKSLOT[2 * token + choice] = slot;
    }
    if (blk < 8) {
        int lo = 0, hi = 0;
#pragma unroll
        for (int e = 0; e < 8; ++e) if (e == blk) { lo = seg[e] + tot[e]; hi = seg[e + 1]; }
        for (int s = lo + C.lane; s < hi; s += 64) { SLOTTOK[s] = 0; SLOTGATE[s] = 0.f; }
    }
    if (blk == 0 && C.lane == 0) {
#pragma unroll
        for (int e = 0; e < 9; ++e) C.ctl[CW_SEG + e] = (unsigned)seg[e];
    }
}

#ifndef MK_PER_PHASE
#define MK_PER_PHASE 0
#endif
#ifndef PH_ENABLE
#define PH_ENABLE 0xFFFF
#endif
constexpr int PH_PER_LAYER = 12, N_PHASES = 1 + DEPTH * PH_PER_LAYER;

__global__ void __launch_bounds__(NTHR, 2) fwd_kernel(Args args) {
    extern __shared__ __attribute__((aligned(16))) unsigned char lds_raw[];
    LAS unsigned char* const lds = (LAS unsigned char*)lds_raw;
    volatile LAS unsigned* MISC = (volatile LAS unsigned*)(lds + MISC_OFF);
    for (int u = threadIdx.x; u < (LDS_BYTES - LDSCTL_OFF) / 4; u += NTHR) ((LAS unsigned*)(lds + LDSCTL_OFF))[u] = 0u;
    __syncthreads();
    const int wave0 = __builtin_amdgcn_readfirstlane((int)threadIdx.x >> 6);
    XcdBarrier bar; bar.bar = (unsigned*)(args.ws + WS_CTL) + CW_BAR; bar.x = 0; bar.st = nullptr;
    if (!MK_PER_PHASE) bar = xcd_barrier_post((unsigned*)(args.ws + WS_CTL) + CW_BAR, MISC + 8, wave0);
    const int lo = args.ph_lo, hi = args.ph_hi;
#define IN(k) (lo <= (k) && (k) < hi)
#define EN(p) ((PH_ENABLE >> (p)) & 1)
#define SEAM(k) do { if (IN((k) + 1)) { if (!MK_PER_PHASE) { unsigned long long bw0_ = 0ull; if (PROBE_ON(14)) bw0_ = __builtin_amdgcn_s_memrealtime(); xcd_barrier<false>(bar, wave0); if ((REP_MASK >> 13) & 1) xcd_barrier<false>(bar, wave0); \
        if (PROBE_ON(14)) { const unsigned long long bw1_ = __builtin_amdgcn_s_memrealtime(), bd_ = bw1_ - bw0_; while (__builtin_amdgcn_s_memrealtime() - bw1_ < bd_) __builtin_amdgcn_s_sleep(8); } \
        if (PROBE_ON(13)) { const unsigned long long bw1_ = __builtin_amdgcn_s_memrealtime(); while (__builtin_amdgcn_s_memrealtime() - bw1_ < 2000ull) __builtin_amdgcn_s_sleep(8); } } } } while (0)
#define SEAM0(k) do { if (IN((k) + 1)) { if (!MK_PER_PHASE) xcd_barrier<true>(bar, wave0); } } while (0)
#define PHASE_CTX kargs_t A = opaque_args(); Ctx C = make_ctx(A, lds, wave0); unsigned char* sc = C.ws + WS_SCR; (void)sc

    PT0(15); if (EN(15) && IN(0)) { PHASE_CTX; p0_prologue(C, A); }
    PEND(15, SEAM0(0));

    for (int layer = 0; layer < DEPTH; ++layer) {
        const int P = 1 + layer * PH_PER_LAYER;
#ifdef FORCE_MOE
        const bool moe = FORCE_MOE != 0;
#else
        const bool moe = (layer & 1) != 0;
#endif
        if (EN(0) && IN(P + 0)) { PT0(0);
            PHASE_CTX;
            pg8::DenseOrder S{(const bf16*)(C.ws + WS_XB), (const bf16*)(C.ws + WS_WIN) + (size_t)layer * NP1 * DM, DM, DM, M / 256, NP1 / 256, C.G, C.bx, REPN(0)};
            EpiInProj E{(bf16*)(sc + SC_CQKV), (bf16*)(sc + SC_CQKV) + (size_t)M * 256, (float*)(sc + SC_KR), (float*)(sc + SC_FL), (bf16*)(sc + SC_FQ), (bf16*)(sc + SC_CI)};
            if (C.bx >= C.G / 2) { ffn_weights(C, A, layer, (C.bx - C.G / 2) * NWAVES + C.wave, (C.G / 2) * NWAVES, 0, ffn_split(layer)); __syncthreads(); }
            pg8::gemm_phase<EpiInProj, pg8::DenseOrder, false, DM, DM, DM>(C.lds, C.tid, S, E);
            PEND(0, SEAM(P + 0));
        }
        if (EN(1) && IN(P + 1)) { PT0(1); PHASE_CTX; p2_thin(C, A, layer); PEND(1, SEAM(P + 1)); }
        if (EN(2) && IN(P + 2)) { PT0(2);
            PHASE_CTX;
            struct QkvOrder { const bf16* A; const bf16* Bt; int G, c, rep;
                __device__ __forceinline__ bool next(int i, pg8::Unit& u) const { return pg8::tile_order_rep(i, G, c, M / 256, 7, rep, u.pm, u.pn); }
                __device__ __forceinline__ const char* a_base(const pg8::Unit& u) const { return (const char*)(A + (u.pn < 3 ? (size_t)0 : (size_t)M * 256)) + (size_t)u.pm * 256 * 256 * 2; }
                __device__ __forceinline__ const char* b_base(const pg8::Unit& u) const { return (const char*)Bt + (size_t)u.pn * 256 * 256 * 2; }
                __device__ __forceinline__ int tok(const pg8::Unit&, int) const { return 0; }
                __device__ __forceinline__ int ktiles(const pg8::Unit& u, int nt) const { return u.pn < 3 ? nt : nt / 2; } };
            QkvOrder S{(const bf16*)(sc + SC_CQKV), (const bf16*)(C.ws + WS_WQ2) + (size_t)layer * NP1 * 256, C.G, C.bx, REPN(2)};
            EpiQKV E{(bf16*)(sc + SC_QM), (bf16*)(sc + SC_KM), (bf16*)(sc + SC_VM), (const float*)(C.ws + WS_TAB), (const float*)(C.ws + WS_TAB) + (size_t)M * 16};
            pg8::gemm_phase<EpiQKV, QkvOrder, false, 256, 256, 256>(C.lds, C.tid, S, E);
            PEND(2, SEAM(P + 2));
        }
        if (EN(3) && IN(P + 3)) { PT0(3);
            PHASE_CTX;
            bf16* MIXED = (bf16*)(sc + SC_MIXED);
            for (int p = C.vcu; p < 512; p += C.G) { const int bh = p >> 3, s = p & 7;
                for (int i = 0; i < 2; ++i) att::attn_unit<96, false>(bh >> 3, bh & 7, i == 0 ? 15 - s : s, (const bf16*)(sc + SC_QM), 768, (const bf16*)(sc + SC_KM), 768, (const bf16*)(sc + SC_VM), 512, MIXED, 1024, (bh & 7) * 64, nullptr, C.lds, C.tid, (float*)(sc + SC_SSQ), bh & 7, nullptr);
            }
            { volatile LAS unsigned* qw = (volatile LAS unsigned*)(C.lds + RING_BYTES + 8192); const int xb = C.bx & 7; unsigned* qctr = C.ctl + CW_ATTQ + layer * 8 + xb;
              const bf16* FQ = (const bf16*)(sc + SC_FQ);
              for (;;) {
                if (C.tid == 0) qw[0] = __hip_atomic_fetch_add(qctr, 1u, RLX_AGENT);
                asm volatile("s_waitcnt vmcnt(0) lgkmcnt(0)\n\ts_barrier" ::: "memory");
                const int idx = __builtin_amdgcn_readfirstlane((int)qw[0]);
                if (idx >= 64) break;
                const int hd = idx & 3, qb = 15 - (idx >> 2), bh = xb * 4 + hd;
                att::attn_unit<64, true>(xb, hd, qb, FQ, 256, FQ + (size_t)M * 256, 256, FQ + (size_t)2 * M * 256, 256, MIXED, 1024, 512 + hd * 64, (const float*)(sc + SC_CUM), C.lds, C.tid, (float*)(sc + SC_SSQ), 8 + hd, C.ctl + CW_QKMAX + layer * 64 + bh * 2);
              }
            }
            PEND(3, SEAM(P + 3));
        }
        if (EN(5) && IN(P + 5)) { PT0(5);
            PHASE_CTX;
            pg8::DenseOrder S{(const bf16*)(sc + SC_MIXED), (const bf16*)(C.ws + WS_WOUT) + (size_t)layer * DM * DM, DM, DM, M / 256, DM / 256, C.G, C.bx, REPN(5)};
            EpiBf16<DM, false> E{(bf16*)(sc + SC_MIXOUT), DM / 256, nullptr};
            pg8::gemm_phase<EpiBf16<DM, false>, pg8::DenseOrder, false, DM, DM, DM, true>(C.lds, C.tid, S, E, (const float*)(sc + SC_SSQ));
            PEND(5, SEAM(P + 5));
        }
        if (EN(6) && IN(P + 6)) { PT0(6);
            if (moe) { PHASE_CTX; ln_pass<1>(C, false, (const bf16*)(sc + SC_MIXOUT), A->in[15] + layer * DM, A->in[16] + layer * DM, A->in[20] + (size_t)(layer >> 1) * DM * NEXP); }
            else     { PHASE_CTX; ln_pass<0>(C, false, (const bf16*)(sc + SC_MIXOUT), A->in[15] + layer * DM, A->in[16] + layer * DM, nullptr); }
            PEND(6, SEAM(P + 6));
        }
        if (EN(7) && IN(P + 7) && moe) { PT0(7); { PHASE_CTX; moe_assign(C); } PEND(7, SEAM(P + 7)); }
        if (EN(8) && IN(P + 8)) { PT0(8);
            if (moe) {
                PHASE_CTX; bf16* W13 = (bf16*)(C.ws + WS_WFFN); bf16* HID = (bf16*)(sc + SC_HID);
                const int* seg = (const int*)(C.ctl + CW_SEG);
                const int U = (seg[8] / 256) * 11;
                MoeIdxOrder<11> S{(const bf16*)(C.ws + WS_XB), W13, DM, DM, C.vcu, C.G, (U / C.G) * C.G, (const int*)(C.ws + WS_MOE + MT_SLOTTOK), seg[1], seg[2], seg[3], seg[4], seg[5], seg[6], seg[7]};
                EpiSwiGLU<DFE> E{HID, 11};
                pg8::gemm_phase<EpiSwiGLU<DFE>, MoeIdxOrder<11>, true, DM, DM, DM>(C.lds, C.tid, S, E);
            } else {
                PHASE_CTX; bf16* W13 = (bf16*)(C.ws + WS_WFFN); bf16* HID = (bf16*)(sc + SC_HID);
                pg8::DenseOrder S{(const bf16*)(C.ws + WS_XB), W13, DM, DM, M / 256, 2 * DFF / 256, C.G, C.bx, REPN(8)};
                EpiSwiGLU<DFF> E{HID, 1 << 30};
                pg8::gemm_phase<EpiSwiGLU<DFF>, pg8::DenseOrder, false, DM, DM, DM>(C.lds, C.tid, S, E);
            }
            PEND(8, SEAM(P + 8));
        }
        if (EN(9) && IN(P + 9)) { PT0(9);
            if (moe) {
                { PHASE_CTX; bf16* W13 = (bf16*)(C.ws + WS_WFFN); bf16* HID = (bf16*)(sc + SC_HID); const int* seg = (const int*)(C.ctl + CW_SEG);
                  const int U = (seg[8] / 256) * 11, UF = (U / C.G) * C.G;
                  if (UF + C.vcu < U) {
                      MoeIdxOrder<11> S{(const bf16*)(C.ws + WS_XB), W13, DM, DM, UF + C.vcu, C.G, U, (const int*)(C.ws + WS_MOE + MT_SLOTTOK), seg[1], seg[2], seg[3], seg[4], seg[5], seg[6], seg[7]};
                      EpiSwiGLU<DFE> E{HID, 11};
                      pg8::gemm_phase<EpiSwiGLU<DFE>, MoeIdxOrder<11>, true, DM, DM, DM>(C.lds, C.tid, S, E);
                      if (C.tid == 0) { __builtin_amdgcn_fence(__ATOMIC_RELEASE, "agent"); asm volatile("s_waitcnt vmcnt(0)" ::: "memory"); __hip_atomic_fetch_add(C.ctl + CW_LEFT + layer, 1u, RLX_AGENT); }
                  } }
                { PHASE_CTX; bf16* W2T = (bf16*)(C.ws + WS_WFFN) + WF_W13_ELEMS; bf16* HID = (bf16*)(sc + SC_HID); bf16* FF = (bf16*)(sc + SC_FF); const int* seg = (const int*)(C.ctl + CW_SEG);
                  const int U = (seg[8] / 256) * 11, UF = (U / C.G) * C.G, DF = (UF / 11) * 4;
                  MoeIdxOrder<4> S{HID, W2T, DFE, DFE, C.vcu, C.G, DF, nullptr, seg[1], seg[2], seg[3], seg[4], seg[5], seg[6], seg[7]};
                  EpiBf16<DM, true> E{FF, 4, (const float*)(C.ws + WS_MOE + MT_SLOTGATE)};
                  pg8::gemm_phase<EpiBf16<DM, true>, MoeIdxOrder<4>, false, DFE, DFE, DFE>(C.lds, C.tid, S, E); }
                { PHASE_CTX; bf16* W2T = (bf16*)(C.ws + WS_WFFN) + WF_W13_ELEMS; bf16* HID = (bf16*)(sc + SC_HID); bf16* FF = (bf16*)(sc + SC_FF); const int* seg = (const int*)(C.ctl + CW_SEG);
                  const int nM = seg[8] / 256, U = nM * 11, UF = (U / C.G) * C.G, DF = (UF / 11) * 4;
                  if (DF + (C.G - 1 - C.vcu) < nM * 4) {
                      if (C.wave == 0) { const unsigned need = (unsigned)(U - UF); unsigned* cw = C.ctl + CW_LEFT + layer;
                          while ((unsigned)__builtin_amdgcn_readfirstlane((int)__hip_atomic_load(cw, RLX_AGENT)) < need) __builtin_amdgcn_s_sleep(4);
                          __builtin_amdgcn_fence(__ATOMIC_ACQUIRE, "agent"); asm volatile("s_waitcnt vmcnt(0)" ::: "memory"); }
                      __syncthreads();
                      MoeIdxOrder<4> S{HID, W2T, DFE, DFE, DF + (C.G - 1 - C.vcu), C.G, nM * 4, nullptr, seg[1], seg[2], seg[3], seg[4], seg[5], seg[6], seg[7]};
                      EpiBf16<DM, true> E{FF, 4, (const float*)(C.ws + WS_MOE + MT_SLOTGATE)};
                      pg8::gemm_phase<EpiBf16<DM, true>, MoeIdxOrder<4>, false, DFE, DFE, DFE>(C.lds, C.tid, S, E);
                  } }
            } else {
                PHASE_CTX; bf16* W2T = (bf16*)(C.ws + WS_WFFN) + WF_W13_ELEMS; bf16* HID = (bf16*)(sc + SC_HID); bf16* FF = (bf16*)(sc + SC_FF);
                pg8::DenseOrder S{HID, W2T, DFF, DFF, M / 256, DM / 256, C.G, C.bx, REPN(9)};
                EpiBf16<DM, false> E{FF, DM / 256, nullptr};
                pg8::gemm_phase<EpiBf16<DM, false>, pg8::DenseOrder, false, DFF, DFF, DFF>(C.lds, C.tid, S, E);
            }
            PEND(9, SEAM(P + 9));
        }
        if (EN(10) && IN(P + 10)) { PT0(10);
            if (moe) { PHASE_CTX; ln_pass<2>(C, layer == DEPTH - 1, (const bf16*)(sc + SC_FF), A->in[24] + layer * DM, A->in[25] + layer * DM, nullptr); }
            else     { PHASE_CTX; ln_pass<0>(C, layer == DEPTH - 1, (const bf16*)(sc + SC_FF), A->in[24] + layer * DM, A->in[25] + layer * DM, nullptr); }
            PEND(10, if (layer < DEPTH - 1) SEAM(P + 10));
        }
    }
#undef IN
#undef SEAM
}

extern "C" void kernel_launch(void* const* d_in, const int* in_sizes, int n_in, void* d_out, int out_size, void* d_ws, size_t ws_size, hipStream_t stream) {
    static int grid = 0;
    if (grid == 0) {
        if (n_in != 26 || out_size != M * DM || ws_size < WS_END) { fprintf(stderr, "kernel_launch: unexpected problem (n_in %d, out %d, ws %zu < %zu)\n", n_in, out_size, ws_size, (size_t)WS_END); grid = -1; return; }
        int dev = 0, cus = 0, per_cu = 0;
        if (hipGetDevice(&dev) != hipSuccess || hipDeviceGetAttribute(&cus, hipDeviceAttributeMultiprocessorCount, dev) != hipSuccess) { grid = -1; return; }
        if (hipFuncSetAttribute((const void*)fwd_kernel, hipFuncAttributeMaxDynamicSharedMemorySize, LDS_BYTES) != hipSuccess) { fprintf(stderr, "kernel_launch: hipFuncSetAttribute failed\n"); grid = -1; return; }
        if (hipOccupancyMaxActiveBlocksPerMultiprocessor(&per_cu, (const void*)fwd_kernel, NTHR, LDS_BYTES) != hipSuccess || per_cu < 1) fprintf(stderr, "kernel_launch: occupancy query says %d\n", per_cu);
        (void)hipGetLastError();
        grid = 256; while (grid > cus && grid > 8) grid >>= 1;
    }
    if (grid < 0) return;
    (void)hipMemsetAsync((char*)d_ws + WS_CTL, 0, CTL_ZERO_BYTES, stream);
    Args a{};
    for (int i = 0; i < 26; ++i) a.in[i] = (const float*)d_in[i];
    a.out = (float*)d_out; a.ws = (unsigned char*)d_ws;
#if MK_PER_PHASE
    for (int p = 0; p < N_PHASES; ++p) { a.ph_lo = p; a.ph_hi = p + 1; hipLaunchKernelGGL(fwd_kernel, dim3(grid), dim3(NTHR), LDS_BYTES, stream, a); }
#else
    a.ph_lo = 0; a.ph_hi = N_PHASES;
    hipLaunchKernelGGL(fwd_kernel, dim3(grid), dim3(NTHR), LDS_BYTES, stream, a);
#endif
}
```

```cpp
#include <hip/hip_runtime.h>
#include <cstdio>
#include <cstdint>
#include <cmath>

#ifndef REP_MASK
#define REP_MASK 0x0
#endif
#ifndef PROBE_MASK
#define PROBE_MASK 0x0
#endif
#define PROBE_ON(k) ((PROBE_MASK >> (k)) & 1)
#define PT0(k) unsigned long long pt0_ = 0ull; if (PROBE_ON(k)) pt0_ = __builtin_amdgcn_s_memrealtime()
#ifndef PROBE_BEFORE
#define PROBE_BEFORE 0
#endif
#define PSPIN(d) do { const unsigned long long pt1_ = __builtin_amdgcn_s_memrealtime(); while (__builtin_amdgcn_s_memrealtime() - pt1_ < (d)) __builtin_amdgcn_s_sleep(8); } while (0)
#define PEND(k, seamexpr) do { unsigned long long pd_ = 0ull; if (PROBE_ON(k)) { pd_ = __builtin_amdgcn_s_memrealtime() - pt0_; if (PROBE_BEFORE) PSPIN(pd_); } seamexpr; \
        if (PROBE_ON(k) && !PROBE_BEFORE) PSPIN(pd_); } while (0)
#define REPN(p) (1 + ((REP_MASK >> (p)) & 1))
#define REPS(p) for (int rep_ = 0; rep_ < 1 + ((REP_MASK >> (p)) & 1); ++rep_)
#define GAS __attribute__((address_space(1)))
#define LAS __attribute__((address_space(3)))
typedef unsigned short bf16;
typedef short bf16x8 __attribute__((ext_vector_type(8)));
typedef short s16x4 __attribute__((ext_vector_type(4)));
typedef float f32x2 __attribute__((ext_vector_type(2)));
typedef float f32x4 __attribute__((ext_vector_type(4)));
typedef float f32x16 __attribute__((ext_vector_type(16)));
typedef unsigned u32x2 __attribute__((ext_vector_type(2)));
typedef unsigned u32x4 __attribute__((ext_vector_type(4)));
typedef __bf16 bf16x2_t __attribute__((ext_vector_type(2)));

constexpr int BATCH = 8, SEQ = 4096, DM = 1024, M = BATCH * SEQ, DEPTH = 4;
constexpr int IN_COLS = 1700, NP1 = 1792;
constexpr int DFF = 2816, DFE = 1408, NEXP = 8;
constexpr int NWAVES = 8, NTHR = 512;
constexpr float ALPHA = 1.6817928305074290f;
constexpr float EPS = 1e-5f;
constexpr float LOG2E = 1.4426950408889634f;
constexpr float C2_MLA = 0.10206207261596577f * LOG2E;
constexpr float C2_FOX = 0.125f * LOG2E;
constexpr int PC_CQ = 0, PC_CKV = 256, PC_KR = 384, PC_FL = 416, PC_FQ = 512, PC_FK = 768, PC_FV = 1024, PC_CI = 1280;
constexpr int MOE_ROWS_MAX = 2 * M + NEXP * 256;

constexpr size_t MiB = 1u << 20;
constexpr size_t WS_CTL = 0, CTL_ZERO_BYTES = 1 * MiB;
constexpr size_t WS_WIN = 1 * MiB;
constexpr size_t WS_WQ2 = WS_WIN + 14 * MiB;
constexpr size_t WS_WOUT = WS_WQ2 + 4 * MiB;
constexpr size_t WS_TAB = WS_WOUT + 8 * MiB;
constexpr size_t WS_MOE = WS_TAB + 4 * MiB;
constexpr size_t WS_WFFN = WS_MOE + 2 * MiB;
constexpr size_t WS_XB = WS_WFFN + 68 * MiB;
constexpr size_t WS_SCR = WS_XB + 64 * MiB;
constexpr size_t SC_CQKV = 0;
constexpr size_t SC_KR = SC_CQKV + 32 * MiB;
constexpr size_t SC_FL = SC_KR + 4 * MiB;
constexpr size_t SC_CUM = SC_FL + MiB / 2;
constexpr size_t SC_FQ = SC_CUM + MiB / 2;
constexpr size_t SC_CI = SC_FQ + 48 * MiB;
constexpr size_t SC_RSQ = SC_CI + 16 * MiB;
constexpr size_t SC_QM = SC_CI + 32 * MiB;
constexpr size_t SC_KM = SC_QM + 48 * MiB;
constexpr size_t SC_VM = SC_KM + 48 * MiB;
constexpr size_t SC_MIXED = SC_VM + 32 * MiB;
constexpr size_t SC_MIXOUT = SC_QM;
constexpr size_t SC_SSQ = SC_MIXED + 64 * MiB;
constexpr size_t SC_MIX_END = SC_SSQ + 2 * MiB;
constexpr size_t SC_HID = 0;
constexpr size_t SC_FF = 182 * MiB;
constexpr size_t SC_END = 316 * MiB;
constexpr size_t WS_END = WS_SCR + SC_END;
static_assert(SC_MIX_END <= SC_END && SC_FF + (size_t)MOE_ROWS_MAX * 1024 * 2 <= SC_END && (size_t)MOE_ROWS_MAX * DFE * 2 <= SC_FF, "scratch map");
static_assert(WS_END <= 512 * MiB, "workspace map");
constexpr size_t WF_W13_ELEMS = (size_t)NEXP * 2 * DFE * DM;
constexpr size_t MT_TOPE = 0;
constexpr size_t MT_TOPG = 256 * 1024;
constexpr size_t MT_TOKSLOT = 512 * 1024;
constexpr size_t MT_SLOTTOK = 768 * 1024;
constexpr size_t MT_SLOTGATE = 768 * 1024 + 272 * 1024;
static_assert((size_t)MOE_ROWS_MAX * 4 <= 272 * 1024 && MT_SLOTGATE + 272 * 1024 <= 2 * MiB, "moe tables");
constexpr int CW_BAR = 4096;
constexpr int CW_CNTB = 16384;
constexpr int CW_SEG = 20480;
constexpr int CW_ATTQ = 2048;
constexpr int CW_LEFT = 2112;
constexpr int CW_QKMAX = 1024;

constexpr int RING_BYTES = 131072;
constexpr int LDSCTL_OFF = RING_BYTES, MISC_OFF = LDSCTL_OFF + 320;
constexpr int LDS_BYTES = 147456;

#define RLX_AGENT __ATOMIC_RELAXED, __HIP_MEMORY_SCOPE_AGENT
__device__ __forceinline__ unsigned pk2(float lo, float hi) { f32x2 v = {lo, hi}; bf16x2_t b = __builtin_convertvector(v, bf16x2_t); return __builtin_bit_cast(unsigned, b); }
__device__ __forceinline__ float bf2f(unsigned short u) { return __uint_as_float((unsigned)u << 16); }
__device__ __forceinline__ float bflo(unsigned u) { return __uint_as_float(u << 16); }
__device__ __forceinline__ float bfhi(unsigned u) { return __uint_as_float(u & 0xffff0000u); }
__device__ __forceinline__ float fexp2(float x) { return __builtin_amdgcn_exp2f(x); }
__device__ __forceinline__ float frcp(float x) { return __builtin_amdgcn_rcpf(x); }
__device__ __forceinline__ float sigmoidf_(float x) { return frcp(1.0f + fexp2(-x * LOG2E)); }
__device__ __forceinline__ float siluf_(float x) { return x * sigmoidf_(x); }
template <int O> __device__ __forceinline__ float lane_xor(float v) {
    if constexpr (O < 32) return __int_as_float(__builtin_amdgcn_ds_swizzle(__float_as_int(v), (O << 10) | 0x1f));
    else { auto rr = __builtin_amdgcn_permlane32_swap(__float_as_uint(v), __float_as_uint(v), false, false); return __uint_as_float(rr[0]) == v ? __uint_as_float(rr[1]) : __uint_as_float(rr[0]); }
}
__device__ __forceinline__ float wave_sum(float v) {
    v += lane_xor<1>(v); v += lane_xor<2>(v); v += lane_xor<4>(v); v += lane_xor<8>(v); v += lane_xor<16>(v);
    { auto rr = __builtin_amdgcn_permlane32_swap(__float_as_uint(v), __float_as_uint(v), false, false); v = __uint_as_float(rr[0]) + __uint_as_float(rr[1]); }
    return v;
}
__device__ __forceinline__ int wave_sum_i(int v) {
    v += __builtin_amdgcn_ds_swizzle(v, (1 << 10) | 0x1f); v += __builtin_amdgcn_ds_swizzle(v, (2 << 10) | 0x1f); v += __builtin_amdgcn_ds_swizzle(v, (4 << 10) | 0x1f);
    v += __builtin_amdgcn_ds_swizzle(v, (8 << 10) | 0x1f); v += __builtin_amdgcn_ds_swizzle(v, (16 << 10) | 0x1f);
    { auto rr = __builtin_amdgcn_permlane32_swap((unsigned)v, (unsigned)v, false, false); v = (int)(rr[0] + rr[1]); }
    return v;
}
__device__ __forceinline__ u32x4 pack8(const f32x4 a, const f32x4 b) { u32x4 w; w.x = pk2(a[0], a[1]); w.y = pk2(a[2], a[3]); w.z = pk2(b[0], b[1]); w.w = pk2(b[2], b[3]); return w; }

#define XB_TMO      128
#define XB_XCNT(j)  (256  + 64 * (j))
#define XB_XSUB(j)  (1280 + 64 * (j))
#define XB_XGEN(j)  (2304 + 64 * (j))
#define XB_TOP      3328
#define XB_TOPGEN   3392
#define XCD_BAR_WORDS 3456
#define XB_SPIN_CAP (1u << 18)
__device__ __forceinline__ unsigned xb_ld(unsigned* p)              { return __hip_atomic_load(p, __ATOMIC_RELAXED, __HIP_MEMORY_SCOPE_AGENT); }
__device__ __forceinline__ unsigned xb_add(unsigned* p, unsigned v) { return __hip_atomic_fetch_add(p, v, __ATOMIC_RELAXED, __HIP_MEMORY_SCOPE_AGENT); }
__device__ __forceinline__ unsigned xb_xcc_id() { return (unsigned)__builtin_amdgcn_s_getreg((3 << 11) | 20) & 0xFu; }
#define XB_SPIN(cond, bar) do { unsigned _sp = 0; while (cond) { __builtin_amdgcn_s_sleep(1); \
    if ((++_sp & 255u) == 0u) { if (xb_ld(&(bar)[XB_TMO])) break; if (_sp > XB_SPIN_CAP) { atomicAdd(&(bar)[XB_TMO], 1u); break; } } } } while (0)
struct XcdBarrier { unsigned* bar; unsigned x; volatile LAS unsigned* st; };
__device__ __forceinline__ bool xb_is_t0(int wave0) { unsigned ones = ~0u; asm volatile("" : "+s"(ones)); return wave0 == 0 && __builtin_amdgcn_mbcnt_hi(ones, __builtin_amdgcn_mbcnt_lo(ones, 0u)) == 0u; }
__device__ __forceinline__ XcdBarrier xcd_barrier_post(unsigned* bar, volatile LAS unsigned* st, int wave0) {
    XcdBarrier b; b.bar = bar; b.x = xb_xcc_id(); b.st = st;
    if (xb_is_t0(wave0)) (void)xb_add(&bar[XB_XCNT(b.x)], 1u);
    return b;
}
__device__ __forceinline__ void xcd_barrier_complete(unsigned* bar, unsigned x, unsigned& nloc, unsigned& nx) {
    const unsigned G = gridDim.x * gridDim.y * gridDim.z;
    unsigned sum, cnt, mine, sp = 0u;
    for (;;) {
        sum = 0u; cnt = 0u; mine = 0u;
#pragma unroll
        for (unsigned j = 0; j < 16; ++j) { const unsigned c = xb_ld(&bar[XB_XCNT(j)]); sum += c; cnt += (c > 0u) ? 1u : 0u; mine = (j == x) ? c : mine; }
        if (sum == G) break;
        __builtin_amdgcn_s_sleep(1);
        if ((++sp & 255u) == 0u) { if (xb_ld(&bar[XB_TMO])) break; if (sp > XB_SPIN_CAP) { atomicAdd(&bar[XB_TMO], 1u); break; } }
    }
    nloc = mine > 0u ? mine : 1u; nx = cnt > 0u ? cnt : 1u;
}
template <bool FIRST>
__device__ __forceinline__ void xcd_barrier(const XcdBarrier& b, int wave0) {
    asm volatile("s_waitcnt vmcnt(0)" ::: "memory");
    __syncthreads();
    if (xb_is_t0(wave0)) {
        unsigned* bar = b.bar;
        __builtin_amdgcn_s_waitcnt(0);
        unsigned nloc = b.st[0], nx = b.st[1];
        if constexpr (FIRST) { if (nloc == 0u) { xcd_barrier_complete(bar, b.x, nloc, nx); b.st[0] = nloc; b.st[1] = nx; } }
        const unsigned old = xb_add(&bar[XB_XSUB(b.x)], 1u);
        const unsigned gen = old / nloc;
        if (old + 1u == (gen + 1u) * nloc) {
            __builtin_amdgcn_fence(__ATOMIC_RELEASE, "agent");
            asm volatile("s_waitcnt vmcnt(0)" ::: "memory");
            const unsigned og = xb_add(&bar[XB_TOP], 1u);
            const unsigned tg = og / nx;
            if (og + 1u == (tg + 1u) * nx) xb_add(&bar[XB_TOPGEN], 1u);
            else XB_SPIN(xb_ld(&bar[XB_TOPGEN]) == tg, bar);
            __builtin_amdgcn_fence(__ATOMIC_ACQUIRE, "agent");
            xb_add(&bar[XB_XGEN(b.x)], 1u);
            asm volatile("s_waitcnt vmcnt(0)" ::: "memory");
        } else {
            XB_SPIN(xb_ld(&bar[XB_XGEN(b.x)]) == gen, bar);
            __builtin_amdgcn_fence(__ATOMIC_ACQUIRE, "agent");
            asm volatile("s_waitcnt vmcnt(0)" ::: "memory");
        }
    }
    __syncthreads();
}

namespace pg8 {
constexpr int BM = 256, BK = 64, HALF = 128, HTB = HALF * BK * 2, STAGE_BYTES = 8 * HTB, NXCD = 8, WGM = 8;
__host__ __device__ __forceinline__ int lds_byte(int r, int c) { const int st = (r >> 4) * 2 + (c >> 5), rr = r & 15, cc = c & 31, ob = rr * 64 + cc * 2; return st * 1024 + (ob ^ (((ob >> 9) & 1) << 5)); }
__host__ __device__ __forceinline__ void stage_rc(int b, int& R, int& C) { const int st = b / 1024, sb = b % 1024, swz = sb ^ (((sb >> 9) & 1) << 5); R = (st >> 1) * 16 + swz / 64; C = (st & 1) * 32 + (swz % 64) / 2; }
__host__ __device__ __forceinline__ int perm32(int rho) { const int n = rho >> 4, i = rho & 15; return 8 * (i >> 2) + 4 * n + (i & 3); }
struct Unit { int pm, pn; };

__device__ __forceinline__ bool tile_order(long L, int nM, int nN, int& pm, int& pn) {
    const int nwg = nM * nN; if (L >= nwg) return false;
    int wgid = (int)L; { const int q = nwg / NXCD, r = nwg % NXCD, xcd = wgid % NXCD, off = wgid / NXCD; wgid = (xcd < r ? xcd * (q + 1) : r * (q + 1) + (xcd - r) * q) + off; }
    const int nig = WGM * nN, gid = wgid / nig, fm = gid * WGM, gsz = (nM - fm) < WGM ? (nM - fm) : WGM;
    pm = fm + ((wgid % nig) % gsz); pn = (wgid % nig) / gsz; return true;
}
__device__ __forceinline__ bool tile_order_rep(int i, int G, int c, int nM, int nN, int rep, int& pm, int& pn) {
    if (rep == 1) return tile_order((long)i * G + c, nM, nN, pm, pn);
    const int nwg = nM * nN, per = c < nwg ? (nwg - c + G - 1) / G : 0; if (i >= per * rep) return false;
    return tile_order((long)(i % per) * G + c, nM, nN, pm, pn);
}
struct DenseOrder {
    const bf16* A; const bf16* Bt; int lda, ldb, nM, nN, G, c, rep;
    __device__ __forceinline__ bool next(int i, Unit& u) const { return tile_order_rep(i, G, c, nM, nN, rep, u.pm, u.pn); }
    __device__ __forceinline__ const char* a_base(const Unit& u) const { return (const char*)A + (size_t)u.pm * BM * lda * 2; }
    __device__ __forceinline__ const char* b_base(const Unit& u) const { return (const char*)Bt + (size_t)u.pn * BM * ldb * 2; }
    __device__ __forceinline__ int tok(const Unit&, int) const { return 0; }
    __device__ __forceinline__ int ktiles(const Unit&, int nt) const { return nt; }
};

template <class Epi, class Sched, bool GATHER, int K, int lda, int ldb, bool SEGSCALE = false>
__device__ __forceinline__ void gemm_phase(LAS unsigned char* lds, const int tid, const Sched& S, const Epi& E, const float* ssq = nullptr) {
    const int wid = __builtin_amdgcn_readfirstlane(tid >> 6), lane = tid & 63, wr = wid >> 2, wc = wid & 3, fr = lane & 15, fq = lane >> 4;
    constexpr int nt = K / BK;
    unsigned voffA[2], voffB[2];
#pragma unroll
    for (int i = 0; i < 2; ++i) { int R, C; stage_rc(tid * 16 + i * 8192, R, C); const int Rb = Epi::PERM ? ((R & ~31) + perm32(R & 31)) : R;
        voffA[i] = (unsigned)(R * lda + C) * 2u; voffB[i] = (unsigned)(Rb * ldb + C) * 2u; }
#define PG8_GOFF(u_, h_, o0_, o1_) do { unsigned ones_ = ~0u; asm volatile("" : "+s"(ones_)); const int t_ = wid * 64 + (int)__builtin_amdgcn_mbcnt_hi(ones_, __builtin_amdgcn_mbcnt_lo(ones_, 0u)); \
        int R0_, C0_, R1_, C1_; stage_rc(t_ * 16, R0_, C0_); stage_rc(t_ * 16 + 8192, R1_, C1_); \
        o0_ = (unsigned)S.tok(u_, (h_) * HALF + R0_) * (unsigned)(lda * 2) + (unsigned)(C0_ * 2); o1_ = (unsigned)S.tok(u_, (h_) * HALF + R1_) * (unsigned)(lda * 2) + (unsigned)(C1_ * 2); } while (0)
    const size_t kstep = (size_t)(BK * 2);
    constexpr size_t hstepA = (size_t)HALF * lda * 2, hstepB = (size_t)HALF * ldb * 2;
    const unsigned ldsw = (unsigned)wid * 1024u;
    const int aoff = lds_byte(wr * 64 + fr, fq * 8), boff = lds_byte(wc * 32 + fr, fq * 8);
#define PG8_SA(b, h) (((b) * 2 + (h)) * HTB)
#define PG8_SB(b, h) ((4 + (b) * 2 + (h)) * HTB)
#define PG8_STAGE(bufoff, gbase, v0, v1) do { \
        __builtin_amdgcn_global_load_lds((const unsigned*)((const char*)(gbase) + (v0)), (LAS unsigned*)(lds + (bufoff) + ldsw), 16, 0, 0); \
        __builtin_amdgcn_global_load_lds((const unsigned*)((const char*)(gbase) + (v1)), (LAS unsigned*)(lds + (bufoff) + ldsw + 8192), 16, 0, 0); } while (0)
#define PG8_STB(bufoff, gbase) PG8_STAGE(bufoff, gbase, voffB[0], voffB[1])
#define PG8_STA(bufoff, gbase, h, G0, G1) do { if constexpr (GATHER) PG8_STAGE(bufoff, gbase, G0, G1); else PG8_STAGE(bufoff, (gbase) + (h) * hstepA, voffA[0], voffA[1]); } while (0)
#define PG8_LDA(dst, b, h) do { _Pragma("unroll") for (int m = 0; m < 4; ++m) _Pragma("unroll") for (int k = 0; k < 2; ++k) dst[m][k] = *(const LAS bf16x8*)(lds + PG8_SA(b, h) + aoff + m * 2048 + k * 1024); } while (0)
#define PG8_LDB(dst, b, h) do { _Pragma("unroll") for (int n = 0; n < 2; ++n) _Pragma("unroll") for (int k = 0; k < 2; ++k) dst[n][k] = *(const LAS bf16x8*)(lds + PG8_SB(b, h) + boff + n * 2048 + k * 1024); } while (0)
#define PG8_MMA(ai, bj, At, Bt) do { __builtin_amdgcn_s_setprio(1); _Pragma("unroll") for (int m = 0; m < 4; ++m) _Pragma("unroll") for (int n = 0; n < 2; ++n) _Pragma("unroll") for (int k = 0; k < 2; ++k) \
        acc[ai][bj][m][n] = __builtin_amdgcn_mfma_f32_16x16x32_bf16(Bt[n][k], At[m][k], acc[ai][bj][m][n], 0, 0, 0); __builtin_amdgcn_s_setprio(0); } while (0)
#define PG8_WAIT_V(n) asm volatile("s_waitcnt vmcnt(" #n ")" ::: "memory")
#define PG8_WAIT_L(n) asm volatile("s_waitcnt lgkmcnt(" #n ")" ::: "memory")
#define PG8_BAR __builtin_amdgcn_s_barrier()
#define PG8_SCHED __builtin_amdgcn_sched_barrier(0)
    Unit cur, nxt; int ui = 0;
    if (!S.next(0, cur)) return;
    f32x4 acc[2][2][4][2];
#pragma unroll
    for (int a = 0; a < 2; ++a)
#pragma unroll
        for (int b = 0; b < 2; ++b)
#pragma unroll
            for (int m = 0; m < 4; ++m)
#pragma unroll
                for (int n = 0; n < 2; ++n) acc[a][b][m][n] = (f32x4){0.f, 0.f, 0.f, 0.f};
    bf16x8 At[4][2], B0[2][2], B1[2][2];
    const char* cA = S.a_base(cur); const char* cB = S.b_base(cur);
    unsigned gc00 = 0, gc01 = 0, gc10 = 0, gc11 = 0, gn00 = 0, gn01 = 0, gn10 = 0, gn11 = 0;
    if constexpr (GATHER) { PG8_GOFF(cur, 0, gc00, gc01); PG8_GOFF(cur, 1, gc10, gc11); }
    PG8_STB(PG8_SB(0, 0), cB); PG8_STB(PG8_SB(0, 1), cB + hstepB); PG8_STA(PG8_SA(0, 0), cA, 0, gc00, gc01); PG8_STA(PG8_SA(0, 1), cA, 1, gc10, gc11);
    if (wr == 1) PG8_BAR;
    PG8_WAIT_V(2); PG8_BAR;
    PG8_STB(PG8_SB(1, 0), cB + kstep); PG8_STA(PG8_SA(1, 0), cA + kstep, 0, gc00, gc01); PG8_STB(PG8_SB(1, 1), cB + hstepB + kstep);
    PG8_WAIT_V(6); PG8_BAR;
    for (;;) {
        const bool has_next = S.next(ui + 1, nxt);
        const char* nA = has_next ? S.a_base(nxt) : cA; const char* nB = has_next ? S.b_base(nxt) : cB;
        if constexpr (SEGSCALE) {
            if (tid < 256) { const f32x4* sp = (const f32x4*)(ssq + (size_t)(cur.pm * 256 + tid) * 12); const f32x4 a = sp[0], b = sp[1], c = sp[2];
                const float sm = ((a[0] + a[1]) + (a[2] + a[3])) + ((b[0] + b[1]) + (b[2] + b[3])), sf = (c[0] + c[1]) + (c[2] + c[3]);
                const float rm = 1.0f / sqrtf(sm * (1.0f / 512) + EPS), rf = 1.0f / sqrtf(sf * (1.0f / 256) + EPS);
                *(LAS f32x2*)(lds + STAGE_BYTES + 1024 + tid * 8) = (f32x2){rm / rf, rf}; }
        }
        if constexpr (GATHER) {
            if (has_next) { PG8_GOFF(nxt, 0, gn00, gn01); PG8_GOFF(nxt, 1, gn10, gn11); }
            else { gn00 = gc00; gn01 = gc01; gn10 = gc10; gn11 = gc11; }
        }
        const int ntu = S.ktiles(cur, nt);
#pragma nounroll
        for (int t = 0; t < ntu; t += 2) {
            const bool last = (t == ntu - 2);
            const char* a1 = cA + (size_t)(t + 1) * kstep;
            const char* a2 = last ? nA : cA + (size_t)(t + 2) * kstep; const char* b2 = last ? nB : cB + (size_t)(t + 2) * kstep;
            const char* a3 = a2 + kstep; const char* b3 = b2 + kstep;
            const unsigned g00 = last ? gn00 : gc00, g01 = last ? gn01 : gc01, g10 = last ? gn10 : gc10, g11 = last ? gn11 : gc11;
            PG8_LDB(B0, 0, 0); PG8_LDB(B1, 0, 1); PG8_SCHED; PG8_LDA(At, 0, 0); PG8_STA(PG8_SA(1, 1), a1, 1, gc10, gc11);
            PG8_WAIT_V(8); PG8_WAIT_L(0); PG8_BAR; PG8_MMA(0, 0, At, B0); PG8_MMA(0, 1, At, B1); PG8_BAR; PG8_SCHED;
            PG8_LDA(At, 0, 1); PG8_STB(PG8_SB(0, 0), b2); PG8_STB(PG8_SB(0, 1), b2 + hstepB); PG8_STA(PG8_SA(0, 0), a2, 0, g00, g01);
            PG8_WAIT_V(8); PG8_WAIT_L(0); PG8_BAR; PG8_MMA(1, 0, At, B0); PG8_MMA(1, 1, At, B1); PG8_BAR; PG8_SCHED;
            PG8_LDB(B0, 1, 0); PG8_LDB(B1, 1, 1); PG8_SCHED; PG8_LDA(At, 1, 0); PG8_STA(PG8_SA(0, 1), a2, 1, g10, g11);
            PG8_WAIT_V(8); PG8_WAIT_L(0); PG8_BAR; PG8_MMA(0, 0, At, B0); PG8_MMA(0, 1, At, B1); PG8_BAR; PG8_SCHED;
            PG8_LDA(At, 1, 1); PG8_STB(PG8_SB(1, 0), b3); PG8_STB(PG8_SB(1, 1), b3 + hstepB); PG8_STA(PG8_SA(1, 0), a3, 0, g00, g01);
            PG8_WAIT_V(8); PG8_WAIT_L(0); PG8_BAR; PG8_MMA(1, 0, At, B0); PG8_MMA(1, 1, At, B1); PG8_BAR; PG8_SCHED;
            if constexpr (SEGSCALE) {
                if (t == 6 || t == 10) {
                    unsigned ones_ = ~0u; asm volatile("" : "+s"(ones_)); const int fr_ = (int)__builtin_amdgcn_mbcnt_hi(ones_, __builtin_amdgcn_mbcnt_lo(ones_, 0u)) & 15;
                    const LAS float* fp = (const LAS float*)(lds + STAGE_BYTES + 1024) + (wr * 64 + fr_) * 2 + (t == 10 ? 1 : 0);
#pragma unroll
                    for (int ai = 0; ai < 2; ++ai)
#pragma unroll
                        for (int m = 0; m < 4; ++m) { const float f = fp[(ai * 128 + m * 16) * 2];
#pragma unroll
                            for (int bj = 0; bj < 2; ++bj)
#pragma unroll
                                for (int n = 0; n < 2; ++n) acc[ai][bj][m][n] *= f; }
                    PG8_SCHED;
                }
            }
        }
        if (wr == 0) PG8_BAR;
        { unsigned ones_ = ~0u; asm volatile("" : "+s"(ones_)); const int l_ = (int)__builtin_amdgcn_mbcnt_hi(ones_, __builtin_amdgcn_mbcnt_lo(ones_, 0u)); E(acc, cur, wr, wc, l_ & 15, l_ >> 4); }
        if (!has_next) break;
#pragma unroll
        for (int a = 0; a < 2; ++a)
#pragma unroll
            for (int b = 0; b < 2; ++b)
#pragma unroll
                for (int m = 0; m < 4; ++m)
#pragma unroll
                    for (int n = 0; n < 2; ++n) acc[a][b][m][n] = (f32x4){0.f, 0.f, 0.f, 0.f};
        cur = nxt; cA = nA; cB = nB; ++ui;
        if constexpr (GATHER) { gc00 = gn00; gc01 = gn01; gc10 = gn10; gc11 = gn11; }
        if (wr == 1) PG8_BAR;
    }
    PG8_WAIT_V(0);
    PG8_BAR;
#undef PG8_GOFF
#undef PG8_SA
#undef PG8_SB
#undef PG8_STAGE
#undef PG8_STB
#undef PG8_STA
#undef PG8_LDA
#undef PG8_LDB
#undef PG8_MMA
#undef PG8_WAIT_V
#undef PG8_WAIT_L
#undef PG8_BAR
#undef PG8_SCHED
}
}

#define EPI_ROWS_BEGIN _Pragma("unroll") for (int ai = 0; ai < 2; ++ai) _Pragma("unroll") for (int m = 0; m < 4; ++m) { const unsigned row = (unsigned)(u.pm * 256 + ai * 128 + wr * 64 + m * 16 + fr);
#define EPI_ROWS_END asm volatile("" ::: "memory"); }
__device__ __forceinline__ void st16(void* base, unsigned off, u32x4 v) { *(u32x4*)((char*)base + off) = v; }
struct EpiInProj {
    static constexpr bool PERM = true;
    bf16* CQ; bf16* CKV; float* KR; float* FL; bf16* FQ; bf16* CI; float* RSQ;
    __device__ __forceinline__ void operator()(const f32x4 (&acc)[2][2][4][2], const pg8::Unit& u, int wr, int wc, int fr, int fq) const {
        const int t = u.pn; const unsigned c8 = (unsigned)(wc * 32 + 8 * fq);
        if (t != 1) {
            bf16* base; unsigned ld;
            if (t >= 5) {
                bf16* hb = CI + (t - 5) * 128;
                EPI_ROWS_BEGIN
                    f32x4 a0 = acc[ai][0][m][0], a1 = acc[ai][0][m][1]; const f32x4 g0 = acc[ai][1][m][0], g1 = acc[ai][1][m][1];
#pragma unroll
                    for (int j = 0; j < 4; ++j) { a0[j] *= sigmoidf_(g0[j]); a1[j] *= sigmoidf_(g1[j]); }
                    st16(hb, (row * 256u + c8) * 2u, pack8(a0, a1));
                EPI_ROWS_END
                return;
            }
            if (t == 0) { base = CQ; ld = 256; } else { base = FQ + (size_t)(t - 2) * M * 256; ld = 256; }
            EPI_ROWS_BEGIN
                const unsigned off = (row * ld + c8) * 2u;
                st16(base, off, pack8(acc[ai][0][m][0], acc[ai][0][m][1]));
                st16(base, off + 256u, pack8(acc[ai][1][m][0], acc[ai][1][m][1]));
                if (t == 0) {
                    const f32x4 a = acc[ai][0][m][0], b = acc[ai][0][m][1], c = acc[ai][1][m][0], d = acc[ai][1][m][1];
                    float ss = ((a[0] * a[0] + a[1] * a[1]) + (a[2] * a[2] + a[3] * a[3])) + ((b[0] * b[0] + b[1] * b[1]) + (b[2] * b[2] + b[3] * b[3]))
                             + ((c[0] * c[0] + c[1] * c[1]) + (c[2] * c[2] + c[3] * c[3])) + ((d[0] * d[0] + d[1] * d[1]) + (d[2] * d[2] + d[3] * d[3]));
                    ss += lane_xor<16>(ss); ss += lane_xor<32>(ss);
                    if (fq == 0) *(float*)((char*)RSQ + (row * 8u + (unsigned)wc) * 4u) = ss;
                }
            EPI_ROWS_END
        } else {
            EPI_ROWS_BEGIN
                const unsigned off = (row * 256u + c8) * 2u;
                st16(CKV, off, pack8(acc[ai][0][m][0], acc[ai][0][m][1]));
                { const f32x4 a = acc[ai][0][m][0], b = acc[ai][0][m][1];
                  float ss = ((a[0] * a[0] + a[1] * a[1]) + (a[2] * a[2] + a[3] * a[3])) + ((b[0] * b[0] + b[1] * b[1]) + (b[2] * b[2] + b[3] * b[3]));
                  ss += lane_xor<16>(ss); ss += lane_xor<32>(ss);
                  if (fq == 0) *(float*)((char*)RSQ + (row * 8u + 4u + (unsigned)wc) * 4u) = ss; }
                if (c8 < 32) { const unsigned ko = (row * 32u + c8) * 4u; *(f32x4*)((char*)KR + ko) = acc[ai][1][m][0]; *(f32x4*)((char*)KR + ko + 16) = acc[ai][1][m][1]; }
                else if (c8 == 32) { *(f32x4*)((char*)FL + row * 16u) = acc[ai][1][m][0]; }
            EPI_ROWS_END
        }
    }
};
struct EpiQKV {
    static constexpr bool PERM = true;
    bf16* QM; bf16* KM; bf16* VM; const float* COS; const float* SIN; const float* RSQ;
    __device__ __forceinline__ void operator()(const f32x4 (&acc)[2][2][4][2], const pg8::Unit& u, int wr, int wc, int fr, int fq) const {
        const int t = u.pn; const unsigned c8 = (unsigned)(wc * 32 + 8 * fq);
        float rf[8];
#pragma unroll
        for (int i = 0; i < 8; ++i) { const unsigned row = (unsigned)(u.pm * 256 + (i >> 2) * 128 + wr * 64 + (i & 3) * 16 + fr);
            const f32x4 p = *(const f32x4*)((const char*)RSQ + (row * 8u + (t < 3 ? 0u : 4u)) * 4u); rf[i] = (p[0] + p[1]) + (p[2] + p[3]); }
#pragma unroll
        for (int i = 0; i < 8; ++i) rf[i] = 1.0f / sqrtf(rf[i] * (t < 3 ? 1.0f / 256 : 1.0f / 128) + EPS);
        if (t < 3) {
#pragma unroll
            for (int bj = 0; bj < 2; ++bj) {
                const unsigned col = (unsigned)(t * 256 + bj * 128) + c8, h = col / 96u, d = col - h * 96u;
                const bool rope = d >= 64; const unsigned f4 = rope ? ((d - 64) >> 1) : 0u;
#pragma unroll
                for (int ai = 0; ai < 2; ++ai) {
                    f32x4 cc[4], ss[4];
                    if (rope) {
#pragma unroll
                        for (int m = 0; m < 4; ++m) { const unsigned to = ((unsigned)(u.pm * 256 + ai * 128 + wr * 64 + m * 16 + fr) * 16u + f4) * 4u;
                            cc[m] = *(const f32x4*)((const char*)COS + to); ss[m] = *(const f32x4*)((const char*)SIN + to); }
                    }
#pragma unroll
                    for (int m = 0; m < 4; ++m) { const unsigned row = (unsigned)(u.pm * 256 + ai * 128 + wr * 64 + m * 16 + fr);
                        f32x4 v0 = acc[ai][bj][m][0] * rf[ai * 4 + m], v1 = acc[ai][bj][m][1] * rf[ai * 4 + m];
                        if (rope) {
                            const f32x4 c = cc[m], s = ss[m], a = v0, b = v1;
                            v0 = (f32x4){a[0] * c[0] - a[2] * s[0], a[1] * c[1] - a[3] * s[1], a[0] * s[0] + a[2] * c[0], a[1] * s[1] + a[3] * c[1]};
                            v1 = (f32x4){b[0] * c[2] - b[2] * s[2], b[1] * c[3] - b[3] * s[3], b[0] * s[2] + b[2] * c[2], b[1] * s[3] + b[3] * c[3]};
                        }
                        st16(QM, (row * 768u + col) * 2u, pack8(v0, v1));
                    }
                    asm volatile("" ::: "memory");
                }
            }
        } else if (t < 5) {
#pragma unroll
            for (int bj = 0; bj < 2; ++bj) {
                const unsigned kc = (unsigned)((t - 3) * 256 + bj * 128) + c8, h = kc >> 6, d = kc & 63;
                EPI_ROWS_BEGIN
                    st16(KM, (row * 768u + h * 96u + d) * 2u, pack8(acc[ai][bj][m][0] * rf[ai * 4 + m], acc[ai][bj][m][1] * rf[ai * 4 + m]));
                EPI_ROWS_END
            }
        } else {
#pragma unroll
            for (int bj = 0; bj < 2; ++bj) {
                const unsigned vc = (unsigned)((t - 5) * 256 + bj * 128) + c8;
                EPI_ROWS_BEGIN
                    st16(VM, (row * 512u + vc) * 2u, pack8(acc[ai][bj][m][0] * rf[ai * 4 + m], acc[ai][bj][m][1] * rf[ai * 4 + m]));
                EPI_ROWS_END
            }
        }
    }
};
template <int LDC, bool SCALE>
struct EpiBf16 {
    static constexpr bool PERM = true;
    bf16* O; int ntn; const float* rowscale;
    __device__ __forceinline__ void operator()(const f32x4 (&acc)[2][2][4][2], const pg8::Unit& u, int wr, int wc, int fr, int fq) const {
        const unsigned col = (unsigned)((u.pn % ntn) * 256 + wc * 32 + 8 * fq);
        float sc8[8];
        if constexpr (SCALE) {
#pragma unroll
            for (int i = 0; i < 8; ++i) sc8[i] = *(const float*)((const char*)rowscale + (unsigned)(u.pm * 256 + (i >> 2) * 128 + wr * 64 + (i & 3) * 16 + fr) * 4u);
        }
        EPI_ROWS_BEGIN
            float s = 1.0f; if constexpr (SCALE) s = sc8[ai * 4 + m];
            const unsigned off = (row * (unsigned)LDC + col) * 2u;
            st16(O, off, pack8(acc[ai][0][m][0] * s, acc[ai][0][m][1] * s));
            st16(O, off + 256u, pack8(acc[ai][1][m][0] * s, acc[ai][1][m][1] * s));
        EPI_ROWS_END
    }
};
template <int LDH>
struct EpiSwiGLU {
    static constexpr bool PERM = true;
    bf16* H; int ntn;
    __device__ __forceinline__ void operator()(const f32x4 (&acc)[2][2][4][2], const pg8::Unit& u, int wr, int wc, int fr, int fq) const {
        const unsigned col = (unsigned)((u.pn % ntn) * 128 + wc * 32 + 8 * fq);
        EPI_ROWS_BEGIN
            f32x4 a0 = acc[ai][0][m][0], a1 = acc[ai][0][m][1]; const f32x4 b0 = acc[ai][1][m][0], b1 = acc[ai][1][m][1];
#pragma unroll
            for (int j = 0; j < 4; ++j) { a0[j] = siluf_(a0[j]) * b0[j]; a1[j] = siluf_(a1[j]) * b1[j]; }
            st16(H, (row * (unsigned)LDH + col) * 2u, pack8(a0, a1));
        EPI_ROWS_END
    }
};
struct MoeOrder {
    const bf16* A; const bf16* Bt; int lda, ldb, nM, nN, G, c, rep; const int* slot_tok; int s1, s2, s3, s4, s5, s6, s7;
    __device__ __forceinline__ int expert_of(int rt) const { const int r = rt * 256; return (r >= s1) + (r >= s2) + (r >= s3) + (r >= s4) + (r >= s5) + (r >= s6) + (r >= s7); }
    __device__ __forceinline__ bool next(int i, pg8::Unit& u) const { int pm, pn; if (!pg8::tile_order_rep(i, G, c, nM, nN, rep, pm, pn)) return false; u.pm = pm; u.pn = expert_of(pm) * nN + pn; return true; }
    __device__ __forceinline__ const char* a_base(const pg8::Unit& u) const { return slot_tok ? (const char*)A : (const char*)A + (size_t)u.pm * 256 * lda * 2; }
    __device__ __forceinline__ const char* b_base(const pg8::Unit& u) const { return (const char*)Bt + (size_t)u.pn * 256 * ldb * 2; }
    __device__ __forceinline__ int tok(const pg8::Unit& u, int r) const { return slot_tok[u.pm * 256 + r]; }
    __device__ __forceinline__ int ktiles(const pg8::Unit&, int nt) const { return nt; }
};

template <int NN>
struct MoeIdxOrder {
    const bf16* A; const bf16* Bt; int lda, ldb, first, stride, end; const int* slot_tok; int s1, s2, s3, s4, s5, s6, s7;
    __device__ __forceinline__ int expert_of(int rt) const { const int r = rt * 256; return (r >= s1) + (r >= s2) + (r >= s3) + (r >= s4) + (r >= s5) + (r >= s6) + (r >= s7); }
    __device__ __forceinline__ bool next(int i, pg8::Unit& u) const { const int idx = first + i * stride; if (idx >= end) return false; const int pm = idx / NN; u.pm = pm; u.pn = expert_of(pm) * NN + (idx - pm * NN); return true; }
    __device__ __forceinline__ const char* a_base(const pg8::Unit& u) const { return slot_tok ? (const char*)A : (const char*)A + (size_t)u.pm * 256 * lda * 2; }
    __device__ __forceinline__ const char* b_base(const pg8::Unit& u) const { return (const char*)Bt + (size_t)u.pn * 256 * ldb * 2; }
    __device__ __forceinline__ int tok(const pg8::Unit& u, int r) const { return slot_tok[u.pm * 256 + r]; }
    __device__ __forceinline__ int ktiles(const pg8::Unit&, int nt) const { return nt; }
};

namespace att {
__device__ __forceinline__ int crow(int r, int hi) { return (r & 3) + 8 * (r >> 2) + 4 * hi; }
__device__ __forceinline__ s16x4 vtr(const LAS unsigned char* p) { typedef short v4i16_t __attribute__((ext_vector_type(4))); return __builtin_bit_cast(s16x4, __builtin_amdgcn_ds_read_tr16_b64_v4i16((LAS v4i16_t*)p)); }
#define ATT_WAITBAR() asm volatile("s_waitcnt vmcnt(0) lgkmcnt(0)\n\ts_barrier" ::: "memory")
__device__ __forceinline__ void glds16(const void* gsrc, unsigned lds_dst) { unsigned keep;
    asm volatile("s_mov_b32 %0, m0\n\ts_mov_b32 m0, %2\n\ts_nop 0\n\tglobal_load_lds_dwordx4 %1, off\n\ts_mov_b32 m0, %0" : "=&s"(keep) : "v"(gsrc), "s"(lds_dst) : "memory"); }

#define MX3(a, b, c) __builtin_fmaxf(__builtin_fmaxf((a), (b)), (c))
template <int DQK> struct AttLds { static constexpr int NCH = DQK / 8, KSLOT = NCH * 1024, ND0 = DQK / 16, LK = 0, LV = 3 * KSLOT, LOST = LV + 3 * 8192, LCUM = LOST + NWAVES * 4608, END = LCUM + SEQ * 4; };

template <int DQK>
__device__ __forceinline__ void att_qk(f32x16& n0, f32x16& n1, const bf16x8 (&qr)[DQK / 16], const LAS unsigned char* kp) {
    constexpr int ND0 = DQK / 16;
    bf16x8 kf[2 * ND0];
#pragma unroll
    for (int d0 = 0; d0 < ND0; ++d0) { kf[2 * d0] = *(const LAS bf16x8*)(kp + d0 * 2048); kf[2 * d0 + 1] = *(const LAS bf16x8*)(kp + d0 * 2048 + 512); }
    n0 = (f32x16){}; n1 = (f32x16){};
#pragma unroll
    for (int d0 = 0; d0 < ND0; ++d0) {
        n0 = __builtin_amdgcn_mfma_f32_32x32x16_bf16(kf[2 * d0], qr[d0], n0, 0, 0, 0);
        n1 = __builtin_amdgcn_mfma_f32_32x32x16_bf16(kf[2 * d0 + 1], qr[d0], n1, 0, 0, 0);
    }
}
template <bool BIAS, bool MASK>
__device__ __forceinline__ void att_bias_mask(f32x16& n0, f32x16& n1, int t, int NT, int qrel, int hi, float fqb, const LAS float* cumL) {
    if constexpr (BIAS) {
#pragma unroll
        for (int g = 0; g < 4; ++g) {
            const f32x4 f0 = *(const LAS f32x4*)(cumL + t * 64 + 8 * g + 4 * hi), f1 = *(const LAS f32x4*)(cumL + t * 64 + 32 + 8 * g + 4 * hi);
#pragma unroll
            for (int j = 0; j < 4; ++j) { n0[4 * g + j] += fqb - f0[j]; n1[4 * g + j] += fqb - f1[j]; }
        }
    }
    if constexpr (MASK) {
        const int kb = 64 * (t - (NT - 4)) + 4 * hi;
#pragma unroll
        for (int r = 0; r < 16; ++r) { const int kv = kb + (r & 3) + 8 * (r >> 2); if (kv > qrel) n0[r] = -INFINITY; if (kv + 32 > qrel) n1[r] = -INFINITY; }
    }
}
template <int DQK, bool BIAS, bool MASK, bool MORE>
__device__ __forceinline__ void att_step(f32x16& s0, f32x16& s1, f32x16& n0, f32x16& n1, f32x16& o0, f32x16& o1, float& mrow, float& lrow, const bf16x8 (&qr)[DQK / 16],
                                         int t, int NT, int qrel, int lane, int hi, int r32, float fqb, const LAS unsigned char* shm, int vslot, int kslot) {
    typedef AttLds<DQK> L;
    constexpr int ND0 = DQK / 16;
    const LAS unsigned char* vp = shm + L::LV + vslot * 8192 + ((lane >> 4) & 1) * 32 + (lane & 3) * 8 + (4 * hi + ((lane & 15) >> 2)) * 64;
    const LAS unsigned char* kp = shm + L::LK + kslot * L::KSLOT + hi * 1024 + r32 * 16;
    bf16x8 kf[2 * ND0];
    if constexpr (MORE) {
#pragma unroll
        for (int d0 = 0; d0 < ND0; ++d0) { kf[2 * d0] = *(const LAS bf16x8*)(kp + d0 * 2048); kf[2 * d0 + 1] = *(const LAS bf16x8*)(kp + d0 * 2048 + 512); }
    }
    float a = MX3(s0[0], s0[1], s1[0]), b = MX3(s0[2], s0[3], s1[1]); a = MX3(a, s1[2], s1[3]);
#pragma unroll
    for (int r = 4; r < 16; r += 4) { a = MX3(a, s0[r], s0[r + 1]); b = MX3(b, s0[r + 2], s0[r + 3]); a = MX3(a, s1[r], s1[r + 1]); b = MX3(b, s1[r + 2], s1[r + 3]); }
    float rm = __builtin_fmaxf(a, b);
    { auto rr = __builtin_amdgcn_permlane32_swap(__float_as_uint(rm), __float_as_uint(rm), false, false); rm = __builtin_fmaxf(__uint_as_float(rr[0]), __uint_as_float(rr[1])); }
    if (__builtin_amdgcn_ballot_w64(rm > mrow + 8.0f) != 0ull) {
        const float mnew = __builtin_fmaxf(mrow, rm), alpha = fexp2(mrow - mnew);
        mrow = mnew; lrow *= alpha;
#pragma unroll
        for (int r = 0; r < 16; ++r) { o0[r] *= alpha; o1[r] *= alpha; }
    }
    if constexpr (MORE) {
        n0 = (f32x16){}; n1 = (f32x16){};
#pragma unroll
        for (int d0 = 0; d0 < ND0; ++d0) {
            n0 = __builtin_amdgcn_mfma_f32_32x32x16_bf16(kf[2 * d0], qr[d0], n0, 0, 0, 0);
            n1 = __builtin_amdgcn_mfma_f32_32x32x16_bf16(kf[2 * d0 + 1], qr[d0], n1, 0, 0, 0);
        }
    }
    float ps = 0.f;
#pragma unroll
    for (int r = 0; r < 16; ++r) { s0[r] = fexp2(s0[r] - mrow); s1[r] = fexp2(s1[r] - mrow); ps += s0[r] + s1[r]; }
    lrow += ps;
    __builtin_amdgcn_sched_barrier(0);
    s16x4 vl[8], vh[8];
#pragma unroll
    for (int i = 0; i < 8; ++i) { vl[i] = vtr(vp + (i >> 2) * 4096 + (i & 3) * 1024); vh[i] = vtr(vp + (i >> 2) * 4096 + (i & 3) * 1024 + 512); }
    u32x4 pw[4];
    pw[0] = (u32x4){pk2(s0[0], s0[1]), pk2(s0[2], s0[3]), pk2(s0[4], s0[5]), pk2(s0[6], s0[7])};
    pw[1] = (u32x4){pk2(s0[8], s0[9]), pk2(s0[10], s0[11]), pk2(s0[12], s0[13]), pk2(s0[14], s0[15])};
    pw[2] = (u32x4){pk2(s1[0], s1[1]), pk2(s1[2], s1[3]), pk2(s1[4], s1[5]), pk2(s1[6], s1[7])};
    pw[3] = (u32x4){pk2(s1[8], s1[9]), pk2(s1[10], s1[11]), pk2(s1[12], s1[13]), pk2(s1[14], s1[15])};
#pragma unroll
    for (int ks = 0; ks < 4; ++ks) {
        const bf16x8 v0 = (bf16x8){vl[ks][0], vl[ks][1], vl[ks][2], vl[ks][3], vh[ks][0], vh[ks][1], vh[ks][2], vh[ks][3]};
        const bf16x8 v1 = (bf16x8){vl[4 + ks][0], vl[4 + ks][1], vl[4 + ks][2], vl[4 + ks][3], vh[4 + ks][0], vh[4 + ks][1], vh[4 + ks][2], vh[4 + ks][3]};
        o0 = __builtin_amdgcn_mfma_f32_32x32x16_bf16(v0, __builtin_bit_cast(bf16x8, pw[ks]), o0, 0, 0, 0);
        o1 = __builtin_amdgcn_mfma_f32_32x32x16_bf16(v1, __builtin_bit_cast(bf16x8, pw[ks]), o1, 0, 0, 0);
    }
    if constexpr (MORE) att_bias_mask<BIAS, MASK>(n0, n1, t + 1, NT, qrel, hi, fqb, (const LAS float*)(shm + L::LCUM));
}

template <int DQK, bool BIAS>
__device__ __forceinline__ void attn_unit(int b, int h, int qb, const bf16* Q, int pq, const bf16* K, int pk, const bf16* V, int pv,
                                          bf16* O, int po, int ocol, const float* cum, LAS unsigned char* shm, const int tid_in, float* ssqp, int hidx, const unsigned* qkmax) {
    int tid = tid_in; asm volatile("" : "+v"(tid));
    typedef AttLds<DQK> L;
    constexpr int NCH = L::NCH, KSLOT = L::KSLOT, ND0 = L::ND0, LK = L::LK, LV = L::LV, LOST = L::LOST;
    static_assert(L::END <= RING_BYTES, "attention LDS");
    const int lane = tid & 63, r32 = lane & 31, hi = lane >> 5; const int wid = __builtin_amdgcn_readfirstlane(tid >> 6);
    const long rowbase = (long)b * SEQ; const int q0 = qb * 256;
    const bf16* Qw = Q + (rowbase + q0 + wid * 32) * pq + h * DQK;
    const bf16* Kh = K + rowbase * pk + h * DQK; const bf16* Vh = V + rowbase * pv + h * 64;
    const int NT = (q0 + 256) / 64;
    LAS float* cumL = (LAS float*)(shm + L::LCUM);
    if constexpr (BIAS) { const float* cs = cum + (size_t)(b * 4 + h) * SEQ; for (int i = tid * 4; i < q0 + 256; i += NTHR * 4) *(LAS f32x4*)(cumL + i) = *(const f32x4*)(cs + i); }
    const bf16* ksrc = Kh + (long)lane * pk + wid * 8;
    const bf16* vsrc = Vh + (long)(16 * (wid & 3) + (lane >> 2)) * pv + (wid >> 2) * 32 + (lane & 3) * 8;
    const unsigned lds0 = (unsigned)(size_t)shm;
#define ATT_DMA_K(t, slot) do { \
        glds16(ksrc + (long)(t) * 64 * pk, (unsigned)__builtin_amdgcn_readfirstlane((int)(lds0 + LK + (slot) * KSLOT + wid * 1024))); \
        if (NCH > 8 && wid + 8 < NCH) glds16(ksrc + (long)(t) * 64 * pk + 64, (unsigned)__builtin_amdgcn_readfirstlane((int)(lds0 + LK + (slot) * KSLOT + (wid + 8) * 1024))); } while (0)
#define ATT_DMA_V(t, slot) glds16(vsrc + (long)(t) * 64 * pv, (unsigned)__builtin_amdgcn_readfirstlane((int)(lds0 + LV + (slot) * 8192 + wid * 1024)))
    const int nK = (NCH > 8 && wid + 8 < NCH) ? 2 : 1;
#define ATT_WAITBAR_N(n) do { const int n_ = (n); if (n_ == 0) asm volatile("s_waitcnt vmcnt(0) lgkmcnt(0)\n\ts_barrier" ::: "memory"); else if (n_ == 1) asm volatile("s_waitcnt vmcnt(1) lgkmcnt(0)\n\ts_barrier" ::: "memory"); \
        else if (n_ == 2) asm volatile("s_waitcnt vmcnt(2) lgkmcnt(0)\n\ts_barrier" ::: "memory"); else asm volatile("s_waitcnt vmcnt(3) lgkmcnt(0)\n\ts_barrier" ::: "memory"); } while (0)
    int tb = 0;
    if constexpr (BIAS) {
        const float qk = sqrtf(__uint_as_float(qkmax[0]) * __uint_as_float(qkmax[1])) * 1.01f + 1.0f, thr = -(150.0f + 2.0f * qk);
        const float* cs = cum + (size_t)(b * 4 + h) * SEQ; const float f0 = cs[q0]; const float fj = lane < NT ? cs[64 * lane + 63] : f0;
        const unsigned long long keep = __builtin_amdgcn_ballot_w64(lane < NT && (f0 - fj) >= thr);
        tb = keep ? (int)__builtin_ctzll(keep) : NT - 4; if (tb > NT - 4) tb = NT - 4;
        tb = __builtin_amdgcn_readfirstlane(tb);
    }
    ATT_DMA_K(tb, 0); ATT_DMA_V(tb, 0); ATT_DMA_K(tb + 1, 1);
    bf16x8 qr[ND0];
#pragma unroll
    for (int d0 = 0; d0 < ND0; ++d0) qr[d0] = *(const bf16x8*)(Qw + (long)r32 * pq + d0 * 16 + hi * 8);
    float mrow = -1e30f, lrow = 0.f; f32x16 o0 = {}, o1 = {};
    const int qrel = wid * 32 + r32;
    ATT_WAITBAR();
#pragma unroll
    for (int d0 = 0; d0 < ND0; ++d0) asm volatile("" : "+v"(qr[d0]));
    ATT_DMA_K(tb + 2, 2); ATT_DMA_V(tb + 1, 1);
    float fqb = 0.f; if constexpr (BIAS) fqb = cumL[q0 + qrel];
    f32x16 s0, s1;
    att_qk<DQK>(s0, s1, qr, shm + LK + hi * 1024 + r32 * 16);
    asm volatile("s_waitcnt lgkmcnt(0)\n\ts_barrier" ::: "memory");
    if (tb == NT - 4) att_bias_mask<BIAS, true>(s0, s1, tb, NT, qrel, hi, fqb, cumL); else att_bias_mask<BIAS, false>(s0, s1, tb, NT, qrel, hi, fqb, cumL);
    int t = tb, sl0 = 0, sl1 = 1, sl2 = 2;
#define ATT_ROT() do { const int x_ = sl0; sl0 = sl1; sl1 = sl2; sl2 = x_; } while (0)
    f32x16 u0, u1;
    for (; t + 1 < NT - 5; t += 2) {
        ATT_DMA_K(t + 3, sl0); ATT_DMA_V(t + 2, sl2);
        att_step<DQK, BIAS, false, true>(s0, s1, u0, u1, o0, o1, mrow, lrow, qr, t, NT, qrel, lane, hi, r32, fqb, shm, sl0, sl1);
        ATT_WAITBAR_N(nK + 1); ATT_ROT();
        ATT_DMA_K(t + 4, sl0); ATT_DMA_V(t + 3, sl2);
        att_step<DQK, BIAS, false, true>(u0, u1, s0, s1, o0, o1, mrow, lrow, qr, t + 1, NT, qrel, lane, hi, r32, fqb, shm, sl0, sl1);
        ATT_WAITBAR_N(nK + 1); ATT_ROT();
    }
    for (; t < NT - 5; ++t) {
        ATT_DMA_K(t + 3, sl0); ATT_DMA_V(t + 2, sl2);
        att_step<DQK, BIAS, false, true>(s0, s1, u0, u1, o0, o1, mrow, lrow, qr, t, NT, qrel, lane, hi, r32, fqb, shm, sl0, sl1);
        s0 = u0; s1 = u1;
        ATT_WAITBAR_N(nK + 1); ATT_ROT();
    }
    for (; t < NT - 1; ++t) {
        int nis = 0;
        if (t + 3 < NT) { ATT_DMA_K(t + 3, sl0); nis += nK; }
        if (t + 2 < NT) { ATT_DMA_V(t + 2, sl2); nis += 1; }
        const int jbc = t - (NT - 4); const bool docur = !(jbc >= 0 && 2 * jbc > wid), donext = !(2 * (jbc + 1) > wid);
        if (docur && donext) { att_step<DQK, BIAS, true, true>(s0, s1, u0, u1, o0, o1, mrow, lrow, qr, t, NT, qrel, lane, hi, r32, fqb, shm, sl0, sl1); s0 = u0; s1 = u1; }
        else if (docur) att_step<DQK, BIAS, false, false>(s0, s1, u0, u1, o0, o1, mrow, lrow, qr, t, NT, qrel, lane, hi, r32, fqb, shm, sl0, sl1);
        ATT_WAITBAR_N(nis); ATT_ROT();
    }
    if (!(2 * 3 > wid)) att_step<DQK, BIAS, false, false>(s0, s1, u0, u1, o0, o1, mrow, lrow, qr, t, NT, qrel, lane, hi, r32, fqb, shm, sl0, sl1);
#undef ATT_ROT
#undef ATT_WAITBAR_N
    { auto rr = __builtin_amdgcn_permlane32_swap(__float_as_uint(lrow), __float_as_uint(lrow), false, false); lrow = __uint_as_float(rr[0]) + __uint_as_float(rr[1]); }
    const float rl = frcp(lrow);
    { float ssq = 0.f;
#pragma unroll
      for (int r = 0; r < 16; ++r) { const float a = o0[r] * rl, b2 = o1[r] * rl; ssq += a * a + b2 * b2; }
      auto rr = __builtin_amdgcn_permlane32_swap(__float_as_uint(ssq), __float_as_uint(ssq), false, false); ssq = __uint_as_float(rr[0]) + __uint_as_float(rr[1]);
      if (hi == 0) ssqp[(size_t)(rowbase + q0 + wid * 32 + r32) * 12 + hidx] = ssq; }
    LAS unsigned char* stg = shm + LOST + wid * 4608;
#pragma unroll
    for (int g = 0; g < 4; ++g) {
        *(LAS u32x2*)(stg + r32 * 144 + (8 * g + 4 * hi) * 2) = (u32x2){pk2(o0[4 * g] * rl, o0[4 * g + 1] * rl), pk2(o0[4 * g + 2] * rl, o0[4 * g + 3] * rl)};
        *(LAS u32x2*)(stg + r32 * 144 + (32 + 8 * g + 4 * hi) * 2) = (u32x2){pk2(o1[4 * g] * rl, o1[4 * g + 1] * rl), pk2(o1[4 * g + 2] * rl, o1[4 * g + 3] * rl)};
    }
    asm volatile("s_waitcnt lgkmcnt(0)" ::: "memory");
    bf16* Ow = O + (rowbase + q0 + wid * 32) * po + ocol;
#pragma unroll
    for (int i = 0; i < 4; ++i) { const int row = i * 8 + (lane >> 3), ch = lane & 7; const u32x4 v = *(const LAS u32x4*)(stg + row * 144 + ch * 16); *(u32x4*)(Ow + (long)row * po + ch * 8) = v; }
    asm volatile("s_waitcnt lgkmcnt(0)\n\ts_barrier" ::: "memory");
#undef ATT_DMA_K
#undef ATT_DMA_V
}
}

struct Args { const float* in[26]; float* out; unsigned char* ws; int ph_lo, ph_hi; };
typedef const __attribute__((address_space(4))) Args* kargs_t;
struct Ctx {
    LAS unsigned char* lds; unsigned* ctl; unsigned char* ws; float* out;
    int tid, lane, wave, vcu, G, gw, NGW, bx;
};
__device__ __forceinline__ kargs_t opaque_args() { kargs_t p = (kargs_t)__builtin_amdgcn_kernarg_segment_ptr(); asm volatile("" : "+s"(p)); return p; }
__device__ __forceinline__ Ctx make_ctx(kargs_t A, LAS unsigned char* lds, int wave0) {
    Ctx C; unsigned ones = ~0u; asm volatile("" : "+s"(ones));
    int t = wave0 * 64 + (int)__builtin_amdgcn_mbcnt_hi(ones, __builtin_amdgcn_mbcnt_lo(ones, 0u)); asm volatile("" : "+v"(t));
    C.lds = lds; C.ws = A->ws; C.ctl = (unsigned*)(C.ws + WS_CTL); C.out = A->out;
    C.tid = t; C.lane = t & 63; C.wave = __builtin_amdgcn_readfirstlane(t >> 6);
    { int g_ = gridDim.x, b_ = blockIdx.x; asm volatile("" : "+s"(g_), "+s"(b_)); C.G = g_; C.bx = b_; } C.vcu = (C.bx % 8) * (C.G / 8) + C.bx / 8;
    C.gw = C.vcu * NWAVES + C.wave; C.NGW = C.G * NWAVES;
    return C;
}
#define LDS_WAIT() asm volatile("s_waitcnt lgkmcnt(0)" ::: "memory")

struct MapWin { __device__ __forceinline__ int row(int n) const {
        if (n < 256) return PC_CQ + n; if (n < 384) return PC_CKV + (n - 256); if (n < 416) return PC_KR + (n - 384); if (n < 672) return PC_FQ + (n - 416);
        if (n < 928) return PC_FK + (n - 672); if (n < 1184) return PC_FV + (n - 928); if (n < 1188) return PC_FL + (n - 1184);
        { const int c = n - 1188, ch = c & 255; return PC_CI + (ch >> 7) * 256 + (c >> 8) * 128 + (ch & 127); } }
    __device__ __forceinline__ float scale(int, int n) const { return (n >= 416 && n < 672) ? C2_FOX : 1.0f; } };
struct MapUq { const float* g; __device__ __forceinline__ int row(int n) const { const int h = n / 96, d = n - h * 96; if (d < 64) return n; const int i = d - 64;
        const int s = (i < 16) ? (4 * (i >> 1) + (i & 1)) : (4 * ((i - 16) >> 1) + 2 + (i & 1)); return h * 96 + 64 + s; }
    __device__ __forceinline__ float scale(int k, int) const { return g[k] * C2_MLA; } };
struct MapUkv { const float* g; __device__ __forceinline__ int row(int n) const { const int h = n >> 7, d = n & 127; return d < 64 ? (768 + h * 64 + d) : (1280 + h * 64 + (d - 64)); }
    __device__ __forceinline__ float scale(int k, int) const { return g[k]; } };
struct MapWout { const float* gm; const float* gf; __device__ __forceinline__ int row(int n) const { return n; }
    __device__ __forceinline__ float scale(int k, int) const { return k < 512 ? gm[k] : (k < 768 ? gf[k - 512] : 1.0f); } };
struct MapW13 { int which; __device__ __forceinline__ int row(int n) const { return (n >> 7) * 256 + which * 128 + (n & 127); }
    __device__ __forceinline__ float scale(int, int) const { return 1.0f; } };
struct MapId { __device__ __forceinline__ int row(int n) const { return n; } __device__ __forceinline__ float scale(int, int) const { return 1.0f; } };

template <class Map>
__device__ __forceinline__ void transpose_item(const float* W, int Nsrc, bf16* WT, int ldk, LAS float* scr, int kb, int nb, int lane, const Map mp) {
    const int k0 = 64 * kb, n0 = 32 * nb, r8 = lane >> 3, nn = n0 + 4 * (lane & 7); const bool nok = nn < Nsrc;
    f32x4 v[8];
#pragma unroll
    for (int i = 0; i < 8; ++i) { v[i] = (f32x4){0.f, 0.f, 0.f, 0.f}; if (nok) v[i] = *(const f32x4*)(W + (size_t)(k0 + 8 * i + r8) * Nsrc + nn); }
#pragma unroll
    for (int i = 0; i < 8; ++i) { const int kk = 8 * i + r8; LAS float* d = scr + kk * 33 + 4 * (lane & 7);
#pragma unroll
        for (int j = 0; j < 4; ++j) d[j] = v[i][j] * mp.scale(k0 + kk, nn + j); }
    LDS_WAIT(); asm volatile("" ::: "memory");
    const int c = lane & 7;
#pragma unroll
    for (int j = 0; j < 4; ++j) { const int n = (lane >> 3) + 8 * j; const LAS float* s = scr + (8 * c) * 33 + n;
        if (n0 + n < Nsrc) { u32x4 o; o.x = pk2(s[0 * 33], s[1 * 33]); o.y = pk2(s[2 * 33], s[3 * 33]); o.z = pk2(s[4 * 33], s[5 * 33]); o.w = pk2(s[6 * 33], s[7 * 33]);
            *(u32x4*)(WT + (size_t)mp.row(n0 + n) * ldk + k0 + 8 * c) = o; } }
    LDS_WAIT(); asm volatile("" ::: "memory");
}

__device__ __forceinline__ void sincos_acc(float ang, float& c, float& s) {
    const double a = (double)ang, q = __builtin_rint(a * 0.63661977236758134308);
    const double y = (a - q * 1.57079632679489655800) - q * 6.12323399573676603587e-17, y2 = y * y;
    const double sp = y * (1.0 + y2 * (-1.0 / 6 + y2 * (1.0 / 120 + y2 * (-1.0 / 5040 + y2 * (1.0 / 362880 + y2 * (-1.0 / 39916800 + y2 * (1.0 / 6227020800.0)))))));
    const double cp = 1.0 + y2 * (-0.5 + y2 * (1.0 / 24 + y2 * (-1.0 / 720 + y2 * (1.0 / 40320 + y2 * (-1.0 / 3628800 + y2 * (1.0 / 479001600 + y2 * (-1.0 / 87178291200.0)))))));
    const int quad = (int)((long long)q & 3);
    const double ss = (quad == 0) ? sp : (quad == 1) ? cp : (quad == 2) ? -sp : -cp;
    const double cc = (quad == 0) ? cp : (quad == 1) ? -sp : (quad == 2) ? -cp : sp;
    c = (float)cc; s = (float)ss;
}
__device__ __forceinline__ float inv_freq(int f) {
    const int a = f >> 2, b = f & 3;
    const float p = (a == 0) ? 1.0f : (a == 1) ? 0.1f : (a == 2) ? 0.01f : 0.001f;
    const float m = (b == 0) ? 1.0f : (b == 1) ? 0.56234132519034908f : (b == 2) ? 0.31622776601683794f : 0.17782794100389228f;
    return (b == 0) ? p : (float)((double)p * (double)m);
}

__device__ __forceinline__ void p0_prologue(Ctx& C, kargs_t A) {
    LAS float* scr = (LAS float*)(C.lds + C.wave * 16384);
    bf16* WIN = (bf16*)(C.ws + WS_WIN); bf16* WQ2 = (bf16*)(C.ws + WS_WQ2); bf16* WOUT = (bf16*)(C.ws + WS_WOUT);
    constexpr int I_IN = 16 * 54, I_UQ = 4 * 24, I_UKV = 2 * 32, I_OUT = 16 * 32, I_L = I_IN + I_UQ + I_UKV + I_OUT;
    REPS(12) for (int it = C.gw; it < DEPTH * I_L; it += C.NGW) {
        const int l = it / I_L; int r = it - l * I_L;
        if (r < I_IN) { transpose_item(A->in[2] + (size_t)l * DM * IN_COLS, IN_COLS, WIN + (size_t)l * NP1 * DM, DM, scr, r / 54, r % 54, C.lane, MapWin{}); continue; } r -= I_IN;
        if (r < I_UQ) { transpose_item(A->in[4] + (size_t)l * 256 * 768, 768, WQ2 + (size_t)l * NP1 * 256, 256, scr, r / 24, r % 24, C.lane, MapUq{A->in[3] + l * 256}); continue; } r -= I_UQ;
        if (r < I_UKV) { transpose_item(A->in[6] + (size_t)l * 128 * 1024, 1024, WQ2 + (size_t)l * NP1 * 256, 256, scr, r / 32, r % 32, C.lane, MapUkv{A->in[5] + l * 128}); continue; } r -= I_UKV;
        transpose_item(A->in[14] + (size_t)l * DM * DM, DM, WOUT + (size_t)l * DM * DM, DM, scr, r / 32, r % 32, C.lane, MapWout{A->in[12] + l * 512, A->in[13] + l * 256});
    }
    const int gt = C.vcu * NTHR + C.tid, NGT = C.G * NTHR;
    for (int i = gt; i < DEPTH * 92 * 128; i += NGT) { const int l = i / (92 * 128), r = i % (92 * 128); *(u32x4*)(WIN + (size_t)l * NP1 * DM + (size_t)(420 + r / 128) * DM + (r % 128) * 8) = (u32x4){0u, 0u, 0u, 0u}; }
    REPS(4) {
    bf16* XB = (bf16*)(C.ws + WS_XB); const float* x = A->in[0];
    for (int m = C.gw; m < M; m += C.NGW) { const f32x4* xr = (const f32x4*)(x + (size_t)m * DM) + C.lane; u32x2* o = (u32x2*)(XB + (size_t)m * DM) + C.lane;
#pragma unroll
        for (int j = 0; j < 4; ++j) { const f32x4 v = xr[64 * j]; o[64 * j] = (u32x2){pk2(v[0], v[1]), pk2(v[2], v[3])}; } }
    float* COS = (float*)(C.ws + WS_TAB); float* SIN = COS + (size_t)M * 16; const int* pos = (const int*)A->in[1];
    for (int i = gt; i < M * 16; i += NGT) { const float ang = (float)pos[i >> 4] * inv_freq(i & 15); float c, s; sincos_acc(ang, c, s); COS[i] = c; SIN[i] = s; }
    }
}

__device__ __forceinline__ int ffn_split(int layer) { return (layer & 1) ? 7744 : 4224; }
__device__ __forceinline__ void ffn_weights(Ctx& C, kargs_t A, int layer, int first, int stride, int lo, int hi) {
    LAS float* scr = (LAS float*)(C.lds + C.wave * 16384);
    bf16* W13 = (bf16*)(C.ws + WS_WFFN); bf16* W2T = W13 + WF_W13_ELEMS; const int j = layer >> 1;
    if ((layer & 1) == 0) {
        constexpr int I1 = 16 * 88, I2 = 44 * 32;
        const float* w1 = A->in[17] + (size_t)j * DM * DFF; const float* w3 = A->in[18] + (size_t)j * DM * DFF; const float* w2 = A->in[19] + (size_t)j * DFF * DM;
        const int end = hi < 2 * I1 + I2 ? hi : 2 * I1 + I2;
        for (int it = lo + first; it < end; it += stride) {
            int r = it;
            if (r < I1) { transpose_item(w1, DFF, W13, DM, scr, r / 88, r % 88, C.lane, MapW13{0}); continue; } r -= I1;
            if (r < I1) { transpose_item(w3, DFF, W13, DM, scr, r / 88, r % 88, C.lane, MapW13{1}); continue; } r -= I1;
            transpose_item(w2, DM, W2T, DFF, scr, r / 32, r % 32, C.lane, MapId{});
        }
    } else {
        constexpr int I1 = 16 * 44, I2 = 22 * 32, IE = 2 * I1 + I2;
        const int end = hi < NEXP * IE ? hi : NEXP * IE;
        for (int it = lo + first; it < end; it += stride) {
            const int e = it / IE; int r = it - e * IE;
            const float* w1 = A->in[21] + ((size_t)j * NEXP + e) * DM * DFE; const float* w3 = A->in[22] + ((size_t)j * NEXP + e) * DM * DFE; const float* w2 = A->in[23] + ((size_t)j * NEXP + e) * DFE * DM;
            bf16* W13e = W13 + (size_t)e * 2 * DFE * DM; bf16* W2Te = W2T + (size_t)e * DM * DFE;
            if (r < I1) { transpose_item(w1, DFE, W13e, DM, scr, r / 44, r % 44, C.lane, MapW13{0}); continue; } r -= I1;
            if (r < I1) { transpose_item(w3, DFE, W13e, DM, scr, r / 44, r % 44, C.lane, MapW13{1}); continue; } r -= I1;
            transpose_item(w2, DM, W2Te, DFE, scr, r / 32, r % 32, C.lane, MapId{});
        }
    }
}

__device__ __forceinline__ void p2_thin(Ctx& C, kargs_t A, int layer) {
    unsigned char* sc = C.ws + WS_SCR;
    bf16* CQ = (bf16*)(sc + SC_CQKV); bf16* CKV = CQ + (size_t)M * 256; const float* KR = (const float*)(sc + SC_KR); const float* FL = (const float*)(sc + SC_FL);
    float* CUM = (float*)(sc + SC_CUM); const bf16* CI = (const bf16*)(sc + SC_CI); const bf16* FQn = (const bf16*)(sc + SC_FQ); bf16* KM = (bf16*)(sc + SC_KM); bf16* MIXED = (bf16*)(sc + SC_MIXED);
    const float* COS = (const float*)(C.ws + WS_TAB); const float* SIN = COS + (size_t)M * 16;
    LAS unsigned* NT2 = (LAS unsigned*)(C.lds + RING_BYTES + 4096);
    if (C.tid < 64) NT2[C.tid] = 0u;
    LAS unsigned* RQ = (LAS unsigned*)(C.lds + RING_BYTES + 8192 + 64);
    if (C.tid == 0) RQ[0] = 0u;
    __syncthreads();
    {
    if (C.wave == 0 && C.vcu < BATCH * 4) {
        const int sq = C.vcu, b = sq >> 2, h = sq & 3; const float bias = A->in[7][layer * 4 + h];
        float v[64]; float run = 0.f;
#pragma unroll
        for (int i = 0; i < 64; ++i) { const float z = FL[((size_t)b * SEQ + C.lane * 64 + i) * 4 + h] + bias; const float e = fexp2(-fabsf(z) * LOG2E);
            const float ls = fminf(z, 0.f) - __builtin_amdgcn_logf(1.0f + e) * 0.6931471805599453f; run += ls * LOG2E; v[i] = run; }
        float incl = run;
#pragma unroll
        for (int o = 1; o < 64; o <<= 1) { const float t = __int_as_float(__builtin_amdgcn_ds_bpermute((C.lane - o) << 2, __float_as_int(incl))); if (C.lane >= o) incl += t; }
        const float excl = incl - run; float* dst = CUM + (size_t)sq * SEQ + C.lane * 64;
#pragma unroll
        for (int i = 0; i < 64; i += 4) *(f32x4*)(dst + i) = (f32x4){v[i] + excl, v[i + 1] + excl, v[i + 2] + excl, v[i + 3] + excl};
    }
    const int rpw = M / C.G;
    for (;;) {
        unsigned jb = 0u; if (C.lane == 0) jb = __hip_atomic_fetch_add(RQ, 1u, __ATOMIC_RELAXED, __HIP_MEMORY_SCOPE_WORKGROUP);
        jb = (unsigned)__builtin_amdgcn_readfirstlane((int)jb);
        if ((int)jb * 4 >= rpw) break;
        const size_t mb = (size_t)C.vcu * rpw + 4 * jb;
        f32x2 x1[4], x2[4], cs[4], sn[4]; u32x2 fqv[4], fkv[4]; const int g4 = C.lane & 7, h = C.lane >> 3;
#pragma unroll
        for (int k = 0; k < 4; ++k) { const size_t m = mb + k;
            x1[k] = *(const f32x2*)(KR + m * 32 + 2 * g4); x2[k] = *(const f32x2*)(KR + m * 32 + 16 + 2 * g4);
            cs[k] = *(const f32x2*)(COS + m * 16 + 2 * g4); sn[k] = *(const f32x2*)(SIN + m * 16 + 2 * g4);
            fqv[k] = ((const u32x2*)(FQn + m * 256))[C.lane]; fkv[k] = ((const u32x2*)(FQn + (size_t)M * 256 + m * 256))[C.lane]; }
#pragma unroll
        for (int k = 0; k < 4; ++k) { const size_t m = mb + k;
            {
              float nq = 0.f, nk = 0.f; { const float a0 = bflo(fqv[k].x), a1 = bfhi(fqv[k].x), a2 = bflo(fqv[k].y), a3 = bfhi(fqv[k].y); nq = (a0 * a0 + a1 * a1) + (a2 * a2 + a3 * a3); }
              { const float a0 = bflo(fkv[k].x), a1 = bfhi(fkv[k].x), a2 = bflo(fkv[k].y), a3 = bfhi(fkv[k].y); nk = (a0 * a0 + a1 * a1) + (a2 * a2 + a3 * a3); }
              nq += lane_xor<1>(nq); nq += lane_xor<2>(nq); nq += lane_xor<4>(nq); nq += lane_xor<8>(nq); nk += lane_xor<1>(nk); nk += lane_xor<2>(nk); nk += lane_xor<4>(nk); nk += lane_xor<8>(nk);
              if ((C.lane & 15) == 0) { const int bi = (int)(m >> 12) * 8 + (C.lane >> 4) * 2; atomicMax((unsigned*)&NT2[bi], __float_as_uint(nq)); atomicMax((unsigned*)&NT2[bi + 1], __float_as_uint(nk)); } }
            *(u32x2*)(KM + m * 768 + h * 96 + 64 + 4 * g4) = (u32x2){pk2(x1[k].x * cs[k].x - x2[k].x * sn[k].x, x1[k].y * cs[k].y - x2[k].y * sn[k].y), pk2(x1[k].x * sn[k].x + x2[k].x * cs[k].x, x1[k].y * sn[k].y + x2[k].y * cs[k].y)}; }
    }
    }
    __syncthreads();
    if (C.tid < 64) atomicMax(C.ctl + CW_QKMAX + layer * 64 + C.tid, NT2[C.tid]);
    {
        LAS float* hL = (LAS float*)C.lds; LAS float* yL = hL + 62 * 256;
        const int cch = (C.wave & 3) * 64 + C.lane, tt0 = (C.wave >> 2) * 16;
        float wj[31];
#pragma unroll
        for (int j = 0; j < 31; ++j) wj[j] = A->in[8][((size_t)layer * 31 + j) * 256 + cch];
        const float cb = A->in[9][layer * 256 + cch];
        const int ntok = C.tid >> 4, ngrp = (C.tid >> 2) & 3, nqt = C.tid & 3, nc0 = ngrp * 64 + nqt * 16;
        u32x4 pa[4];
#define CONV_LOAD(tl) do { const int t0_ = (tl) * 32, seq0_ = (t0_ / SEQ) * SEQ; _Pragma("unroll") for (int k = 0; k < 4; ++k) { const int it = C.tid + NTHR * k, r = it >> 5, ch = it & 31, tok = t0_ - 30 + r; \
            pa[k] = (u32x4){0u, 0u, 0u, 0u}; \
            if (it < 62 * 32 && tok >= seq0_) pa[k] = *(const u32x4*)(CI + (size_t)tok * 256 + ch * 8); } } while (0)
        if (C.vcu < M / 32) CONV_LOAD(C.vcu);
        for (int tile = C.vcu; tile < M / 32; tile += C.G) {
            const int t0 = tile * 32;
#pragma unroll
            for (int k = 0; k < 4; ++k) { const int it = C.tid + NTHR * k, r = it >> 5, ch = it & 31;
                if (it < 62 * 32) { const u32x4 a = pa[k];
                    *(LAS f32x4*)(hL + r * 256 + ch * 8) = (f32x4){bflo(a.x), bfhi(a.x), bflo(a.y), bfhi(a.y)}; *(LAS f32x4*)(hL + r * 256 + ch * 8 + 4) = (f32x4){bflo(a.z), bfhi(a.z), bflo(a.w), bfhi(a.w)}; } }
            __syncthreads();
            if (tile + C.G < M / 32) CONV_LOAD(tile + C.G);
#pragma unroll
            for (int chunk = 0; chunk < 2; ++chunk) { const int base = tt0 + chunk * 8; float hv[38];
#pragma unroll
                for (int i = 0; i < 38; ++i) hv[i] = hL[(base + i) * 256 + cch];
#pragma unroll
                for (int tt = 0; tt < 8; ++tt) { float acc = cb;
#pragma unroll
                    for (int j = 0; j < 31; ++j) acc += wj[j] * hv[tt + j];
                    yL[(base + tt) * 256 + cch] = acc; } }
            __syncthreads();
            { float v[16]; float s = 0.f;
#pragma unroll
              for (int i = 0; i < 16; i += 4) { const f32x4 t4 = *(const LAS f32x4*)(yL + ntok * 256 + nc0 + i); v[i] = t4[0]; v[i + 1] = t4[1]; v[i + 2] = t4[2]; v[i + 3] = t4[3]; s += (t4[0] + t4[1]) + (t4[2] + t4[3]); }
              s += lane_xor<1>(s); s += lane_xor<2>(s); const float mean = s * (1.0f / 64); float q = 0.f;
#pragma unroll
              for (int i = 0; i < 16; ++i) { v[i] -= mean; q += v[i] * v[i]; }
              q += lane_xor<1>(q); q += lane_xor<2>(q); const float rstd = 1.0f / sqrtf(q * (1.0f / 64) + EPS);
              const float* gg = A->in[10] + layer * 256 + nc0; const float* gb = A->in[11] + layer * 256 + nc0; float o[16];
#pragma unroll
              for (int i = 0; i < 16; ++i) o[i] = siluf_(v[i] * rstd * gg[i] + gb[i]);
              bf16* dst = MIXED + (size_t)(t0 + ntok) * 1024 + 768 + nc0;
              *(u32x4*)dst = (u32x4){pk2(o[0], o[1]), pk2(o[2], o[3]), pk2(o[4], o[5]), pk2(o[6], o[7])};
              *(u32x4*)(dst + 8) = (u32x4){pk2(o[8], o[9]), pk2(o[10], o[11]), pk2(o[12], o[13]), pk2(o[14], o[15])}; }
        }
        __syncthreads();
    }
    REPS(11) ffn_weights(C, A, layer, C.gw, C.NGW, ffn_split(layer), 1 << 30);
}

__device__ __forceinline__ void p5_rms(Ctx& C) {
    bf16* MIXED = (bf16*)(C.ws + WS_SCR + SC_MIXED);
    REPS(7) for (int mb = C.gw; mb < M; mb += 4 * C.NGW) {
        u32x4 wa[4]; u32x2 wb[4];
#pragma unroll
        for (int k = 0; k < 4; ++k) { const bf16* r = MIXED + ((size_t)mb + (size_t)k * C.NGW) * 1024; wa[k] = ((const u32x4*)r)[C.lane]; wb[k] = ((const u32x2*)(r + 512))[C.lane]; }
#pragma unroll
        for (int k = 0; k < 4; ++k) { bf16* r = MIXED + ((size_t)mb + (size_t)k * C.NGW) * 1024;
            { const u32x4 w = wa[k]; float a[8] = {bflo(w.x), bfhi(w.x), bflo(w.y), bfhi(w.y), bflo(w.z), bfhi(w.z), bflo(w.w), bfhi(w.w)}; float ss = 0.f;
#pragma unroll
              for (int i = 0; i < 8; ++i) ss += a[i] * a[i];
              ss = wave_sum(ss); const float rs = 1.0f / sqrtf(ss * (1.0f / 512) + EPS);
              ((u32x4*)r)[C.lane] = (u32x4){pk2(a[0] * rs, a[1] * rs), pk2(a[2] * rs, a[3] * rs), pk2(a[4] * rs, a[5] * rs), pk2(a[6] * rs, a[7] * rs)}; }
            { const u32x2 w = wb[k]; const float a0 = bflo(w.x), a1 = bfhi(w.x), a2 = bflo(w.y), a3 = bfhi(w.y);
              const float ss = wave_sum((a0 * a0 + a1 * a1) + (a2 * a2 + a3 * a3)); const float rs = 1.0f / sqrtf(ss * (1.0f / 256) + EPS); ((u32x2*)(r + 512))[C.lane] = (u32x2){pk2(a0 * rs, a1 * rs), pk2(a2 * rs, a3 * rs)}; }
        }
    }
}

template <int MODE>
__device__ __forceinline__ void ln_pass(Ctx& C, const bool final, const bf16* add, const float* gam, const float* bet, const float* router_w) {
    bf16* XB = (bf16*)(C.ws + WS_XB); float* out = C.out;
    REPS(14) {
    const bool dry = ((REP_MASK >> 14) & 1) && rep_ == 0; float* jf = (float*)(C.ws + WS_SCR); bf16* jb = (bf16*)(C.ws + WS_SCR + 40 * MiB);
    int* TOPE = (int*)(C.ws + WS_MOE + MT_TOPE); float* TOPG = (float*)(C.ws + WS_MOE + MT_TOPG); const int* TOKSLOT = (const int*)(C.ws + WS_MOE + MT_TOKSLOT);
    LAS float* RW = (LAS float*)C.lds; LAS unsigned* CNT = (LAS unsigned*)(C.lds + 32768);
    if constexpr (MODE == 1) {
        for (int i = C.tid; i < 1024 * 8 / 4; i += NTHR) *(LAS f32x4*)(RW + 4 * i) = *(const f32x4*)(router_w + 4 * i);
        if (C.tid < 8) CNT[C.tid] = 0u;
        __syncthreads();
    }
    f32x4 g4[4], b4[4];
#pragma unroll
    for (int j = 0; j < 4; ++j) { g4[j] = ((const f32x4*)gam)[64 * j + C.lane]; b4[j] = ((const f32x4*)bet)[64 * j + C.lane]; }
    const int RPB = M / C.G, row0 = C.bx * RPB;
    unsigned cnt0 = 0, cnt1 = 0, cnt2 = 0, cnt3 = 0, cnt4 = 0, cnt5 = 0, cnt6 = 0, cnt7 = 0;
    u32x2 xA[4], aA[4], bA[4], xB[4], aB[4], bB[4]; int sA0 = 0, sA1 = 0, sB0 = 0, sB1 = 0;
#define LN_LOAD(NX, NA, NB, mm, s0_, s1_) do { _Pragma("unroll") for (int j = 0; j < 4; ++j) { NX[j] = ((const u32x2*)(XB + (size_t)(mm) * DM))[64 * j + C.lane]; \
        if constexpr (MODE == 2) { NA[j] = ((const u32x2*)(add + (size_t)(s0_) * DM))[64 * j + C.lane]; NB[j] = ((const u32x2*)(add + (size_t)(s1_) * DM))[64 * j + C.lane]; } \
        else { NA[j] = ((const u32x2*)(add + (size_t)(mm) * DM))[64 * j + C.lane]; NB[j] = (u32x2){0u, 0u}; } } } while (0)
#define LN_SLOTS(s0_, s1_, rrr) do { if constexpr (MODE == 2) { if ((rrr) < RPB) { s0_ = TOKSLOT[2 * (row0 + (rrr))]; s1_ = TOKSLOT[2 * (row0 + (rrr)) + 1]; } } } while (0)
#define LN_ROW(NX, NA, NB, S0, S1, rr_) do { const int m = row0 + (rr_); \
        f32x4 v[4]; \
        _Pragma("unroll") for (int j = 0; j < 4; ++j) { v[j] = (f32x4){bflo(NX[j].x), bfhi(NX[j].x), bflo(NX[j].y), bfhi(NX[j].y)} * ALPHA + (f32x4){bflo(NA[j].x), bfhi(NA[j].x), bflo(NA[j].y), bfhi(NA[j].y)}; \
            if constexpr (MODE == 2) v[j] += (f32x4){bflo(NB[j].x), bfhi(NB[j].x), bflo(NB[j].y), bfhi(NB[j].y)}; } \
        if ((rr_) + 2 * NWAVES < RPB) { LN_LOAD(NX, NA, NB, m + 2 * NWAVES, S0, S1); LN_SLOTS(S0, S1, (rr_) + 4 * NWAVES); } \
        float s = 0.f; \
        _Pragma("unroll") for (int j = 0; j < 4; ++j) s += (v[j][0] + v[j][1]) + (v[j][2] + v[j][3]); \
        const float mean = wave_sum(s) * (1.0f / DM); float q = 0.f; \
        _Pragma("unroll") for (int j = 0; j < 4; ++j) { v[j] = v[j] - mean; q += (v[j][0] * v[j][0] + v[j][1] * v[j][1]) + (v[j][2] * v[j][2] + v[j][3] * v[j][3]); } \
        const float rstd = 1.0f / sqrtf(wave_sum(q) * (1.0f / DM) + EPS); \
        _Pragma("unroll") for (int j = 0; j < 4; ++j) { v[j] = v[j] * rstd * g4[j] + b4[j]; if (final) ((f32x4*)((dry ? jf + (size_t)(m & 8191) * DM : out + (size_t)m * DM)))[64 * j + C.lane] = v[j]; \
            ((u32x2*)((dry ? jb + (size_t)(m & 8191) * DM : XB + (size_t)m * DM)))[64 * j + C.lane] = (u32x2){pk2(v[j][0], v[j][1]), pk2(v[j][2], v[j][3])}; } \
        if constexpr (MODE == 1) { \
            float lg[8] = {0.f, 0.f, 0.f, 0.f, 0.f, 0.f, 0.f, 0.f}; \
            _Pragma("unroll") for (int j = 0; j < 4; ++j) \
                _Pragma("unroll") for (int i = 0; i < 4; ++i) { const int col = 256 * j + 4 * C.lane + i; const f32x4 w0 = *(const LAS f32x4*)(RW + col * 8), w1 = *(const LAS f32x4*)(RW + col * 8 + 4); const float xv = v[j][i]; \
                    lg[0] += xv * w0[0]; lg[1] += xv * w0[1]; lg[2] += xv * w0[2]; lg[3] += xv * w0[3]; lg[4] += xv * w1[0]; lg[5] += xv * w1[1]; lg[6] += xv * w1[2]; lg[7] += xv * w1[3]; } \
            _Pragma("unroll") for (int e = 0; e < 8; ++e) lg[e] = wave_sum(lg[e]); \
            int e1 = 0; float v1 = lg[0]; \
            _Pragma("unroll") for (int e = 1; e < 8; ++e) if (lg[e] > v1) { v1 = lg[e]; e1 = e; } \
            int e2 = -1; float v2 = -INFINITY; \
            _Pragma("unroll") for (int e = 0; e < 8; ++e) if (e != e1 && lg[e] > v2) { v2 = lg[e]; e2 = e; } \
            const float ex = fexp2((v2 - v1) * LOG2E), gA = 1.0f / (1.0f + ex), gB = ex * gA; \
            if (C.lane == 0) { TOPE[2 * m] = e1; TOPE[2 * m + 1] = e2; TOPG[2 * m] = gA; TOPG[2 * m + 1] = gB; } \
            cnt0 += (e1 == 0) + (e2 == 0); cnt1 += (e1 == 1) + (e2 == 1); cnt2 += (e1 == 2) + (e2 == 2); cnt3 += (e1 == 3) + (e2 == 3); \
            cnt4 += (e1 == 4) + (e2 == 4); cnt5 += (e1 == 5) + (e2 == 5); cnt6 += (e1 == 6) + (e2 == 6); cnt7 += (e1 == 7) + (e2 == 7); \
        } } while (0)
    LN_SLOTS(sA0, sA1, C.wave); LN_SLOTS(sB0, sB1, C.wave + NWAVES);
    LN_LOAD(xA, aA, bA, row0 + C.wave, sA0, sA1); LN_LOAD(xB, aB, bB, row0 + C.wave + NWAVES, sB0, sB1);
    LN_SLOTS(sA0, sA1, C.wave + 2 * NWAVES); LN_SLOTS(sB0, sB1, C.wave + 3 * NWAVES);
    for (int rr = C.wave; rr < RPB; rr += 2 * NWAVES) {
        LN_ROW(xA, aA, bA, sA0, sA1, rr);
        LN_ROW(xB, aB, bB, sB0, sB1, rr + NWAVES);
    }
    if constexpr (MODE == 1) {
        if (C.lane == 0) { atomicAdd((unsigned*)&CNT[0], cnt0); atomicAdd((unsigned*)&CNT[1], cnt1); atomicAdd((unsigned*)&CNT[2], cnt2); atomicAdd((unsigned*)&CNT[3], cnt3);
                           atomicAdd((unsigned*)&CNT[4], cnt4); atomicAdd((unsigned*)&CNT[5], cnt5); atomicAdd((unsigned*)&CNT[6], cnt6); atomicAdd((unsigned*)&CNT[7], cnt7); }
        __syncthreads();
        if (C.tid < 8) C.ctl[CW_CNTB + C.bx * 8 + C.tid] = CNT[C.tid];
        __syncthreads();
    }
    }
#undef LN_LOAD
#undef LN_SLOTS
#undef LN_ROW
}

__device__ __forceinline__ void moe_assign(Ctx& C) {
    if (C.wave != 0) return;
    const int* TOPE = (const int*)(C.ws + WS_MOE + MT_TOPE); const float* TOPG = (const float*)(C.ws + WS_MOE + MT_TOPG);
    int* TOKSLOT = (int*)(C.ws + WS_MOE + MT_TOKSLOT); int* SLOTTOK = (int*)(C.ws + WS_MOE + MT_SLOTTOK); float* SLOTGATE = (float*)(C.ws + WS_MOE + MT_SLOTGATE);
    const int blk = C.bx, RPB = M / C.G, row0 = blk * RPB;
    int tot[8] = {0, 0, 0, 0, 0, 0, 0, 0}, pre[8] = {0, 0, 0, 0, 0, 0, 0, 0};
    for (int bb = C.lane; bb < C.G; bb += 64) {
        const u32x4* cp = (const u32x4*)(C.ctl + CW_CNTB + bb * 8); const u32x4 ca = cp[0], cb = cp[1]; const int lt = bb < blk ? 1 : 0;
        const int c[8] = {(int)ca.x, (int)ca.y, (int)ca.z, (int)ca.w, (int)cb.x, (int)cb.y, (int)cb.z, (int)cb.w};
#pragma unroll
        for (int e = 0; e < 8; ++e) { tot[e] += c[e]; pre[e] += lt * c[e]; }
    }
#pragma unroll
    for (int e = 0; e < 8; ++e) { tot[e] = wave_sum_i(tot[e]); pre[e] = wave_sum_i(pre[e]); }
    int seg[9]; seg[0] = 0;
#pragma unroll
    for (int e = 0; e < 8; ++e) seg[e + 1] = seg[e] + ((tot[e] + 255) & ~255);
    int run[8];
#pragma unroll
    for (int e = 0; e < 8; ++e) run[e] = seg[e] + pre[e];
    const unsigned long long ltmask = (1ull << C.lane) - 1ull;
    for (int base = 0; base < RPB * 2; base += 64) {
        const int idx = base + C.lane, token = row0 + (idx >> 1), choice = idx & 1;
        const int ex = TOPE[2 * token + choice]; const float gate = TOPG[2 * token + choice]; int slot = 0;
#pragma unroll
        for (int e = 0; e < 8; ++e) { const unsigned long long mk = __builtin_amdgcn_ballot_w64(ex == e); if (ex == e) slot = run[e] + __popcll(mk & ltmask); run[e] += __popcll(mk); }
        SLOTTOK[slot] = token; SLOTGATE[slot] = gate; TOKSLOT[2 * token + choice] = slot;
    }
    if (blk < 8) {
        int lo = 0, hi = 0;
#pragma unroll
        for (int e = 0; e < 8; ++e) if (e == blk) { lo = seg[e] + tot[e]; hi = seg[e + 1]; }
        for (int s = lo + C.lane; s < hi; s += 64) { SLOTTOK[s] = 0; SLOTGATE[s] = 0.f; }
    }
    if (blk == 0 && C.lane == 0) {
#pragma unroll
        for (int e = 0; e < 9; ++e) C.ctl[CW_SEG + e] = (unsigned)seg[e];
    }
}

#ifndef MK_PER_PHASE
#define MK_PER_PHASE 0
#endif
#ifndef PH_ENABLE
#define PH_ENABLE 0xFFFF
#endif
constexpr int PH_PER_LAYER = 12, N_PHASES = 1 + DEPTH * PH_PER_LAYER;

__global__ void __launch_bounds__(NTHR, 2) fwd_kernel(Args args) {
    extern __shared__ __attribute__((aligned(16))) unsigned char lds_raw[];
    LAS unsigned char* const lds = (LAS unsigned char*)lds_raw;
    volatile LAS unsigned* MISC = (volatile LAS unsigned*)(lds + MISC_OFF);
    for (int u = threadIdx.x; u < (LDS_BYTES - LDSCTL_OFF) / 4; u += NTHR) ((LAS unsigned*)(lds + LDSCTL_OFF))[u] = 0u;
    __syncthreads();
    const int wave0 = __builtin_amdgcn_readfirstlane((int)threadIdx.x >> 6);
    XcdBarrier bar; bar.bar = (unsigned*)(args.ws + WS_CTL) + CW_BAR; bar.x = 0; bar.st = nullptr;
    if (!MK_PER_PHASE) bar = xcd_barrier_post((unsigned*)(args.ws + WS_CTL) + CW_BAR, MISC + 8, wave0);
    const int lo = args.ph_lo, hi = args.ph_hi;
#define IN(k) (lo <= (k) && (k) < hi)
#define EN(p) ((PH_ENABLE >> (p)) & 1)
#define SEAM(k) do { if (IN((k) + 1)) { if (!MK_PER_PHASE) { unsigned long long bw0_ = 0ull; if (PROBE_ON(14)) bw0_ = __builtin_amdgcn_s_memrealtime(); xcd_barrier<false>(bar, wave0); if ((REP_MASK >> 13) & 1) xcd_barrier<false>(bar, wave0); \
        if (PROBE_ON(14)) { const unsigned long long bw1_ = __builtin_amdgcn_s_memrealtime(), bd_ = bw1_ - bw0_; while (__builtin_amdgcn_s_memrealtime() - bw1_ < bd_) __builtin_amdgcn_s_sleep(8); } \
        if (PROBE_ON(13)) { const unsigned long long bw1_ = __builtin_amdgcn_s_memrealtime(); while (__builtin_amdgcn_s_memrealtime() - bw1_ < 2000ull) __builtin_amdgcn_s_sleep(8); } } } } while (0)
#define SEAM0(k) do { if (IN((k) + 1)) { if (!MK_PER_PHASE) xcd_barrier<true>(bar, wave0); } } while (0)
#define PHASE_CTX kargs_t A = opaque_args(); Ctx C = make_ctx(A, lds, wave0); unsigned char* sc = C.ws + WS_SCR; (void)sc

    PT0(15); if (EN(15) && IN(0)) { PHASE_CTX; p0_prologue(C, A); }
    PEND(15, SEAM0(0));

    for (int layer = 0; layer < DEPTH; ++layer) {
        const int P = 1 + layer * PH_PER_LAYER;
#ifdef FORCE_MOE
        const bool moe = FORCE_MOE != 0;
#else
        const bool moe = (layer & 1) != 0;
#endif
        if (EN(0) && IN(P + 0)) { PT0(0);
            PHASE_CTX;
            pg8::DenseOrder S{(const bf16*)(C.ws + WS_XB), (const bf16*)(C.ws + WS_WIN) + (size_t)layer * NP1 * DM, DM, DM, M / 256, NP1 / 256, C.G, C.bx, REPN(0)};
            EpiInProj E{(bf16*)(sc + SC_CQKV), (bf16*)(sc + SC_CQKV) + (size_t)M * 256, (float*)(sc + SC_KR), (float*)(sc + SC_FL), (bf16*)(sc + SC_FQ), (bf16*)(sc + SC_CI), (float*)(sc + SC_RSQ)};
            if (C.bx >= C.G / 2) { ffn_weights(C, A, layer, (C.bx - C.G / 2) * NWAVES + C.wave, (C.G / 2) * NWAVES, 0, ffn_split(layer)); __syncthreads(); }
            pg8::gemm_phase<EpiInProj, pg8::DenseOrder, false, DM, DM, DM>(C.lds, C.tid, S, E);
            PEND(0, SEAM(P + 0));
        }
        if (EN(1) && IN(P + 1)) { PT0(1); PHASE_CTX; p2_thin(C, A, layer); PEND(1, SEAM(P + 1)); }
        if (EN(2) && IN(P + 2)) { PT0(2);
            PHASE_CTX;
            struct QkvOrder { const bf16* A; const bf16* Bt; int G, c, rep;
                __device__ __forceinline__ bool next(int i, pg8::Unit& u) const { return pg8::tile_order_rep(i, G, c, M / 256, 7, rep, u.pm, u.pn); }
                __device__ __forceinline__ const char* a_base(const pg8::Unit& u) const { return (const char*)(A + (u.pn < 3 ? (size_t)0 : (size_t)M * 256)) + (size_t)u.pm * 256 * 256 * 2; }
                __device__ __forceinline__ const char* b_base(const pg8::Unit& u) const { return (const char*)Bt + (size_t)u.pn * 256 * 256 * 2; }
                __device__ __forceinline__ int tok(const pg8::Unit&, int) const { return 0; }
                __device__ __forceinline__ int ktiles(const pg8::Unit& u, int nt) const { return u.pn < 3 ? nt : nt / 2; } };
            QkvOrder S{(const bf16*)(sc + SC_CQKV), (const bf16*)(C.ws + WS_WQ2) + (size_t)layer * NP1 * 256, C.G, C.bx, REPN(2)};
            EpiQKV E{(bf16*)(sc + SC_QM), (bf16*)(sc + SC_KM), (bf16*)(sc + SC_VM), (const float*)(C.ws + WS_TAB), (const float*)(C.ws + WS_TAB) + (size_t)M * 16, (const float*)(sc + SC_RSQ)};
            pg8::gemm_phase<EpiQKV, QkvOrder, false, 256, 256, 256>(C.lds, C.tid, S, E);
            PEND(2, SEAM(P + 2));
        }
        if (EN(3) && IN(P + 3)) { PT0(3);
            PHASE_CTX;
            bf16* MIXED = (bf16*)(sc + SC_MIXED);
            for (int p = C.vcu; p < 512; p += C.G) { const int bh = p >> 3, s = p & 7;
                for (int i = 0; i < 2; ++i) att::attn_unit<96, false>(bh >> 3, bh & 7, i == 0 ? 15 - s : s, (const bf16*)(sc + SC_QM), 768, (const bf16*)(sc + SC_KM), 768, (const bf16*)(sc + SC_VM), 512, MIXED, 1024, (bh & 7) * 64, nullptr, C.lds, C.tid, (float*)(sc + SC_SSQ), bh & 7, nullptr);
            }
            { volatile LAS unsigned* qw = (volatile LAS unsigned*)(C.lds + RING_BYTES + 8192); const int xb = C.bx & 7; unsigned* qctr = C.ctl + CW_ATTQ + layer * 8 + xb;
              const bf16* FQ = (const bf16*)(sc + SC_FQ);
              for (;;) {
                if (C.tid == 0) qw[0] = __hip_atomic_fetch_add(qctr, 1u, RLX_AGENT);
                asm volatile("s_waitcnt vmcnt(0) lgkmcnt(0)\n\ts_barrier" ::: "memory");
                const int idx = __builtin_amdgcn_readfirstlane((int)qw[0]);
                if (idx >= 64) break;
                const int hd = idx & 3, qb = 15 - (idx >> 2), bh = xb * 4 + hd;
                att::attn_unit<64, true>(xb, hd, qb, FQ, 256, FQ + (size_t)M * 256, 256, FQ + (size_t)2 * M * 256, 256, MIXED, 1024, 512 + hd * 64, (const float*)(sc + SC_CUM), C.lds, C.tid, (float*)(sc + SC_SSQ), 8 + hd, C.ctl + CW_QKMAX + layer * 64 + bh * 2);
              }
            }
            PEND(3, SEAM(P + 3));
        }
        if (EN(5) && IN(P + 5)) { PT0(5);
            PHASE_CTX;
            pg8::DenseOrder S{(const bf16*)(sc + SC_MIXED), (const bf16*)(C.ws + WS_WOUT) + (size_t)layer * DM * DM, DM, DM, M / 256, DM / 256, C.G, C.bx, REPN(5)};
            EpiBf16<DM, false> E{(bf16*)(sc + SC_MIXOUT), DM / 256, nullptr};
            pg8::gemm_phase<EpiBf16<DM, false>, pg8::DenseOrder, false, DM, DM, DM, true>(C.lds, C.tid, S, E, (const float*)(sc + SC_SSQ));
            PEND(5, SEAM(P + 5));
        }
        if (EN(6) && IN(P + 6)) { PT0(6);
            if (moe) { PHASE_CTX; ln_pass<1>(C, false, (const bf16*)(sc + SC_MIXOUT), A->in[15] + layer * DM, A->in[16] + layer * DM, A->in[20] + (size_t)(layer >> 1) * DM * NEXP); }
            else     { PHASE_CTX; ln_pass<0>(C, false, (const bf16*)(sc + SC_MIXOUT), A->in[15] + layer * DM, A->in[16] + layer * DM, nullptr); }
            PEND(6, SEAM(P + 6));
        }
        if (EN(7) && IN(P + 7) && moe) { PT0(7); { PHASE_CTX; moe_assign(C); } PEND(7, SEAM(P + 7)); }
        if (EN(8) && IN(P + 8)) { PT0(8);
            if (moe) {
                PHASE_CTX; bf16* W13 = (bf16*)(C.ws + WS_WFFN); bf16* HID = (bf16*)(sc + SC_HID);
                const int* seg = (const int*)(C.ctl + CW_SEG);
                const int U = (seg[8] / 256) * 11;
                MoeIdxOrder<11> S{(const bf16*)(C.ws + WS_XB), W13, DM, DM, C.vcu, C.G, (U / C.G) * C.G, (const int*)(C.ws + WS_MOE + MT_SLOTTOK), seg[1], seg[2], seg[3], seg[4], seg[5], seg[6], seg[7]};
                EpiSwiGLU<DFE> E{HID, 11};
                pg8::gemm_phase<EpiSwiGLU<DFE>, MoeIdxOrder<11>, true, DM, DM, DM>(C.lds, C.tid, S, E);
            } else {
                PHASE_CTX; bf16* W13 = (bf16*)(C.ws + WS_WFFN); bf16* HID = (bf16*)(sc + SC_HID);
                pg8::DenseOrder S{(const bf16*)(C.ws + WS_XB), W13, DM, DM, M / 256, 2 * DFF / 256, C.G, C.bx, REPN(8)};
                EpiSwiGLU<DFF> E{HID, 1 << 30};
                pg8::gemm_phase<EpiSwiGLU<DFF>, pg8::DenseOrder, false, DM, DM, DM>(C.lds, C.tid, S, E);
            }
            PEND(8, SEAM(P + 8));
        }
        if (EN(9) && IN(P + 9)) { PT0(9);
            if (moe) {
                { PHASE_CTX; bf16* W13 = (bf16*)(C.ws + WS_WFFN); bf16* HID = (bf16*)(sc + SC_HID); const int* seg = (const int*)(C.ctl + CW_SEG);
                  const int U = (seg[8] / 256) * 11, UF = (U / C.G) * C.G;
                  if (UF + C.vcu < U) {
                      MoeIdxOrder<11> S{(const bf16*)(C.ws + WS_XB), W13, DM, DM, UF + C.vcu, C.G, U, (const int*)(C.ws + WS_MOE + MT_SLOTTOK), seg[1], seg[2], seg[3], seg[4], seg[5], seg[6], seg[7]};
                      EpiSwiGLU<DFE> E{HID, 11};
                      pg8::gemm_phase<EpiSwiGLU<DFE>, MoeIdxOrder<11>, true, DM, DM, DM>(C.lds, C.tid, S, E);
                      if (C.tid == 0) { __builtin_amdgcn_fence(__ATOMIC_RELEASE, "agent"); asm volatile("s_waitcnt vmcnt(0)" ::: "memory"); __hip_atomic_fetch_add(C.ctl + CW_LEFT + layer, 1u, RLX_AGENT); }
                  } }
                { PHASE_CTX; bf16* W2T = (bf16*)(C.ws + WS_WFFN) + WF_W13_ELEMS; bf16* HID = (bf16*)(sc + SC_HID); bf16* FF = (bf16*)(sc + SC_FF); const int* seg = (const int*)(C.ctl + CW_SEG);
                  const int U = (seg[8] / 256) * 11, UF = (U / C.G) * C.G, DF = (UF / 11) * 4;
                  MoeIdxOrder<4> S{HID, W2T, DFE, DFE, C.vcu, C.G, DF, nullptr, seg[1], seg[2], seg[3], seg[4], seg[5], seg[6], seg[7]};
                  EpiBf16<DM, true> E{FF, 4, (const float*)(C.ws + WS_MOE + MT_SLOTGATE)};
                  pg8::gemm_phase<EpiBf16<DM, true>, MoeIdxOrder<4>, false, DFE, DFE, DFE>(C.lds, C.tid, S, E); }
                { PHASE_CTX; bf16* W2T = (bf16*)(C.ws + WS_WFFN) + WF_W13_ELEMS; bf16* HID = (bf16*)(sc + SC_HID); bf16* FF = (bf16*)(sc + SC_FF); const int* seg = (const int*)(C.ctl + CW_SEG);
                  const int nM = seg[8] / 256, U = nM * 11, UF = (U / C.G) * C.G, DF = (UF / 11) * 4;
                  if (DF + (C.G - 1 - C.vcu) < nM * 4) {
                      if (C.wave == 0) { const unsigned need = (unsigned)(U - UF); unsigned* cw = C.ctl + CW_LEFT + layer;
                          while ((unsigned)__builtin_amdgcn_readfirstlane((int)__hip_atomic_load(cw, RLX_AGENT)) < need) __builtin_amdgcn_s_sleep(4);
                          __builtin_amdgcn_fence(__ATOMIC_ACQUIRE, "agent"); asm volatile("s_waitcnt vmcnt(0)" ::: "memory"); }
                      __syncthreads();
                      MoeIdxOrder<4> S{HID, W2T, DFE, DFE, DF + (C.G - 1 - C.vcu), C.G, nM * 4, nullptr, seg[1], seg[2], seg[3], seg[4], seg[5], seg[6], seg[7]};
                      EpiBf16<DM, true> E{FF, 4, (const float*)(C.ws + WS_MOE + MT_SLOTGATE)};
                      pg8::gemm_phase<EpiBf16<DM, true>, MoeIdxOrder<4>, false, DFE, DFE, DFE>(C.lds, C.tid, S, E);
                  } }
            } else {
                PHASE_CTX; bf16* W2T = (bf16*)(C.ws + WS_WFFN) + WF_W13_ELEMS; bf16* HID = (bf16*)(sc + SC_HID); bf16* FF = (bf16*)(sc + SC_FF);
                pg8::DenseOrder S{HID, W2T, DFF, DFF, M / 256, DM / 256, C.G, C.bx, REPN(9)};
                EpiBf16<DM, false> E{FF, DM / 256, nullptr};
                pg8::gemm_phase<EpiBf16<DM, false>, pg8::DenseOrder, false, DFF, DFF, DFF>(C.lds, C.tid, S, E);
            }
            PEND(9, SEAM(P + 9));
        }
        if (EN(10) && IN(P + 10)) { PT0(10);
            if (moe) { PHASE_CTX; ln_pass<2>(C, layer == DEPTH - 1, (const bf16*)(sc + SC_FF), A->in[24] + layer * DM, A->in[25] + layer * DM, nullptr); }
            else     { PHASE_CTX; ln_pass<0>(C, layer == DEPTH - 1, (const bf16*)(sc + SC_FF), A->in[24] + layer * DM, A->in[25] + layer * DM, nullptr); }
            PEND(10, if (layer < DEPTH - 1) SEAM(P + 10));
        }
    }
#undef IN
#undef SEAM
}

extern "C" void kernel_launch(void* const* d_in, const int* in_sizes, int n_in, void* d_out, int out_size, void* d_ws, size_t ws_size, hipStream_t stream) {
    static int grid = 0;
    if (grid == 0) {
        if (n_in != 26 || out_size != M * DM || ws_size < WS_END) { fprintf(stderr, "kernel_launch: unexpected problem (n_in %d, out %d, ws %zu < %zu)\n", n_in, out_size, ws_size, (size_t)WS_END); grid = -1; return; }
        int dev = 0, cus = 0, per_cu = 0;
        if (hipGetDevice(&dev) != hipSuccess || hipDeviceGetAttribute(&cus, hipDeviceAttributeMultiprocessorCount, dev) != hipSuccess) { grid = -1; return; }
        if (hipFuncSetAttribute((const void*)fwd_kernel, hipFuncAttributeMaxDynamicSharedMemorySize, LDS_BYTES) != hipSuccess) { fprintf(stderr, "kernel_launch: hipFuncSetAttribute failed\n"); grid = -1; return; }
        if (hipOccupancyMaxActiveBlocksPerMultiprocessor(&per_cu, (const void*)fwd_kernel, NTHR, LDS_BYTES) != hipSuccess || per_cu < 1) fprintf(stderr, "kernel_launch: occupancy query says %d\n", per_cu);
        (void)hipGetLastError();
        grid = 256; while (grid > cus && grid > 8) grid >>= 1;
    }
    if (grid < 0) return;
    (void)hipMemsetAsync((char*)d_ws + WS_CTL, 0, CTL_ZERO_BYTES, stream);
    Args a{};
    for (int i = 0; i < 26; ++i) a.in[i] = (const float*)d_in[i];
    a.out = (float*)d_out; a.ws = (unsigned char*)d_ws;
#if MK_PER_PHASE
    for (int p = 0; p < N_PHASES; ++p) { a.ph_lo = p; a.ph_hi = p + 1; hipLaunchKernelGGL(fwd_kernel, dim3(grid), dim3(NTHR), LDS_BYTES, stream, a); }
#else
    a.ph_lo = 0; a.ph_hi = N_PHASES;
    hipLaunchKernelGGL(fwd_kernel, dim3(grid), dim3(NTHR), LDS_BYTES, stream, a);
#endif
}
```

```cpp
#include <hip/hip_runtime.h>
#include <cstdio>
#include <cstdint>
#include <cmath>

#ifndef REP_MASK
#define REP_MASK 0x0
#endif
#ifndef PROBE_MASK
#define PROBE_MASK 0x0
#endif
#define PROBE_ON(k) ((PROBE_MASK >> (k)) & 1)
#define PT0(k) unsigned long long pt0_ = 0ull; if (PROBE_ON(k)) pt0_ = __builtin_amdgcn_s_memrealtime()
#ifndef PROBE_BEFORE
#define PROBE_BEFORE 0
#endif
#define PSPIN(d) do { const unsigned long long pt1_ = __builtin_amdgcn_s_memrealtime(); while (__builtin_amdgcn_s_memrealtime() - pt1_ < (d)) __builtin_amdgcn_s_sleep(8); } while (0)
#define PEND(k, seamexpr) do { unsigned long long pd_ = 0ull; if (PROBE_ON(k)) { pd_ = __builtin_amdgcn_s_memrealtime() - pt0_; if (PROBE_BEFORE) PSPIN(pd_); } seamexpr; \
        if (PROBE_ON(k) && !PROBE_BEFORE) PSPIN(pd_); } while (0)
#define REPN(p) (1 + ((REP_MASK >> (p)) & 1))
#define REPS(p) for (int rep_ = 0; rep_ < 1 + ((REP_MASK >> (p)) & 1); ++rep_)
#define GAS __attribute__((address_space(1)))
#define LAS __attribute__((address_space(3)))
typedef unsigned short bf16;
typedef short bf16x8 __attribute__((ext_vector_type(8)));
typedef short s16x4 __attribute__((ext_vector_type(4)));
typedef float f32x2 __attribute__((ext_vector_type(2)));
typedef float f32x4 __attribute__((ext_vector_type(4)));
typedef float f32x16 __attribute__((ext_vector_type(16)));
typedef unsigned u32x2 __attribute__((ext_vector_type(2)));
typedef unsigned u32x4 __attribute__((ext_vector_type(4)));
typedef __bf16 bf16x2_t __attribute__((ext_vector_type(2)));

constexpr int BATCH = 8, SEQ = 4096, DM = 1024, M = BATCH * SEQ, DEPTH = 4;
constexpr int IN_COLS = 1700, NP1 = 1792;
constexpr int DFF = 2816, DFE = 1408, NEXP = 8;
constexpr int NWAVES = 8, NTHR = 512;
constexpr float ALPHA = 1.6817928305074290f;
constexpr float EPS = 1e-5f;
constexpr float LOG2E = 1.4426950408889634f;
constexpr float C2_MLA = 0.10206207261596577f * LOG2E;
constexpr float C2_FOX = 0.125f * LOG2E;
constexpr int PC_CQ = 0, PC_CKV = 256, PC_KR = 384, PC_FL = 416, PC_FQ = 512, PC_FK = 768, PC_FV = 1024, PC_CI = 1280;
constexpr int MOE_ROWS_MAX = 2 * M + NEXP * 256;

constexpr size_t MiB = 1u << 20;
constexpr size_t WS_CTL = 0, CTL_ZERO_BYTES = 1 * MiB;
constexpr size_t WS_WIN = 1 * MiB;
constexpr size_t WS_WQ2 = WS_WIN + 14 * MiB;
constexpr size_t WS_WOUT = WS_WQ2 + 4 * MiB;
constexpr size_t WS_TAB = WS_WOUT + 8 * MiB;
constexpr size_t WS_MOE = WS_TAB + 4 * MiB;
constexpr size_t WS_WFFN = WS_MOE + 2 * MiB;
constexpr size_t WS_XB = WS_WFFN + 68 * MiB;
constexpr size_t WS_SCR = WS_XB + 64 * MiB;
constexpr size_t SC_CQKV = 0;
constexpr size_t SC_KR = SC_CQKV + 32 * MiB;
constexpr size_t SC_FL = SC_KR + 4 * MiB;
constexpr size_t SC_CUM = SC_FL + MiB / 2;
constexpr size_t SC_FQ = SC_CUM + MiB / 2;
constexpr size_t SC_CI = SC_FQ + 48 * MiB;
constexpr size_t SC_RSQ = SC_CI + 16 * MiB;
constexpr size_t SC_QM = SC_CI + 32 * MiB;
constexpr size_t SC_KM = SC_QM + 48 * MiB;
constexpr size_t SC_VM = SC_KM + 48 * MiB;
constexpr size_t SC_MIXED = SC_VM + 32 * MiB;
constexpr size_t SC_MIXOUT = SC_QM;
constexpr size_t SC_SSQ = SC_MIXED + 64 * MiB;
constexpr size_t SC_MIX_END = SC_SSQ + 2 * MiB;
constexpr size_t SC_HID = 0;
constexpr size_t SC_FF = 182 * MiB;
constexpr size_t SC_END = 316 * MiB;
constexpr size_t WS_END = WS_SCR + SC_END;
static_assert(SC_MIX_END <= SC_END && SC_FF + (size_t)MOE_ROWS_MAX * 1024 * 2 <= SC_END && (size_t)MOE_ROWS_MAX * DFE * 2 <= SC_FF, "scratch map");
static_assert(WS_END <= 512 * MiB, "workspace map");
constexpr size_t WF_W13_ELEMS = (size_t)NEXP * 2 * DFE * DM;
constexpr size_t MT_TOPE = 0;
constexpr size_t MT_TOPG = 256 * 1024;
constexpr size_t MT_TOKSLOT = 512 * 1024;
constexpr size_t MT_SLOTTOK = 768 * 1024;
constexpr size_t MT_SLOTGATE = 768 * 1024 + 272 * 1024;
static_assert((size_t)MOE_ROWS_MAX * 4 <= 272 * 1024 && MT_SLOTGATE + 272 * 1024 <= 2 * MiB, "moe tables");
constexpr int CW_BAR = 4096;
constexpr int CW_CNTB = 16384;
constexpr int CW_SEG = 20480;
constexpr int CW_ATTQ = 2048;
constexpr int CW_LEFT = 2112;
constexpr int CW_QKMAX = 1024;

constexpr int RING_BYTES = 131072;
constexpr int LDSCTL_OFF = RING_BYTES, MISC_OFF = LDSCTL_OFF + 320;
constexpr int LDS_BYTES = 147456;

#define RLX_AGENT __ATOMIC_RELAXED, __HIP_MEMORY_SCOPE_AGENT
__device__ __forceinline__ unsigned pk2(float lo, float hi) { f32x2 v = {lo, hi}; bf16x2_t b = __builtin_convertvector(v, bf16x2_t); return __builtin_bit_cast(unsigned, b); }
__device__ __forceinline__ float bf2f(unsigned short u) { return __uint_as_float((unsigned)u << 16); }
__device__ __forceinline__ float bflo(unsigned u) { return __uint_as_float(u << 16); }
__device__ __forceinline__ float bfhi(unsigned u) { return __uint_as_float(u & 0xffff0000u); }
__device__ __forceinline__ float fexp2(float x) { return __builtin_amdgcn_exp2f(x); }
__device__ __forceinline__ float frcp(float x) { return __builtin_amdgcn_rcpf(x); }
__device__ __forceinline__ float sigmoidf_(float x) { return frcp(1.0f + fexp2(-x * LOG2E)); }
__device__ __forceinline__ float siluf_(float x) { return x * sigmoidf_(x); }
template <int O> __device__ __forceinline__ float lane_xor(float v) {
    if constexpr (O < 32) return __int_as_float(__builtin_amdgcn_ds_swizzle(__float_as_int(v), (O << 10) | 0x1f));
    else { auto rr = __builtin_amdgcn_permlane32_swap(__float_as_uint(v), __float_as_uint(v), false, false); return __uint_as_float(rr[0]) == v ? __uint_as_float(rr[1]) : __uint_as_float(rr[0]); }
}
__device__ __forceinline__ float wave_sum(float v) {
    v += lane_xor<1>(v); v += lane_xor<2>(v); v += lane_xor<4>(v); v += lane_xor<8>(v); v += lane_xor<16>(v);
    { auto rr = __builtin_amdgcn_permlane32_swap(__float_as_uint(v), __float_as_uint(v), false, false); v = __uint_as_float(rr[0]) + __uint_as_float(rr[1]); }
    return v;
}
__device__ __forceinline__ int wave_sum_i(int v) {
    v += __builtin_amdgcn_ds_swizzle(v, (1 << 10) | 0x1f); v += __builtin_amdgcn_ds_swizzle(v, (2 << 10) | 0x1f); v += __builtin_amdgcn_ds_swizzle(v, (4 << 10) | 0x1f);
    v += __builtin_amdgcn_ds_swizzle(v, (8 << 10) | 0x1f); v += __builtin_amdgcn_ds_swizzle(v, (16 << 10) | 0x1f);
    { auto rr = __builtin_amdgcn_permlane32_swap((unsigned)v, (unsigned)v, false, false); v = (int)(rr[0] + rr[1]); }
    return v;
}
__device__ __forceinline__ u32x4 pack8(const f32x4 a, const f32x4 b) { u32x4 w; w.x = pk2(a[0], a[1]); w.y = pk2(a[2], a[3]); w.z = pk2(b[0], b[1]); w.w = pk2(b[2], b[3]); return w; }

#define XB_TMO      128
#define XB_XCNT(j)  (256  + 64 * (j))
#define XB_XSUB(j)  (1280 + 64 * (j))
#define XB_XGEN(j)  (2304 + 64 * (j))
#define XB_TOP      3328
#define XB_TOPGEN   3392
#define XCD_BAR_WORDS 3456
#define XB_SPIN_CAP (1u << 18)
__device__ __forceinline__ unsigned xb_ld(unsigned* p)              { return __hip_atomic_load(p, __ATOMIC_RELAXED, __HIP_MEMORY_SCOPE_AGENT); }
__device__ __forceinline__ unsigned xb_add(unsigned* p, unsigned v) { return __hip_atomic_fetch_add(p, v, __ATOMIC_RELAXED, __HIP_MEMORY_SCOPE_AGENT); }
__device__ __forceinline__ unsigned xb_xcc_id() { return (unsigned)__builtin_amdgcn_s_getreg((3 << 11) | 20) & 0xFu; }
#define XB_SPIN(cond, bar) do { unsigned _sp = 0; while (cond) { __builtin_amdgcn_s_sleep(1); \
    if ((++_sp & 255u) == 0u) { if (xb_ld(&(bar)[XB_TMO])) break; if (_sp > XB_SPIN_CAP) { atomicAdd(&(bar)[XB_TMO], 1u); break; } } } } while (0)
struct XcdBarrier { unsigned* bar; unsigned x; volatile LAS unsigned* st; };
__device__ __forceinline__ bool xb_is_t0(int wave0) { unsigned ones = ~0u; asm volatile("" : "+s"(ones)); return wave0 == 0 && __builtin_amdgcn_mbcnt_hi(ones, __builtin_amdgcn_mbcnt_lo(ones, 0u)) == 0u; }
__device__ __forceinline__ XcdBarrier xcd_barrier_post(unsigned* bar, volatile LAS unsigned* st, int wave0) {
    XcdBarrier b; b.bar = bar; b.x = xb_xcc_id(); b.st = st;
    if (xb_is_t0(wave0)) (void)xb_add(&bar[XB_XCNT(b.x)], 1u);
    return b;
}
__device__ __forceinline__ void xcd_barrier_complete(unsigned* bar, unsigned x, unsigned& nloc, unsigned& nx) {
    const unsigned G = gridDim.x * gridDim.y * gridDim.z;
    unsigned sum, cnt, mine, sp = 0u;
    for (;;) {
        sum = 0u; cnt = 0u; mine = 0u;
#pragma unroll
        for (unsigned j = 0; j < 16; ++j) { const unsigned c = xb_ld(&bar[XB_XCNT(j)]); sum += c; cnt += (c > 0u) ? 1u : 0u; mine = (j == x) ? c : mine; }
        if (sum == G) break;
        __builtin_amdgcn_s_sleep(1);
        if ((++sp & 255u) == 0u) { if (xb_ld(&bar[XB_TMO])) break; if (sp > XB_SPIN_CAP) { atomicAdd(&bar[XB_TMO], 1u); break; } }
    }
    nloc = mine > 0u ? mine : 1u; nx = cnt > 0u ? cnt : 1u;
}
template <bool FIRST>
__device__ __forceinline__ void xcd_barrier(const XcdBarrier& b, int wave0) {
    asm volatile("s_waitcnt vmcnt(0)" ::: "memory");
    __syncthreads();
    if (xb_is_t0(wave0)) {
        unsigned* bar = b.bar;
        __builtin_amdgcn_s_waitcnt(0);
        unsigned nloc = b.st[0], nx = b.st[1];
        if constexpr (FIRST) { if (nloc == 0u) { xcd_barrier_complete(bar, b.x, nloc, nx); b.st[0] = nloc; b.st[1] = nx; } }
        const unsigned old = xb_add(&bar[XB_XSUB(b.x)], 1u);
        const unsigned gen = old / nloc;
        if (old + 1u == (gen + 1u) * nloc) {
            __builtin_amdgcn_fence(__ATOMIC_RELEASE, "agent");
            asm volatile("s_waitcnt vmcnt(0)" ::: "memory");
            const unsigned og = xb_add(&bar[XB_TOP], 1u);
            const unsigned tg = og / nx;
            if (og + 1u == (tg + 1u) * nx) xb_add(&bar[XB_TOPGEN], 1u);
            else XB_SPIN(xb_ld(&bar[XB_TOPGEN]) == tg, bar);
            __builtin_amdgcn_fence(__ATOMIC_ACQUIRE, "agent");
            xb_add(&bar[XB_XGEN(b.x)], 1u);
            asm volatile("s_waitcnt vmcnt(0)" ::: "memory");
        } else {
            XB_SPIN(xb_ld(&bar[XB_XGEN(b.x)]) == gen, bar);
            __builtin_amdgcn_fence(__ATOMIC_ACQUIRE, "agent");
            asm volatile("s_waitcnt vmcnt(0)" ::: "memory");
        }
    }
    __syncthreads();
}

namespace pg8 {
constexpr int BM = 256, BK = 64, HALF = 128, HTB = HALF * BK * 2, STAGE_BYTES = 8 * HTB, NXCD = 8, WGM = 8;
__host__ __device__ __forceinline__ int lds_byte(int r, int c) { const int st = (r >> 4) * 2 + (c >> 5), rr = r & 15, cc = c & 31, ob = rr * 64 + cc * 2; return st * 1024 + (ob ^ (((ob >> 9) & 1) << 5)); }
__host__ __device__ __forceinline__ void stage_rc(int b, int& R, int& C) { const int st = b / 1024, sb = b % 1024, swz = sb ^ (((sb >> 9) & 1) << 5); R = (st >> 1) * 16 + swz / 64; C = (st & 1) * 32 + (swz % 64) / 2; }
__host__ __device__ __forceinline__ int perm32(int rho) { const int n = rho >> 4, i = rho & 15; return 8 * (i >> 2) + 4 * n + (i & 3); }
struct Unit { int pm, pn; };

__device__ __forceinline__ bool tile_order(long L, int nM, int nN, int& pm, int& pn) {
    const int nwg = nM * nN; if (L >= nwg) return false;
    int wgid = (int)L; { const int q = nwg / NXCD, r = nwg % NXCD, xcd = wgid % NXCD, off = wgid / NXCD; wgid = (xcd < r ? xcd * (q + 1) : r * (q + 1) + (xcd - r) * q) + off; }
    const int nig = WGM * nN, gid = wgid / nig, fm = gid * WGM, gsz = (nM - fm) < WGM ? (nM - fm) : WGM;
    pm = fm + ((wgid % nig) % gsz); pn = (wgid % nig) / gsz; return true;
}
__device__ __forceinline__ bool tile_order_rep(int i, int G, int c, int nM, int nN, int rep, int& pm, int& pn) {
    if (rep == 1) return tile_order((long)i * G + c, nM, nN, pm, pn);
    const int nwg = nM * nN, per = c < nwg ? (nwg - c + G - 1) / G : 0; if (i >= per * rep) return false;
    return tile_order((long)(i % per) * G + c, nM, nN, pm, pn);
}
struct DenseOrder {
    const bf16* A; const bf16* Bt; int lda, ldb, nM, nN, G, c, rep;
    __device__ __forceinline__ bool next(int i, Unit& u) const { return tile_order_rep(i, G, c, nM, nN, rep, u.pm, u.pn); }
    __device__ __forceinline__ const char* a_base(const Unit& u) const { return (const char*)A + (size_t)u.pm * BM * lda * 2; }
    __device__ __forceinline__ const char* b_base(const Unit& u) const { return (const char*)Bt + (size_t)u.pn * BM * ldb * 2; }
    __device__ __forceinline__ int tok(const Unit&, int) const { return 0; }
    __device__ __forceinline__ int ktiles(const Unit&, int nt) const { return nt; }
};

template <class Epi, class Sched, bool GATHER, int K, int lda, int ldb, bool SEGSCALE = false>
__device__ __forceinline__ void gemm_phase(LAS unsigned char* lds, const int tid, const Sched& S, const Epi& E, const float* ssq = nullptr) {
    const int wid = __builtin_amdgcn_readfirstlane(tid >> 6), lane = tid & 63, wr = wid >> 2, wc = wid & 3, fr = lane & 15, fq = lane >> 4;
    constexpr int nt = K / BK;
    unsigned voffA[2], voffB[2];
#pragma unroll
    for (int i = 0; i < 2; ++i) { int R, C; stage_rc(tid * 16 + i * 8192, R, C); const int Rb = Epi::PERM ? ((R & ~31) + perm32(R & 31)) : R;
        voffA[i] = (unsigned)(R * lda + C) * 2u; voffB[i] = (unsigned)(Rb * ldb + C) * 2u; }
#define PG8_GOFF(u_, h_, o0_, o1_) do { unsigned ones_ = ~0u; asm volatile("" : "+s"(ones_)); const int t_ = wid * 64 + (int)__builtin_amdgcn_mbcnt_hi(ones_, __builtin_amdgcn_mbcnt_lo(ones_, 0u)); \
        int R0_, C0_, R1_, C1_; stage_rc(t_ * 16, R0_, C0_); stage_rc(t_ * 16 + 8192, R1_, C1_); \
        o0_ = (unsigned)S.tok(u_, (h_) * HALF + R0_) * (unsigned)(lda * 2) + (unsigned)(C0_ * 2); o1_ = (unsigned)S.tok(u_, (h_) * HALF + R1_) * (unsigned)(lda * 2) + (unsigned)(C1_ * 2); } while (0)
    const size_t kstep = (size_t)(BK * 2);
    constexpr size_t hstepA = (size_t)HALF * lda * 2, hstepB = (size_t)HALF * ldb * 2;
    const unsigned ldsw = (unsigned)wid * 1024u;
    const int aoff = lds_byte(wr * 64 + fr, fq * 8), boff = lds_byte(wc * 32 + fr, fq * 8);
#define PG8_SA(b, h) (((b) * 2 + (h)) * HTB)
#define PG8_SB(b, h) ((4 + (b) * 2 + (h)) * HTB)
#define PG8_STAGE(bufoff, gbase, v0, v1) do { \
        __builtin_amdgcn_global_load_lds((const unsigned*)((const char*)(gbase) + (v0)), (LAS unsigned*)(lds + (bufoff) + ldsw), 16, 0, 0); \
        __builtin_amdgcn_global_load_lds((const unsigned*)((const char*)(gbase) + (v1)), (LAS unsigned*)(lds + (bufoff) + ldsw + 8192), 16, 0, 0); } while (0)
#define PG8_STB(bufoff, gbase) PG8_STAGE(bufoff, gbase, voffB[0], voffB[1])
#define PG8_STA(bufoff, gbase, h, G0, G1) do { if constexpr (GATHER) PG8_STAGE(bufoff, gbase, G0, G1); else PG8_STAGE(bufoff, (gbase) + (h) * hstepA, voffA[0], voffA[1]); } while (0)
#define PG8_LDA(dst, b, h) do { _Pragma("unroll") for (int m = 0; m < 4; ++m) _Pragma("unroll") for (int k = 0; k < 2; ++k) dst[m][k] = *(const LAS bf16x8*)(lds + PG8_SA(b, h) + aoff + m * 2048 + k * 1024); } while (0)
#define PG8_LDB(dst, b, h) do { _Pragma("unroll") for (int n = 0; n < 2; ++n) _Pragma("unroll") for (int k = 0; k < 2; ++k) dst[n][k] = *(const LAS bf16x8*)(lds + PG8_SB(b, h) + boff + n * 2048 + k * 1024); } while (0)
#define PG8_MMA(ai, bj, At, Bt) do { __builtin_amdgcn_s_setprio(1); _Pragma("unroll") for (int m = 0; m < 4; ++m) _Pragma("unroll") for (int n = 0; n < 2; ++n) _Pragma("unroll") for (int k = 0; k < 2; ++k) \
        acc[ai][bj][m][n] = __builtin_amdgcn_mfma_f32_16x16x32_bf16(Bt[n][k], At[m][k], acc[ai][bj][m][n], 0, 0, 0); __builtin_amdgcn_s_setprio(0); } while (0)
#define PG8_WAIT_V(n) asm volatile("s_waitcnt vmcnt(" #n ")" ::: "memory")
#define PG8_WAIT_L(n) asm volatile("s_waitcnt lgkmcnt(" #n ")" ::: "memory")
#define PG8_BAR __builtin_amdgcn_s_barrier()
#define PG8_SCHED __builtin_amdgcn_sched_barrier(0)
    Unit cur, nxt; int ui = 0;
    if (!S.next(0, cur)) return;
    f32x4 acc[2][2][4][2];
#pragma unroll
    for (int a = 0; a < 2; ++a)
#pragma unroll
        for (int b = 0; b < 2; ++b)
#pragma unroll
            for (int m = 0; m < 4; ++m)
#pragma unroll
                for (int n = 0; n < 2; ++n) acc[a][b][m][n] = (f32x4){0.f, 0.f, 0.f, 0.f};
    bf16x8 At[4][2], B0[2][2], B1[2][2];
    const char* cA = S.a_base(cur); const char* cB = S.b_base(cur);
    unsigned gc00 = 0, gc01 = 0, gc10 = 0, gc11 = 0, gn00 = 0, gn01 = 0, gn10 = 0, gn11 = 0;
    if constexpr (GATHER) { PG8_GOFF(cur, 0, gc00, gc01); PG8_GOFF(cur, 1, gc10, gc11); }
    PG8_STB(PG8_SB(0, 0), cB); PG8_STB(PG8_SB(0, 1), cB + hstepB); PG8_STA(PG8_SA(0, 0), cA, 0, gc00, gc01); PG8_STA(PG8_SA(0, 1), cA, 1, gc10, gc11);
    if (wr == 1) PG8_BAR;
    PG8_WAIT_V(2); PG8_BAR;
    PG8_STB(PG8_SB(1, 0), cB + kstep); PG8_STA(PG8_SA(1, 0), cA + kstep, 0, gc00, gc01); PG8_STB(PG8_SB(1, 1), cB + hstepB + kstep);
    PG8_WAIT_V(6); PG8_BAR;
    for (;;) {
        const bool has_next = S.next(ui + 1, nxt);
        const char* nA = has_next ? S.a_base(nxt) : cA; const char* nB = has_next ? S.b_base(nxt) : cB;
        if constexpr (SEGSCALE) {
            if (tid < 256) { const f32x4* sp = (const f32x4*)(ssq + (size_t)(cur.pm * 256 + tid) * 12); const f32x4 a = sp[0], b = sp[1], c = sp[2];
                const float sm = ((a[0] + a[1]) + (a[2] + a[3])) + ((b[0] + b[1]) + (b[2] + b[3])), sf = (c[0] + c[1]) + (c[2] + c[3]);
                const float rm = 1.0f / sqrtf(sm * (1.0f / 512) + EPS), rf = 1.0f / sqrtf(sf * (1.0f / 256) + EPS);
                *(LAS f32x2*)(lds + STAGE_BYTES + 1024 + tid * 8) = (f32x2){rm / rf, rf}; }
        }
        if constexpr (GATHER) {
            if (has_next) { PG8_GOFF(nxt, 0, gn00, gn01); PG8_GOFF(nxt, 1, gn10, gn11); }
            else { gn00 = gc00; gn01 = gc01; gn10 = gc10; gn11 = gc11; }
        }
        const int ntu = S.ktiles(cur, nt);
#pragma nounroll
        for (int t = 0; t < ntu; t += 2) {
            const bool last = (t == ntu - 2);
            const char* a1 = cA + (size_t)(t + 1) * kstep;
            const char* a2 = last ? nA : cA + (size_t)(t + 2) * kstep; const char* b2 = last ? nB : cB + (size_t)(t + 2) * kstep;
            const char* a3 = a2 + kstep; const char* b3 = b2 + kstep;
            const unsigned g00 = last ? gn00 : gc00, g01 = last ? gn01 : gc01, g10 = last ? gn10 : gc10, g11 = last ? gn11 : gc11;
            PG8_LDB(B0, 0, 0); PG8_LDB(B1, 0, 1); PG8_SCHED; PG8_LDA(At, 0, 0); PG8_STA(PG8_SA(1, 1), a1, 1, gc10, gc11);
            PG8_WAIT_V(8); PG8_WAIT_L(0); PG8_BAR; PG8_MMA(0, 0, At, B0); PG8_MMA(0, 1, At, B1); PG8_BAR; PG8_SCHED;
            PG8_LDA(At, 0, 1); PG8_STB(PG8_SB(0, 0), b2); PG8_STB(PG8_SB(0, 1), b2 + hstepB); PG8_STA(PG8_SA(0, 0), a2, 0, g00, g01);
            PG8_WAIT_V(8); PG8_WAIT_L(0); PG8_BAR; PG8_MMA(1, 0, At, B0); PG8_MMA(1, 1, At, B1); PG8_BAR; PG8_SCHED;
            PG8_LDB(B0, 1, 0); PG8_LDB(B1, 1, 1); PG8_SCHED; PG8_LDA(At, 1, 0); PG8_STA(PG8_SA(0, 1), a2, 1, g10, g11);
            PG8_WAIT_V(8); PG8_WAIT_L(0); PG8_BAR; PG8_MMA(0, 0, At, B0); PG8_MMA(0, 1, At, B1); PG8_BAR; PG8_SCHED;
            PG8_LDA(At, 1, 1); PG8_STB(PG8_SB(1, 0), b3); PG8_STB(PG8_SB(1, 1), b3 + hstepB); PG8_STA(PG8_SA(1, 0), a3, 0, g00, g01);
            PG8_WAIT_V(8); PG8_WAIT_L(0); PG8_BAR; PG8_MMA(1, 0, At, B0); PG8_MMA(1, 1, At, B1); PG8_BAR; PG8_SCHED;
            if constexpr (SEGSCALE) {
                if (t == 6 || t == 10) {
                    unsigned ones_ = ~0u; asm volatile("" : "+s"(ones_)); const int fr_ = (int)__builtin_amdgcn_mbcnt_hi(ones_, __builtin_amdgcn_mbcnt_lo(ones_, 0u)) & 15;
                    const LAS float* fp = (const LAS float*)(lds + STAGE_BYTES + 1024) + (wr * 64 + fr_) * 2 + (t == 10 ? 1 : 0);
#pragma unroll
                    for (int ai = 0; ai < 2; ++ai)
#pragma unroll
                        for (int m = 0; m < 4; ++m) { const float f = fp[(ai * 128 + m * 16) * 2];
#pragma unroll
                            for (int bj = 0; bj < 2; ++bj)
#pragma unroll
                                for (int n = 0; n < 2; ++n) acc[ai][bj][m][n] *= f; }
                    PG8_SCHED;
                }
            }
        }
        if (wr == 0) PG8_BAR;
        { unsigned ones_ = ~0u; asm volatile("" : "+s"(ones_)); const int l_ = (int)__builtin_amdgcn_mbcnt_hi(ones_, __builtin_amdgcn_mbcnt_lo(ones_, 0u)); E(acc, cur, wr, wc, l_ & 15, l_ >> 4); }
        if (!has_next) break;
#pragma unroll
        for (int a = 0; a < 2; ++a)
#pragma unroll
            for (int b = 0; b < 2; ++b)
#pragma unroll
                for (int m = 0; m < 4; ++m)
#pragma unroll
                    for (int n = 0; n < 2; ++n) acc[a][b][m][n] = (f32x4){0.f, 0.f, 0.f, 0.f};
        cur = nxt; cA = nA; cB = nB; ++ui;
        if constexpr (GATHER) { gc00 = gn00; gc01 = gn01; gc10 = gn10; gc11 = gn11; }
        if (wr == 1) PG8_BAR;
    }
    PG8_WAIT_V(0);
    PG8_BAR;
#undef PG8_GOFF
#undef PG8_SA
#undef PG8_SB
#undef PG8_STAGE
#undef PG8_STB
#undef PG8_STA
#undef PG8_LDA
#undef PG8_LDB
#undef PG8_MMA
#undef PG8_WAIT_V
#undef PG8_WAIT_L
#undef PG8_BAR
#undef PG8_SCHED
}
}

#define EPI_ROWS_BEGIN _Pragma("unroll") for (int ai = 0; ai < 2; ++ai) _Pragma("unroll") for (int m = 0; m < 4; ++m) { const unsigned row = (unsigned)(u.pm * 256 + ai * 128 + wr * 64 + m * 16 + fr);
#define EPI_ROWS_END asm volatile("" ::: "memory"); }
__device__ __forceinline__ void st16(void* base, unsigned off, u32x4 v) { *(u32x4*)((char*)base + off) = v; }
struct EpiInProj {
    static constexpr bool PERM = true;
    bf16* CQ; bf16* CKV; bf16* KRC; float* FL; bf16* FQ; bf16* CI; float* RSQ; const float* COS; const float* SIN;
    __device__ __forceinline__ void operator()(const f32x4 (&acc)[2][2][4][2], const pg8::Unit& u, int wr, int wc, int fr, int fq) const {
        const int t = u.pn; const unsigned c8 = (unsigned)(wc * 32 + 8 * fq);
        if (t != 1) {
            bf16* base; unsigned ld;
            if (t >= 5) {
                bf16* hb = CI + (t - 5) * 128;
                EPI_ROWS_BEGIN
                    f32x4 a0 = acc[ai][0][m][0], a1 = acc[ai][0][m][1]; const f32x4 g0 = acc[ai][1][m][0], g1 = acc[ai][1][m][1];
#pragma unroll
                    for (int j = 0; j < 4; ++j) { a0[j] *= sigmoidf_(g0[j]); a1[j] *= sigmoidf_(g1[j]); }
                    st16(hb, (row * 256u + c8) * 2u, pack8(a0, a1));
                EPI_ROWS_END
                return;
            }
            if (t == 0) { base = CQ; ld = 256; } else { base = FQ + (size_t)(t - 2) * M * 256; ld = 256; }
            EPI_ROWS_BEGIN
                const unsigned off = (row * ld + c8) * 2u;
                st16(base, off, pack8(acc[ai][0][m][0], acc[ai][0][m][1]));
                st16(base, off + 256u, pack8(acc[ai][1][m][0], acc[ai][1][m][1]));
                if (t == 0) {
                    const f32x4 a = acc[ai][0][m][0], b = acc[ai][0][m][1], c = acc[ai][1][m][0], d = acc[ai][1][m][1];
                    float ss = ((a[0] * a[0] + a[1] * a[1]) + (a[2] * a[2] + a[3] * a[3])) + ((b[0] * b[0] + b[1] * b[1]) + (b[2] * b[2] + b[3] * b[3]))
                             + ((c[0] * c[0] + c[1] * c[1]) + (c[2] * c[2] + c[3] * c[3])) + ((d[0] * d[0] + d[1] * d[1]) + (d[2] * d[2] + d[3] * d[3]));
                    ss += lane_xor<16>(ss); ss += lane_xor<32>(ss);
                    if (fq == 0) *(float*)((char*)RSQ + (row * 8u + (unsigned)wc) * 4u) = ss;
                }
            EPI_ROWS_END
        } else {
            EPI_ROWS_BEGIN
                const unsigned off = (row * 256u + c8) * 2u;
                st16(CKV, off, pack8(acc[ai][0][m][0], acc[ai][0][m][1]));
                { const f32x4 a = acc[ai][0][m][0], b = acc[ai][0][m][1];
                  float ss = ((a[0] * a[0] + a[1] * a[1]) + (a[2] * a[2] + a[3] * a[3])) + ((b[0] * b[0] + b[1] * b[1]) + (b[2] * b[2] + b[3] * b[3]));
                  ss += lane_xor<16>(ss); ss += lane_xor<32>(ss);
                  if (fq == 0) *(float*)((char*)RSQ + (row * 8u + 4u + (unsigned)wc) * 4u) = ss; }
                if (c8 < 32) {
                    const unsigned to = (row * 16u + (c8 >> 1)) * 4u;
                    const f32x4 c = *(const f32x4*)((const char*)COS + to), s = *(const f32x4*)((const char*)SIN + to), a = acc[ai][1][m][0], b = acc[ai][1][m][1];
                    const f32x4 v0 = (f32x4){a[0] * c[0] - a[2] * s[0], a[1] * c[1] - a[3] * s[1], a[0] * s[0] + a[2] * c[0], a[1] * s[1] + a[3] * c[1]};
                    const f32x4 v1 = (f32x4){b[0] * c[2] - b[2] * s[2], b[1] * c[3] - b[3] * s[3], b[0] * s[2] + b[2] * c[2], b[1] * s[3] + b[3] * c[3]};
                    st16(KRC, (row * 32u + c8) * 2u, pack8(v0, v1));
                }
                else if (c8 == 32) { *(f32x4*)((char*)FL + row * 16u) = acc[ai][1][m][0]; }
            EPI_ROWS_END
        }
    }
};
struct EpiQKV {
    static constexpr bool PERM = true;
    bf16* QM; bf16* KM; bf16* VM; const float* COS; const float* SIN; const float* RSQ;
    __device__ __forceinline__ void operator()(const f32x4 (&acc)[2][2][4][2], const pg8::Unit& u, int wr, int wc, int fr, int fq) const {
        const int t = u.pn; const unsigned c8 = (unsigned)(wc * 32 + 8 * fq);
        float rf[8];
#pragma unroll
        for (int i = 0; i < 8; ++i) { const unsigned row = (unsigned)(u.pm * 256 + (i >> 2) * 128 + wr * 64 + (i & 3) * 16 + fr);
            const f32x4 p = *(const f32x4*)((const char*)RSQ + (row * 8u + (t < 3 ? 0u : 4u)) * 4u); rf[i] = (p[0] + p[1]) + (p[2] + p[3]); }
#pragma unroll
        for (int i = 0; i < 8; ++i) rf[i] = 1.0f / sqrtf(rf[i] * (t < 3 ? 1.0f / 256 : 1.0f / 128) + EPS);
        if (t < 3) {
#pragma unroll
            for (int bj = 0; bj < 2; ++bj) {
                const unsigned col = (unsigned)(t * 256 + bj * 128) + c8, h = col / 96u, d = col - h * 96u;
                const bool rope = d >= 64; const unsigned f4 = rope ? ((d - 64) >> 1) : 0u;
#pragma unroll
                for (int ai = 0; ai < 2; ++ai) {
                    f32x4 cc[4], ss[4];
                    if (rope) {
#pragma unroll
                        for (int m = 0; m < 4; ++m) { const unsigned to = ((unsigned)(u.pm * 256 + ai * 128 + wr * 64 + m * 16 + fr) * 16u + f4) * 4u;
                            cc[m] = *(const f32x4*)((const char*)COS + to); ss[m] = *(const f32x4*)((const char*)SIN + to); }
                    }
#pragma unroll
                    for (int m = 0; m < 4; ++m) { const unsigned row = (unsigned)(u.pm * 256 + ai * 128 + wr * 64 + m * 16 + fr);
                        f32x4 v0 = acc[ai][bj][m][0] * rf[ai * 4 + m], v1 = acc[ai][bj][m][1] * rf[ai * 4 + m];
                        if (rope) {
                            const f32x4 c = cc[m], s = ss[m], a = v0, b = v1;
                            v0 = (f32x4){a[0] * c[0] - a[2] * s[0], a[1] * c[1] - a[3] * s[1], a[0] * s[0] + a[2] * c[0], a[1] * s[1] + a[3] * c[1]};
                            v1 = (f32x4){b[0] * c[2] - b[2] * s[2], b[1] * c[3] - b[3] * s[3], b[0] * s[2] + b[2] * c[2], b[1] * s[3] + b[3] * c[3]};
                        }
                        st16(QM, (row * 768u + col) * 2u, pack8(v0, v1));
                    }
                    asm volatile("" ::: "memory");
                }
            }
        } else if (t < 5) {
#pragma unroll
            for (int bj = 0; bj < 2; ++bj) {
                const unsigned kc = (unsigned)((t - 3) * 256 + bj * 128) + c8, h = kc >> 6, d = kc & 63;
                EPI_ROWS_BEGIN
                    st16(KM, (row * 768u + h * 96u + d) * 2u, pack8(acc[ai][bj][m][0] * rf[ai * 4 + m], acc[ai][bj][m][1] * rf[ai * 4 + m]));
                EPI_ROWS_END
            }
        } else {
#pragma unroll
            for (int bj = 0; bj < 2; ++bj) {
                const unsigned vc = (unsigned)((t - 5) * 256 + bj * 128) + c8;
                EPI_ROWS_BEGIN
                    st16(VM, (row * 512u + vc) * 2u, pack8(acc[ai][bj][m][0] * rf[ai * 4 + m], acc[ai][bj][m][1] * rf[ai * 4 + m]));
                EPI_ROWS_END
            }
        }
    }
};
template <int LDC, bool SCALE>
struct EpiBf16 {
    static constexpr bool PERM = true;
    bf16* O; int ntn; const float* rowscale;
    __device__ __forceinline__ void operator()(const f32x4 (&acc)[2][2][4][2], const pg8::Unit& u, int wr, int wc, int fr, int fq) const {
        const unsigned col = (unsigned)((u.pn % ntn) * 256 + wc * 32 + 8 * fq);
        float sc8[8];
        if constexpr (SCALE) {
#pragma unroll
            for (int i = 0; i < 8; ++i) sc8[i] = *(const float*)((const char*)rowscale + (unsigned)(u.pm * 256 + (i >> 2) * 128 + wr * 64 + (i & 3) * 16 + fr) * 4u);
        }
        EPI_ROWS_BEGIN
            float s = 1.0f; if constexpr (SCALE) s = sc8[ai * 4 + m];
            const unsigned off = (row * (unsigned)LDC + col) * 2u;
            st16(O, off, pack8(acc[ai][0][m][0] * s, acc[ai][0][m][1] * s));
            st16(O, off + 256u, pack8(acc[ai][1][m][0] * s, acc[ai][1][m][1] * s));
        EPI_ROWS_END
    }
};
template <int LDH>
struct EpiSwiGLU {
    static constexpr bool PERM = true;
    bf16* H; int ntn;
    __device__ __forceinline__ void operator()(const f32x4 (&acc)[2][2][4][2], const pg8::Unit& u, int wr, int wc, int fr, int fq) const {
        const unsigned col = (unsigned)((u.pn % ntn) * 128 + wc * 32 + 8 * fq);
        EPI_ROWS_BEGIN
            f32x4 a0 = acc[ai][0][m][0], a1 = acc[ai][0][m][1]; const f32x4 b0 = acc[ai][1][m][0], b1 = acc[ai][1][m][1];
#pragma unroll
            for (int j = 0; j < 4; ++j) { a0[j] = siluf_(a0[j]) * b0[j]; a1[j] = siluf_(a1[j]) * b1[j]; }
            st16(H, (row * (unsigned)LDH + col) * 2u, pack8(a0, a1));
        EPI_ROWS_END
    }
};
struct MoeOrder {
    const bf16* A; const bf16* Bt; int lda, ldb, nM, nN, G, c, rep; const int* slot_tok; int s1, s2, s3, s4, s5, s6, s7;
    __device__ __forceinline__ int expert_of(int rt) const { const int r = rt * 256; return (r >= s1) + (r >= s2) + (r >= s3) + (r >= s4) + (r >= s5) + (r >= s6) + (r >= s7); }
    __device__ __forceinline__ bool next(int i, pg8::Unit& u) const { int pm, pn; if (!pg8::tile_order_rep(i, G, c, nM, nN, rep, pm, pn)) return false; u.pm = pm; u.pn = expert_of(pm) * nN + pn; return true; }
    __device__ __forceinline__ const char* a_base(const pg8::Unit& u) const { return slot_tok ? (const char*)A : (const char*)A + (size_t)u.pm * 256 * lda * 2; }
    __device__ __forceinline__ const char* b_base(const pg8::Unit& u) const { return (const char*)Bt + (size_t)u.pn * 256 * ldb * 2; }
    __device__ __forceinline__ int tok(const pg8::Unit& u, int r) const { return slot_tok[u.pm * 256 + r]; }
    __device__ __forceinline__ int ktiles(const pg8::Unit&, int nt) const { return nt; }
};

template <int NN>
struct MoeIdxOrder {
    const bf16* A; const bf16* Bt; int lda, ldb, first, stride, end; const int* slot_tok; int s1, s2, s3, s4, s5, s6, s7;
    __device__ __forceinline__ int expert_of(int rt) const { const int r = rt * 256; return (r >= s1) + (r >= s2) + (r >= s3) + (r >= s4) + (r >= s5) + (r >= s6) + (r >= s7); }
    __device__ __forceinline__ bool next(int i, pg8::Unit& u) const { const int idx = first + i * stride; if (idx >= end) return false; const int pm = idx / NN; u.pm = pm; u.pn = expert_of(pm) * NN + (idx - pm * NN); return true; }
    __device__ __forceinline__ const char* a_base(const pg8::Unit& u) const { return slot_tok ? (const char*)A : (const char*)A + (size_t)u.pm * 256 * lda * 2; }
    __device__ __forceinline__ const char* b_base(const pg8::Unit& u) const { return (const char*)Bt + (size_t)u.pn * 256 * ldb * 2; }
    __device__ __forceinline__ int tok(const pg8::Unit& u, int r) const { return slot_tok[u.pm * 256 + r]; }
    __device__ __forceinline__ int ktiles(const pg8::Unit&, int nt) const { return nt; }
};

namespace att {
__device__ __forceinline__ int crow(int r, int hi) { return (r & 3) + 8 * (r >> 2) + 4 * hi; }
__device__ __forceinline__ s16x4 vtr(const LAS unsigned char* p) { typedef short v4i16_t __attribute__((ext_vector_type(4))); return __builtin_bit_cast(s16x4, __builtin_amdgcn_ds_read_tr16_b64_v4i16((LAS v4i16_t*)p)); }
#define ATT_WAITBAR() asm volatile("s_waitcnt vmcnt(0) lgkmcnt(0)\n\ts_barrier" ::: "memory")
__device__ __forceinline__ void glds16(const void* gsrc, unsigned lds_dst) { unsigned keep;
    asm volatile("s_mov_b32 %0, m0\n\ts_mov_b32 m0, %2\n\ts_nop 0\n\tglobal_load_lds_dwordx4 %1, off\n\ts_mov_b32 m0, %0" : "=&s"(keep) : "v"(gsrc), "s"(lds_dst) : "memory"); }

#define MX3(a, b, c) __builtin_fmaxf(__builtin_fmaxf((a), (b)), (c))
template <int DQK> struct AttLds { static constexpr int NCH = DQK / 8, KSLOT = NCH * 1024, ND0 = DQK / 16, LK = 0, LV = 3 * KSLOT, LOST = LV + 3 * 8192, LCUM = LOST + NWAVES * 4608, END = LCUM + SEQ * 4; };

template <int DQK>
__device__ __forceinline__ void att_qk(f32x16& n0, f32x16& n1, const bf16x8 (&qr)[DQK / 16], const LAS unsigned char* kp) {
    constexpr int ND0 = DQK / 16;
    bf16x8 kf[2 * ND0];
#pragma unroll
    for (int d0 = 0; d0 < ND0; ++d0) { kf[2 * d0] = *(const LAS bf16x8*)(kp + d0 * 2048); kf[2 * d0 + 1] = *(const LAS bf16x8*)(kp + d0 * 2048 + 512); }
    n0 = (f32x16){}; n1 = (f32x16){};
#pragma unroll
    for (int d0 = 0; d0 < ND0; ++d0) {
        n0 = __builtin_amdgcn_mfma_f32_32x32x16_bf16(kf[2 * d0], qr[d0], n0, 0, 0, 0);
        n1 = __builtin_amdgcn_mfma_f32_32x32x16_bf16(kf[2 * d0 + 1], qr[d0], n1, 0, 0, 0);
    }
}
template <bool BIAS, bool MASK>
__device__ __forceinline__ void att_bias_mask(f32x16& n0, f32x16& n1, int t, int NT, int qrel, int hi, float fqb, const LAS float* cumL) {
    if constexpr (BIAS) {
#pragma unroll
        for (int g = 0; g < 4; ++g) {
            const f32x4 f0 = *(const LAS f32x4*)(cumL + t * 64 + 8 * g + 4 * hi), f1 = *(const LAS f32x4*)(cumL + t * 64 + 32 + 8 * g + 4 * hi);
#pragma unroll
            for (int j = 0; j < 4; ++j) { n0[4 * g + j] += fqb - f0[j]; n1[4 * g + j] += fqb - f1[j]; }
        }
    }
    if constexpr (MASK) {
        const int kb = 64 * (t - (NT - 4)) + 4 * hi;
#pragma unroll
        for (int r = 0; r < 16; ++r) { const int kv = kb + (r & 3) + 8 * (r >> 2); if (kv > qrel) n0[r] = -INFINITY; if (kv + 32 > qrel) n1[r] = -INFINITY; }
    }
}
template <int DQK, bool BIAS, bool MASK, bool MORE>
__device__ __forceinline__ void att_step(f32x16& s0, f32x16& s1, f32x16& n0, f32x16& n1, f32x16& o0, f32x16& o1, float& mrow, float& lrow, const bf16x8 (&qr)[DQK / 16],
                                         int t, int NT, int qrel, int lane, int hi, int r32, float fqb, const LAS unsigned char* shm, int vslot, int kslot) {
    typedef AttLds<DQK> L;
    constexpr int ND0 = DQK / 16;
    const LAS unsigned char* vp = shm + L::LV + vslot * 8192 + ((lane >> 4) & 1) * 32 + (lane & 3) * 8 + (4 * hi + ((lane & 15) >> 2)) * 64;
    const LAS unsigned char* kp = shm + L::LK + kslot * L::KSLOT + hi * 1024 + r32 * 16;
    bf16x8 kf[2 * ND0];
    if constexpr (MORE) {
#pragma unroll
        for (int d0 = 0; d0 < ND0; ++d0) { kf[2 * d0] = *(const LAS bf16x8*)(kp + d0 * 2048); kf[2 * d0 + 1] = *(const LAS bf16x8*)(kp + d0 * 2048 + 512); }
    }
    float a = MX3(s0[0], s0[1], s1[0]), b = MX3(s0[2], s0[3], s1[1]); a = MX3(a, s1[2], s1[3]);
#pragma unroll
    for (int r = 4; r < 16; r += 4) { a = MX3(a, s0[r], s0[r + 1]); b = MX3(b, s0[r + 2], s0[r + 3]); a = MX3(a, s1[r], s1[r + 1]); b = MX3(b, s1[r + 2], s1[r + 3]); }
    float rm = __builtin_fmaxf(a, b);
    { auto rr = __builtin_amdgcn_permlane32_swap(__float_as_uint(rm), __float_as_uint(rm), false, false); rm = __builtin_fmaxf(__uint_as_float(rr[0]), __uint_as_float(rr[1])); }
    if (__builtin_amdgcn_ballot_w64(rm > mrow + 8.0f) != 0ull) {
        const float mnew = __builtin_fmaxf(mrow, rm), alpha = fexp2(mrow - mnew);
        mrow = mnew; lrow *= alpha;
#pragma unroll
        for (int r = 0; r < 16; ++r) { o0[r] *= alpha; o1[r] *= alpha; }
    }
    if constexpr (MORE) {
        n0 = (f32x16){}; n1 = (f32x16){};
#pragma unroll
        for (int d0 = 0; d0 < ND0; ++d0) {
            n0 = __builtin_amdgcn_mfma_f32_32x32x16_bf16(kf[2 * d0], qr[d0], n0, 0, 0, 0);
            n1 = __builtin_amdgcn_mfma_f32_32x32x16_bf16(kf[2 * d0 + 1], qr[d0], n1, 0, 0, 0);
        }
    }
    float ps = 0.f;
#pragma unroll
    for (int r = 0; r < 16; ++r) { s0[r] = fexp2(s0[r] - mrow); s1[r] = fexp2(s1[r] - mrow); ps += s0[r] + s1[r]; }
    lrow += ps;
    __builtin_amdgcn_sched_barrier(0);
    s16x4 vl[8], vh[8];
#pragma unroll
    for (int i = 0; i < 8; ++i) { vl[i] = vtr(vp + (i >> 2) * 4096 + (i & 3) * 1024); vh[i] = vtr(vp + (i >> 2) * 4096 + (i & 3) * 1024 + 512); }
    u32x4 pw[4];
    pw[0] = (u32x4){pk2(s0[0], s0[1]), pk2(s0[2], s0[3]), pk2(s0[4], s0[5]), pk2(s0[6], s0[7])};
    pw[1] = (u32x4){pk2(s0[8], s0[9]), pk2(s0[10], s0[11]), pk2(s0[12], s0[13]), pk2(s0[14], s0[15])};
    pw[2] = (u32x4){pk2(s1[0], s1[1]), pk2(s1[2], s1[3]), pk2(s1[4], s1[5]), pk2(s1[6], s1[7])};
    pw[3] = (u32x4){pk2(s1[8], s1[9]), pk2(s1[10], s1[11]), pk2(s1[12], s1[13]), pk2(s1[14], s1[15])};
#pragma unroll
    for (int ks = 0; ks < 4; ++ks) {
        const bf16x8 v0 = (bf16x8){vl[ks][0], vl[ks][1], vl[ks][2], vl[ks][3], vh[ks][0], vh[ks][1], vh[ks][2], vh[ks][3]};
        const bf16x8 v1 = (bf16x8){vl[4 + ks][0], vl[4 + ks][1], vl[4 + ks][2], vl[4 + ks][3], vh[4 + ks][0], vh[4 + ks][1], vh[4 + ks][2], vh[4 + ks][3]};
        o0 = __builtin_amdgcn_mfma_f32_32x32x16_bf16(v0, __builtin_bit_cast(bf16x8, pw[ks]), o0, 0, 0, 0);
        o1 = __builtin_amdgcn_mfma_f32_32x32x16_bf16(v1, __builtin_bit_cast(bf16x8, pw[ks]), o1, 0, 0, 0);
    }
    if constexpr (MORE) att_bias_mask<BIAS, MASK>(n0, n1, t + 1, NT, qrel, hi, fqb, (const LAS float*)(shm + L::LCUM));
}

template <int DQK, bool BIAS>
__device__ __forceinline__ void attn_unit(int b, int h, int qb, const bf16* Q, int pq, const bf16* K, int pk, const bf16* V, int pv,
                                          bf16* O, int po, int ocol, const float* cum, LAS unsigned char* shm, const int tid_in, float* ssqp, int hidx, const unsigned* qkmax, const bf16* KRC = nullptr) {
    int tid = tid_in; asm volatile("" : "+v"(tid));
    typedef AttLds<DQK> L;
    constexpr int NCH = L::NCH, KSLOT = L::KSLOT, ND0 = L::ND0, LK = L::LK, LV = L::LV, LOST = L::LOST;
    static_assert(L::END <= RING_BYTES, "attention LDS");
    const int lane = tid & 63, r32 = lane & 31, hi = lane >> 5; const int wid = __builtin_amdgcn_readfirstlane(tid >> 6);
    const long rowbase = (long)b * SEQ; const int q0 = qb * 256;
    const bf16* Qw = Q + (rowbase + q0 + wid * 32) * pq + h * DQK;
    const bf16* Kh = K + rowbase * pk + h * DQK; const bf16* Vh = V + rowbase * pv + h * 64;
    const int NT = (q0 + 256) / 64;
    LAS float* cumL = (LAS float*)(shm + L::LCUM);
    if constexpr (BIAS) { const float* cs = cum + (size_t)(b * 4 + h) * SEQ; for (int i = tid * 4; i < q0 + 256; i += NTHR * 4) *(LAS f32x4*)(cumL + i) = *(const f32x4*)(cs + i); }
    const bf16* ksrc = Kh + (long)lane * pk + wid * 8;
    const bf16* krsrc = KRC + (rowbase + lane) * 32 + (wid & 3) * 8;
    const bf16* vsrc = Vh + (long)(16 * (wid & 3) + (lane >> 2)) * pv + (wid >> 2) * 32 + (lane & 3) * 8;
    const unsigned lds0 = (unsigned)(size_t)shm;
#define ATT_DMA_K(t, slot) do { \
        glds16(ksrc + (long)(t) * 64 * pk, (unsigned)__builtin_amdgcn_readfirstlane((int)(lds0 + LK + (slot) * KSLOT + wid * 1024))); \
        if (NCH > 8 && wid + 8 < NCH) glds16(krsrc + (long)(t) * 64 * 32, (unsigned)__builtin_amdgcn_readfirstlane((int)(lds0 + LK + (slot) * KSLOT + (wid + 8) * 1024))); } while (0)
#define ATT_DMA_V(t, slot) glds16(vsrc + (long)(t) * 64 * pv, (unsigned)__builtin_amdgcn_readfirstlane((int)(lds0 + LV + (slot) * 8192 + wid * 1024)))
    const int nK = (NCH > 8 && wid + 8 < NCH) ? 2 : 1;
#define ATT_WAITBAR_N(n) do { const int n_ = (n); if (n_ == 0) asm volatile("s_waitcnt vmcnt(0) lgkmcnt(0)\n\ts_barrier" ::: "memory"); else if (n_ == 1) asm volatile("s_waitcnt vmcnt(1) lgkmcnt(0)\n\ts_barrier" ::: "memory"); \
        else if (n_ == 2) asm volatile("s_waitcnt vmcnt(2) lgkmcnt(0)\n\ts_barrier" ::: "memory"); else asm volatile("s_waitcnt vmcnt(3) lgkmcnt(0)\n\ts_barrier" ::: "memory"); } while (0)
    int tb = 0;
    if constexpr (BIAS) {
        const float qk = sqrtf(__uint_as_float(qkmax[0]) * __uint_as_float(qkmax[1])) * 1.01f + 1.0f, thr = -(150.0f + 2.0f * qk);
        const float* cs = cum + (size_t)(b * 4 + h) * SEQ; const float f0 = cs[q0]; const float fj = lane < NT ? cs[64 * lane + 63] : f0;
        const unsigned long long keep = __builtin_amdgcn_ballot_w64(lane < NT && (f0 - fj) >= thr);
        tb = keep ? (int)__builtin_ctzll(keep) : NT - 4; if (tb > NT - 4) tb = NT - 4;
        tb = __builtin_amdgcn_readfirstlane(tb);
    }
    ATT_DMA_K(tb, 0); ATT_DMA_V(tb, 0); ATT_DMA_K(tb + 1, 1);
    bf16x8 qr[ND0];
#pragma unroll
    for (int d0 = 0; d0 < ND0; ++d0) qr[d0] = *(const bf16x8*)(Qw + (long)r32 * pq + d0 * 16 + hi * 8);
    float mrow = -1e30f, lrow = 0.f; f32x16 o0 = {}, o1 = {};
    const int qrel = wid * 32 + r32;
    ATT_WAITBAR();
#pragma unroll
    for (int d0 = 0; d0 < ND0; ++d0) asm volatile("" : "+v"(qr[d0]));
    ATT_DMA_K(tb + 2, 2); ATT_DMA_V(tb + 1, 1);
    float fqb = 0.f; if constexpr (BIAS) fqb = cumL[q0 + qrel];
    f32x16 s0, s1;
    att_qk<DQK>(s0, s1, qr, shm + LK + hi * 1024 + r32 * 16);
    asm volatile("s_waitcnt lgkmcnt(0)\n\ts_barrier" ::: "memory");
    if (tb == NT - 4) att_bias_mask<BIAS, true>(s0, s1, tb, NT, qrel, hi, fqb, cumL); else att_bias_mask<BIAS, false>(s0, s1, tb, NT, qrel, hi, fqb, cumL);
    int t = tb, sl0 = 0, sl1 = 1, sl2 = 2;
#define ATT_ROT() do { const int x_ = sl0; sl0 = sl1; sl1 = sl2; sl2 = x_; } while (0)
    f32x16 u0, u1;
    for (; t + 1 < NT - 5; t += 2) {
        ATT_DMA_K(t + 3, sl0); ATT_DMA_V(t + 2, sl2);
        att_step<DQK, BIAS, false, true>(s0, s1, u0, u1, o0, o1, mrow, lrow, qr, t, NT, qrel, lane, hi, r32, fqb, shm, sl0, sl1);
        ATT_WAITBAR_N(nK + 1); ATT_ROT();
        ATT_DMA_K(t + 4, sl0); ATT_DMA_V(t + 3, sl2);
        att_step<DQK, BIAS, false, true>(u0, u1, s0, s1, o0, o1, mrow, lrow, qr, t + 1, NT, qrel, lane, hi, r32, fqb, shm, sl0, sl1);
        ATT_WAITBAR_N(nK + 1); ATT_ROT();
    }
    for (; t < NT - 5; ++t) {
        ATT_DMA_K(t + 3, sl0); ATT_DMA_V(t + 2, sl2);
        att_step<DQK, BIAS, false, true>(s0, s1, u0, u1, o0, o1, mrow, lrow, qr, t, NT, qrel, lane, hi, r32, fqb, shm, sl0, sl1);
        s0 = u0; s1 = u1;
        ATT_WAITBAR_N(nK + 1); ATT_ROT();
    }
    for (; t < NT - 1; ++t) {
        int nis = 0;
        if (t + 3 < NT) { ATT_DMA_K(t + 3, sl0); nis += nK; }
        if (t + 2 < NT) { ATT_DMA_V(t + 2, sl2); nis += 1; }
        const int jbc = t - (NT - 4); const bool docur = !(jbc >= 0 && 2 * jbc > wid), donext = !(2 * (jbc + 1) > wid);
        if (docur && donext) { att_step<DQK, BIAS, true, true>(s0, s1, u0, u1, o0, o1, mrow, lrow, qr, t, NT, qrel, lane, hi, r32, fqb, shm, sl0, sl1); s0 = u0; s1 = u1; }
        else if (docur) att_step<DQK, BIAS, false, false>(s0, s1, u0, u1, o0, o1, mrow, lrow, qr, t, NT, qrel, lane, hi, r32, fqb, shm, sl0, sl1);
        ATT_WAITBAR_N(nis); ATT_ROT();
    }
    if (!(2 * 3 > wid)) att_step<DQK, BIAS, false, false>(s0, s1, u0, u1, o0, o1, mrow, lrow, qr, t, NT, qrel, lane, hi, r32, fqb, shm, sl0, sl1);
#undef ATT_ROT
#undef ATT_WAITBAR_N
    { auto rr = __builtin_amdgcn_permlane32_swap(__float_as_uint(lrow), __float_as_uint(lrow), false, false); lrow = __uint_as_float(rr[0]) + __uint_as_float(rr[1]); }
    const float rl = frcp(lrow);
    { float ssq = 0.f;
#pragma unroll
      for (int r = 0; r < 16; ++r) { const float a = o0[r] * rl, b2 = o1[r] * rl; ssq += a * a + b2 * b2; }
      auto rr = __builtin_amdgcn_permlane32_swap(__float_as_uint(ssq), __float_as_uint(ssq), false, false); ssq = __uint_as_float(rr[0]) + __uint_as_float(rr[1]);
      if (hi == 0) ssqp[(size_t)(rowbase + q0 + wid * 32 + r32) * 12 + hidx] = ssq; }
    LAS unsigned char* stg = shm + LOST + wid * 4608;
#pragma unroll
    for (int g = 0; g < 4; ++g) {
        *(LAS u32x2*)(stg + r32 * 144 + (8 * g + 4 * hi) * 2) = (u32x2){pk2(o0[4 * g] * rl, o0[4 * g + 1] * rl), pk2(o0[4 * g + 2] * rl, o0[4 * g + 3] * rl)};
        *(LAS u32x2*)(stg + r32 * 144 + (32 + 8 * g + 4 * hi) * 2) = (u32x2){pk2(o1[4 * g] * rl, o1[4 * g + 1] * rl), pk2(o1[4 * g + 2] * rl, o1[4 * g + 3] * rl)};
    }
    asm volatile("s_waitcnt lgkmcnt(0)" ::: "memory");
    bf16* Ow = O + (rowbase + q0 + wid * 32) * po + ocol;
#pragma unroll
    for (int i = 0; i < 4; ++i) { const int row = i * 8 + (lane >> 3), ch = lane & 7; const u32x4 v = *(const LAS u32x4*)(stg + row * 144 + ch * 16); *(u32x4*)(Ow + (long)row * po + ch * 8) = v; }
    asm volatile("s_waitcnt lgkmcnt(0)\n\ts_barrier" ::: "memory");
#undef ATT_DMA_K
#undef ATT_DMA_V
}
}

struct Args { const float* in[26]; float* out; unsigned char* ws; int ph_lo, ph_hi; };
typedef const __attribute__((address_space(4))) Args* kargs_t;
struct Ctx {
    LAS unsigned char* lds; unsigned* ctl; unsigned char* ws; float* out;
    int tid, lane, wave, vcu, G, gw, NGW, bx;
};
__device__ __forceinline__ kargs_t opaque_args() { kargs_t p = (kargs_t)__builtin_amdgcn_kernarg_segment_ptr(); asm volatile("" : "+s"(p)); return p; }
__device__ __forceinline__ Ctx make_ctx(kargs_t A, LAS unsigned char* lds, int wave0) {
    Ctx C; unsigned ones = ~0u; asm volatile("" : "+s"(ones));
    int t = wave0 * 64 + (int)__builtin_amdgcn_mbcnt_hi(ones, __builtin_amdgcn_mbcnt_lo(ones, 0u)); asm volatile("" : "+v"(t));
    C.lds = lds; C.ws = A->ws; C.ctl = (unsigned*)(C.ws + WS_CTL); C.out = A->out;
    C.tid = t; C.lane = t & 63; C.wave = __builtin_amdgcn_readfirstlane(t >> 6);
    { int g_ = gridDim.x, b_ = blockIdx.x; asm volatile("" : "+s"(g_), "+s"(b_)); C.G = g_; C.bx = b_; } C.vcu = (C.bx % 8) * (C.G / 8) + C.bx / 8;
    C.gw = C.vcu * NWAVES + C.wave; C.NGW = C.G * NWAVES;
    return C;
}
#define LDS_WAIT() asm volatile("s_waitcnt lgkmcnt(0)" ::: "memory")

struct MapWin { __device__ __forceinline__ int row(int n) const {
        if (n < 256) return PC_CQ + n; if (n < 384) return PC_CKV + (n - 256); if (n < 416) { const int i = n - 384; return PC_KR + ((i < 16) ? (4 * (i >> 1) + (i & 1)) : (4 * ((i - 16) >> 1) + 2 + (i & 1))); }
        if (n < 928) return PC_FK + (n - 672); if (n < 1184) return PC_FV + (n - 928); if (n < 1188) return PC_FL + (n - 1184);
        { const int c = n - 1188, ch = c & 255; return PC_CI + (ch >> 7) * 256 + (c >> 8) * 128 + (ch & 127); } }
    __device__ __forceinline__ float scale(int, int n) const { return (n >= 416 && n < 672) ? C2_FOX : 1.0f; } };
struct MapUq { const float* g; __device__ __forceinline__ int row(int n) const { const int h = n / 96, d = n - h * 96; if (d < 64) return n; const int i = d - 64;
        const int s = (i < 16) ? (4 * (i >> 1) + (i & 1)) : (4 * ((i - 16) >> 1) + 2 + (i & 1)); return h * 96 + 64 + s; }
    __device__ __forceinline__ float scale(int k, int) const { return g[k] * C2_MLA; } };
struct MapUkv { const float* g; __device__ __forceinline__ int row(int n) const { const int h = n >> 7, d = n & 127; return d < 64 ? (768 + h * 64 + d) : (1280 + h * 64 + (d - 64)); }
    __device__ __forceinline__ float scale(int k, int) const { return g[k]; } };
struct MapWout { const float* gm; const float* gf; __device__ __forceinline__ int row(int n) const { return n; }
    __device__ __forceinline__ float scale(int k, int) const { return k < 512 ? gm[k] : (k < 768 ? gf[k - 512] : 1.0f); } };
struct MapW13 { int which; __device__ __forceinline__ int row(int n) const { return (n >> 7) * 256 + which * 128 + (n & 127); }
    __device__ __forceinline__ float scale(int, int) const { return 1.0f; } };
struct MapId { __device__ __forceinline__ int row(int n) const { return n; } __device__ __forceinline__ float scale(int, int) const { return 1.0f; } };

template <class Map>
__device__ __forceinline__ void transpose_item(const float* W, int Nsrc, bf16* WT, int ldk, LAS float* scr, int kb, int nb, int lane, const Map mp) {
    const int k0 = 64 * kb, n0 = 32 * nb, r8 = lane >> 3, nn = n0 + 4 * (lane & 7); const bool nok = nn < Nsrc;
    f32x4 v[8];
#pragma unroll
    for (int i = 0; i < 8; ++i) { v[i] = (f32x4){0.f, 0.f, 0.f, 0.f}; if (nok) v[i] = *(const f32x4*)(W + (size_t)(k0 + 8 * i + r8) * Nsrc + nn); }
#pragma unroll
    for (int i = 0; i < 8; ++i) { const int kk = 8 * i + r8; LAS float* d = scr + kk * 33 + 4 * (lane & 7);
#pragma unroll
        for (int j = 0; j < 4; ++j) d[j] = v[i][j] * mp.scale(k0 + kk, nn + j); }
    LDS_WAIT(); asm volatile("" ::: "memory");
    const int c = lane & 7;
#pragma unroll
    for (int j = 0; j < 4; ++j) { const int n = (lane >> 3) + 8 * j; const LAS float* s = scr + (8 * c) * 33 + n;
        if (n0 + n < Nsrc) { u32x4 o; o.x = pk2(s[0 * 33], s[1 * 33]); o.y = pk2(s[2 * 33], s[3 * 33]); o.z = pk2(s[4 * 33], s[5 * 33]); o.w = pk2(s[6 * 33], s[7 * 33]);
            *(u32x4*)(WT + (size_t)mp.row(n0 + n) * ldk + k0 + 8 * c) = o; } }
    LDS_WAIT(); asm volatile("" ::: "memory");
}

__device__ __forceinline__ void sincos_acc(float ang, float& c, float& s) {
    const double a = (double)ang, q = __builtin_rint(a * 0.63661977236758134308);
    const double y = (a - q * 1.57079632679489655800) - q * 6.12323399573676603587e-17, y2 = y * y;
    const double sp = y * (1.0 + y2 * (-1.0 / 6 + y2 * (1.0 / 120 + y2 * (-1.0 / 5040 + y2 * (1.0 / 362880 + y2 * (-1.0 / 39916800 + y2 * (1.0 / 6227020800.0)))))));
    const double cp = 1.0 + y2 * (-0.5 + y2 * (1.0 / 24 + y2 * (-1.0 / 720 + y2 * (1.0 / 40320 + y2 * (-1.0 / 3628800 + y2 * (1.0 / 479001600 + y2 * (-1.0 / 87178291200.0)))))));
    const int quad = (int)((long long)q & 3);
    const double ss = (quad == 0) ? sp : (quad == 1) ? cp : (quad == 2) ? -sp : -cp;
    const double cc = (quad == 0) ? cp : (quad == 1) ? -sp : (quad == 2) ? -cp : sp;
    c = (float)cc; s = (float)ss;
}
__device__ __forceinline__ float inv_freq(int f) {
    const int a = f >> 2, b = f & 3;
    const float p = (a == 0) ? 1.0f : (a == 1) ? 0.1f : (a == 2) ? 0.01f : 0.001f;
    const float m = (b == 0) ? 1.0f : (b == 1) ? 0.56234132519034908f : (b == 2) ? 0.31622776601683794f : 0.17782794100389228f;
    return (b == 0) ? p : (float)((double)p * (double)m);
}

__device__ __forceinline__ void p0_prologue(Ctx& C, kargs_t A) {
    LAS float* scr = (LAS float*)(C.lds + C.wave * 16384);
    bf16* WIN = (bf16*)(C.ws + WS_WIN); bf16* WQ2 = (bf16*)(C.ws + WS_WQ2); bf16* WOUT = (bf16*)(C.ws + WS_WOUT);
    constexpr int I_IN = 16 * 54, I_UQ = 4 * 24, I_UKV = 2 * 32, I_OUT = 16 * 32, I_L = I_IN + I_UQ + I_UKV + I_OUT;
    REPS(12) for (int it = C.gw; it < DEPTH * I_L; it += C.NGW) {
        const int l = it / I_L; int r = it - l * I_L;
        if (r < I_IN) { transpose_item(A->in[2] + (size_t)l * DM * IN_COLS, IN_COLS, WIN + (size_t)l * NP1 * DM, DM, scr, r / 54, r % 54, C.lane, MapWin{}); continue; } r -= I_IN;
        if (r < I_UQ) { transpose_item(A->in[4] + (size_t)l * 256 * 768, 768, WQ2 + (size_t)l * NP1 * 256, 256, scr, r / 24, r % 24, C.lane, MapUq{A->in[3] + l * 256}); continue; } r -= I_UQ;
        if (r < I_UKV) { transpose_item(A->in[6] + (size_t)l * 128 * 1024, 1024, WQ2 + (size_t)l * NP1 * 256, 256, scr, r / 32, r % 32, C.lane, MapUkv{A->in[5] + l * 128}); continue; } r -= I_UKV;
        transpose_item(A->in[14] + (size_t)l * DM * DM, DM, WOUT + (size_t)l * DM * DM, DM, scr, r / 32, r % 32, C.lane, MapWout{A->in[12] + l * 512, A->in[13] + l * 256});
    }
    const int gt = C.vcu * NTHR + C.tid, NGT = C.G * NTHR;
    for (int i = gt; i < DEPTH * 92 * 128; i += NGT) { const int l = i / (92 * 128), r = i % (92 * 128); *(u32x4*)(WIN + (size_t)l * NP1 * DM + (size_t)(420 + r / 128) * DM + (r % 128) * 8) = (u32x4){0u, 0u, 0u, 0u}; }
    REPS(4) {
    bf16* XB = (bf16*)(C.ws + WS_XB); const float* x = A->in[0];
    for (int m = C.gw; m < M; m += C.NGW) { const f32x4* xr = (const f32x4*)(x + (size_t)m * DM) + C.lane; u32x2* o = (u32x2*)(XB + (size_t)m * DM) + C.lane;
#pragma unroll
        for (int j = 0; j < 4; ++j) { const f32x4 v = xr[64 * j]; o[64 * j] = (u32x2){pk2(v[0], v[1]), pk2(v[2], v[3])}; } }
    float* COS = (float*)(C.ws + WS_TAB); float* SIN = COS + (size_t)M * 16; const int* pos = (const int*)A->in[1];
    for (int i = gt; i < M * 16; i += NGT) { const float ang = (float)pos[i >> 4] * inv_freq(i & 15); float c, s; sincos_acc(ang, c, s); COS[i] = c; SIN[i] = s; }
    }
}

__device__ __forceinline__ int ffn_split(int layer) { return (layer & 1) ? 7744 : 4224; }
__device__ __forceinline__ void ffn_weights(Ctx& C, kargs_t A, int layer, int first, int stride, int lo, int hi) {
    LAS float* scr = (LAS float*)(C.lds + C.wave * 16384);
    bf16* W13 = (bf16*)(C.ws + WS_WFFN); bf16* W2T = W13 + WF_W13_ELEMS; const int j = layer >> 1;
    if ((layer & 1) == 0) {
        constexpr int I1 = 16 * 88, I2 = 44 * 32;
        const float* w1 = A->in[17] + (size_t)j * DM * DFF; const float* w3 = A->in[18] + (size_t)j * DM * DFF; const float* w2 = A->in[19] + (size_t)j * DFF * DM;
        const int end = hi < 2 * I1 + I2 ? hi : 2 * I1 + I2;
        for (int it = lo + first; it < end; it += stride) {
            int r = it;
            if (r < I1) { transpose_item(w1, DFF, W13, DM, scr, r / 88, r % 88, C.lane, MapW13{0}); continue; } r -= I1;
            if (r < I1) { transpose_item(w3, DFF, W13, DM, scr, r / 88, r % 88, C.lane, MapW13{1}); continue; } r -= I1;
            transpose_item(w2, DM, W2T, DFF, scr, r / 32, r % 32, C.lane, MapId{});
        }
    } else {
        constexpr int I1 = 16 * 44, I2 = 22 * 32, IE = 2 * I1 + I2;
        const int end = hi < NEXP * IE ? hi : NEXP * IE;
        for (int it = lo + first; it < end; it += stride) {
            const int e = it / IE; int r = it - e * IE;
            const float* w1 = A->in[21] + ((size_t)j * NEXP + e) * DM * DFE; const float* w3 = A->in[22] + ((size_t)j * NEXP + e) * DM * DFE; const float* w2 = A->in[23] + ((size_t)j * NEXP + e) * DFE * DM;
            bf16* W13e = W13 + (size_t)e * 2 * DFE * DM; bf16* W2Te = W2T + (size_t)e * DM * DFE;
            if (r < I1) { transpose_item(w1, DFE, W13e, DM, scr, r / 44, r % 44, C.lane, MapW13{0}); continue; } r -= I1;
            if (r < I1) { transpose_item(w3, DFE, W13e, DM, scr, r / 44, r % 44, C.lane, MapW13{1}); continue; } r -= I1;
            transpose_item(w2, DM, W2Te, DFE, scr, r / 32, r % 32, C.lane, MapId{});
        }
    }
}

__device__ __forceinline__ void p2_thin(Ctx& C, kargs_t A, int layer) {
    unsigned char* sc = C.ws + WS_SCR;
    bf16* CQ = (bf16*)(sc + SC_CQKV); bf16* CKV = CQ + (size_t)M * 256; const float* KR = (const float*)(sc + SC_KR); const float* FL = (const float*)(sc + SC_FL);
    float* CUM = (float*)(sc + SC_CUM); const bf16* CI = (const bf16*)(sc + SC_CI); const bf16* FQn = (const bf16*)(sc + SC_FQ); bf16* KM = (bf16*)(sc + SC_KM); bf16* MIXED = (bf16*)(sc + SC_MIXED);
    const float* COS = (const float*)(C.ws + WS_TAB); const float* SIN = COS + (size_t)M * 16;
    LAS unsigned* NT2 = (LAS unsigned*)(C.lds + RING_BYTES + 4096);
    if (C.tid < 64) NT2[C.tid] = 0u;
    LAS unsigned* RQ = (LAS unsigned*)(C.lds + RING_BYTES + 8192 + 64);
    if (C.tid == 0) RQ[0] = 0u;
    __syncthreads();
    {
    if (C.wave == 0 && C.vcu < BATCH * 4) {
        const int sq = C.vcu, b = sq >> 2, h = sq & 3; const float bias = A->in[7][layer * 4 + h];
        float v[64]; float run = 0.f;
#pragma unroll
        for (int i = 0; i < 64; ++i) { const float z = FL[((size_t)b * SEQ + C.lane * 64 + i) * 4 + h] + bias; const float e = fexp2(-fabsf(z) * LOG2E);
            const float ls = fminf(z, 0.f) - __builtin_amdgcn_logf(1.0f + e) * 0.6931471805599453f; run += ls * LOG2E; v[i] = run; }
        float incl = run;
#pragma unroll
        for (int o = 1; o < 64; o <<= 1) { const float t = __int_as_float(__builtin_amdgcn_ds_bpermute((C.lane - o) << 2, __float_as_int(incl))); if (C.lane >= o) incl += t; }
        const float excl = incl - run; float* dst = CUM + (size_t)sq * SEQ + C.lane * 64;
#pragma unroll
        for (int i = 0; i < 64; i += 4) *(f32x4*)(dst + i) = (f32x4){v[i] + excl, v[i + 1] + excl, v[i + 2] + excl, v[i + 3] + excl};
    }
    const int rpw = M / C.G;
    for (;;) {
        unsigned jb = 0u; if (C.lane == 0) jb = __hip_atomic_fetch_add(RQ, 1u, __ATOMIC_RELAXED, __HIP_MEMORY_SCOPE_WORKGROUP);
        jb = (unsigned)__builtin_amdgcn_readfirstlane((int)jb);
        if ((int)jb * 4 >= rpw) break;
        const size_t mb = (size_t)C.vcu * rpw + 4 * jb;
        u32x2 fqv[4], fkv[4];
#pragma unroll
        for (int k = 0; k < 4; ++k) { const size_t m = mb + k;
            fqv[k] = ((const u32x2*)(FQn + m * 256))[C.lane]; fkv[k] = ((const u32x2*)(FQn + (size_t)M * 256 + m * 256))[C.lane]; }
#pragma unroll
        for (int k = 0; k < 4; ++k) { const size_t m = mb + k;
            {
              float nq = 0.f, nk = 0.f; { const float a0 = bflo(fqv[k].x), a1 = bfhi(fqv[k].x), a2 = bflo(fqv[k].y), a3 = bfhi(fqv[k].y); nq = (a0 * a0 + a1 * a1) + (a2 * a2 + a3 * a3); }
              { const float a0 = bflo(fkv[k].x), a1 = bfhi(fkv[k].x), a2 = bflo(fkv[k].y), a3 = bfhi(fkv[k].y); nk = (a0 * a0 + a1 * a1) + (a2 * a2 + a3 * a3); }
              nq += lane_xor<1>(nq); nq += lane_xor<2>(nq); nq += lane_xor<4>(nq); nq += lane_xor<8>(nq); nk += lane_xor<1>(nk); nk += lane_xor<2>(nk); nk += lane_xor<4>(nk); nk += lane_xor<8>(nk);
              if ((C.lane & 15) == 0) { const int bi = (int)(m >> 12) * 8 + (C.lane >> 4) * 2; atomicMax((unsigned*)&NT2[bi], __float_as_uint(nq)); atomicMax((unsigned*)&NT2[bi + 1], __float_as_uint(nk)); } }
        }
    }
    }
    __syncthreads();
    if (C.tid < 64) atomicMax(C.ctl + CW_QKMAX + layer * 64 + C.tid, NT2[C.tid]);
    {
        LAS float* hL = (LAS float*)C.lds; LAS float* yL = hL + 62 * 256;
        const int cch = (C.wave & 3) * 64 + C.lane, tt0 = (C.wave >> 2) * 16;
        float wj[31];
#pragma unroll
        for (int j = 0; j < 31; ++j) wj[j] = A->in[8][((size_t)layer * 31 + j) * 256 + cch];
        const float cb = A->in[9][layer * 256 + cch];
        const int ntok = C.tid >> 4, ngrp = (C.tid >> 2) & 3, nqt = C.tid & 3, nc0 = ngrp * 64 + nqt * 16;
        u32x4 pa[4];
#define CONV_LOAD(tl) do { const int t0_ = (tl) * 32, seq0_ = (t0_ / SEQ) * SEQ; _Pragma("unroll") for (int k = 0; k < 4; ++k) { const int it = C.tid + NTHR * k, r = it >> 5, ch = it & 31, tok = t0_ - 30 + r; \
            pa[k] = (u32x4){0u, 0u, 0u, 0u}; \
            if (it < 62 * 32 && tok >= seq0_) pa[k] = *(const u32x4*)(CI + (size_t)tok * 256 + ch * 8); } } while (0)
        if (C.vcu < M / 32) CONV_LOAD(C.vcu);
        for (int tile = C.vcu; tile < M / 32; tile += C.G) {
            const int t0 = tile * 32;
#pragma unroll
            for (int k = 0; k < 4; ++k) { const int it = C.tid + NTHR * k, r = it >> 5, ch = it & 31;
                if (it < 62 * 32) { const u32x4 a = pa[k];
                    *(LAS f32x4*)(hL + r * 256 + ch * 8) = (f32x4){bflo(a.x), bfhi(a.x), bflo(a.y), bfhi(a.y)}; *(LAS f32x4*)(hL + r * 256 + ch * 8 + 4) = (f32x4){bflo(a.z), bfhi(a.z), bflo(a.w), bfhi(a.w)}; } }
            __syncthreads();
            if (tile + C.G < M / 32) CONV_LOAD(tile + C.G);
#pragma unroll
            for (int chunk = 0; chunk < 2; ++chunk) { const int base = tt0 + chunk * 8; float hv[38];
#pragma unroll
                for (int i = 0; i < 38; ++i) hv[i] = hL[(base + i) * 256 + cch];
#pragma unroll
                for (int tt = 0; tt < 8; ++tt) { float acc = cb;
#pragma unroll
                    for (int j = 0; j < 31; ++j) acc += wj[j] * hv[tt + j];
                    yL[(base + tt) * 256 + cch] = acc; } }
            __syncthreads();
            { float v[16]; float s = 0.f;
#pragma unroll
              for (int i = 0; i < 16; i += 4) { const f32x4 t4 = *(const LAS f32x4*)(yL + ntok * 256 + nc0 + i); v[i] = t4[0]; v[i + 1] = t4[1]; v[i + 2] = t4[2]; v[i + 3] = t4[3]; s += (t4[0] + t4[1]) + (t4[2] + t4[3]); }
              s += lane_xor<1>(s); s += lane_xor<2>(s); const float mean = s * (1.0f / 64); float q = 0.f;
#pragma unroll
              for (int i = 0; i < 16; ++i) { v[i] -= mean; q += v[i] * v[i]; }
              q += lane_xor<1>(q); q += lane_xor<2>(q); const float rstd = 1.0f / sqrtf(q * (1.0f / 64) + EPS);
              const float* gg = A->in[10] + layer * 256 + nc0; const float* gb = A->in[11] + layer * 256 + nc0; float o[16];
#pragma unroll
              for (int i = 0; i < 16; ++i) o[i] = siluf_(v[i] * rstd * gg[i] + gb[i]);
              bf16* dst = MIXED + (size_t)(t0 + ntok) * 1024 + 768 + nc0;
              *(u32x4*)dst = (u32x4){pk2(o[0], o[1]), pk2(o[2], o[3]), pk2(o[4], o[5]), pk2(o[6], o[7])};
              *(u32x4*)(dst + 8) = (u32x4){pk2(o[8], o[9]), pk2(o[10], o[11]), pk2(o[12], o[13]), pk2(o[14], o[15])}; }
        }
        __syncthreads();
    }
    REPS(11) ffn_weights(C, A, layer, C.gw, C.NGW, ffn_split(layer), 1 << 30);
}

__device__ __forceinline__ void p5_rms(Ctx& C) {
    bf16* MIXED = (bf16*)(C.ws + WS_SCR + SC_MIXED);
    REPS(7) for (int mb = C.gw; mb < M; mb += 4 * C.NGW) {
        u32x4 wa[4]; u32x2 wb[4];
#pragma unroll
        for (int k = 0; k < 4; ++k) { const bf16* r = MIXED + ((size_t)mb + (size_t)k * C.NGW) * 1024; wa[k] = ((const u32x4*)r)[C.lane]; wb[k] = ((const u32x2*)(r + 512))[C.lane]; }
#pragma unroll
        for (int k = 0; k < 4; ++k) { bf16* r = MIXED + ((size_t)mb + (size_t)k * C.NGW) * 1024;
            { const u32x4 w = wa[k]; float a[8] = {bflo(w.x), bfhi(w.x), bflo(w.y), bfhi(w.y), bflo(w.z), bfhi(w.z), bflo(w.w), bfhi(w.w)}; float ss = 0.f;
#pragma unroll
              for (int i = 0; i < 8; ++i) ss += a[i] * a[i];
              ss = wave_sum(ss); const float rs = 1.0f / sqrtf(ss * (1.0f / 512) + EPS);
              ((u32x4*)r)[C.lane] = (u32x4){pk2(a[0] * rs, a[1] * rs), pk2(a[2] * rs, a[3] * rs), pk2(a[4] * rs, a[5] * rs), pk2(a[6] * rs, a[7] * rs)}; }
            { const u32x2 w = wb[k]; const float a0 = bflo(w.x), a1 = bfhi(w.x), a2 = bflo(w.y), a3 = bfhi(w.y);
              const float ss = wave_sum((a0 * a0 + a1 * a1) + (a2 * a2 + a3 * a3)); const float rs = 1.0f / sqrtf(ss * (1.0f / 256) + EPS); ((u32x2*)(r + 512))[C.lane] = (u32x2){pk2(a0 * rs, a1 * rs), pk2(a2 * rs, a3 * rs)}; }
        }
    }
}

template <int MODE>
__device__ __forceinline__ void ln_pass(Ctx& C, const bool final, const bf16* add, const float* gam, const float* bet, const float* router_w) {
    bf16* XB = (bf16*)(C.ws + WS_XB); float* out = C.out;
    REPS(14) {
    const bool dry = ((REP_MASK >> 14) & 1) && rep_ == 0; float* jf = (float*)(C.ws + WS_SCR); bf16* jb = (bf16*)(C.ws + WS_SCR + 40 * MiB);
    int* TOPE = (int*)(C.ws + WS_MOE + MT_TOPE); float* TOPG = (float*)(C.ws + WS_MOE + MT_TOPG); const int* TOKSLOT = (const int*)(C.ws + WS_MOE + MT_TOKSLOT);
    LAS float* RW = (LAS float*)C.lds; LAS unsigned* CNT = (LAS unsigned*)(C.lds + 32768);
    if constexpr (MODE == 1) {
        for (int i = C.tid; i < 1024 * 8 / 4; i += NTHR) *(LAS f32x4*)(RW + 4 * i) = *(const f32x4*)(router_w + 4 * i);
        if (C.tid < 8) CNT[C.tid] = 0u;
        __syncthreads();
    }
    f32x4 g4[4], b4[4];
#pragma unroll
    for (int j = 0; j < 4; ++j) { g4[j] = ((const f32x4*)gam)[64 * j + C.lane]; b4[j] = ((const f32x4*)bet)[64 * j + C.lane]; }
    const int RPB = M / C.G, row0 = C.bx * RPB;
    unsigned cnt0 = 0, cnt1 = 0, cnt2 = 0, cnt3 = 0, cnt4 = 0, cnt5 = 0, cnt6 = 0, cnt7 = 0;
    u32x2 xA[4], aA[4], bA[4], xB[4], aB[4], bB[4]; int sA0 = 0, sA1 = 0, sB0 = 0, sB1 = 0;
#define LN_LOAD(NX, NA, NB, mm, s0_, s1_) do { _Pragma("unroll") for (int j = 0; j < 4; ++j) { NX[j] = ((const u32x2*)(XB + (size_t)(mm) * DM))[64 * j + C.lane]; \
        if constexpr (MODE == 2) { NA[j] = ((const u32x2*)(add + (size_t)(s0_) * DM))[64 * j + C.lane]; NB[j] = ((const u32x2*)(add + (size_t)(s1_) * DM))[64 * j + C.lane]; } \
        else { NA[j] = ((const u32x2*)(add + (size_t)(mm) * DM))[64 * j + C.lane]; NB[j] = (u32x2){0u, 0u}; } } } while (0)
#define LN_SLOTS(s0_, s1_, rrr) do { if constexpr (MODE == 2) { if ((rrr) < RPB) { s0_ = TOKSLOT[2 * (row0 + (rrr))]; s1_ = TOKSLOT[2 * (row0 + (rrr)) + 1]; } } } while (0)
#define LN_ROW(NX, NA, NB, S0, S1, rr_) do { const int m = row0 + (rr_); \
        f32x4 v[4]; \
        _Pragma("unroll") for (int j = 0; j < 4; ++j) { v[j] = (f32x4){bflo(NX[j].x), bfhi(NX[j].x), bflo(NX[j].y), bfhi(NX[j].y)} * ALPHA + (f32x4){bflo(NA[j].x), bfhi(NA[j].x), bflo(NA[j].y), bfhi(NA[j].y)}; \
            if constexpr (MODE == 2) v[j] += (f32x4){bflo(NB[j].x), bfhi(NB[j].x), bflo(NB[j].y), bfhi(NB[j].y)}; } \
        if ((rr_) + 2 * NWAVES < RPB) { LN_LOAD(NX, NA, NB, m + 2 * NWAVES, S0, S1); LN_SLOTS(S0, S1, (rr_) + 4 * NWAVES); } \
        float s = 0.f; \
        _Pragma("unroll") for (int j = 0; j < 4; ++j) s += (v[j][0] + v[j][1]) + (v[j][2] + v[j][3]); \
        const float mean = wave_sum(s) * (1.0f / DM); float q = 0.f; \
        _Pragma("unroll") for (int j = 0; j < 4; ++j) { v[j] = v[j] - mean; q += (v[j][0] * v[j][0] + v[j][1] * v[j][1]) + (v[j][2] * v[j][2] + v[j][3] * v[j][3]); } \
        const float rstd = 1.0f / sqrtf(wave_sum(q) * (1.0f / DM) + EPS); \
        _Pragma("unroll") for (int j = 0; j < 4; ++j) { v[j] = v[j] * rstd * g4[j] + b4[j]; if (final) ((f32x4*)((dry ? jf + (size_t)(m & 8191) * DM : out + (size_t)m * DM)))[64 * j + C.lane] = v[j]; \
            ((u32x2*)((dry ? jb + (size_t)(m & 8191) * DM : XB + (size_t)m * DM)))[64 * j + C.lane] = (u32x2){pk2(v[j][0], v[j][1]), pk2(v[j][2], v[j][3])}; } \
        if constexpr (MODE == 1) { \
            float lg[8] = {0.f, 0.f, 0.f, 0.f, 0.f, 0.f, 0.f, 0.f}; \
            _Pragma("unroll") for (int j = 0; j < 4; ++j) \
                _Pragma("unroll") for (int i = 0; i < 4; ++i) { const int col = 256 * j + 4 * C.lane + i; const f32x4 w0 = *(const LAS f32x4*)(RW + col * 8), w1 = *(const LAS f32x4*)(RW + col * 8 + 4); const float xv = v[j][i]; \
                    lg[0] += xv * w0[0]; lg[1] += xv * w0[1]; lg[2] += xv * w0[2]; lg[3] += xv * w0[3]; lg[4] += xv * w1[0]; lg[5] += xv * w1[1]; lg[6] += xv * w1[2]; lg[7] += xv * w1[3]; } \
            _Pragma("unroll") for (int e = 0; e < 8; ++e) lg[e] = wave_sum(lg[e]); \
            int e1 = 0; float v1 = lg[0]; \
            _Pragma("unroll") for (int e = 1; e < 8; ++e) if (lg[e] > v1) { v1 = lg[e]; e1 = e; } \
            int e2 = -1; float v2 = -INFINITY; \
            _Pragma("unroll") for (int e = 0; e < 8; ++e) if (e != e1 && lg[e] > v2) { v2 = lg[e]; e2 = e; } \
            const float ex = fexp2((v2 - v1) * LOG2E), gA = 1.0f / (1.0f + ex), gB = ex * gA; \
            if (C.lane == 0) { TOPE[2 * m] = e1; TOPE[2 * m + 1] = e2; TOPG[2 * m] = gA; TOPG[2 * m + 1] = gB; } \
            cnt0 += (e1 == 0) + (e2 == 0); cnt1 += (e1 == 1) + (e2 == 1); cnt2 += (e1 == 2) + (e2 == 2); cnt3 += (e1 == 3) + (e2 == 3); \
            cnt4 += (e1 == 4) + (e2 == 4); cnt5 += (e1 == 5) + (e2 == 5); cnt6 += (e1 == 6) + (e2 == 6); cnt7 += (e1 == 7) + (e2 == 7); \
        } } while (0)
    LN_SLOTS(sA0, sA1, C.wave); LN_SLOTS(sB0, sB1, C.wave + NWAVES);
    LN_LOAD(xA, aA, bA, row0 + C.wave, sA0, sA1); LN_LOAD(xB, aB, bB, row0 + C.wave + NWAVES, sB0, sB1);
    LN_SLOTS(sA0, sA1, C.wave + 2 * NWAVES); LN_SLOTS(sB0, sB1, C.wave + 3 * NWAVES);
    for (int rr = C.wave; rr < RPB; rr += 2 * NWAVES) {
        LN_ROW(xA, aA, bA, sA0, sA1, rr);
        LN_ROW(xB, aB, bB, sB0, sB1, rr + NWAVES);
    }
    if constexpr (MODE == 1) {
        if (C.lane == 0) { atomicAdd((unsigned*)&CNT[0], cnt0); atomicAdd((unsigned*)&CNT[1], cnt1); atomicAdd((unsigned*)&CNT[2], cnt2); atomicAdd((unsigned*)&CNT[3], cnt3);
                           atomicAdd((unsigned*)&CNT[4], cnt4); atomicAdd((unsigned*)&CNT[5], cnt5); atomicAdd((unsigned*)&CNT[6], cnt6); atomicAdd((unsigned*)&CNT[7], cnt7); }
        __syncthreads();
        if (C.tid < 8) C.ctl[CW_CNTB + C.bx * 8 + C.tid] = CNT[C.tid];
        __syncthreads();
    }
    }
#undef LN_LOAD
#undef LN_SLOTS
#undef LN_ROW
}

__device__ __forceinline__ void moe_assign(Ctx& C) {
    if (C.wave != 0) return;
    const int* TOPE = (const int*)(C.ws + WS_MOE + MT_TOPE); const float* TOPG = (const float*)(C.ws + WS_MOE + MT_TOPG);
    int* TOKSLOT = (int*)(C.ws + WS_MOE + MT_TOKSLOT); int* SLOTTOK = (int*)(C.ws + WS_MOE + MT_SLOTTOK); float* SLOTGATE = (float*)(C.ws + WS_MOE + MT_SLOTGATE);
    const int blk = C.bx, RPB = M / C.G, row0 = blk * RPB;
    int tot[8] = {0, 0, 0, 0, 0, 0, 0, 0}, pre[8] = {0, 0, 0, 0, 0, 0, 0, 0};
    for (int bb = C.lane; bb < C.G; bb += 64) {
        const u32x4* cp = (const u32x4*)(C.ctl + CW_CNTB + bb * 8); const u32x4 ca = cp[0], cb = cp[1]; const int lt = bb < blk ? 1 : 0;
        const int c[8] = {(int)ca.x, (int)ca.y, (int)ca.z, (int)ca.w, (int)cb.x, (int)cb.y, (int)cb.z, (int)cb.w};
#pragma unroll
        for (int e = 0; e < 8; ++e) { tot[e] += c[e]; pre[e] += lt * c[e]; }
    }
#pragma unroll
    for (int e = 0; e < 8; ++e) { tot[e] = wave_sum_i(tot[e]); pre[e] = wave_sum_i(pre[e]); }
    int seg[9]; seg[0] = 0;
#pragma unroll
    for (int e = 0; e < 8; ++e) seg[e + 1] = seg[e] + ((tot[e] + 255) & ~255);
    int run[8];
#pragma unroll
    for (int e = 0; e < 8; ++e) run[e] = seg[e] + pre[e];
    const unsigned long long ltmask = (1ull << C.lane) - 1ull;
    for (int base = 0; base < RPB * 2; base += 64) {
        const int idx = base + C.lane, token = row0 + (idx >> 1), choice = idx & 1;
        const int ex = TOPE[2 * token + choice]; const float gate = TOPG[2 * token + choice]; int slot = 0;
#pragma unroll
        for (int e = 0; e < 8; ++e) { const unsigned long long mk = __builtin_amdgcn_ballot_w64(ex == e); if (ex == e) slot = run[e] + __popcll(mk & ltmask); run[e] += __popcll(mk); }
        SLOTTOK[slot] = token; SLOTGATE[slot] = gate; TOKSLOT[2 * token + choice] = slot;
    }
    if (blk < 8) {
        int lo = 0, hi = 0;
#pragma unroll
        for (int e = 0; e < 8; ++e) if (e == blk) { lo = seg[e] + tot[e]; hi = seg[e + 1]; }
        for (int s = lo + C.lane; s < hi; s += 64) { SLOTTOK[s] = 0; SLOTGATE[s] = 0.f; }
    }
    if (blk == 0 && C.lane == 0) {
#pragma unroll
        for (int e = 0; e < 9; ++e) C.ctl[CW_SEG + e] = (unsigned)seg[e];
    }
}

#ifndef MK_PER_PHASE
#define MK_PER_PHASE 0
#endif
#ifndef PH_ENABLE
#define PH_ENABLE 0xFFFF
#endif
constexpr int PH_PER_LAYER = 12, N_PHASES = 1 + DEPTH * PH_PER_LAYER;

__global__ void __launch_bounds__(NTHR, 2) fwd_kernel(Args args) {
    extern __shared__ __attribute__((aligned(16))) unsigned char lds_raw[];
    LAS unsigned char* const lds = (LAS unsigned char*)lds_raw;
    volatile LAS unsigned* MISC = (volatile LAS unsigned*)(lds + MISC_OFF);
    for (int u = threadIdx.x; u < (LDS_BYTES - LDSCTL_OFF) / 4; u += NTHR) ((LAS unsigned*)(lds + LDSCTL_OFF))[u] = 0u;
    __syncthreads();
    const int wave0 = __builtin_amdgcn_readfirstlane((int)threadIdx.x >> 6);
    XcdBarrier bar; bar.bar = (unsigned*)(args.ws + WS_CTL) + CW_BAR; bar.x = 0; bar.st = nullptr;
    if (!MK_PER_PHASE) bar = xcd_barrier_post((unsigned*)(args.ws + WS_CTL) + CW_BAR, MISC + 8, wave0);
    const int lo = args.ph_lo, hi = args.ph_hi;
#define IN(k) (lo <= (k) && (k) < hi)
#define EN(p) ((PH_ENABLE >> (p)) & 1)
#define SEAM(k) do { if (IN((k) + 1)) { if (!MK_PER_PHASE) { unsigned long long bw0_ = 0ull; if (PROBE_ON(14)) bw0_ = __builtin_amdgcn_s_memrealtime(); xcd_barrier<false>(bar, wave0); if ((REP_MASK >> 13) & 1) xcd_barrier<false>(bar, wave0); \
        if (PROBE_ON(14)) { const unsigned long long bw1_ = __builtin_amdgcn_s_memrealtime(), bd_ = bw1_ - bw0_; while (__builtin_amdgcn_s_memrealtime() - bw1_ < bd_) __builtin_amdgcn_s_sleep(8); } \
        if (PROBE_ON(13)) { const unsigned long long bw1_ = __builtin_amdgcn_s_memrealtime(); while (__builtin_amdgcn_s_memrealtime() - bw1_ < 2000ull) __builtin_amdgcn_s_sleep(8); } } } } while (0)
#define SEAM0(k) do { if (IN((k) + 1)) { if (!MK_PER_PHASE) xcd_barrier<true>(bar, wave0); } } while (0)
#define PHASE_CTX kargs_t A = opaque_args(); Ctx C = make_ctx(A, lds, wave0); unsigned char* sc = C.ws + WS_SCR; (void)sc

    PT0(15); if (EN(15) && IN(0)) { PHASE_CTX; p0_prologue(C, A); }
    PEND(15, SEAM0(0));

    for (int layer = 0; layer < DEPTH; ++layer) {
        const int P = 1 + layer * PH_PER_LAYER;
#ifdef FORCE_MOE
        const bool moe = FORCE_MOE != 0;
#else
        const bool moe = (layer & 1) != 0;
#endif
        if (EN(0) && IN(P + 0)) { PT0(0);
            PHASE_CTX;
            pg8::DenseOrder S{(const bf16*)(C.ws + WS_XB), (const bf16*)(C.ws + WS_WIN) + (size_t)layer * NP1 * DM, DM, DM, M / 256, NP1 / 256, C.G, C.bx, REPN(0)};
            EpiInProj E{(bf16*)(sc + SC_CQKV), (bf16*)(sc + SC_CQKV) + (size_t)M * 256, (bf16*)(sc + SC_KR), (float*)(sc + SC_FL), (bf16*)(sc + SC_FQ), (bf16*)(sc + SC_CI), (float*)(sc + SC_RSQ), (const float*)(C.ws + WS_TAB), (const float*)(C.ws + WS_TAB) + (size_t)M * 16};
            if (C.bx >= C.G / 2) { ffn_weights(C, A, layer, (C.bx - C.G / 2) * NWAVES + C.wave, (C.G / 2) * NWAVES, 0, ffn_split(layer)); __syncthreads(); }
            pg8::gemm_phase<EpiInProj, pg8::DenseOrder, false, DM, DM, DM>(C.lds, C.tid, S, E);
            PEND(0, SEAM(P + 0));
        }
        if (EN(1) && IN(P + 1)) { PT0(1); PHASE_CTX; p2_thin(C, A, layer); PEND(1, SEAM(P + 1)); }
        if (EN(2) && IN(P + 2)) { PT0(2);
            PHASE_CTX;
            struct QkvOrder { const bf16* A; const bf16* Bt; int G, c, rep;
                __device__ __forceinline__ bool next(int i, pg8::Unit& u) const { return pg8::tile_order_rep(i, G, c, M / 256, 7, rep, u.pm, u.pn); }
                __device__ __forceinline__ const char* a_base(const pg8::Unit& u) const { return (const char*)(A + (u.pn < 3 ? (size_t)0 : (size_t)M * 256)) + (size_t)u.pm * 256 * 256 * 2; }
                __device__ __forceinline__ const char* b_base(const pg8::Unit& u) const { return (const char*)Bt + (size_t)u.pn * 256 * 256 * 2; }
                __device__ __forceinline__ int tok(const pg8::Unit&, int) const { return 0; }
                __device__ __forceinline__ int ktiles(const pg8::Unit& u, int nt) const { return u.pn < 3 ? nt : nt / 2; } };
            QkvOrder S{(const bf16*)(sc + SC_CQKV), (const bf16*)(C.ws + WS_WQ2) + (size_t)layer * NP1 * 256, C.G, C.bx, REPN(2)};
            EpiQKV E{(bf16*)(sc + SC_QM), (bf16*)(sc + SC_KM), (bf16*)(sc + SC_VM), (const float*)(C.ws + WS_TAB), (const float*)(C.ws + WS_TAB) + (size_t)M * 16, (const float*)(sc + SC_RSQ)};
            pg8::gemm_phase<EpiQKV, QkvOrder, false, 256, 256, 256>(C.lds, C.tid, S, E);
            PEND(2, SEAM(P + 2));
        }
        if (EN(3) && IN(P + 3)) { PT0(3);
            PHASE_CTX;
            bf16* MIXED = (bf16*)(sc + SC_MIXED);
            for (int p = C.vcu; p < 512; p += C.G) { const int bh = p >> 3, s = p & 7;
                for (int i = 0; i < 2; ++i) att::attn_unit<96, false>(bh >> 3, bh & 7, i == 0 ? 15 - s : s, (const bf16*)(sc + SC_QM), 768, (const bf16*)(sc + SC_KM), 768, (const bf16*)(sc + SC_VM), 512, MIXED, 1024, (bh & 7) * 64, nullptr, C.lds, C.tid, (float*)(sc + SC_SSQ), bh & 7, nullptr, (const bf16*)(sc + SC_KR));
            }
            { volatile LAS unsigned* qw = (volatile LAS unsigned*)(C.lds + RING_BYTES + 8192); const int xb = C.bx & 7; unsigned* qctr = C.ctl + CW_ATTQ + layer * 8 + xb;
              const bf16* FQ = (const bf16*)(sc + SC_FQ);
              for (;;) {
                if (C.tid == 0) qw[0] = __hip_atomic_fetch_add(qctr, 1u, RLX_AGENT);
                asm volatile("s_waitcnt vmcnt(0) lgkmcnt(0)\n\ts_barrier" ::: "memory");
                const int idx = __builtin_amdgcn_readfirstlane((int)qw[0]);
                if (idx >= 64) break;
                const int hd = idx & 3, qb = 15 - (idx >> 2), bh = xb * 4 + hd;
                att::attn_unit<64, true>(xb, hd, qb, FQ, 256, FQ + (size_t)M * 256, 256, FQ + (size_t)2 * M * 256, 256, MIXED, 1024, 512 + hd * 64, (const float*)(sc + SC_CUM), C.lds, C.tid, (float*)(sc + SC_SSQ), 8 + hd, C.ctl + CW_QKMAX + layer * 64 + bh * 2);
              }
            }
            PEND(3, SEAM(P + 3));
        }
        if (EN(5) && IN(P + 5)) { PT0(5);
            PHASE_CTX;
            pg8::DenseOrder S{(const bf16*)(sc + SC_MIXED), (const bf16*)(C.ws + WS_WOUT) + (size_t)layer * DM * DM, DM, DM, M / 256, DM / 256, C.G, C.bx, REPN(5)};
            EpiBf16<DM, false> E{(bf16*)(sc + SC_MIXOUT), DM / 256, nullptr};
            pg8::gemm_phase<EpiBf16<DM, false>, pg8::DenseOrder, false, DM, DM, DM, true>(C.lds, C.tid, S, E, (const float*)(sc + SC_SSQ));
            PEND(5, SEAM(P + 5));
        }
        if (EN(6) && IN(P + 6)) { PT0(6);
            if (moe) { PHASE_CTX; ln_pass<1>(C, false, (const bf16*)(sc + SC_MIXOUT), A->in[15] + layer * DM, A->in[16] + layer * DM, A->in[20] + (size_t)(layer >> 1) * DM * NEXP); }
            else     { PHASE_CTX; ln_pass<0>(C, false, (const bf16*)(sc + SC_MIXOUT), A->in[15] + layer * DM, A->in[16] + layer * DM, nullptr); }
            PEND(6, SEAM(P + 6));
        }
        if (EN(7) && IN(P + 7) && moe) { PT0(7); { PHASE_CTX; moe_assign(C); } PEND(7, SEAM(P + 7)); }
        if (EN(8) && IN(P + 8)) { PT0(8);
            if (moe) {
                PHASE_CTX; bf16* W13 = (bf16*)(C.ws + WS_WFFN); bf16* HID = (bf16*)(sc + SC_HID);
                const int* seg = (const int*)(C.ctl + CW_SEG);
                const int U = (seg[8] / 256) * 11;
                MoeIdxOrder<11> S{(const bf16*)(C.ws + WS_XB), W13, DM, DM, C.vcu, C.G, (U / C.G) * C.G, (const int*)(C.ws + WS_MOE + MT_SLOTTOK), seg[1], seg[2], seg[3], seg[4], seg[5], seg[6], seg[7]};
                EpiSwiGLU<DFE> E{HID, 11};
                pg8::gemm_phase<EpiSwiGLU<DFE>, MoeIdxOrder<11>, true, DM, DM, DM>(C.lds, C.tid, S, E);
            } else {
                PHASE_CTX; bf16* W13 = (bf16*)(C.ws + WS_WFFN); bf16* HID = (bf16*)(sc + SC_HID);
                pg8::DenseOrder S{(const bf16*)(C.ws + WS_XB), W13, DM, DM, M / 256, 2 * DFF / 256, C.G, C.bx, REPN(8)};
                EpiSwiGLU<DFF> E{HID, 1 << 30};
                pg8::gemm_phase<EpiSwiGLU<DFF>, pg8::DenseOrder, false, DM, DM, DM>(C.lds, C.tid, S, E);
            }
            PEND(8, SEAM(P + 8));
        }
        if (EN(9) && IN(P + 9)) { PT0(9);
            if (moe) {
                { PHASE_CTX; bf16* W13 = (bf16*)(C.ws + WS_WFFN); bf16* HID = (bf16*)(sc + SC_HID); const int* seg = (const int*)(C.ctl + CW_SEG);
                  const int U = (seg[8] / 256) * 11, UF = (U / C.G) * C.G;
                  if (UF + C.vcu < U) {
                      MoeIdxOrder<11> S{(const bf16*)(C.ws + WS_XB), W13, DM, DM, UF + C.vcu, C.G, U, (const int*)(C.ws + WS_MOE + MT_SLOTTOK), seg[1], seg[2], seg[3], seg[4], seg[5], seg[6], seg[7]};
                      EpiSwiGLU<DFE> E{HID, 11};
                      pg8::gemm_phase<EpiSwiGLU<DFE>, MoeIdxOrder<11>, true, DM, DM, DM>(C.lds, C.tid, S, E);
                      if (C.tid == 0) { __builtin_amdgcn_fence(__ATOMIC_RELEASE, "agent"); asm volatile("s_waitcnt vmcnt(0)" ::: "memory"); __hip_atomic_fetch_add(C.ctl + CW_LEFT + layer, 1u, RLX_AGENT); }
                  } }
                { PHASE_CTX; bf16* W2T = (bf16*)(C.ws + WS_WFFN) + WF_W13_ELEMS; bf16* HID = (bf16*)(sc + SC_HID); bf16* FF = (bf16*)(sc + SC_FF); const int* seg = (const int*)(C.ctl + CW_SEG);
                  const int U = (seg[8] / 256) * 11, UF = (U / C.G) * C.G, DF = (UF / 11) * 4;
                  MoeIdxOrder<4> S{HID, W2T, DFE, DFE, C.vcu, C.G, DF, nullptr, seg[1], seg[2], seg[3], seg[4], seg[5], seg[6], seg[7]};
                  EpiBf16<DM, true> E{FF, 4, (const float*)(C.ws + WS_MOE + MT_SLOTGATE)};
                  pg8::gemm_phase<EpiBf16<DM, true>, MoeIdxOrder<4>, false, DFE, DFE, DFE>(C.lds, C.tid, S, E); }
                { PHASE_CTX; bf16* W2T = (bf16*)(C.ws + WS_WFFN) + WF_W13_ELEMS; bf16* HID = (bf16*)(sc + SC_HID); bf16* FF = (bf16*)(sc + SC_FF); const int* seg = (const int*)(C.ctl + CW_SEG);
                  const int nM = seg[8] / 256, U = nM * 11, UF = (U / C.G) * C.G, DF = (UF / 11) * 4;
                  if (DF + (C.G - 1 - C.vcu) < nM * 4) {
                      if (C.wave == 0) { const unsigned need = (unsigned)(U - UF); unsigned* cw = C.ctl + CW_LEFT + layer;
                          while ((unsigned)__builtin_amdgcn_readfirstlane((int)__hip_atomic_load(cw, RLX_AGENT)) < need) __builtin_amdgcn_s_sleep(4);
                          __builtin_amdgcn_fence(__ATOMIC_ACQUIRE, "agent"); asm volatile("s_waitcnt vmcnt(0)" ::: "memory"); }
                      __syncthreads();
                      MoeIdxOrder<4> S{HID, W2T, DFE, DFE, DF + (C.G - 1 - C.vcu), C.G, nM * 4, nullptr, seg[1], seg[2], seg[3], seg[4], seg[5], seg[6], seg[7]};
                      EpiBf16<DM, true> E{FF, 4, (const float*)(C.ws + WS_MOE + MT_SLOTGATE)};
                      pg8::gemm_phase<EpiBf16<DM, true>, MoeIdxOrder<4>, false, DFE, DFE, DFE>(C.lds, C.tid, S, E);
                  } }
            } else {
                PHASE_CTX; bf16* W2T = (bf16*)(C.ws + WS_WFFN) + WF_W13_ELEMS; bf16* HID = (bf16*)(sc + SC_HID); bf16* FF = (bf16*)(sc + SC_FF);
                pg8::DenseOrder S{HID, W2T, DFF, DFF, M / 256, DM / 256, C.G, C.bx, REPN(9)};
                EpiBf16<DM, false> E{FF, DM / 256, nullptr};
                pg8::gemm_phase<EpiBf16<DM, false>, pg8::DenseOrder, false, DFF, DFF, DFF>(C.lds, C.tid, S, E);
            }
            PEND(9, SEAM(P + 9));
        }
        if (EN(10) && IN(P + 10)) { PT0(10);
            if (moe) { PHASE_CTX; ln_pass<2>(C, layer == DEPTH - 1, (const bf16*)(sc + SC_FF), A->in[24] + layer * DM, A->in[25] + layer * DM, nullptr); }
            else     { PHASE_CTX; ln_pass<0>(C, layer == DEPTH - 1, (const bf16*)(sc + SC_FF), A->in[24] + layer * DM, A->in[25] + layer * DM, nullptr); }
            PEND(10, if (layer < DEPTH - 1) SEAM(P + 10));
        }
    }
#undef IN
#undef SEAM
}

extern "C" void kernel_launch(void* const* d_in, const int* in_sizes, int n_in, void* d_out, int out_size, void* d_ws, size_t ws_size, hipStream_t stream) {
    static int grid = 0;
    if (grid == 0) {
        if (n_in != 26 || out_size != M * DM || ws_size < WS_END) { fprintf(stderr, "kernel_launch: unexpected problem (n_in %d, out %d, ws %zu < %zu)\n", n_in, out_size, ws_size, (size_t)WS_END); grid = -1; return; }
        int dev = 0, cus = 0, per_cu = 0;
        if (hipGetDevice(&dev) != hipSuccess || hipDeviceGetAttribute(&cus, hipDeviceAttributeMultiprocessorCount, dev) != hipSuccess) { grid = -1; return; }
        if (hipFuncSetAttribute((const void*)fwd_kernel, hipFuncAttributeMaxDynamicSharedMemorySize, LDS_BYTES) != hipSuccess) { fprintf(stderr, "kernel_launch: hipFuncSetAttribute failed\n"); grid = -1; return; }
        if (hipOccupancyMaxActiveBlocksPerMultiprocessor(&per_cu, (const void*)fwd_kernel, NTHR, LDS_BYTES) != hipSuccess || per_cu < 1) fprintf(stderr, "kernel_launch: occupancy query says %d\n", per_cu);
        (void)hipGetLastError();
        grid = 256; while (grid > cus && grid > 8) grid >>= 1;
    }
    if (grid < 0) return;
    (void)hipMemsetAsync((char*)d_ws + WS_CTL, 0, CTL_ZERO_BYTES, stream);
    Args a{};
    for (int i = 0; i < 26; ++i) a.in[i] = (const float*)d_in[i];
    a.out = (float*)d_out; a.ws = (unsigned char*)d_ws;
#if MK_PER_PHASE
    for (int p = 0; p < N_PHASES; ++p) { a.ph_lo = p; a.ph_hi = p + 1; hipLaunchKernelGGL(fwd_kernel, dim3(grid), dim3(NTHR), LDS_BYTES, stream, a); }
#else
    a.ph_lo = 0; a.ph_hi = N_PHASES;
    hipLaunchKernelGGL(fwd_kernel, dim3(grid), dim3(NTHR), LDS_BYTES, stream, a);
#endif
}
```

```cpp
#include <hip/hip_runtime.h>
#include <cstdio>
#include <cstdint>
#include <cmath>

#ifndef REP_MASK
#define REP_MASK 0x0
#endif
#ifndef PROBE_MASK
#define PROBE_MASK 0x0
#endif
#define PROBE_ON(k) ((PROBE_MASK >> (k)) & 1)
#define PT0(k) unsigned long long pt0_ = 0ull; if (PROBE_ON(k)) pt0_ = __builtin_amdgcn_s_memrealtime()
#ifndef PROBE_BEFORE
#define PROBE_BEFORE 0
#endif
#define PSPIN(d) do { const unsigned long long pt1_ = __builtin_amdgcn_s_memrealtime(); while (__builtin_amdgcn_s_memrealtime() - pt1_ < (d)) __builtin_amdgcn_s_sleep(8); } while (0)
#define PEND(k, seamexpr) do { unsigned long long pd_ = 0ull; if (PROBE_ON(k)) { pd_ = __builtin_amdgcn_s_memrealtime() - pt0_; if (PROBE_BEFORE) PSPIN(pd_); } seamexpr; \
        if (PROBE_ON(k) && !PROBE_BEFORE) PSPIN(pd_); } while (0)
#define REPN(p) (1 + ((REP_MASK >> (p)) & 1))
#define REPS(p) for (int rep_ = 0; rep_ < 1 + ((REP_MASK >> (p)) & 1); ++rep_)
#define GAS __attribute__((address_space(1)))
#define LAS __attribute__((address_space(3)))
typedef unsigned short bf16;
typedef short bf16x8 __attribute__((ext_vector_type(8)));
typedef short s16x4 __attribute__((ext_vector_type(4)));
typedef float f32x2 __attribute__((ext_vector_type(2)));
typedef float f32x4 __attribute__((ext_vector_type(4)));
typedef float f32x16 __attribute__((ext_vector_type(16)));
typedef unsigned u32x2 __attribute__((ext_vector_type(2)));
typedef unsigned u32x4 __attribute__((ext_vector_type(4)));
typedef __bf16 bf16x2_t __attribute__((ext_vector_type(2)));

constexpr int BATCH = 8, SEQ = 4096, DM = 1024, M = BATCH * SEQ, DEPTH = 4;
constexpr int IN_COLS = 1700, NP1 = 1792;
constexpr int DFF = 2816, DFE = 1408, NEXP = 8;
constexpr int NWAVES = 8, NTHR = 512;
constexpr float ALPHA = 1.6817928305074290f;
constexpr float EPS = 1e-5f;
constexpr float LOG2E = 1.4426950408889634f;
constexpr float C2_MLA = 0.10206207261596577f * LOG2E;
constexpr float C2_FOX = 0.125f * LOG2E;
constexpr int PC_CQ = 0, PC_CKV = 256, PC_KR = 384, PC_FL = 416, PC_FQ = 512, PC_FK = 768, PC_FV = 1024, PC_CI = 1280;
constexpr int MOE_ROWS_MAX = 2 * M + NEXP * 256;

constexpr size_t MiB = 1u << 20;
constexpr size_t WS_CTL = 0, CTL_ZERO_BYTES = 1 * MiB;
constexpr size_t WS_WIN = 1 * MiB;
constexpr size_t WS_WQ2 = WS_WIN + 14 * MiB;
constexpr size_t WS_WOUT = WS_WQ2 + 4 * MiB;
constexpr size_t WS_TAB = WS_WOUT + 8 * MiB;
constexpr size_t WS_MOE = WS_TAB + 4 * MiB;
constexpr size_t WS_WFFN = WS_MOE + 2 * MiB;
constexpr size_t WS_WFFD = WS_WFFN + 68 * MiB;
constexpr size_t WS_XB = WS_WFFD + 18 * MiB;
constexpr size_t WS_SCR = WS_XB + 64 * MiB;
constexpr size_t SC_CQKV = 0;
constexpr size_t SC_KR = SC_CQKV + 32 * MiB;
constexpr size_t SC_FL = SC_KR + 4 * MiB;
constexpr size_t SC_CUM = SC_FL + MiB / 2;
constexpr size_t SC_FQ = SC_CUM + MiB / 2;
constexpr size_t SC_CI = SC_FQ + 48 * MiB;
constexpr size_t SC_RSQ = SC_CI + 16 * MiB;
constexpr size_t SC_QM = SC_CI + 32 * MiB;
constexpr size_t SC_KM = SC_QM + 48 * MiB;
constexpr size_t SC_VM = SC_KM + 48 * MiB;
constexpr size_t SC_MIXED = SC_VM + 32 * MiB;
constexpr size_t SC_MIXOUT = SC_QM;
constexpr size_t SC_SSQ = SC_MIXED + 64 * MiB;
constexpr size_t SC_MIX_END = SC_SSQ + 2 * MiB;
constexpr size_t SC_HID = 0;
constexpr size_t SC_FF = 182 * MiB;
constexpr size_t SC_END = 316 * MiB;
constexpr size_t WS_END = WS_SCR + SC_END;
static_assert(SC_MIX_END <= SC_END && SC_FF + (size_t)MOE_ROWS_MAX * 1024 * 2 <= SC_END && (size_t)MOE_ROWS_MAX * DFE * 2 <= SC_FF, "scratch map");
static_assert(WS_END <= 512 * MiB, "workspace map");
constexpr size_t WF_W13_ELEMS = (size_t)NEXP * 2 * DFE * DM;
constexpr size_t WD_W13_ELEMS = (size_t)2 * DFF * DM;
constexpr size_t MT_TOPE = 0;
constexpr size_t MT_TOPG = 256 * 1024;
constexpr size_t MT_TOKSLOT = 512 * 1024;
constexpr size_t MT_SLOTTOK = 768 * 1024;
constexpr size_t MT_SLOTGATE = 768 * 1024 + 272 * 1024;
static_assert((size_t)MOE_ROWS_MAX * 4 <= 272 * 1024 && MT_SLOTGATE + 272 * 1024 <= 2 * MiB, "moe tables");
constexpr int CW_BAR = 4096;
constexpr int CW_CNTB = 16384;
constexpr int CW_SEG = 20480;
constexpr int CW_ATTQ = 2048;
constexpr int CW_LEFT = 2112;
constexpr int CW_CONVQ = 2176;
constexpr int CW_KNMAX = 2304;
constexpr int CW_KRMAX = 2816;
constexpr int CW_QKMAX = 1024;

constexpr int RING_BYTES = 131072;
constexpr int LDSCTL_OFF = RING_BYTES, MISC_OFF = LDSCTL_OFF + 320;
constexpr int LDS_BYTES = 147456;

#define RLX_AGENT __ATOMIC_RELAXED, __HIP_MEMORY_SCOPE_AGENT
__device__ __forceinline__ unsigned pk2(float lo, float hi) { f32x2 v = {lo, hi}; bf16x2_t b = __builtin_convertvector(v, bf16x2_t); return __builtin_bit_cast(unsigned, b); }
__device__ __forceinline__ float bf2f(unsigned short u) { return __uint_as_float((unsigned)u << 16); }
__device__ __forceinline__ float bflo(unsigned u) { return __uint_as_float(u << 16); }
__device__ __forceinline__ float bfhi(unsigned u) { return __uint_as_float(u & 0xffff0000u); }
__device__ __forceinline__ float fexp2(float x) { return __builtin_amdgcn_exp2f(x); }
__device__ __forceinline__ float frcp(float x) { return __builtin_amdgcn_rcpf(x); }
__device__ __forceinline__ float sigmoidf_(float x) { return frcp(1.0f + fexp2(-x * LOG2E)); }
__device__ __forceinline__ float siluf_(float x) { return x * sigmoidf_(x); }
template <int O> __device__ __forceinline__ float lane_xor(float v) {
    if constexpr (O < 32) return __int_as_float(__builtin_amdgcn_ds_swizzle(__float_as_int(v), (O << 10) | 0x1f));
    else { auto rr = __builtin_amdgcn_permlane32_swap(__float_as_uint(v), __float_as_uint(v), false, false); return __uint_as_float(rr[0]) == v ? __uint_as_float(rr[1]) : __uint_as_float(rr[0]); }
}
template <int CTRL> __device__ __forceinline__ float dpp_mov(float v) { return __int_as_float(__builtin_amdgcn_update_dpp(0, __float_as_int(v), CTRL, 0xf, 0xf, false)); }
__device__ __forceinline__ float wave_sum(float v) {
    v += dpp_mov<0xB1>(v); v += dpp_mov<0x4E>(v); v += dpp_mov<0x141>(v); v += dpp_mov<0x140>(v);
    { auto rr = __builtin_amdgcn_permlane16_swap(__float_as_uint(v), __float_as_uint(v), false, false); v = __uint_as_float(rr[0]) + __uint_as_float(rr[1]); }
    { auto rr = __builtin_amdgcn_permlane32_swap(__float_as_uint(v), __float_as_uint(v), false, false); v = __uint_as_float(rr[0]) + __uint_as_float(rr[1]); }
    return v;
}
__device__ __forceinline__ int wave_sum_i(int v) {
    v += __builtin_amdgcn_ds_swizzle(v, (1 << 10) | 0x1f); v += __builtin_amdgcn_ds_swizzle(v, (2 << 10) | 0x1f); v += __builtin_amdgcn_ds_swizzle(v, (4 << 10) | 0x1f);
    v += __builtin_amdgcn_ds_swizzle(v, (8 << 10) | 0x1f); v += __builtin_amdgcn_ds_swizzle(v, (16 << 10) | 0x1f);
    { auto rr = __builtin_amdgcn_permlane32_swap((unsigned)v, (unsigned)v, false, false); v = (int)(rr[0] + rr[1]); }
    return v;
}
__device__ __forceinline__ u32x4 pack8(const f32x4 a, const f32x4 b) { u32x4 w; w.x = pk2(a[0], a[1]); w.y = pk2(a[2], a[3]); w.z = pk2(b[0], b[1]); w.w = pk2(b[2], b[3]); return w; }

#define XB_TMO      128
#define XB_XCNT(j)  (256  + 64 * (j))
#define XB_XSUB(j)  (1280 + 64 * (j))
#define XB_XGEN(j)  (2304 + 64 * (j))
#define XB_TOP      3328
#define XB_TOPGEN   3392
#define XCD_BAR_WORDS 3456
#define XB_SPIN_CAP (1u << 18)
__device__ __forceinline__ unsigned xb_ld(unsigned* p)              { return __hip_atomic_load(p, __ATOMIC_RELAXED, __HIP_MEMORY_SCOPE_AGENT); }
__device__ __forceinline__ unsigned xb_add(unsigned* p, unsigned v) { return __hip_atomic_fetch_add(p, v, __ATOMIC_RELAXED, __HIP_MEMORY_SCOPE_AGENT); }
__device__ __forceinline__ unsigned xb_xcc_id() { return (unsigned)__builtin_amdgcn_s_getreg((3 << 11) | 20) & 0xFu; }
#define XB_SPIN(cond, bar) do { unsigned _sp = 0; while (cond) { __builtin_amdgcn_s_sleep(1); \
    if ((++_sp & 255u) == 0u) { if (xb_ld(&(bar)[XB_TMO])) break; if (_sp > XB_SPIN_CAP) { atomicAdd(&(bar)[XB_TMO], 1u); break; } } } } while (0)
struct XcdBarrier { unsigned* bar; unsigned x; volatile LAS unsigned* st; };
__device__ __forceinline__ bool xb_is_t0(int wave0) { unsigned ones = ~0u; asm volatile("" : "+s"(ones)); return wave0 == 0 && __builtin_amdgcn_mbcnt_hi(ones, __builtin_amdgcn_mbcnt_lo(ones, 0u)) == 0u; }
__device__ __forceinline__ XcdBarrier xcd_barrier_post(unsigned* bar, volatile LAS unsigned* st, int wave0) {
    XcdBarrier b; b.bar = bar; b.x = xb_xcc_id(); b.st = st;
    if (xb_is_t0(wave0)) (void)xb_add(&bar[XB_XCNT(b.x)], 1u);
    return b;
}
__device__ __forceinline__ void xcd_barrier_complete(unsigned* bar, unsigned x, unsigned& nloc, unsigned& nx) {
    const unsigned G = gridDim.x * gridDim.y * gridDim.z;
    unsigned sum, cnt, mine, sp = 0u;
    for (;;) {
        sum = 0u; cnt = 0u; mine = 0u;
#pragma unroll
        for (unsigned j = 0; j < 16; ++j) { const unsigned c = xb_ld(&bar[XB_XCNT(j)]); sum += c; cnt += (c > 0u) ? 1u : 0u; mine = (j == x) ? c : mine; }
        if (sum == G) break;
        __builtin_amdgcn_s_sleep(1);
        if ((++sp & 255u) == 0u) { if (xb_ld(&bar[XB_TMO])) break; if (sp > XB_SPIN_CAP) { atomicAdd(&bar[XB_TMO], 1u); break; } }
    }
    nloc = mine > 0u ? mine : 1u; nx = cnt > 0u ? cnt : 1u;
}
template <bool FIRST>
__device__ __forceinline__ void xcd_barrier(const XcdBarrier& b, int wave0) {
    asm volatile("s_waitcnt vmcnt(0)" ::: "memory");
    __syncthreads();
    if (xb_is_t0(wave0)) {
        unsigned* bar = b.bar;
        __builtin_amdgcn_s_waitcnt(0);
        unsigned nloc = b.st[0], nx = b.st[1];
        if constexpr (FIRST) { if (nloc == 0u) { xcd_barrier_complete(bar, b.x, nloc, nx); b.st[0] = nloc; b.st[1] = nx; } }
        const unsigned old = xb_add(&bar[XB_XSUB(b.x)], 1u);
        const unsigned gen = old / nloc;
        if (old + 1u == (gen + 1u) * nloc) {
            __builtin_amdgcn_fence(__ATOMIC_RELEASE, "agent");
            asm volatile("s_waitcnt vmcnt(0)" ::: "memory");
            const unsigned og = xb_add(&bar[XB_TOP], 1u);
            const unsigned tg = og / nx;
            if (og + 1u == (tg + 1u) * nx) xb_add(&bar[XB_TOPGEN], 1u);
            else XB_SPIN(xb_ld(&bar[XB_TOPGEN]) == tg, bar);
            __builtin_amdgcn_fence(__ATOMIC_ACQUIRE, "agent");
            xb_add(&bar[XB_XGEN(b.x)], 1u);
            asm volatile("s_waitcnt vmcnt(0)" ::: "memory");
        } else {
            XB_SPIN(xb_ld(&bar[XB_XGEN(b.x)]) == gen, bar);
            __builtin_amdgcn_fence(__ATOMIC_ACQUIRE, "agent");
            asm volatile("s_waitcnt vmcnt(0)" ::: "memory");
        }
    }
    __syncthreads();
}

namespace pg8 {
constexpr int BM = 256, BK = 64, HALF = 128, HTB = HALF * BK * 2, STAGE_BYTES = 8 * HTB, NXCD = 8, WGM = 8;
__host__ __device__ __forceinline__ int lds_byte(int r, int c) { const int st = (r >> 4) * 2 + (c >> 5), rr = r & 15, cc = c & 31, ob = rr * 64 + cc * 2; return st * 1024 + (ob ^ (((ob >> 9) & 1) << 5)); }
__host__ __device__ __forceinline__ void stage_rc(int b, int& R, int& C) { const int st = b / 1024, sb = b % 1024, swz = sb ^ (((sb >> 9) & 1) << 5); R = (st >> 1) * 16 + swz / 64; C = (st & 1) * 32 + (swz % 64) / 2; }
__host__ __device__ __forceinline__ int perm32(int rho) { const int n = rho >> 4, i = rho & 15; return 8 * (i >> 2) + 4 * n + (i & 3); }
struct Unit { int pm, pn; };

__device__ __forceinline__ bool tile_order(long L, int nM, int nN, int& pm, int& pn) {
    const int nwg = nM * nN; if (L >= nwg) return false;
    int wgid = (int)L; { const int q = nwg / NXCD, r = nwg % NXCD, xcd = wgid % NXCD, off = wgid / NXCD; wgid = (xcd < r ? xcd * (q + 1) : r * (q + 1) + (xcd - r) * q) + off; }
    const int nig = WGM * nN, gid = wgid / nig, fm = gid * WGM, gsz = (nM - fm) < WGM ? (nM - fm) : WGM;
    pm = fm + ((wgid % nig) % gsz); pn = (wgid % nig) / gsz; return true;
}
__device__ __forceinline__ bool tile_order_rep(int i, int G, int c, int nM, int nN, int rep, int& pm, int& pn) {
    if (rep == 1) return tile_order((long)i * G + c, nM, nN, pm, pn);
    const int nwg = nM * nN, per = c < nwg ? (nwg - c + G - 1) / G : 0; if (i >= per * rep) return false;
    return tile_order((long)(i % per) * G + c, nM, nN, pm, pn);
}
struct DenseOrder {
    const bf16* A; const bf16* Bt; int lda, ldb, nM, nN, G, c, rep;
    __device__ __forceinline__ bool next(int i, Unit& u) const { return tile_order_rep(i, G, c, nM, nN, rep, u.pm, u.pn); }
    __device__ __forceinline__ const char* a_base(const Unit& u) const { return (const char*)A + (size_t)u.pm * BM * lda * 2; }
    __device__ __forceinline__ const char* b_base(const Unit& u) const { return (const char*)Bt + (size_t)u.pn * BM * ldb * 2; }
    __device__ __forceinline__ int tok(const Unit&, int) const { return 0; }
    __device__ __forceinline__ int ktiles(const Unit&, int nt) const { return nt; }
};

template <class Epi, class Sched, bool GATHER, int K, int lda, int ldb, bool SEGSCALE = false>
__device__ __forceinline__ void gemm_phase(LAS unsigned char* lds, const int tid, const Sched& S, const Epi& E, const float* ssq = nullptr) {
    const int wid = __builtin_amdgcn_readfirstlane(tid >> 6), lane = tid & 63, wr = wid >> 2, wc = wid & 3, fr = lane & 15, fq = lane >> 4;
    constexpr int nt = K / BK;
    unsigned voffA[2], voffB[2];
#pragma unroll
    for (int i = 0; i < 2; ++i) { int R, C; stage_rc(tid * 16 + i * 8192, R, C); const int Rb = Epi::PERM ? ((R & ~31) + perm32(R & 31)) : R;
        voffA[i] = (unsigned)(R * lda + C) * 2u; voffB[i] = (unsigned)(Rb * ldb + C) * 2u; }
#define PG8_GOFF(u_, h_, o0_, o1_) do { unsigned ones_ = ~0u; asm volatile("" : "+s"(ones_)); const int t_ = wid * 64 + (int)__builtin_amdgcn_mbcnt_hi(ones_, __builtin_amdgcn_mbcnt_lo(ones_, 0u)); \
        int R0_, C0_, R1_, C1_; stage_rc(t_ * 16, R0_, C0_); stage_rc(t_ * 16 + 8192, R1_, C1_); \
        o0_ = (unsigned)S.tok(u_, (h_) * HALF + R0_) * (unsigned)(lda * 2) + (unsigned)(C0_ * 2); o1_ = (unsigned)S.tok(u_, (h_) * HALF + R1_) * (unsigned)(lda * 2) + (unsigned)(C1_ * 2); } while (0)
    const size_t kstep = (size_t)(BK * 2);
    constexpr size_t hstepA = (size_t)HALF * lda * 2, hstepB = (size_t)HALF * ldb * 2;
    const unsigned ldsw = (unsigned)wid * 1024u;
    const int aoff = lds_byte(wr * 64 + fr, fq * 8), boff = lds_byte(wc * 32 + fr, fq * 8);
#define PG8_SA(b, h) (((b) * 2 + (h)) * HTB)
#define PG8_SB(b, h) ((4 + (b) * 2 + (h)) * HTB)
#define PG8_STAGE(bufoff, gbase, v0, v1) do { \
        __builtin_amdgcn_global_load_lds((const unsigned*)((const char*)(gbase) + (v0)), (LAS unsigned*)(lds + (bufoff) + ldsw), 16, 0, 0); \
        __builtin_amdgcn_global_load_lds((const unsigned*)((const char*)(gbase) + (v1)), (LAS unsigned*)(lds + (bufoff) + ldsw + 8192), 16, 0, 0); } while (0)
#define PG8_STB(bufoff, gbase) PG8_STAGE(bufoff, gbase, voffB[0], voffB[1])
#define PG8_STA(bufoff, gbase, h, G0, G1) do { if constexpr (GATHER) PG8_STAGE(bufoff, gbase, G0, G1); else PG8_STAGE(bufoff, (gbase) + (h) * hstepA, voffA[0], voffA[1]); } while (0)
#define PG8_LDA(dst, b, h) do { _Pragma("unroll") for (int m = 0; m < 4; ++m) _Pragma("unroll") for (int k = 0; k < 2; ++k) dst[m][k] = *(const LAS bf16x8*)(lds + PG8_SA(b, h) + aoff + m * 2048 + k * 1024); } while (0)
#define PG8_LDB(dst, b, h) do { _Pragma("unroll") for (int n = 0; n < 2; ++n) _Pragma("unroll") for (int k = 0; k < 2; ++k) dst[n][k] = *(const LAS bf16x8*)(lds + PG8_SB(b, h) + boff + n * 2048 + k * 1024); } while (0)
#define PG8_MMA(ai, bj, At, Bt) do { __builtin_amdgcn_s_setprio(1); _Pragma("unroll") for (int m = 0; m < 4; ++m) _Pragma("unroll") for (int n = 0; n < 2; ++n) _Pragma("unroll") for (int k = 0; k < 2; ++k) \
        acc[ai][bj][m][n] = __builtin_amdgcn_mfma_f32_16x16x32_bf16(Bt[n][k], At[m][k], acc[ai][bj][m][n], 0, 0, 0); __builtin_amdgcn_s_setprio(0); } while (0)
#define PG8_WAIT_V(n) asm volatile("s_waitcnt vmcnt(" #n ")" ::: "memory")
#define PG8_WAIT_L(n) asm volatile("s_waitcnt lgkmcnt(" #n ")" ::: "memory")
#define PG8_BAR __builtin_amdgcn_s_barrier()
#define PG8_SCHED __builtin_amdgcn_sched_barrier(0)
    Unit cur, nxt; int ui = 0;
    if (!S.next(0, cur)) return;
    f32x4 acc[2][2][4][2];
#pragma unroll
    for (int a = 0; a < 2; ++a)
#pragma unroll
        for (int b = 0; b < 2; ++b)
#pragma unroll
            for (int m = 0; m < 4; ++m)
#pragma unroll
                for (int n = 0; n < 2; ++n) acc[a][b][m][n] = (f32x4){0.f, 0.f, 0.f, 0.f};
    bf16x8 At[4][2], B0[2][2], B1[2][2];
    const char* cA = S.a_base(cur); const char* cB = S.b_base(cur);
    unsigned gc00 = 0, gc01 = 0, gc10 = 0, gc11 = 0, gn00 = 0, gn01 = 0, gn10 = 0, gn11 = 0;
    if constexpr (GATHER) { PG8_GOFF(cur, 0, gc00, gc01); PG8_GOFF(cur, 1, gc10, gc11); }
    PG8_STB(PG8_SB(0, 0), cB); PG8_STB(PG8_SB(0, 1), cB + hstepB); PG8_STA(PG8_SA(0, 0), cA, 0, gc00, gc01); PG8_STA(PG8_SA(0, 1), cA, 1, gc10, gc11);
    if (wr == 1) PG8_BAR;
    PG8_WAIT_V(2); PG8_BAR;
    PG8_STB(PG8_SB(1, 0), cB + kstep); PG8_STA(PG8_SA(1, 0), cA + kstep, 0, gc00, gc01); PG8_STB(PG8_SB(1, 1), cB + hstepB + kstep);
    PG8_WAIT_V(6); PG8_BAR;
    for (;;) {
        const bool has_next = S.next(ui + 1, nxt);
        const char* nA = has_next ? S.a_base(nxt) : cA; const char* nB = has_next ? S.b_base(nxt) : cB;
        if constexpr (SEGSCALE) {
            if (tid < 256) { const f32x4* sp = (const f32x4*)(ssq + (size_t)(cur.pm * 256 + tid) * 12); const f32x4 a = sp[0], b = sp[1], c = sp[2];
                const float sm = ((a[0] + a[1]) + (a[2] + a[3])) + ((b[0] + b[1]) + (b[2] + b[3])), sf = (c[0] + c[1]) + (c[2] + c[3]);
                const float rm = 1.0f / sqrtf(sm * (1.0f / 512) + EPS), rf = 1.0f / sqrtf(sf * (1.0f / 256) + EPS);
                *(LAS f32x2*)(lds + STAGE_BYTES + 1024 + tid * 8) = (f32x2){rm / rf, rf}; }
        }
        if constexpr (GATHER) {
            if (has_next) { PG8_GOFF(nxt, 0, gn00, gn01); PG8_GOFF(nxt, 1, gn10, gn11); }
            else { gn00 = gc00; gn01 = gc01; gn10 = gc10; gn11 = gc11; }
        }
        const int ntu = S.ktiles(cur, nt);
#pragma nounroll
        for (int t = 0; t < ntu; t += 2) {
            const bool last = (t == ntu - 2);
            const char* a1 = cA + (size_t)(t + 1) * kstep;
            const char* a2 = last ? nA : cA + (size_t)(t + 2) * kstep; const char* b2 = last ? nB : cB + (size_t)(t + 2) * kstep;
            const char* a3 = a2 + kstep; const char* b3 = b2 + kstep;
            const unsigned g00 = last ? gn00 : gc00, g01 = last ? gn01 : gc01, g10 = last ? gn10 : gc10, g11 = last ? gn11 : gc11;
            PG8_LDB(B0, 0, 0); PG8_LDB(B1, 0, 1); PG8_SCHED; PG8_LDA(At, 0, 0); PG8_STA(PG8_SA(1, 1), a1, 1, gc10, gc11);
            PG8_WAIT_V(8); PG8_WAIT_L(0); PG8_BAR; PG8_MMA(0, 0, At, B0); PG8_MMA(0, 1, At, B1); PG8_BAR; PG8_SCHED;
            PG8_LDA(At, 0, 1); PG8_STB(PG8_SB(0, 0), b2); PG8_STB(PG8_SB(0, 1), b2 + hstepB); PG8_STA(PG8_SA(0, 0), a2, 0, g00, g01);
            PG8_WAIT_V(8); PG8_WAIT_L(0); PG8_BAR; PG8_MMA(1, 0, At, B0); PG8_MMA(1, 1, At, B1); PG8_BAR; PG8_SCHED;
            PG8_LDB(B0, 1, 0); PG8_LDB(B1, 1, 1); PG8_SCHED; PG8_LDA(At, 1, 0); PG8_STA(PG8_SA(0, 1), a2, 1, g10, g11);
            PG8_WAIT_V(8); PG8_WAIT_L(0); PG8_BAR; PG8_MMA(0, 0, At, B0); PG8_MMA(0, 1, At, B1); PG8_BAR; PG8_SCHED;
            PG8_LDA(At, 1, 1); PG8_STB(PG8_SB(1, 0), b3); PG8_STB(PG8_SB(1, 1), b3 + hstepB); PG8_STA(PG8_SA(1, 0), a3, 0, g00, g01);
            PG8_WAIT_V(8); PG8_WAIT_L(0); PG8_BAR; PG8_MMA(1, 0, At, B0); PG8_MMA(1, 1, At, B1); PG8_BAR; PG8_SCHED;
            if constexpr (SEGSCALE) {
                if (t == 6 || t == 10) {
                    unsigned ones_ = ~0u; asm volatile("" : "+s"(ones_)); const int fr_ = (int)__builtin_amdgcn_mbcnt_hi(ones_, __builtin_amdgcn_mbcnt_lo(ones_, 0u)) & 15;
                    const LAS float* fp = (const LAS float*)(lds + STAGE_BYTES + 1024) + (wr * 64 + fr_) * 2 + (t == 10 ? 1 : 0);
#pragma unroll
                    for (int ai = 0; ai < 2; ++ai)
#pragma unroll
                        for (int m = 0; m < 4; ++m) { const float f = fp[(ai * 128 + m * 16) * 2];
#pragma unroll
                            for (int bj = 0; bj < 2; ++bj)
#pragma unroll
                                for (int n = 0; n < 2; ++n) acc[ai][bj][m][n] *= f; }
                    PG8_SCHED;
                }
            }
        }
        if (wr == 0) PG8_BAR;
        { unsigned ones_ = ~0u; asm volatile("" : "+s"(ones_)); const int l_ = (int)__builtin_amdgcn_mbcnt_hi(ones_, __builtin_amdgcn_mbcnt_lo(ones_, 0u)); E(acc, cur, wr, wc, l_ & 15, l_ >> 4); }
        if (!has_next) break;
#pragma unroll
        for (int a = 0; a < 2; ++a)
#pragma unroll
            for (int b = 0; b < 2; ++b)
#pragma unroll
                for (int m = 0; m < 4; ++m)
#pragma unroll
                    for (int n = 0; n < 2; ++n) acc[a][b][m][n] = (f32x4){0.f, 0.f, 0.f, 0.f};
        cur = nxt; cA = nA; cB = nB; ++ui;
        if constexpr (GATHER) { gc00 = gn00; gc01 = gn01; gc10 = gn10; gc11 = gn11; }
        if (wr == 1) PG8_BAR;
    }
    PG8_WAIT_V(0);
    PG8_BAR;
#undef PG8_GOFF
#undef PG8_SA
#undef PG8_SB
#undef PG8_STAGE
#undef PG8_STB
#undef PG8_STA
#undef PG8_LDA
#undef PG8_LDB
#undef PG8_MMA
#undef PG8_WAIT_V
#undef PG8_WAIT_L
#undef PG8_BAR
#undef PG8_SCHED
}
}

#define EPI_ROWS_BEGIN _Pragma("unroll") for (int ai = 0; ai < 2; ++ai) _Pragma("unroll") for (int m = 0; m < 4; ++m) { const unsigned row = (unsigned)(u.pm * 256 + ai * 128 + wr * 64 + m * 16 + fr);
#define EPI_ROWS_END asm volatile("" ::: "memory"); }
__device__ __forceinline__ void st16(void* base, unsigned off, u32x4 v) { *(u32x4*)((char*)base + off) = v; }
struct EpiInProj {
    static constexpr bool PERM = true;
    bf16* CQ; bf16* CKV; bf16* KRC; float* FL; bf16* FQ; bf16* CI; float* RSQ; const float* COS; const float* SIN; LAS unsigned* NT2;
    __device__ __forceinline__ void operator()(const f32x4 (&acc)[2][2][4][2], const pg8::Unit& u, int wr, int wc, int fr, int fq) const {
        const int t = u.pn; const unsigned c8 = (unsigned)(wc * 32 + 8 * fq);
        if (t != 1) {
            bf16* base; unsigned ld;
            if (t >= 5) {
                bf16* hb = CI + (t - 5) * 128;
                EPI_ROWS_BEGIN
                    f32x4 a0 = acc[ai][0][m][0], a1 = acc[ai][0][m][1]; const f32x4 g0 = acc[ai][1][m][0], g1 = acc[ai][1][m][1];
#pragma unroll
                    for (int j = 0; j < 4; ++j) { a0[j] *= sigmoidf_(g0[j]); a1[j] *= sigmoidf_(g1[j]); }
                    st16(hb, (row * 256u + c8) * 2u, pack8(a0, a1));
                EPI_ROWS_END
                return;
            }
            if (t == 0) { base = CQ; ld = 256; } else { base = FQ + (size_t)(t - 2) * M * 256; ld = 256; }
            float nmx0 = 0.f, nmx1 = 0.f;
            EPI_ROWS_BEGIN
                const unsigned off = (row * ld + c8) * 2u;
                st16(base, off, pack8(acc[ai][0][m][0], acc[ai][0][m][1]));
                st16(base, off + 256u, pack8(acc[ai][1][m][0], acc[ai][1][m][1]));
                if (t == 2 || t == 3) {
                    const f32x4 a = acc[ai][0][m][0], b = acc[ai][0][m][1], c = acc[ai][1][m][0], d = acc[ai][1][m][1];
                    float s0 = ((a[0] * a[0] + a[1] * a[1]) + (a[2] * a[2] + a[3] * a[3])) + ((b[0] * b[0] + b[1] * b[1]) + (b[2] * b[2] + b[3] * b[3]));
                    float s1 = ((c[0] * c[0] + c[1] * c[1]) + (c[2] * c[2] + c[3] * c[3])) + ((d[0] * d[0] + d[1] * d[1]) + (d[2] * d[2] + d[3] * d[3]));
                    s0 += lane_xor<16>(s0); s0 += lane_xor<32>(s0); s1 += lane_xor<16>(s1); s1 += lane_xor<32>(s1);
                    nmx0 = __builtin_fmaxf(nmx0, s0); nmx1 = __builtin_fmaxf(nmx1, s1);
                }
                if (t == 0) {
                    const f32x4 a = acc[ai][0][m][0], b = acc[ai][0][m][1], c = acc[ai][1][m][0], d = acc[ai][1][m][1];
                    float ss = ((a[0] * a[0] + a[1] * a[1]) + (a[2] * a[2] + a[3] * a[3])) + ((b[0] * b[0] + b[1] * b[1]) + (b[2] * b[2] + b[3] * b[3]))
                             + ((c[0] * c[0] + c[1] * c[1]) + (c[2] * c[2] + c[3] * c[3])) + ((d[0] * d[0] + d[1] * d[1]) + (d[2] * d[2] + d[3] * d[3]));
                    ss += lane_xor<16>(ss); ss += lane_xor<32>(ss);
                    if (fq == 0) *(float*)((char*)RSQ + (row * 8u + (unsigned)wc) * 4u) = ss;
                }
            EPI_ROWS_END
            if (t == 2 || t == 3) {
                nmx0 = __builtin_fmaxf(nmx0, lane_xor<1>(nmx0)); nmx0 = __builtin_fmaxf(nmx0, lane_xor<2>(nmx0)); nmx0 = __builtin_fmaxf(nmx0, lane_xor<4>(nmx0)); nmx0 = __builtin_fmaxf(nmx0, lane_xor<8>(nmx0));
                nmx1 = __builtin_fmaxf(nmx1, lane_xor<1>(nmx1)); nmx1 = __builtin_fmaxf(nmx1, lane_xor<2>(nmx1)); nmx1 = __builtin_fmaxf(nmx1, lane_xor<4>(nmx1)); nmx1 = __builtin_fmaxf(nmx1, lane_xor<8>(nmx1));
                if (fr == 0 && fq == 0) { const int bb = (u.pm * 256) >> 12, hf = wc & 1, qk = t - 2;
                    atomicMax((unsigned*)&NT2[((bb * 4 + (wc >> 1)) * 2 + hf) * 2 + qk], __float_as_uint(nmx0));
                    atomicMax((unsigned*)&NT2[((bb * 4 + 2 + (wc >> 1)) * 2 + hf) * 2 + qk], __float_as_uint(nmx1)); }
            }
        } else {
            float krmx = 0.f;
            EPI_ROWS_BEGIN
                const unsigned off = (row * 256u + c8) * 2u;
                st16(CKV, off, pack8(acc[ai][0][m][0], acc[ai][0][m][1]));
                { const f32x4 a = acc[ai][0][m][0], b = acc[ai][0][m][1];
                  float ss = ((a[0] * a[0] + a[1] * a[1]) + (a[2] * a[2] + a[3] * a[3])) + ((b[0] * b[0] + b[1] * b[1]) + (b[2] * b[2] + b[3] * b[3]));
                  ss += lane_xor<16>(ss); ss += lane_xor<32>(ss);
                  if (fq == 0) *(float*)((char*)RSQ + (row * 8u + 4u + (unsigned)wc) * 4u) = ss; }
                if (c8 < 32) {
                    const unsigned to = (row * 16u + (c8 >> 1)) * 4u;
                    const f32x4 c = *(const f32x4*)((const char*)COS + to), s = *(const f32x4*)((const char*)SIN + to), a = acc[ai][1][m][0], b = acc[ai][1][m][1];
                    const f32x4 v0 = (f32x4){a[0] * c[0] - a[2] * s[0], a[1] * c[1] - a[3] * s[1], a[0] * s[0] + a[2] * c[0], a[1] * s[1] + a[3] * c[1]};
                    const f32x4 v1 = (f32x4){b[0] * c[2] - b[2] * s[2], b[1] * c[3] - b[3] * s[3], b[0] * s[2] + b[2] * c[2], b[1] * s[3] + b[3] * c[3]};
                    st16(KRC, (row * 32u + c8) * 2u, pack8(v0, v1));
                    float sk = ((v0[0] * v0[0] + v0[1] * v0[1]) + (v0[2] * v0[2] + v0[3] * v0[3])) + ((v1[0] * v1[0] + v1[1] * v1[1]) + (v1[2] * v1[2] + v1[3] * v1[3]));
                    sk += lane_xor<16>(sk); sk += lane_xor<32>(sk); krmx = __builtin_fmaxf(krmx, sk);
                }
                else if (c8 == 32) { *(f32x4*)((char*)FL + row * 16u) = acc[ai][1][m][0]; }
            EPI_ROWS_END
            if (wc == 0) {
                krmx = __builtin_fmaxf(krmx, lane_xor<1>(krmx)); krmx = __builtin_fmaxf(krmx, lane_xor<2>(krmx)); krmx = __builtin_fmaxf(krmx, lane_xor<4>(krmx)); krmx = __builtin_fmaxf(krmx, lane_xor<8>(krmx));
                if (fr == 0 && fq == 0) atomicMax((unsigned*)&NT2[128 + ((u.pm * 256) >> 12)], __float_as_uint(krmx));
            }
        }
    }
};
struct EpiQKV {
    static constexpr bool PERM = true;
    bf16* QM; bf16* KM; bf16* VM; const float* COS; const float* SIN; const float* RSQ; LAS unsigned* NTK;
    __device__ __forceinline__ void operator()(const f32x4 (&acc)[2][2][4][2], const pg8::Unit& u, int wr, int wc, int fr, int fq) const {
        const int t = u.pn; const unsigned c8 = (unsigned)(wc * 32 + 8 * fq);
        float rf[8];
#pragma unroll
        for (int i = 0; i < 8; ++i) { const unsigned row = (unsigned)(u.pm * 256 + (i >> 2) * 128 + wr * 64 + (i & 3) * 16 + fr);
            const f32x4 p = *(const f32x4*)((const char*)RSQ + (row * 8u + (t < 3 ? 0u : 4u)) * 4u); rf[i] = (p[0] + p[1]) + (p[2] + p[3]); }
#pragma unroll
        for (int i = 0; i < 8; ++i) rf[i] = 1.0f / sqrtf(rf[i] * (t < 3 ? 1.0f / 256 : 1.0f / 128) + EPS);
        if (t < 3) {
#pragma unroll
            for (int bj = 0; bj < 2; ++bj) {
                const unsigned col = (unsigned)(t * 256 + bj * 128) + c8, h = col / 96u, d = col - h * 96u;
                const bool rope = d >= 64; const unsigned f4 = rope ? ((d - 64) >> 1) : 0u;
#pragma unroll
                for (int ai = 0; ai < 2; ++ai) {
                    f32x4 cc[4], ss[4];
                    if (rope) {
#pragma unroll
                        for (int m = 0; m < 4; ++m) { const unsigned to = ((unsigned)(u.pm * 256 + ai * 128 + wr * 64 + m * 16 + fr) * 16u + f4) * 4u;
                            cc[m] = *(const f32x4*)((const char*)COS + to); ss[m] = *(const f32x4*)((const char*)SIN + to); }
                    }
#pragma unroll
                    for (int m = 0; m < 4; ++m) { const unsigned row = (unsigned)(u.pm * 256 + ai * 128 + wr * 64 + m * 16 + fr);
                        f32x4 v0 = acc[ai][bj][m][0] * rf[ai * 4 + m], v1 = acc[ai][bj][m][1] * rf[ai * 4 + m];
                        if (rope) {
                            const f32x4 c = cc[m], s = ss[m], a = v0, b = v1;
                            v0 = (f32x4){a[0] * c[0] - a[2] * s[0], a[1] * c[1] - a[3] * s[1], a[0] * s[0] + a[2] * c[0], a[1] * s[1] + a[3] * c[1]};
                            v1 = (f32x4){b[0] * c[2] - b[2] * s[2], b[1] * c[3] - b[3] * s[3], b[0] * s[2] + b[2] * c[2], b[1] * s[3] + b[3] * c[3]};
                        }
                        st16(QM, (row * 768u + col) * 2u, pack8(v0, v1));
                    }
                    asm volatile("" ::: "memory");
                }
            }
        } else if (t < 5) {
#pragma unroll
            for (int bj = 0; bj < 2; ++bj) {
                const unsigned kc = (unsigned)((t - 3) * 256 + bj * 128) + c8, h = kc >> 6, d = kc & 63;
                float knmx = 0.f;
                EPI_ROWS_BEGIN
                    const f32x4 a = acc[ai][bj][m][0] * rf[ai * 4 + m], b = acc[ai][bj][m][1] * rf[ai * 4 + m];
                    st16(KM, (row * 768u + h * 96u + d) * 2u, pack8(a, b));
                    float sk = ((a[0] * a[0] + a[1] * a[1]) + (a[2] * a[2] + a[3] * a[3])) + ((b[0] * b[0] + b[1] * b[1]) + (b[2] * b[2] + b[3] * b[3]));
                    sk += lane_xor<16>(sk); sk += lane_xor<32>(sk); knmx = __builtin_fmaxf(knmx, sk);
                EPI_ROWS_END
                knmx = __builtin_fmaxf(knmx, lane_xor<1>(knmx)); knmx = __builtin_fmaxf(knmx, lane_xor<2>(knmx)); knmx = __builtin_fmaxf(knmx, lane_xor<4>(knmx)); knmx = __builtin_fmaxf(knmx, lane_xor<8>(knmx));
                if (fr == 0 && fq == 0) atomicMax((unsigned*)&NTK[((((u.pm * 256) >> 12) * 8 + (int)h) * 2 + (int)((kc >> 5) & 1u))], __float_as_uint(knmx));
            }
        } else {
#pragma unroll
            for (int bj = 0; bj < 2; ++bj) {
                const unsigned vc = (unsigned)((t - 5) * 256 + bj * 128) + c8;
                EPI_ROWS_BEGIN
                    st16(VM, (row * 512u + vc) * 2u, pack8(acc[ai][bj][m][0] * rf[ai * 4 + m], acc[ai][bj][m][1] * rf[ai * 4 + m]));
                EPI_ROWS_END
            }
        }
    }
};
template <int LDC, bool SCALE>
struct EpiBf16 {
    static constexpr bool PERM = true;
    bf16* O; int ntn; const float* rowscale;
    __device__ __forceinline__ void operator()(const f32x4 (&acc)[2][2][4][2], const pg8::Unit& u, int wr, int wc, int fr, int fq) const {
        const unsigned col = (unsigned)((u.pn % ntn) * 256 + wc * 32 + 8 * fq);
        float sc8[8];
        if constexpr (SCALE) {
#pragma unroll
            for (int i = 0; i < 8; ++i) sc8[i] = *(const float*)((const char*)rowscale + (unsigned)(u.pm * 256 + (i >> 2) * 128 + wr * 64 + (i & 3) * 16 + fr) * 4u);
        }
        EPI_ROWS_BEGIN
            float s = 1.0f; if constexpr (SCALE) s = sc8[ai * 4 + m];
            const unsigned off = (row * (unsigned)LDC + col) * 2u;
            st16(O, off, pack8(acc[ai][0][m][0] * s, acc[ai][0][m][1] * s));
            st16(O, off + 256u, pack8(acc[ai][1][m][0] * s, acc[ai][1][m][1] * s));
        EPI_ROWS_END
    }
};
template <int LDH>
struct EpiSwiGLU {
    static constexpr bool PERM = true;
    bf16* H; int ntn;
    __device__ __forceinline__ void operator()(const f32x4 (&acc)[2][2][4][2], const pg8::Unit& u, int wr, int wc, int fr, int fq) const {
        const unsigned col = (unsigned)((u.pn % ntn) * 128 + wc * 32 + 8 * fq);
        EPI_ROWS_BEGIN
            f32x4 a0 = acc[ai][0][m][0], a1 = acc[ai][0][m][1]; const f32x4 b0 = acc[ai][1][m][0], b1 = acc[ai][1][m][1];
#pragma unroll
            for (int j = 0; j < 4; ++j) { a0[j] = a0[j] * frcp(1.0f + fexp2(-a0[j])) * b0[j]; a1[j] = a1[j] * frcp(1.0f + fexp2(-a1[j])) * b1[j]; }
            st16(H, (row * (unsigned)LDH + col) * 2u, pack8(a0, a1));
        EPI_ROWS_END
    }
};
struct MoeOrder {
    const bf16* A; const bf16* Bt; int lda, ldb, nM, nN, G, c, rep; const int* slot_tok; int s1, s2, s3, s4, s5, s6, s7;
    __device__ __forceinline__ int expert_of(int rt) const { const int r = rt * 256; return (r >= s1) + (r >= s2) + (r >= s3) + (r >= s4) + (r >= s5) + (r >= s6) + (r >= s7); }
    __device__ __forceinline__ bool next(int i, pg8::Unit& u) const { int pm, pn; if (!pg8::tile_order_rep(i, G, c, nM, nN, rep, pm, pn)) return false; u.pm = pm; u.pn = expert_of(pm) * nN + pn; return true; }
    __device__ __forceinline__ const char* a_base(const pg8::Unit& u) const { return slot_tok ? (const char*)A : (const char*)A + (size_t)u.pm * 256 * lda * 2; }
    __device__ __forceinline__ const char* b_base(const pg8::Unit& u) const { return (const char*)Bt + (size_t)u.pn * 256 * ldb * 2; }
    __device__ __forceinline__ int tok(const pg8::Unit& u, int r) const { return slot_tok[u.pm * 256 + r]; }
    __device__ __forceinline__ int ktiles(const pg8::Unit&, int nt) const { return nt; }
};

template <int NN>
struct MoeIdxOrder {
    const bf16* A; const bf16* Bt; int lda, ldb, first, stride, end; const int* slot_tok; int s1, s2, s3, s4, s5, s6, s7;
    __device__ __forceinline__ int expert_of(int rt) const { const int r = rt * 256; return (r >= s1) + (r >= s2) + (r >= s3) + (r >= s4) + (r >= s5) + (r >= s6) + (r >= s7); }
    __device__ __forceinline__ bool next(int i, pg8::Unit& u) const { const int idx = first + i * stride; if (idx >= end) return false; const int pm = idx / NN; u.pm = pm; u.pn = expert_of(pm) * NN + (idx - pm * NN); return true; }
    __device__ __forceinline__ const char* a_base(const pg8::Unit& u) const { return slot_tok ? (const char*)A : (const char*)A + (size_t)u.pm * 256 * lda * 2; }
    __device__ __forceinline__ const char* b_base(const pg8::Unit& u) const { return (const char*)Bt + (size_t)u.pn * 256 * ldb * 2; }
    __device__ __forceinline__ int tok(const pg8::Unit& u, int r) const { return slot_tok[u.pm * 256 + r]; }
    __device__ __forceinline__ int ktiles(const pg8::Unit&, int nt) const { return nt; }
};

namespace att {
__device__ __forceinline__ int crow(int r, int hi) { return (r & 3) + 8 * (r >> 2) + 4 * hi; }
__device__ __forceinline__ s16x4 vtr(const LAS unsigned char* p) { typedef short v4i16_t __attribute__((ext_vector_type(4))); return __builtin_bit_cast(s16x4, __builtin_amdgcn_ds_read_tr16_b64_v4i16((LAS v4i16_t*)p)); }
#define ATT_WAITBAR() asm volatile("s_waitcnt vmcnt(0) lgkmcnt(0)\n\ts_barrier" ::: "memory")
__device__ __forceinline__ void glds16(const void* gsrc, unsigned lds_dst) { unsigned keep;
    asm volatile("s_mov_b32 %0, m0\n\ts_mov_b32 m0, %2\n\ts_nop 0\n\tglobal_load_lds_dwordx4 %1, off\n\ts_mov_b32 m0, %0" : "=&s"(keep) : "v"(gsrc), "s"(lds_dst) : "memory"); }

#define MX3(a, b, c) __builtin_fmaxf(__builtin_fmaxf((a), (b)), (c))
template <int DQK> struct AttLds { static constexpr int NCH = DQK / 8, KSLOT = NCH * 1024, ND0 = DQK / 16, LK = 0, LV = 3 * KSLOT, LOST = LV + 3 * 8192, LCUM = LOST + NWAVES * 4608, END = LCUM + SEQ * 4; };

template <int DQK>
__device__ __forceinline__ void att_qk(f32x16& n0, f32x16& n1, const bf16x8 (&qr)[DQK / 16], const LAS unsigned char* kp) {
    constexpr int ND0 = DQK / 16;
    bf16x8 kf[2 * ND0];
#pragma unroll
    for (int d0 = 0; d0 < ND0; ++d0) { kf[2 * d0] = *(const LAS bf16x8*)(kp + d0 * 2048); kf[2 * d0 + 1] = *(const LAS bf16x8*)(kp + d0 * 2048 + 512); }
    n0 = (f32x16){}; n1 = (f32x16){};
#pragma unroll
    for (int d0 = 0; d0 < ND0; ++d0) {
        n0 = __builtin_amdgcn_mfma_f32_32x32x16_bf16(kf[2 * d0], qr[d0], n0, 0, 0, 0);
        n1 = __builtin_amdgcn_mfma_f32_32x32x16_bf16(kf[2 * d0 + 1], qr[d0], n1, 0, 0, 0);
    }
}
template <bool BIAS, bool MASK>
__device__ __forceinline__ void att_bias_mask(f32x16& n0, f32x16& n1, int t, int NT, int qrel, int hi, float fqb, const LAS float* cumL) {
    if constexpr (BIAS) {
#pragma unroll
        for (int g = 0; g < 4; ++g) {
            const f32x4 f0 = *(const LAS f32x4*)(cumL + t * 64 + 8 * g + 4 * hi), f1 = *(const LAS f32x4*)(cumL + t * 64 + 32 + 8 * g + 4 * hi);
#pragma unroll
            for (int j = 0; j < 4; ++j) { n0[4 * g + j] += fqb - f0[j]; n1[4 * g + j] += fqb - f1[j]; }
        }
    }
    if constexpr (MASK) {
        const int kb = 64 * (t - (NT - 4)) + 4 * hi;
#pragma unroll
        for (int r = 0; r < 16; ++r) { const int kv = kb + (r & 3) + 8 * (r >> 2); if (kv > qrel) n0[r] = -INFINITY; if (kv + 32 > qrel) n1[r] = -INFINITY; }
    }
}
template <int DQK, bool BIAS, bool MASK, bool MORE, bool NOMAX = false>
__device__ __forceinline__ void att_step(f32x16& s0, f32x16& s1, f32x16& n0, f32x16& n1, f32x16& o0, f32x16& o1, float& mrow, float& lrow, const bf16x8 (&qr)[DQK / 16],
                                         int t, int NT, int qrel, int lane, int hi, int r32, float fqb, const LAS unsigned char* shm, int vslot, int kslot) {
    typedef AttLds<DQK> L;
    constexpr int ND0 = DQK / 16;
    const LAS unsigned char* vp = shm + L::LV + vslot * 8192 + ((lane >> 4) & 1) * 32 + (lane & 3) * 8 + (4 * hi + ((lane & 15) >> 2)) * 64;
    const LAS unsigned char* kp = shm + L::LK + kslot * L::KSLOT + hi * 1024 + r32 * 16;
    bf16x8 kf[2 * ND0];
    if constexpr (MORE) {
#pragma unroll
        for (int d0 = 0; d0 < ND0; ++d0) { kf[2 * d0] = *(const LAS bf16x8*)(kp + d0 * 2048); kf[2 * d0 + 1] = *(const LAS bf16x8*)(kp + d0 * 2048 + 512); }
    }
    if constexpr (!NOMAX) {
    float a = MX3(s0[0], s0[1], s1[0]), b = MX3(s0[2], s0[3], s1[1]); a = MX3(a, s1[2], s1[3]);
#pragma unroll
    for (int r = 4; r < 16; r += 4) { a = MX3(a, s0[r], s0[r + 1]); b = MX3(b, s0[r + 2], s0[r + 3]); a = MX3(a, s1[r], s1[r + 1]); b = MX3(b, s1[r + 2], s1[r + 3]); }
    float rm = __builtin_fmaxf(a, b);
    { auto rr = __builtin_amdgcn_permlane32_swap(__float_as_uint(rm), __float_as_uint(rm), false, false); rm = __builtin_fmaxf(__uint_as_float(rr[0]), __uint_as_float(rr[1])); }
    if (__builtin_amdgcn_ballot_w64(rm > mrow + 8.0f) != 0ull) {
        const float mnew = __builtin_fmaxf(mrow, rm), alpha = fexp2(mrow - mnew);
        mrow = mnew; lrow *= alpha;
#pragma unroll
        for (int r = 0; r < 16; ++r) { o0[r] *= alpha; o1[r] *= alpha; }
    }
    }
    if constexpr (MORE) {
        if constexpr (BIAS) {
            const LAS float* cumL = (const LAS float*)(shm + L::LCUM);
#pragma unroll
            for (int g = 0; g < 4; ++g) {
                const f32x4 f0 = *(const LAS f32x4*)(cumL + (t + 1) * 64 + 8 * g + 4 * hi), f1 = *(const LAS f32x4*)(cumL + (t + 1) * 64 + 32 + 8 * g + 4 * hi);
#pragma unroll
                for (int j = 0; j < 4; ++j) { n0[4 * g + j] = fqb - f0[j]; n1[4 * g + j] = fqb - f1[j]; }
            }
        } else { n0 = (f32x16){}; n1 = (f32x16){}; }
#pragma unroll
        for (int d0 = 0; d0 < ND0; ++d0) {
            n0 = __builtin_amdgcn_mfma_f32_32x32x16_bf16(kf[2 * d0], qr[d0], n0, 0, 0, 0);
            n1 = __builtin_amdgcn_mfma_f32_32x32x16_bf16(kf[2 * d0 + 1], qr[d0], n1, 0, 0, 0);
        }
    }
    float ps = 0.f;
#pragma unroll
    for (int r = 0; r < 16; ++r) { if constexpr (NOMAX) { s0[r] = fexp2(s0[r]); s1[r] = fexp2(s1[r]); } else { s0[r] = fexp2(s0[r] - mrow); s1[r] = fexp2(s1[r] - mrow); } ps += s0[r] + s1[r]; }
    lrow += ps;
    if constexpr (NOMAX && MORE && DQK == 96) {
#pragma unroll
        for (int g = 0; g < 2 * ND0; ++g) { __builtin_amdgcn_sched_group_barrier(0x008, 1, 0); __builtin_amdgcn_sched_group_barrier(0x400, 3, 0); }
    }
    __builtin_amdgcn_sched_barrier(0);
    s16x4 vl[8], vh[8];
#pragma unroll
    for (int i = 0; i < 8; ++i) { vl[i] = vtr(vp + (i >> 2) * 4096 + (i & 3) * 1024); vh[i] = vtr(vp + (i >> 2) * 4096 + (i & 3) * 1024 + 512); }
    u32x4 pw[4];
    pw[0] = (u32x4){pk2(s0[0], s0[1]), pk2(s0[2], s0[3]), pk2(s0[4], s0[5]), pk2(s0[6], s0[7])};
    pw[1] = (u32x4){pk2(s0[8], s0[9]), pk2(s0[10], s0[11]), pk2(s0[12], s0[13]), pk2(s0[14], s0[15])};
    pw[2] = (u32x4){pk2(s1[0], s1[1]), pk2(s1[2], s1[3]), pk2(s1[4], s1[5]), pk2(s1[6], s1[7])};
    pw[3] = (u32x4){pk2(s1[8], s1[9]), pk2(s1[10], s1[11]), pk2(s1[12], s1[13]), pk2(s1[14], s1[15])};
#pragma unroll
    for (int ks = 0; ks < 4; ++ks) {
        const bf16x8 v0 = (bf16x8){vl[ks][0], vl[ks][1], vl[ks][2], vl[ks][3], vh[ks][0], vh[ks][1], vh[ks][2], vh[ks][3]};
        const bf16x8 v1 = (bf16x8){vl[4 + ks][0], vl[4 + ks][1], vl[4 + ks][2], vl[4 + ks][3], vh[4 + ks][0], vh[4 + ks][1], vh[4 + ks][2], vh[4 + ks][3]};
        o0 = __builtin_amdgcn_mfma_f32_32x32x16_bf16(v0, __builtin_bit_cast(bf16x8, pw[ks]), o0, 0, 0, 0);
        o1 = __builtin_amdgcn_mfma_f32_32x32x16_bf16(v1, __builtin_bit_cast(bf16x8, pw[ks]), o1, 0, 0, 0);
    }
    if constexpr (MORE) att_bias_mask<false, MASK>(n0, n1, t + 1, NT, qrel, hi, fqb, (const LAS float*)(shm + L::LCUM));
}

template <int DQK, bool BIAS>
__device__ __forceinline__ void attn_unit(int b, int h, int qb, const bf16* Q, int pq, const bf16* K, int pk, const bf16* V, int pv,
                                          bf16* O, int po, int ocol, const float* cum, LAS unsigned char* shm, const int tid_in, float* ssqp, int hidx, const unsigned* qkmax, const bf16* KRC = nullptr, float kmax2 = 3.0e38f) {
    int tid = tid_in; asm volatile("" : "+v"(tid));
    typedef AttLds<DQK> L;
    constexpr int NCH = L::NCH, KSLOT = L::KSLOT, ND0 = L::ND0, LK = L::LK, LV = L::LV, LOST = L::LOST;
    static_assert(L::END <= RING_BYTES, "attention LDS");
    const int lane = tid & 63, r32 = lane & 31, hi = lane >> 5; const int wid = __builtin_amdgcn_readfirstlane(tid >> 6);
    const long rowbase = (long)b * SEQ; const int q0 = qb * 256;
    const bf16* Qw = Q + (rowbase + q0 + wid * 32) * pq + h * DQK;
    const bf16* Kh = K + rowbase * pk + h * DQK; const bf16* Vh = V + rowbase * pv + h * 64;
    const int NT = (q0 + 256) / 64;
    LAS float* cumL = (LAS float*)(shm + L::LCUM);
    const bf16* ksrc = Kh + (long)lane * pk + wid * 8;
    const bf16* krsrc = KRC + (rowbase + lane) * 32 + (wid & 3) * 8;
    const bf16* vsrc = Vh + (long)(16 * (wid & 3) + (lane >> 2)) * pv + (wid >> 2) * 32 + (lane & 3) * 8;
    const unsigned lds0 = (unsigned)(size_t)shm;
#define ATT_DMA_K(t, slot) do { \
        glds16(ksrc + (long)(t) * 64 * pk, (unsigned)__builtin_amdgcn_readfirstlane((int)(lds0 + LK + (slot) * KSLOT + wid * 1024))); \
        if (NCH > 8 && wid + 8 < NCH) glds16(krsrc + (long)(t) * 64 * 32, (unsigned)__builtin_amdgcn_readfirstlane((int)(lds0 + LK + (slot) * KSLOT + (wid + 8) * 1024))); } while (0)
#define ATT_DMA_V(t, slot) glds16(vsrc + (long)(t) * 64 * pv, (unsigned)__builtin_amdgcn_readfirstlane((int)(lds0 + LV + (slot) * 8192 + wid * 1024)))
    const int nK = (NCH > 8 && wid + 8 < NCH) ? 2 : 1;
#define ATT_WAITBAR_N(n) do { const int n_ = (n); if (n_ == 0) asm volatile("s_waitcnt vmcnt(0) lgkmcnt(0)\n\ts_barrier" ::: "memory"); else if (n_ == 1) asm volatile("s_waitcnt vmcnt(1) lgkmcnt(0)\n\ts_barrier" ::: "memory"); \
        else if (n_ == 2) asm volatile("s_waitcnt vmcnt(2) lgkmcnt(0)\n\ts_barrier" ::: "memory"); else asm volatile("s_waitcnt vmcnt(3) lgkmcnt(0)\n\ts_barrier" ::: "memory"); } while (0)
    int tb = 0;
    if constexpr (BIAS) {
        const float qk = sqrtf((__uint_as_float(qkmax[0]) + __uint_as_float(qkmax[2])) * (__uint_as_float(qkmax[1]) + __uint_as_float(qkmax[3]))) * 1.01f + 1.0f, thr = -(150.0f + 2.0f * qk);
        const float* cs = cum + (size_t)(b * 4 + h) * SEQ; const float f0 = cs[q0]; const float fj = lane < NT ? cs[64 * lane + 63] : f0;
        const unsigned long long keep = __builtin_amdgcn_ballot_w64(lane < NT && (f0 - fj) >= thr);
        tb = keep ? (int)__builtin_ctzll(keep) : NT - 4; if (tb > NT - 4) tb = NT - 4;
        tb = __builtin_amdgcn_readfirstlane(tb);
    }
    ATT_DMA_K(tb, 0); ATT_DMA_V(tb, 0); ATT_DMA_K(tb + 1, 1);
    bf16x8 qr[ND0];
#pragma unroll
    for (int d0 = 0; d0 < ND0; ++d0) qr[d0] = *(const bf16x8*)(Qw + (long)r32 * pq + d0 * 16 + hi * 8);
    float mrow = -1e30f, lrow = 0.f; f32x16 o0 = {}, o1 = {};
    const int qrel = wid * 32 + r32;
    if constexpr (BIAS) { const float* cs = cum + (size_t)(b * 4 + h) * SEQ; for (int i = tid * 4; i < q0 + 256; i += NTHR * 4) *(LAS f32x4*)(cumL + i) = *(const f32x4*)(cs + i); }
    ATT_WAITBAR();
#pragma unroll
    for (int d0 = 0; d0 < ND0; ++d0) asm volatile("" : "+v"(qr[d0]));
    ATT_DMA_K(tb + 2, 2); ATT_DMA_V(tb + 1, 1);
    float fqb = 0.f; if constexpr (BIAS) fqb = cumL[q0 + qrel];
    f32x16 s0, s1;
    att_qk<DQK>(s0, s1, qr, shm + LK + hi * 1024 + r32 * 16);
    asm volatile("s_waitcnt lgkmcnt(0)\n\ts_barrier" ::: "memory");
    if (tb == NT - 4) att_bias_mask<BIAS, true>(s0, s1, tb, NT, qrel, hi, fqb, cumL); else att_bias_mask<BIAS, false>(s0, s1, tb, NT, qrel, hi, fqb, cumL);
    int t = tb, sl0 = 0, sl1 = 1, sl2 = 2;
#define ATT_ROT() do { const int x_ = sl0; sl0 = sl1; sl1 = sl2; sl2 = x_; } while (0)
    f32x16 u0, u1;
    bool fast;
    { float qn = 0.f;
#pragma unroll
      for (int d0 = 0; d0 < ND0; ++d0)
#pragma unroll
          for (int e = 0; e < 8; ++e) { const float v = __uint_as_float((unsigned)(unsigned short)qr[d0][e] << 16); qn += v * v; }
      { auto rr = __builtin_amdgcn_permlane32_swap(__float_as_uint(qn), __float_as_uint(qn), false, false); qn = __uint_as_float(rr[0]) + __uint_as_float(rr[1]); }
      float k2 = kmax2; if constexpr (BIAS) k2 = __uint_as_float(qkmax[1]) + __uint_as_float(qkmax[3]);
      const float bound = sqrtf(qn * k2) * 1.02f + 1.0f;
      fast = __builtin_amdgcn_ballot_w64(!(bound <= 90.0f)) == 0ull; }
#define ATT_MAIN_LOOPS(NM_) do { \
    for (; t + 1 < NT - 5; t += 2) { \
        ATT_DMA_K(t + 3, sl0); ATT_DMA_V(t + 2, sl2); \
        att_step<DQK, BIAS, false, true, NM_>(s0, s1, u0, u1, o0, o1, mrow, lrow, qr, t, NT, qrel, lane, hi, r32, fqb, shm, sl0, sl1); \
        ATT_WAITBAR_N(nK + 1); ATT_ROT(); \
        ATT_DMA_K(t + 4, sl0); ATT_DMA_V(t + 3, sl2); \
        att_step<DQK, BIAS, false, true, NM_>(u0, u1, s0, s1, o0, o1, mrow, lrow, qr, t + 1, NT, qrel, lane, hi, r32, fqb, shm, sl0, sl1); \
        ATT_WAITBAR_N(nK + 1); ATT_ROT(); \
    } \
    for (; t < NT - 5; ++t) { \
        ATT_DMA_K(t + 3, sl0); ATT_DMA_V(t + 2, sl2); \
        att_step<DQK, BIAS, false, true, NM_>(s0, s1, u0, u1, o0, o1, mrow, lrow, qr, t, NT, qrel, lane, hi, r32, fqb, shm, sl0, sl1); \
        s0 = u0; s1 = u1; \
        ATT_WAITBAR_N(nK + 1); ATT_ROT(); \
    } \
    for (; t < NT - 1; ++t) { \
        int nis = 0; \
        if (t + 3 < NT) { ATT_DMA_K(t + 3, sl0); nis += nK; } \
        if (t + 2 < NT) { ATT_DMA_V(t + 2, sl2); nis += 1; } \
        const int jbc = t - (NT - 4); const bool docur = !(jbc >= 0 && 2 * jbc > wid), donext = !(2 * (jbc + 1) > wid); \
        if (docur && donext) { att_step<DQK, BIAS, true, true, NM_>(s0, s1, u0, u1, o0, o1, mrow, lrow, qr, t, NT, qrel, lane, hi, r32, fqb, shm, sl0, sl1); s0 = u0; s1 = u1; } \
        else if (docur) att_step<DQK, BIAS, false, false, NM_>(s0, s1, u0, u1, o0, o1, mrow, lrow, qr, t, NT, qrel, lane, hi, r32, fqb, shm, sl0, sl1); \
        ATT_WAITBAR_N(nis); ATT_ROT(); \
    } \
    if (!(2 * 3 > wid)) att_step<DQK, BIAS, false, false, NM_>(s0, s1, u0, u1, o0, o1, mrow, lrow, qr, t, NT, qrel, lane, hi, r32, fqb, shm, sl0, sl1); \
    } while (0)
    if (fast) ATT_MAIN_LOOPS(true); else ATT_MAIN_LOOPS(false);
#undef ATT_MAIN_LOOPS
#undef ATT_ROT
#undef ATT_WAITBAR_N
    { auto rr = __builtin_amdgcn_permlane32_swap(__float_as_uint(lrow), __float_as_uint(lrow), false, false); lrow = __uint_as_float(rr[0]) + __uint_as_float(rr[1]); }
    const float rl = frcp(lrow);
    { float ssq = 0.f;
#pragma unroll
      for (int r = 0; r < 16; ++r) { const float a = o0[r] * rl, b2 = o1[r] * rl; ssq += a * a + b2 * b2; }
      auto rr = __builtin_amdgcn_permlane32_swap(__float_as_uint(ssq), __float_as_uint(ssq), false, false); ssq = __uint_as_float(rr[0]) + __uint_as_float(rr[1]);
      if (hi == 0) ssqp[(size_t)(rowbase + q0 + wid * 32 + r32) * 12 + hidx] = ssq; }
    LAS unsigned char* stg = shm + LOST + wid * 4608;
#pragma unroll
    for (int g = 0; g < 4; ++g) {
        *(LAS u32x2*)(stg + r32 * 144 + (8 * g + 4 * hi) * 2) = (u32x2){pk2(o0[4 * g] * rl, o0[4 * g + 1] * rl), pk2(o0[4 * g + 2] * rl, o0[4 * g + 3] * rl)};
        *(LAS u32x2*)(stg + r32 * 144 + (32 + 8 * g + 4 * hi) * 2) = (u32x2){pk2(o1[4 * g] * rl, o1[4 * g + 1] * rl), pk2(o1[4 * g + 2] * rl, o1[4 * g + 3] * rl)};
    }
    asm volatile("s_waitcnt lgkmcnt(0)" ::: "memory");
    bf16* Ow = O + (rowbase + q0 + wid * 32) * po + ocol;
#pragma unroll
    for (int i = 0; i < 4; ++i) { const int row = i * 8 + (lane >> 3), ch = lane & 7; const u32x4 v = *(const LAS u32x4*)(stg + row * 144 + ch * 16); *(u32x4*)(Ow + (long)row * po + ch * 8) = v; }
    asm volatile("s_waitcnt lgkmcnt(0)\n\ts_barrier" ::: "memory");
#undef ATT_DMA_K
#undef ATT_DMA_V
}
}

struct Args { const float* in[26]; float* out; unsigned char* ws; int ph_lo, ph_hi; };
typedef const __attribute__((address_space(4))) Args* kargs_t;
struct Ctx {
    LAS unsigned char* lds; unsigned* ctl; unsigned char* ws; float* out;
    int tid, lane, wave, vcu, G, gw, NGW, bx;
};
__device__ __forceinline__ kargs_t opaque_args() { kargs_t p = (kargs_t)__builtin_amdgcn_kernarg_segment_ptr(); asm volatile("" : "+s"(p)); return p; }
__device__ __forceinline__ Ctx make_ctx(kargs_t A, LAS unsigned char* lds, int wave0) {
    Ctx C; unsigned ones = ~0u; asm volatile("" : "+s"(ones));
    int t = wave0 * 64 + (int)__builtin_amdgcn_mbcnt_hi(ones, __builtin_amdgcn_mbcnt_lo(ones, 0u)); asm volatile("" : "+v"(t));
    C.lds = lds; C.ws = A->ws; C.ctl = (unsigned*)(C.ws + WS_CTL); C.out = A->out;
    C.tid = t; C.lane = t & 63; C.wave = __builtin_amdgcn_readfirstlane(t >> 6);
    { int g_ = gridDim.x, b_ = blockIdx.x; asm volatile("" : "+s"(g_), "+s"(b_)); C.G = g_; C.bx = b_; } C.vcu = (C.bx % 8) * (C.G / 8) + C.bx / 8;
    C.gw = C.vcu * NWAVES + C.wave; C.NGW = C.G * NWAVES;
    return C;
}
#define LDS_WAIT() asm volatile("s_waitcnt lgkmcnt(0)" ::: "memory")

struct MapWin { __device__ __forceinline__ int row(int n) const {
        if (n < 256) return PC_CQ + n; if (n < 384) return PC_CKV + (n - 256); if (n < 416) { const int i = n - 384; return PC_KR + ((i < 16) ? (4 * (i >> 1) + (i & 1)) : (4 * ((i - 16) >> 1) + 2 + (i & 1))); }
        if (n < 928) return PC_FK + (n - 672); if (n < 1184) return PC_FV + (n - 928); if (n < 1188) return PC_FL + (n - 1184);
        { const int c = n - 1188, ch = c & 255; return PC_CI + (ch >> 7) * 256 + (c >> 8) * 128 + (ch & 127); } }
    __device__ __forceinline__ float scale(int, int n) const { return (n >= 416 && n < 672) ? C2_FOX : 1.0f; } };
struct MapUq { const float* g; __device__ __forceinline__ int row(int n) const { const int h = n / 96, d = n - h * 96; if (d < 64) return n; const int i = d - 64;
        const int s = (i < 16) ? (4 * (i >> 1) + (i & 1)) : (4 * ((i - 16) >> 1) + 2 + (i & 1)); return h * 96 + 64 + s; }
    __device__ __forceinline__ float scale(int k, int) const { return g[k] * C2_MLA; } };
struct MapUkv { const float* g; __device__ __forceinline__ int row(int n) const { const int h = n >> 7, d = n & 127; return d < 64 ? (768 + h * 64 + d) : (1280 + h * 64 + (d - 64)); }
    __device__ __forceinline__ float scale(int k, int) const { return g[k]; } };
struct MapWout { const float* gm; const float* gf; __device__ __forceinline__ int row(int n) const { return n; }
    __device__ __forceinline__ float scale(int k, int) const { return k < 512 ? gm[k] : (k < 768 ? gf[k - 512] : 1.0f); } };
struct MapW13 { int which; __device__ __forceinline__ int row(int n) const { return (n >> 7) * 256 + which * 128 + (n & 127); }
    __device__ __forceinline__ float scale(int, int) const { return which == 0 ? LOG2E : (1.0f / LOG2E); } };
struct MapId { __device__ __forceinline__ int row(int n) const { return n; } __device__ __forceinline__ float scale(int, int) const { return 1.0f; } };

template <class Map>
__device__ __forceinline__ void transpose_item(const float* W, int Nsrc, bf16* WT, int ldk, LAS float* scr, int kb, int nb, int lane, const Map mp) {
    const int k0 = 64 * kb, n0 = 32 * nb, r8 = lane >> 3, nn = n0 + 4 * (lane & 7); const bool nok = nn < Nsrc;
    f32x4 v[8];
#pragma unroll
    for (int i = 0; i < 8; ++i) { v[i] = (f32x4){0.f, 0.f, 0.f, 0.f}; if (nok) v[i] = *(const f32x4*)(W + (size_t)(k0 + 8 * i + r8) * Nsrc + nn); }
#pragma unroll
    for (int i = 0; i < 8; ++i) { const int kk = 8 * i + r8; LAS float* d = scr + kk * 33 + 4 * (lane & 7);
#pragma unroll
        for (int j = 0; j < 4; ++j) d[j] = v[i][j] * mp.scale(k0 + kk, nn + j); }
    LDS_WAIT(); asm volatile("" ::: "memory");
    const int c = lane & 7;
#pragma unroll
    for (int j = 0; j < 4; ++j) { const int n = (lane >> 3) + 8 * j; const LAS float* s = scr + (8 * c) * 33 + n;
        if (n0 + n < Nsrc) { u32x4 o; o.x = pk2(s[0 * 33], s[1 * 33]); o.y = pk2(s[2 * 33], s[3 * 33]); o.z = pk2(s[4 * 33], s[5 * 33]); o.w = pk2(s[6 * 33], s[7 * 33]);
            *(u32x4*)(WT + (size_t)mp.row(n0 + n) * ldk + k0 + 8 * c) = o; } }
    LDS_WAIT(); asm volatile("" ::: "memory");
}

__device__ __forceinline__ void sincos_acc(float ang, float& c, float& s) {
    const double a = (double)ang, q = __builtin_rint(a * 0.63661977236758134308);
    const double y = (a - q * 1.57079632679489655800) - q * 6.12323399573676603587e-17, y2 = y * y;
    const double sp = y * (1.0 + y2 * (-1.0 / 6 + y2 * (1.0 / 120 + y2 * (-1.0 / 5040 + y2 * (1.0 / 362880 + y2 * (-1.0 / 39916800 + y2 * (1.0 / 6227020800.0)))))));
    const double cp = 1.0 + y2 * (-0.5 + y2 * (1.0 / 24 + y2 * (-1.0 / 720 + y2 * (1.0 / 40320 + y2 * (-1.0 / 3628800 + y2 * (1.0 / 479001600 + y2 * (-1.0 / 87178291200.0)))))));
    const int quad = (int)((long long)q & 3);
    const double ss = (quad == 0) ? sp : (quad == 1) ? cp : (quad == 2) ? -sp : -cp;
    const double cc = (quad == 0) ? cp : (quad == 1) ? -sp : (quad == 2) ? -cp : sp;
    c = (float)cc; s = (float)ss;
}
__device__ __forceinline__ float inv_freq(int f) {
    const int a = f >> 2, b = f & 3;
    const float p = (a == 0) ? 1.0f : (a == 1) ? 0.1f : (a == 2) ? 0.01f : 0.001f;
    const float m = (b == 0) ? 1.0f : (b == 1) ? 0.56234132519034908f : (b == 2) ? 0.31622776601683794f : 0.17782794100389228f;
    return (b == 0) ? p : (float)((double)p * (double)m);
}

__device__ __forceinline__ void p0_prologue(Ctx& C, kargs_t A) {
    LAS float* scr = (LAS float*)(C.lds + C.wave * 16384);
    bf16* WIN = (bf16*)(C.ws + WS_WIN); bf16* WQ2 = (bf16*)(C.ws + WS_WQ2); bf16* WOUT = (bf16*)(C.ws + WS_WOUT);
    constexpr int I_IN = 16 * 54, I_UQ = 4 * 24, I_UKV = 2 * 32, I_OUT = 16 * 32, I_L = I_IN + I_UQ + I_UKV + I_OUT;
    REPS(12) for (int it = C.gw; it < DEPTH * I_L; it += C.NGW) {
        const int l = it / I_L; int r = it - l * I_L;
        if (r < I_IN) { transpose_item(A->in[2] + (size_t)l * DM * IN_COLS, IN_COLS, WIN + (size_t)l * NP1 * DM, DM, scr, r / 54, r % 54, C.lane, MapWin{}); continue; } r -= I_IN;
        if (r < I_UQ) { transpose_item(A->in[4] + (size_t)l * 256 * 768, 768, WQ2 + (size_t)l * NP1 * 256, 256, scr, r / 24, r % 24, C.lane, MapUq{A->in[3] + l * 256}); continue; } r -= I_UQ;
        if (r < I_UKV) { transpose_item(A->in[6] + (size_t)l * 128 * 1024, 1024, WQ2 + (size_t)l * NP1 * 256, 256, scr, r / 32, r % 32, C.lane, MapUkv{A->in[5] + l * 128}); continue; } r -= I_UKV;
        transpose_item(A->in[14] + (size_t)l * DM * DM, DM, WOUT + (size_t)l * DM * DM, DM, scr, r / 32, r % 32, C.lane, MapWout{A->in[12] + l * 512, A->in[13] + l * 256});
    }
    const int gt = C.vcu * NTHR + C.tid, NGT = C.G * NTHR;
    for (int i = gt; i < DEPTH * 92 * 128; i += NGT) { const int l = i / (92 * 128), r = i % (92 * 128); *(u32x4*)(WIN + (size_t)l * NP1 * DM + (size_t)(420 + r / 128) * DM + (r % 128) * 8) = (u32x4){0u, 0u, 0u, 0u}; }
    REPS(4) {
    bf16* XB = (bf16*)(C.ws + WS_XB); const float* x = A->in[0];
    for (int m = C.gw; m < M; m += C.NGW) { const f32x4* xr = (const f32x4*)(x + (size_t)m * DM) + C.lane; u32x2* o = (u32x2*)(XB + (size_t)m * DM) + C.lane;
#pragma unroll
        for (int j = 0; j < 4; ++j) { const f32x4 v = xr[64 * j]; o[64 * j] = (u32x2){pk2(v[0], v[1]), pk2(v[2], v[3])}; } }
    float* COS = (float*)(C.ws + WS_TAB); float* SIN = COS + (size_t)M * 16; const int* pos = (const int*)A->in[1];
    for (int i = gt; i < M * 16; i += NGT) { const float ang = (float)pos[i >> 4] * inv_freq(i & 15); float c, s; sincos_acc(ang, c, s); COS[i] = c; SIN[i] = s; }
    }
}

constexpr int FFN_PRE = 3840;
__device__ __forceinline__ int ffn_pre(int layer) { return layer >= 3 ? FFN_PRE + 4224 : FFN_PRE; }
__device__ __forceinline__ int ffn_split(int layer) { return (layer & 1) ? ffn_pre(layer) + 7744 : 4224; }
__device__ __forceinline__ void ffn_weights(Ctx& C, kargs_t A, int layer, int first, int stride, int lo, int hi) {
    LAS float* scr = (LAS float*)(C.lds + C.wave * 16384);
    bf16* W13 = (bf16*)(C.ws + ((layer & 1) ? WS_WFFN : WS_WFFD)); bf16* W2T = W13 + ((layer & 1) ? WF_W13_ELEMS : WD_W13_ELEMS); const int j = layer >> 1;
    if ((layer & 1) == 0) {
        constexpr int I1 = 16 * 88, I2 = 44 * 32;
        const float* w1 = A->in[17] + (size_t)j * DM * DFF; const float* w3 = A->in[18] + (size_t)j * DM * DFF; const float* w2 = A->in[19] + (size_t)j * DFF * DM;
        const int end = hi < 2 * I1 + I2 ? hi : 2 * I1 + I2;
        for (int it = lo + first; it < end; it += stride) {
            int r = it;
            if (r < I1) { transpose_item(w1, DFF, W13, DM, scr, r / 88, r % 88, C.lane, MapW13{0}); continue; } r -= I1;
            if (r < I1) { transpose_item(w3, DFF, W13, DM, scr, r / 88, r % 88, C.lane, MapW13{1}); continue; } r -= I1;
            transpose_item(w2, DM, W2T, DFF, scr, r / 32, r % 32, C.lane, MapId{});
        }
    } else {
        constexpr int I1 = 16 * 44, I2 = 22 * 32, IE = 2 * I1 + I2;
        const int end = hi < NEXP * IE ? hi : NEXP * IE;
        for (int it = lo + first; it < end; it += stride) {
            const int e = it / IE; int r = it - e * IE;
            const float* w1 = A->in[21] + ((size_t)j * NEXP + e) * DM * DFE; const float* w3 = A->in[22] + ((size_t)j * NEXP + e) * DM * DFE; const float* w2 = A->in[23] + ((size_t)j * NEXP + e) * DFE * DM;
            bf16* W13e = W13 + (size_t)e * 2 * DFE * DM; bf16* W2Te = W2T + (size_t)e * DM * DFE;
            if (r < I1) { transpose_item(w1, DFE, W13e, DM, scr, r / 44, r % 44, C.lane, MapW13{0}); continue; } r -= I1;
            if (r < I1) { transpose_item(w3, DFE, W13e, DM, scr, r / 44, r % 44, C.lane, MapW13{1}); continue; } r -= I1;
            transpose_item(w2, DM, W2Te, DFE, scr, r / 32, r % 32, C.lane, MapId{});
        }
    }
}

constexpr int CONV_STATIC = 3;
__device__ __forceinline__ void conv_group(Ctx& C, kargs_t A, int layer, int first, int last, unsigned* qctr) {
    unsigned char* sc = C.ws + WS_SCR; const bf16* CI = (const bf16*)(sc + SC_CI); bf16* MIXED = (bf16*)(sc + SC_MIXED);
    LAS float* hL = (LAS float*)C.lds; LAS float* yL = hL + 62 * 256;
    volatile LAS unsigned* qw = (volatile LAS unsigned*)(C.lds + RING_BYTES + 8192 + 128);
    const int cch = (C.wave & 3) * 64 + C.lane, tt0 = (C.wave >> 2) * 16;
    float wj[31];
#pragma unroll
    for (int j = 0; j < 31; ++j) wj[j] = A->in[8][((size_t)layer * 31 + j) * 256 + cch];
    const float cb = A->in[9][layer * 256 + cch];
    const int ntok = C.tid >> 4, ngrp = (C.tid >> 2) & 3, nqt = C.tid & 3, nc0 = ngrp * 64 + nqt * 16;
    u32x4 pa[4];
#define CONV_LOAD(tl) do { const int t0_ = (tl) * 32, seq0_ = (t0_ / SEQ) * SEQ; _Pragma("unroll") for (int k = 0; k < 4; ++k) { const int it = C.tid + NTHR * k, r = it >> 5, ch = it & 31, tok = t0_ - 30 + r; \
        pa[k] = (u32x4){0u, 0u, 0u, 0u}; \
        if (it < 62 * 32 && tok >= seq0_) pa[k] = *(const u32x4*)(CI + (size_t)tok * 256 + ch * 8); } } while (0)
    unsigned mine = 0u; int tile = first;
    if (qctr != nullptr) { if (C.tid == 0) mine = __hip_atomic_fetch_add(qctr, 1u, RLX_AGENT); }
    else if (first < last) CONV_LOAD(first);
    for (int it = 0;; ++it) {
        if (qctr != nullptr) {
            if (C.tid == 0) { qw[it & 1] = mine; mine = __hip_atomic_fetch_add(qctr, 1u, RLX_AGENT); }
            asm volatile("s_waitcnt lgkmcnt(0)\n\ts_barrier" ::: "memory");
            tile = first + __builtin_amdgcn_readfirstlane((int)qw[it & 1]);
            if (tile >= last) break;
            CONV_LOAD(tile);
        } else if (tile >= last) break;
        const int t0 = tile * 32;
#pragma unroll
        for (int k = 0; k < 4; ++k) { const int it2 = C.tid + NTHR * k, r = it2 >> 5, ch = it2 & 31;
            if (it2 < 62 * 32) { const u32x4 a = pa[k];
                *(LAS f32x4*)(hL + r * 256 + ch * 8) = (f32x4){bflo(a.x), bfhi(a.x), bflo(a.y), bfhi(a.y)}; *(LAS f32x4*)(hL + r * 256 + ch * 8 + 4) = (f32x4){bflo(a.z), bfhi(a.z), bflo(a.w), bfhi(a.w)}; } }
        __syncthreads();
        if (qctr == nullptr && tile + 1 < last) CONV_LOAD(tile + 1);
#pragma unroll
        for (int chunk = 0; chunk < 2; ++chunk) { const int base = tt0 + chunk * 8; float hv[38];
#pragma unroll
            for (int i = 0; i < 38; ++i) hv[i] = hL[(base + i) * 256 + cch];
#pragma unroll
            for (int tt = 0; tt < 8; ++tt) { float acc = cb;
#pragma unroll
                for (int j = 0; j < 31; ++j) acc += wj[j] * hv[tt + j];
                yL[(base + tt) * 256 + cch] = acc; } }
        __syncthreads();
        { float v[16]; float s = 0.f;
#pragma unroll
          for (int i = 0; i < 16; i += 4) { const f32x4 t4 = *(const LAS f32x4*)(yL + ntok * 256 + nc0 + i); v[i] = t4[0]; v[i + 1] = t4[1]; v[i + 2] = t4[2]; v[i + 3] = t4[3]; s += (t4[0] + t4[1]) + (t4[2] + t4[3]); }
          s += lane_xor<1>(s); s += lane_xor<2>(s); const float mean = s * (1.0f / 64); float q = 0.f;
#pragma unroll
          for (int i = 0; i < 16; ++i) { v[i] -= mean; q += v[i] * v[i]; }
          q += lane_xor<1>(q); q += lane_xor<2>(q); const float rstd = 1.0f / sqrtf(q * (1.0f / 64) + EPS);
          const float* gg = A->in[10] + layer * 256 + nc0; const float* gb = A->in[11] + layer * 256 + nc0; float o[16];
#pragma unroll
          for (int i = 0; i < 16; ++i) o[i] = siluf_(v[i] * rstd * gg[i] + gb[i]);
          bf16* dst = MIXED + (size_t)(t0 + ntok) * 1024 + 768 + nc0;
          *(u32x4*)dst = (u32x4){pk2(o[0], o[1]), pk2(o[2], o[3]), pk2(o[4], o[5]), pk2(o[6], o[7])};
          *(u32x4*)(dst + 8) = (u32x4){pk2(o[8], o[9]), pk2(o[10], o[11]), pk2(o[12], o[13]), pk2(o[14], o[15])}; }
        if (qctr == nullptr) ++tile;
    }
    __syncthreads();
#undef CONV_LOAD
}

__device__ __forceinline__ void p2_thin(Ctx& C, kargs_t A, int layer) {
    unsigned char* sc = C.ws + WS_SCR;
    bf16* CQ = (bf16*)(sc + SC_CQKV); bf16* CKV = CQ + (size_t)M * 256; const float* KR = (const float*)(sc + SC_KR); const float* FL = (const float*)(sc + SC_FL);
    float* CUM = (float*)(sc + SC_CUM); const bf16* CI = (const bf16*)(sc + SC_CI); const bf16* FQn = (const bf16*)(sc + SC_FQ); bf16* KM = (bf16*)(sc + SC_KM); bf16* MIXED = (bf16*)(sc + SC_MIXED);
    const float* COS = (const float*)(C.ws + WS_TAB); const float* SIN = COS + (size_t)M * 16;
    {
    if (C.vcu < BATCH * 4) {
        const int sq = C.vcu, b = sq >> 2, h = sq & 3; const float bias = A->in[7][layer * 4 + h];
        LAS float* WT = (LAS float*)(C.lds + RING_BYTES + 8192 + 256);
        float v[8]; float run = 0.f;
#pragma unroll
        for (int i = 0; i < 8; ++i) { const float z = FL[((size_t)b * SEQ + C.tid * 8 + i) * 4 + h] + bias; const float e = fexp2(-fabsf(z) * LOG2E);
            const float ls = fminf(z, 0.f) - __builtin_amdgcn_logf(1.0f + e) * 0.6931471805599453f; run += ls * LOG2E; v[i] = run; }
        float incl = run;
#pragma unroll
        for (int o = 1; o < 64; o <<= 1) { const float t = __int_as_float(__builtin_amdgcn_ds_bpermute((C.lane - o) << 2, __float_as_int(incl))); if (C.lane >= o) incl += t; }
        if (C.lane == 63) WT[C.wave] = incl;
        __syncthreads();
        float pre = 0.f;
#pragma unroll
        for (int w = 0; w < NWAVES; ++w) { const float t = WT[w]; if (w < C.wave) pre += t; }
        const float excl = (incl - run) + pre; float* dst = CUM + (size_t)sq * SEQ + C.tid * 8;
        *(f32x4*)dst = (f32x4){v[0] + excl, v[1] + excl, v[2] + excl, v[3] + excl}; *(f32x4*)(dst + 4) = (f32x4){v[4] + excl, v[5] + excl, v[6] + excl, v[7] + excl};
    }
    }
    __syncthreads();
    if (C.bx >= C.G / 2) conv_group(C, A, layer, (C.bx - C.G / 2) * CONV_STATIC, (C.bx - C.G / 2 + 1) * CONV_STATIC, nullptr);
    REPS(11) ffn_weights(C, A, layer, C.gw, C.NGW, ffn_split(layer), 1 << 30);
}

__device__ __forceinline__ void p5_rms(Ctx& C) {
    bf16* MIXED = (bf16*)(C.ws + WS_SCR + SC_MIXED);
    REPS(7) for (int mb = C.gw; mb < M; mb += 4 * C.NGW) {
        u32x4 wa[4]; u32x2 wb[4];
#pragma unroll
        for (int k = 0; k < 4; ++k) { const bf16* r = MIXED + ((size_t)mb + (size_t)k * C.NGW) * 1024; wa[k] = ((const u32x4*)r)[C.lane]; wb[k] = ((const u32x2*)(r + 512))[C.lane]; }
#pragma unroll
        for (int k = 0; k < 4; ++k) { bf16* r = MIXED + ((size_t)mb + (size_t)k * C.NGW) * 1024;
            { const u32x4 w = wa[k]; float a[8] = {bflo(w.x), bfhi(w.x), bflo(w.y), bfhi(w.y), bflo(w.z), bfhi(w.z), bflo(w.w), bfhi(w.w)}; float ss = 0.f;
#pragma unroll
              for (int i = 0; i < 8; ++i) ss += a[i] * a[i];
              ss = wave_sum(ss); const float rs = 1.0f / sqrtf(ss * (1.0f / 512) + EPS);
              ((u32x4*)r)[C.lane] = (u32x4){pk2(a[0] * rs, a[1] * rs), pk2(a[2] * rs, a[3] * rs), pk2(a[4] * rs, a[5] * rs), pk2(a[6] * rs, a[7] * rs)}; }
            { const u32x2 w = wb[k]; const float a0 = bflo(w.x), a1 = bfhi(w.x), a2 = bflo(w.y), a3 = bfhi(w.y);
              const float ss = wave_sum((a0 * a0 + a1 * a1) + (a2 * a2 + a3 * a3)); const float rs = 1.0f / sqrtf(ss * (1.0f / 256) + EPS); ((u32x2*)(r + 512))[C.lane] = (u32x2){pk2(a0 * rs, a1 * rs), pk2(a2 * rs, a3 * rs)}; }
        }
    }
}

template <int MODE>
__device__ __forceinline__ void ln_pass(Ctx& C, const bool final, const bf16* add, const float* gam, const float* bet, const float* router_w) {
    bf16* XB = (bf16*)(C.ws + WS_XB); float* out = C.out;
    REPS(14) {
    const bool dry = ((REP_MASK >> 14) & 1) && rep_ == 0; float* jf = (float*)(C.ws + WS_SCR); bf16* jb = (bf16*)(C.ws + WS_SCR + 40 * MiB);
    int* TOPE = (int*)(C.ws + WS_MOE + MT_TOPE); float* TOPG = (float*)(C.ws + WS_MOE + MT_TOPG); const int* TOKSLOT = (const int*)(C.ws + WS_MOE + MT_TOKSLOT);
    LAS float* RW = (LAS float*)C.lds; LAS unsigned* CNT = (LAS unsigned*)(C.lds + 32768);
    if constexpr (MODE == 1) {
        for (int i = C.tid; i < 1024 * 8 / 4; i += NTHR) *(LAS f32x4*)(RW + 4 * i) = *(const f32x4*)(router_w + 4 * i);
        if (C.tid < 8) CNT[C.tid] = 0u;
        __syncthreads();
    }
    f32x4 g4[4], b4[4];
#pragma unroll
    for (int j = 0; j < 4; ++j) { g4[j] = ((const f32x4*)gam)[64 * j + C.lane]; b4[j] = ((const f32x4*)bet)[64 * j + C.lane]; }
    const int RPB = M / C.G, row0 = C.bx * RPB;
    unsigned cnt0 = 0, cnt1 = 0, cnt2 = 0, cnt3 = 0, cnt4 = 0, cnt5 = 0, cnt6 = 0, cnt7 = 0;
    u32x2 xA[4], aA[4], bA[4], xB[4], aB[4], bB[4]; int sA0 = 0, sA1 = 0, sB0 = 0, sB1 = 0;
#define LN_LOAD(NX, NA, NB, mm, s0_, s1_) do { _Pragma("unroll") for (int j = 0; j < 4; ++j) { NX[j] = ((const u32x2*)(XB + (size_t)(mm) * DM))[64 * j + C.lane]; \
        if constexpr (MODE == 2) { NA[j] = ((const u32x2*)(add + (size_t)(s0_) * DM))[64 * j + C.lane]; NB[j] = ((const u32x2*)(add + (size_t)(s1_) * DM))[64 * j + C.lane]; } \
        else { NA[j] = ((const u32x2*)(add + (size_t)(mm) * DM))[64 * j + C.lane]; NB[j] = (u32x2){0u, 0u}; } } } while (0)
#define LN_SLOTS(s0_, s1_, rrr) do { if constexpr (MODE == 2) { if ((rrr) < RPB) { s0_ = TOKSLOT[2 * (row0 + (rrr))]; s1_ = TOKSLOT[2 * (row0 + (rrr)) + 1]; } } } while (0)
#define LN_ROW(NX, NA, NB, S0, S1, rr_, v) do { const int m = row0 + (rr_); \
        _Pragma("unroll") for (int j = 0; j < 4; ++j) { v[j] = (f32x4){bflo(NX[j].x), bfhi(NX[j].x), bflo(NX[j].y), bfhi(NX[j].y)} * ALPHA + (f32x4){bflo(NA[j].x), bfhi(NA[j].x), bflo(NA[j].y), bfhi(NA[j].y)}; \
            if constexpr (MODE == 2) v[j] += (f32x4){bflo(NB[j].x), bfhi(NB[j].x), bflo(NB[j].y), bfhi(NB[j].y)}; } \
        if ((rr_) + 2 * NWAVES < RPB) { LN_LOAD(NX, NA, NB, m + 2 * NWAVES, S0, S1); LN_SLOTS(S0, S1, (rr_) + 4 * NWAVES); } \
        float s = 0.f; \
        _Pragma("unroll") for (int j = 0; j < 4; ++j) s += (v[j][0] + v[j][1]) + (v[j][2] + v[j][3]); \
        const float mean = wave_sum(s) * (1.0f / DM); float q = 0.f; \
        _Pragma("unroll") for (int j = 0; j < 4; ++j) { v[j] = v[j] - mean; q += (v[j][0] * v[j][0] + v[j][1] * v[j][1]) + (v[j][2] * v[j][2] + v[j][3] * v[j][3]); } \
        const float rstd = 1.0f / sqrtf(wave_sum(q) * (1.0f / DM) + EPS); \
        _Pragma("unroll") for (int j = 0; j < 4; ++j) { v[j] = v[j] * rstd * g4[j] + b4[j]; if (final) ((f32x4*)((dry ? jf + (size_t)(m & 8191) * DM : out + (size_t)m * DM)))[64 * j + C.lane] = v[j]; \
            else ((u32x2*)((dry ? jb + (size_t)(m & 8191) * DM : XB + (size_t)m * DM)))[64 * j + C.lane] = (u32x2){pk2(v[j][0], v[j][1]), pk2(v[j][2], v[j][3])}; } \
        } while (0)
#define ROUTE_FIN(lg, m) do { \
            {   \
                float k4[4]; _Pragma("unroll") for (int k = 0; k < 4; ++k) { auto sw = __builtin_amdgcn_permlane32_swap(__float_as_uint(lg[k]), __float_as_uint(lg[k + 4]), false, false); k4[k] = __uint_as_float(sw[0]) + __uint_as_float(sw[1]); } \
                const bool b3 = (C.lane & 8) != 0; \
                float k2[2]; _Pragma("unroll") for (int k = 0; k < 2; ++k) { auto sw = __builtin_amdgcn_permlane16_swap(__float_as_uint(k4[k]), __float_as_uint(k4[k + 2]), false, false); k2[k] = __uint_as_float(sw[0]) + __uint_as_float(sw[1]); } \
                float k1; { const float snd = b3 ? k2[0] : k2[1], kp = b3 ? k2[1] : k2[0]; k1 = kp + dpp_mov<0x128>(snd); }        \
                k1 += dpp_mov<0xB1>(k1); k1 += dpp_mov<0x4E>(k1); k1 += dpp_mov<0x141>(k1); \
                _Pragma("unroll") for (int e = 0; e < 8; ++e) lg[e] = __int_as_float(__builtin_amdgcn_readlane(__float_as_int(k1), 8 * e)); } \
            int e1 = 0; float v1 = lg[0]; \
            _Pragma("unroll") for (int e = 1; e < 8; ++e) if (lg[e] > v1) { v1 = lg[e]; e1 = e; } \
            int e2 = -1; float v2 = -INFINITY; \
            _Pragma("unroll") for (int e = 0; e < 8; ++e) if (e != e1 && lg[e] > v2) { v2 = lg[e]; e2 = e; } \
            const float ex = fexp2((v2 - v1) * LOG2E), gA = 1.0f / (1.0f + ex), gB = ex * gA; \
            if (C.lane == 0) { TOPE[2 * m] = e1; TOPE[2 * m + 1] = e2; TOPG[2 * m] = gA; TOPG[2 * m + 1] = gB; } \
            cnt0 += (e1 == 0) + (e2 == 0); cnt1 += (e1 == 1) + (e2 == 1); cnt2 += (e1 == 2) + (e2 == 2); cnt3 += (e1 == 3) + (e2 == 3); \
            cnt4 += (e1 == 4) + (e2 == 4); cnt5 += (e1 == 5) + (e2 == 5); cnt6 += (e1 == 6) + (e2 == 6); cnt7 += (e1 == 7) + (e2 == 7); \
        } while (0)
#define ROUTE2(vA, vB, mA, mB) do {        \
            float lgA[8] = {0.f, 0.f, 0.f, 0.f, 0.f, 0.f, 0.f, 0.f}, lgB[8] = {0.f, 0.f, 0.f, 0.f, 0.f, 0.f, 0.f, 0.f}; \
            _Pragma("unroll") for (int j = 0; j < 4; ++j) \
                _Pragma("unroll") for (int i = 0; i < 4; ++i) { const int col = 256 * j + 4 * C.lane + i; const f32x4 w0 = *(const LAS f32x4*)(RW + col * 8), w1 = *(const LAS f32x4*)(RW + col * 8 + 4); const float xa = vA[j][i], xb = vB[j][i]; \
                    lgA[0] += xa * w0[0]; lgA[1] += xa * w0[1]; lgA[2] += xa * w0[2]; lgA[3] += xa * w0[3]; lgA[4] += xa * w1[0]; lgA[5] += xa * w1[1]; lgA[6] += xa * w1[2]; lgA[7] += xa * w1[3]; \
                    lgB[0] += xb * w0[0]; lgB[1] += xb * w0[1]; lgB[2] += xb * w0[2]; lgB[3] += xb * w0[3]; lgB[4] += xb * w1[0]; lgB[5] += xb * w1[1]; lgB[6] += xb * w1[2]; lgB[7] += xb * w1[3]; } \
            ROUTE_FIN(lgA, (mA)); ROUTE_FIN(lgB, (mB)); } while (0)
    LN_SLOTS(sA0, sA1, C.wave); LN_SLOTS(sB0, sB1, C.wave + NWAVES);
    LN_LOAD(xA, aA, bA, row0 + C.wave, sA0, sA1); LN_LOAD(xB, aB, bB, row0 + C.wave + NWAVES, sB0, sB1);
    LN_SLOTS(sA0, sA1, C.wave + 2 * NWAVES); LN_SLOTS(sB0, sB1, C.wave + 3 * NWAVES);
    for (int rr = C.wave; rr < RPB; rr += 2 * NWAVES) {
        f32x4 vA_[4], vB_[4];
        LN_ROW(xA, aA, bA, sA0, sA1, rr, vA_);
        LN_ROW(xB, aB, bB, sB0, sB1, rr + NWAVES, vB_);
        if constexpr (MODE == 1) ROUTE2(vA_, vB_, (row0 + rr), (row0 + rr + NWAVES));
    }
    if constexpr (MODE == 1) {
        if (C.lane == 0) { atomicAdd((unsigned*)&CNT[0], cnt0); atomicAdd((unsigned*)&CNT[1], cnt1); atomicAdd((unsigned*)&CNT[2], cnt2); atomicAdd((unsigned*)&CNT[3], cnt3);
                           atomicAdd((unsigned*)&CNT[4], cnt4); atomicAdd((unsigned*)&CNT[5], cnt5); atomicAdd((unsigned*)&CNT[6], cnt6); atomicAdd((unsigned*)&CNT[7], cnt7); }
        __syncthreads();
        if (C.tid < 8) C.ctl[CW_CNTB + C.bx * 8 + C.tid] = CNT[C.tid];
        __syncthreads();
    }
    }
#undef LN_LOAD
#undef ROUTE_FIN
#undef ROUTE2
#undef LN_SLOTS
#undef LN_ROW
}

__device__ __forceinline__ void moe_assign(Ctx& C) {
    if (C.wave != 0) return;
    const int* TOPE = (const int*)(C.ws + WS_MOE + MT_TOPE); const float* TOPG = (const float*)(C.ws + WS_MOE + MT_TOPG);
    int* TOKSLOT = (int*)(C.ws + WS_MOE + MT_TOKSLOT); int* SLOTTOK = (int*)(C.ws + WS_MOE + MT_SLOTTOK); float* SLOTGATE = (float*)(C.ws + WS_MOE + MT_SLOTGATE);
    const int blk = C.bx, RPB = M / C.G, row0 = blk * RPB;
    int tot[8] = {0, 0, 0, 0, 0, 0, 0, 0}, pre[8] = {0, 0, 0, 0, 0, 0, 0, 0};
    for (int bb = C.lane; bb < C.G; bb += 64) {
        const u32x4* cp = (const u32x4*)(C.ctl + CW_CNTB + bb * 8); const u32x4 ca = cp[0], cb = cp[1]; const int lt = bb < blk ? 1 : 0;
        const int c[8] = {(int)ca.x, (int)ca.y, (int)ca.z, (int)ca.w, (int)cb.x, (int)cb.y, (int)cb.z, (int)cb.w};
#pragma unroll
        for (int e = 0; e < 8; ++e) { tot[e] += c[e]; pre[e] += lt * c[e]; }
    }
#pragma unroll
    for (int e = 0; e < 8; ++e) { tot[e] = wave_sum_i(tot[e]); pre[e] = wave_sum_i(pre[e]); }
    int seg[9]; seg[0] = 0;
#pragma unroll
    for (int e = 0; e < 8; ++e) seg[e + 1] = seg[e] + ((tot[e] + 255) & ~255);
    int run[8];
#pragma unroll
    for (int e = 0; e < 8; ++e) run[e] = seg[e] + pre[e];
    const unsigned long long ltmask = (1ull << C.lane) - 1ull;
    for (int base = 0; base < RPB * 2; base += 64) {
        const int idx = base + C.lane, token = row0 + (idx >> 1), choice = idx & 1;
        const int ex = TOPE[2 * token + choice]; const float gate = TOPG[2 * token + choice]; int slot = 0;
#pragma unroll
        for (int e = 0; e < 8; ++e) { const unsigned long long mk = __builtin_amdgcn_ballot_w64(ex == e); if (ex == e) slot = run[e] + __popcll(mk & ltmask); run[e] += __popcll(mk); }
        SLOTTOK[slot] = token; SLOTGATE[slot] = gate; TOKSLOT[2 * token + choice] = slot;
    }
    if (blk < 8) {
        int lo = 0, hi = 0;
#pragma unroll
        for (int e = 0; e < 8; ++e) if (e == blk) { lo = seg[e] + tot[e]; hi = seg[e + 1]; }
        for (int s = lo + C.lane; s < hi; s += 64) { SLOTTOK[s] = 0; SLOTGATE[s] = 0.f; }
    }
    if (blk == 0 && C.lane == 0) {
#pragma unroll
        for (int e = 0; e < 9; ++e) C.ctl[CW_SEG + e] = (unsigned)seg[e];
    }
}

#ifndef MK_PER_PHASE
#define MK_PER_PHASE 0
#endif
#ifndef PH_ENABLE
#define PH_ENABLE 0xFFFF
#endif
constexpr int PH_PER_LAYER = 12, N_PHASES = 1 + DEPTH * PH_PER_LAYER;

__global__ void __launch_bounds__(NTHR, 2) fwd_kernel(Args args) {
    extern __shared__ __attribute__((aligned(16))) unsigned char lds_raw[];
    LAS unsigned char* const lds = (LAS unsigned char*)lds_raw;
    volatile LAS unsigned* MISC = (volatile LAS unsigned*)(lds + MISC_OFF);
    for (int u = threadIdx.x; u < (LDS_BYTES - LDSCTL_OFF) / 4; u += NTHR) ((LAS unsigned*)(lds + LDSCTL_OFF))[u] = 0u;
    __syncthreads();
    const int wave0 = __builtin_amdgcn_readfirstlane((int)threadIdx.x >> 6);
    XcdBarrier bar; bar.bar = (unsigned*)(args.ws + WS_CTL) + CW_BAR; bar.x = 0; bar.st = nullptr;
    if (!MK_PER_PHASE) bar = xcd_barrier_post((unsigned*)(args.ws + WS_CTL) + CW_BAR, MISC + 8, wave0);
    const int lo = args.ph_lo, hi = args.ph_hi;
#define IN(k) (lo <= (k) && (k) < hi)
#define EN(p) ((PH_ENABLE >> (p)) & 1)
#define SEAM(k) do { if (IN((k) + 1)) { if (!MK_PER_PHASE) { unsigned long long bw0_ = 0ull; if (PROBE_ON(14)) bw0_ = __builtin_amdgcn_s_memrealtime(); xcd_barrier<false>(bar, wave0); if ((REP_MASK >> 13) & 1) xcd_barrier<false>(bar, wave0); \
        if (PROBE_ON(14)) { const unsigned long long bw1_ = __builtin_amdgcn_s_memrealtime(), bd_ = bw1_ - bw0_; while (__builtin_amdgcn_s_memrealtime() - bw1_ < bd_) __builtin_amdgcn_s_sleep(8); } \
        if (PROBE_ON(13)) { const unsigned long long bw1_ = __builtin_amdgcn_s_memrealtime(); while (__builtin_amdgcn_s_memrealtime() - bw1_ < 2000ull) __builtin_amdgcn_s_sleep(8); } } } } while (0)
#define SEAM0(k) do { if (IN((k) + 1)) { if (!MK_PER_PHASE) xcd_barrier<true>(bar, wave0); } } while (0)
#define PHASE_CTX kargs_t A = opaque_args(); Ctx C = make_ctx(A, lds, wave0); unsigned char* sc = C.ws + WS_SCR; (void)sc

    PT0(15); if (EN(15) && IN(0)) { PHASE_CTX; p0_prologue(C, A); }
    PEND(15, SEAM0(0));

    for (int layer = 0; layer < DEPTH; ++layer) {
        const int P = 1 + layer * PH_PER_LAYER;
#ifdef FORCE_MOE
        const bool moe = FORCE_MOE != 0;
#else
        const bool moe = (layer & 1) != 0;
#endif
        if (EN(0) && IN(P + 0)) { PT0(0);
            PHASE_CTX;
            pg8::DenseOrder S{(const bf16*)(C.ws + WS_XB), (const bf16*)(C.ws + WS_WIN) + (size_t)layer * NP1 * DM, DM, DM, M / 256, NP1 / 256, C.G, C.bx, REPN(0)};
            EpiInProj E{(bf16*)(sc + SC_CQKV), (bf16*)(sc + SC_CQKV) + (size_t)M * 256, (bf16*)(sc + SC_KR), (float*)(sc + SC_FL), (bf16*)(sc + SC_FQ), (bf16*)(sc + SC_CI), (float*)(sc + SC_RSQ), (const float*)(C.ws + WS_TAB), (const float*)(C.ws + WS_TAB) + (size_t)M * 16, (LAS unsigned*)(C.lds + RING_BYTES + 4096)};
            LAS unsigned* NT2 = (LAS unsigned*)(C.lds + RING_BYTES + 4096);
            if (C.tid < 136) NT2[C.tid] = 0u;
            if (C.bx >= C.G / 2) { const int wk = (C.bx - C.G / 2) * NWAVES + C.wave, nwk = (C.G / 2) * NWAVES;
                if (moe) ffn_weights(C, A, layer, wk, nwk, ffn_pre(layer), ffn_split(layer));
                else { if (layer == 0) ffn_weights(C, A, layer, wk, nwk, 0, ffn_split(layer));
                       if (layer + 1 < DEPTH) ffn_weights(C, A, layer + 1, wk, nwk, 0, ffn_pre(layer + 1)); } }
            __syncthreads();
            pg8::gemm_phase<EpiInProj, pg8::DenseOrder, false, DM, DM, DM>(C.lds, C.tid, S, E);
            if (C.tid < 136) { const unsigned v = NT2[C.tid]; if (v != 0u) atomicMax(C.tid < 128 ? C.ctl + CW_QKMAX + layer * 128 + C.tid : C.ctl + CW_KRMAX + layer * 8 + (C.tid - 128), v); }
            PEND(0, SEAM(P + 0));
        }
        if (EN(1) && IN(P + 1)) { PT0(1); PHASE_CTX; p2_thin(C, A, layer); if (C.tid < 128) ((LAS unsigned*)(C.lds + RING_BYTES + 4096))[C.tid] = 0u; __syncthreads(); PEND(1, (void)0); }
        if (EN(2) && IN(P + 2)) { PT0(2);
            PHASE_CTX;
            struct QkvOrder { const bf16* A; const bf16* Bt; int G, c, rep;
                __device__ __forceinline__ bool next(int i, pg8::Unit& u) const { return pg8::tile_order_rep(i, G, c, M / 256, 7, rep, u.pm, u.pn); }
                __device__ __forceinline__ const char* a_base(const pg8::Unit& u) const { return (const char*)(A + (u.pn < 3 ? (size_t)0 : (size_t)M * 256)) + (size_t)u.pm * 256 * 256 * 2; }
                __device__ __forceinline__ const char* b_base(const pg8::Unit& u) const { return (const char*)Bt + (size_t)u.pn * 256 * 256 * 2; }
                __device__ __forceinline__ int tok(const pg8::Unit&, int) const { return 0; }
                __device__ __forceinline__ int ktiles(const pg8::Unit& u, int nt) const { return u.pn < 3 ? nt : nt / 2; } };
            QkvOrder S{(const bf16*)(sc + SC_CQKV), (const bf16*)(C.ws + WS_WQ2) + (size_t)layer * NP1 * 256, C.G, C.bx, REPN(2)};
            EpiQKV E{(bf16*)(sc + SC_QM), (bf16*)(sc + SC_KM), (bf16*)(sc + SC_VM), (const float*)(C.ws + WS_TAB), (const float*)(C.ws + WS_TAB) + (size_t)M * 16, (const float*)(sc + SC_RSQ), (LAS unsigned*)(C.lds + RING_BYTES + 4096)};
            pg8::gemm_phase<EpiQKV, QkvOrder, false, 256, 256, 256>(C.lds, C.tid, S, E);
            if (C.tid < 128) { const unsigned v = ((LAS unsigned*)(C.lds + RING_BYTES + 4096))[C.tid]; if (v != 0u) atomicMax(C.ctl + CW_KNMAX + layer * 128 + C.tid, v); }
            PEND(2, SEAM(P + 2));
        }
        if (EN(3) && IN(P + 3)) { PT0(3);
            PHASE_CTX;
            bf16* MIXED = (bf16*)(sc + SC_MIXED);
            for (int p = C.vcu; p < 512; p += C.G) { const int bh = p >> 3, s = p & 7;
                const unsigned* kn_ = C.ctl + CW_KNMAX + layer * 128 + bh * 2;
                const float kmax2 = (__uint_as_float(kn_[0]) + __uint_as_float(kn_[1])) + __uint_as_float(C.ctl[CW_KRMAX + layer * 8 + (bh >> 3)]);
                for (int i = 0; i < 2; ++i) att::attn_unit<96, false>(bh >> 3, bh & 7, i == 0 ? 15 - s : s, (const bf16*)(sc + SC_QM), 768, (const bf16*)(sc + SC_KM), 768, (const bf16*)(sc + SC_VM), 512, MIXED, 1024, (bh & 7) * 64, nullptr, C.lds, C.tid, (float*)(sc + SC_SSQ), bh & 7, nullptr, (const bf16*)(sc + SC_KR), kmax2);
            }
            { volatile LAS unsigned* qw = (volatile LAS unsigned*)(C.lds + RING_BYTES + 8192); const int xb = C.bx & 7; unsigned* qctr = C.ctl + CW_ATTQ + layer * 8 + xb;
              const bf16* FQ = (const bf16*)(sc + SC_FQ);
              const int nxw = C.G >> 3, jx = C.bx >> 3;
              for (int it = 0;; ++it) {
                if (it > 0 || jx >= 64) { if (C.tid == 0) qw[0] = (unsigned)nxw + __hip_atomic_fetch_add(qctr, 1u, RLX_AGENT); }
                else if (C.tid == 0) qw[0] = (unsigned)jx;
                asm volatile("s_waitcnt vmcnt(0) lgkmcnt(0)\n\ts_barrier" ::: "memory");
                const int idx = __builtin_amdgcn_readfirstlane((int)qw[0]);
                if (idx >= 64) break;
                const int hd = idx & 3, qb = 15 - (idx >> 2), bh = xb * 4 + hd;
                att::attn_unit<64, true>(xb, hd, qb, FQ, 256, FQ + (size_t)M * 256, 256, FQ + (size_t)2 * M * 256, 256, MIXED, 1024, 512 + hd * 64, (const float*)(sc + SC_CUM), C.lds, C.tid, (float*)(sc + SC_SSQ), 8 + hd, C.ctl + CW_QKMAX + layer * 128 + bh * 4);
              }
            }
            __syncthreads();
            { PHASE_CTX; conv_group(C, A, layer, (C.G / 2) * CONV_STATIC, M / 32, C.ctl + CW_CONVQ + layer); }
            PEND(3, SEAM(P + 3));
        }
        if (EN(5) && IN(P + 5)) { PT0(5);
            PHASE_CTX;
            pg8::DenseOrder S{(const bf16*)(sc + SC_MIXED), (const bf16*)(C.ws + WS_WOUT) + (size_t)layer * DM * DM, DM, DM, M / 256, DM / 256, C.G, C.bx, REPN(5)};
            EpiBf16<DM, false> E{(bf16*)(sc + SC_MIXOUT), DM / 256, nullptr};
            pg8::gemm_phase<EpiBf16<DM, false>, pg8::DenseOrder, false, DM, DM, DM, true>(C.lds, C.tid, S, E, (const float*)(sc + SC_SSQ));
            PEND(5, SEAM(P + 5));
        }
        if (EN(6) && IN(P + 6)) { PT0(6);
            if (moe) { PHASE_CTX; ln_pass<1>(C, false, (const bf16*)(sc + SC_MIXOUT), A->in[15] + layer * DM, A->in[16] + layer * DM, A->in[20] + (size_t)(layer >> 1) * DM * NEXP); }
            else     { PHASE_CTX; ln_pass<0>(C, false, (const bf16*)(sc + SC_MIXOUT), A->in[15] + layer * DM, A->in[16] + layer * DM, nullptr); }
            PEND(6, SEAM(P + 6));
        }
        if (EN(7) && IN(P + 7) && moe) { PT0(7); { PHASE_CTX; moe_assign(C); } PEND(7, SEAM(P + 7)); }
        if (EN(8) && IN(P + 8)) { PT0(8);
            if (moe) {
                PHASE_CTX; bf16* W13 = (bf16*)(C.ws + WS_WFFN); bf16* HID = (bf16*)(sc + SC_HID);
                const int* seg = (const int*)(C.ctl + CW_SEG);
                const int U = (seg[8] / 256) * 11;
                MoeIdxOrder<11> S{(const bf16*)(C.ws + WS_XB), W13, DM, DM, C.vcu, C.G, (U / C.G) * C.G, (const int*)(C.ws + WS_MOE + MT_SLOTTOK), seg[1], seg[2], seg[3], seg[4], seg[5], seg[6], seg[7]};
                EpiSwiGLU<DFE> E{HID, 11};
                pg8::gemm_phase<EpiSwiGLU<DFE>, MoeIdxOrder<11>, true, DM, DM, DM>(C.lds, C.tid, S, E);
            } else {
                PHASE_CTX; bf16* W13 = (bf16*)(C.ws + WS_WFFD); bf16* HID = (bf16*)(sc + SC_HID);
                pg8::DenseOrder S{(const bf16*)(C.ws + WS_XB), W13, DM, DM, M / 256, 2 * DFF / 256, C.G, C.bx, REPN(8)};
                EpiSwiGLU<DFF> E{HID, 1 << 30};
                pg8::gemm_phase<EpiSwiGLU<DFF>, pg8::DenseOrder, false, DM, DM, DM>(C.lds, C.tid, S, E);
            }
            PEND(8, SEAM(P + 8));
        }
        if (EN(9) && IN(P + 9)) { PT0(9);
            if (moe) {
                { PHASE_CTX; bf16* W13 = (bf16*)(C.ws + WS_WFFN); bf16* HID = (bf16*)(sc + SC_HID); const int* seg = (const int*)(C.ctl + CW_SEG);
                  const int U = (seg[8] / 256) * 11, UF = (U / C.G) * C.G;
                  if (UF + C.vcu < U) {
                      MoeIdxOrder<11> S{(const bf16*)(C.ws + WS_XB), W13, DM, DM, UF + C.vcu, C.G, U, (const int*)(C.ws + WS_MOE + MT_SLOTTOK), seg[1], seg[2], seg[3], seg[4], seg[5], seg[6], seg[7]};
                      EpiSwiGLU<DFE> E{HID, 11};
                      pg8::gemm_phase<EpiSwiGLU<DFE>, MoeIdxOrder<11>, true, DM, DM, DM>(C.lds, C.tid, S, E);
                      if (C.tid == 0) { __builtin_amdgcn_fence(__ATOMIC_RELEASE, "agent"); asm volatile("s_waitcnt vmcnt(0)" ::: "memory"); __hip_atomic_fetch_add(C.ctl + CW_LEFT + layer, 1u, RLX_AGENT); }
                  } }
                { PHASE_CTX; bf16* W2T = (bf16*)(C.ws + WS_WFFN) + WF_W13_ELEMS; bf16* HID = (bf16*)(sc + SC_HID); bf16* FF = (bf16*)(sc + SC_FF); const int* seg = (const int*)(C.ctl + CW_SEG);
                  const int U = (seg[8] / 256) * 11, UF = (U / C.G) * C.G, DF = (UF / 11) * 4;
                  MoeIdxOrder<4> S{HID, W2T, DFE, DFE, C.vcu, C.G, DF, nullptr, seg[1], seg[2], seg[3], seg[4], seg[5], seg[6], seg[7]};
                  EpiBf16<DM, true> E{FF, 4, (const float*)(C.ws + WS_MOE + MT_SLOTGATE)};
                  pg8::gemm_phase<EpiBf16<DM, true>, MoeIdxOrder<4>, false, DFE, DFE, DFE>(C.lds, C.tid, S, E); }
                if (layer + 1 < DEPTH) { PHASE_CTX; const int* seg = (const int*)(C.ctl + CW_SEG);
                  const int nM = seg[8] / 256, U = nM * 11, UF = (U / C.G) * C.G, DF = (UF / 11) * 4, a = U - UF, b = C.G - (nM * 4 - DF);
                  __syncthreads();
                  if (C.vcu >= a && C.vcu < b) ffn_weights(C, A, layer + 1, (C.vcu - a) * NWAVES + C.wave, (b - a) * NWAVES, 0, ffn_split(layer + 1));
                  __syncthreads(); }
                { PHASE_CTX; bf16* W2T = (bf16*)(C.ws + WS_WFFN) + WF_W13_ELEMS; bf16* HID = (bf16*)(sc + SC_HID); bf16* FF = (bf16*)(sc + SC_FF); const int* seg = (const int*)(C.ctl + CW_SEG);
                  const int nM = seg[8] / 256, U = nM * 11, UF = (U / C.G) * C.G, DF = (UF / 11) * 4;
                  if (DF + (C.G - 1 - C.vcu) < nM * 4) {
                      if (C.wave == 0) { const unsigned need = (unsigned)(U - UF); unsigned* cw = C.ctl + CW_LEFT + layer;
                          while ((unsigned)__builtin_amdgcn_readfirstlane((int)__hip_atomic_load(cw, RLX_AGENT)) < need) __builtin_amdgcn_s_sleep(4);
                          __builtin_amdgcn_fence(__ATOMIC_ACQUIRE, "agent"); asm volatile("s_waitcnt vmcnt(0)" ::: "memory"); }
                      __syncthreads();
                      MoeIdxOrder<4> S{HID, W2T, DFE, DFE, DF + (C.G - 1 - C.vcu), C.G, nM * 4, nullptr, seg[1], seg[2], seg[3], seg[4], seg[5], seg[6], seg[7]};
                      EpiBf16<DM, true> E{FF, 4, (const float*)(C.ws + WS_MOE + MT_SLOTGATE)};
                      pg8::gemm_phase<EpiBf16<DM, true>, MoeIdxOrder<4>, false, DFE, DFE, DFE>(C.lds, C.tid, S, E);
                  } }
            } else {
                PHASE_CTX; bf16* W2T = (bf16*)(C.ws + WS_WFFD) + WD_W13_ELEMS; bf16* HID = (bf16*)(sc + SC_HID); bf16* FF = (bf16*)(sc + SC_FF);
                pg8::DenseOrder S{HID, W2T, DFF, DFF, M / 256, DM / 256, C.G, C.bx, REPN(9)};
                EpiBf16<DM, false> E{FF, DM / 256, nullptr};
                pg8::gemm_phase<EpiBf16<DM, false>, pg8::DenseOrder, false, DFF, DFF, DFF>(C.lds, C.tid, S, E);
            }
            PEND(9, SEAM(P + 9));
        }
        if (EN(10) && IN(P + 10)) { PT0(10);
            if (moe) { PHASE_CTX; ln_pass<2>(C, layer == DEPTH - 1, (const bf16*)(sc + SC_FF), A->in[24] + layer * DM, A->in[25] + layer * DM, nullptr); }
            else     { PHASE_CTX; ln_pass<0>(C, layer == DEPTH - 1, (const bf16*)(sc + SC_FF), A->in[24] + layer * DM, A->in[25] + layer * DM, nullptr); }
            PEND(10, if (layer < DEPTH - 1) SEAM(P + 10));
        }
    }
#undef IN
#undef SEAM
}

extern "C" void kernel_launch(void* const* d_in, const int* in_sizes, int n_in, void* d_out, int out_size, void* d_ws, size_t ws_size, hipStream_t stream) {
    static int grid = 0;
    if (grid == 0) {
        if (n_in != 26 || out_size != M * DM || ws_size < WS_END) { fprintf(stderr, "kernel_launch: unexpected problem (n_in %d, out %d, ws %zu < %zu)\n", n_in, out_size, ws_size, (size_t)WS_END); grid = -1; return; }
        int dev = 0, cus = 0, per_cu = 0;
        if (hipGetDevice(&dev) != hipSuccess || hipDeviceGetAttribute(&cus, hipDeviceAttributeMultiprocessorCount, dev) != hipSuccess) { grid = -1; return; }
        if (hipFuncSetAttribute((const void*)fwd_kernel, hipFuncAttributeMaxDynamicSharedMemorySize, LDS_BYTES) != hipSuccess) { fprintf(stderr, "kernel_launch: hipFuncSetAttribute failed\n"); grid = -1; return; }
        if (hipOccupancyMaxActiveBlocksPerMultiprocessor(&per_cu, (const void*)fwd_kernel, NTHR, LDS_BYTES) != hipSuccess || per_cu < 1) fprintf(stderr, "kernel_launch: occupancy query says %d\n", per_cu);
        (void)hipGetLastError();
        grid = 256; while (grid > cus && grid > 8) grid >>= 1;
    }
    if (grid < 0) return;
    (void)hipMemsetAsync((char*)d_ws + WS_CTL, 0, CTL_ZERO_BYTES, stream);
    Args a{};
    for (int i = 0; i < 26; ++i) a.in[i] = (const float*)d_in[i];
    a.out = (float*)d_out; a.ws = (unsigned char*)d_ws;
#if MK_PER_PHASE
    for (int p = 0; p < N_PHASES; ++p) { a.ph_lo = p; a.ph_hi = p + 1; hipLaunchKernelGGL(fwd_kernel, dim3(grid), dim3(NTHR), LDS_BYTES, stream, a); }
#else
    a.ph_lo = 0; a.ph_hi = N_PHASES;
    hipLaunchKernelGGL(fwd_kernel, dim3(grid), dim3(NTHR), LDS_BYTES, stream, a);
#endif
}
```
